# Optimizing an MI355X kernel written in HIP

```python
import math
import jax, jax.numpy as jnp
from jax import lax
import numpy as np

D_MODEL = 1024
BATCH = 4
SEQ = 8192
DEPTH = 1

CHUNK = 64
POOL_WIDTH = D_MODEL // 2
POOL_WINDOWS = (2, 4, 8, 16)
N_POOL_GROUPS = len(POOL_WINDOWS)
POOL_GROUP = POOL_WIDTH // N_POOL_GROUPS
ATTN_WIDTH = D_MODEL - POOL_WIDTH
HEAD_DIM = 64
N_HEADS = ATTN_WIDTH // HEAD_DIM
Q_BLOCK = 128
IN_WIDTH = POOL_WIDTH + 3 * ATTN_WIDTH + N_HEADS
N_EXPERTS = 32
TOP_K = 4
D_EXPERT = D_MODEL
SWIGLU_LIMIT = 7.0
SWIGLU_ALPHA = 1.702
EXPERT_BLOCK = 128
RMS_EPS = 1e-5

kernel_name = 'hybrid_pool_fox_moe_block'


def rms_norm(x, g):
    xf = x.astype(jnp.float32)
    y = xf * lax.rsqrt(jnp.mean(xf * xf, axis=-1, keepdims=True) + RMS_EPS)
    return (y * g.astype(jnp.float32)).astype(x.dtype)


def pool_mixer(u, w_pool, pool_scale):
    B, S, _ = u.shape
    uf = u.astype(jnp.float32)
    cs = jnp.cumsum(uf, axis=1)
    t = jnp.arange(S)
    outs = []
    for gi, w in enumerate(POOL_WINDOWS):
        sl = slice(gi * POOL_GROUP, (gi + 1) * POOL_GROUP)
        c = cs[:, :, sl]
        lower = jnp.pad(c[:, :S - w], ((0, 0), (w, 0), (0, 0)))
        cnt = jnp.minimum(t + 1, w).astype(jnp.float32)
        outs.append((c - lower) / cnt[None, :, None] - uf[:, :, sl])
    p = jnp.stack(outs, axis=2).astype(u.dtype)
    y = jnp.einsum('bsgc,gcd->bsgd', p, w_pool).reshape(B, S, POOL_WIDTH)
    return y * pool_scale


def forgetting_attention(q, k, v, log_f):
    B, H, S, Dh = q.shape
    c = jnp.cumsum(log_f, axis=-1)
    kf = k.astype(jnp.float32)
    key_pos = jnp.arange(S)
    scale = HEAD_DIM ** -0.5

    def block(i):
        start = i * Q_BLOCK
        qb = lax.dynamic_slice_in_dim(q, start, Q_BLOCK, axis=2).astype(jnp.float32)
        cb = lax.dynamic_slice_in_dim(c, start, Q_BLOCK, axis=2)
        logits = jnp.einsum('bhqd,bhkd->bhqk', qb, kf) * scale + cb[..., :, None] - c[..., None, :]
        q_pos = start + jnp.arange(Q_BLOCK)
        mask = key_pos[None, :] <= q_pos[:, None]
        logits = jnp.where(mask, logits, -jnp.inf)
        p = jax.nn.softmax(logits, axis=-1)
        return jnp.einsum('bhqk,bhkd->bhqd', p.astype(v.dtype), v)

    out = lax.map(block, jnp.arange(S // Q_BLOCK))
    return jnp.moveaxis(out, 0, 2).reshape(B, H, S, Dh)


def clamped_swiglu(a):
    x_glu, x_lin = a[..., :D_EXPERT], a[..., D_EXPERT:]
    x_glu = jnp.minimum(x_glu, SWIGLU_LIMIT)
    x_lin = jnp.clip(x_lin, -SWIGLU_LIMIT, SWIGLU_LIMIT)
    return x_glu * jax.nn.sigmoid(SWIGLU_ALPHA * x_glu) * (x_lin + 1.0)


def moe_ffn(h, w_router, b_router, w_up, b_up, w_down, b_down):
    B, S, D = h.shape
    T = B * S
    hf = h.reshape(T, D)
    logits = (hf @ w_router).astype(jnp.float32) + b_router.astype(jnp.float32)
    top_vals, top_idx = lax.top_k(logits, TOP_K)
    gates = jax.nn.softmax(top_vals, axis=-1)
    n_assign = T * TOP_K
    flat_e = top_idx.reshape(-1).astype(jnp.int32)
    flat_tok = jnp.arange(n_assign, dtype=jnp.int32) // TOP_K
    order = jnp.argsort(flat_e)
    sorted_e = flat_e[order]
    sorted_tok = flat_tok[order]
    sorted_gate = gates.reshape(-1)[order]
    counts = jnp.bincount(flat_e, length=N_EXPERTS)
    starts = jnp.cumsum(counts) - counts
    padded = (counts + EXPERT_BLOCK - 1) // EXPERT_BLOCK * EXPERT_BLOCK
    pad_ends = jnp.cumsum(padded)
    pad_starts = pad_ends - padded
    dest = pad_starts[sorted_e] + (jnp.arange(n_assign, dtype=jnp.int32) - starts[sorted_e])
    n_rows = n_assign + N_EXPERTS * EXPERT_BLOCK
    n_blocks = n_rows // EXPERT_BLOCK
    row_tok = jnp.full((n_rows,), T, jnp.int32).at[dest].set(sorted_tok)
    row_gate = jnp.zeros((n_rows,), jnp.float32).at[dest].set(sorted_gate)
    block_e = jnp.minimum(
        jnp.searchsorted(pad_ends, jnp.arange(n_blocks) * EXPERT_BLOCK, side='right'),
        N_EXPERTS - 1)
    h_pad = jnp.concatenate([hf, jnp.zeros((1, D), hf.dtype)], axis=0)
    xs = h_pad[row_tok].reshape(n_blocks, EXPERT_BLOCK, D)

    def expert_block(args):
        xb, e = args
        a = xb @ w_up[e] + b_up[e]
        return clamped_swiglu(a) @ w_down[e] + b_down[e]

    ys = lax.map(expert_block, (xs, block_e)).reshape(n_rows, D)
    contrib = ys.astype(jnp.float32) * row_gate[:, None]
    out = jax.ops.segment_sum(contrib, row_tok, num_segments=T + 1)[:T]
    return out.reshape(B, S, D).astype(h.dtype)


def setup_inputs(seed: int = 0) -> dict:
    key = jax.random.key(seed)
    ks = jax.random.split(key, 16)
    f32 = jnp.float32
    L = DEPTH

    def nrm(k, shape, scale):
        return jax.random.normal(k, shape, f32) * scale

    return {
        'x': nrm(ks[0], (BATCH, SEQ, D_MODEL), 1.0),
        'g_mix': 1.0 + nrm(ks[1], (L, D_MODEL), 0.05),
        'w_in': nrm(ks[2], (L, D_MODEL, IN_WIDTH), D_MODEL ** -0.5),
        'b_forget': 2.0 + nrm(ks[3], (L, N_HEADS), 0.5),
        'w_pool': nrm(ks[4], (L, N_POOL_GROUPS, POOL_GROUP, POOL_GROUP), POOL_GROUP ** -0.5),
        'pool_scale': 1.0 + nrm(ks[5], (L, POOL_WIDTH), 0.1),
        'w_out': nrm(ks[6], (L, D_MODEL, D_MODEL), D_MODEL ** -0.5),
        'g_ffn': 1.0 + nrm(ks[7], (L, D_MODEL), 0.05),
        'w_router': nrm(ks[8], (L, D_MODEL, N_EXPERTS), D_MODEL ** -0.5),
        'b_router': nrm(ks[9], (L, N_EXPERTS), 0.01),
        'w_up': nrm(ks[10], (L, N_EXPERTS, D_MODEL, 2 * D_EXPERT), D_MODEL ** -0.5),
        'b_up': nrm(ks[11], (L, N_EXPERTS, 2 * D_EXPERT), 0.01),
        'w_down': nrm(ks[12], (L, N_EXPERTS, D_EXPERT, D_MODEL), D_EXPERT ** -0.5),
        'b_down': nrm(ks[13], (L, N_EXPERTS, D_MODEL), 0.01),
        'g_final': 1.0 + nrm(ks[14], (D_MODEL,), 0.05),
    }


def reference(x, g_mix, w_in, b_forget, w_pool, pool_scale, w_out, g_ffn,
              w_router, b_router, w_up, b_up, w_down, b_down, g_final):
    B, S, D = x.shape
    for l in range(DEPTH):
        h = rms_norm(x, g_mix[l])
        proj = h @ w_in[l]
        o = POOL_WIDTH
        u = proj[..., :o]
        q = proj[..., o:o + ATTN_WIDTH]
        k = proj[..., o + ATTN_WIDTH:o + 2 * ATTN_WIDTH]
        v = proj[..., o + 2 * ATTN_WIDTH:o + 3 * ATTN_WIDTH]
        f_logit = proj[..., o + 3 * ATTN_WIDTH:]
        to_heads = lambda t: t.reshape(B, S, N_HEADS, HEAD_DIM).transpose(0, 2, 1, 3)
        log_f = jax.nn.log_sigmoid(f_logit.astype(jnp.float32) + b_forget[l].astype(jnp.float32))
        log_f = log_f.transpose(0, 2, 1)
        y_pool = pool_mixer(u, w_pool[l], pool_scale[l])
        y_attn = forgetting_attention(to_heads(q), to_heads(k), to_heads(v), log_f)
        y_attn = y_attn.transpose(0, 2, 1, 3).reshape(B, S, ATTN_WIDTH)
        x = x + jnp.concatenate([y_pool, y_attn], axis=-1) @ w_out[l]
        h2 = rms_norm(x, g_ffn[l])
        x = x + moe_ffn(h2, w_router[l], b_router[l], w_up[l], b_up[l], w_down[l], b_down[l])
    return rms_norm(x, g_final)
```

```cpp
#include <hip/hip_runtime.h>
#include <cstdio>
#include <cstdint>

constexpr int BATCH = 4, SEQ = 8192, DM = 1024, T = BATCH * SEQ;
constexpr int PW = 512, AW = 512, NH = 8, HD = 64, INW = PW + 3 * AW + NH;
constexpr int NE = 32, TOPK = 4, DE = 1024;
constexpr float RMS_EPS = 1e-5f, SW_LIMIT = 7.0f, SW_ALPHA = 1.702f;
constexpr float LOG2E = 1.4426950408889634f;
constexpr float C2 = 0.125f * LOG2E;
constexpr int RT = 256;
constexpr int NROWS_PAD = T * TOPK + NE * RT;

typedef unsigned short bf16;
typedef float f32x4 __attribute__((ext_vector_type(4)));
typedef unsigned u32x4 __attribute__((ext_vector_type(4)));
typedef unsigned u32x2 __attribute__((ext_vector_type(2)));

constexpr size_t MiB = 1u << 20;
constexpr size_t WS_CTL = 0;
constexpr size_t WS_LOGF = 1 * MiB;
constexpr size_t WS_CUM = 2 * MiB;
constexpr size_t WS_SEL = 3 * MiB;
constexpr size_t WS_LTK = 4 * MiB;
constexpr size_t WS_LGT = 8 * MiB;
constexpr size_t WS_XN = 12 * MiB;
constexpr size_t WS_WIN = 76 * MiB;
constexpr size_t WS_WO = 80 * MiB;
constexpr size_t WS_WU = 82 * MiB;
constexpr size_t WS_WD = 210 * MiB;
constexpr size_t WS_U = 274 * MiB;
constexpr size_t WS_Q = 306 * MiB;
constexpr size_t WS_K = 338 * MiB;
constexpr size_t WS_V = 370 * MiB;
constexpr size_t WS_CAT = 402 * MiB;
constexpr size_t WS_P = 466 * MiB;
constexpr size_t WS_ACT = 274 * MiB;
constexpr size_t WS_Y = 546 * MiB;
constexpr size_t WS_END = 818 * MiB;
static_assert(WS_ACT + (size_t)NROWS_PAD * 1024 * 2 <= WS_Y, "ACT overlay");
static_assert(WS_Y + (size_t)NROWS_PAD * 1024 * 2 <= WS_END, "Y");
constexpr int CW_CNT = 64;

struct Params {
    const float *x, *g_mix, *w_in, *b_forget, *w_pool, *pool_scale, *w_out, *g_ffn, *w_router, *b_router, *w_up, *b_up, *w_down, *b_down, *g_final;
    float* out; unsigned char* ws;
};

__device__ __forceinline__ unsigned f2bf(float f) { unsigned u = __builtin_bit_cast(unsigned, f); return (u + 0x7fffu + ((u >> 16) & 1u)) >> 16; }
__device__ __forceinline__ unsigned pk2(float lo, float hi) { return f2bf(lo) | (f2bf(hi) << 16); }
__device__ __forceinline__ float bf2f(unsigned short b) { return __builtin_bit_cast(float, (unsigned)b << 16); }
__device__ __forceinline__ float wave_sum(float v) {
#pragma unroll
    for (int o = 1; o < 64; o <<= 1) v += __shfl_xor(v, o);
    return v;
}

__global__ void __launch_bounds__(512) k_prologue(Params p) {
    __shared__ float wf[1024 * 8];
    const int tid = threadIdx.x, lane = tid & 63, wave = tid >> 6;
    for (int i = tid; i < 1024 * 8; i += 512) wf[i] = p.w_in[(size_t)(i >> 3) * INW + 2048 + (i & 7)];
    if (blockIdx.x == 0 && tid < 64) ((int*)(p.ws + WS_CTL))[CW_CNT + tid] = 0;
    __syncthreads();
    bf16* XN = (bf16*)(p.ws + WS_XN); float* LOGF = (float*)(p.ws + WS_LOGF);
    const int gw = blockIdx.x * 8 + wave, NGW = gridDim.x * 8;
    f32x4 g[4];
#pragma unroll
    for (int j = 0; j < 4; ++j) g[j] = *(const f32x4*)(p.g_mix + 4 * lane + 256 * j);
    for (int m = gw; m < T; m += NGW) {
        const float* xr = p.x + (size_t)m * DM;
        f32x4 v[4]; float ss = 0.f;
#pragma unroll
        for (int j = 0; j < 4; ++j) { v[j] = *(const f32x4*)(xr + 4 * lane + 256 * j); ss += v[j].x * v[j].x + v[j].y * v[j].y + v[j].z * v[j].z + v[j].w * v[j].w; }
        const float rstd = rsqrtf(wave_sum(ss) * (1.f / DM) + RMS_EPS);
        float fl[8];
#pragma unroll
        for (int e = 0; e < 8; ++e) fl[e] = 0.f;
#pragma unroll
        for (int j = 0; j < 4; ++j) {
            v[j] = v[j] * rstd * g[j];
#pragma unroll
            for (int i = 0; i < 4; ++i) {
                const int d = 4 * lane + 256 * j + i; const float hv = v[j][i];
                const f32x4 w0 = *(const f32x4*)(wf + d * 8), w1 = *(const f32x4*)(wf + d * 8 + 4);
                fl[0] += hv * w0.x; fl[1] += hv * w0.y; fl[2] += hv * w0.z; fl[3] += hv * w0.w;
                fl[4] += hv * w1.x; fl[5] += hv * w1.y; fl[6] += hv * w1.z; fl[7] += hv * w1.w;
            }
            u32x2 o; o.x = pk2(v[j].x, v[j].y); o.y = pk2(v[j].z, v[j].w);
            *(u32x2*)(XN + (size_t)m * DM + 4 * lane + 256 * j) = o;
        }
#pragma unroll
        for (int e = 0; e < 8; ++e) fl[e] = wave_sum(fl[e]);
        if (lane < 8) {
            float z = 0.f;
#pragma unroll
            for (int e = 0; e < 8; ++e) if (lane == e) z = fl[e];
            z += p.b_forget[lane];
            const float ls = fminf(z, 0.f) - log1pf(expf(-fabsf(z)));
            const int b = m / SEQ, s = m % SEQ;
            LOGF[((size_t)b * NH + lane) * SEQ + s] = ls;
        }
    }
}

__global__ void __launch_bounds__(512) k_cumsum(Params p) {
    __shared__ double part[512];
    const int tid = threadIdx.x;
    const float* LOGF = (const float*)(p.ws + WS_LOGF); float* CUM = (float*)(p.ws + WS_CUM);
    for (int bh = blockIdx.x; bh < BATCH * NH; bh += gridDim.x) {
        const float* src = LOGF + (size_t)bh * SEQ + tid * 16; float v[16]; double s = 0.0;
#pragma unroll
        for (int i = 0; i < 16; ++i) { v[i] = src[i]; s += (double)v[i]; }
        part[tid] = s; __syncthreads();
        if (tid == 0) { double a = 0.0; for (int i = 0; i < 512; ++i) { const double t_ = part[i]; part[i] = a; a += t_; } }
        __syncthreads();
        double a = part[tid];
        float* dst = CUM + (size_t)bh * SEQ + tid * 16;
#pragma unroll
        for (int i = 0; i < 16; ++i) { a += (double)v[i]; dst[i] = (float)(a * (double)LOG2E); }
        __syncthreads();
    }
}

__global__ void __launch_bounds__(512) k_pool(Params p, bf16* dst, int ldd) {
    const bf16* U = (const bf16*)(p.ws + WS_U);
    const size_t total = (size_t)T * 64;
    for (size_t i = (size_t)blockIdx.x * 512 + threadIdx.x; i < total; i += (size_t)gridDim.x * 512) {
        const int row = (int)(i >> 6), ch = (int)(i & 63), c0 = ch * 8, g = c0 >> 7, w = 2 << g, t = row % SEQ;
        const int n = t + 1 < w ? t + 1 : w;
        float acc[8], self[8];
#pragma unroll
        for (int k = 0; k < 8; ++k) acc[k] = 0.f;
        for (int j = 0; j < n; ++j) {
            const u32x4 r = *(const u32x4*)(U + (size_t)(row - j) * PW + c0);
            const unsigned rr[4] = {r.x, r.y, r.z, r.w};
#pragma unroll
            for (int k = 0; k < 4; ++k) { const float lo = __builtin_bit_cast(float, rr[k] << 16), hi = __builtin_bit_cast(float, rr[k] & 0xffff0000u); acc[2 * k] += lo; acc[2 * k + 1] += hi;
                if (j == 0) { self[2 * k] = lo; self[2 * k + 1] = hi; } }
        }
        const float inv = 1.f / (float)n; u32x4 o;
        o.x = pk2(acc[0] * inv - self[0], acc[1] * inv - self[1]); o.y = pk2(acc[2] * inv - self[2], acc[3] * inv - self[3]);
        o.z = pk2(acc[4] * inv - self[4], acc[5] * inv - self[5]); o.w = pk2(acc[6] * inv - self[6], acc[7] * inv - self[7]);
        *(u32x4*)(dst + (size_t)row * ldd + c0) = o;
    }
}

template <class ARow, class Epi, bool DUAL>
__device__ __forceinline__ void naive_tile(int tm, int tn, int K, const ARow& arow, const float* W, const float* W2, int ldw, const Epi& epi, float* lds) {
    float* As = lds;
    float* Ws = lds + 16 * 68;
    float* Ws2 = Ws + 16 * 128;
    const int tid = threadIdx.x, tx = tid & 31, ty = tid >> 5;
    float acc[4][4], acc2[4][4];
#pragma unroll
    for (int i = 0; i < 4; ++i)
#pragma unroll
        for (int j = 0; j < 4; ++j) { acc[i][j] = 0.f; acc2[i][j] = 0.f; }
    const int ar = tid >> 3, ak = (tid & 7) * 2;
    const bf16* aptr = arow(tm * 64 + ar);
    const int wk = tid >> 5, wc = (tid & 31) * 4;
    for (int k0 = 0; k0 < K; k0 += 16) {
        unsigned av = aptr ? *(const unsigned*)(aptr + k0 + ak) : 0u;
        const f32x4 wv = *(const f32x4*)(W + (size_t)(k0 + wk) * ldw + tn * 128 + wc);
        f32x4 wv2; if (DUAL) wv2 = *(const f32x4*)(W2 + (size_t)(k0 + wk) * ldw + tn * 128 + wc);
        __syncthreads();
        As[ak * 68 + ar] = __builtin_bit_cast(float, av << 16); As[(ak + 1) * 68 + ar] = __builtin_bit_cast(float, av & 0xffff0000u);
        *(f32x4*)(Ws + wk * 128 + wc) = wv; if (DUAL) *(f32x4*)(Ws2 + wk * 128 + wc) = wv2;
        __syncthreads();
#pragma unroll
        for (int k = 0; k < 16; ++k) {
            const f32x4 a = *(const f32x4*)(As + k * 68 + ty * 4), w = *(const f32x4*)(Ws + k * 128 + tx * 4);
#pragma unroll
            for (int i = 0; i < 4; ++i)
#pragma unroll
                for (int j = 0; j < 4; ++j) acc[i][j] += a[i] * w[j];
            if (DUAL) { const f32x4 w2 = *(const f32x4*)(Ws2 + k * 128 + tx * 4);
#pragma unroll
                for (int i = 0; i < 4; ++i)
#pragma unroll
                    for (int j = 0; j < 4; ++j) acc2[i][j] += a[i] * w2[j]; }
        }
    }
#pragma unroll
    for (int i = 0; i < 4; ++i) epi(tm * 64 + ty * 4 + i, tn * 128 + tx * 4, acc[i], acc2[i]);
}
constexpr int NAIVE_LDS_FLOATS = 16 * 68 + 2 * 16 * 128;

struct ARowPlain { const bf16* A; int lda; __device__ __forceinline__ const bf16* operator()(int r) const { return A + (size_t)r * lda; } };
struct EpiInproj { bf16* U; __device__ __forceinline__ void operator()(int r, int c, const float (&a)[4], const float (&)[4]) const {
        const int t = c >> 9, cc = c & 511; const float s = (t == 1) ? C2 : 1.f;
        u32x2 o; o.x = pk2(a[0] * s, a[1] * s); o.y = pk2(a[2] * s, a[3] * s);
        *(u32x2*)(U + (size_t)t * ((WS_Q - WS_U) / 2) + (size_t)r * 512 + cc) = o; } };
__global__ void __launch_bounds__(512) k_inproj_naive(Params p) {
    __shared__ __attribute__((aligned(16))) float lds[NAIVE_LDS_FLOATS];
    ARowPlain ar{(const bf16*)(p.ws + WS_XN), DM}; EpiInproj ep{(bf16*)(p.ws + WS_U)};
    const int nM = T / 64, nN = 2048 / 128;
    for (int u = blockIdx.x; u < nM * nN; u += gridDim.x) naive_tile<ARowPlain, EpiInproj, false>(u / nN, u % nN, DM, ar, p.w_in, nullptr, INW, ep, lds);
}
struct EpiPool { bf16* CAT; const float* ps; int g; __device__ __forceinline__ void operator()(int r, int c, const float (&a)[4], const float (&)[4]) const {
        const int cc = g * 128 + c; const f32x4 s = *(const f32x4*)(ps + cc);
        u32x2 o; o.x = pk2(a[0] * s.x, a[1] * s.y); o.y = pk2(a[2] * s.z, a[3] * s.w);
        *(u32x2*)(CAT + (size_t)r * DM + cc) = o; } };
__global__ void __launch_bounds__(512) k_poolgemm_naive(Params p) {
    __shared__ __attribute__((aligned(16))) float lds[NAIVE_LDS_FLOATS];
    const int nM = T / 64;
    for (int u = blockIdx.x; u < nM * 4; u += gridDim.x) { const int g = u & 3, tm = u >> 2;
        ARowPlain ar{(const bf16*)(p.ws + WS_P) + g * 128, PW}; EpiPool ep{(bf16*)(p.ws + WS_CAT), p.pool_scale, g};
        naive_tile<ARowPlain, EpiPool, false>(tm, 0, 128, ar, p.w_pool + (size_t)g * 128 * 128, nullptr, 128, ep, lds); }
}
struct EpiOut { const float* x; float* out; __device__ __forceinline__ void operator()(int r, int c, const float (&a)[4], const float (&)[4]) const {
        const f32x4 xv = *(const f32x4*)(x + (size_t)r * DM + c); f32x4 o = {xv.x + a[0], xv.y + a[1], xv.z + a[2], xv.w + a[3]};
        *(f32x4*)(out + (size_t)r * DM + c) = o; } };
__global__ void __launch_bounds__(512) k_outproj_naive(Params p) {
    __shared__ __attribute__((aligned(16))) float lds[NAIVE_LDS_FLOATS];
    ARowPlain ar{(const bf16*)(p.ws + WS_CAT), DM}; EpiOut ep{p.x, p.out};
    const int nM = T / 64, nN = DM / 128;
    for (int u = blockIdx.x; u < nM * nN; u += gridDim.x) naive_tile<ARowPlain, EpiOut, false>(u / nN, u % nN, DM, ar, p.w_out, nullptr, DM, ep, lds);
}

__global__ void __launch_bounds__(512) k_attn_naive(Params p) {
    __shared__ __attribute__((aligned(16))) float Ks[64 * 68];
    __shared__ __attribute__((aligned(16))) float Vs[64 * 64];
    __shared__ float Ss[64 * 65];
    __shared__ float cs[64];
    const bf16* Q = (const bf16*)(p.ws + WS_Q); const bf16* K = (const bf16*)(p.ws + WS_K); const bf16* V = (const bf16*)(p.ws + WS_V);
    bf16* CAT = (bf16*)(p.ws + WS_CAT); const float* CUM = (const float*)(p.ws + WS_CUM);
    const int tid = threadIdx.x, r = tid >> 3, part = tid & 7;
    for (int u = blockIdx.x; u < BATCH * NH * (SEQ / 64); u += gridDim.x) {
        const int qb = (SEQ / 64 - 1) - (u / (BATCH * NH)), bh = u % (BATCH * NH), b = bh / NH, h = bh % NH;
        const size_t rowbase = (size_t)b * SEQ; const int t = qb * 64 + r;
        float q[64];
        { const bf16* qp = Q + (rowbase + t) * AW + h * HD;
#pragma unroll
          for (int i = 0; i < 64; i += 2) { const unsigned v = *(const unsigned*)(qp + i); q[i] = __builtin_bit_cast(float, v << 16); q[i + 1] = __builtin_bit_cast(float, v & 0xffff0000u); } }
        const float ct = CUM[(size_t)bh * SEQ + t];
        float o[8]; float m = -INFINITY, l = 0.f;
#pragma unroll
        for (int i = 0; i < 8; ++i) o[i] = 0.f;
        for (int kt = 0; kt <= qb; ++kt) {
            __syncthreads();
            { const int kr = tid >> 3, kc = (tid & 7) * 8;
              const u32x4 kv = *(const u32x4*)(K + (rowbase + kt * 64 + kr) * AW + h * HD + kc), vv = *(const u32x4*)(V + (rowbase + kt * 64 + kr) * AW + h * HD + kc);
              const unsigned ka[4] = {kv.x, kv.y, kv.z, kv.w}, va[4] = {vv.x, vv.y, vv.z, vv.w};
#pragma unroll
              for (int i = 0; i < 4; ++i) { Ks[kr * 68 + kc + 2 * i] = __builtin_bit_cast(float, ka[i] << 16); Ks[kr * 68 + kc + 2 * i + 1] = __builtin_bit_cast(float, ka[i] & 0xffff0000u);
                  Vs[kr * 64 + kc + 2 * i] = __builtin_bit_cast(float, va[i] << 16); Vs[kr * 64 + kc + 2 * i + 1] = __builtin_bit_cast(float, va[i] & 0xffff0000u); }
              if (tid < 64) cs[tid] = CUM[(size_t)bh * SEQ + kt * 64 + tid]; }
            __syncthreads();
            float lg[8]; float mx = -INFINITY;
#pragma unroll
            for (int j = 0; j < 8; ++j) { const int s = part * 8 + j; float d = 0.f;
#pragma unroll
                for (int i = 0; i < 64; i += 4) { const f32x4 kk = *(const f32x4*)(Ks + s * 68 + i); d += q[i] * kk.x + q[i + 1] * kk.y + q[i + 2] * kk.z + q[i + 3] * kk.w; }
                d += ct - cs[s]; if (kt * 64 + s > t) d = -INFINITY; lg[j] = d; mx = fmaxf(mx, d); }
            mx = fmaxf(mx, __shfl_xor(mx, 1)); mx = fmaxf(mx, __shfl_xor(mx, 2)); mx = fmaxf(mx, __shfl_xor(mx, 4));
            const float mn = fmaxf(m, mx); const float alpha = exp2f(m - mn); float ps = 0.f;
#pragma unroll
            for (int j = 0; j < 8; ++j) { const float pv = exp2f(lg[j] - mn); ps += pv; Ss[r * 65 + part * 8 + j] = pv; }
            ps += __shfl_xor(ps, 1); ps += __shfl_xor(ps, 2); ps += __shfl_xor(ps, 4);
            l = l * alpha + ps; m = mn;
#pragma unroll
            for (int i = 0; i < 8; ++i) o[i] *= alpha;
            __syncthreads();
            for (int s = 0; s < 64; ++s) { const float pv = Ss[r * 65 + s]; const f32x4 v0 = *(const f32x4*)(Vs + s * 64 + part * 8), v1 = *(const f32x4*)(Vs + s * 64 + part * 8 + 4);
                o[0] += pv * v0.x; o[1] += pv * v0.y; o[2] += pv * v0.z; o[3] += pv * v0.w; o[4] += pv * v1.x; o[5] += pv * v1.y; o[6] += pv * v1.z; o[7] += pv * v1.w; }
        }
        const float il = 1.f / l; u32x4 ov;
        ov.x = pk2(o[0] * il, o[1] * il); ov.y = pk2(o[2] * il, o[3] * il); ov.z = pk2(o[4] * il, o[5] * il); ov.w = pk2(o[6] * il, o[7] * il);
        *(u32x4*)(CAT + (rowbase + t) * DM + PW + h * HD + part * 8) = ov;
    }
}

__global__ void __launch_bounds__(512) k_router(Params p) {
    __shared__ __attribute__((aligned(16))) float wr[1024 * 32];
    __shared__ int ch_e[128 * 4]; __shared__ float ch_g[128 * 4]; __shared__ int lcnt[32], lbase[32];
    const int tid = threadIdx.x, lane = tid & 63, wave = tid >> 6;
    for (int i = tid; i < 1024 * 32 / 4; i += 512) ((f32x4*)wr)[i] = ((const f32x4*)p.w_router)[i];
    __syncthreads();
    const float* X1 = p.out; bf16* H2 = (bf16*)(p.ws + WS_XN);
    int* cnt = (int*)(p.ws + WS_CTL) + CW_CNT; int* SEL = (int*)(p.ws + WS_SEL); int* LTK = (int*)(p.ws + WS_LTK); float* LGT = (float*)(p.ws + WS_LGT);
    f32x4 g[4];
#pragma unroll
    for (int j = 0; j < 4; ++j) g[j] = *(const f32x4*)(p.g_ffn + 4 * lane + 256 * j);
    const float br = p.b_router[lane & 31];
    for (int grp = blockIdx.x; grp < T / 128; grp += gridDim.x) {
        if (tid < 32) lcnt[tid] = 0;
        __syncthreads();
        for (int it = 0; it < 16; ++it) {
            const int lt = wave * 16 + it, m = grp * 128 + lt;
            const float* xr = X1 + (size_t)m * DM;
            f32x4 v[4]; float ss = 0.f;
#pragma unroll
            for (int j = 0; j < 4; ++j) { v[j] = *(const f32x4*)(xr + 4 * lane + 256 * j); ss += v[j].x * v[j].x + v[j].y * v[j].y + v[j].z * v[j].z + v[j].w * v[j].w; }
            const float rstd = rsqrtf(wave_sum(ss) * (1.f / DM) + RMS_EPS);
            float lg[32];
#pragma unroll
            for (int e = 0; e < 32; ++e) lg[e] = 0.f;
#pragma unroll
            for (int j = 0; j < 4; ++j) {
                v[j] = v[j] * rstd * g[j];
                u32x2 o; o.x = pk2(v[j].x, v[j].y); o.y = pk2(v[j].z, v[j].w);
                *(u32x2*)(H2 + (size_t)m * DM + 4 * lane + 256 * j) = o;
#pragma unroll
                for (int i = 0; i < 4; ++i) { const int d = 4 * lane + 256 * j + i; const float hv = v[j][i];
#pragma unroll
                    for (int e4 = 0; e4 < 8; ++e4) { const f32x4 w = *(const f32x4*)(wr + d * 32 + e4 * 4);
                        lg[e4 * 4] += hv * w.x; lg[e4 * 4 + 1] += hv * w.y; lg[e4 * 4 + 2] += hv * w.z; lg[e4 * 4 + 3] += hv * w.w; }
                    asm volatile("" ::: "memory"); }
            }
            float mine;
            {
                float a16[16];
                const bool up = lane >= 32;
#pragma unroll
                for (int e = 0; e < 16; ++e) { const float keep = up ? lg[16 + e] : lg[e], give = up ? lg[e] : lg[16 + e]; a16[e] = keep + __shfl_xor(give, 32); }
                float a8[8]; const bool u16 = (lane & 16) != 0;
#pragma unroll
                for (int e = 0; e < 8; ++e) { const float keep = u16 ? a16[8 + e] : a16[e], give = u16 ? a16[e] : a16[8 + e]; a8[e] = keep + __shfl_xor(give, 16); }
                float a4[4]; const bool u8 = (lane & 8) != 0;
#pragma unroll
                for (int e = 0; e < 4; ++e) { const float keep = u8 ? a8[4 + e] : a8[e], give = u8 ? a8[e] : a8[4 + e]; a4[e] = keep + __shfl_xor(give, 8); }
                float a2[2]; const bool u4 = (lane & 4) != 0;
#pragma unroll
                for (int e = 0; e < 2; ++e) { const float keep = u4 ? a4[2 + e] : a4[e], give = u4 ? a4[e] : a4[2 + e]; a2[e] = keep + __shfl_xor(give, 4); }
                const bool u2 = (lane & 2) != 0;
                float a1 = (u2 ? a2[1] : a2[0]) + __shfl_xor(u2 ? a2[0] : a2[1], 2);
                a1 += __shfl_xor(a1, 1);
                mine = a1;
            }
            const int myexp = ((lane >> 5) & 1) * 16 + ((lane >> 4) & 1) * 8 + ((lane >> 3) & 1) * 4 + ((lane >> 2) & 1) * 2 + ((lane >> 1) & 1);
            float val = mine + p.b_router[myexp]; (void)br;
            if (lane & 1) val = -INFINITY;
            float tv[4]; int ti[4];
#pragma unroll
            for (int k = 0; k < 4; ++k) {
                float bv = val; int bi = myexp;
#pragma unroll
                for (int o = 1; o < 64; o <<= 1) { const float ov = __shfl_xor(bv, o); const int oi = __shfl_xor(bi, o); if (ov > bv || (ov == bv && oi < bi)) { bv = ov; bi = oi; } }
                tv[k] = bv; ti[k] = bi; if (myexp == bi) val = -INFINITY;
            }
            const float e0 = 1.f, e1 = expf(tv[1] - tv[0]), e2 = expf(tv[2] - tv[0]), e3 = expf(tv[3] - tv[0]); const float inv = 1.f / (e0 + e1 + e2 + e3);
            if (lane < 4) { const float gg = (lane == 0 ? e0 : lane == 1 ? e1 : lane == 2 ? e2 : e3) * inv; const int ee = lane == 0 ? ti[0] : lane == 1 ? ti[1] : lane == 2 ? ti[2] : ti[3];
                ch_e[lt * 4 + lane] = ee; ch_g[lt * 4 + lane] = gg; atomicAdd(&lcnt[ee], 1); }
        }
        __syncthreads();
        if (tid < 32) { lbase[tid] = atomicAdd(&cnt[tid], lcnt[tid]); lcnt[tid] = 0; }
        __syncthreads();
        { const int e = ch_e[tid]; const int slot = lbase[e] + atomicAdd(&lcnt[e], 1); const int tk = (grp * 128 + (tid >> 2)) * 4 + (tid & 3);
          LTK[(size_t)e * T + slot] = tk; LGT[(size_t)e * T + slot] = ch_g[tid]; SEL[tk] = (slot << 5) | e; }
        __syncthreads();
    }
}

struct ExpertMap { int cnt[32]; int pstart[33]; };
__device__ __forceinline__ void load_expert_map(const int* cnt, int* s_cnt, int* s_ps) {
    if (threadIdx.x == 0) { int a = 0; for (int e = 0; e < 32; ++e) { const int c = cnt[e]; s_cnt[e] = c; s_ps[e] = a; a += ((c + RT - 1) / RT) * RT; } s_ps[32] = a; }
}
struct ARowGather { const bf16* H2; const int* ltk; int pstart, cnt; __device__ __forceinline__ const bf16* operator()(int r) const { const int s = r - pstart; return s < cnt ? H2 + (size_t)(ltk[s] >> 2) * DM : nullptr; } };
struct EpiUp { bf16* ACT; const float* bu; __device__ __forceinline__ void operator()(int r, int c, const float (&a)[4], const float (&a2)[4]) const {
        const f32x4 bg = *(const f32x4*)(bu + c), bl = *(const f32x4*)(bu + DE + c); float o[4];
#pragma unroll
        for (int i = 0; i < 4; ++i) { const float gl = fminf(a[i] + bg[i], SW_LIMIT), li = fminf(fmaxf(a2[i] + bl[i], -SW_LIMIT), SW_LIMIT); o[i] = gl * (1.f / (1.f + expf(-SW_ALPHA * gl))) * (li + 1.f); }
        u32x2 ov; ov.x = pk2(o[0], o[1]); ov.y = pk2(o[2], o[3]); *(u32x2*)(ACT + (size_t)r * DE + c) = ov; } };
__global__ void __launch_bounds__(512) k_up_naive(Params p) {
    __shared__ __attribute__((aligned(16))) float lds[NAIVE_LDS_FLOATS]; __shared__ int s_cnt[32], s_ps[33];
    load_expert_map((const int*)(p.ws + WS_CTL) + CW_CNT, s_cnt, s_ps); __syncthreads();
    const int ntm = s_ps[32] / 64, nN = DE / 128;
    for (int u = blockIdx.x; u < ntm * nN; u += gridDim.x) { const int tm = u / nN, tn = u % nN; int e = 0; while (s_ps[e + 1] <= tm * 64) ++e;
        if (tm * 64 - s_ps[e] >= s_cnt[e]) continue;
        ARowGather ar{(const bf16*)(p.ws + WS_XN), (const int*)(p.ws + WS_LTK) + (size_t)e * T, s_ps[e], s_cnt[e]}; EpiUp ep{(bf16*)(p.ws + WS_ACT), p.b_up + (size_t)e * 2 * DE};
        naive_tile<ARowGather, EpiUp, true>(tm, tn, DM, ar, p.w_up + (size_t)e * DM * 2 * DE, p.w_up + (size_t)e * DM * 2 * DE + DE, 2 * DE, ep, lds); }
}
struct ARowAct { const bf16* ACT; int pstart, cnt; __device__ __forceinline__ const bf16* operator()(int r) const { return (r - pstart) < cnt ? ACT + (size_t)r * DE : nullptr; } };
struct EpiDown { bf16* Y; const float* bd; const float* lgt; int pstart, cnt; __device__ __forceinline__ void operator()(int r, int c, const float (&a)[4], const float (&)[4]) const {
        const int s = r - pstart; if (s >= cnt) return; const float gt = lgt[s]; const f32x4 b = *(const f32x4*)(bd + c);
        u32x2 ov; ov.x = pk2((a[0] + b.x) * gt, (a[1] + b.y) * gt); ov.y = pk2((a[2] + b.z) * gt, (a[3] + b.w) * gt); *(u32x2*)(Y + (size_t)r * DM + c) = ov; } };
__global__ void __launch_bounds__(512) k_down_naive(Params p) {
    __shared__ __attribute__((aligned(16))) float lds[NAIVE_LDS_FLOATS]; __shared__ int s_cnt[32], s_ps[33];
    load_expert_map((const int*)(p.ws + WS_CTL) + CW_CNT, s_cnt, s_ps); __syncthreads();
    const int ntm = s_ps[32] / 64, nN = DM / 128;
    for (int u = blockIdx.x; u < ntm * nN; u += gridDim.x) { const int tm = u / nN, tn = u % nN; int e = 0; while (s_ps[e + 1] <= tm * 64) ++e;
        if (tm * 64 - s_ps[e] >= s_cnt[e]) continue;
        ARowAct ar{(const bf16*)(p.ws + WS_ACT), s_ps[e], s_cnt[e]}; EpiDown ep{(bf16*)(p.ws + WS_Y), p.b_down + (size_t)e * DM, (const float*)(p.ws + WS_LGT) + (size_t)e * T, s_ps[e], s_cnt[e]};
        naive_tile<ARowAct, EpiDown, false>(tm, tn, DE, ar, p.w_down + (size_t)e * DE * DM, nullptr, DM, ep, lds); }
}

__global__ void __launch_bounds__(512) k_final(Params p) {
    __shared__ int s_cnt[32], s_ps[33];
    load_expert_map((const int*)(p.ws + WS_CTL) + CW_CNT, s_cnt, s_ps); __syncthreads();
    const int tid = threadIdx.x, lane = tid & 63, wave = tid >> 6;
    const int* SEL = (const int*)(p.ws + WS_SEL); const bf16* Y = (const bf16*)(p.ws + WS_Y);
    f32x4 g[4];
#pragma unroll
    for (int j = 0; j < 4; ++j) g[j] = *(const f32x4*)(p.g_final + 4 * lane + 256 * j);
    for (int m = blockIdx.x * 8 + wave; m < T; m += gridDim.x * 8) {
        float* xr = p.out + (size_t)m * DM; f32x4 v[4];
#pragma unroll
        for (int j = 0; j < 4; ++j) v[j] = *(const f32x4*)(xr + 4 * lane + 256 * j);
#pragma unroll
        for (int k = 0; k < 4; ++k) { const int sv = SEL[m * 4 + k]; const int e = sv & 31, slot = sv >> 5; const bf16* yr = Y + (size_t)(s_ps[e] + slot) * DM;
#pragma unroll
            for (int j = 0; j < 4; ++j) { const u32x2 y = *(const u32x2*)(yr + 4 * lane + 256 * j);
                v[j].x += __builtin_bit_cast(float, y.x << 16); v[j].y += __builtin_bit_cast(float, y.x & 0xffff0000u); v[j].z += __builtin_bit_cast(float, y.y << 16); v[j].w += __builtin_bit_cast(float, y.y & 0xffff0000u); } }
        float ss = 0.f;
#pragma unroll
        for (int j = 0; j < 4; ++j) ss += v[j].x * v[j].x + v[j].y * v[j].y + v[j].z * v[j].z + v[j].w * v[j].w;
        const float rstd = rsqrtf(wave_sum(ss) * (1.f / DM) + RMS_EPS);
#pragma unroll
        for (int j = 0; j < 4; ++j) *(f32x4*)(xr + 4 * lane + 256 * j) = v[j] * rstd * g[j];
    }
}

extern "C" void kernel_launch(void* const* d_in, const int* in_sizes, int n_in, void* d_out, int out_size, void* d_ws, size_t ws_size, hipStream_t stream) {
    if (n_in != 15 || out_size != T * DM || ws_size < WS_END) { fprintf(stderr, "kernel_launch: unexpected shapes (n_in %d out %d ws %zu)\n", n_in, out_size, ws_size); return; }
    Params p{};
    p.x = (const float*)d_in[0]; p.g_mix = (const float*)d_in[1]; p.w_in = (const float*)d_in[2]; p.b_forget = (const float*)d_in[3]; p.w_pool = (const float*)d_in[4];
    p.pool_scale = (const float*)d_in[5]; p.w_out = (const float*)d_in[6]; p.g_ffn = (const float*)d_in[7]; p.w_router = (const float*)d_in[8]; p.b_router = (const float*)d_in[9];
    p.w_up = (const float*)d_in[10]; p.b_up = (const float*)d_in[11]; p.w_down = (const float*)d_in[12]; p.b_down = (const float*)d_in[13]; p.g_final = (const float*)d_in[14];
    p.out = (float*)d_out; p.ws = (unsigned char*)d_ws;
    const int G = 1024;
    k_prologue<<<G, 512, 0, stream>>>(p);
    k_cumsum<<<32, 512, 0, stream>>>(p);
    k_inproj_naive<<<2048, 512, 0, stream>>>(p);
    k_pool<<<2048, 512, 0, stream>>>(p, (bf16*)((unsigned char*)d_ws + WS_P), PW);
    k_poolgemm_naive<<<2048, 512, 0, stream>>>(p);
    k_attn_naive<<<BATCH * NH * (SEQ / 64), 512, 0, stream>>>(p);
    k_outproj_naive<<<2048, 512, 0, stream>>>(p);
    k_router<<<256, 512, 0, stream>>>(p);
    k_up_naive<<<4096, 512, 0, stream>>>(p);
    k_down_naive<<<4096, 512, 0, stream>>>(p);
    k_final<<<G, 512, 0, stream>>>(p);
}
```

```cpp
#define MK_MODE 2
#include <hip/hip_runtime.h>
#include <cstdio>
#include <cstdint>

constexpr int BATCH = 4, SEQ = 8192, DM = 1024, T = BATCH * SEQ;
constexpr int PW = 512, AW = 512, NH = 8, HD = 64, INW = PW + 3 * AW + NH;
constexpr int NE = 32, TOPK = 4, DE = 1024;
constexpr float RMS_EPS = 1e-5f, SW_LIMIT = 7.0f, SW_ALPHA = 1.702f;
constexpr float LOG2E = 1.4426950408889634f;
constexpr float C2 = 0.125f * LOG2E;
constexpr int RT = 256;
constexpr int NROWS_PAD = T * TOPK + NE * RT;

typedef unsigned short bf16;
typedef float f32x4 __attribute__((ext_vector_type(4)));
typedef unsigned u32x4 __attribute__((ext_vector_type(4)));
typedef unsigned u32x2 __attribute__((ext_vector_type(2)));

constexpr size_t MiB = 1u << 20;
constexpr size_t WS_CTL = 0;
constexpr size_t WS_LOGF = 1 * MiB;
constexpr size_t WS_CUM = 2 * MiB;
constexpr size_t WS_SEL = 3 * MiB;
constexpr size_t WS_LTK = 4 * MiB;
constexpr size_t WS_LGT = 8 * MiB;
constexpr size_t WS_XN = 12 * MiB;
constexpr size_t WS_WIN = 76 * MiB;
constexpr size_t WS_WO = 80 * MiB;
constexpr size_t WS_WU = 82 * MiB;
constexpr size_t WS_WD = 210 * MiB;
constexpr size_t WS_U = 274 * MiB;
constexpr size_t WS_Q = 306 * MiB;
constexpr size_t WS_K = 338 * MiB;
constexpr size_t WS_V = 370 * MiB;
constexpr size_t WS_CAT = 402 * MiB;
constexpr size_t WS_P = 466 * MiB;
constexpr size_t WS_ACT = 274 * MiB;
constexpr size_t WS_Y = 546 * MiB;
constexpr size_t WS_END = 818 * MiB;
static_assert(WS_ACT + (size_t)NROWS_PAD * 1024 * 2 <= WS_Y, "ACT overlay");
static_assert(WS_Y + (size_t)NROWS_PAD * 1024 * 2 <= WS_END, "Y");
constexpr int CW_CNT = 64;

struct Params {
    const float *x, *g_mix, *w_in, *b_forget, *w_pool, *pool_scale, *w_out, *g_ffn, *w_router, *b_router, *w_up, *b_up, *w_down, *b_down, *g_final;
    float* out; unsigned char* ws;
};

__device__ __forceinline__ unsigned f2bf(float f) { unsigned u = __builtin_bit_cast(unsigned, f); return (u + 0x7fffu + ((u >> 16) & 1u)) >> 16; }
__device__ __forceinline__ unsigned pk2(float lo, float hi) { return f2bf(lo) | (f2bf(hi) << 16); }
__device__ __forceinline__ float bf2f(unsigned short b) { return __builtin_bit_cast(float, (unsigned)b << 16); }
__device__ __forceinline__ float wave_sum(float v) {
#pragma unroll
    for (int o = 1; o < 64; o <<= 1) v += __shfl_xor(v, o);
    return v;
}

__global__ void __launch_bounds__(512) k_prologue(Params p) {
    __shared__ float wf[1024 * 8];
    const int tid = threadIdx.x, lane = tid & 63, wave = tid >> 6;
    for (int i = tid; i < 1024 * 8; i += 512) wf[i] = p.w_in[(size_t)(i >> 3) * INW + 2048 + (i & 7)];
    if (blockIdx.x == 0 && tid < 64) ((int*)(p.ws + WS_CTL))[CW_CNT + tid] = 0;
    __syncthreads();
    bf16* XN = (bf16*)(p.ws + WS_XN); float* LOGF = (float*)(p.ws + WS_LOGF);
    const int gw = blockIdx.x * 8 + wave, NGW = gridDim.x * 8;
    f32x4 g[4];
#pragma unroll
    for (int j = 0; j < 4; ++j) g[j] = *(const f32x4*)(p.g_mix + 4 * lane + 256 * j);
    for (int m = gw; m < T; m += NGW) {
        const float* xr = p.x + (size_t)m * DM;
        f32x4 v[4]; float ss = 0.f;
#pragma unroll
        for (int j = 0; j < 4; ++j) { v[j] = *(const f32x4*)(xr + 4 * lane + 256 * j); ss += v[j].x * v[j].x + v[j].y * v[j].y + v[j].z * v[j].z + v[j].w * v[j].w; }
        const float rstd = rsqrtf(wave_sum(ss) * (1.f / DM) + RMS_EPS);
        float fl[8];
#pragma unroll
        for (int e = 0; e < 8; ++e) fl[e] = 0.f;
#pragma unroll
        for (int j = 0; j < 4; ++j) {
            v[j] = v[j] * rstd * g[j];
#pragma unroll
            for (int i = 0; i < 4; ++i) {
                const int d = 4 * lane + 256 * j + i; const float hv = v[j][i];
                const f32x4 w0 = *(const f32x4*)(wf + d * 8), w1 = *(const f32x4*)(wf + d * 8 + 4);
                fl[0] += hv * w0.x; fl[1] += hv * w0.y; fl[2] += hv * w0.z; fl[3] += hv * w0.w;
                fl[4] += hv * w1.x; fl[5] += hv * w1.y; fl[6] += hv * w1.z; fl[7] += hv * w1.w;
            }
            u32x2 o; o.x = pk2(v[j].x, v[j].y); o.y = pk2(v[j].z, v[j].w);
            *(u32x2*)(XN + (size_t)m * DM + 4 * lane + 256 * j) = o;
        }
#pragma unroll
        for (int e = 0; e < 8; ++e) fl[e] = wave_sum(fl[e]);
        if (lane < 8) {
            float z = 0.f;
#pragma unroll
            for (int e = 0; e < 8; ++e) if (lane == e) z = fl[e];
            z += p.b_forget[lane];
            const float ls = fminf(z, 0.f) - log1pf(expf(-fabsf(z)));
            const int b = m / SEQ, s = m % SEQ;
            LOGF[((size_t)b * NH + lane) * SEQ + s] = ls;
        }
    }
}

__global__ void __launch_bounds__(512) k_cumsum(Params p) {
    __shared__ double part[512];
    const int tid = threadIdx.x;
    const float* LOGF = (const float*)(p.ws + WS_LOGF); float* CUM = (float*)(p.ws + WS_CUM);
    for (int bh = blockIdx.x; bh < BATCH * NH; bh += gridDim.x) {
        const float* src = LOGF + (size_t)bh * SEQ + tid * 16; float v[16]; double s = 0.0;
#pragma unroll
        for (int i = 0; i < 16; ++i) { v[i] = src[i]; s += (double)v[i]; }
        part[tid] = s; __syncthreads();
        if (tid == 0) { double a = 0.0; for (int i = 0; i < 512; ++i) { const double t_ = part[i]; part[i] = a; a += t_; } }
        __syncthreads();
        double a = part[tid];
        float* dst = CUM + (size_t)bh * SEQ + tid * 16;
#pragma unroll
        for (int i = 0; i < 16; ++i) { a += (double)v[i]; dst[i] = (float)(a * (double)LOG2E); }
        __syncthreads();
    }
}

__global__ void __launch_bounds__(512) k_pool(Params p, bf16* dst, int ldd) {
    const bf16* U = (const bf16*)(p.ws + WS_U);
    const size_t total = (size_t)T * 64;
    for (size_t i = (size_t)blockIdx.x * 512 + threadIdx.x; i < total; i += (size_t)gridDim.x * 512) {
        const int row = (int)(i >> 6), ch = (int)(i & 63), c0 = ch * 8, g = c0 >> 7, w = 2 << g, t = row % SEQ;
        const int n = t + 1 < w ? t + 1 : w;
        float acc[8], self[8];
#pragma unroll
        for (int k = 0; k < 8; ++k) acc[k] = 0.f;
        for (int j = 0; j < n; ++j) {
            const u32x4 r = *(const u32x4*)(U + (size_t)(row - j) * PW + c0);
            const unsigned rr[4] = {r.x, r.y, r.z, r.w};
#pragma unroll
            for (int k = 0; k < 4; ++k) { const float lo = __builtin_bit_cast(float, rr[k] << 16), hi = __builtin_bit_cast(float, rr[k] & 0xffff0000u); acc[2 * k] += lo; acc[2 * k + 1] += hi;
                if (j == 0) { self[2 * k] = lo; self[2 * k + 1] = hi; } }
        }
        const float inv = 1.f / (float)n; u32x4 o;
        o.x = pk2(acc[0] * inv - self[0], acc[1] * inv - self[1]); o.y = pk2(acc[2] * inv - self[2], acc[3] * inv - self[3]);
        o.z = pk2(acc[4] * inv - self[4], acc[5] * inv - self[5]); o.w = pk2(acc[6] * inv - self[6], acc[7] * inv - self[7]);
        *(u32x4*)(dst + (size_t)row * ldd + c0) = o;
    }
}

template <class ARow, class Epi, bool DUAL>
__device__ __forceinline__ void naive_tile(int tm, int tn, int K, const ARow& arow, const float* W, const float* W2, int ldw, const Epi& epi, float* lds) {
    float* As = lds;
    float* Ws = lds + 16 * 68;
    float* Ws2 = Ws + 16 * 128;
    const int tid = threadIdx.x, tx = tid & 31, ty = tid >> 5;
    float acc[4][4], acc2[4][4];
#pragma unroll
    for (int i = 0; i < 4; ++i)
#pragma unroll
        for (int j = 0; j < 4; ++j) { acc[i][j] = 0.f; acc2[i][j] = 0.f; }
    const int ar = tid >> 3, ak = (tid & 7) * 2;
    const bf16* aptr = arow(tm * 64 + ar);
    const int wk = tid >> 5, wc = (tid & 31) * 4;
    for (int k0 = 0; k0 < K; k0 += 16) {
        unsigned av = aptr ? *(const unsigned*)(aptr + k0 + ak) : 0u;
        const f32x4 wv = *(const f32x4*)(W + (size_t)(k0 + wk) * ldw + tn * 128 + wc);
        f32x4 wv2; if (DUAL) wv2 = *(const f32x4*)(W2 + (size_t)(k0 + wk) * ldw + tn * 128 + wc);
        __syncthreads();
        As[ak * 68 + ar] = __builtin_bit_cast(float, av << 16); As[(ak + 1) * 68 + ar] = __builtin_bit_cast(float, av & 0xffff0000u);
        *(f32x4*)(Ws + wk * 128 + wc) = wv; if (DUAL) *(f32x4*)(Ws2 + wk * 128 + wc) = wv2;
        __syncthreads();
#pragma unroll
        for (int k = 0; k < 16; ++k) {
            const f32x4 a = *(const f32x4*)(As + k * 68 + ty * 4), w = *(const f32x4*)(Ws + k * 128 + tx * 4);
#pragma unroll
            for (int i = 0; i < 4; ++i)
#pragma unroll
                for (int j = 0; j < 4; ++j) acc[i][j] += a[i] * w[j];
            if (DUAL) { const f32x4 w2 = *(const f32x4*)(Ws2 + k * 128 + tx * 4);
#pragma unroll
                for (int i = 0; i < 4; ++i)
#pragma unroll
                    for (int j = 0; j < 4; ++j) acc2[i][j] += a[i] * w2[j]; }
        }
    }
#pragma unroll
    for (int i = 0; i < 4; ++i) epi(tm * 64 + ty * 4 + i, tn * 128 + tx * 4, acc[i], acc2[i]);
}
constexpr int NAIVE_LDS_FLOATS = 16 * 68 + 2 * 16 * 128;

struct ARowPlain { const bf16* A; int lda; __device__ __forceinline__ const bf16* operator()(int r) const { return A + (size_t)r * lda; } };
struct EpiInproj { bf16* U; __device__ __forceinline__ void operator()(int r, int c, const float (&a)[4], const float (&)[4]) const {
        const int t = c >> 9, cc = c & 511; const float s = (t == 1) ? C2 : 1.f;
        u32x2 o; o.x = pk2(a[0] * s, a[1] * s); o.y = pk2(a[2] * s, a[3] * s);
        *(u32x2*)(U + (size_t)t * ((WS_Q - WS_U) / 2) + (size_t)r * 512 + cc) = o; } };
__global__ void __launch_bounds__(512) k_inproj_naive(Params p) {
    __shared__ __attribute__((aligned(16))) float lds[NAIVE_LDS_FLOATS];
    ARowPlain ar{(const bf16*)(p.ws + WS_XN), DM}; EpiInproj ep{(bf16*)(p.ws + WS_U)};
    const int nM = T / 64, nN = 2048 / 128;
    for (int u = blockIdx.x; u < nM * nN; u += gridDim.x) naive_tile<ARowPlain, EpiInproj, false>(u / nN, u % nN, DM, ar, p.w_in, nullptr, INW, ep, lds);
}
struct EpiPool { bf16* CAT; const float* ps; int g; __device__ __forceinline__ void operator()(int r, int c, const float (&a)[4], const float (&)[4]) const {
        const int cc = g * 128 + c; const f32x4 s = *(const f32x4*)(ps + cc);
        u32x2 o; o.x = pk2(a[0] * s.x, a[1] * s.y); o.y = pk2(a[2] * s.z, a[3] * s.w);
        *(u32x2*)(CAT + (size_t)r * DM + cc) = o; } };
__global__ void __launch_bounds__(512) k_poolgemm_naive(Params p) {
    __shared__ __attribute__((aligned(16))) float lds[NAIVE_LDS_FLOATS];
    const int nM = T / 64;
    for (int u = blockIdx.x; u < nM * 4; u += gridDim.x) { const int g = u & 3, tm = u >> 2;
        ARowPlain ar{(const bf16*)(p.ws + WS_P) + g * 128, PW}; EpiPool ep{(bf16*)(p.ws + WS_CAT), p.pool_scale, g};
        naive_tile<ARowPlain, EpiPool, false>(tm, 0, 128, ar, p.w_pool + (size_t)g * 128 * 128, nullptr, 128, ep, lds); }
}
struct EpiOut { const float* x; float* out; __device__ __forceinline__ void operator()(int r, int c, const float (&a)[4], const float (&)[4]) const {
        const f32x4 xv = *(const f32x4*)(x + (size_t)r * DM + c); f32x4 o = {xv.x + a[0], xv.y + a[1], xv.z + a[2], xv.w + a[3]};
        *(f32x4*)(out + (size_t)r * DM + c) = o; } };
__global__ void __launch_bounds__(512) k_outproj_naive(Params p) {
    __shared__ __attribute__((aligned(16))) float lds[NAIVE_LDS_FLOATS];
    ARowPlain ar{(const bf16*)(p.ws + WS_CAT), DM}; EpiOut ep{p.x, p.out};
    const int nM = T / 64, nN = DM / 128;
    for (int u = blockIdx.x; u < nM * nN; u += gridDim.x) naive_tile<ARowPlain, EpiOut, false>(u / nN, u % nN, DM, ar, p.w_out, nullptr, DM, ep, lds);
}

__global__ void __launch_bounds__(512) k_attn_naive(Params p) {
    __shared__ __attribute__((aligned(16))) float Ks[64 * 68];
    __shared__ __attribute__((aligned(16))) float Vs[64 * 64];
    __shared__ float Ss[64 * 65];
    __shared__ float cs[64];
    const bf16* Q = (const bf16*)(p.ws + WS_Q); const bf16* K = (const bf16*)(p.ws + WS_K); const bf16* V = (const bf16*)(p.ws + WS_V);
    bf16* CAT = (bf16*)(p.ws + WS_CAT); const float* CUM = (const float*)(p.ws + WS_CUM);
    const int tid = threadIdx.x, r = tid >> 3, part = tid & 7;
    for (int u = blockIdx.x; u < BATCH * NH * (SEQ / 64); u += gridDim.x) {
        const int qb = (SEQ / 64 - 1) - (u / (BATCH * NH)), bh = u % (BATCH * NH), b = bh / NH, h = bh % NH;
        const size_t rowbase = (size_t)b * SEQ; const int t = qb * 64 + r;
        float q[64];
        { const bf16* qp = Q + (rowbase + t) * AW + h * HD;
#pragma unroll
          for (int i = 0; i < 64; i += 2) { const unsigned v = *(const unsigned*)(qp + i); q[i] = __builtin_bit_cast(float, v << 16); q[i + 1] = __builtin_bit_cast(float, v & 0xffff0000u); } }
        const float ct = CUM[(size_t)bh * SEQ + t];
        float o[8]; float m = -INFINITY, l = 0.f;
#pragma unroll
        for (int i = 0; i < 8; ++i) o[i] = 0.f;
        for (int kt = 0; kt <= qb; ++kt) {
            __syncthreads();
            { const int kr = tid >> 3, kc = (tid & 7) * 8;
              const u32x4 kv = *(const u32x4*)(K + (rowbase + kt * 64 + kr) * AW + h * HD + kc), vv = *(const u32x4*)(V + (rowbase + kt * 64 + kr) * AW + h * HD + kc);
              const unsigned ka[4] = {kv.x, kv.y, kv.z, kv.w}, va[4] = {vv.x, vv.y, vv.z, vv.w};
#pragma unroll
              for (int i = 0; i < 4; ++i) { Ks[kr * 68 + kc + 2 * i] = __builtin_bit_cast(float, ka[i] << 16); Ks[kr * 68 + kc + 2 * i + 1] = __builtin_bit_cast(float, ka[i] & 0xffff0000u);
                  Vs[kr * 64 + kc + 2 * i] = __builtin_bit_cast(float, va[i] << 16); Vs[kr * 64 + kc + 2 * i + 1] = __builtin_bit_cast(float, va[i] & 0xffff0000u); }
              if (tid < 64) cs[tid] = CUM[(size_t)bh * SEQ + kt * 64 + tid]; }
            __syncthreads();
            float lg[8]; float mx = -INFINITY;
#pragma unroll
            for (int j = 0; j < 8; ++j) { const int s = part * 8 + j; float d = 0.f;
#pragma unroll
                for (int i = 0; i < 64; i += 4) { const f32x4 kk = *(const f32x4*)(Ks + s * 68 + i); d += q[i] * kk.x + q[i + 1] * kk.y + q[i + 2] * kk.z + q[i + 3] * kk.w; }
                d += ct - cs[s]; if (kt * 64 + s > t) d = -INFINITY; lg[j] = d; mx = fmaxf(mx, d); }
            mx = fmaxf(mx, __shfl_xor(mx, 1)); mx = fmaxf(mx, __shfl_xor(mx, 2)); mx = fmaxf(mx, __shfl_xor(mx, 4));
            const float mn = fmaxf(m, mx); const float alpha = exp2f(m - mn); float ps = 0.f;
#pragma unroll
            for (int j = 0; j < 8; ++j) { const float pv = exp2f(lg[j] - mn); ps += pv; Ss[r * 65 + part * 8 + j] = pv; }
            ps += __shfl_xor(ps, 1); ps += __shfl_xor(ps, 2); ps += __shfl_xor(ps, 4);
            l = l * alpha + ps; m = mn;
#pragma unroll
            for (int i = 0; i < 8; ++i) o[i] *= alpha;
            __syncthreads();
            for (int s = 0; s < 64; ++s) { const float pv = Ss[r * 65 + s]; const f32x4 v0 = *(const f32x4*)(Vs + s * 64 + part * 8), v1 = *(const f32x4*)(Vs + s * 64 + part * 8 + 4);
                o[0] += pv * v0.x; o[1] += pv * v0.y; o[2] += pv * v0.z; o[3] += pv * v0.w; o[4] += pv * v1.x; o[5] += pv * v1.y; o[6] += pv * v1.z; o[7] += pv * v1.w; }
        }
        const float il = 1.f / l; u32x4 ov;
        ov.x = pk2(o[0] * il, o[1] * il); ov.y = pk2(o[2] * il, o[3] * il); ov.z = pk2(o[4] * il, o[5] * il); ov.w = pk2(o[6] * il, o[7] * il);
        *(u32x4*)(CAT + (rowbase + t) * DM + PW + h * HD + part * 8) = ov;
    }
}

__global__ void __launch_bounds__(512) k_router(Params p) {
    __shared__ __attribute__((aligned(16))) float wr[1024 * 32];
    __shared__ int ch_e[128 * 4]; __shared__ float ch_g[128 * 4]; __shared__ int lcnt[32], lbase[32];
    const int tid = threadIdx.x, lane = tid & 63, wave = tid >> 6;
    for (int i = tid; i < 1024 * 32 / 4; i += 512) ((f32x4*)wr)[i] = ((const f32x4*)p.w_router)[i];
    __syncthreads();
    const float* X1 = p.out; bf16* H2 = (bf16*)(p.ws + WS_XN);
    int* cnt = (int*)(p.ws + WS_CTL) + CW_CNT; int* SEL = (int*)(p.ws + WS_SEL); int* LTK = (int*)(p.ws + WS_LTK); float* LGT = (float*)(p.ws + WS_LGT);
    f32x4 g[4];
#pragma unroll
    for (int j = 0; j < 4; ++j) g[j] = *(const f32x4*)(p.g_ffn + 4 * lane + 256 * j);
    const float br = p.b_router[lane & 31];
    for (int grp = blockIdx.x; grp < T / 128; grp += gridDim.x) {
        if (tid < 32) lcnt[tid] = 0;
        __syncthreads();
        for (int it = 0; it < 16; ++it) {
            const int lt = wave * 16 + it, m = grp * 128 + lt;
            const float* xr = X1 + (size_t)m * DM;
            f32x4 v[4]; float ss = 0.f;
#pragma unroll
            for (int j = 0; j < 4; ++j) { v[j] = *(const f32x4*)(xr + 4 * lane + 256 * j); ss += v[j].x * v[j].x + v[j].y * v[j].y + v[j].z * v[j].z + v[j].w * v[j].w; }
            const float rstd = rsqrtf(wave_sum(ss) * (1.f / DM) + RMS_EPS);
            float lg[32];
#pragma unroll
            for (int e = 0; e < 32; ++e) lg[e] = 0.f;
#pragma unroll
            for (int j = 0; j < 4; ++j) {
                v[j] = v[j] * rstd * g[j];
                u32x2 o; o.x = pk2(v[j].x, v[j].y); o.y = pk2(v[j].z, v[j].w);
                *(u32x2*)(H2 + (size_t)m * DM + 4 * lane + 256 * j) = o;
#pragma unroll
                for (int i = 0; i < 4; ++i) { const int d = 4 * lane + 256 * j + i; const float hv = v[j][i];
#pragma unroll
                    for (int e4 = 0; e4 < 8; ++e4) { const f32x4 w = *(const f32x4*)(wr + d * 32 + e4 * 4);
                        lg[e4 * 4] += hv * w.x; lg[e4 * 4 + 1] += hv * w.y; lg[e4 * 4 + 2] += hv * w.z; lg[e4 * 4 + 3] += hv * w.w; }
                    asm volatile("" ::: "memory"); }
            }
            float mine;
            {
                float a16[16];
                const bool up = lane >= 32;
#pragma unroll
                for (int e = 0; e < 16; ++e) { const float keep = up ? lg[16 + e] : lg[e], give = up ? lg[e] : lg[16 + e]; a16[e] = keep + __shfl_xor(give, 32); }
                float a8[8]; const bool u16 = (lane & 16) != 0;
#pragma unroll
                for (int e = 0; e < 8; ++e) { const float keep = u16 ? a16[8 + e] : a16[e], give = u16 ? a16[e] : a16[8 + e]; a8[e] = keep + __shfl_xor(give, 16); }
                float a4[4]; const bool u8 = (lane & 8) != 0;
#pragma unroll
                for (int e = 0; e < 4; ++e) { const float keep = u8 ? a8[4 + e] : a8[e], give = u8 ? a8[e] : a8[4 + e]; a4[e] = keep + __shfl_xor(give, 8); }
                float a2[2]; const bool u4 = (lane & 4) != 0;
#pragma unroll
                for (int e = 0; e < 2; ++e) { const float keep = u4 ? a4[2 + e] : a4[e], give = u4 ? a4[e] : a4[2 + e]; a2[e] = keep + __shfl_xor(give, 4); }
                const bool u2 = (lane & 2) != 0;
                float a1 = (u2 ? a2[1] : a2[0]) + __shfl_xor(u2 ? a2[0] : a2[1], 2);
                a1 += __shfl_xor(a1, 1);
                mine = a1;
            }
            const int myexp = ((lane >> 5) & 1) * 16 + ((lane >> 4) & 1) * 8 + ((lane >> 3) & 1) * 4 + ((lane >> 2) & 1) * 2 + ((lane >> 1) & 1);
            float val = mine + p.b_router[myexp]; (void)br;
            if (lane & 1) val = -INFINITY;
            float tv[4]; int ti[4];
#pragma unroll
            for (int k = 0; k < 4; ++k) {
                float bv = val; int bi = myexp;
#pragma unroll
                for (int o = 1; o < 64; o <<= 1) { const float ov = __shfl_xor(bv, o); const int oi = __shfl_xor(bi, o); if (ov > bv || (ov == bv && oi < bi)) { bv = ov; bi = oi; } }
                tv[k] = bv; ti[k] = bi; if (myexp == bi) val = -INFINITY;
            }
            const float e0 = 1.f, e1 = expf(tv[1] - tv[0]), e2 = expf(tv[2] - tv[0]), e3 = expf(tv[3] - tv[0]); const float inv = 1.f / (e0 + e1 + e2 + e3);
            if (lane < 4) { const float gg = (lane == 0 ? e0 : lane == 1 ? e1 : lane == 2 ? e2 : e3) * inv; const int ee = lane == 0 ? ti[0] : lane == 1 ? ti[1] : lane == 2 ? ti[2] : ti[3];
                ch_e[lt * 4 + lane] = ee; ch_g[lt * 4 + lane] = gg; atomicAdd(&lcnt[ee], 1); }
        }
        __syncthreads();
        if (tid < 32) { lbase[tid] = atomicAdd(&cnt[tid], lcnt[tid]); lcnt[tid] = 0; }
        __syncthreads();
        { const int e = ch_e[tid]; const int slot = lbase[e] + atomicAdd(&lcnt[e], 1); const int tk = (grp * 128 + (tid >> 2)) * 4 + (tid & 3);
          LTK[(size_t)e * T + slot] = tk; LGT[(size_t)e * T + slot] = ch_g[tid]; SEL[tk] = (slot << 5) | e; }
        __syncthreads();
    }
}

struct ExpertMap { int cnt[32]; int pstart[33]; };
__device__ __forceinline__ void load_expert_map(const int* cnt, int* s_cnt, int* s_ps) {
    if (threadIdx.x == 0) { int a = 0; for (int e = 0; e < 32; ++e) { const int c = cnt[e]; s_cnt[e] = c; s_ps[e] = a; a += ((c + RT - 1) / RT) * RT; } s_ps[32] = a; }
}
struct ARowGather { const bf16* H2; const int* ltk; int pstart, cnt; __device__ __forceinline__ const bf16* operator()(int r) const { const int s = r - pstart; return s < cnt ? H2 + (size_t)(ltk[s] >> 2) * DM : nullptr; } };
struct EpiUp { bf16* ACT; const float* bu; __device__ __forceinline__ void operator()(int r, int c, const float (&a)[4], const float (&a2)[4]) const {
        const f32x4 bg = *(const f32x4*)(bu + c), bl = *(const f32x4*)(bu + DE + c); float o[4];
#pragma unroll
        for (int i = 0; i < 4; ++i) { const float gl = fminf(a[i] + bg[i], SW_LIMIT), li = fminf(fmaxf(a2[i] + bl[i], -SW_LIMIT), SW_LIMIT); o[i] = gl * (1.f / (1.f + expf(-SW_ALPHA * gl))) * (li + 1.f); }
        u32x2 ov; ov.x = pk2(o[0], o[1]); ov.y = pk2(o[2], o[3]); *(u32x2*)(ACT + (size_t)r * DE + c) = ov; } };
__global__ void __launch_bounds__(512) k_up_naive(Params p) {
    __shared__ __attribute__((aligned(16))) float lds[NAIVE_LDS_FLOATS]; __shared__ int s_cnt[32], s_ps[33];
    load_expert_map((const int*)(p.ws + WS_CTL) + CW_CNT, s_cnt, s_ps); __syncthreads();
    const int ntm = s_ps[32] / 64, nN = DE / 128;
    for (int u = blockIdx.x; u < ntm * nN; u += gridDim.x) { const int tm = u / nN, tn = u % nN; int e = 0; while (s_ps[e + 1] <= tm * 64) ++e;
        if (tm * 64 - s_ps[e] >= s_cnt[e]) continue;
        ARowGather ar{(const bf16*)(p.ws + WS_XN), (const int*)(p.ws + WS_LTK) + (size_t)e * T, s_ps[e], s_cnt[e]}; EpiUp ep{(bf16*)(p.ws + WS_ACT), p.b_up + (size_t)e * 2 * DE};
        naive_tile<ARowGather, EpiUp, true>(tm, tn, DM, ar, p.w_up + (size_t)e * DM * 2 * DE, p.w_up + (size_t)e * DM * 2 * DE + DE, 2 * DE, ep, lds); }
}
struct ARowAct { const bf16* ACT; int pstart, cnt; __device__ __forceinline__ const bf16* operator()(int r) const { return (r - pstart) < cnt ? ACT + (size_t)r * DE : nullptr; } };
struct EpiDown { bf16* Y; const float* bd; const float* lgt; int pstart, cnt; __device__ __forceinline__ void operator()(int r, int c, const float (&a)[4], const float (&)[4]) const {
        const int s = r - pstart; if (s >= cnt) return; const float gt = lgt[s]; const f32x4 b = *(const f32x4*)(bd + c);
        u32x2 ov; ov.x = pk2((a[0] + b.x) * gt, (a[1] + b.y) * gt); ov.y = pk2((a[2] + b.z) * gt, (a[3] + b.w) * gt); *(u32x2*)(Y + (size_t)r * DM + c) = ov; } };
__global__ void __launch_bounds__(512) k_down_naive(Params p) {
    __shared__ __attribute__((aligned(16))) float lds[NAIVE_LDS_FLOATS]; __shared__ int s_cnt[32], s_ps[33];
    load_expert_map((const int*)(p.ws + WS_CTL) + CW_CNT, s_cnt, s_ps); __syncthreads();
    const int ntm = s_ps[32] / 64, nN = DM / 128;
    for (int u = blockIdx.x; u < ntm * nN; u += gridDim.x) { const int tm = u / nN, tn = u % nN; int e = 0; while (s_ps[e + 1] <= tm * 64) ++e;
        if (tm * 64 - s_ps[e] >= s_cnt[e]) continue;
        ARowAct ar{(const bf16*)(p.ws + WS_ACT), s_ps[e], s_cnt[e]}; EpiDown ep{(bf16*)(p.ws + WS_Y), p.b_down + (size_t)e * DM, (const float*)(p.ws + WS_LGT) + (size_t)e * T, s_ps[e], s_cnt[e]};
        naive_tile<ARowAct, EpiDown, false>(tm, tn, DE, ar, p.w_down + (size_t)e * DE * DM, nullptr, DM, ep, lds); }
}

__global__ void __launch_bounds__(512) k_final(Params p) {
    __shared__ int s_cnt[32], s_ps[33];
    load_expert_map((const int*)(p.ws + WS_CTL) + CW_CNT, s_cnt, s_ps); __syncthreads();
    const int tid = threadIdx.x, lane = tid & 63, wave = tid >> 6;
    const int* SEL = (const int*)(p.ws + WS_SEL); const bf16* Y = (const bf16*)(p.ws + WS_Y);
    f32x4 g[4];
#pragma unroll
    for (int j = 0; j < 4; ++j) g[j] = *(const f32x4*)(p.g_final + 4 * lane + 256 * j);
    for (int m = blockIdx.x * 8 + wave; m < T; m += gridDim.x * 8) {
        float* xr = p.out + (size_t)m * DM; f32x4 v[4];
#pragma unroll
        for (int j = 0; j < 4; ++j) v[j] = *(const f32x4*)(xr + 4 * lane + 256 * j);
#pragma unroll
        for (int k = 0; k < 4; ++k) { const int sv = SEL[m * 4 + k]; const int e = sv & 31, slot = sv >> 5; const bf16* yr = Y + (size_t)(s_ps[e] + slot) * DM;
#pragma unroll
            for (int j = 0; j < 4; ++j) { const u32x2 y = *(const u32x2*)(yr + 4 * lane + 256 * j);
                v[j].x += __builtin_bit_cast(float, y.x << 16); v[j].y += __builtin_bit_cast(float, y.x & 0xffff0000u); v[j].z += __builtin_bit_cast(float, y.y << 16); v[j].w += __builtin_bit_cast(float, y.y & 0xffff0000u); } }
        float ss = 0.f;
#pragma unroll
        for (int j = 0; j < 4; ++j) ss += v[j].x * v[j].x + v[j].y * v[j].y + v[j].z * v[j].z + v[j].w * v[j].w;
        const float rstd = rsqrtf(wave_sum(ss) * (1.f / DM) + RMS_EPS);
#pragma unroll
        for (int j = 0; j < 4; ++j) *(f32x4*)(xr + 4 * lane + 256 * j) = v[j] * rstd * g[j];
    }
}

namespace pg8 {
#define PG8_LAS __attribute__((address_space(3)))
typedef unsigned short bf16_t;
typedef short bf16x8 __attribute__((ext_vector_type(8)));
typedef float f32x4 __attribute__((ext_vector_type(4)));
typedef unsigned u32x4 __attribute__((ext_vector_type(4)));
constexpr int BM = 256, BK = 64, HALF = 128, HTB = HALF * BK * 2  , STAGE_BYTES = 8 * HTB, NXCD = 8, WGM = 8;

__host__ __device__ __forceinline__ int lds_byte(int r, int c) { const int st = (r >> 4) * 2 + (c >> 5), rr = r & 15, cc = c & 31, ob = rr * 64 + cc * 2; return st * 1024 + (ob ^ (((ob >> 9) & 1) << 5)); }
__host__ __device__ __forceinline__ void stage_rc(int b, int& R, int& C) { const int st = b / 1024, sb = b % 1024, swz = sb ^ (((sb >> 9) & 1) << 5); R = (st >> 1) * 16 + swz / 64; C = (st & 1) * 32 + (swz % 64) / 2; }
__host__ __device__ __forceinline__ int perm32(int rho) { const int n = rho >> 4, i = rho & 15; return 8 * (i >> 2) + 4 * n + (i & 3); }

struct Unit { int pm, pn, e, lrow0; size_t boff; };
struct Gemm { const bf16_t* A; const bf16_t* Bt; int K; };

struct StaticOrder {
    int nM, nN, nwg, G, c;
    __host__ __device__ void init(int M, int N, int G_, int c_) { nM = M / BM; nN = N / BM; nwg = nM * nN; G = G_; c = c_; }
    __host__ __device__ bool next(int i, Unit& u) const {
        const long L = (long)i * G + c; if (L >= nwg) return false;
        int wgid = (int)L; { const int q = nwg / NXCD, r = nwg % NXCD, xcd = wgid % NXCD, off = wgid / NXCD; wgid = (xcd < r ? xcd * (q + 1) : r * (q + 1) + (xcd - r) * q) + off; }
        const int nig = WGM * nN, gid = wgid / nig, fm = gid * WGM, gsz = (nM - fm) < WGM ? (nM - fm) : WGM;
        u.pm = fm + ((wgid % nig) % gsz); u.pn = (wgid % nig) / gsz; u.e = 0; u.lrow0 = 0; u.boff = 0; return true;
    }
};
template <int NCOL> struct MoeOrder {
    const PG8_LAS int* pt; int G, c; size_t bstride;
    __device__ __forceinline__ bool next(int i, Unit& u) const {
        const int L = i * G + c; const int nrt = pt[32]; if (L >= nrt * NCOL) return false;
        const int rt = L / NCOL; int e = 0;
#pragma unroll 1
        for (int j = 1; j < 32; ++j) e += (pt[j] <= rt) ? 1 : 0;
        u.pm = rt; u.pn = L % NCOL; u.e = e; u.lrow0 = (rt - pt[e]) * BM; u.boff = (size_t)e * bstride; return true;
    }
};

__device__ __forceinline__ unsigned cvt_pk_bf16(float lo, float hi) { unsigned r; asm volatile("v_cvt_pk_bf16_f32 %0, %1, %2" : "=v"(r) : "v"(lo), "v"(hi)); return r; }

struct EpiInproj {
    static constexpr bool PERM = true;
    bf16_t* O; size_t split_stride; float qscale;
    __device__ __forceinline__ void operator()(const f32x4 (&acc)[2][2][4][2], const Unit& u, int wr, int wc, int fr, int fq) const {
        const int row0 = u.pm * BM + wr * 64 + fr; int colt = u.pn * BM; const int t = colt >> 9; bf16_t* base = O + (size_t)t * split_stride; colt -= t * 512;
        const float sc = (t == 1) ? qscale : 1.f; const int col0 = colt + wc * 32 + 8 * fq;
#pragma unroll
        for (int ai = 0; ai < 2; ++ai)
#pragma unroll
            for (int m = 0; m < 4; ++m) { bf16_t* rowp = base + (size_t)(row0 + ai * HALF + m * 16) * 512 + col0;
#pragma unroll
                for (int bj = 0; bj < 2; ++bj) { const f32x4 v0 = acc[ai][bj][m][0] * sc, v1 = acc[ai][bj][m][1] * sc;
                    u32x4 w; w.x = cvt_pk_bf16(v0[0], v0[1]); w.y = cvt_pk_bf16(v0[2], v0[3]); w.z = cvt_pk_bf16(v1[0], v1[1]); w.w = cvt_pk_bf16(v1[2], v1[3]);
                    *(u32x4*)(rowp + bj * HALF) = w; } }
    }
};
struct EpiResF32 {
    static constexpr bool PERM = false;
    const float* x; float* out;
    __device__ __forceinline__ void operator()(const f32x4 (&acc)[2][2][4][2], const Unit& u, int wr, int wc, int fr, int fq) const {
        const int row0 = u.pm * BM + wr * 64 + fr, col0 = u.pn * BM + wc * 32 + 4 * fq;
#pragma unroll
        for (int ai = 0; ai < 2; ++ai)
#pragma unroll
            for (int m = 0; m < 4; ++m) { const size_t off = (size_t)(row0 + ai * HALF + m * 16) * 1024 + col0;
#pragma unroll
                for (int bj = 0; bj < 2; ++bj)
#pragma unroll
                    for (int n = 0; n < 2; ++n) { const f32x4 xv = *(const f32x4*)(x + off + bj * HALF + n * 16); *(f32x4*)(out + off + bj * HALF + n * 16) = xv + acc[ai][bj][m][n]; }
                if (m & 1) asm volatile("" ::: "memory"); }
    }
};
__device__ __forceinline__ float swiglu1(float g, float l) {
    const float gl = fminf(g, 7.0f), li = fminf(fmaxf(l, -7.0f), 7.0f);
    const float sg = __builtin_amdgcn_rcpf(1.0f + __builtin_amdgcn_exp2f(gl * (-1.702f * 1.4426950408889634f)));
    return gl * sg * (li + 1.0f);
}
struct EpiSwiglu {
    static constexpr bool PERM = true;
    bf16_t* ACT; const float* bup;
    __device__ __forceinline__ void operator()(const f32x4 (&acc)[2][2][4][2], const Unit& u, int wr, int wc, int fr, int fq) const {
        const int row0 = u.pm * BM + wr * 64 + fr, col0 = u.pn * HALF + wc * 32 + 8 * fq;
        const float* bb = bup + (size_t)u.e * 2048 + col0;
        f32x4 bg[2], bl[2];
#pragma unroll
        for (int n = 0; n < 2; ++n) { bg[n] = *(const f32x4*)(bb + 4 * n); bl[n] = *(const f32x4*)(bb + 1024 + 4 * n); }
#pragma unroll
        for (int ai = 0; ai < 2; ++ai)
#pragma unroll
            for (int m = 0; m < 4; ++m) { bf16_t* rowp = ACT + (size_t)(row0 + ai * HALF + m * 16) * 1024 + col0;
                const f32x4 g0 = acc[ai][0][m][0] + bg[0], g1 = acc[ai][0][m][1] + bg[1], l0 = acc[ai][1][m][0] + bl[0], l1 = acc[ai][1][m][1] + bl[1];
                u32x4 w; w.x = cvt_pk_bf16(swiglu1(g0[0], l0[0]), swiglu1(g0[1], l0[1])); w.y = cvt_pk_bf16(swiglu1(g0[2], l0[2]), swiglu1(g0[3], l0[3]));
                w.z = cvt_pk_bf16(swiglu1(g1[0], l1[0]), swiglu1(g1[1], l1[1])); w.w = cvt_pk_bf16(swiglu1(g1[2], l1[2]), swiglu1(g1[3], l1[3]));
                *(u32x4*)rowp = w; }
    }
};
struct EpiDown {
    static constexpr bool PERM = true;
    bf16_t* Y; const float* bdn; const float* lgt; const PG8_LAS int* cnt; int Ttok;
    __device__ __forceinline__ void operator()(const f32x4 (&acc)[2][2][4][2], const Unit& u, int wr, int wc, int fr, int fq) const {
        const int rl = wr * 64 + fr, col0 = u.pn * BM + wc * 32 + 8 * fq; const int ce = cnt[u.e];
        const float* bb = bdn + (size_t)u.e * 1024 + col0; const float* gp = lgt + (size_t)u.e * Ttok + u.lrow0;
        f32x4 bv[2][2];
#pragma unroll
        for (int bj = 0; bj < 2; ++bj)
#pragma unroll
            for (int n = 0; n < 2; ++n) bv[bj][n] = *(const f32x4*)(bb + bj * HALF + 4 * n);
#pragma unroll
        for (int ai = 0; ai < 2; ++ai)
#pragma unroll
            for (int m = 0; m < 4; ++m) { const int r = rl + ai * HALF + m * 16; const float gt = (u.lrow0 + r < ce) ? gp[r] : 0.f;
                bf16_t* rowp = Y + (size_t)(u.pm * BM + r) * 1024 + col0;
#pragma unroll
                for (int bj = 0; bj < 2; ++bj) { const f32x4 v0 = (acc[ai][bj][m][0] + bv[bj][0]) * gt, v1 = (acc[ai][bj][m][1] + bv[bj][1]) * gt;
                    u32x4 w; w.x = cvt_pk_bf16(v0[0], v0[1]); w.y = cvt_pk_bf16(v0[2], v0[3]); w.z = cvt_pk_bf16(v1[0], v1[1]); w.w = cvt_pk_bf16(v1[2], v1[3]);
                    *(u32x4*)(rowp + bj * HALF) = w; } }
    }
};

template <class Epi, class Sched, bool ALIGN_EPI, bool GATHER>
__device__ __forceinline__ void gemm_phase(PG8_LAS unsigned char* lds, const Gemm g, const Sched& S, const Epi& E, const PG8_LAS unsigned* tab) {
    const int tid = threadIdx.x, wid = __builtin_amdgcn_readfirstlane(tid >> 6), lane = tid & 63, wr = wid >> 2, wc = wid & 3, fr = lane & 15, fq = lane >> 4;
    const int K = g.K, nt = K / BK;
    unsigned voffA[2], voffB[2], cby[2]; int rsl[2];
#pragma unroll
    for (int i = 0; i < 2; ++i) { int R, C; stage_rc(tid * 16 + i * 8192, R, C); const int Rb = Epi::PERM ? ((R & ~31) + perm32(R & 31)) : R;
        voffA[i] = (unsigned)(R * K + C) * 2u; voffB[i] = (unsigned)(Rb * K + C) * 2u; rsl[i] = R; cby[i] = (unsigned)C * 2u; }
    const size_t kstep = (size_t)(BK * 2);
    const size_t hstep = (size_t)HALF * K * 2;
    const size_t tstep = 2 * hstep;
    const size_t ahstep = GATHER ? 0 : hstep;
    const unsigned ldsw = (unsigned)wid * 1024u;
    const int aoff = lds_byte(wr * 64 + fr, fq * 8), boff = lds_byte(wc * 32 + fr, fq * 8);
#define PG8_SA(b, h) (((b) * 2 + (h)) * HTB)
#define PG8_SB(b, h) ((4 + (b) * 2 + (h)) * HTB)
#define PG8_STAGE(bufoff, gbase, voff) do { _Pragma("unroll") for (int _i = 0; _i < 2; ++_i) \
        __builtin_amdgcn_global_load_lds((const unsigned*)((const char*)(gbase) + (voff)[_i]), (PG8_LAS unsigned*)(lds + (bufoff) + ldsw + _i * 8192), 16, 0, 0); } while (0)
#define PG8_LDA(dst, b, h) do { _Pragma("unroll") for (int m = 0; m < 4; ++m) _Pragma("unroll") for (int k = 0; k < 2; ++k) dst[m][k] = *(const PG8_LAS bf16x8*)(lds + PG8_SA(b, h) + aoff + m * 2048 + k * 1024); } while (0)
#define PG8_LDB(dst, b, h) do { _Pragma("unroll") for (int n = 0; n < 2; ++n) _Pragma("unroll") for (int k = 0; k < 2; ++k) dst[n][k] = *(const PG8_LAS bf16x8*)(lds + PG8_SB(b, h) + boff + n * 2048 + k * 1024); } while (0)
#define PG8_MMA(ai, bj, At, Bt) do { __builtin_amdgcn_s_setprio(1); _Pragma("unroll") for (int m = 0; m < 4; ++m) _Pragma("unroll") for (int n = 0; n < 2; ++n) _Pragma("unroll") for (int k = 0; k < 2; ++k) \
        acc[ai][bj][m][n] = __builtin_amdgcn_mfma_f32_16x16x32_bf16(Bt[n][k], At[m][k], acc[ai][bj][m][n], 0, 0, 0); __builtin_amdgcn_s_setprio(0); } while (0)
#define PG8_WAIT_V(n) asm volatile("s_waitcnt vmcnt(" #n ")" ::: "memory")
#define PG8_WAIT_L(n) asm volatile("s_waitcnt lgkmcnt(" #n ")" ::: "memory")
#define PG8_BAR __builtin_amdgcn_s_barrier()
#define PG8_SCHED __builtin_amdgcn_sched_barrier(0)
    Unit cur, nxt; int ui = 0;
    if (!S.next(0, cur)) return;
    f32x4 acc[2][2][4][2];
#pragma unroll
    for (int a = 0; a < 2; ++a)
#pragma unroll
        for (int b = 0; b < 2; ++b)
#pragma unroll
            for (int m = 0; m < 4; ++m)
#pragma unroll
                for (int n = 0; n < 2; ++n) acc[a][b][m][n] = (f32x4){0.f, 0.f, 0.f, 0.f};
    bf16x8 At[4][2], B0[2][2], B1[2][2];
    const char* cA = GATHER ? (const char*)g.A : (const char*)g.A + (size_t)cur.pm * tstep; const char* cB = (const char*)g.Bt + cur.boff + (size_t)cur.pn * tstep;
    unsigned cv0[2], cv1[2], nv0[2], nv1[2];
#pragma unroll
    for (int i = 0; i < 2; ++i) { if constexpr (GATHER) { cv0[i] = tab[rsl[i]] + cby[i]; cv1[i] = tab[HALF + rsl[i]] + cby[i]; } else { cv0[i] = voffA[i]; cv1[i] = voffA[i]; } nv0[i] = cv0[i]; nv1[i] = cv1[i]; }
    PG8_STAGE(PG8_SB(0, 0), cB, voffB); PG8_STAGE(PG8_SB(0, 1), cB + hstep, voffB); PG8_STAGE(PG8_SA(0, 0), cA, cv0); PG8_STAGE(PG8_SA(0, 1), cA + ahstep, cv1);
    if (wr == 1) PG8_BAR;
    PG8_WAIT_V(2); PG8_BAR;
    PG8_STAGE(PG8_SB(1, 0), cB + kstep, voffB); PG8_STAGE(PG8_SA(1, 0), cA + kstep, cv0); PG8_STAGE(PG8_SB(1, 1), cB + hstep + kstep, voffB);
    PG8_WAIT_V(6); PG8_BAR;
    for (;;) {
        const bool has_next = S.next(ui + 1, nxt);
        const char* nA = has_next ? (GATHER ? (const char*)g.A : (const char*)g.A + (size_t)nxt.pm * tstep) : cA; const char* nB = has_next ? (const char*)g.Bt + nxt.boff + (size_t)nxt.pn * tstep : cB;
        if constexpr (GATHER) {
#pragma unroll
            for (int i = 0; i < 2; ++i) { if (has_next) { nv0[i] = tab[(ui + 1) * BM + rsl[i]] + cby[i]; nv1[i] = tab[(ui + 1) * BM + HALF + rsl[i]] + cby[i]; } else { nv0[i] = cv0[i]; nv1[i] = cv1[i]; } }
        }
        for (int t = 0; t < nt; t += 2) {
            const bool last = (t == nt - 2);
            const char* a1 = cA + (size_t)(t + 1) * kstep;
            const char* a2 = last ? nA : cA + (size_t)(t + 2) * kstep; const char* b2 = last ? nB : cB + (size_t)(t + 2) * kstep;
            const char* a3 = a2 + kstep; const char* b3 = b2 + kstep;
            unsigned s0[2], s1[2];
#pragma unroll
            for (int i = 0; i < 2; ++i) { s0[i] = last ? nv0[i] : cv0[i]; s1[i] = last ? nv1[i] : cv1[i]; }
            PG8_LDB(B0, 0, 0); PG8_LDB(B1, 0, 1); PG8_SCHED; PG8_LDA(At, 0, 0); PG8_STAGE(PG8_SA(1, 1), a1 + ahstep, cv1);
            PG8_WAIT_V(8); PG8_WAIT_L(0); PG8_BAR; PG8_MMA(0, 0, At, B0); PG8_MMA(0, 1, At, B1); PG8_BAR; PG8_SCHED;
            PG8_LDA(At, 0, 1); PG8_STAGE(PG8_SB(0, 0), b2, voffB); PG8_STAGE(PG8_SB(0, 1), b2 + hstep, voffB); PG8_STAGE(PG8_SA(0, 0), a2, s0);
            PG8_WAIT_V(8); PG8_WAIT_L(0); PG8_BAR; PG8_MMA(1, 0, At, B0); PG8_MMA(1, 1, At, B1); PG8_BAR; PG8_SCHED;
            PG8_LDB(B0, 1, 0); PG8_LDB(B1, 1, 1); PG8_SCHED; PG8_LDA(At, 1, 0); PG8_STAGE(PG8_SA(0, 1), a2 + ahstep, s1);
            PG8_WAIT_V(8); PG8_WAIT_L(0); PG8_BAR; PG8_MMA(0, 0, At, B0); PG8_MMA(0, 1, At, B1); PG8_BAR; PG8_SCHED;
            PG8_LDA(At, 1, 1); PG8_STAGE(PG8_SB(1, 0), b3, voffB); PG8_STAGE(PG8_SB(1, 1), b3 + hstep, voffB); PG8_STAGE(PG8_SA(1, 0), a3, s0);
            PG8_WAIT_V(8); PG8_WAIT_L(0); PG8_BAR; PG8_MMA(1, 0, At, B0); PG8_MMA(1, 1, At, B1); PG8_BAR; PG8_SCHED;
        }
        if constexpr (ALIGN_EPI) { if (wr == 0) PG8_BAR; }
        E(acc, cur, wr, wc, fr, fq);
        if (!has_next) break;
#pragma unroll
        for (int a = 0; a < 2; ++a)
#pragma unroll
            for (int b = 0; b < 2; ++b)
#pragma unroll
                for (int m = 0; m < 4; ++m)
#pragma unroll
                    for (int n = 0; n < 2; ++n) acc[a][b][m][n] = (f32x4){0.f, 0.f, 0.f, 0.f};
        cur = nxt; cA = nA; cB = nB; ++ui;
#pragma unroll
        for (int i = 0; i < 2; ++i) { cv0[i] = nv0[i]; cv1[i] = nv1[i]; }
        if constexpr (ALIGN_EPI) { if (wr == 1) PG8_BAR; }
    }
    PG8_WAIT_V(0);
    if constexpr (!ALIGN_EPI) { if (wr == 0) PG8_BAR; }
    PG8_BAR;
#undef PG8_SA
#undef PG8_SB
#undef PG8_STAGE
#undef PG8_LDA
#undef PG8_LDB
#undef PG8_MMA
#undef PG8_WAIT_V
#undef PG8_WAIT_L
#undef PG8_BAR
#undef PG8_SCHED
}
}
#include <hip/hip_bf16.h>
#include <cmath>
namespace attn_body {
using bf16=__hip_bfloat16;
using bf16x8=__attribute__((ext_vector_type(8)))short;
using s16x4=__attribute__((ext_vector_type(4)))short;
using f32x16=__attribute__((ext_vector_type(16)))float;
using u32x4=__attribute__((ext_vector_type(4)))unsigned;
constexpr int BATCH=4,NHEAD=8,SEQ=8192,D=64,DM=NHEAD*D,ODM=1024;
constexpr int NW=8,QBLK=32,QB=QBLK*NW,KVBLK=64,NQB=SEQ/QB;
constexpr int ATTN_PITCH=DM, ATTN_UNIT_ROWS=QB;
__device__ __forceinline__ int crow(int r,int hi){return (r&3)+8*(r>>2)+4*hi;}
#define SBAR() __builtin_amdgcn_sched_barrier(0)
__device__ __forceinline__ void cmask(f32x16&p0,f32x16&p1,int jb,int qrel,int hi){
  const float NEG=-INFINITY; int kb=64*jb+4*hi;
  #pragma unroll
  for(int r=0;r<16;++r){int kv=kb+(r&3)+8*(r>>2); if(kv>qrel)p0[r]=NEG; if(kv+32>qrel)p1[r]=NEG;}
}

constexpr int NSLOT=3, SLOTB=8192;
constexpr int LDS_K=0, LDS_V=NSLOT*SLOTB, LDS_WS=2*NSLOT*SLOTB, LDS_OST=LDS_WS+NW*64*4, LDS_C2=LDS_OST+NW*4096, LDS_BYTES=LDS_C2+SEQ*4;
constexpr float C2=0.125f*1.4426950408889634f;
__device__ __forceinline__ void glds16(const void*gsrc,unsigned lds_dst){unsigned keep;
  asm volatile("s_mov_b32 %0, m0\n\ts_mov_b32 m0, %2\n\ts_nop 0\n\tglobal_load_lds_dwordx4 %1, off\n\ts_mov_b32 m0, %0":"=&s"(keep):"v"(gsrc),"s"(lds_dst):"memory");}
__device__ __forceinline__ float max3f(float a,float b,float c){float r;asm("v_max3_f32 %0, %1, %2, %3":"=v"(r):"v"(a),"v"(b),"v"(c));return r;}
__device__ __forceinline__ float max2f(float a,float b){float r;asm("v_max_f32_e32 %0, %1, %2":"=v"(r):"v"(a),"v"(b));return r;}
__device__ __forceinline__ float fadd_s(float a,float b){float r;asm("v_add_f32_e32 %0, %1, %2":"=v"(r):"v"(a),"v"(b));return r;}
__device__ __forceinline__ float fsub_s(float a,float b){float r;asm("v_sub_f32_e32 %0, %1, %2":"=v"(r):"v"(a),"v"(b));return r;}
typedef float f32x2_t __attribute__((ext_vector_type(2))); typedef float f32x4_t __attribute__((ext_vector_type(4))); typedef __bf16 bf16x2_t __attribute__((ext_vector_type(2)));
__device__ __forceinline__ unsigned cvtpk_s(float lo,float hi){f32x2_t v={lo,hi};bf16x2_t b=__builtin_convertvector(v,bf16x2_t);return __builtin_bit_cast(unsigned,b);}
#define WAIT_BAR(N) asm volatile("s_waitcnt vmcnt(" #N ") lgkmcnt(0)\n\ts_barrier":::"memory")

__device__ __forceinline__ void qkt(f32x16&p0,f32x16&p1,const char*Kslot,const bf16x8*qr,const f32x16&cin0,const f32x16&cin1,int r32,int hi){
  const char*kb=Kslot+hi*1024+r32*16;
  #pragma unroll
  for(int d0=0;d0<4;++d0){
    const bf16x8 b0=*reinterpret_cast<const bf16x8*>(kb+d0*2048);
    const bf16x8 b1=*reinterpret_cast<const bf16x8*>(kb+d0*2048+512);
    if(d0==0){p0=__builtin_amdgcn_mfma_f32_32x32x16_bf16(b0,qr[0],cin0,0,0,0);p1=__builtin_amdgcn_mfma_f32_32x32x16_bf16(b1,qr[0],cin1,0,0,0);}
    else{p0=__builtin_amdgcn_mfma_f32_32x32x16_bf16(b0,qr[d0],p0,0,0,0);p1=__builtin_amdgcn_mfma_f32_32x32x16_bf16(b1,qr[d0],p1,0,0,0);}}
}
typedef __attribute__((address_space(3))) const char* lds_cptr;
typedef short v4i16_t __attribute__((ext_vector_type(4)));
__device__ __forceinline__ void kload8(bf16x8*kf,lds_cptr kp){
  kf[0]=*(const __attribute__((address_space(3))) bf16x8*)(kp);      kf[1]=*(const __attribute__((address_space(3))) bf16x8*)(kp+512);
  kf[2]=*(const __attribute__((address_space(3))) bf16x8*)(kp+2048); kf[3]=*(const __attribute__((address_space(3))) bf16x8*)(kp+2560);
  kf[4]=*(const __attribute__((address_space(3))) bf16x8*)(kp+4096); kf[5]=*(const __attribute__((address_space(3))) bf16x8*)(kp+4608);
  kf[6]=*(const __attribute__((address_space(3))) bf16x8*)(kp+6144); kf[7]=*(const __attribute__((address_space(3))) bf16x8*)(kp+6656);
}
__device__ __forceinline__ void kload2(bf16x8*kf,lds_cptr kp,int j){ kf[2*j]=*(const __attribute__((address_space(3))) bf16x8*)(kp+j*2048); kf[2*j+1]=*(const __attribute__((address_space(3))) bf16x8*)(kp+j*2048+512); }
__device__ __forceinline__ s16x4 vtr(lds_cptr p){ return __builtin_bit_cast(s16x4,__builtin_amdgcn_ds_read_tr16_b64_v4i16((__attribute__((address_space(3))) v4i16_t*)p)); }
__device__ __forceinline__ float rowmax(const f32x16&p0,const f32x16&p1){
  float a=max3f(p0[0],p0[1],p1[0]),b=max3f(p0[2],p0[3],p1[1]);a=max3f(a,p1[2],p1[3]);
  #pragma unroll
  for(int r=4;r<16;r+=4){a=max3f(a,p0[r],p0[r+1]);b=max3f(b,p0[r+2],p0[r+3]);a=max3f(a,p1[r],p1[r+1]);b=max3f(b,p1[r+2],p1[r+3]);}
  const float m=max2f(a,b);
  auto rr=__builtin_amdgcn_permlane32_swap(__float_as_uint(m),__float_as_uint(m),false,false);
  return max2f(__uint_as_float(rr[0]),__uint_as_float(rr[1]));
}
__device__ __forceinline__ void pv(f32x16*o,int vb,bf16x8 pa0,bf16x8 pa1,bf16x8 pa2,bf16x8 pa3){
  #pragma unroll
  for(int d0=0;d0<2;++d0){s16x4 lo[4],hi[4];
    #pragma unroll
    for(int ks=0;ks<4;++ks){
      asm volatile("ds_read_b64_tr_b16 %0,%1 offset:%c2":"=&v"(lo[ks]):"v"(vb),"i"(d0*4096+ks*1024):"memory");
      asm volatile("ds_read_b64_tr_b16 %0,%1 offset:%c2":"=&v"(hi[ks]):"v"(vb),"i"(d0*4096+ks*1024+512):"memory");}
    asm volatile("s_waitcnt lgkmcnt(0)":::"memory");SBAR();
    #define PK(k) (bf16x8){lo[k][0],lo[k][1],lo[k][2],lo[k][3],hi[k][0],hi[k][1],hi[k][2],hi[k][3]}
    o[d0]=__builtin_amdgcn_mfma_f32_32x32x16_bf16(pa0,PK(0),o[d0],0,0,0);
    o[d0]=__builtin_amdgcn_mfma_f32_32x32x16_bf16(pa1,PK(1),o[d0],0,0,0);
    o[d0]=__builtin_amdgcn_mfma_f32_32x32x16_bf16(pa2,PK(2),o[d0],0,0,0);
    o[d0]=__builtin_amdgcn_mfma_f32_32x32x16_bf16(pa3,PK(3),o[d0],0,0,0);
    #undef PK
  }
}

#ifndef ATTN_STORE16
#define ATTN_STORE16(p,v) (*(u32x4*)(p)=(v))
#endif
template<int THRL> __device__ __forceinline__ void attn_unit(int b,int h,int qb,const bf16*Q,const bf16*__restrict__ K,const bf16*__restrict__ V,bf16*O,char*shm){
  const int tid=threadIdx.x,lane=tid&63,r32=lane&31,hi=lane>>5; const int wid=__builtin_amdgcn_readfirstlane(tid>>6);
  const long rowbase=(long)b*SEQ; const int q0=qb*QB;
  const bf16*Qw=Q+(rowbase+q0+wid*QBLK)*DM+h*D;
  const bf16*Kh=K+rowbase*DM+h*D,*Vh=V+rowbase*DM+h*D;
  const unsigned lds0=(unsigned)(uintptr_t)shm; const lds_cptr shm3=(lds_cptr)shm;
  float*wsf=(float*)(shm+LDS_WS)+wid*64;
  const bf16*ksrc=Kh+(long)lane*DM+wid*8;
  const bf16*vsrc=Vh+(long)(16*(wid&3)+(lane>>2))*DM+(wid>>2)*32+(lane&3)*8;
  const unsigned kdst=lds0+LDS_K+wid*1024, vdst=lds0+LDS_V+wid*1024;
  #define DMA_K(t,slot) glds16(ksrc+(long)(t)*KVBLK*DM,(unsigned)__builtin_amdgcn_readfirstlane(kdst+(slot)))
  #define DMA_V(t,slot) glds16(vsrc+(long)(t)*KVBLK*DM,(unsigned)__builtin_amdgcn_readfirstlane(vdst+(slot)))
  const int vb0=(int)(lds0+LDS_V)+((lane>>4)&1)*32+(lane&3)*8+(4*hi+((lane&15)>>2))*64;
  const char*Kbase=shm+LDS_K; bf16x8 kf[8];
  const lds_cptr kp0=shm3+LDS_K+hi*1024+r32*16; const lds_cptr vp0=shm3+LDS_V+((lane>>4)&1)*32+(lane&3)*8+(4*hi+((lane&15)>>2))*64;
  const int NT=(q0+QB)/KVBLK;
  DMA_K(0,0);DMA_V(0,0);DMA_K(1,SLOTB);
  bf16x8 qr[4];
  #pragma unroll
  for(int d0=0;d0<4;++d0)qr[d0]=*reinterpret_cast<const bf16x8*>(&Qw[(long)r32*DM+d0*16+hi*8]);
  float l_reg=0.f;f32x16 o[2];o[0]=f32x16{};o[1]=f32x16{};
  typedef __attribute__((address_space(3))) const f32x4_t* lds_f4ptr; const lds_f4ptr c2p=(lds_f4ptr)(shm3+LDS_C2)+hi;
  float ctm=((const __attribute__((address_space(3))) float*)(shm3+LDS_C2))[q0+wid*QBLK+r32];
  f32x16 cin0,cin1;
  #define CIN(t) do{ const lds_f4ptr cq_=c2p+16*(t); const f32x4_t a0_=cq_[0],a1_=cq_[2],a2_=cq_[4],a3_=cq_[6],b0_=cq_[8],b1_=cq_[10],b2_=cq_[12],b3_=cq_[14]; \
    _Pragma("unroll") for(int j_=0;j_<4;++j_){ cin0[j_]=ctm-a0_[j_];cin0[4+j_]=ctm-a1_[j_];cin0[8+j_]=ctm-a2_[j_];cin0[12+j_]=ctm-a3_[j_]; cin1[j_]=ctm-b0_[j_];cin1[4+j_]=ctm-b1_[j_];cin1[8+j_]=ctm-b2_[j_];cin1[12+j_]=ctm-b3_[j_]; } }while(0)
  const int qrel=wid*QBLK+r32;
  #define CMASK(P0,P1,t) do{int jb_=(t)-(NT-4); if(jb_>=0)cmask(P0,P1,jb_,qrel,hi);}while(0)
  bool resc=false;
  #define START(P0,P1) do{ const float rm=rowmax(P0,P1); resc=false; \
    if(__any(rm>(float)THRL)){ const float dl=__builtin_fmaxf(rm,0.f); ctm-=dl; \
      _Pragma("unroll") for(int r=0;r<16;++r){P0[r]-=dl;P1[r]-=dl;} } \
    _Pragma("unroll") for(int r=0;r<16;++r)P0[r]=__builtin_amdgcn_exp2f(P0[r]); }while(0)
  #define RESC() do{ if(resc){ asm volatile("s_waitcnt lgkmcnt(0)":::"memory"); \
      _Pragma("unroll") for(int d_=0;d_<2;++d_) _Pragma("unroll") for(int r=0;r<16;++r)o[d_][r]*=wsf[crow(r,hi)]; } }while(0)
  f32x16 pA0,pA1,pB0,pB1;
  int sl_prev=0,sl_cur=0,sl_next=SLOTB;
  #define ROT() do{sl_prev=sl_cur;sl_cur=sl_next;sl_next=(sl_next==(NSLOT-1)*SLOTB)?0:sl_next+SLOTB;}while(0)
  DMA_K(2,2*SLOTB);
  WAIT_BAR(3);
  CIN(0); qkt(pA0,pA1,Kbase,qr,cin0,cin1,r32,hi);asm volatile("s_nop 15\n\ts_nop 7":"+v"(pA0),"+v"(pA1));CMASK(pA0,pA1,0);
  START(pA0,pA1);
  _Pragma("unroll") for(int r=0;r<16;++r)pA1[r]=__builtin_amdgcn_exp2f(pA1[r]);
  WAIT_BAR(0);
  DMA_K(3,0);DMA_V(1,SLOTB);
  ROT();
  kload8(kf,kp0+sl_cur);
  WAIT_BAR(2);
  s16x4 vlo[8],vhi[8]; u32x4 pw0,pw1,pw2,pw3;
  #define PKW(P,B) cvtpk_s(P[B],P[B+1])
  #define PAF(k) __builtin_bit_cast(bf16x8,pw##k)
  #define VFR(i) (bf16x8){vlo[i][0],vlo[i][1],vlo[i][2],vlo[i][3],vhi[i][0],vhi[i][1],vhi[i][2],vhi[i][3]}
  #define PIN(x) asm volatile("":"+v"(x))
  #define MX3(a,b,c) __builtin_fmaxf(__builtin_fmaxf((a),(b)),(c))
  #define GAPA(MF,A0,A1,A2,A3,W0,W1,PW) do{ MF; sacc+=A0; sacc+=A1; sacc+=A2; sacc+=A3; PIN(sacc); W0; W1; PIN(PW); SBAR(); }while(0)
  #define EX(v) __builtin_amdgcn_exp2f(v)
  #define GAPB(MF,X,B) do{ MF; X[B]=EX(X[B]); X[B+1]=EX(X[B+1]); X[B+2]=EX(X[B+2]); X[B+3]=EX(X[B+3]); PIN(X); SBAR(); }while(0)
  #define VRD(i) do{ vlo[i]=vtr(vp_+(((i)>>2)*4096+((i)&3)*1024)); vhi[i]=vtr(vp_+(((i)>>2)*4096+((i)&3)*1024+512)); }while(0)
  #define KRD(G,j) do{ if(G){ kload2(kf,kp0+sl_next,j); SBAR(); } }while(0)
  #define STEP(C0,C1,P0,P1,t,GK,GV,GL) do{ SBAR(); CIN(t); SBAR(); \
    const lds_cptr vp_=vp0+sl_prev; \
    VRD(0); SBAR(); float sacc=(P0[0]+P0[1]); \
    GAPA(C0=__builtin_amdgcn_mfma_f32_32x32x16_bf16(kf[0],qr[0],cin0,0,0,0), P0[2],P0[3],P0[4],P0[5],     pw0[0]=PKW(P0,0), pw0[1]=PKW(P0,2), pw0); \
    VRD(4); SBAR(); GAPA(C1=__builtin_amdgcn_mfma_f32_32x32x16_bf16(kf[1],qr[0],cin1,0,0,0), P0[6],P0[7],P0[8],P0[9],     pw0[2]=PKW(P0,4), pw0[3]=PKW(P0,6), pw0); \
    VRD(1); SBAR(); GAPA(C0=__builtin_amdgcn_mfma_f32_32x32x16_bf16(kf[2],qr[1],C0,0,0,0),   P0[10],P0[11],P0[12],P0[13], pw1[0]=PKW(P0,8), pw1[1]=PKW(P0,10), pw1); \
    VRD(5); SBAR(); GAPA(C1=__builtin_amdgcn_mfma_f32_32x32x16_bf16(kf[3],qr[1],C1,0,0,0),   P0[14],P0[15],P1[0],P1[1],   pw1[2]=PKW(P0,12),pw1[3]=PKW(P0,14), pw1); \
    VRD(2); SBAR(); GAPA(C0=__builtin_amdgcn_mfma_f32_32x32x16_bf16(kf[4],qr[2],C0,0,0,0),   P1[2],P1[3],P1[4],P1[5],     pw2[0]=PKW(P1,0), pw2[1]=PKW(P1,2), pw2); \
    VRD(6); SBAR(); GAPA(C1=__builtin_amdgcn_mfma_f32_32x32x16_bf16(kf[5],qr[2],C1,0,0,0),   P1[6],P1[7],P1[8],P1[9],     pw2[2]=PKW(P1,4), pw2[3]=PKW(P1,6), pw2); \
    VRD(3); SBAR(); GAPA(C0=__builtin_amdgcn_mfma_f32_32x32x16_bf16(kf[6],qr[3],C0,0,0,0),   P1[10],P1[11],P1[12],P1[13], pw3[0]=PKW(P1,8), pw3[1]=PKW(P1,10), pw3); \
    VRD(7); SBAR(); GAPA(C1=__builtin_amdgcn_mfma_f32_32x32x16_bf16(kf[7],qr[3],C1,0,0,0),   P1[14],P1[15],0.f,0.f,       pw3[2]=PKW(P1,12),pw3[3]=PKW(P1,14), pw3); \
    l_reg+=sacc; \
    if(GK){DMA_K((t)+3,sl_cur);} if(GV){DMA_V((t)+1,sl_next);} \
    CMASK(C0,C1,t); \
    { float a=MX3(C0[0],C0[1],C1[0]),b=MX3(C0[2],C0[3],C1[1]); a=MX3(a,C1[2],C1[3]); \
      _Pragma("unroll") for(int r=4;r<16;r+=4){a=MX3(a,C0[r],C0[r+1]);b=MX3(b,C0[r+2],C0[r+3]);a=MX3(a,C1[r],C1[r+1]);b=MX3(b,C1[r+2],C1[r+3]);} \
      float rm=__builtin_fmaxf(a,b); { auto rr=__builtin_amdgcn_permlane32_swap(__float_as_uint(rm),__float_as_uint(rm),false,false); rm=__builtin_fmaxf(__uint_as_float(rr[0]),__uint_as_float(rr[1])); } \
      resc=false; \
      if(__builtin_expect(__any(rm>(float)THRL),0)){ const float dl=__builtin_fmaxf(rm,0.f); ctm-=dl; \
        _Pragma("unroll") for(int r=0;r<16;++r){C0[r]-=dl;C1[r]-=dl;} \
        const float f=__builtin_amdgcn_exp2f(-dl); l_reg*=f; if(hi==0)wsf[r32]=f; resc=true; } } \
    SBAR(); \
    GAPB(o[0]=__builtin_amdgcn_mfma_f32_32x32x16_bf16(PAF(0),VFR(0),o[0],0,0,0), C0,0); \
    GAPB(o[1]=__builtin_amdgcn_mfma_f32_32x32x16_bf16(PAF(0),VFR(4),o[1],0,0,0), C0,4); \
    KRD(GL,0); GAPB(o[0]=__builtin_amdgcn_mfma_f32_32x32x16_bf16(PAF(1),VFR(1),o[0],0,0,0), C0,8); \
    KRD(GL,1); GAPB(o[1]=__builtin_amdgcn_mfma_f32_32x32x16_bf16(PAF(1),VFR(5),o[1],0,0,0), C0,12); \
    KRD(GL,2); GAPB(o[0]=__builtin_amdgcn_mfma_f32_32x32x16_bf16(PAF(2),VFR(2),o[0],0,0,0), C1,0); \
    KRD(GL,3); GAPB(o[1]=__builtin_amdgcn_mfma_f32_32x32x16_bf16(PAF(2),VFR(6),o[1],0,0,0), C1,4); \
    GAPB(o[0]=__builtin_amdgcn_mfma_f32_32x32x16_bf16(PAF(3),VFR(3),o[0],0,0,0), C1,8); \
    GAPB(o[1]=__builtin_amdgcn_mfma_f32_32x32x16_bf16(PAF(3),VFR(7),o[1],0,0,0), C1,12); \
    }while(0)
  int t=1;
  #undef CMASK
  #define CMASK(P0,P1,t) do{}while(0)
  for(;t+5<NT;t+=2){
    STEP(pB0,pB1,pA0,pA1,t,true,true,true);     WAIT_BAR(2); RESC(); ROT();
    STEP(pA0,pA1,pB0,pB1,t+1,true,true,true);   WAIT_BAR(2); RESC(); ROT();
  }
  #undef CMASK
  #define CMASK(P0,P1,t) do{int jb_=(t)-(NT-4); if(jb_>=0)cmask(P0,P1,jb_,qrel,hi);}while(0)
  #define ENDW(tt) do{ if((tt)+3<NT){WAIT_BAR(2);} else if((tt)+2<NT){WAIT_BAR(1);} else {WAIT_BAR(0);} }while(0)
  for(;t+1<NT;t+=2){
    STEP(pB0,pB1,pA0,pA1,t,(t+3<NT),(t+1<NT),(t+1<NT));       ENDW(t);   RESC(); ROT();
    STEP(pA0,pA1,pB0,pB1,t+1,(t+4<NT),(t+2<NT),(t+2<NT));     ENDW(t+1); RESC(); ROT();
  }
  STEP(pB0,pB1,pA0,pA1,NT-1,false,false,false); RESC();
  { float sacc=pB0[0]+pB0[1]; _Pragma("unroll") for(int r=2;r<16;++r)sacc+=pB0[r]; _Pragma("unroll") for(int r=0;r<16;++r)sacc+=pB1[r]; l_reg+=sacc;
    pw0=(u32x4){PKW(pB0,0),PKW(pB0,2),PKW(pB0,4),PKW(pB0,6)};pw1=(u32x4){PKW(pB0,8),PKW(pB0,10),PKW(pB0,12),PKW(pB0,14)};pw2=(u32x4){PKW(pB1,0),PKW(pB1,2),PKW(pB1,4),PKW(pB1,6)};pw3=(u32x4){PKW(pB1,8),PKW(pB1,10),PKW(pB1,12),PKW(pB1,14)};
    SBAR(); pv(o,vb0+sl_cur,PAF(0),PAF(1),PAF(2),PAF(3)); }
  #undef PKW
  #undef PAF
  #undef VFR
  #undef PIN
  #undef MX3
  #undef GAPA
  #undef GAPB
  #undef EX
  #undef VRD
  #undef KRD
  #undef STEP
  #undef ENDW
  {auto rr=__builtin_amdgcn_permlane32_swap(__float_as_uint(l_reg),__float_as_uint(l_reg),false,false);l_reg=__uint_as_float(rr[0])+__uint_as_float(rr[1]);}
  if(hi==0)wsf[32+r32]=l_reg;asm volatile("s_waitcnt lgkmcnt(0)":::"memory");
  float rli[16];
  #pragma unroll
  for(int r=0;r<16;++r)rli[r]=__builtin_amdgcn_rcpf(wsf[32+crow(r,hi)]);
  bf16*Ow=O+(rowbase+q0+wid*QBLK)*ODM+h*D;
  { bf16*stg=(bf16*)(shm+LDS_OST)+wid*2048;
    #pragma unroll
    for(int r=0;r<16;++r){const int orow=crow(r,hi);
      #pragma unroll
      for(int d0=0;d0<2;++d0)stg[orow*64+d0*32+r32]=__float2bfloat16(o[d0][r]*rli[r]);}
    asm volatile("s_waitcnt lgkmcnt(0)":::"memory");
    #pragma unroll
    for(int i=0;i<4;++i){const int row=i*8+(lane>>3),ch=lane&7; const u32x4 v=*(const u32x4*)(stg+row*64+ch*8); ATTN_STORE16(Ow+(long)row*ODM+ch*8,v);} }
  asm volatile("s_waitcnt lgkmcnt(0)\n\ts_barrier":::"memory");
  #undef CIN
  #undef DMA_K
  #undef DMA_V
  #undef CMASK
  #undef START
  #undef RESC
  #undef ROT
}
constexpr int ATTN_LDS_BYTES=LDS_BYTES;
struct AttnTensors { const bf16* Q; const bf16* K; const bf16* V; bf16* O; };
struct AttnUnit { int bh; int qb; };
struct StaticOrder {
  int vcu;
  __device__ __forceinline__ explicit StaticOrder(int grid,int block):vcu((block%8)*(grid/8)+block/8){}
  __device__ __forceinline__ bool next(int i,AttnUnit&u)const{ if(i>=4)return false; const int s=vcu&7; u.bh=vcu>>3; u.qb=(i==0)?s:(i==1)?15-s:(i==2)?16+s:31-s; return true; }
  __device__ __forceinline__ void a_ready(const AttnUnit&)const{}
  __device__ __forceinline__ void done(const AttnUnit&)const{}
};
template<class Sched,int THRL=8> __device__ __forceinline__ void attn_phase(char*lds,const AttnTensors&T,const Sched&S){
  AttnUnit u;
  for(int i=0;S.next(i,u);++i){ S.a_ready(u); attn_unit<THRL>(u.bh/NHEAD,u.bh%NHEAD,u.qb,T.Q,T.K,T.V,T.O,lds); S.done(u); }
}
#undef SBAR
#undef WAIT_BAR
}
#define GAS __attribute__((address_space(1)))
#define LAS __attribute__((address_space(3)))
typedef GAS unsigned gu32;
#define RLX_AGENT __ATOMIC_RELAXED, __HIP_MEMORY_SCOPE_AGENT
#define LDS_WAIT() asm volatile("s_waitcnt lgkmcnt(0)" ::: "memory")
#define VM_WAIT() asm volatile("s_waitcnt vmcnt(0)" ::: "memory")

constexpr int NWAVES = 8;
constexpr int N_PHASES = 8;
constexpr int RING_OFF = 0, RING_BYTES = 131072;
constexpr int TAB_OFF = 131072, TAB_UNITS = 17;
constexpr int RT_CHE = 131072, RT_CHG = 133120, RT_LCNT = 135168, RT_LBASE = 135296;
constexpr int LDS_TOTAL = 155648;
constexpr int LDSCTL_OFF = LDS_TOTAL - 1024;
static_assert(TAB_OFF + TAB_UNITS * 256 * 4 <= LDSCTL_OFF && RT_LBASE + 128 <= LDSCTL_OFF, "LDS map");
constexpr int CW_BAR = 4096;

#define XB_TMO      128
#define XB_XCNT(j)  (256  + 64 * (j))
#define XB_XSUB(j)  (1280 + 64 * (j))
#define XB_XGEN(j)  (2304 + 64 * (j))
#define XB_TOP      3328
#define XB_TOPGEN   3392
#define XCD_BAR_WORDS 3456
#define XB_SPIN_CAP (1u << 18)

__device__ __forceinline__ unsigned xb_ld(unsigned* p)              { return __hip_atomic_load(p, __ATOMIC_RELAXED, __HIP_MEMORY_SCOPE_AGENT); }
__device__ __forceinline__ unsigned xb_add(unsigned* p, unsigned v) { return __hip_atomic_fetch_add(p, v, __ATOMIC_RELAXED, __HIP_MEMORY_SCOPE_AGENT); }
__device__ __forceinline__ unsigned xb_xcc_id() { return (unsigned)__builtin_amdgcn_s_getreg((3 << 11) | 20) & 0xFu; }
#define XB_SPIN(cond, bar) do { unsigned _sp = 0; while (cond) { __builtin_amdgcn_s_sleep(1); \
    if ((++_sp & 255u) == 0u) { if (xb_ld(&(bar)[XB_TMO])) break; if (_sp > XB_SPIN_CAP) { atomicAdd(&(bar)[XB_TMO], 1u); break; } } } } while (0)

struct XcdBarrier {
    unsigned* bar; unsigned x;
    volatile LAS unsigned* st;
};

__device__ __forceinline__ XcdBarrier xcd_barrier_post(unsigned* bar, volatile LAS unsigned* st) {
    XcdBarrier b; b.bar = bar; b.x = xb_xcc_id(); b.st = st;
    if (threadIdx.x == 0) (void)xb_add(&bar[XB_XCNT(b.x)], 1u);
    return b;
}
__device__ __forceinline__ void xcd_barrier_complete(unsigned* bar, unsigned x, unsigned& nloc, unsigned& nx) {
    const unsigned G = gridDim.x * gridDim.y * gridDim.z;
    unsigned sum, cnt, mine, sp = 0u;
    for (;;) {
        sum = 0u; cnt = 0u; mine = 0u;
#pragma unroll
        for (unsigned j = 0; j < 16; ++j) { const unsigned c = xb_ld(&bar[XB_XCNT(j)]); sum += c; cnt += (c > 0u) ? 1u : 0u; mine = (j == x) ? c : mine; }
        if (sum == G) break;
        __builtin_amdgcn_s_sleep(1);
        if ((++sp & 255u) == 0u) { if (xb_ld(&bar[XB_TMO])) break; if (sp > XB_SPIN_CAP) { atomicAdd(&bar[XB_TMO], 1u); break; } }
    }
    nloc = mine > 0u ? mine : 1u; nx = cnt > 0u ? cnt : 1u;
}

__device__ __forceinline__ void xcd_barrier(const XcdBarrier& b) {
    asm volatile("s_waitcnt vmcnt(0)" ::: "memory");
    __syncthreads();
    if (threadIdx.x == 0) {
        unsigned* bar = b.bar;
        __builtin_amdgcn_s_waitcnt(0);
        unsigned nloc = b.st[0], nx = b.st[1];
        if (nloc == 0u) { xcd_barrier_complete(bar, b.x, nloc, nx); b.st[0] = nloc; b.st[1] = nx; }
        const unsigned old = xb_add(&bar[XB_XSUB(b.x)], 1u);
        const unsigned gen = old / nloc;
        if (old + 1u == (gen + 1u) * nloc) {
            __builtin_amdgcn_fence(__ATOMIC_RELEASE, "agent");
            asm volatile("s_waitcnt vmcnt(0)" ::: "memory");
            const unsigned og = xb_add(&bar[XB_TOP], 1u);
            const unsigned tg = og / nx;
            if (og + 1u == (tg + 1u) * nx) xb_add(&bar[XB_TOPGEN], 1u);
            else XB_SPIN(xb_ld(&bar[XB_TOPGEN]) == tg, bar);
            __builtin_amdgcn_fence(__ATOMIC_ACQUIRE, "agent");
            xb_add(&bar[XB_XGEN(b.x)], 1u);
            asm volatile("s_waitcnt vmcnt(0)" ::: "memory");
        } else {
            XB_SPIN(xb_ld(&bar[XB_XGEN(b.x)]) == gen, bar);
            __builtin_amdgcn_fence(__ATOMIC_ACQUIRE, "agent");
            asm volatile("s_waitcnt vmcnt(0)" ::: "memory");
        }
    }
    __syncthreads();
}


struct Args { const float* in[15]; float* out; unsigned char* ws; int ph_lo, ph_hi, use_bar, pad; };

__device__ __forceinline__ void p0_transpose_item(const float* W, int ldw, bf16* WT, int ldt, LAS float* scr, int lane) {
#pragma unroll 8
    for (int i = 0; i < 32; ++i) { const int kk = 2 * i + (lane >> 5); scr[kk * 33 + (lane & 31)] = W[(size_t)kk * ldw + (lane & 31)]; }
    LDS_WAIT(); asm volatile("" ::: "memory");
    const int c = lane & 7;
#pragma unroll
    for (int j = 0; j < 4; ++j) { const int n = (lane >> 3) + 8 * j; const LAS float* s = scr + (8 * c) * 33 + n;
        u32x4 o; o.x = pk2(s[0 * 33], s[1 * 33]); o.y = pk2(s[2 * 33], s[3 * 33]); o.z = pk2(s[4 * 33], s[5 * 33]); o.w = pk2(s[6 * 33], s[7 * 33]);
        *(GAS u32x4*)(WT + (size_t)n * ldt + 8 * c) = o; }
    LDS_WAIT(); asm volatile("" ::: "memory");
}
constexpr int I_WIN = 16 * 64, I_WO = 8 * 32, I_WEFF = 4 * 16 * 16, I_WU = 32 * 16 * 64, I_WD = 32 * 16 * 32;
constexpr int P0_ITEMS = I_WIN + I_WO + I_WEFF + I_WU + I_WD;

__device__ __forceinline__ void phase0(const Args& a, LAS unsigned char* L, int vcu, int G, int tid, int lane, int wave) {
    const float* w_in = a.in[2]; const float* w_pool = a.in[4]; const float* pscale = a.in[5]; const float* w_out = a.in[6]; const float* w_up = a.in[10]; const float* w_down = a.in[12];
    bf16* Win_t = (bf16*)(a.ws + WS_WIN); bf16* Wo_t = (bf16*)(a.ws + WS_WO); bf16* Wu_t = (bf16*)(a.ws + WS_WU); bf16* Wd_t = (bf16*)(a.ws + WS_WD);
    LAS float* scr = (LAS float*)(L + wave * 8448);
    LAS float* wf = (LAS float*)(L + 69632);
    for (int i = tid; i < 1024 * 8; i += 512) wf[i] = w_in[(size_t)(i >> 3) * INW + 2048 + (i & 7)];
    __syncthreads();
    const int gw = vcu * NWAVES + wave, NGW = G * NWAVES;
    {
        const float* x = a.in[0]; const float* g_mix = a.in[1]; const float* b_forget = a.in[3];
        bf16* XN = (bf16*)(a.ws + WS_XN); float* LOGF = (float*)(a.ws + WS_LOGF);
        f32x4 g[4];
#pragma unroll
        for (int j = 0; j < 4; ++j) g[j] = *(const f32x4*)(g_mix + 4 * lane + 256 * j);
        for (int m = gw; m < T; m += NGW) {
            const float* xr = x + (size_t)m * DM;
            f32x4 v[4]; float ss = 0.f;
#pragma unroll
            for (int j = 0; j < 4; ++j) { v[j] = *(const f32x4*)(xr + 4 * lane + 256 * j); ss += v[j].x * v[j].x + v[j].y * v[j].y + v[j].z * v[j].z + v[j].w * v[j].w; }
            const float rstd = rsqrtf(wave_sum(ss) * (1.f / DM) + RMS_EPS);
            float fl[8];
#pragma unroll
            for (int e = 0; e < 8; ++e) fl[e] = 0.f;
#pragma unroll
            for (int j = 0; j < 4; ++j) {
                v[j] = v[j] * rstd * g[j];
#pragma unroll
                for (int i = 0; i < 4; ++i) {
                    const int d = 4 * lane + 256 * j + i; const float hv = v[j][i];
                    const f32x4 w0 = *(const LAS f32x4*)(wf + d * 8), w1 = *(const LAS f32x4*)(wf + d * 8 + 4);
                    fl[0] += hv * w0.x; fl[1] += hv * w0.y; fl[2] += hv * w0.z; fl[3] += hv * w0.w;
                    fl[4] += hv * w1.x; fl[5] += hv * w1.y; fl[6] += hv * w1.z; fl[7] += hv * w1.w;
                }
                u32x2 o; o.x = pk2(v[j].x, v[j].y); o.y = pk2(v[j].z, v[j].w);
                *(u32x2*)(XN + (size_t)m * DM + 4 * lane + 256 * j) = o;
            }
#pragma unroll
            for (int e = 0; e < 8; ++e) fl[e] = wave_sum(fl[e]);
            if (lane < 8) {
                float z = 0.f;
#pragma unroll
                for (int e = 0; e < 8; ++e) if (lane == e) z = fl[e];
                z += b_forget[lane];
                const float ls = fminf(z, 0.f) - log1pf(expf(-fabsf(z)));
                LOGF[((size_t)(m / SEQ) * NH + lane) * SEQ + (m % SEQ)] = ls;
            }
        }
    }
    for (int it = gw; it < P0_ITEMS; it += NGW) {
        int r = it;
        if (r < I_WIN) { const int kb = r >> 6, nb = r & 63; p0_transpose_item(w_in + (size_t)(64 * kb) * INW + 32 * nb, INW, Win_t + (size_t)(32 * nb) * DM + 64 * kb, DM, scr, lane); continue; } r -= I_WIN;
        if (r < I_WO) { const int kb = r >> 5, nb = r & 31; p0_transpose_item(w_out + (size_t)(512 + 64 * kb) * DM + 32 * nb, DM, Wo_t + (size_t)(32 * nb) * DM + 512 + 64 * kb, DM, scr, lane); continue; } r -= I_WO;
        if (r < I_WEFF) {
            const int g = r >> 8, nb = (r >> 4) & 15, kb = r & 15, n = nb * 64 + lane; float acc[8];
#pragma unroll
            for (int i = 0; i < 8; ++i) acc[i] = 0.f;
            const float* wp = w_pool + (size_t)g * 16384 + (size_t)(kb * 8) * 128;
            for (int d = 0; d < 128; ++d) { const float av = w_out[(size_t)(g * 128 + d) * DM + n] * pscale[g * 128 + d];
#pragma unroll
                for (int i = 0; i < 8; ++i) acc[i] += av * wp[i * 128 + d]; }
            u32x4 o; o.x = pk2(acc[0], acc[1]); o.y = pk2(acc[2], acc[3]); o.z = pk2(acc[4], acc[5]); o.w = pk2(acc[6], acc[7]);
            *(GAS u32x4*)(Wo_t + (size_t)n * DM + g * 128 + kb * 8) = o; continue; } r -= I_WEFF;
        if (r < I_WU) { const int e = r >> 10, kb = (r >> 6) & 15, nb = r & 63, n0 = 32 * nb;
            const int rowp = n0 < 1024 ? (n0 >> 7) * 256 + (n0 & 127) : ((n0 - 1024) >> 7) * 256 + 128 + ((n0 - 1024) & 127);
            p0_transpose_item(w_up + (size_t)e * DM * 2048 + (size_t)(64 * kb) * 2048 + n0, 2048, Wu_t + ((size_t)e * 2048 + rowp) * DM + 64 * kb, DM, scr, lane); continue; } r -= I_WU;
        { const int e = r >> 9, kb = (r >> 5) & 15, nb = r & 31;
            p0_transpose_item(w_down + (size_t)e * DE * DM + (size_t)(64 * kb) * DM + 32 * nb, DM, Wd_t + ((size_t)e * DM + 32 * nb) * DE + 64 * kb, DE, scr, lane); }
    }
}

__device__ __forceinline__ void pool_pass(const Args& a, int vcu, int G, int tid) {
    const bf16* U = (const bf16*)(a.ws + WS_U); bf16* CAT = (bf16*)(a.ws + WS_CAT);
    const size_t total = (size_t)T * 64;
    for (size_t i = (size_t)vcu * 512 + tid; i < total; i += (size_t)G * 512) {
        const int row = (int)(i >> 6), ch = (int)(i & 63), c0 = ch * 8, g = c0 >> 7, w = 2 << g, t = row % SEQ;
        const int n = t + 1 < w ? t + 1 : w;
        float acc[8], self[8];
#pragma unroll
        for (int k = 0; k < 8; ++k) { acc[k] = 0.f; self[k] = 0.f; }
        for (int j = 0; j < n; ++j) {
            const u32x4 r = *(const u32x4*)(U + (size_t)(row - j) * PW + c0);
            const unsigned rr[4] = {r.x, r.y, r.z, r.w};
#pragma unroll
            for (int k = 0; k < 4; ++k) { const float lo = __builtin_bit_cast(float, rr[k] << 16), hi = __builtin_bit_cast(float, rr[k] & 0xffff0000u); acc[2 * k] += lo; acc[2 * k + 1] += hi;
                if (j == 0) { self[2 * k] = lo; self[2 * k + 1] = hi; } }
        }
        const float inv = 1.f / (float)n; u32x4 o;
        o.x = pk2(acc[0] * inv - self[0], acc[1] * inv - self[1]); o.y = pk2(acc[2] * inv - self[2], acc[3] * inv - self[3]);
        o.z = pk2(acc[4] * inv - self[4], acc[5] * inv - self[5]); o.w = pk2(acc[6] * inv - self[6], acc[7] * inv - self[7]);
        *(u32x4*)(CAT + (size_t)row * DM + c0) = o;
    }
}
__device__ __forceinline__ void c2_scan(const Args& a, LAS unsigned char* L, int bh, int tid, int lane, int wave) {
    const float* src = (const float*)(a.ws + WS_LOGF) + (size_t)bh * SEQ + tid * 16;
    LAS double* wtot = (LAS double*)(L + 0);
    LAS float* c2s = (LAS float*)(L + attn_body::LDS_C2);
    float v[16]; double s = 0.0;
#pragma unroll
    for (int i = 0; i < 16; ++i) { v[i] = src[i]; s += (double)v[i]; }
    double inc = s;
#pragma unroll
    for (int o = 1; o < 64; o <<= 1) { const double t_ = __shfl_up(inc, o); if (lane >= o) inc += t_; }
    if (lane == 63) wtot[wave] = inc;
    __syncthreads();
    double base = inc - s;
    for (int w = 0; w < wave; ++w) base += wtot[w];
#pragma unroll
    for (int i = 0; i < 16; ++i) { base += (double)v[i]; c2s[tid * 16 + i] = (float)(base * (double)LOG2E); }
    __syncthreads();
}

__device__ __forceinline__ void router_phase(const Args& a, LAS unsigned char* L, int vcu, int G, int tid, int lane, int wave) {
    LAS float* wr = (LAS float*)L;
    LAS int* ch_e = (LAS int*)(L + RT_CHE); LAS float* ch_g = (LAS float*)(L + RT_CHG); LAS int* lcnt = (LAS int*)(L + RT_LCNT); LAS int* lbase = (LAS int*)(L + RT_LBASE);
    const float* w_router = a.in[8]; const float* b_router = a.in[9]; const float* g_ffn = a.in[7];
    for (int i = tid; i < 1024 * 32 / 4; i += 512) ((LAS f32x4*)wr)[i] = ((const f32x4*)w_router)[i];
    __syncthreads();
    const float* X1 = a.out; bf16* H2 = (bf16*)(a.ws + WS_XN);
    int* cnt = (int*)(a.ws + WS_CTL) + CW_CNT; int* SEL = (int*)(a.ws + WS_SEL); int* LTK = (int*)(a.ws + WS_LTK); float* LGT = (float*)(a.ws + WS_LGT);
    f32x4 g[4];
#pragma unroll
    for (int j = 0; j < 4; ++j) g[j] = *(const f32x4*)(g_ffn + 4 * lane + 256 * j);
    const int myexp = ((lane >> 5) & 1) * 16 + ((lane >> 4) & 1) * 8 + ((lane >> 3) & 1) * 4 + ((lane >> 2) & 1) * 2 + ((lane >> 1) & 1);
    const float mybias = b_router[myexp];
    for (int grp = vcu; grp < T / 128; grp += G) {
        if (tid < 32) lcnt[tid] = 0;
        __syncthreads();
        for (int it = 0; it < 16; ++it) {
            const int lt = wave * 16 + it, m = grp * 128 + lt;
            const float* xr = X1 + (size_t)m * DM;
            f32x4 v[4]; float ss = 0.f;
#pragma unroll
            for (int j = 0; j < 4; ++j) { v[j] = *(const f32x4*)(xr + 4 * lane + 256 * j); ss += v[j].x * v[j].x + v[j].y * v[j].y + v[j].z * v[j].z + v[j].w * v[j].w; }
            const float rstd = rsqrtf(wave_sum(ss) * (1.f / DM) + RMS_EPS);
            float lg[32];
#pragma unroll
            for (int e = 0; e < 32; ++e) lg[e] = 0.f;
#pragma unroll
            for (int j = 0; j < 4; ++j) {
                v[j] = v[j] * rstd * g[j];
                u32x2 o; o.x = pk2(v[j].x, v[j].y); o.y = pk2(v[j].z, v[j].w);
                *(u32x2*)(H2 + (size_t)m * DM + 4 * lane + 256 * j) = o;
#pragma unroll
                for (int i = 0; i < 4; ++i) { const int d = 4 * lane + 256 * j + i; const float hv = v[j][i];
#pragma unroll
                    for (int e4 = 0; e4 < 8; ++e4) { const f32x4 w = *(const LAS f32x4*)(wr + d * 32 + e4 * 4);
                        lg[e4 * 4] += hv * w.x; lg[e4 * 4 + 1] += hv * w.y; lg[e4 * 4 + 2] += hv * w.z; lg[e4 * 4 + 3] += hv * w.w; }
                    asm volatile("" ::: "memory"); }
            }
            float mine;
            {
                float a16[16]; const bool up = lane >= 32;
#pragma unroll
                for (int e = 0; e < 16; ++e) { const float keep = up ? lg[16 + e] : lg[e], give = up ? lg[e] : lg[16 + e]; a16[e] = keep + __shfl_xor(give, 32); }
                float a8[8]; const bool u16 = (lane & 16) != 0;
#pragma unroll
                for (int e = 0; e < 8; ++e) { const float keep = u16 ? a16[8 + e] : a16[e], give = u16 ? a16[e] : a16[8 + e]; a8[e] = keep + __shfl_xor(give, 16); }
                float a4[4]; const bool u8 = (lane & 8) != 0;
#pragma unroll
                for (int e = 0; e < 4; ++e) { const float keep = u8 ? a8[4 + e] : a8[e], give = u8 ? a8[e] : a8[4 + e]; a4[e] = keep + __shfl_xor(give, 8); }
                float a2[2]; const bool u4 = (lane & 4) != 0;
#pragma unroll
                for (int e = 0; e < 2; ++e) { const float keep = u4 ? a4[2 + e] : a4[e], give = u4 ? a4[e] : a4[2 + e]; a2[e] = keep + __shfl_xor(give, 4); }
                const bool u2 = (lane & 2) != 0;
                float a1 = (u2 ? a2[1] : a2[0]) + __shfl_xor(u2 ? a2[0] : a2[1], 2);
                a1 += __shfl_xor(a1, 1);
                mine = a1;
            }
            float val = mine + mybias;
            if (lane & 1) val = -INFINITY;
            float tv[4]; int ti[4];
#pragma unroll
            for (int k = 0; k < 4; ++k) {
                float bv = val; int bi = myexp;
#pragma unroll
                for (int o = 1; o < 64; o <<= 1) { const float ov = __shfl_xor(bv, o); const int oi = __shfl_xor(bi, o); if (ov > bv || (ov == bv && oi < bi)) { bv = ov; bi = oi; } }
                tv[k] = bv; ti[k] = bi; if (myexp == bi) val = -INFINITY;
            }
            const float e0 = 1.f, e1 = expf(tv[1] - tv[0]), e2 = expf(tv[2] - tv[0]), e3 = expf(tv[3] - tv[0]); const float inv = 1.f / (e0 + e1 + e2 + e3);
            if (lane < 4) { const float gg = (lane == 0 ? e0 : lane == 1 ? e1 : lane == 2 ? e2 : e3) * inv; const int ee = lane == 0 ? ti[0] : lane == 1 ? ti[1] : lane == 2 ? ti[2] : ti[3];
                ch_e[lt * 4 + lane] = ee; ch_g[lt * 4 + lane] = gg; __hip_atomic_fetch_add(&lcnt[ee], 1, __ATOMIC_RELAXED, __HIP_MEMORY_SCOPE_WORKGROUP); }
        }
        __syncthreads();
        if (tid < 32) { lbase[tid] = atomicAdd(&cnt[tid], lcnt[tid]); lcnt[tid] = 0; }
        __syncthreads();
        { const int e = ch_e[tid]; const int slot = lbase[e] + __hip_atomic_fetch_add(&lcnt[e], 1, __ATOMIC_RELAXED, __HIP_MEMORY_SCOPE_WORKGROUP); const int tk = (grp * 128 + (tid >> 2)) * 4 + (tid & 3);
          LTK[(size_t)e * T + slot] = tk; LGT[(size_t)e * T + slot] = ch_g[tid]; SEL[tk] = (slot << 5) | e; }
        __syncthreads();
    }
}

__device__ __forceinline__ void expert_map(const Args& a, volatile LAS unsigned* MISC, int tid) {
    if (tid == 0) { const int* cnt = (const int*)(a.ws + WS_CTL) + CW_CNT; int acc = 0;
        for (int e = 0; e < 32; ++e) { const int c = __hip_atomic_load((int*)cnt + e, RLX_AGENT); MISC[64 + e] = (unsigned)c; MISC[96 + e] = (unsigned)acc; acc += (c + RT - 1) / RT; } MISC[128] = (unsigned)acc; }
    __syncthreads();
}

__device__ __forceinline__ void final_phase(const Args& a, volatile LAS unsigned* MISC, int vcu, int G, int lane, int wave) {
    const int* SEL = (const int*)(a.ws + WS_SEL); const bf16* Y = (const bf16*)(a.ws + WS_Y); const float* g_final = a.in[14];
    f32x4 g[4];
#pragma unroll
    for (int j = 0; j < 4; ++j) g[j] = *(const f32x4*)(g_final + 4 * lane + 256 * j);
    for (int m = vcu * 8 + wave; m < T; m += G * 8) {
        float* xr = a.out + (size_t)m * DM; f32x4 v[4];
#pragma unroll
        for (int j = 0; j < 4; ++j) v[j] = *(const f32x4*)(xr + 4 * lane + 256 * j);
#pragma unroll
        for (int k = 0; k < 4; ++k) { const int sv = SEL[m * 4 + k]; const int e = sv & 31, slot = sv >> 5; const bf16* yr = Y + ((size_t)MISC[96 + e] * RT + slot) * DM;
#pragma unroll
            for (int j = 0; j < 4; ++j) { const u32x2 y = *(const u32x2*)(yr + 4 * lane + 256 * j);
                v[j].x += __builtin_bit_cast(float, y.x << 16); v[j].y += __builtin_bit_cast(float, y.x & 0xffff0000u); v[j].z += __builtin_bit_cast(float, y.y << 16); v[j].w += __builtin_bit_cast(float, y.y & 0xffff0000u); } }
        float ss = 0.f;
#pragma unroll
        for (int j = 0; j < 4; ++j) ss += v[j].x * v[j].x + v[j].y * v[j].y + v[j].z * v[j].z + v[j].w * v[j].w;
        const float rstd = rsqrtf(wave_sum(ss) * (1.f / DM) + RMS_EPS);
#pragma unroll
        for (int j = 0; j < 4; ++j) *(f32x4*)(xr + 4 * lane + 256 * j) = v[j] * rstd * g[j];
    }
}

__global__ void __launch_bounds__(NWAVES * 64, 2) mk_fwd(Args args) {
    extern __shared__ __attribute__((aligned(16))) unsigned char lds[];
    LAS unsigned char* L = (LAS unsigned char*)lds;
    volatile LAS unsigned* MISC = (volatile LAS unsigned*)(L + LDSCTL_OFF);
    const int tid = threadIdx.x, lane = tid & 63, wave = __builtin_amdgcn_readfirstlane(tid >> 6);
    const int G = gridDim.x; const int bx = blockIdx.x; const int vcu = (G % 8 == 0) ? (bx % 8) * (G / 8) + bx / 8 : bx;
    unsigned char* ws = args.ws;
    for (int u = tid; u < (LDS_TOTAL - LDSCTL_OFF) / 4; u += NWAVES * 64) ((LAS unsigned*)(L + LDSCTL_OFF))[u] = 0u;
    __syncthreads();
    XcdBarrier bar; bar.bar = (unsigned*)(ws + WS_CTL) + CW_BAR; bar.x = 0; bar.st = nullptr;
    if (args.use_bar) bar = xcd_barrier_post((unsigned*)(ws + WS_CTL) + CW_BAR, MISC + 8);
    const int lo = args.ph_lo, hi = args.ph_hi;
#define IN(k) (lo <= (k) && (k) < hi)
#define SEAM(k) do { if (IN(k) && IN((k) + 1)) xcd_barrier(bar); } while (0)

    if (IN(0)) { phase0(args, L, vcu, G, tid, lane, wave); }
    SEAM(0);
    if (IN(1)) {
        pg8::Gemm g{(const bf16*)(ws + WS_XN), (const bf16*)(ws + WS_WIN), DM}; pg8::StaticOrder S; S.init(T, 2048, G, bx);
        pg8::EpiInproj E{(bf16*)(ws + WS_U), (size_t)(WS_Q - WS_U) / 2, C2};
        pg8::gemm_phase<pg8::EpiInproj, pg8::StaticOrder, true, false>(L + RING_OFF, g, S, E, nullptr);
    }
    SEAM(1);
    if (IN(2)) {
        pool_pass(args, vcu, G, tid);
        const attn_body::StaticOrder S(G, bx);
        c2_scan(args, L, S.vcu >> 3, tid, lane, wave);
        const attn_body::AttnTensors AT{(const attn_body::bf16*)(ws + WS_Q), (const attn_body::bf16*)(ws + WS_K), (const attn_body::bf16*)(ws + WS_V), (attn_body::bf16*)(ws + WS_CAT) + PW};
        attn_body::attn_phase<attn_body::StaticOrder>((char*)lds + RING_OFF, AT, S);
    }
    SEAM(2);
    if (IN(3)) {
        pg8::Gemm g{(const bf16*)(ws + WS_CAT), (const bf16*)(ws + WS_WO), DM}; pg8::StaticOrder S; S.init(T, DM, G, bx);
        pg8::EpiResF32 E{args.in[0], args.out};
        pg8::gemm_phase<pg8::EpiResF32, pg8::StaticOrder, true, false>(L + RING_OFF, g, S, E, nullptr);
    }
    SEAM(3);
    if (IN(4)) { router_phase(args, L, vcu, G, tid, lane, wave); }
    SEAM(4);
    if (IN(5)) {
        expert_map(args, MISC, tid);
        const LAS int* pt = (const LAS int*)(L + LDSCTL_OFF + 96 * 4); const LAS int* cn = (const LAS int*)(L + LDSCTL_OFF + 64 * 4);
        LAS unsigned* tab = (LAS unsigned*)(L + TAB_OFF);
        const pg8::MoeOrder<8> S{pt, G, bx, (size_t)2048 * DM * 2};
        { const int* LTK = (const int*)(ws + WS_LTK); pg8::Unit u;
          for (int i = 0; i < TAB_UNITS && S.next(i, u); ++i) { if (tid < 256) { const int slot = u.lrow0 + tid; const int tok = slot < cn[u.e] ? (LTK[(size_t)u.e * T + slot] >> 2) : 0; tab[i * 256 + tid] = (unsigned)tok * (unsigned)(DM * 2); } } }
        __syncthreads();
        pg8::Gemm g{(const bf16*)(ws + WS_XN), (const bf16*)(ws + WS_WU), DM};
        pg8::EpiSwiglu E{(bf16*)(ws + WS_ACT), args.in[11]};
        pg8::gemm_phase<pg8::EpiSwiglu, pg8::MoeOrder<8>, true, true>(L + RING_OFF, g, S, E, tab);
    }
    SEAM(5);
    if (IN(6)) {
        expert_map(args, MISC, tid);
        const LAS int* pt = (const LAS int*)(L + LDSCTL_OFF + 96 * 4); const LAS int* cn = (const LAS int*)(L + LDSCTL_OFF + 64 * 4);
        const pg8::MoeOrder<4> S{pt, G, bx, (size_t)DM * DE * 2};
        pg8::Gemm g{(const bf16*)(ws + WS_ACT), (const bf16*)(ws + WS_WD), DE};
        pg8::EpiDown E{(bf16*)(ws + WS_Y), args.in[13], (const float*)(ws + WS_LGT), cn, T};
        pg8::gemm_phase<pg8::EpiDown, pg8::MoeOrder<4>, true, false>(L + RING_OFF, g, S, E, nullptr);
    }
    SEAM(6);
    if (IN(7)) { expert_map(args, MISC, tid); final_phase(args, MISC, vcu, G, lane, wave); }
#undef IN
#undef SEAM
}
#ifndef MK_MODE
#define MK_MODE 1
#endif
#ifndef MK_NAIVE_MASK
#define MK_NAIVE_MASK 0
#endif
extern "C" void kernel_launch(void* const* d_in, const int* in_sizes, int n_in, void* d_out, int out_size, void* d_ws, size_t ws_size, hipStream_t stream) {
    if (n_in != 15 || out_size != T * DM || ws_size < WS_END) { fprintf(stderr, "kernel_launch: unexpected shapes (n_in %d out %d ws %zu)\n", n_in, out_size, ws_size); return; }
    Params p{};
    p.x = (const float*)d_in[0]; p.g_mix = (const float*)d_in[1]; p.w_in = (const float*)d_in[2]; p.b_forget = (const float*)d_in[3]; p.w_pool = (const float*)d_in[4];
    p.pool_scale = (const float*)d_in[5]; p.w_out = (const float*)d_in[6]; p.g_ffn = (const float*)d_in[7]; p.w_router = (const float*)d_in[8]; p.b_router = (const float*)d_in[9];
    p.w_up = (const float*)d_in[10]; p.b_up = (const float*)d_in[11]; p.w_down = (const float*)d_in[12]; p.b_down = (const float*)d_in[13]; p.g_final = (const float*)d_in[14];
    p.out = (float*)d_out; p.ws = (unsigned char*)d_ws;
    Args a{};
    for (int i = 0; i < 15; ++i) a.in[i] = (const float*)d_in[i];
    a.out = (float*)d_out; a.ws = (unsigned char*)d_ws;
    static bool attr_done = false;
    if (!attr_done) { if (hipFuncSetAttribute((const void*)mk_fwd, hipFuncAttributeMaxDynamicSharedMemorySize, LDS_TOTAL) != hipSuccess) fprintf(stderr, "kernel_launch: hipFuncSetAttribute failed\n"); attr_done = true; }
    (void)hipMemsetAsync((char*)d_ws + WS_CTL, 0, 1 * MiB, stream);
    const int GRID = 256;
#if MK_MODE == 2
    a.ph_lo = 0; a.ph_hi = N_PHASES; a.use_bar = 1;
    hipLaunchKernelGGL(mk_fwd, dim3(GRID), dim3(NWAVES * 64), LDS_TOTAL, stream, a);
#else
    const unsigned mask = (MK_MODE == 0) ? 0xffu : (unsigned)(MK_NAIVE_MASK);
    auto fast = [&](int k) { a.ph_lo = k; a.ph_hi = k + 1; a.use_bar = 0; hipLaunchKernelGGL(mk_fwd, dim3(GRID), dim3(NWAVES * 64), LDS_TOTAL, stream, a); };
    auto nv = [&](int k) { return (mask >> k) & 1u; };
    if (mask != 0xffu || !nv(0)) fast(0);
    if (nv(0)) k_prologue<<<1024, 512, 0, stream>>>(p);
    if (nv(1)) k_inproj_naive<<<2048, 512, 0, stream>>>(p); else fast(1);
    if (nv(2)) { k_cumsum<<<32, 512, 0, stream>>>(p); k_attn_naive<<<BATCH * NH * (SEQ / 64), 512, 0, stream>>>(p); if (!nv(3)) k_pool<<<2048, 512, 0, stream>>>(p, (bf16*)((unsigned char*)d_ws + WS_CAT), DM); }
    else fast(2);
    if (nv(3)) { k_pool<<<2048, 512, 0, stream>>>(p, (bf16*)((unsigned char*)d_ws + WS_P), PW); k_poolgemm_naive<<<2048, 512, 0, stream>>>(p); k_outproj_naive<<<2048, 512, 0, stream>>>(p); }
    else fast(3);
    if (nv(4)) k_router<<<256, 512, 0, stream>>>(p); else fast(4);
    if (nv(5)) k_up_naive<<<4096, 512, 0, stream>>>(p); else fast(5);
    if (nv(6)) k_down_naive<<<4096, 512, 0, stream>>>(p); else fast(6);
    if (nv(7)) k_final<<<1024, 512, 0, stream>>>(p); else fast(7);
#endif
}
```

```cpp
#define MK_MODE 2
#include <hip/hip_runtime.h>
#include <cstdio>
#include <cstdint>

constexpr int BATCH = 4, SEQ = 8192, DM = 1024, T = BATCH * SEQ;
constexpr int PW = 512, AW = 512, NH = 8, HD = 64, INW = PW + 3 * AW + NH;
constexpr int NE = 32, TOPK = 4, DE = 1024;
constexpr float RMS_EPS = 1e-5f, SW_LIMIT = 7.0f, SW_ALPHA = 1.702f;
constexpr float LOG2E = 1.4426950408889634f;
constexpr float C2 = 0.125f * LOG2E;
constexpr int RT = 256;
constexpr int NROWS_PAD = T * TOPK + NE * RT;

typedef unsigned short bf16;
typedef float f32x4 __attribute__((ext_vector_type(4)));
typedef unsigned u32x4 __attribute__((ext_vector_type(4)));
typedef unsigned u32x2 __attribute__((ext_vector_type(2)));

constexpr size_t MiB = 1u << 20;
constexpr size_t WS_CTL = 0;
constexpr size_t WS_LOGF = 1 * MiB;
constexpr size_t WS_CUM = 2 * MiB;
constexpr size_t WS_SEL = 3 * MiB;
constexpr size_t WS_LTK = 4 * MiB;
constexpr size_t WS_LGT = 8 * MiB;
constexpr size_t WS_XN = 12 * MiB;
constexpr size_t WS_WIN = 76 * MiB;
constexpr size_t WS_WO = 80 * MiB;
constexpr size_t WS_WU = 82 * MiB;
constexpr size_t WS_WD = 210 * MiB;
constexpr size_t WS_U = 274 * MiB;
constexpr size_t WS_Q = 306 * MiB;
constexpr size_t WS_K = 338 * MiB;
constexpr size_t WS_V = 370 * MiB;
constexpr size_t WS_CAT = 402 * MiB;
constexpr size_t WS_P = 466 * MiB;
constexpr size_t WS_ACT = 274 * MiB;
constexpr size_t WS_Y = 546 * MiB;
constexpr size_t WS_END = 818 * MiB;
static_assert(WS_ACT + (size_t)NROWS_PAD * 1024 * 2 <= WS_Y, "ACT overlay");
static_assert(WS_Y + (size_t)NROWS_PAD * 1024 * 2 <= WS_END, "Y");
constexpr int CW_CNT = 64;

struct Params {
    const float *x, *g_mix, *w_in, *b_forget, *w_pool, *pool_scale, *w_out, *g_ffn, *w_router, *b_router, *w_up, *b_up, *w_down, *b_down, *g_final;
    float* out; unsigned char* ws;
};

__device__ __forceinline__ unsigned f2bf(float f) { unsigned u = __builtin_bit_cast(unsigned, f); return (u + 0x7fffu + ((u >> 16) & 1u)) >> 16; }
__device__ __forceinline__ unsigned pk2(float lo, float hi) { return f2bf(lo) | (f2bf(hi) << 16); }
__device__ __forceinline__ float bf2f(unsigned short b) { return __builtin_bit_cast(float, (unsigned)b << 16); }
__device__ __forceinline__ float wave_sum(float v) {
#pragma unroll
    for (int o = 1; o < 64; o <<= 1) v += __shfl_xor(v, o);
    return v;
}

__global__ void __launch_bounds__(512) k_prologue(Params p) {
    __shared__ float wf[1024 * 8];
    const int tid = threadIdx.x, lane = tid & 63, wave = tid >> 6;
    for (int i = tid; i < 1024 * 8; i += 512) wf[i] = p.w_in[(size_t)(i >> 3) * INW + 2048 + (i & 7)];
    if (blockIdx.x == 0 && tid < 64) ((int*)(p.ws + WS_CTL))[CW_CNT + tid] = 0;
    __syncthreads();
    bf16* XN = (bf16*)(p.ws + WS_XN); float* LOGF = (float*)(p.ws + WS_LOGF);
    const int gw = blockIdx.x * 8 + wave, NGW = gridDim.x * 8;
    f32x4 g[4];
#pragma unroll
    for (int j = 0; j < 4; ++j) g[j] = *(const f32x4*)(p.g_mix + 4 * lane + 256 * j);
    for (int m = gw; m < T; m += NGW) {
        const float* xr = p.x + (size_t)m * DM;
        f32x4 v[4]; float ss = 0.f;
#pragma unroll
        for (int j = 0; j < 4; ++j) { v[j] = *(const f32x4*)(xr + 4 * lane + 256 * j); ss += v[j].x * v[j].x + v[j].y * v[j].y + v[j].z * v[j].z + v[j].w * v[j].w; }
        const float rstd = rsqrtf(wave_sum(ss) * (1.f / DM) + RMS_EPS);
        float fl[8];
#pragma unroll
        for (int e = 0; e < 8; ++e) fl[e] = 0.f;
#pragma unroll
        for (int j = 0; j < 4; ++j) {
            v[j] = v[j] * rstd * g[j];
#pragma unroll
            for (int i = 0; i < 4; ++i) {
                const int d = 4 * lane + 256 * j + i; const float hv = v[j][i];
                const f32x4 w0 = *(const f32x4*)(wf + d * 8), w1 = *(const f32x4*)(wf + d * 8 + 4);
                fl[0] += hv * w0.x; fl[1] += hv * w0.y; fl[2] += hv * w0.z; fl[3] += hv * w0.w;
                fl[4] += hv * w1.x; fl[5] += hv * w1.y; fl[6] += hv * w1.z; fl[7] += hv * w1.w;
            }
            u32x2 o; o.x = pk2(v[j].x, v[j].y); o.y = pk2(v[j].z, v[j].w);
            *(u32x2*)(XN + (size_t)m * DM + 4 * lane + 256 * j) = o;
        }
#pragma unroll
        for (int e = 0; e < 8; ++e) fl[e] = wave_sum(fl[e]);
        if (lane < 8) {
            float z = 0.f;
#pragma unroll
            for (int e = 0; e < 8; ++e) if (lane == e) z = fl[e];
            z += p.b_forget[lane];
            const float ls = fminf(z, 0.f) - log1pf(expf(-fabsf(z)));
            const int b = m / SEQ, s = m % SEQ;
            LOGF[((size_t)b * NH + lane) * SEQ + s] = ls;
        }
    }
}

__global__ void __launch_bounds__(512) k_cumsum(Params p) {
    __shared__ double part[512];
    const int tid = threadIdx.x;
    const float* LOGF = (const float*)(p.ws + WS_LOGF); float* CUM = (float*)(p.ws + WS_CUM);
    for (int bh = blockIdx.x; bh < BATCH * NH; bh += gridDim.x) {
        const float* src = LOGF + (size_t)bh * SEQ + tid * 16; float v[16]; double s = 0.0;
#pragma unroll
        for (int i = 0; i < 16; ++i) { v[i] = src[i]; s += (double)v[i]; }
        part[tid] = s; __syncthreads();
        if (tid == 0) { double a = 0.0; for (int i = 0; i < 512; ++i) { const double t_ = part[i]; part[i] = a; a += t_; } }
        __syncthreads();
        double a = part[tid];
        float* dst = CUM + (size_t)bh * SEQ + tid * 16;
#pragma unroll
        for (int i = 0; i < 16; ++i) { a += (double)v[i]; dst[i] = (float)(a * (double)LOG2E); }
        __syncthreads();
    }
}

__global__ void __launch_bounds__(512) k_pool(Params p, bf16* dst, int ldd) {
    const bf16* U = (const bf16*)(p.ws + WS_U);
    const size_t total = (size_t)T * 64;
    for (size_t i = (size_t)blockIdx.x * 512 + threadIdx.x; i < total; i += (size_t)gridDim.x * 512) {
        const int row = (int)(i >> 6), ch = (int)(i & 63), c0 = ch * 8, g = c0 >> 7, w = 2 << g, t = row % SEQ;
        const int n = t + 1 < w ? t + 1 : w;
        float acc[8], self[8];
#pragma unroll
        for (int k = 0; k < 8; ++k) acc[k] = 0.f;
        for (int j = 0; j < n; ++j) {
            const u32x4 r = *(const u32x4*)(U + (size_t)(row - j) * PW + c0);
            const unsigned rr[4] = {r.x, r.y, r.z, r.w};
#pragma unroll
            for (int k = 0; k < 4; ++k) { const float lo = __builtin_bit_cast(float, rr[k] << 16), hi = __builtin_bit_cast(float, rr[k] & 0xffff0000u); acc[2 * k] += lo; acc[2 * k + 1] += hi;
                if (j == 0) { self[2 * k] = lo; self[2 * k + 1] = hi; } }
        }
        const float inv = 1.f / (float)n; u32x4 o;
        o.x = pk2(acc[0] * inv - self[0], acc[1] * inv - self[1]); o.y = pk2(acc[2] * inv - self[2], acc[3] * inv - self[3]);
        o.z = pk2(acc[4] * inv - self[4], acc[5] * inv - self[5]); o.w = pk2(acc[6] * inv - self[6], acc[7] * inv - self[7]);
        *(u32x4*)(dst + (size_t)row * ldd + c0) = o;
    }
}

template <class ARow, class Epi, bool DUAL>
__device__ __forceinline__ void naive_tile(int tm, int tn, int K, const ARow& arow, const float* W, const float* W2, int ldw, const Epi& epi, float* lds) {
    float* As = lds;
    float* Ws = lds + 16 * 68;
    float* Ws2 = Ws + 16 * 128;
    const int tid = threadIdx.x, tx = tid & 31, ty = tid >> 5;
    float acc[4][4], acc2[4][4];
#pragma unroll
    for (int i = 0; i < 4; ++i)
#pragma unroll
        for (int j = 0; j < 4; ++j) { acc[i][j] = 0.f; acc2[i][j] = 0.f; }
    const int ar = tid >> 3, ak = (tid & 7) * 2;
    const bf16* aptr = arow(tm * 64 + ar);
    const int wk = tid >> 5, wc = (tid & 31) * 4;
    for (int k0 = 0; k0 < K; k0 += 16) {
        unsigned av = aptr ? *(const unsigned*)(aptr + k0 + ak) : 0u;
        const f32x4 wv = *(const f32x4*)(W + (size_t)(k0 + wk) * ldw + tn * 128 + wc);
        f32x4 wv2; if (DUAL) wv2 = *(const f32x4*)(W2 + (size_t)(k0 + wk) * ldw + tn * 128 + wc);
        __syncthreads();
        As[ak * 68 + ar] = __builtin_bit_cast(float, av << 16); As[(ak + 1) * 68 + ar] = __builtin_bit_cast(float, av & 0xffff0000u);
        *(f32x4*)(Ws + wk * 128 + wc) = wv; if (DUAL) *(f32x4*)(Ws2 + wk * 128 + wc) = wv2;
        __syncthreads();
#pragma unroll
        for (int k = 0; k < 16; ++k) {
            const f32x4 a = *(const f32x4*)(As + k * 68 + ty * 4), w = *(const f32x4*)(Ws + k * 128 + tx * 4);
#pragma unroll
            for (int i = 0; i < 4; ++i)
#pragma unroll
                for (int j = 0; j < 4; ++j) acc[i][j] += a[i] * w[j];
            if (DUAL) { const f32x4 w2 = *(const f32x4*)(Ws2 + k * 128 + tx * 4);
#pragma unroll
                for (int i = 0; i < 4; ++i)
#pragma unroll
                    for (int j = 0; j < 4; ++j) acc2[i][j] += a[i] * w2[j]; }
        }
    }
#pragma unroll
    for (int i = 0; i < 4; ++i) epi(tm * 64 + ty * 4 + i, tn * 128 + tx * 4, acc[i], acc2[i]);
}
constexpr int NAIVE_LDS_FLOATS = 16 * 68 + 2 * 16 * 128;

struct ARowPlain { const bf16* A; int lda; __device__ __forceinline__ const bf16* operator()(int r) const { return A + (size_t)r * lda; } };
struct EpiInproj { bf16* U; __device__ __forceinline__ void operator()(int r, int c, const float (&a)[4], const float (&)[4]) const {
        const int t = c >> 9, cc = c & 511; const float s = (t == 1) ? C2 : 1.f;
        u32x2 o; o.x = pk2(a[0] * s, a[1] * s); o.y = pk2(a[2] * s, a[3] * s);
        *(u32x2*)(U + (size_t)t * ((WS_Q - WS_U) / 2) + (size_t)r * 512 + cc) = o; } };
__global__ void __launch_bounds__(512) k_inproj_naive(Params p) {
    __shared__ __attribute__((aligned(16))) float lds[NAIVE_LDS_FLOATS];
    ARowPlain ar{(const bf16*)(p.ws + WS_XN), DM}; EpiInproj ep{(bf16*)(p.ws + WS_U)};
    const int nM = T / 64, nN = 2048 / 128;
    for (int u = blockIdx.x; u < nM * nN; u += gridDim.x) naive_tile<ARowPlain, EpiInproj, false>(u / nN, u % nN, DM, ar, p.w_in, nullptr, INW, ep, lds);
}
struct EpiPool { bf16* CAT; const float* ps; int g; __device__ __forceinline__ void operator()(int r, int c, const float (&a)[4], const float (&)[4]) const {
        const int cc = g * 128 + c; const f32x4 s = *(const f32x4*)(ps + cc);
        u32x2 o; o.x = pk2(a[0] * s.x, a[1] * s.y); o.y = pk2(a[2] * s.z, a[3] * s.w);
        *(u32x2*)(CAT + (size_t)r * DM + cc) = o; } };
__global__ void __launch_bounds__(512) k_poolgemm_naive(Params p) {
    __shared__ __attribute__((aligned(16))) float lds[NAIVE_LDS_FLOATS];
    const int nM = T / 64;
    for (int u = blockIdx.x; u < nM * 4; u += gridDim.x) { const int g = u & 3, tm = u >> 2;
        ARowPlain ar{(const bf16*)(p.ws + WS_P) + g * 128, PW}; EpiPool ep{(bf16*)(p.ws + WS_CAT), p.pool_scale, g};
        naive_tile<ARowPlain, EpiPool, false>(tm, 0, 128, ar, p.w_pool + (size_t)g * 128 * 128, nullptr, 128, ep, lds); }
}
struct EpiOut { const float* x; float* out; __device__ __forceinline__ void operator()(int r, int c, const float (&a)[4], const float (&)[4]) const {
        const f32x4 xv = *(const f32x4*)(x + (size_t)r * DM + c); f32x4 o = {xv.x + a[0], xv.y + a[1], xv.z + a[2], xv.w + a[3]};
        *(f32x4*)(out + (size_t)r * DM + c) = o; } };
__global__ void __launch_bounds__(512) k_outproj_naive(Params p) {
    __shared__ __attribute__((aligned(16))) float lds[NAIVE_LDS_FLOATS];
    ARowPlain ar{(const bf16*)(p.ws + WS_CAT), DM}; EpiOut ep{p.x, p.out};
    const int nM = T / 64, nN = DM / 128;
    for (int u = blockIdx.x; u < nM * nN; u += gridDim.x) naive_tile<ARowPlain, EpiOut, false>(u / nN, u % nN, DM, ar, p.w_out, nullptr, DM, ep, lds);
}

__global__ void __launch_bounds__(512) k_attn_naive(Params p) {
    __shared__ __attribute__((aligned(16))) float Ks[64 * 68];
    __shared__ __attribute__((aligned(16))) float Vs[64 * 64];
    __shared__ float Ss[64 * 65];
    __shared__ float cs[64];
    const bf16* Q = (const bf16*)(p.ws + WS_Q); const bf16* K = (const bf16*)(p.ws + WS_K); const bf16* V = (const bf16*)(p.ws + WS_V);
    bf16* CAT = (bf16*)(p.ws + WS_CAT); const float* CUM = (const float*)(p.ws + WS_CUM);
    const int tid = threadIdx.x, r = tid >> 3, part = tid & 7;
    for (int u = blockIdx.x; u < BATCH * NH * (SEQ / 64); u += gridDim.x) {
        const int qb = (SEQ / 64 - 1) - (u / (BATCH * NH)), bh = u % (BATCH * NH), b = bh / NH, h = bh % NH;
        const size_t rowbase = (size_t)b * SEQ; const int t = qb * 64 + r;
        float q[64];
        { const bf16* qp = Q + (rowbase + t) * AW + h * HD;
#pragma unroll
          for (int i = 0; i < 64; i += 2) { const unsigned v = *(const unsigned*)(qp + i); q[i] = __builtin_bit_cast(float, v << 16); q[i + 1] = __builtin_bit_cast(float, v & 0xffff0000u); } }
        const float ct = CUM[(size_t)bh * SEQ + t];
        float o[8]; float m = -INFINITY, l = 0.f;
#pragma unroll
        for (int i = 0; i < 8; ++i) o[i] = 0.f;
        for (int kt = 0; kt <= qb; ++kt) {
            __syncthreads();
            { const int kr = tid >> 3, kc = (tid & 7) * 8;
              const u32x4 kv = *(const u32x4*)(K + (rowbase + kt * 64 + kr) * AW + h * HD + kc), vv = *(const u32x4*)(V + (rowbase + kt * 64 + kr) * AW + h * HD + kc);
              const unsigned ka[4] = {kv.x, kv.y, kv.z, kv.w}, va[4] = {vv.x, vv.y, vv.z, vv.w};
#pragma unroll
              for (int i = 0; i < 4; ++i) { Ks[kr * 68 + kc + 2 * i] = __builtin_bit_cast(float, ka[i] << 16); Ks[kr * 68 + kc + 2 * i + 1] = __builtin_bit_cast(float, ka[i] & 0xffff0000u);
                  Vs[kr * 64 + kc + 2 * i] = __builtin_bit_cast(float, va[i] << 16); Vs[kr * 64 + kc + 2 * i + 1] = __builtin_bit_cast(float, va[i] & 0xffff0000u); }
              if (tid < 64) cs[tid] = CUM[(size_t)bh * SEQ + kt * 64 + tid]; }
            __syncthreads();
            float lg[8]; float mx = -INFINITY;
#pragma unroll
            for (int j = 0; j < 8; ++j) { const int s = part * 8 + j; float d = 0.f;
#pragma unroll
                for (int i = 0; i < 64; i += 4) { const f32x4 kk = *(const f32x4*)(Ks + s * 68 + i); d += q[i] * kk.x + q[i + 1] * kk.y + q[i + 2] * kk.z + q[i + 3] * kk.w; }
                d += ct - cs[s]; if (kt * 64 + s > t) d = -INFINITY; lg[j] = d; mx = fmaxf(mx, d); }
            mx = fmaxf(mx, __shfl_xor(mx, 1)); mx = fmaxf(mx, __shfl_xor(mx, 2)); mx = fmaxf(mx, __shfl_xor(mx, 4));
            const float mn = fmaxf(m, mx); const float alpha = exp2f(m - mn); float ps = 0.f;
#pragma unroll
            for (int j = 0; j < 8; ++j) { const float pv = exp2f(lg[j] - mn); ps += pv; Ss[r * 65 + part * 8 + j] = pv; }
            ps += __shfl_xor(ps, 1); ps += __shfl_xor(ps, 2); ps += __shfl_xor(ps, 4);
            l = l * alpha + ps; m = mn;
#pragma unroll
            for (int i = 0; i < 8; ++i) o[i] *= alpha;
            __syncthreads();
            for (int s = 0; s < 64; ++s) { const float pv = Ss[r * 65 + s]; const f32x4 v0 = *(const f32x4*)(Vs + s * 64 + part * 8), v1 = *(const f32x4*)(Vs + s * 64 + part * 8 + 4);
                o[0] += pv * v0.x; o[1] += pv * v0.y; o[2] += pv * v0.z; o[3] += pv * v0.w; o[4] += pv * v1.x; o[5] += pv * v1.y; o[6] += pv * v1.z; o[7] += pv * v1.w; }
        }
        const float il = 1.f / l; u32x4 ov;
        ov.x = pk2(o[0] * il, o[1] * il); ov.y = pk2(o[2] * il, o[3] * il); ov.z = pk2(o[4] * il, o[5] * il); ov.w = pk2(o[6] * il, o[7] * il);
        *(u32x4*)(CAT + (rowbase + t) * DM + PW + h * HD + part * 8) = ov;
    }
}

__global__ void __launch_bounds__(512) k_router(Params p) {
    __shared__ __attribute__((aligned(16))) float wr[1024 * 32];
    __shared__ int ch_e[128 * 4]; __shared__ float ch_g[128 * 4]; __shared__ int lcnt[32], lbase[32];
    const int tid = threadIdx.x, lane = tid & 63, wave = tid >> 6;
    for (int i = tid; i < 1024 * 32 / 4; i += 512) ((f32x4*)wr)[i] = ((const f32x4*)p.w_router)[i];
    __syncthreads();
    const float* X1 = p.out; bf16* H2 = (bf16*)(p.ws + WS_XN);
    int* cnt = (int*)(p.ws + WS_CTL) + CW_CNT; int* SEL = (int*)(p.ws + WS_SEL); int* LTK = (int*)(p.ws + WS_LTK); float* LGT = (float*)(p.ws + WS_LGT);
    f32x4 g[4];
#pragma unroll
    for (int j = 0; j < 4; ++j) g[j] = *(const f32x4*)(p.g_ffn + 4 * lane + 256 * j);
    const float br = p.b_router[lane & 31];
    for (int grp = blockIdx.x; grp < T / 128; grp += gridDim.x) {
        if (tid < 32) lcnt[tid] = 0;
        __syncthreads();
        for (int it = 0; it < 16; ++it) {
            const int lt = wave * 16 + it, m = grp * 128 + lt;
            const float* xr = X1 + (size_t)m * DM;
            f32x4 v[4]; float ss = 0.f;
#pragma unroll
            for (int j = 0; j < 4; ++j) { v[j] = *(const f32x4*)(xr + 4 * lane + 256 * j); ss += v[j].x * v[j].x + v[j].y * v[j].y + v[j].z * v[j].z + v[j].w * v[j].w; }
            const float rstd = rsqrtf(wave_sum(ss) * (1.f / DM) + RMS_EPS);
            float lg[32];
#pragma unroll
            for (int e = 0; e < 32; ++e) lg[e] = 0.f;
#pragma unroll
            for (int j = 0; j < 4; ++j) {
                v[j] = v[j] * rstd * g[j];
                u32x2 o; o.x = pk2(v[j].x, v[j].y); o.y = pk2(v[j].z, v[j].w);
                *(u32x2*)(H2 + (size_t)m * DM + 4 * lane + 256 * j) = o;
#pragma unroll
                for (int i = 0; i < 4; ++i) { const int d = 4 * lane + 256 * j + i; const float hv = v[j][i];
#pragma unroll
                    for (int e4 = 0; e4 < 8; ++e4) { const f32x4 w = *(const f32x4*)(wr + d * 32 + e4 * 4);
                        lg[e4 * 4] += hv * w.x; lg[e4 * 4 + 1] += hv * w.y; lg[e4 * 4 + 2] += hv * w.z; lg[e4 * 4 + 3] += hv * w.w; }
                    asm volatile("" ::: "memory"); }
            }
            float mine;
            {
                float a16[16];
                const bool up = lane >= 32;
#pragma unroll
                for (int e = 0; e < 16; ++e) { const float keep = up ? lg[16 + e] : lg[e], give = up ? lg[e] : lg[16 + e]; a16[e] = keep + __shfl_xor(give, 32); }
                float a8[8]; const bool u16 = (lane & 16) != 0;
#pragma unroll
                for (int e = 0; e < 8; ++e) { const float keep = u16 ? a16[8 + e] : a16[e], give = u16 ? a16[e] : a16[8 + e]; a8[e] = keep + __shfl_xor(give, 16); }
                float a4[4]; const bool u8 = (lane & 8) != 0;
#pragma unroll
                for (int e = 0; e < 4; ++e) { const float keep = u8 ? a8[4 + e] : a8[e], give = u8 ? a8[e] : a8[4 + e]; a4[e] = keep + __shfl_xor(give, 8); }
                float a2[2]; const bool u4 = (lane & 4) != 0;
#pragma unroll
                for (int e = 0; e < 2; ++e) { const float keep = u4 ? a4[2 + e] : a4[e], give = u4 ? a4[e] : a4[2 + e]; a2[e] = keep + __shfl_xor(give, 4); }
                const bool u2 = (lane & 2) != 0;
                float a1 = (u2 ? a2[1] : a2[0]) + __shfl_xor(u2 ? a2[0] : a2[1], 2);
                a1 += __shfl_xor(a1, 1);
                mine = a1;
            }
            const int myexp = ((lane >> 5) & 1) * 16 + ((lane >> 4) & 1) * 8 + ((lane >> 3) & 1) * 4 + ((lane >> 2) & 1) * 2 + ((lane >> 1) & 1);
            float val = mine + p.b_router[myexp]; (void)br;
            if (lane & 1) val = -INFINITY;
            float tv[4]; int ti[4];
#pragma unroll
            for (int k = 0; k < 4; ++k) {
                float bv = val; int bi = myexp;
#pragma unroll
                for (int o = 1; o < 64; o <<= 1) { const float ov = __shfl_xor(bv, o); const int oi = __shfl_xor(bi, o); if (ov > bv || (ov == bv && oi < bi)) { bv = ov; bi = oi; } }
                tv[k] = bv; ti[k] = bi; if (myexp == bi) val = -INFINITY;
            }
            const float e0 = 1.f, e1 = expf(tv[1] - tv[0]), e2 = expf(tv[2] - tv[0]), e3 = expf(tv[3] - tv[0]); const float inv = 1.f / (e0 + e1 + e2 + e3);
            if (lane < 4) { const float gg = (lane == 0 ? e0 : lane == 1 ? e1 : lane == 2 ? e2 : e3) * inv; const int ee = lane == 0 ? ti[0] : lane == 1 ? ti[1] : lane == 2 ? ti[2] : ti[3];
                ch_e[lt * 4 + lane] = ee; ch_g[lt * 4 + lane] = gg; atomicAdd(&lcnt[ee], 1); }
        }
        __syncthreads();
        if (tid < 32) { lbase[tid] = atomicAdd(&cnt[tid], lcnt[tid]); lcnt[tid] = 0; }
        __syncthreads();
        { const int e = ch_e[tid]; const int slot = lbase[e] + atomicAdd(&lcnt[e], 1); const int tk = (grp * 128 + (tid >> 2)) * 4 + (tid & 3);
          LTK[(size_t)e * T + slot] = tk; LGT[(size_t)e * T + slot] = ch_g[tid]; SEL[tk] = (slot << 5) | e; }
        __syncthreads();
    }
}

struct ExpertMap { int cnt[32]; int pstart[33]; };
__device__ __forceinline__ void load_expert_map(const int* cnt, int* s_cnt, int* s_ps) {
    if (threadIdx.x == 0) { int a = 0; for (int e = 0; e < 32; ++e) { const int c = cnt[e]; s_cnt[e] = c; s_ps[e] = a; a += ((c + RT - 1) / RT) * RT; } s_ps[32] = a; }
}
struct ARowGather { const bf16* H2; const int* ltk; int pstart, cnt; __device__ __forceinline__ const bf16* operator()(int r) const { const int s = r - pstart; return s < cnt ? H2 + (size_t)(ltk[s] >> 2) * DM : nullptr; } };
struct EpiUp { bf16* ACT; const float* bu; __device__ __forceinline__ void operator()(int r, int c, const float (&a)[4], const float (&a2)[4]) const {
        const f32x4 bg = *(const f32x4*)(bu + c), bl = *(const f32x4*)(bu + DE + c); float o[4];
#pragma unroll
        for (int i = 0; i < 4; ++i) { const float gl = fminf(a[i] + bg[i], SW_LIMIT), li = fminf(fmaxf(a2[i] + bl[i], -SW_LIMIT), SW_LIMIT); o[i] = gl * (1.f / (1.f + expf(-SW_ALPHA * gl))) * (li + 1.f); }
        u32x2 ov; ov.x = pk2(o[0], o[1]); ov.y = pk2(o[2], o[3]); *(u32x2*)(ACT + (size_t)r * DE + c) = ov; } };
__global__ void __launch_bounds__(512) k_up_naive(Params p) {
    __shared__ __attribute__((aligned(16))) float lds[NAIVE_LDS_FLOATS]; __shared__ int s_cnt[32], s_ps[33];
    load_expert_map((const int*)(p.ws + WS_CTL) + CW_CNT, s_cnt, s_ps); __syncthreads();
    const int ntm = s_ps[32] / 64, nN = DE / 128;
    for (int u = blockIdx.x; u < ntm * nN; u += gridDim.x) { const int tm = u / nN, tn = u % nN; int e = 0; while (s_ps[e + 1] <= tm * 64) ++e;
        if (tm * 64 - s_ps[e] >= s_cnt[e]) continue;
        ARowGather ar{(const bf16*)(p.ws + WS_XN), (const int*)(p.ws + WS_LTK) + (size_t)e * T, s_ps[e], s_cnt[e]}; EpiUp ep{(bf16*)(p.ws + WS_ACT), p.b_up + (size_t)e * 2 * DE};
        naive_tile<ARowGather, EpiUp, true>(tm, tn, DM, ar, p.w_up + (size_t)e * DM * 2 * DE, p.w_up + (size_t)e * DM * 2 * DE + DE, 2 * DE, ep, lds); }
}
struct ARowAct { const bf16* ACT; int pstart, cnt; __device__ __forceinline__ const bf16* operator()(int r) const { return (r - pstart) < cnt ? ACT + (size_t)r * DE : nullptr; } };
struct EpiDown { bf16* Y; const float* bd; const float* lgt; int pstart, cnt; __device__ __forceinline__ void operator()(int r, int c, const float (&a)[4], const float (&)[4]) const {
        const int s = r - pstart; if (s >= cnt) return; const float gt = lgt[s]; const f32x4 b = *(const f32x4*)(bd + c);
        u32x2 ov; ov.x = pk2((a[0] + b.x) * gt, (a[1] + b.y) * gt); ov.y = pk2((a[2] + b.z) * gt, (a[3] + b.w) * gt); *(u32x2*)(Y + (size_t)r * DM + c) = ov; } };
__global__ void __launch_bounds__(512) k_down_naive(Params p) {
    __shared__ __attribute__((aligned(16))) float lds[NAIVE_LDS_FLOATS]; __shared__ int s_cnt[32], s_ps[33];
    load_expert_map((const int*)(p.ws + WS_CTL) + CW_CNT, s_cnt, s_ps); __syncthreads();
    const int ntm = s_ps[32] / 64, nN = DM / 128;
    for (int u = blockIdx.x; u < ntm * nN; u += gridDim.x) { const int tm = u / nN, tn = u % nN; int e = 0; while (s_ps[e + 1] <= tm * 64) ++e;
        if (tm * 64 - s_ps[e] >= s_cnt[e]) continue;
        ARowAct ar{(const bf16*)(p.ws + WS_ACT), s_ps[e], s_cnt[e]}; EpiDown ep{(bf16*)(p.ws + WS_Y), p.b_down + (size_t)e * DM, (const float*)(p.ws + WS_LGT) + (size_t)e * T, s_ps[e], s_cnt[e]};
        naive_tile<ARowAct, EpiDown, false>(tm, tn, DE, ar, p.w_down + (size_t)e * DE * DM, nullptr, DM, ep, lds); }
}

__global__ void __launch_bounds__(512) k_final(Params p) {
    __shared__ int s_cnt[32], s_ps[33];
    load_expert_map((const int*)(p.ws + WS_CTL) + CW_CNT, s_cnt, s_ps); __syncthreads();
    const int tid = threadIdx.x, lane = tid & 63, wave = tid >> 6;
    const int* SEL = (const int*)(p.ws + WS_SEL); const bf16* Y = (const bf16*)(p.ws + WS_Y);
    f32x4 g[4];
#pragma unroll
    for (int j = 0; j < 4; ++j) g[j] = *(const f32x4*)(p.g_final + 4 * lane + 256 * j);
    for (int m = blockIdx.x * 8 + wave; m < T; m += gridDim.x * 8) {
        float* xr = p.out + (size_t)m * DM; f32x4 v[4];
#pragma unroll
        for (int j = 0; j < 4; ++j) v[j] = *(const f32x4*)(xr + 4 * lane + 256 * j);
#pragma unroll
        for (int k = 0; k < 4; ++k) { const int sv = SEL[m * 4 + k]; const int e = sv & 31, slot = sv >> 5; const bf16* yr = Y + (size_t)(s_ps[e] + slot) * DM;
#pragma unroll
            for (int j = 0; j < 4; ++j) { const u32x2 y = *(const u32x2*)(yr + 4 * lane + 256 * j);
                v[j].x += __builtin_bit_cast(float, y.x << 16); v[j].y += __builtin_bit_cast(float, y.x & 0xffff0000u); v[j].z += __builtin_bit_cast(float, y.y << 16); v[j].w += __builtin_bit_cast(float, y.y & 0xffff0000u); } }
        float ss = 0.f;
#pragma unroll
        for (int j = 0; j < 4; ++j) ss += v[j].x * v[j].x + v[j].y * v[j].y + v[j].z * v[j].z + v[j].w * v[j].w;
        const float rstd = rsqrtf(wave_sum(ss) * (1.f / DM) + RMS_EPS);
#pragma unroll
        for (int j = 0; j < 4; ++j) *(f32x4*)(xr + 4 * lane + 256 * j) = v[j] * rstd * g[j];
    }
}

namespace pg8 {
#define PG8_LAS __attribute__((address_space(3)))
typedef unsigned short bf16_t;
typedef short bf16x8 __attribute__((ext_vector_type(8)));
typedef float f32x4 __attribute__((ext_vector_type(4)));
typedef unsigned u32x4 __attribute__((ext_vector_type(4)));
constexpr int BM = 256, BK = 64, HALF = 128, HTB = HALF * BK * 2  , STAGE_BYTES = 8 * HTB, NXCD = 8, WGM = 8;

__host__ __device__ __forceinline__ int lds_byte(int r, int c) { const int st = (r >> 4) * 2 + (c >> 5), rr = r & 15, cc = c & 31, ob = rr * 64 + cc * 2; return st * 1024 + (ob ^ (((ob >> 9) & 1) << 5)); }
__host__ __device__ __forceinline__ void stage_rc(int b, int& R, int& C) { const int st = b / 1024, sb = b % 1024, swz = sb ^ (((sb >> 9) & 1) << 5); R = (st >> 1) * 16 + swz / 64; C = (st & 1) * 32 + (swz % 64) / 2; }
__host__ __device__ __forceinline__ int perm32(int rho) { const int n = rho >> 4, i = rho & 15; return 8 * (i >> 2) + 4 * n + (i & 3); }

struct Unit { int pm, pn, e, lrow0; size_t boff; };
struct Gemm { const bf16_t* A; const bf16_t* Bt; int K; };

struct StaticOrder {
    int nM, nN, nwg, G, c;
    __host__ __device__ void init(int M, int N, int G_, int c_) { nM = M / BM; nN = N / BM; nwg = nM * nN; G = G_; c = c_; }
    __host__ __device__ bool next(int i, Unit& u) const {
        const long L = (long)i * G + c; if (L >= nwg) return false;
        int wgid = (int)L; { const int q = nwg / NXCD, r = nwg % NXCD, xcd = wgid % NXCD, off = wgid / NXCD; wgid = (xcd < r ? xcd * (q + 1) : r * (q + 1) + (xcd - r) * q) + off; }
        const int nig = WGM * nN, gid = wgid / nig, fm = gid * WGM, gsz = (nM - fm) < WGM ? (nM - fm) : WGM;
        u.pm = fm + ((wgid % nig) % gsz); u.pn = (wgid % nig) / gsz; u.e = 0; u.lrow0 = 0; u.boff = 0; return true;
    }
};
template <int NCOL> struct MoeOrder {
    const PG8_LAS int* pt; int G, c; size_t bstride;
    __device__ __forceinline__ bool next(int i, Unit& u) const {
        const int L = i * G + c; const int nrt = pt[32]; if (L >= nrt * NCOL) return false;
        const int rt = L / NCOL; int e = 0;
#pragma unroll 1
        for (int j = 1; j < 32; ++j) e += (pt[j] <= rt) ? 1 : 0;
        u.pm = rt; u.pn = L % NCOL; u.e = e; u.lrow0 = (rt - pt[e]) * BM; u.boff = (size_t)e * bstride; return true;
    }
};

__device__ __forceinline__ unsigned cvt_pk_bf16(float lo, float hi) { unsigned r; asm volatile("v_cvt_pk_bf16_f32 %0, %1, %2" : "=v"(r) : "v"(lo), "v"(hi)); return r; }

struct EpiInproj {
    static constexpr bool PERM = true;
    bf16_t* O; size_t split_stride; float qscale;
    __device__ __forceinline__ void operator()(const f32x4 (&acc)[2][2][4][2], const Unit& u, int wr, int wc, int fr, int fq) const {
        const int row0 = u.pm * BM + wr * 64 + fr; int colt = u.pn * BM; const int t = colt >> 9; bf16_t* base = O + (size_t)t * split_stride; colt -= t * 512;
        const float sc = (t == 1) ? qscale : 1.f; const int col0 = colt + wc * 32 + 8 * fq;
#pragma unroll
        for (int ai = 0; ai < 2; ++ai)
#pragma unroll
            for (int m = 0; m < 4; ++m) { bf16_t* rowp = base + (size_t)(row0 + ai * HALF + m * 16) * 512 + col0;
#pragma unroll
                for (int bj = 0; bj < 2; ++bj) { const f32x4 v0 = acc[ai][bj][m][0] * sc, v1 = acc[ai][bj][m][1] * sc;
                    u32x4 w; w.x = cvt_pk_bf16(v0[0], v0[1]); w.y = cvt_pk_bf16(v0[2], v0[3]); w.z = cvt_pk_bf16(v1[0], v1[1]); w.w = cvt_pk_bf16(v1[2], v1[3]);
                    *(u32x4*)(rowp + bj * HALF) = w; } }
    }
};
struct EpiResF32 {
    static constexpr bool PERM = false;
    const float* x; float* out;
    __device__ __forceinline__ void operator()(const f32x4 (&acc)[2][2][4][2], const Unit& u, int wr, int wc, int fr, int fq) const {
        const int row0 = u.pm * BM + wr * 64 + fr, col0 = u.pn * BM + wc * 32 + 4 * fq;
#pragma unroll
        for (int ai = 0; ai < 2; ++ai)
#pragma unroll
            for (int m = 0; m < 4; ++m) { const size_t off = (size_t)(row0 + ai * HALF + m * 16) * 1024 + col0;
#pragma unroll
                for (int bj = 0; bj < 2; ++bj)
#pragma unroll
                    for (int n = 0; n < 2; ++n) { const f32x4 xv = *(const f32x4*)(x + off + bj * HALF + n * 16); *(f32x4*)(out + off + bj * HALF + n * 16) = xv + acc[ai][bj][m][n]; }
                if (m & 1) asm volatile("" ::: "memory"); }
    }
};
__device__ __forceinline__ float swiglu1(float g, float l) {
    const float gl = fminf(g, 7.0f), li = fminf(fmaxf(l, -7.0f), 7.0f);
    const float sg = __builtin_amdgcn_rcpf(1.0f + __builtin_amdgcn_exp2f(gl * (-1.702f * 1.4426950408889634f)));
    return gl * sg * (li + 1.0f);
}
struct EpiSwiglu {
    static constexpr bool PERM = true;
    bf16_t* ACT; const float* bup;
    __device__ __forceinline__ void operator()(const f32x4 (&acc)[2][2][4][2], const Unit& u, int wr, int wc, int fr, int fq) const {
        const int row0 = u.pm * BM + wr * 64 + fr, col0 = u.pn * HALF + wc * 32 + 8 * fq;
        const float* bb = bup + (size_t)u.e * 2048 + col0;
        f32x4 bg[2], bl[2];
#pragma unroll
        for (int n = 0; n < 2; ++n) { bg[n] = *(const f32x4*)(bb + 4 * n); bl[n] = *(const f32x4*)(bb + 1024 + 4 * n); }
#pragma unroll
        for (int ai = 0; ai < 2; ++ai)
#pragma unroll
            for (int m = 0; m < 4; ++m) { bf16_t* rowp = ACT + (size_t)(row0 + ai * HALF + m * 16) * 1024 + col0;
                const f32x4 g0 = acc[ai][0][m][0] + bg[0], g1 = acc[ai][0][m][1] + bg[1], l0 = acc[ai][1][m][0] + bl[0], l1 = acc[ai][1][m][1] + bl[1];
                u32x4 w; w.x = cvt_pk_bf16(swiglu1(g0[0], l0[0]), swiglu1(g0[1], l0[1])); w.y = cvt_pk_bf16(swiglu1(g0[2], l0[2]), swiglu1(g0[3], l0[3]));
                w.z = cvt_pk_bf16(swiglu1(g1[0], l1[0]), swiglu1(g1[1], l1[1])); w.w = cvt_pk_bf16(swiglu1(g1[2], l1[2]), swiglu1(g1[3], l1[3]));
                *(u32x4*)rowp = w; }
    }
};
struct EpiDown {
    static constexpr bool PERM = true;
    bf16_t* Y; const float* bdn; const float* lgt; const PG8_LAS int* cnt; int Ttok;
    __device__ __forceinline__ void operator()(const f32x4 (&acc)[2][2][4][2], const Unit& u, int wr, int wc, int fr, int fq) const {
        const int rl = wr * 64 + fr, col0 = u.pn * BM + wc * 32 + 8 * fq; const int ce = cnt[u.e];
        const float* bb = bdn + (size_t)u.e * 1024 + col0; const float* gp = lgt + (size_t)u.e * Ttok + u.lrow0;
        f32x4 bv[2][2];
#pragma unroll
        for (int bj = 0; bj < 2; ++bj)
#pragma unroll
            for (int n = 0; n < 2; ++n) bv[bj][n] = *(const f32x4*)(bb + bj * HALF + 4 * n);
#pragma unroll
        for (int ai = 0; ai < 2; ++ai)
#pragma unroll
            for (int m = 0; m < 4; ++m) { const int r = rl + ai * HALF + m * 16; const float gt = (u.lrow0 + r < ce) ? gp[r] : 0.f;
                bf16_t* rowp = Y + (size_t)(u.pm * BM + r) * 1024 + col0;
#pragma unroll
                for (int bj = 0; bj < 2; ++bj) { const f32x4 v0 = (acc[ai][bj][m][0] + bv[bj][0]) * gt, v1 = (acc[ai][bj][m][1] + bv[bj][1]) * gt;
                    u32x4 w; w.x = cvt_pk_bf16(v0[0], v0[1]); w.y = cvt_pk_bf16(v0[2], v0[3]); w.z = cvt_pk_bf16(v1[0], v1[1]); w.w = cvt_pk_bf16(v1[2], v1[3]);
                    *(u32x4*)(rowp + bj * HALF) = w; } }
    }
};

template <class Epi, class Sched, bool ALIGN_EPI, bool GATHER>
__device__ __forceinline__ void gemm_phase(PG8_LAS unsigned char* lds, const Gemm g, const Sched& S, const Epi& E, const PG8_LAS unsigned* tab) {
    const int tid = threadIdx.x, wid = __builtin_amdgcn_readfirstlane(tid >> 6), lane = tid & 63, wr = wid >> 2, wc = wid & 3, fr = lane & 15, fq = lane >> 4;
    const int K = g.K, nt = K / BK;
    unsigned voffA[2], voffB[2], cby[2]; int rsl[2];
#pragma unroll
    for (int i = 0; i < 2; ++i) { int R, C; stage_rc(tid * 16 + i * 8192, R, C); const int Rb = Epi::PERM ? ((R & ~31) + perm32(R & 31)) : R;
        voffA[i] = (unsigned)(R * K + C) * 2u; voffB[i] = (unsigned)(Rb * K + C) * 2u; rsl[i] = R; cby[i] = (unsigned)C * 2u; }
    const size_t kstep = (size_t)(BK * 2);
    const size_t hstep = (size_t)HALF * K * 2;
    const size_t tstep = 2 * hstep;
    const size_t ahstep = GATHER ? 0 : hstep;
    const unsigned ldsw = (unsigned)wid * 1024u;
    const int aoff = lds_byte(wr * 64 + fr, fq * 8), boff = lds_byte(wc * 32 + fr, fq * 8);
#define PG8_SA(b, h) (((b) * 2 + (h)) * HTB)
#define PG8_SB(b, h) ((4 + (b) * 2 + (h)) * HTB)
#define PG8_STAGE(bufoff, gbase, voff) do { _Pragma("unroll") for (int _i = 0; _i < 2; ++_i) \
        __builtin_amdgcn_global_load_lds((const unsigned*)((const char*)(gbase) + (voff)[_i]), (PG8_LAS unsigned*)(lds + (bufoff) + ldsw + _i * 8192), 16, 0, 0); } while (0)
#define PG8_LDA(dst, b, h) do { _Pragma("unroll") for (int m = 0; m < 4; ++m) _Pragma("unroll") for (int k = 0; k < 2; ++k) dst[m][k] = *(const PG8_LAS bf16x8*)(lds + PG8_SA(b, h) + aoff + m * 2048 + k * 1024); } while (0)
#define PG8_LDB(dst, b, h) do { _Pragma("unroll") for (int n = 0; n < 2; ++n) _Pragma("unroll") for (int k = 0; k < 2; ++k) dst[n][k] = *(const PG8_LAS bf16x8*)(lds + PG8_SB(b, h) + boff + n * 2048 + k * 1024); } while (0)
#define PG8_MMA(ai, bj, At, Bt) do { __builtin_amdgcn_s_setprio(1); _Pragma("unroll") for (int m = 0; m < 4; ++m) _Pragma("unroll") for (int n = 0; n < 2; ++n) _Pragma("unroll") for (int k = 0; k < 2; ++k) \
        acc[ai][bj][m][n] = __builtin_amdgcn_mfma_f32_16x16x32_bf16(Bt[n][k], At[m][k], acc[ai][bj][m][n], 0, 0, 0); __builtin_amdgcn_s_setprio(0); } while (0)
#define PG8_WAIT_V(n) asm volatile("s_waitcnt vmcnt(" #n ")" ::: "memory")
#define PG8_WAIT_L(n) asm volatile("s_waitcnt lgkmcnt(" #n ")" ::: "memory")
#define PG8_BAR __builtin_amdgcn_s_barrier()
#define PG8_SCHED __builtin_amdgcn_sched_barrier(0)
    Unit cur, nxt; int ui = 0;
    if (!S.next(0, cur)) return;
    f32x4 acc[2][2][4][2];
#pragma unroll
    for (int a = 0; a < 2; ++a)
#pragma unroll
        for (int b = 0; b < 2; ++b)
#pragma unroll
            for (int m = 0; m < 4; ++m)
#pragma unroll
                for (int n = 0; n < 2; ++n) acc[a][b][m][n] = (f32x4){0.f, 0.f, 0.f, 0.f};
    bf16x8 At[4][2], B0[2][2], B1[2][2];
    const char* cA = GATHER ? (const char*)g.A : (const char*)g.A + (size_t)cur.pm * tstep; const char* cB = (const char*)g.Bt + cur.boff + (size_t)cur.pn * tstep;
    unsigned cv0[2], cv1[2], nv0[2], nv1[2];
#pragma unroll
    for (int i = 0; i < 2; ++i) { if constexpr (GATHER) { cv0[i] = tab[rsl[i]] + cby[i]; cv1[i] = tab[HALF + rsl[i]] + cby[i]; } else { cv0[i] = voffA[i]; cv1[i] = voffA[i]; } nv0[i] = cv0[i]; nv1[i] = cv1[i]; }
    PG8_STAGE(PG8_SB(0, 0), cB, voffB); PG8_STAGE(PG8_SB(0, 1), cB + hstep, voffB); PG8_STAGE(PG8_SA(0, 0), cA, cv0); PG8_STAGE(PG8_SA(0, 1), cA + ahstep, cv1);
    if (wr == 1) PG8_BAR;
    PG8_WAIT_V(2); PG8_BAR;
    PG8_STAGE(PG8_SB(1, 0), cB + kstep, voffB); PG8_STAGE(PG8_SA(1, 0), cA + kstep, cv0); PG8_STAGE(PG8_SB(1, 1), cB + hstep + kstep, voffB);
    PG8_WAIT_V(6); PG8_BAR;
    for (;;) {
        const bool has_next = S.next(ui + 1, nxt);
        const char* nA = has_next ? (GATHER ? (const char*)g.A : (const char*)g.A + (size_t)nxt.pm * tstep) : cA; const char* nB = has_next ? (const char*)g.Bt + nxt.boff + (size_t)nxt.pn * tstep : cB;
        if constexpr (GATHER) {
#pragma unroll
            for (int i = 0; i < 2; ++i) { if (has_next) { nv0[i] = tab[(ui + 1) * BM + rsl[i]] + cby[i]; nv1[i] = tab[(ui + 1) * BM + HALF + rsl[i]] + cby[i]; } else { nv0[i] = cv0[i]; nv1[i] = cv1[i]; } }
        }
        for (int t = 0; t < nt; t += 2) {
            const bool last = (t == nt - 2);
            const char* a1 = cA + (size_t)(t + 1) * kstep;
            const char* a2 = last ? nA : cA + (size_t)(t + 2) * kstep; const char* b2 = last ? nB : cB + (size_t)(t + 2) * kstep;
            const char* a3 = a2 + kstep; const char* b3 = b2 + kstep;
            unsigned s0[2], s1[2];
#pragma unroll
            for (int i = 0; i < 2; ++i) { s0[i] = last ? nv0[i] : cv0[i]; s1[i] = last ? nv1[i] : cv1[i]; }
            PG8_LDB(B0, 0, 0); PG8_LDB(B1, 0, 1); PG8_SCHED; PG8_LDA(At, 0, 0); PG8_STAGE(PG8_SA(1, 1), a1 + ahstep, cv1);
            PG8_WAIT_V(8); PG8_WAIT_L(0); PG8_BAR; PG8_MMA(0, 0, At, B0); PG8_MMA(0, 1, At, B1); PG8_BAR; PG8_SCHED;
            PG8_LDA(At, 0, 1); PG8_STAGE(PG8_SB(0, 0), b2, voffB); PG8_STAGE(PG8_SB(0, 1), b2 + hstep, voffB); PG8_STAGE(PG8_SA(0, 0), a2, s0);
            PG8_WAIT_V(8); PG8_WAIT_L(0); PG8_BAR; PG8_MMA(1, 0, At, B0); PG8_MMA(1, 1, At, B1); PG8_BAR; PG8_SCHED;
            PG8_LDB(B0, 1, 0); PG8_LDB(B1, 1, 1); PG8_SCHED; PG8_LDA(At, 1, 0); PG8_STAGE(PG8_SA(0, 1), a2 + ahstep, s1);
            PG8_WAIT_V(8); PG8_WAIT_L(0); PG8_BAR; PG8_MMA(0, 0, At, B0); PG8_MMA(0, 1, At, B1); PG8_BAR; PG8_SCHED;
            PG8_LDA(At, 1, 1); PG8_STAGE(PG8_SB(1, 0), b3, voffB); PG8_STAGE(PG8_SB(1, 1), b3 + hstep, voffB); PG8_STAGE(PG8_SA(1, 0), a3, s0);
            PG8_WAIT_V(8); PG8_WAIT_L(0); PG8_BAR; PG8_MMA(1, 0, At, B0); PG8_MMA(1, 1, At, B1); PG8_BAR; PG8_SCHED;
        }
        if constexpr (ALIGN_EPI) { if (wr == 0) PG8_BAR; }
        E(acc, cur, wr, wc, fr, fq);
        if (!has_next) break;
#pragma unroll
        for (int a = 0; a < 2; ++a)
#pragma unroll
            for (int b = 0; b < 2; ++b)
#pragma unroll
                for (int m = 0; m < 4; ++m)
#pragma unroll
                    for (int n = 0; n < 2; ++n) acc[a][b][m][n] = (f32x4){0.f, 0.f, 0.f, 0.f};
        cur = nxt; cA = nA; cB = nB; ++ui;
#pragma unroll
        for (int i = 0; i < 2; ++i) { cv0[i] = nv0[i]; cv1[i] = nv1[i]; }
        if constexpr (ALIGN_EPI) { if (wr == 1) PG8_BAR; }
    }
    PG8_WAIT_V(0);
    if constexpr (!ALIGN_EPI) { if (wr == 0) PG8_BAR; }
    PG8_BAR;
#undef PG8_SA
#undef PG8_SB
#undef PG8_STAGE
#undef PG8_LDA
#undef PG8_LDB
#undef PG8_MMA
#undef PG8_WAIT_V
#undef PG8_WAIT_L
#undef PG8_BAR
#undef PG8_SCHED
}
}
#include <hip/hip_bf16.h>
#include <cmath>
namespace attn_body {
using bf16=__hip_bfloat16;
using bf16x8=__attribute__((ext_vector_type(8)))short;
using s16x4=__attribute__((ext_vector_type(4)))short;
using f32x16=__attribute__((ext_vector_type(16)))float;
using u32x4=__attribute__((ext_vector_type(4)))unsigned;
constexpr int BATCH=4,NHEAD=8,SEQ=8192,D=64,DM=NHEAD*D,ODM=1024;
constexpr int NW=8,QBLK=32,QB=QBLK*NW,KVBLK=64,NQB=SEQ/QB;
constexpr int ATTN_PITCH=DM, ATTN_UNIT_ROWS=QB;
__device__ __forceinline__ int crow(int r,int hi){return (r&3)+8*(r>>2)+4*hi;}
#define SBAR() __builtin_amdgcn_sched_barrier(0)
__device__ __forceinline__ void cmask(f32x16&p0,f32x16&p1,int jb,int qrel,int hi){
  const float NEG=-INFINITY; int kb=64*jb+4*hi;
  #pragma unroll
  for(int r=0;r<16;++r){int kv=kb+(r&3)+8*(r>>2); if(kv>qrel)p0[r]=NEG; if(kv+32>qrel)p1[r]=NEG;}
}

constexpr int NSLOT=3, SLOTB=8192;
constexpr int LDS_K=0, LDS_V=NSLOT*SLOTB, LDS_WS=2*NSLOT*SLOTB, LDS_OST=LDS_WS+NW*64*4, LDS_C2=LDS_OST+NW*4096, LDS_BYTES=LDS_C2+SEQ*4;
constexpr float C2=0.125f*1.4426950408889634f;
__device__ __forceinline__ void glds16(const void*gsrc,unsigned lds_dst){unsigned keep;
  asm volatile("s_mov_b32 %0, m0\n\ts_mov_b32 m0, %2\n\ts_nop 0\n\tglobal_load_lds_dwordx4 %1, off\n\ts_mov_b32 m0, %0":"=&s"(keep):"v"(gsrc),"s"(lds_dst):"memory");}
__device__ __forceinline__ float max3f(float a,float b,float c){float r;asm("v_max3_f32 %0, %1, %2, %3":"=v"(r):"v"(a),"v"(b),"v"(c));return r;}
__device__ __forceinline__ float max2f(float a,float b){float r;asm("v_max_f32_e32 %0, %1, %2":"=v"(r):"v"(a),"v"(b));return r;}
__device__ __forceinline__ float fadd_s(float a,float b){float r;asm("v_add_f32_e32 %0, %1, %2":"=v"(r):"v"(a),"v"(b));return r;}
__device__ __forceinline__ float fsub_s(float a,float b){float r;asm("v_sub_f32_e32 %0, %1, %2":"=v"(r):"v"(a),"v"(b));return r;}
typedef float f32x2_t __attribute__((ext_vector_type(2))); typedef float f32x4_t __attribute__((ext_vector_type(4))); typedef __bf16 bf16x2_t __attribute__((ext_vector_type(2)));
__device__ __forceinline__ unsigned cvtpk_s(float lo,float hi){f32x2_t v={lo,hi};bf16x2_t b=__builtin_convertvector(v,bf16x2_t);return __builtin_bit_cast(unsigned,b);}
#define WAIT_BAR(N) asm volatile("s_waitcnt vmcnt(" #N ") lgkmcnt(0)\n\ts_barrier":::"memory")

__device__ __forceinline__ void qkt(f32x16&p0,f32x16&p1,const char*Kslot,const bf16x8*qr,const f32x16&cin0,const f32x16&cin1,int r32,int hi){
  const char*kb=Kslot+hi*1024+r32*16;
  #pragma unroll
  for(int d0=0;d0<4;++d0){
    const bf16x8 b0=*reinterpret_cast<const bf16x8*>(kb+d0*2048);
    const bf16x8 b1=*reinterpret_cast<const bf16x8*>(kb+d0*2048+512);
    if(d0==0){p0=__builtin_amdgcn_mfma_f32_32x32x16_bf16(b0,qr[0],cin0,0,0,0);p1=__builtin_amdgcn_mfma_f32_32x32x16_bf16(b1,qr[0],cin1,0,0,0);}
    else{p0=__builtin_amdgcn_mfma_f32_32x32x16_bf16(b0,qr[d0],p0,0,0,0);p1=__builtin_amdgcn_mfma_f32_32x32x16_bf16(b1,qr[d0],p1,0,0,0);}}
}
typedef __attribute__((address_space(3))) const char* lds_cptr;
typedef short v4i16_t __attribute__((ext_vector_type(4)));
__device__ __forceinline__ void kload8(bf16x8*kf,lds_cptr kp){
  kf[0]=*(const __attribute__((address_space(3))) bf16x8*)(kp);      kf[1]=*(const __attribute__((address_space(3))) bf16x8*)(kp+512);
  kf[2]=*(const __attribute__((address_space(3))) bf16x8*)(kp+2048); kf[3]=*(const __attribute__((address_space(3))) bf16x8*)(kp+2560);
  kf[4]=*(const __attribute__((address_space(3))) bf16x8*)(kp+4096); kf[5]=*(const __attribute__((address_space(3))) bf16x8*)(kp+4608);
  kf[6]=*(const __attribute__((address_space(3))) bf16x8*)(kp+6144); kf[7]=*(const __attribute__((address_space(3))) bf16x8*)(kp+6656);
}
__device__ __forceinline__ void kload2(bf16x8*kf,lds_cptr kp,int j){ kf[2*j]=*(const __attribute__((address_space(3))) bf16x8*)(kp+j*2048); kf[2*j+1]=*(const __attribute__((address_space(3))) bf16x8*)(kp+j*2048+512); }
__device__ __forceinline__ s16x4 vtr(lds_cptr p){ return __builtin_bit_cast(s16x4,__builtin_amdgcn_ds_read_tr16_b64_v4i16((__attribute__((address_space(3))) v4i16_t*)p)); }
__device__ __forceinline__ float rowmax(const f32x16&p0,const f32x16&p1){
  float a=max3f(p0[0],p0[1],p1[0]),b=max3f(p0[2],p0[3],p1[1]);a=max3f(a,p1[2],p1[3]);
  #pragma unroll
  for(int r=4;r<16;r+=4){a=max3f(a,p0[r],p0[r+1]);b=max3f(b,p0[r+2],p0[r+3]);a=max3f(a,p1[r],p1[r+1]);b=max3f(b,p1[r+2],p1[r+3]);}
  const float m=max2f(a,b);
  auto rr=__builtin_amdgcn_permlane32_swap(__float_as_uint(m),__float_as_uint(m),false,false);
  return max2f(__uint_as_float(rr[0]),__uint_as_float(rr[1]));
}
__device__ __forceinline__ void pv(f32x16*o,int vb,bf16x8 pa0,bf16x8 pa1,bf16x8 pa2,bf16x8 pa3){
  #pragma unroll
  for(int d0=0;d0<2;++d0){s16x4 lo[4],hi[4];
    #pragma unroll
    for(int ks=0;ks<4;++ks){
      asm volatile("ds_read_b64_tr_b16 %0,%1 offset:%c2":"=&v"(lo[ks]):"v"(vb),"i"(d0*4096+ks*1024):"memory");
      asm volatile("ds_read_b64_tr_b16 %0,%1 offset:%c2":"=&v"(hi[ks]):"v"(vb),"i"(d0*4096+ks*1024+512):"memory");}
    asm volatile("s_waitcnt lgkmcnt(0)":::"memory");SBAR();
    #define PK(k) (bf16x8){lo[k][0],lo[k][1],lo[k][2],lo[k][3],hi[k][0],hi[k][1],hi[k][2],hi[k][3]}
    o[d0]=__builtin_amdgcn_mfma_f32_32x32x16_bf16(pa0,PK(0),o[d0],0,0,0);
    o[d0]=__builtin_amdgcn_mfma_f32_32x32x16_bf16(pa1,PK(1),o[d0],0,0,0);
    o[d0]=__builtin_amdgcn_mfma_f32_32x32x16_bf16(pa2,PK(2),o[d0],0,0,0);
    o[d0]=__builtin_amdgcn_mfma_f32_32x32x16_bf16(pa3,PK(3),o[d0],0,0,0);
    #undef PK
  }
}

#ifndef ATTN_STORE16
#define ATTN_STORE16(p,v) (*(u32x4*)(p)=(v))
#endif
template<int THRL> __device__ __forceinline__ void attn_unit(int b,int h,int qb,const bf16*Q,const bf16*__restrict__ K,const bf16*__restrict__ V,bf16*O,char*shm,float qkb2){
  const int tid=threadIdx.x,lane=tid&63,r32=lane&31,hi=lane>>5; const int wid=__builtin_amdgcn_readfirstlane(tid>>6);
  const long rowbase=(long)b*SEQ; const int q0=qb*QB;
  const bf16*Qw=Q+(rowbase+q0+wid*QBLK)*DM+h*D;
  const bf16*Kh=K+rowbase*DM+h*D,*Vh=V+rowbase*DM+h*D;
  const unsigned lds0=(unsigned)(uintptr_t)shm; const lds_cptr shm3=(lds_cptr)shm;
  float*wsf=(float*)(shm+LDS_WS)+wid*64;
  const bf16*ksrc=Kh+(long)lane*DM+wid*8;
  const bf16*vsrc=Vh+(long)(16*(wid&3)+(lane>>2))*DM+(wid>>2)*32+(lane&3)*8;
  const unsigned kdst=lds0+LDS_K+wid*1024, vdst=lds0+LDS_V+wid*1024;
  #define DMA_K(t,slot) glds16(ksrc+(long)(t)*KVBLK*DM,(unsigned)__builtin_amdgcn_readfirstlane(kdst+(slot)))
  #define DMA_V(t,slot) glds16(vsrc+(long)(t)*KVBLK*DM,(unsigned)__builtin_amdgcn_readfirstlane(vdst+(slot)))
  const int vb0=(int)(lds0+LDS_V)+((lane>>4)&1)*32+(lane&3)*8+(4*hi+((lane&15)>>2))*64;
  const char*Kbase=shm+LDS_K; bf16x8 kf[8];
  const lds_cptr kp0=shm3+LDS_K+hi*1024+r32*16; const lds_cptr vp0=shm3+LDS_V+((lane>>4)&1)*32+(lane&3)*8+(4*hi+((lane&15)>>2))*64;
  const int NT=(q0+QB)/KVBLK;
  int j0=0;
  { const __attribute__((address_space(3))) float* c2f=(const __attribute__((address_space(3))) float*)((lds_cptr)shm+LDS_C2); const float cq=c2f[q0]+qkb2+64.0f;
    int lo_=0,hi_=(NT-4)>>1;
    while(lo_<hi_){ const int mid=(lo_+hi_+1)>>1; if(cq-c2f[128*mid-1]<0.f)lo_=mid; else hi_=mid-1; }
    j0=__builtin_amdgcn_readfirstlane(2*lo_); }
  DMA_K(j0,0);DMA_V(j0,0);DMA_K(j0+1,SLOTB);
  bf16x8 qr[4];
  #pragma unroll
  for(int d0=0;d0<4;++d0)qr[d0]=*reinterpret_cast<const bf16x8*>(&Qw[(long)r32*DM+d0*16+hi*8]);
  float l_reg=0.f;f32x16 o[2];o[0]=f32x16{};o[1]=f32x16{};
  typedef __attribute__((address_space(3))) const f32x4_t* lds_f4ptr; const lds_f4ptr c2p=(lds_f4ptr)(shm3+LDS_C2)+hi;
  float ctm=((const __attribute__((address_space(3))) float*)(shm3+LDS_C2))[q0+wid*QBLK+r32];
  f32x16 cin0,cin1;
  #define CIN(t) do{ const lds_f4ptr cq_=c2p+16*(t); const f32x4_t a0_=cq_[0],a1_=cq_[2],a2_=cq_[4],a3_=cq_[6],b0_=cq_[8],b1_=cq_[10],b2_=cq_[12],b3_=cq_[14]; \
    _Pragma("unroll") for(int j_=0;j_<4;++j_){ cin0[j_]=ctm-a0_[j_];cin0[4+j_]=ctm-a1_[j_];cin0[8+j_]=ctm-a2_[j_];cin0[12+j_]=ctm-a3_[j_]; cin1[j_]=ctm-b0_[j_];cin1[4+j_]=ctm-b1_[j_];cin1[8+j_]=ctm-b2_[j_];cin1[12+j_]=ctm-b3_[j_]; } }while(0)
  const int qrel=wid*QBLK+r32;
  #define CMASK(P0,P1,t) do{int jb_=(t)-(NT-4); if(jb_>=0)cmask(P0,P1,jb_,qrel,hi);}while(0)
  bool resc=false;
  #define START(P0,P1) do{ const float rm=rowmax(P0,P1); resc=false; \
    if(__any(rm>(float)THRL)){ const float dl=__builtin_fmaxf(rm,0.f); ctm-=dl; \
      _Pragma("unroll") for(int r=0;r<16;++r){P0[r]-=dl;P1[r]-=dl;} } \
    _Pragma("unroll") for(int r=0;r<16;++r)P0[r]=__builtin_amdgcn_exp2f(P0[r]); }while(0)
  #define RESC() do{ if(resc){ asm volatile("s_waitcnt lgkmcnt(0)":::"memory"); \
      _Pragma("unroll") for(int d_=0;d_<2;++d_) _Pragma("unroll") for(int r=0;r<16;++r)o[d_][r]*=wsf[crow(r,hi)]; } }while(0)
  f32x16 pA0,pA1,pB0,pB1;
  int sl_prev=0,sl_cur=0,sl_next=SLOTB;
  #define ROT() do{sl_prev=sl_cur;sl_cur=sl_next;sl_next=(sl_next==(NSLOT-1)*SLOTB)?0:sl_next+SLOTB;}while(0)
  DMA_K(j0+2,2*SLOTB);
  WAIT_BAR(3);
  CIN(j0); qkt(pA0,pA1,Kbase,qr,cin0,cin1,r32,hi);asm volatile("s_nop 15\n\ts_nop 7":"+v"(pA0),"+v"(pA1));CMASK(pA0,pA1,j0);
  START(pA0,pA1);
  _Pragma("unroll") for(int r=0;r<16;++r)pA1[r]=__builtin_amdgcn_exp2f(pA1[r]);
  WAIT_BAR(0);
  DMA_K(j0+3,0);DMA_V(j0+1,SLOTB);
  ROT();
  kload8(kf,kp0+sl_cur);
  WAIT_BAR(2);
  s16x4 vlo[8],vhi[8]; u32x4 pw0,pw1,pw2,pw3;
  #define PKW(P,B) cvtpk_s(P[B],P[B+1])
  #define PAF(k) __builtin_bit_cast(bf16x8,pw##k)
  #define VFR(i) (bf16x8){vlo[i][0],vlo[i][1],vlo[i][2],vlo[i][3],vhi[i][0],vhi[i][1],vhi[i][2],vhi[i][3]}
  #define PIN(x) asm volatile("":"+v"(x))
  #define MX3(a,b,c) __builtin_fmaxf(__builtin_fmaxf((a),(b)),(c))
  #define GAPA(MF,A0,A1,A2,A3,W0,W1,PW) do{ MF; sacc+=A0; sacc+=A1; sacc+=A2; sacc+=A3; PIN(sacc); W0; W1; PIN(PW); SBAR(); }while(0)
  #define EX(v) __builtin_amdgcn_exp2f(v)
  #define GAPB(MF,X,B) do{ MF; X[B]=EX(X[B]); X[B+1]=EX(X[B+1]); X[B+2]=EX(X[B+2]); X[B+3]=EX(X[B+3]); PIN(X); SBAR(); }while(0)
  #define VRD(i) do{ vlo[i]=vtr(vp_+(((i)>>2)*4096+((i)&3)*1024)); vhi[i]=vtr(vp_+(((i)>>2)*4096+((i)&3)*1024+512)); }while(0)
  #define KRD(G,j) do{ if(G){ kload2(kf,kp0+sl_next,j); SBAR(); } }while(0)
  #define STEP(C0,C1,P0,P1,t,GK,GV,GL) do{ SBAR(); CIN(t); SBAR(); \
    const lds_cptr vp_=vp0+sl_prev; \
    VRD(0); SBAR(); float sacc=(P0[0]+P0[1]); \
    GAPA(C0=__builtin_amdgcn_mfma_f32_32x32x16_bf16(kf[0],qr[0],cin0,0,0,0), P0[2],P0[3],P0[4],P0[5],     pw0[0]=PKW(P0,0), pw0[1]=PKW(P0,2), pw0); \
    VRD(4); SBAR(); GAPA(C1=__builtin_amdgcn_mfma_f32_32x32x16_bf16(kf[1],qr[0],cin1,0,0,0), P0[6],P0[7],P0[8],P0[9],     pw0[2]=PKW(P0,4), pw0[3]=PKW(P0,6), pw0); \
    VRD(1); SBAR(); GAPA(C0=__builtin_amdgcn_mfma_f32_32x32x16_bf16(kf[2],qr[1],C0,0,0,0),   P0[10],P0[11],P0[12],P0[13], pw1[0]=PKW(P0,8), pw1[1]=PKW(P0,10), pw1); \
    VRD(5); SBAR(); GAPA(C1=__builtin_amdgcn_mfma_f32_32x32x16_bf16(kf[3],qr[1],C1,0,0,0),   P0[14],P0[15],P1[0],P1[1],   pw1[2]=PKW(P0,12),pw1[3]=PKW(P0,14), pw1); \
    VRD(2); SBAR(); GAPA(C0=__builtin_amdgcn_mfma_f32_32x32x16_bf16(kf[4],qr[2],C0,0,0,0),   P1[2],P1[3],P1[4],P1[5],     pw2[0]=PKW(P1,0), pw2[1]=PKW(P1,2), pw2); \
    VRD(6); SBAR(); GAPA(C1=__builtin_amdgcn_mfma_f32_32x32x16_bf16(kf[5],qr[2],C1,0,0,0),   P1[6],P1[7],P1[8],P1[9],     pw2[2]=PKW(P1,4), pw2[3]=PKW(P1,6), pw2); \
    VRD(3); SBAR(); GAPA(C0=__builtin_amdgcn_mfma_f32_32x32x16_bf16(kf[6],qr[3],C0,0,0,0),   P1[10],P1[11],P1[12],P1[13], pw3[0]=PKW(P1,8), pw3[1]=PKW(P1,10), pw3); \
    VRD(7); SBAR(); GAPA(C1=__builtin_amdgcn_mfma_f32_32x32x16_bf16(kf[7],qr[3],C1,0,0,0),   P1[14],P1[15],0.f,0.f,       pw3[2]=PKW(P1,12),pw3[3]=PKW(P1,14), pw3); \
    l_reg+=sacc; \
    if(GK){DMA_K((t)+3,sl_cur);} if(GV){DMA_V((t)+1,sl_next);} \
    CMASK(C0,C1,t); \
    { float a=MX3(C0[0],C0[1],C1[0]),b=MX3(C0[2],C0[3],C1[1]); a=MX3(a,C1[2],C1[3]); \
      _Pragma("unroll") for(int r=4;r<16;r+=4){a=MX3(a,C0[r],C0[r+1]);b=MX3(b,C0[r+2],C0[r+3]);a=MX3(a,C1[r],C1[r+1]);b=MX3(b,C1[r+2],C1[r+3]);} \
      float rm=__builtin_fmaxf(a,b); { auto rr=__builtin_amdgcn_permlane32_swap(__float_as_uint(rm),__float_as_uint(rm),false,false); rm=__builtin_fmaxf(__uint_as_float(rr[0]),__uint_as_float(rr[1])); } \
      resc=false; \
      if(__builtin_expect(__any(rm>(float)THRL),0)){ const float dl=__builtin_fmaxf(rm,0.f); ctm-=dl; \
        _Pragma("unroll") for(int r=0;r<16;++r){C0[r]-=dl;C1[r]-=dl;} \
        const float f=__builtin_amdgcn_exp2f(-dl); l_reg*=f; if(hi==0)wsf[r32]=f; resc=true; } } \
    SBAR(); \
    GAPB(o[0]=__builtin_amdgcn_mfma_f32_32x32x16_bf16(PAF(0),VFR(0),o[0],0,0,0), C0,0); \
    GAPB(o[1]=__builtin_amdgcn_mfma_f32_32x32x16_bf16(PAF(0),VFR(4),o[1],0,0,0), C0,4); \
    KRD(GL,0); GAPB(o[0]=__builtin_amdgcn_mfma_f32_32x32x16_bf16(PAF(1),VFR(1),o[0],0,0,0), C0,8); \
    KRD(GL,1); GAPB(o[1]=__builtin_amdgcn_mfma_f32_32x32x16_bf16(PAF(1),VFR(5),o[1],0,0,0), C0,12); \
    KRD(GL,2); GAPB(o[0]=__builtin_amdgcn_mfma_f32_32x32x16_bf16(PAF(2),VFR(2),o[0],0,0,0), C1,0); \
    KRD(GL,3); GAPB(o[1]=__builtin_amdgcn_mfma_f32_32x32x16_bf16(PAF(2),VFR(6),o[1],0,0,0), C1,4); \
    GAPB(o[0]=__builtin_amdgcn_mfma_f32_32x32x16_bf16(PAF(3),VFR(3),o[0],0,0,0), C1,8); \
    GAPB(o[1]=__builtin_amdgcn_mfma_f32_32x32x16_bf16(PAF(3),VFR(7),o[1],0,0,0), C1,12); \
    }while(0)
  int t=j0+1;
  #undef CMASK
  #define CMASK(P0,P1,t) do{}while(0)
  for(;t+5<NT;t+=2){
    STEP(pB0,pB1,pA0,pA1,t,true,true,true);     WAIT_BAR(2); RESC(); ROT();
    STEP(pA0,pA1,pB0,pB1,t+1,true,true,true);   WAIT_BAR(2); RESC(); ROT();
  }
  #undef CMASK
  #define CMASK(P0,P1,t) do{int jb_=(t)-(NT-4); if(jb_>=0)cmask(P0,P1,jb_,qrel,hi);}while(0)
  #define ENDW(tt) do{ if((tt)+3<NT){WAIT_BAR(2);} else if((tt)+2<NT){WAIT_BAR(1);} else {WAIT_BAR(0);} }while(0)
  for(;t+1<NT;t+=2){
    STEP(pB0,pB1,pA0,pA1,t,(t+3<NT),(t+1<NT),(t+1<NT));       ENDW(t);   RESC(); ROT();
    STEP(pA0,pA1,pB0,pB1,t+1,(t+4<NT),(t+2<NT),(t+2<NT));     ENDW(t+1); RESC(); ROT();
  }
  STEP(pB0,pB1,pA0,pA1,NT-1,false,false,false); RESC();
  { float sacc=pB0[0]+pB0[1]; _Pragma("unroll") for(int r=2;r<16;++r)sacc+=pB0[r]; _Pragma("unroll") for(int r=0;r<16;++r)sacc+=pB1[r]; l_reg+=sacc;
    pw0=(u32x4){PKW(pB0,0),PKW(pB0,2),PKW(pB0,4),PKW(pB0,6)};pw1=(u32x4){PKW(pB0,8),PKW(pB0,10),PKW(pB0,12),PKW(pB0,14)};pw2=(u32x4){PKW(pB1,0),PKW(pB1,2),PKW(pB1,4),PKW(pB1,6)};pw3=(u32x4){PKW(pB1,8),PKW(pB1,10),PKW(pB1,12),PKW(pB1,14)};
    SBAR(); pv(o,vb0+sl_cur,PAF(0),PAF(1),PAF(2),PAF(3)); }
  #undef PKW
  #undef PAF
  #undef VFR
  #undef PIN
  #undef MX3
  #undef GAPA
  #undef GAPB
  #undef EX
  #undef VRD
  #undef KRD
  #undef STEP
  #undef ENDW
  {auto rr=__builtin_amdgcn_permlane32_swap(__float_as_uint(l_reg),__float_as_uint(l_reg),false,false);l_reg=__uint_as_float(rr[0])+__uint_as_float(rr[1]);}
  if(hi==0)wsf[32+r32]=l_reg;asm volatile("s_waitcnt lgkmcnt(0)":::"memory");
  float rli[16];
  #pragma unroll
  for(int r=0;r<16;++r)rli[r]=__builtin_amdgcn_rcpf(wsf[32+crow(r,hi)]);
  bf16*Ow=O+(rowbase+q0+wid*QBLK)*ODM+h*D;
  { bf16*stg=(bf16*)(shm+LDS_OST)+wid*2048;
    #pragma unroll
    for(int r=0;r<16;++r){const int orow=crow(r,hi);
      #pragma unroll
      for(int d0=0;d0<2;++d0)stg[orow*64+d0*32+r32]=__float2bfloat16(o[d0][r]*rli[r]);}
    asm volatile("s_waitcnt lgkmcnt(0)":::"memory");
    #pragma unroll
    for(int i=0;i<4;++i){const int row=i*8+(lane>>3),ch=lane&7; const u32x4 v=*(const u32x4*)(stg+row*64+ch*8); ATTN_STORE16(Ow+(long)row*ODM+ch*8,v);} }
  asm volatile("s_waitcnt lgkmcnt(0)\n\ts_barrier":::"memory");
  #undef CIN
  #undef DMA_K
  #undef DMA_V
  #undef CMASK
  #undef START
  #undef RESC
  #undef ROT
}
constexpr int ATTN_LDS_BYTES=LDS_BYTES;
struct AttnTensors { const bf16* Q; const bf16* K; const bf16* V; bf16* O; };
struct AttnUnit { int bh; int qb; };
struct StaticOrder {
  int vcu;
  __device__ __forceinline__ explicit StaticOrder(int grid,int block):vcu((block%8)*(grid/8)+block/8){}
  __device__ __forceinline__ bool next(int i,AttnUnit&u)const{ if(i>=4)return false; const int s=vcu&7; u.bh=vcu>>3; u.qb=(i==0)?s:(i==1)?15-s:(i==2)?16+s:31-s; return true; }
  __device__ __forceinline__ void a_ready(const AttnUnit&)const{}
  __device__ __forceinline__ void done(const AttnUnit&)const{}
};
template<class Sched,int THRL=8> __device__ __forceinline__ void attn_phase(char*lds,const AttnTensors&T,const Sched&S,float qkb2){
  AttnUnit u;
  for(int i=0;S.next(i,u);++i){ S.a_ready(u); attn_unit<THRL>(u.bh/NHEAD,u.bh%NHEAD,u.qb,T.Q,T.K,T.V,T.O,lds,qkb2); S.done(u); }
}
#undef SBAR
#undef WAIT_BAR
}
#define GAS __attribute__((address_space(1)))
#define LAS __attribute__((address_space(3)))
typedef GAS unsigned gu32;
#define RLX_AGENT __ATOMIC_RELAXED, __HIP_MEMORY_SCOPE_AGENT
#define LDS_WAIT() asm volatile("s_waitcnt lgkmcnt(0)" ::: "memory")
#define VM_WAIT() asm volatile("s_waitcnt vmcnt(0)" ::: "memory")

constexpr int NWAVES = 8;
constexpr int N_PHASES = 8;
constexpr int RING_OFF = 0, RING_BYTES = 131072;
constexpr int TAB_OFF = 131072, TAB_UNITS = 17;
constexpr int RT_CHE = 131072, RT_CHG = 133120, RT_LCNT = 135168, RT_LBASE = 135296;
constexpr int LDS_TOTAL = 155648;
constexpr int LDSCTL_OFF = LDS_TOTAL - 1024;
static_assert(TAB_OFF + TAB_UNITS * 256 * 4 <= LDSCTL_OFF && RT_LBASE + 128 <= LDSCTL_OFF, "LDS map");
constexpr int CW_BAR = 4096;

#define XB_TMO      128
#define XB_XCNT(j)  (256  + 64 * (j))
#define XB_XSUB(j)  (1280 + 64 * (j))
#define XB_XGEN(j)  (2304 + 64 * (j))
#define XB_TOP      3328
#define XB_TOPGEN   3392
#define XCD_BAR_WORDS 3456
#define XB_SPIN_CAP (1u << 18)

__device__ __forceinline__ unsigned xb_ld(unsigned* p)              { return __hip_atomic_load(p, __ATOMIC_RELAXED, __HIP_MEMORY_SCOPE_AGENT); }
__device__ __forceinline__ unsigned xb_add(unsigned* p, unsigned v) { return __hip_atomic_fetch_add(p, v, __ATOMIC_RELAXED, __HIP_MEMORY_SCOPE_AGENT); }
__device__ __forceinline__ unsigned xb_xcc_id() { return (unsigned)__builtin_amdgcn_s_getreg((3 << 11) | 20) & 0xFu; }
#define XB_SPIN(cond, bar) do { unsigned _sp = 0; while (cond) { __builtin_amdgcn_s_sleep(1); \
    if ((++_sp & 255u) == 0u) { if (xb_ld(&(bar)[XB_TMO])) break; if (_sp > XB_SPIN_CAP) { atomicAdd(&(bar)[XB_TMO], 1u); break; } } } } while (0)

struct XcdBarrier {
    unsigned* bar; unsigned x;
    volatile LAS unsigned* st;
};

__device__ __forceinline__ XcdBarrier xcd_barrier_post(unsigned* bar, volatile LAS unsigned* st) {
    XcdBarrier b; b.bar = bar; b.x = xb_xcc_id(); b.st = st;
    if (threadIdx.x == 0) (void)xb_add(&bar[XB_XCNT(b.x)], 1u);
    return b;
}
__device__ __forceinline__ void xcd_barrier_complete(unsigned* bar, unsigned x, unsigned& nloc, unsigned& nx) {
    const unsigned G = gridDim.x * gridDim.y * gridDim.z;
    unsigned sum, cnt, mine, sp = 0u;
    for (;;) {
        sum = 0u; cnt = 0u; mine = 0u;
#pragma unroll
        for (unsigned j = 0; j < 16; ++j) { const unsigned c = xb_ld(&bar[XB_XCNT(j)]); sum += c; cnt += (c > 0u) ? 1u : 0u; mine = (j == x) ? c : mine; }
        if (sum == G) break;
        __builtin_amdgcn_s_sleep(1);
        if ((++sp & 255u) == 0u) { if (xb_ld(&bar[XB_TMO])) break; if (sp > XB_SPIN_CAP) { atomicAdd(&bar[XB_TMO], 1u); break; } }
    }
    nloc = mine > 0u ? mine : 1u; nx = cnt > 0u ? cnt : 1u;
}

__device__ __forceinline__ void xcd_barrier(const XcdBarrier& b) {
    asm volatile("s_waitcnt vmcnt(0)" ::: "memory");
    __syncthreads();
    if (threadIdx.x == 0) {
        unsigned* bar = b.bar;
        __builtin_amdgcn_s_waitcnt(0);
        unsigned nloc = b.st[0], nx = b.st[1];
        if (nloc == 0u) { xcd_barrier_complete(bar, b.x, nloc, nx); b.st[0] = nloc; b.st[1] = nx; }
        const unsigned old = xb_add(&bar[XB_XSUB(b.x)], 1u);
        const unsigned gen = old / nloc;
        if (old + 1u == (gen + 1u) * nloc) {
            __builtin_amdgcn_fence(__ATOMIC_RELEASE, "agent");
            asm volatile("s_waitcnt vmcnt(0)" ::: "memory");
            const unsigned og = xb_add(&bar[XB_TOP], 1u);
            const unsigned tg = og / nx;
            if (og + 1u == (tg + 1u) * nx) xb_add(&bar[XB_TOPGEN], 1u);
            else XB_SPIN(xb_ld(&bar[XB_TOPGEN]) == tg, bar);
            __builtin_amdgcn_fence(__ATOMIC_ACQUIRE, "agent");
            xb_add(&bar[XB_XGEN(b.x)], 1u);
            asm volatile("s_waitcnt vmcnt(0)" ::: "memory");
        } else {
            XB_SPIN(xb_ld(&bar[XB_XGEN(b.x)]) == gen, bar);
            __builtin_amdgcn_fence(__ATOMIC_ACQUIRE, "agent");
            asm volatile("s_waitcnt vmcnt(0)" ::: "memory");
        }
    }
    __syncthreads();
}


struct Args { const float* in[15]; float* out; unsigned char* ws; int ph_lo, ph_hi, use_bar, pad; };

__device__ __forceinline__ void p0_transpose_item(const float* W, int ldw, bf16* WT, int ldt, LAS float* scr, int lane) {
    float tv[32];
    const float* wp_ = W + (size_t)(lane >> 5) * ldw + (lane & 31);
#pragma unroll
    for (int i = 0; i < 32; ++i) tv[i] = wp_[(size_t)(2 * i) * ldw];
#pragma unroll
    for (int i = 0; i < 32; ++i) scr[(2 * i + (lane >> 5)) * 33 + (lane & 31)] = tv[i];
    LDS_WAIT(); asm volatile("" ::: "memory");
    const int c = lane & 7;
#pragma unroll
    for (int j = 0; j < 4; ++j) { const int n = (lane >> 3) + 8 * j; const LAS float* s = scr + (8 * c) * 33 + n;
        u32x4 o; o.x = pg8::cvt_pk_bf16(s[0 * 33], s[1 * 33]); o.y = pg8::cvt_pk_bf16(s[2 * 33], s[3 * 33]); o.z = pg8::cvt_pk_bf16(s[4 * 33], s[5 * 33]); o.w = pg8::cvt_pk_bf16(s[6 * 33], s[7 * 33]);
        *(GAS u32x4*)(WT + (size_t)n * ldt + 8 * c) = o; }
    LDS_WAIT(); asm volatile("" ::: "memory");
}
constexpr int I_WIN = 16 * 64, I_WO = 8 * 32, I_WEFF = 4 * 16 * 16, I_WU = 32 * 16 * 64, I_WD = 32 * 16 * 32;
constexpr int P0_ITEMS = I_WIN + I_WO + I_WEFF + I_WU + I_WD;

__device__ __forceinline__ void phase0(const Args& a, LAS unsigned char* L, int vcu, int G, int tid, int lane, int wave) {
    const float* w_in = a.in[2]; const float* w_pool = a.in[4]; const float* pscale = a.in[5]; const float* w_out = a.in[6]; const float* w_up = a.in[10]; const float* w_down = a.in[12];
    bf16* Win_t = (bf16*)(a.ws + WS_WIN); bf16* Wo_t = (bf16*)(a.ws + WS_WO); bf16* Wu_t = (bf16*)(a.ws + WS_WU); bf16* Wd_t = (bf16*)(a.ws + WS_WD);
    LAS float* scr = (LAS float*)(L + wave * 8448);
    LAS float* wf = (LAS float*)(L + 69632);
    for (int i = tid; i < 1024 * 8; i += 512) wf[i] = w_in[(size_t)(i >> 3) * INW + 2048 + (i & 7)];
    __syncthreads();
    const int gw = vcu * NWAVES + wave, NGW = G * NWAVES;
    {
        const float* x = a.in[0]; const float* g_mix = a.in[1]; const float* b_forget = a.in[3];
        bf16* XN = (bf16*)(a.ws + WS_XN); float* LOGF = (float*)(a.ws + WS_LOGF);
        f32x4 g[4];
#pragma unroll
        for (int j = 0; j < 4; ++j) g[j] = *(const f32x4*)(g_mix + 4 * lane + 256 * j);
        for (int m = gw; m < T; m += NGW) {
            const float* xr = x + (size_t)m * DM;
            f32x4 v[4]; float ss = 0.f;
#pragma unroll
            for (int j = 0; j < 4; ++j) { v[j] = *(const f32x4*)(xr + 4 * lane + 256 * j); ss += v[j].x * v[j].x + v[j].y * v[j].y + v[j].z * v[j].z + v[j].w * v[j].w; }
            const float rstd = rsqrtf(wave_sum(ss) * (1.f / DM) + RMS_EPS);
            float fl[8];
#pragma unroll
            for (int e = 0; e < 8; ++e) fl[e] = 0.f;
#pragma unroll
            for (int j = 0; j < 4; ++j) {
                v[j] = v[j] * rstd * g[j];
#pragma unroll
                for (int i = 0; i < 4; ++i) {
                    const int d = 4 * lane + 256 * j + i; const float hv = v[j][i];
                    const f32x4 w0 = *(const LAS f32x4*)(wf + d * 8), w1 = *(const LAS f32x4*)(wf + d * 8 + 4);
                    fl[0] += hv * w0.x; fl[1] += hv * w0.y; fl[2] += hv * w0.z; fl[3] += hv * w0.w;
                    fl[4] += hv * w1.x; fl[5] += hv * w1.y; fl[6] += hv * w1.z; fl[7] += hv * w1.w;
                }
                u32x2 o; o.x = pk2(v[j].x, v[j].y); o.y = pk2(v[j].z, v[j].w);
                *(u32x2*)(XN + (size_t)m * DM + 4 * lane + 256 * j) = o;
            }
#pragma unroll
            for (int e = 0; e < 8; ++e) fl[e] = wave_sum(fl[e]);
            if (lane < 8) {
                float z = 0.f;
#pragma unroll
                for (int e = 0; e < 8; ++e) if (lane == e) z = fl[e];
                z += b_forget[lane];
                const float ls = fminf(z, 0.f) - log1pf(expf(-fabsf(z)));
                LOGF[((size_t)(m / SEQ) * NH + lane) * SEQ + (m % SEQ)] = ls;
            }
        }
    }
    for (int it = gw; it < P0_ITEMS; it += NGW) {
        int r = it;
        if (r < I_WIN) { const int kb = r >> 6, nb = r & 63; p0_transpose_item(w_in + (size_t)(64 * kb) * INW + 32 * nb, INW, Win_t + (size_t)(32 * nb) * DM + 64 * kb, DM, scr, lane); continue; } r -= I_WIN;
        if (r < I_WO) { const int kb = r >> 5, nb = r & 31; p0_transpose_item(w_out + (size_t)(512 + 64 * kb) * DM + 32 * nb, DM, Wo_t + (size_t)(32 * nb) * DM + 512 + 64 * kb, DM, scr, lane); continue; } r -= I_WO;
        if (r < I_WEFF) {
            const int g = r >> 8, nb = (r >> 4) & 15, kb = r & 15, n = nb * 64 + lane; float acc[8];
#pragma unroll
            for (int i = 0; i < 8; ++i) acc[i] = 0.f;
            const float* wp = w_pool + (size_t)g * 16384 + (size_t)(kb * 8) * 128;
#pragma unroll 2
            for (int d = 0; d < 128; d += 4) { f32x4 av;
#pragma unroll
                for (int q = 0; q < 4; ++q) av[q] = w_out[(size_t)(g * 128 + d + q) * DM + n];
                av = av * *(const f32x4*)(pscale + g * 128 + d);
#pragma unroll
                for (int i = 0; i < 8; ++i) { const f32x4 wv = *(const f32x4*)(wp + i * 128 + d); acc[i] += av.x * wv.x + av.y * wv.y + av.z * wv.z + av.w * wv.w; } }
            u32x4 o; o.x = pk2(acc[0], acc[1]); o.y = pk2(acc[2], acc[3]); o.z = pk2(acc[4], acc[5]); o.w = pk2(acc[6], acc[7]);
            *(GAS u32x4*)(Wo_t + (size_t)n * DM + g * 128 + kb * 8) = o; continue; } r -= I_WEFF;
        if (r < I_WU) { const int e = r >> 10, kb = (r >> 6) & 15, nb = r & 63, n0 = 32 * nb;
            const int rowp = n0 < 1024 ? (n0 >> 7) * 256 + (n0 & 127) : ((n0 - 1024) >> 7) * 256 + 128 + ((n0 - 1024) & 127);
            p0_transpose_item(w_up + (size_t)e * DM * 2048 + (size_t)(64 * kb) * 2048 + n0, 2048, Wu_t + ((size_t)e * 2048 + rowp) * DM + 64 * kb, DM, scr, lane); continue; } r -= I_WU;
        { const int e = r >> 9, kb = (r >> 5) & 15, nb = r & 31;
            p0_transpose_item(w_down + (size_t)e * DE * DM + (size_t)(64 * kb) * DM + 32 * nb, DM, Wd_t + ((size_t)e * DM + 32 * nb) * DE + 64 * kb, DE, scr, lane); }
    }
}

__device__ __forceinline__ void pool_pass(const Args& a, int vcu, int G, int tid) {
    const bf16* U = (const bf16*)(a.ws + WS_U); bf16* CAT = (bf16*)(a.ws + WS_CAT);
    const size_t total = (size_t)T * 64;
    for (size_t i = (size_t)vcu * 512 + tid; i < total; i += (size_t)G * 512) {
        const int row = (int)(i >> 6), ch = (int)(i & 63), c0 = ch * 8, g = c0 >> 7, w = 2 << g, t = row % SEQ;
        const int n = t + 1 < w ? t + 1 : w;
        float acc[8], self[8];
#pragma unroll
        for (int k = 0; k < 8; ++k) { acc[k] = 0.f; self[k] = 0.f; }
        for (int j = 0; j < n; ++j) {
            const u32x4 r = *(const u32x4*)(U + (size_t)(row - j) * PW + c0);
            const unsigned rr[4] = {r.x, r.y, r.z, r.w};
#pragma unroll
            for (int k = 0; k < 4; ++k) { const float lo = __builtin_bit_cast(float, rr[k] << 16), hi = __builtin_bit_cast(float, rr[k] & 0xffff0000u); acc[2 * k] += lo; acc[2 * k + 1] += hi;
                if (j == 0) { self[2 * k] = lo; self[2 * k + 1] = hi; } }
        }
        const float inv = 1.f / (float)n; u32x4 o;
        o.x = pk2(acc[0] * inv - self[0], acc[1] * inv - self[1]); o.y = pk2(acc[2] * inv - self[2], acc[3] * inv - self[3]);
        o.z = pk2(acc[4] * inv - self[4], acc[5] * inv - self[5]); o.w = pk2(acc[6] * inv - self[6], acc[7] * inv - self[7]);
        *(u32x4*)(CAT + (size_t)row * DM + c0) = o;
    }
}
__device__ __forceinline__ float slice_max_norm2(const bf16* base, LAS float* red, int tid, int lane, int wave) {
    float mx = 0.f; const int chunk = tid & 7, r0 = tid >> 3;
#pragma unroll 8
    for (int i = 0; i < SEQ / 64; ++i) { const u32x4 v = *(const u32x4*)(base + (size_t)(i * 64 + r0) * AW + chunk * 8); const unsigned w[4] = {v.x, v.y, v.z, v.w}; float s = 0.f;
#pragma unroll
        for (int k = 0; k < 4; ++k) { const float lo = __builtin_bit_cast(float, w[k] << 16), hi = __builtin_bit_cast(float, w[k] & 0xffff0000u); s += lo * lo + hi * hi; }
        s += __shfl_xor(s, 1); s += __shfl_xor(s, 2); s += __shfl_xor(s, 4); mx = fmaxf(mx, s); }
#pragma unroll
    for (int o = 8; o < 64; o <<= 1) mx = fmaxf(mx, __shfl_xor(mx, o));
    __syncthreads();
    if (lane == 0) red[wave] = mx;
    __syncthreads();
    float r = red[0];
#pragma unroll
    for (int w = 1; w < 8; ++w) r = fmaxf(r, red[w]);
    return r;
}
__device__ __forceinline__ void c2_scan(const Args& a, LAS unsigned char* L, int bh, int tid, int lane, int wave) {
    const float* src = (const float*)(a.ws + WS_LOGF) + (size_t)bh * SEQ + tid * 16;
    LAS double* wtot = (LAS double*)(L + 0);
    LAS float* c2s = (LAS float*)(L + attn_body::LDS_C2);
    float v[16]; double s = 0.0;
#pragma unroll
    for (int i = 0; i < 16; ++i) { v[i] = src[i]; s += (double)v[i]; }
    double inc = s;
#pragma unroll
    for (int o = 1; o < 64; o <<= 1) { const double t_ = __shfl_up(inc, o); if (lane >= o) inc += t_; }
    if (lane == 63) wtot[wave] = inc;
    __syncthreads();
    double base = inc - s;
    for (int w = 0; w < wave; ++w) base += wtot[w];
#pragma unroll
    for (int i = 0; i < 16; ++i) { base += (double)v[i]; c2s[tid * 16 + i] = (float)(base * (double)LOG2E); }
    __syncthreads();
}

__device__ __forceinline__ void router_phase(const Args& a, LAS unsigned char* L, int vcu, int G, int tid, int lane, int wave) {
    LAS float* wr = (LAS float*)L;
    LAS int* ch_e = (LAS int*)(L + RT_CHE); LAS float* ch_g = (LAS float*)(L + RT_CHG); LAS int* lcnt = (LAS int*)(L + RT_LCNT); LAS int* lbase = (LAS int*)(L + RT_LBASE);
    const float* w_router = a.in[8]; const float* b_router = a.in[9]; const float* g_ffn = a.in[7];
    for (int i = tid; i < 1024 * 32 / 4; i += 512) ((LAS f32x4*)wr)[i] = ((const f32x4*)w_router)[i];
    __syncthreads();
    const float* X1 = a.out; bf16* H2 = (bf16*)(a.ws + WS_XN);
    int* cnt = (int*)(a.ws + WS_CTL) + CW_CNT; int* SEL = (int*)(a.ws + WS_SEL); int* LTK = (int*)(a.ws + WS_LTK); float* LGT = (float*)(a.ws + WS_LGT);
    f32x4 g[4];
#pragma unroll
    for (int j = 0; j < 4; ++j) g[j] = *(const f32x4*)(g_ffn + 4 * lane + 256 * j);
    const int myexp = ((lane >> 5) & 1) * 16 + ((lane >> 4) & 1) * 8 + ((lane >> 3) & 1) * 4 + ((lane >> 2) & 1) * 2 + ((lane >> 1) & 1);
    const float mybias = b_router[myexp];
    for (int grp = vcu; grp < T / 128; grp += G) {
        if (tid < 32) lcnt[tid] = 0;
        __syncthreads();
        for (int it = 0; it < 16; ++it) {
            const int lt = wave * 16 + it, m = grp * 128 + lt;
            const float* xr = X1 + (size_t)m * DM;
            f32x4 v[4]; float ss = 0.f;
#pragma unroll
            for (int j = 0; j < 4; ++j) { v[j] = *(const f32x4*)(xr + 4 * lane + 256 * j); ss += v[j].x * v[j].x + v[j].y * v[j].y + v[j].z * v[j].z + v[j].w * v[j].w; }
            const float rstd = rsqrtf(wave_sum(ss) * (1.f / DM) + RMS_EPS);
            float lg[32];
#pragma unroll
            for (int e = 0; e < 32; ++e) lg[e] = 0.f;
#pragma unroll
            for (int j = 0; j < 4; ++j) {
                v[j] = v[j] * rstd * g[j];
                u32x2 o; o.x = pk2(v[j].x, v[j].y); o.y = pk2(v[j].z, v[j].w);
                *(u32x2*)(H2 + (size_t)m * DM + 4 * lane + 256 * j) = o;
#pragma unroll
                for (int i = 0; i < 4; ++i) { const int d = 4 * lane + 256 * j + i; const float hv = v[j][i];
#pragma unroll
                    for (int e4 = 0; e4 < 8; ++e4) { const f32x4 w = *(const LAS f32x4*)(wr + d * 32 + e4 * 4);
                        lg[e4 * 4] += hv * w.x; lg[e4 * 4 + 1] += hv * w.y; lg[e4 * 4 + 2] += hv * w.z; lg[e4 * 4 + 3] += hv * w.w; }
                    asm volatile("" ::: "memory"); }
            }
            float mine;
            {
                float a16[16]; const bool up = lane >= 32;
#pragma unroll
                for (int e = 0; e < 16; ++e) { const float keep = up ? lg[16 + e] : lg[e], give = up ? lg[e] : lg[16 + e]; a16[e] = keep + __shfl_xor(give, 32); }
                float a8[8]; const bool u16 = (lane & 16) != 0;
#pragma unroll
                for (int e = 0; e < 8; ++e) { const float keep = u16 ? a16[8 + e] : a16[e], give = u16 ? a16[e] : a16[8 + e]; a8[e] = keep + __shfl_xor(give, 16); }
                float a4[4]; const bool u8 = (lane & 8) != 0;
#pragma unroll
                for (int e = 0; e < 4; ++e) { const float keep = u8 ? a8[4 + e] : a8[e], give = u8 ? a8[e] : a8[4 + e]; a4[e] = keep + __shfl_xor(give, 8); }
                float a2[2]; const bool u4 = (lane & 4) != 0;
#pragma unroll
                for (int e = 0; e < 2; ++e) { const float keep = u4 ? a4[2 + e] : a4[e], give = u4 ? a4[e] : a4[2 + e]; a2[e] = keep + __shfl_xor(give, 4); }
                const bool u2 = (lane & 2) != 0;
                float a1 = (u2 ? a2[1] : a2[0]) + __shfl_xor(u2 ? a2[0] : a2[1], 2);
                a1 += __shfl_xor(a1, 1);
                mine = a1;
            }
            float val = mine + mybias;
            if (lane & 1) val = -INFINITY;
            float tv[4]; int ti[4];
#pragma unroll
            for (int k = 0; k < 4; ++k) {
                float bv = val; int bi = myexp;
#pragma unroll
                for (int o = 1; o < 64; o <<= 1) { const float ov = __shfl_xor(bv, o); const int oi = __shfl_xor(bi, o); if (ov > bv || (ov == bv && oi < bi)) { bv = ov; bi = oi; } }
                tv[k] = bv; ti[k] = bi; if (myexp == bi) val = -INFINITY;
            }
            const float e0 = 1.f, e1 = expf(tv[1] - tv[0]), e2 = expf(tv[2] - tv[0]), e3 = expf(tv[3] - tv[0]); const float inv = 1.f / (e0 + e1 + e2 + e3);
            if (lane < 4) { const float gg = (lane == 0 ? e0 : lane == 1 ? e1 : lane == 2 ? e2 : e3) * inv; const int ee = lane == 0 ? ti[0] : lane == 1 ? ti[1] : lane == 2 ? ti[2] : ti[3];
                ch_e[lt * 4 + lane] = ee; ch_g[lt * 4 + lane] = gg; __hip_atomic_fetch_add(&lcnt[ee], 1, __ATOMIC_RELAXED, __HIP_MEMORY_SCOPE_WORKGROUP); }
        }
        __syncthreads();
        if (tid < 32) { lbase[tid] = atomicAdd(&cnt[tid], lcnt[tid]); lcnt[tid] = 0; }
        __syncthreads();
        { const int e = ch_e[tid]; const int slot = lbase[e] + __hip_atomic_fetch_add(&lcnt[e], 1, __ATOMIC_RELAXED, __HIP_MEMORY_SCOPE_WORKGROUP); const int tk = (grp * 128 + (tid >> 2)) * 4 + (tid & 3);
          LTK[(size_t)e * T + slot] = tk; LGT[(size_t)e * T + slot] = ch_g[tid]; SEL[tk] = (slot << 5) | e; }
        __syncthreads();
    }
}

__device__ __forceinline__ void expert_map(const Args& a, volatile LAS unsigned* MISC, int tid) {
    if (tid == 0) { const int* cnt = (const int*)(a.ws + WS_CTL) + CW_CNT; int acc = 0;
        for (int e = 0; e < 32; ++e) { const int c = __hip_atomic_load((int*)cnt + e, RLX_AGENT); MISC[64 + e] = (unsigned)c; MISC[96 + e] = (unsigned)acc; acc += (c + RT - 1) / RT; } MISC[128] = (unsigned)acc; }
    __syncthreads();
}

__device__ __forceinline__ void final_phase(const Args& a, volatile LAS unsigned* MISC, int vcu, int G, int lane, int wave) {
    const int* SEL = (const int*)(a.ws + WS_SEL); const bf16* Y = (const bf16*)(a.ws + WS_Y); const float* g_final = a.in[14];
    f32x4 g[4];
#pragma unroll
    for (int j = 0; j < 4; ++j) g[j] = *(const f32x4*)(g_final + 4 * lane + 256 * j);
    for (int m = vcu * 8 + wave; m < T; m += G * 8) {
        float* xr = a.out + (size_t)m * DM; f32x4 v[4];
#pragma unroll
        for (int j = 0; j < 4; ++j) v[j] = *(const f32x4*)(xr + 4 * lane + 256 * j);
#pragma unroll
        for (int k = 0; k < 4; ++k) { const int sv = SEL[m * 4 + k]; const int e = sv & 31, slot = sv >> 5; const bf16* yr = Y + ((size_t)MISC[96 + e] * RT + slot) * DM;
#pragma unroll
            for (int j = 0; j < 4; ++j) { const u32x2 y = *(const u32x2*)(yr + 4 * lane + 256 * j);
                v[j].x += __builtin_bit_cast(float, y.x << 16); v[j].y += __builtin_bit_cast(float, y.x & 0xffff0000u); v[j].z += __builtin_bit_cast(float, y.y << 16); v[j].w += __builtin_bit_cast(float, y.y & 0xffff0000u); } }
        float ss = 0.f;
#pragma unroll
        for (int j = 0; j < 4; ++j) ss += v[j].x * v[j].x + v[j].y * v[j].y + v[j].z * v[j].z + v[j].w * v[j].w;
        const float rstd = rsqrtf(wave_sum(ss) * (1.f / DM) + RMS_EPS);
#pragma unroll
        for (int j = 0; j < 4; ++j) *(f32x4*)(xr + 4 * lane + 256 * j) = v[j] * rstd * g[j];
    }
}

__global__ void __launch_bounds__(NWAVES * 64, 2) mk_fwd(Args args) {
    extern __shared__ __attribute__((aligned(16))) unsigned char lds[];
    LAS unsigned char* L = (LAS unsigned char*)lds;
    volatile LAS unsigned* MISC = (volatile LAS unsigned*)(L + LDSCTL_OFF);
    const int tid = threadIdx.x, lane = tid & 63, wave = __builtin_amdgcn_readfirstlane(tid >> 6);
    const int G = gridDim.x; const int bx = blockIdx.x; const int vcu = (G % 8 == 0) ? (bx % 8) * (G / 8) + bx / 8 : bx;
    unsigned char* ws = args.ws;
    for (int u = tid; u < (LDS_TOTAL - LDSCTL_OFF) / 4; u += NWAVES * 64) ((LAS unsigned*)(L + LDSCTL_OFF))[u] = 0u;
    __syncthreads();
    XcdBarrier bar; bar.bar = (unsigned*)(ws + WS_CTL) + CW_BAR; bar.x = 0; bar.st = nullptr;
    if (args.use_bar) bar = xcd_barrier_post((unsigned*)(ws + WS_CTL) + CW_BAR, MISC + 8);
    const int lo = args.ph_lo, hi = args.ph_hi;
#define IN(k) (lo <= (k) && (k) < hi)
#define SEAM(k) do { if (IN(k) && IN((k) + 1)) xcd_barrier(bar); } while (0)
#ifndef MK_DUP
#define MK_DUP -1
#endif
#define REPS(k) for (int rep_ = 0; rep_ < ((MK_DUP) == (k) ? 2 : 1); ++rep_, ((MK_DUP) == (k) && rep_ == 1 ? xcd_barrier(bar) : (void)0))

    if (IN(0)) REPS(0) { phase0(args, L, vcu, G, tid, lane, wave); }
    SEAM(0);
    if (IN(1)) REPS(1) {
        pg8::Gemm g{(const bf16*)(ws + WS_XN), (const bf16*)(ws + WS_WIN), DM}; pg8::StaticOrder S; S.init(T, 2048, G, bx);
        pg8::EpiInproj E{(bf16*)(ws + WS_U), (size_t)(WS_Q - WS_U) / 2, C2};
        pg8::gemm_phase<pg8::EpiInproj, pg8::StaticOrder, true, false>(L + RING_OFF, g, S, E, nullptr);
    }
    SEAM(1);
    if (IN(2)) {
        pool_pass(args, vcu, G, tid);
        const attn_body::StaticOrder S(G, bx);
        const int bh = S.vcu >> 3; const size_t hoff = (size_t)(bh / NH) * SEQ * AW + (size_t)(bh % NH) * HD;
        const float mq2 = slice_max_norm2((const bf16*)(ws + WS_Q) + hoff, (LAS float*)(L + 256), tid, lane, wave);
        const float mk2 = slice_max_norm2((const bf16*)(ws + WS_K) + hoff, (LAS float*)(L + 512), tid, lane, wave);
        const float qkb2 = 2.0f * sqrtf(mq2 * mk2) * 1.001f;
        c2_scan(args, L, bh, tid, lane, wave);
        const attn_body::AttnTensors AT{(const attn_body::bf16*)(ws + WS_Q), (const attn_body::bf16*)(ws + WS_K), (const attn_body::bf16*)(ws + WS_V), (attn_body::bf16*)(ws + WS_CAT) + PW};
        attn_body::attn_phase<attn_body::StaticOrder>((char*)lds + RING_OFF, AT, S, qkb2);
    }
#if MK_DUP == 2
    xcd_barrier(bar);
    if (IN(2)) {
        pool_pass(args, vcu, G, tid);
        const attn_body::StaticOrder S(G, bx);
        const int bh = S.vcu >> 3; const size_t hoff = (size_t)(bh / NH) * SEQ * AW + (size_t)(bh % NH) * HD;
        const float mq2 = slice_max_norm2((const bf16*)(ws + WS_Q) + hoff, (LAS float*)(L + 256), tid, lane, wave);
        const float mk2 = slice_max_norm2((const bf16*)(ws + WS_K) + hoff, (LAS float*)(L + 512), tid, lane, wave);
        const float qkb2 = 2.0f * sqrtf(mq2 * mk2) * 1.001f;
        c2_scan(args, L, bh, tid, lane, wave);
        const attn_body::AttnTensors AT{(const attn_body::bf16*)(ws + WS_Q), (const attn_body::bf16*)(ws + WS_K), (const attn_body::bf16*)(ws + WS_V), (attn_body::bf16*)(ws + WS_CAT) + PW};
        attn_body::attn_phase<attn_body::StaticOrder>((char*)lds + RING_OFF, AT, S, qkb2);
    }
#endif
    SEAM(2);
    if (IN(3)) REPS(3) {
        pg8::Gemm g{(const bf16*)(ws + WS_CAT), (const bf16*)(ws + WS_WO), DM}; pg8::StaticOrder S; S.init(T, DM, G, bx);
        pg8::EpiResF32 E{args.in[0], args.out};
        pg8::gemm_phase<pg8::EpiResF32, pg8::StaticOrder, true, false>(L + RING_OFF, g, S, E, nullptr);
    }
    SEAM(3);
    if (IN(4)) { router_phase(args, L, vcu, G, tid, lane, wave); }
    SEAM(4);
    if (IN(5)) REPS(5) {
        expert_map(args, MISC, tid);
        const LAS int* pt = (const LAS int*)(L + LDSCTL_OFF + 96 * 4); const LAS int* cn = (const LAS int*)(L + LDSCTL_OFF + 64 * 4);
        LAS unsigned* tab = (LAS unsigned*)(L + TAB_OFF);
        const pg8::MoeOrder<8> S{pt, G, bx, (size_t)2048 * DM * 2};
        { const int* LTK = (const int*)(ws + WS_LTK); pg8::Unit u;
          for (int i = 0; i < TAB_UNITS && S.next(i, u); ++i) { if (tid < 256) { const int slot = u.lrow0 + tid; const int tok = slot < cn[u.e] ? (LTK[(size_t)u.e * T + slot] >> 2) : 0; tab[i * 256 + tid] = (unsigned)tok * (unsigned)(DM * 2); } } }
        __syncthreads();
        pg8::Gemm g{(const bf16*)(ws + WS_XN), (const bf16*)(ws + WS_WU), DM};
        pg8::EpiSwiglu E{(bf16*)(ws + WS_ACT), args.in[11]};
        pg8::gemm_phase<pg8::EpiSwiglu, pg8::MoeOrder<8>, true, true>(L + RING_OFF, g, S, E, tab);
    }
    SEAM(5);
    if (IN(6)) REPS(6) {
        expert_map(args, MISC, tid);
        const LAS int* pt = (const LAS int*)(L + LDSCTL_OFF + 96 * 4); const LAS int* cn = (const LAS int*)(L + LDSCTL_OFF + 64 * 4);
        const pg8::MoeOrder<4> S{pt, G, bx, (size_t)DM * DE * 2};
        pg8::Gemm g{(const bf16*)(ws + WS_ACT), (const bf16*)(ws + WS_WD), DE};
        pg8::EpiDown E{(bf16*)(ws + WS_Y), args.in[13], (const float*)(ws + WS_LGT), cn, T};
        pg8::gemm_phase<pg8::EpiDown, pg8::MoeOrder<4>, true, false>(L + RING_OFF, g, S, E, nullptr);
    }
    SEAM(6);
    if (IN(7)) { expert_map(args, MISC, tid); final_phase(args, MISC, vcu, G, lane, wave); }
#undef IN
#undef SEAM
}
#ifndef MK_MODE
#define MK_MODE 1
#endif
#ifndef MK_NAIVE_MASK
#define MK_NAIVE_MASK 0
#endif
extern "C" void kernel_launch(void* const* d_in, const int* in_sizes, int n_in, void* d_out, int out_size, void* d_ws, size_t ws_size, hipStream_t stream) {
    if (n_in != 15 || out_size != T * DM || ws_size < WS_END) { fprintf(stderr, "kernel_launch: unexpected shapes (n_in %d out %d ws %zu)\n", n_in, out_size, ws_size); return; }
    Params p{};
    p.x = (const float*)d_in[0]; p.g_mix = (const float*)d_in[1]; p.w_in = (const float*)d_in[2]; p.b_forget = (const float*)d_in[3]; p.w_pool = (const float*)d_in[4];
    p.pool_scale = (const float*)d_in[5]; p.w_out = (const float*)d_in[6]; p.g_ffn = (const float*)d_in[7]; p.w_router = (const float*)d_in[8]; p.b_router = (const float*)d_in[9];
    p.w_up = (const float*)d_in[10]; p.b_up = (const float*)d_in[11]; p.w_down = (const float*)d_in[12]; p.b_down = (const float*)d_in[13]; p.g_final = (const float*)d_in[14];
    p.out = (float*)d_out; p.ws = (unsigned char*)d_ws;
    Args a{};
    for (int i = 0; i < 15; ++i) a.in[i] = (const float*)d_in[i];
    a.out = (float*)d_out; a.ws = (unsigned char*)d_ws;
    static bool attr_done = false;
    if (!attr_done) { if (hipFuncSetAttribute((const void*)mk_fwd, hipFuncAttributeMaxDynamicSharedMemorySize, LDS_TOTAL) != hipSuccess) fprintf(stderr, "kernel_launch: hipFuncSetAttribute failed\n"); attr_done = true; }
    (void)hipMemsetAsync((char*)d_ws + WS_CTL, 0, 1 * MiB, stream);
    const int GRID = 256;
#if MK_MODE == 2
    a.ph_lo = 0; a.ph_hi = N_PHASES; a.use_bar = 1;
    hipLaunchKernelGGL(mk_fwd, dim3(GRID), dim3(NWAVES * 64), LDS_TOTAL, stream, a);
#else
    const unsigned mask = (MK_MODE == 0) ? 0xffu : (unsigned)(MK_NAIVE_MASK);
    auto fast = [&](int k) { a.ph_lo = k; a.ph_hi = k + 1; a.use_bar = 0; hipLaunchKernelGGL(mk_fwd, dim3(GRID), dim3(NWAVES * 64), LDS_TOTAL, stream, a); };
    auto nv = [&](int k) { return (mask >> k) & 1u; };
    if (mask != 0xffu || !nv(0)) fast(0);
    if (nv(0)) k_prologue<<<1024, 512, 0, stream>>>(p);
    if (nv(1)) k_inproj_naive<<<2048, 512, 0, stream>>>(p); else fast(1);
    if (nv(2)) { k_cumsum<<<32, 512, 0, stream>>>(p); k_attn_naive<<<BATCH * NH * (SEQ / 64), 512, 0, stream>>>(p); if (!nv(3)) k_pool<<<2048, 512, 0, stream>>>(p, (bf16*)((unsigned char*)d_ws + WS_CAT), DM); }
    else fast(2);
    if (nv(3)) { k_pool<<<2048, 512, 0, stream>>>(p, (bf16*)((unsigned char*)d_ws + WS_P), PW); k_poolgemm_naive<<<2048, 512, 0, stream>>>(p); k_outproj_naive<<<2048, 512, 0, stream>>>(p); }
    else fast(3);
    if (nv(4)) k_router<<<256, 512, 0, stream>>>(p); else fast(4);
    if (nv(5)) k_up_naive<<<4096, 512, 0, stream>>>(p); else fast(5);
    if (nv(6)) k_down_naive<<<4096, 512, 0, stream>>>(p); else fast(6);
    if (nv(7)) k_final<<<1024, 512, 0, stream>>>(p); else fast(7);
#endif
}
```

```cpp
#define MK_MODE 2
#include <hip/hip_runtime.h>
#include <cstdio>
#include <cstdint>

constexpr int BATCH = 4, SEQ = 8192, DM = 1024, T = BATCH * SEQ;
constexpr int PW = 512, AW = 512, NH = 8, HD = 64, INW = PW + 3 * AW + NH;
constexpr int NE = 32, TOPK = 4, DE = 1024;
constexpr float RMS_EPS = 1e-5f, SW_LIMIT = 7.0f, SW_ALPHA = 1.702f;
constexpr float LOG2E = 1.4426950408889634f;
constexpr float C2 = 0.125f * LOG2E;
constexpr int RT = 256;
constexpr int NROWS_PAD = T * TOPK + NE * RT;

typedef unsigned short bf16;
typedef float f32x4 __attribute__((ext_vector_type(4)));
typedef unsigned u32x4 __attribute__((ext_vector_type(4)));
typedef unsigned u32x2 __attribute__((ext_vector_type(2)));

constexpr size_t MiB = 1u << 20;
constexpr size_t WS_CTL = 0;
constexpr size_t WS_LOGF = 1 * MiB;
constexpr size_t WS_CUM = 2 * MiB;
constexpr size_t WS_SEL = 3 * MiB;
constexpr size_t WS_LTK = 4 * MiB;
constexpr size_t WS_LGT = 8 * MiB;
constexpr size_t WS_XN = 12 * MiB;
constexpr size_t WS_WIN = 76 * MiB;
constexpr size_t WS_WO = 80 * MiB;
constexpr size_t WS_WU = 82 * MiB;
constexpr size_t WS_WD = 210 * MiB;
constexpr size_t WS_U = 274 * MiB;
constexpr size_t WS_Q = 306 * MiB;
constexpr size_t WS_K = 338 * MiB;
constexpr size_t WS_V = 370 * MiB;
constexpr size_t WS_CAT = 402 * MiB;
constexpr size_t WS_P = 466 * MiB;
constexpr size_t WS_ACT = 274 * MiB;
constexpr size_t WS_Y = 546 * MiB;
constexpr size_t WS_END = 818 * MiB;
static_assert(WS_ACT + (size_t)NROWS_PAD * 1024 * 2 <= WS_Y, "ACT overlay");
static_assert(WS_Y + (size_t)NROWS_PAD * 1024 * 2 <= WS_END, "Y");
constexpr int CW_CNT = 64;

struct Params {
    const float *x, *g_mix, *w_in, *b_forget, *w_pool, *pool_scale, *w_out, *g_ffn, *w_router, *b_router, *w_up, *b_up, *w_down, *b_down, *g_final;
    float* out; unsigned char* ws;
};

__device__ __forceinline__ unsigned f2bf(float f) { unsigned u = __builtin_bit_cast(unsigned, f); return (u + 0x7fffu + ((u >> 16) & 1u)) >> 16; }
__device__ __forceinline__ unsigned pk2(float lo, float hi) { return f2bf(lo) | (f2bf(hi) << 16); }
__device__ __forceinline__ float bf2f(unsigned short b) { return __builtin_bit_cast(float, (unsigned)b << 16); }
__device__ __forceinline__ float wave_sum(float v) {
#pragma unroll
    for (int o = 1; o < 64; o <<= 1) v += __shfl_xor(v, o);
    return v;
}

__global__ void __launch_bounds__(512) k_prologue(Params p) {
    __shared__ float wf[1024 * 8];
    const int tid = threadIdx.x, lane = tid & 63, wave = tid >> 6;
    for (int i = tid; i < 1024 * 8; i += 512) wf[i] = p.w_in[(size_t)(i >> 3) * INW + 2048 + (i & 7)];
    if (blockIdx.x == 0 && tid < 64) ((int*)(p.ws + WS_CTL))[CW_CNT + tid] = 0;
    __syncthreads();
    bf16* XN = (bf16*)(p.ws + WS_XN); float* LOGF = (float*)(p.ws + WS_LOGF);
    const int gw = blockIdx.x * 8 + wave, NGW = gridDim.x * 8;
    f32x4 g[4];
#pragma unroll
    for (int j = 0; j < 4; ++j) g[j] = *(const f32x4*)(p.g_mix + 4 * lane + 256 * j);
    for (int m = gw; m < T; m += NGW) {
        const float* xr = p.x + (size_t)m * DM;
        f32x4 v[4]; float ss = 0.f;
#pragma unroll
        for (int j = 0; j < 4; ++j) { v[j] = *(const f32x4*)(xr + 4 * lane + 256 * j); ss += v[j].x * v[j].x + v[j].y * v[j].y + v[j].z * v[j].z + v[j].w * v[j].w; }
        const float rstd = rsqrtf(wave_sum(ss) * (1.f / DM) + RMS_EPS);
        float fl[8];
#pragma unroll
        for (int e = 0; e < 8; ++e) fl[e] = 0.f;
#pragma unroll
        for (int j = 0; j < 4; ++j) {
            v[j] = v[j] * rstd * g[j];
#pragma unroll
            for (int i = 0; i < 4; ++i) {
                const int d = 4 * lane + 256 * j + i; const float hv = v[j][i];
                const f32x4 w0 = *(const f32x4*)(wf + d * 8), w1 = *(const f32x4*)(wf + d * 8 + 4);
                fl[0] += hv * w0.x; fl[1] += hv * w0.y; fl[2] += hv * w0.z; fl[3] += hv * w0.w;
                fl[4] += hv * w1.x; fl[5] += hv * w1.y; fl[6] += hv * w1.z; fl[7] += hv * w1.w;
            }
            u32x2 o; o.x = pk2(v[j].x, v[j].y); o.y = pk2(v[j].z, v[j].w);
            *(u32x2*)(XN + (size_t)m * DM + 4 * lane + 256 * j) = o;
        }
#pragma unroll
        for (int e = 0; e < 8; ++e) fl[e] = wave_sum(fl[e]);
        if (lane < 8) {
            float z = 0.f;
#pragma unroll
            for (int e = 0; e < 8; ++e) if (lane == e) z = fl[e];
            z += p.b_forget[lane];
            const float ls = fminf(z, 0.f) - log1pf(expf(-fabsf(z)));
            const int b = m / SEQ, s = m % SEQ;
            LOGF[((size_t)b * NH + lane) * SEQ + s] = ls;
        }
    }
}

__global__ void __launch_bounds__(512) k_cumsum(Params p) {
    __shared__ double part[512];
    const int tid = threadIdx.x;
    const float* LOGF = (const float*)(p.ws + WS_LOGF); float* CUM = (float*)(p.ws + WS_CUM);
    for (int bh = blockIdx.x; bh < BATCH * NH; bh += gridDim.x) {
        const float* src = LOGF + (size_t)bh * SEQ + tid * 16; float v[16]; double s = 0.0;
#pragma unroll
        for (int i = 0; i < 16; ++i) { v[i] = src[i]; s += (double)v[i]; }
        part[tid] = s; __syncthreads();
        if (tid == 0) { double a = 0.0; for (int i = 0; i < 512; ++i) { const double t_ = part[i]; part[i] = a; a += t_; } }
        __syncthreads();
        double a = part[tid];
        float* dst = CUM + (size_t)bh * SEQ + tid * 16;
#pragma unroll
        for (int i = 0; i < 16; ++i) { a += (double)v[i]; dst[i] = (float)(a * (double)LOG2E); }
        __syncthreads();
    }
}

__global__ void __launch_bounds__(512) k_pool(Params p, bf16* dst, int ldd) {
    const bf16* U = (const bf16*)(p.ws + WS_U);
    const size_t total = (size_t)T * 64;
    for (size_t i = (size_t)blockIdx.x * 512 + threadIdx.x; i < total; i += (size_t)gridDim.x * 512) {
        const int row = (int)(i >> 6), ch = (int)(i & 63), c0 = ch * 8, g = c0 >> 7, w = 2 << g, t = row % SEQ;
        const int n = t + 1 < w ? t + 1 : w;
        float acc[8], self[8];
#pragma unroll
        for (int k = 0; k < 8; ++k) acc[k] = 0.f;
        for (int j = 0; j < n; ++j) {
            const u32x4 r = *(const u32x4*)(U + (size_t)(row - j) * PW + c0);
            const unsigned rr[4] = {r.x, r.y, r.z, r.w};
#pragma unroll
            for (int k = 0; k < 4; ++k) { const float lo = __builtin_bit_cast(float, rr[k] << 16), hi = __builtin_bit_cast(float, rr[k] & 0xffff0000u); acc[2 * k] += lo; acc[2 * k + 1] += hi;
                if (j == 0) { self[2 * k] = lo; self[2 * k + 1] = hi; } }
        }
        const float inv = 1.f / (float)n; u32x4 o;
        o.x = pk2(acc[0] * inv - self[0], acc[1] * inv - self[1]); o.y = pk2(acc[2] * inv - self[2], acc[3] * inv - self[3]);
        o.z = pk2(acc[4] * inv - self[4], acc[5] * inv - self[5]); o.w = pk2(acc[6] * inv - self[6], acc[7] * inv - self[7]);
        *(u32x4*)(dst + (size_t)row * ldd + c0) = o;
    }
}

template <class ARow, class Epi, bool DUAL>
__device__ __forceinline__ void naive_tile(int tm, int tn, int K, const ARow& arow, const float* W, const float* W2, int ldw, const Epi& epi, float* lds) {
    float* As = lds;
    float* Ws = lds + 16 * 68;
    float* Ws2 = Ws + 16 * 128;
    const int tid = threadIdx.x, tx = tid & 31, ty = tid >> 5;
    float acc[4][4], acc2[4][4];
#pragma unroll
    for (int i = 0; i < 4; ++i)
#pragma unroll
        for (int j = 0; j < 4; ++j) { acc[i][j] = 0.f; acc2[i][j] = 0.f; }
    const int ar = tid >> 3, ak = (tid & 7) * 2;
    const bf16* aptr = arow(tm * 64 + ar);
    const int wk = tid >> 5, wc = (tid & 31) * 4;
    for (int k0 = 0; k0 < K; k0 += 16) {
        unsigned av = aptr ? *(const unsigned*)(aptr + k0 + ak) : 0u;
        const f32x4 wv = *(const f32x4*)(W + (size_t)(k0 + wk) * ldw + tn * 128 + wc);
        f32x4 wv2; if (DUAL) wv2 = *(const f32x4*)(W2 + (size_t)(k0 + wk) * ldw + tn * 128 + wc);
        __syncthreads();
        As[ak * 68 + ar] = __builtin_bit_cast(float, av << 16); As[(ak + 1) * 68 + ar] = __builtin_bit_cast(float, av & 0xffff0000u);
        *(f32x4*)(Ws + wk * 128 + wc) = wv; if (DUAL) *(f32x4*)(Ws2 + wk * 128 + wc) = wv2;
        __syncthreads();
#pragma unroll
        for (int k = 0; k < 16; ++k) {
            const f32x4 a = *(const f32x4*)(As + k * 68 + ty * 4), w = *(const f32x4*)(Ws + k * 128 + tx * 4);
#pragma unroll
            for (int i = 0; i < 4; ++i)
#pragma unroll
                for (int j = 0; j < 4; ++j) acc[i][j] += a[i] * w[j];
            if (DUAL) { const f32x4 w2 = *(const f32x4*)(Ws2 + k * 128 + tx * 4);
#pragma unroll
                for (int i = 0; i < 4; ++i)
#pragma unroll
                    for (int j = 0; j < 4; ++j) acc2[i][j] += a[i] * w2[j]; }
        }
    }
#pragma unroll
    for (int i = 0; i < 4; ++i) epi(tm * 64 + ty * 4 + i, tn * 128 + tx * 4, acc[i], acc2[i]);
}
constexpr int NAIVE_LDS_FLOATS = 16 * 68 + 2 * 16 * 128;

struct ARowPlain { const bf16* A; int lda; __device__ __forceinline__ const bf16* operator()(int r) const { return A + (size_t)r * lda; } };
struct EpiInproj { bf16* U; __device__ __forceinline__ void operator()(int r, int c, const float (&a)[4], const float (&)[4]) const {
        const int t = c >> 9, cc = c & 511; const float s = (t == 1) ? C2 : 1.f;
        u32x2 o; o.x = pk2(a[0] * s, a[1] * s); o.y = pk2(a[2] * s, a[3] * s);
        *(u32x2*)(U + (size_t)t * ((WS_Q - WS_U) / 2) + (size_t)r * 512 + cc) = o; } };
__global__ void __launch_bounds__(512) k_inproj_naive(Params p) {
    __shared__ __attribute__((aligned(16))) float lds[NAIVE_LDS_FLOATS];
    ARowPlain ar{(const bf16*)(p.ws + WS_XN), DM}; EpiInproj ep{(bf16*)(p.ws + WS_U)};
    const int nM = T / 64, nN = 2048 / 128;
    for (int u = blockIdx.x; u < nM * nN; u += gridDim.x) naive_tile<ARowPlain, EpiInproj, false>(u / nN, u % nN, DM, ar, p.w_in, nullptr, INW, ep, lds);
}
struct EpiPool { bf16* CAT; const float* ps; int g; __device__ __forceinline__ void operator()(int r, int c, const float (&a)[4], const float (&)[4]) const {
        const int cc = g * 128 + c; const f32x4 s = *(const f32x4*)(ps + cc);
        u32x2 o; o.x = pk2(a[0] * s.x, a[1] * s.y); o.y = pk2(a[2] * s.z, a[3] * s.w);
        *(u32x2*)(CAT + (size_t)r * DM + cc) = o; } };
__global__ void __launch_bounds__(512) k_poolgemm_naive(Params p) {
    __shared__ __attribute__((aligned(16))) float lds[NAIVE_LDS_FLOATS];
    const int nM = T / 64;
    for (int u = blockIdx.x; u < nM * 4; u += gridDim.x) { const int g = u & 3, tm = u >> 2;
        ARowPlain ar{(const bf16*)(p.ws + WS_P) + g * 128, PW}; EpiPool ep{(bf16*)(p.ws + WS_CAT), p.pool_scale, g};
        naive_tile<ARowPlain, EpiPool, false>(tm, 0, 128, ar, p.w_pool + (size_t)g * 128 * 128, nullptr, 128, ep, lds); }
}
struct EpiOut { const float* x; float* out; __device__ __forceinline__ void operator()(int r, int c, const float (&a)[4], const float (&)[4]) const {
        const f32x4 xv = *(const f32x4*)(x + (size_t)r * DM + c); f32x4 o = {xv.x + a[0], xv.y + a[1], xv.z + a[2], xv.w + a[3]};
        *(f32x4*)(out + (size_t)r * DM + c) = o; } };
__global__ void __launch_bounds__(512) k_outproj_naive(Params p) {
    __shared__ __attribute__((aligned(16))) float lds[NAIVE_LDS_FLOATS];
    ARowPlain ar{(const bf16*)(p.ws + WS_CAT), DM}; EpiOut ep{p.x, p.out};
    const int nM = T / 64, nN = DM / 128;
    for (int u = blockIdx.x; u < nM * nN; u += gridDim.x) naive_tile<ARowPlain, EpiOut, false>(u / nN, u % nN, DM, ar, p.w_out, nullptr, DM, ep, lds);
}

__global__ void __launch_bounds__(512) k_attn_naive(Params p) {
    __shared__ __attribute__((aligned(16))) float Ks[64 * 68];
    __shared__ __attribute__((aligned(16))) float Vs[64 * 64];
    __shared__ float Ss[64 * 65];
    __shared__ float cs[64];
    const bf16* Q = (const bf16*)(p.ws + WS_Q); const bf16* K = (const bf16*)(p.ws + WS_K); const bf16* V = (const bf16*)(p.ws + WS_V);
    bf16* CAT = (bf16*)(p.ws + WS_CAT); const float* CUM = (const float*)(p.ws + WS_CUM);
    const int tid = threadIdx.x, r = tid >> 3, part = tid & 7;
    for (int u = blockIdx.x; u < BATCH * NH * (SEQ / 64); u += gridDim.x) {
        const int qb = (SEQ / 64 - 1) - (u / (BATCH * NH)), bh = u % (BATCH * NH), b = bh / NH, h = bh % NH;
        const size_t rowbase = (size_t)b * SEQ; const int t = qb * 64 + r;
        float q[64];
        { const bf16* qp = Q + (rowbase + t) * AW + h * HD;
#pragma unroll
          for (int i = 0; i < 64; i += 2) { const unsigned v = *(const unsigned*)(qp + i); q[i] = __builtin_bit_cast(float, v << 16); q[i + 1] = __builtin_bit_cast(float, v & 0xffff0000u); } }
        const float ct = CUM[(size_t)bh * SEQ + t];
        float o[8]; float m = -INFINITY, l = 0.f;
#pragma unroll
        for (int i = 0; i < 8; ++i) o[i] = 0.f;
        for (int kt = 0; kt <= qb; ++kt) {
            __syncthreads();
            { const int kr = tid >> 3, kc = (tid & 7) * 8;
              const u32x4 kv = *(const u32x4*)(K + (rowbase + kt * 64 + kr) * AW + h * HD + kc), vv = *(const u32x4*)(V + (rowbase + kt * 64 + kr) * AW + h * HD + kc);
              const unsigned ka[4] = {kv.x, kv.y, kv.z, kv.w}, va[4] = {vv.x, vv.y, vv.z, vv.w};
#pragma unroll
              for (int i = 0; i < 4; ++i) { Ks[kr * 68 + kc + 2 * i] = __builtin_bit_cast(float, ka[i] << 16); Ks[kr * 68 + kc + 2 * i + 1] = __builtin_bit_cast(float, ka[i] & 0xffff0000u);
                  Vs[kr * 64 + kc + 2 * i] = __builtin_bit_cast(float, va[i] << 16); Vs[kr * 64 + kc + 2 * i + 1] = __builtin_bit_cast(float, va[i] & 0xffff0000u); }
              if (tid < 64) cs[tid] = CUM[(size_t)bh * SEQ + kt * 64 + tid]; }
            __syncthreads();
            float lg[8]; float mx = -INFINITY;
#pragma unroll
            for (int j = 0; j < 8; ++j) { const int s = part * 8 + j; float d = 0.f;
#pragma unroll
                for (int i = 0; i < 64; i += 4) { const f32x4 kk = *(const f32x4*)(Ks + s * 68 + i); d += q[i] * kk.x + q[i + 1] * kk.y + q[i + 2] * kk.z + q[i + 3] * kk.w; }
                d += ct - cs[s]; if (kt * 64 + s > t) d = -INFINITY; lg[j] = d; mx = fmaxf(mx, d); }
            mx = fmaxf(mx, __shfl_xor(mx, 1)); mx = fmaxf(mx, __shfl_xor(mx, 2)); mx = fmaxf(mx, __shfl_xor(mx, 4));
            const float mn = fmaxf(m, mx); const float alpha = exp2f(m - mn); float ps = 0.f;
#pragma unroll
            for (int j = 0; j < 8; ++j) { const float pv = exp2f(lg[j] - mn); ps += pv; Ss[r * 65 + part * 8 + j] = pv; }
            ps += __shfl_xor(ps, 1); ps += __shfl_xor(ps, 2); ps += __shfl_xor(ps, 4);
            l = l * alpha + ps; m = mn;
#pragma unroll
            for (int i = 0; i < 8; ++i) o[i] *= alpha;
            __syncthreads();
            for (int s = 0; s < 64; ++s) { const float pv = Ss[r * 65 + s]; const f32x4 v0 = *(const f32x4*)(Vs + s * 64 + part * 8), v1 = *(const f32x4*)(Vs + s * 64 + part * 8 + 4);
                o[0] += pv * v0.x; o[1] += pv * v0.y; o[2] += pv * v0.z; o[3] += pv * v0.w; o[4] += pv * v1.x; o[5] += pv * v1.y; o[6] += pv * v1.z; o[7] += pv * v1.w; }
        }
        const float il = 1.f / l; u32x4 ov;
        ov.x = pk2(o[0] * il, o[1] * il); ov.y = pk2(o[2] * il, o[3] * il); ov.z = pk2(o[4] * il, o[5] * il); ov.w = pk2(o[6] * il, o[7] * il);
        *(u32x4*)(CAT + (rowbase + t) * DM + PW + h * HD + part * 8) = ov;
    }
}

__global__ void __launch_bounds__(512) k_router(Params p) {
    __shared__ __attribute__((aligned(16))) float wr[1024 * 32];
    __shared__ int ch_e[128 * 4]; __shared__ float ch_g[128 * 4]; __shared__ int lcnt[32], lbase[32];
    const int tid = threadIdx.x, lane = tid & 63, wave = tid >> 6;
    for (int i = tid; i < 1024 * 32 / 4; i += 512) ((f32x4*)wr)[i] = ((const f32x4*)p.w_router)[i];
    __syncthreads();
    const float* X1 = p.out; bf16* H2 = (bf16*)(p.ws + WS_XN);
    int* cnt = (int*)(p.ws + WS_CTL) + CW_CNT; int* SEL = (int*)(p.ws + WS_SEL); int* LTK = (int*)(p.ws + WS_LTK); float* LGT = (float*)(p.ws + WS_LGT);
    f32x4 g[4];
#pragma unroll
    for (int j = 0; j < 4; ++j) g[j] = *(const f32x4*)(p.g_ffn + 4 * lane + 256 * j);
    const float br = p.b_router[lane & 31];
    for (int grp = blockIdx.x; grp < T / 128; grp += gridDim.x) {
        if (tid < 32) lcnt[tid] = 0;
        __syncthreads();
        for (int it = 0; it < 16; ++it) {
            const int lt = wave * 16 + it, m = grp * 128 + lt;
            const float* xr = X1 + (size_t)m * DM;
            f32x4 v[4]; float ss = 0.f;
#pragma unroll
            for (int j = 0; j < 4; ++j) { v[j] = *(const f32x4*)(xr + 4 * lane + 256 * j); ss += v[j].x * v[j].x + v[j].y * v[j].y + v[j].z * v[j].z + v[j].w * v[j].w; }
            const float rstd = rsqrtf(wave_sum(ss) * (1.f / DM) + RMS_EPS);
            float lg[32];
#pragma unroll
            for (int e = 0; e < 32; ++e) lg[e] = 0.f;
#pragma unroll
            for (int j = 0; j < 4; ++j) {
                v[j] = v[j] * rstd * g[j];
                u32x2 o; o.x = pk2(v[j].x, v[j].y); o.y = pk2(v[j].z, v[j].w);
                *(u32x2*)(H2 + (size_t)m * DM + 4 * lane + 256 * j) = o;
#pragma unroll
                for (int i = 0; i < 4; ++i) { const int d = 4 * lane + 256 * j + i; const float hv = v[j][i];
#pragma unroll
                    for (int e4 = 0; e4 < 8; ++e4) { const f32x4 w = *(const f32x4*)(wr + d * 32 + e4 * 4);
                        lg[e4 * 4] += hv * w.x; lg[e4 * 4 + 1] += hv * w.y; lg[e4 * 4 + 2] += hv * w.z; lg[e4 * 4 + 3] += hv * w.w; }
                    asm volatile("" ::: "memory"); }
            }
            float mine;
            {
                float a16[16];
                const bool up = lane >= 32;
#pragma unroll
                for (int e = 0; e < 16; ++e) { const float keep = up ? lg[16 + e] : lg[e], give = up ? lg[e] : lg[16 + e]; a16[e] = keep + __shfl_xor(give, 32); }
                float a8[8]; const bool u16 = (lane & 16) != 0;
#pragma unroll
                for (int e = 0; e < 8; ++e) { const float keep = u16 ? a16[8 + e] : a16[e], give = u16 ? a16[e] : a16[8 + e]; a8[e] = keep + __shfl_xor(give, 16); }
                float a4[4]; const bool u8 = (lane & 8) != 0;
#pragma unroll
                for (int e = 0; e < 4; ++e) { const float keep = u8 ? a8[4 + e] : a8[e], give = u8 ? a8[e] : a8[4 + e]; a4[e] = keep + __shfl_xor(give, 8); }
                float a2[2]; const bool u4 = (lane & 4) != 0;
#pragma unroll
                for (int e = 0; e < 2; ++e) { const float keep = u4 ? a4[2 + e] : a4[e], give = u4 ? a4[e] : a4[2 + e]; a2[e] = keep + __shfl_xor(give, 4); }
                const bool u2 = (lane & 2) != 0;
                float a1 = (u2 ? a2[1] : a2[0]) + __shfl_xor(u2 ? a2[0] : a2[1], 2);
                a1 += __shfl_xor(a1, 1);
                mine = a1;
            }
            const int myexp = ((lane >> 5) & 1) * 16 + ((lane >> 4) & 1) * 8 + ((lane >> 3) & 1) * 4 + ((lane >> 2) & 1) * 2 + ((lane >> 1) & 1);
            float val = mine + p.b_router[myexp]; (void)br;
            if (lane & 1) val = -INFINITY;
            float tv[4]; int ti[4];
#pragma unroll
            for (int k = 0; k < 4; ++k) {
                float bv = val; int bi = myexp;
#pragma unroll
                for (int o = 1; o < 64; o <<= 1) { const float ov = __shfl_xor(bv, o); const int oi = __shfl_xor(bi, o); if (ov > bv || (ov == bv && oi < bi)) { bv = ov; bi = oi; } }
                tv[k] = bv; ti[k] = bi; if (myexp == bi) val = -INFINITY;
            }
            const float e0 = 1.f, e1 = expf(tv[1] - tv[0]), e2 = expf(tv[2] - tv[0]), e3 = expf(tv[3] - tv[0]); const float inv = 1.f / (e0 + e1 + e2 + e3);
            if (lane < 4) { const float gg = (lane == 0 ? e0 : lane == 1 ? e1 : lane == 2 ? e2 : e3) * inv; const int ee = lane == 0 ? ti[0] : lane == 1 ? ti[1] : lane == 2 ? ti[2] : ti[3];
                ch_e[lt * 4 + lane] = ee; ch_g[lt * 4 + lane] = gg; atomicAdd(&lcnt[ee], 1); }
        }
        __syncthreads();
        if (tid < 32) { lbase[tid] = atomicAdd(&cnt[tid], lcnt[tid]); lcnt[tid] = 0; }
        __syncthreads();
        { const int e = ch_e[tid]; const int slot = lbase[e] + atomicAdd(&lcnt[e], 1); const int tk = (grp * 128 + (tid >> 2)) * 4 + (tid & 3);
          LTK[(size_t)e * T + slot] = tk; LGT[(size_t)e * T + slot] = ch_g[tid]; SEL[tk] = (slot << 5) | e; }
        __syncthreads();
    }
}

struct ExpertMap { int cnt[32]; int pstart[33]; };
__device__ __forceinline__ void load_expert_map(const int* cnt, int* s_cnt, int* s_ps) {
    if (threadIdx.x == 0) { int a = 0; for (int e = 0; e < 32; ++e) { const int c = cnt[e]; s_cnt[e] = c; s_ps[e] = a; a += ((c + RT - 1) / RT) * RT; } s_ps[32] = a; }
}
struct ARowGather { const bf16* H2; const int* ltk; int pstart, cnt; __device__ __forceinline__ const bf16* operator()(int r) const { const int s = r - pstart; return s < cnt ? H2 + (size_t)(ltk[s] >> 2) * DM : nullptr; } };
struct EpiUp { bf16* ACT; const float* bu; __device__ __forceinline__ void operator()(int r, int c, const float (&a)[4], const float (&a2)[4]) const {
        const f32x4 bg = *(const f32x4*)(bu + c), bl = *(const f32x4*)(bu + DE + c); float o[4];
#pragma unroll
        for (int i = 0; i < 4; ++i) { const float gl = fminf(a[i] + bg[i], SW_LIMIT), li = fminf(fmaxf(a2[i] + bl[i], -SW_LIMIT), SW_LIMIT); o[i] = gl * (1.f / (1.f + expf(-SW_ALPHA * gl))) * (li + 1.f); }
        u32x2 ov; ov.x = pk2(o[0], o[1]); ov.y = pk2(o[2], o[3]); *(u32x2*)(ACT + (size_t)r * DE + c) = ov; } };
__global__ void __launch_bounds__(512) k_up_naive(Params p) {
    __shared__ __attribute__((aligned(16))) float lds[NAIVE_LDS_FLOATS]; __shared__ int s_cnt[32], s_ps[33];
    load_expert_map((const int*)(p.ws + WS_CTL) + CW_CNT, s_cnt, s_ps); __syncthreads();
    const int ntm = s_ps[32] / 64, nN = DE / 128;
    for (int u = blockIdx.x; u < ntm * nN; u += gridDim.x) { const int tm = u / nN, tn = u % nN; int e = 0; while (s_ps[e + 1] <= tm * 64) ++e;
        if (tm * 64 - s_ps[e] >= s_cnt[e]) continue;
        ARowGather ar{(const bf16*)(p.ws + WS_XN), (const int*)(p.ws + WS_LTK) + (size_t)e * T, s_ps[e], s_cnt[e]}; EpiUp ep{(bf16*)(p.ws + WS_ACT), p.b_up + (size_t)e * 2 * DE};
        naive_tile<ARowGather, EpiUp, true>(tm, tn, DM, ar, p.w_up + (size_t)e * DM * 2 * DE, p.w_up + (size_t)e * DM * 2 * DE + DE, 2 * DE, ep, lds); }
}
struct ARowAct { const bf16* ACT; int pstart, cnt; __device__ __forceinline__ const bf16* operator()(int r) const { return (r - pstart) < cnt ? ACT + (size_t)r * DE : nullptr; } };
struct EpiDown { bf16* Y; const float* bd; const float* lgt; int pstart, cnt; __device__ __forceinline__ void operator()(int r, int c, const float (&a)[4], const float (&)[4]) const {
        const int s = r - pstart; if (s >= cnt) return; const float gt = lgt[s]; const f32x4 b = *(const f32x4*)(bd + c);
        u32x2 ov; ov.x = pk2((a[0] + b.x) * gt, (a[1] + b.y) * gt); ov.y = pk2((a[2] + b.z) * gt, (a[3] + b.w) * gt); *(u32x2*)(Y + (size_t)r * DM + c) = ov; } };
__global__ void __launch_bounds__(512) k_down_naive(Params p) {
    __shared__ __attribute__((aligned(16))) float lds[NAIVE_LDS_FLOATS]; __shared__ int s_cnt[32], s_ps[33];
    load_expert_map((const int*)(p.ws + WS_CTL) + CW_CNT, s_cnt, s_ps); __syncthreads();
    const int ntm = s_ps[32] / 64, nN = DM / 128;
    for (int u = blockIdx.x; u < ntm * nN; u += gridDim.x) { const int tm = u / nN, tn = u % nN; int e = 0; while (s_ps[e + 1] <= tm * 64) ++e;
        if (tm * 64 - s_ps[e] >= s_cnt[e]) continue;
        ARowAct ar{(const bf16*)(p.ws + WS_ACT), s_ps[e], s_cnt[e]}; EpiDown ep{(bf16*)(p.ws + WS_Y), p.b_down + (size_t)e * DM, (const float*)(p.ws + WS_LGT) + (size_t)e * T, s_ps[e], s_cnt[e]};
        naive_tile<ARowAct, EpiDown, false>(tm, tn, DE, ar, p.w_down + (size_t)e * DE * DM, nullptr, DM, ep, lds); }
}

__global__ void __launch_bounds__(512) k_final(Params p) {
    __shared__ int s_cnt[32], s_ps[33];
    load_expert_map((const int*)(p.ws + WS_CTL) + CW_CNT, s_cnt, s_ps); __syncthreads();
    const int tid = threadIdx.x, lane = tid & 63, wave = tid >> 6;
    const int* SEL = (const int*)(p.ws + WS_SEL); const bf16* Y = (const bf16*)(p.ws + WS_Y);
    f32x4 g[4];
#pragma unroll
    for (int j = 0; j < 4; ++j) g[j] = *(const f32x4*)(p.g_final + 4 * lane + 256 * j);
    for (int m = blockIdx.x * 8 + wave; m < T; m += gridDim.x * 8) {
        float* xr = p.out + (size_t)m * DM; f32x4 v[4];
#pragma unroll
        for (int j = 0; j < 4; ++j) v[j] = *(const f32x4*)(xr + 4 * lane + 256 * j);
#pragma unroll
        for (int k = 0; k < 4; ++k) { const int sv = SEL[m * 4 + k]; const int e = sv & 31, slot = sv >> 5; const bf16* yr = Y + (size_t)(s_ps[e] + slot) * DM;
#pragma unroll
            for (int j = 0; j < 4; ++j) { const u32x2 y = *(const u32x2*)(yr + 4 * lane + 256 * j);
                v[j].x += __builtin_bit_cast(float, y.x << 16); v[j].y += __builtin_bit_cast(float, y.x & 0xffff0000u); v[j].z += __builtin_bit_cast(float, y.y << 16); v[j].w += __builtin_bit_cast(float, y.y & 0xffff0000u); } }
        float ss = 0.f;
#pragma unroll
        for (int j = 0; j < 4; ++j) ss += v[j].x * v[j].x + v[j].y * v[j].y + v[j].z * v[j].z + v[j].w * v[j].w;
        const float rstd = rsqrtf(wave_sum(ss) * (1.f / DM) + RMS_EPS);
#pragma unroll
        for (int j = 0; j < 4; ++j) *(f32x4*)(xr + 4 * lane + 256 * j) = v[j] * rstd * g[j];
    }
}

namespace pg8 {
#define PG8_LAS __attribute__((address_space(3)))
typedef unsigned short bf16_t;
typedef short bf16x8 __attribute__((ext_vector_type(8)));
typedef float f32x4 __attribute__((ext_vector_type(4)));
typedef unsigned u32x4 __attribute__((ext_vector_type(4)));
constexpr int BM = 256, BK = 64, HALF = 128, HTB = HALF * BK * 2  , STAGE_BYTES = 8 * HTB, NXCD = 8, WGM = 8;

__host__ __device__ __forceinline__ int lds_byte(int r, int c) { const int st = (r >> 4) * 2 + (c >> 5), rr = r & 15, cc = c & 31, ob = rr * 64 + cc * 2; return st * 1024 + (ob ^ (((ob >> 9) & 1) << 5)); }
__host__ __device__ __forceinline__ void stage_rc(int b, int& R, int& C) { const int st = b / 1024, sb = b % 1024, swz = sb ^ (((sb >> 9) & 1) << 5); R = (st >> 1) * 16 + swz / 64; C = (st & 1) * 32 + (swz % 64) / 2; }
__host__ __device__ __forceinline__ int perm32(int rho) { const int n = rho >> 4, i = rho & 15; return 8 * (i >> 2) + 4 * n + (i & 3); }

struct Unit { int pm, pn, e, lrow0; size_t boff; };
struct Gemm { const bf16_t* A; const bf16_t* Bt; int K; };

struct StaticOrder {
    int nM, nN, nwg, G, c;
    __host__ __device__ void init(int M, int N, int G_, int c_) { nM = M / BM; nN = N / BM; nwg = nM * nN; G = G_; c = c_; }
    __host__ __device__ bool next(int i, Unit& u) const {
        const long L = (long)i * G + c; if (L >= nwg) return false;
        int wgid = (int)L; { const int q = nwg / NXCD, r = nwg % NXCD, xcd = wgid % NXCD, off = wgid / NXCD; wgid = (xcd < r ? xcd * (q + 1) : r * (q + 1) + (xcd - r) * q) + off; }
        const int nig = WGM * nN, gid = wgid / nig, fm = gid * WGM, gsz = (nM - fm) < WGM ? (nM - fm) : WGM;
        u.pm = fm + ((wgid % nig) % gsz); u.pn = (wgid % nig) / gsz; u.e = 0; u.lrow0 = 0; u.boff = 0; return true;
    }
};
template <int NCOL> struct MoeOrder {
    static constexpr int RG = 32 / NCOL;
    const PG8_LAS int* pt; int G, c; size_t bstride;
    __device__ __forceinline__ bool next(int i, Unit& u) const {
        const int nrt = pt[32]; const int x = c & 7, j = c >> 3;
        const int lo = (nrt * x) >> 3, hi = (nrt * (x + 1)) >> 3;
        const int rt = lo + RG * i + j / NCOL; if (rt >= hi) return false;
        int e = 0;
#pragma unroll 1
        for (int k = 1; k < 32; ++k) e += (pt[k] <= rt) ? 1 : 0;
        u.pm = rt; u.pn = j % NCOL; u.e = e; u.lrow0 = (rt - pt[e]) * BM; u.boff = (size_t)e * bstride; return true;
    }
};

__device__ __forceinline__ unsigned cvt_pk_bf16(float lo, float hi) { unsigned r; asm volatile("v_cvt_pk_bf16_f32 %0, %1, %2" : "=v"(r) : "v"(lo), "v"(hi)); return r; }

struct EpiInproj {
    static constexpr bool PERM = true;
    bf16_t* O; size_t split_stride; float qscale;
    __device__ __forceinline__ void operator()(const f32x4 (&acc)[2][2][4][2], const Unit& u, int wr, int wc, int fr, int fq) const {
        const int row0 = u.pm * BM + wr * 64 + fr; int colt = u.pn * BM; const int t = colt >> 9; bf16_t* base = O + (size_t)t * split_stride; colt -= t * 512;
        const float sc = (t == 1) ? qscale : 1.f; const int col0 = colt + wc * 32 + 8 * fq;
#pragma unroll
        for (int ai = 0; ai < 2; ++ai)
#pragma unroll
            for (int m = 0; m < 4; ++m) { bf16_t* rowp = base + (size_t)(row0 + ai * HALF + m * 16) * 512 + col0;
#pragma unroll
                for (int bj = 0; bj < 2; ++bj) { const f32x4 v0 = acc[ai][bj][m][0] * sc, v1 = acc[ai][bj][m][1] * sc;
                    u32x4 w; w.x = cvt_pk_bf16(v0[0], v0[1]); w.y = cvt_pk_bf16(v0[2], v0[3]); w.z = cvt_pk_bf16(v1[0], v1[1]); w.w = cvt_pk_bf16(v1[2], v1[3]);
                    *(u32x4*)(rowp + bj * HALF) = w; } }
    }
};
struct EpiResF32 {
    static constexpr bool PERM = false;
    const float* x; float* out;
    __device__ __forceinline__ void operator()(const f32x4 (&acc)[2][2][4][2], const Unit& u, int wr, int wc, int fr, int fq) const {
        const int row0 = u.pm * BM + wr * 64 + fr, col0 = u.pn * BM + wc * 32 + 4 * fq;
#pragma unroll
        for (int ai = 0; ai < 2; ++ai)
#pragma unroll
            for (int m = 0; m < 4; ++m) { const size_t off = (size_t)(row0 + ai * HALF + m * 16) * 1024 + col0;
#pragma unroll
                for (int bj = 0; bj < 2; ++bj)
#pragma unroll
                    for (int n = 0; n < 2; ++n) { const f32x4 xv = *(const f32x4*)(x + off + bj * HALF + n * 16); *(f32x4*)(out + off + bj * HALF + n * 16) = xv + acc[ai][bj][m][n]; }
                if (m & 1) asm volatile("" ::: "memory"); }
    }
};
__device__ __forceinline__ float swiglu1(float g, float l) {
    const float gl = fminf(g, 7.0f), li = fminf(fmaxf(l, -7.0f), 7.0f);
    const float sg = __builtin_amdgcn_rcpf(1.0f + __builtin_amdgcn_exp2f(gl * (-1.702f * 1.4426950408889634f)));
    return gl * sg * (li + 1.0f);
}
struct EpiSwiglu {
    static constexpr bool PERM = true;
    bf16_t* ACT; const float* bup;
    __device__ __forceinline__ void operator()(const f32x4 (&acc)[2][2][4][2], const Unit& u, int wr, int wc, int fr, int fq) const {
        const int row0 = u.pm * BM + wr * 64 + fr, col0 = u.pn * HALF + wc * 32 + 8 * fq;
        const float* bb = bup + (size_t)u.e * 2048 + col0;
        f32x4 bg[2], bl[2];
#pragma unroll
        for (int n = 0; n < 2; ++n) { bg[n] = *(const f32x4*)(bb + 4 * n); bl[n] = *(const f32x4*)(bb + 1024 + 4 * n); }
#pragma unroll
        for (int ai = 0; ai < 2; ++ai)
#pragma unroll
            for (int m = 0; m < 4; ++m) { bf16_t* rowp = ACT + (size_t)(row0 + ai * HALF + m * 16) * 1024 + col0;
                const f32x4 g0 = acc[ai][0][m][0] + bg[0], g1 = acc[ai][0][m][1] + bg[1], l0 = acc[ai][1][m][0] + bl[0], l1 = acc[ai][1][m][1] + bl[1];
                u32x4 w; w.x = cvt_pk_bf16(swiglu1(g0[0], l0[0]), swiglu1(g0[1], l0[1])); w.y = cvt_pk_bf16(swiglu1(g0[2], l0[2]), swiglu1(g0[3], l0[3]));
                w.z = cvt_pk_bf16(swiglu1(g1[0], l1[0]), swiglu1(g1[1], l1[1])); w.w = cvt_pk_bf16(swiglu1(g1[2], l1[2]), swiglu1(g1[3], l1[3]));
                *(u32x4*)rowp = w; }
    }
};

constexpr float FP8_SA = 4.0f, FP8_SW = 256.0f, FP8_INV = 1.0f / (FP8_SA * FP8_SW);
__device__ __forceinline__ unsigned pack4_fp8(float a, float b, float c, float d) { unsigned p = 0; p = __builtin_amdgcn_cvt_pk_fp8_f32(a, b, p, false); p = __builtin_amdgcn_cvt_pk_fp8_f32(c, d, p, true); return p; }
struct EpiSwiglu8 {
    static constexpr bool PERM = true;
    unsigned char* ACT; const float* bup;
    __device__ __forceinline__ void operator()(const f32x4 (&acc)[2][2][4][2], const Unit& u, int wr, int wc, int fr, int fq) const {
        const int row0 = u.pm * BM + wr * 64 + fr, col0 = u.pn * HALF + wc * 32 + 8 * fq;
        const float* bb = bup + (size_t)u.e * 2048 + col0;
        f32x4 bg[2], bl[2];
#pragma unroll
        for (int n = 0; n < 2; ++n) { bg[n] = *(const f32x4*)(bb + 4 * n); bl[n] = *(const f32x4*)(bb + 1024 + 4 * n); }
#pragma unroll
        for (int ai = 0; ai < 2; ++ai)
#pragma unroll
            for (int m = 0; m < 4; ++m) { unsigned char* rowp = ACT + (size_t)(row0 + ai * HALF + m * 16) * 1024 + col0;
                const f32x4 g0 = acc[ai][0][m][0] * FP8_INV + bg[0], g1 = acc[ai][0][m][1] * FP8_INV + bg[1], l0 = acc[ai][1][m][0] * FP8_INV + bl[0], l1 = acc[ai][1][m][1] * FP8_INV + bl[1];
                typedef unsigned u32x2_t __attribute__((ext_vector_type(2))); u32x2_t w;
                w.x = pack4_fp8(swiglu1(g0[0], l0[0]) * FP8_SA, swiglu1(g0[1], l0[1]) * FP8_SA, swiglu1(g0[2], l0[2]) * FP8_SA, swiglu1(g0[3], l0[3]) * FP8_SA);
                w.y = pack4_fp8(swiglu1(g1[0], l1[0]) * FP8_SA, swiglu1(g1[1], l1[1]) * FP8_SA, swiglu1(g1[2], l1[2]) * FP8_SA, swiglu1(g1[3], l1[3]) * FP8_SA);
                *(u32x2_t*)rowp = w; }
    }
};
struct EpiDown {
    static constexpr bool PERM = true;
    bf16_t* Y; const float* bdn; const float* lgt; const PG8_LAS int* cnt; int Ttok; float ascale;
    __device__ __forceinline__ void operator()(const f32x4 (&acc)[2][2][4][2], const Unit& u, int wr, int wc, int fr, int fq) const {
        const int rl = wr * 64 + fr, col0 = u.pn * BM + wc * 32 + 8 * fq; const int ce = cnt[u.e];
        const float* bb = bdn + (size_t)u.e * 1024 + col0; const float* gp = lgt + (size_t)u.e * Ttok + u.lrow0;
        f32x4 bv[2][2];
#pragma unroll
        for (int bj = 0; bj < 2; ++bj)
#pragma unroll
            for (int n = 0; n < 2; ++n) bv[bj][n] = *(const f32x4*)(bb + bj * HALF + 4 * n);
#pragma unroll
        for (int ai = 0; ai < 2; ++ai)
#pragma unroll
            for (int m = 0; m < 4; ++m) { const int r = rl + ai * HALF + m * 16; const float gt = (u.lrow0 + r < ce) ? gp[r] : 0.f;
                bf16_t* rowp = Y + (size_t)(u.pm * BM + r) * 1024 + col0;
#pragma unroll
                for (int bj = 0; bj < 2; ++bj) { const f32x4 v0 = (acc[ai][bj][m][0] * ascale + bv[bj][0]) * gt, v1 = (acc[ai][bj][m][1] * ascale + bv[bj][1]) * gt;
                    u32x4 w; w.x = cvt_pk_bf16(v0[0], v0[1]); w.y = cvt_pk_bf16(v0[2], v0[3]); w.z = cvt_pk_bf16(v1[0], v1[1]); w.w = cvt_pk_bf16(v1[2], v1[3]);
                    *(u32x4*)(rowp + bj * HALF) = w; } }
    }
};

typedef int v4i_t __attribute__((ext_vector_type(4)));
typedef int v8i_t __attribute__((ext_vector_type(8)));
template <class Epi, class Sched, bool ALIGN_EPI, bool GATHER, bool FP8 = false>
__device__ __forceinline__ void gemm_phase(PG8_LAS unsigned char* lds, const Gemm g, const Sched& S, const Epi& E, const PG8_LAS unsigned* tab) {
    const int tid = threadIdx.x, wid = __builtin_amdgcn_readfirstlane(tid >> 6), lane = tid & 63, wr = wid >> 2, wc = wid & 3, fr = lane & 15, fq = lane >> 4;
    const int K = g.K, nt = K / BK;
    unsigned voffA[2], voffB[2], cby[2]; int rsl[2];
#pragma unroll
    for (int i = 0; i < 2; ++i) { int R, C; stage_rc(tid * 16 + i * 8192, R, C); const int Rb = Epi::PERM ? ((R & ~31) + perm32(R & 31)) : R;
        voffA[i] = (unsigned)(R * K + C) * 2u; voffB[i] = (unsigned)(Rb * K + C) * 2u; rsl[i] = R; cby[i] = (unsigned)C * 2u; }
    const size_t kstep = (size_t)(BK * 2);
    const size_t hstep = (size_t)HALF * K * 2;
    const size_t tstep = 2 * hstep;
    const size_t ahstep = GATHER ? 0 : hstep;
    const unsigned ldsw = (unsigned)wid * 1024u;
    const int aoff = lds_byte(wr * 64 + fr, fq * 8), boff = lds_byte(wc * 32 + fr, fq * 8);
#define PG8_SA(b, h) (((b) * 2 + (h)) * HTB)
#define PG8_SB(b, h) ((4 + (b) * 2 + (h)) * HTB)
#define PG8_STAGE(bufoff, gbase, voff) do { _Pragma("unroll") for (int _i = 0; _i < 2; ++_i) \
        __builtin_amdgcn_global_load_lds((const unsigned*)((const char*)(gbase) + (voff)[_i]), (PG8_LAS unsigned*)(lds + (bufoff) + ldsw + _i * 8192), 16, 0, 0); } while (0)
#define PG8_LD16(off) (*(const PG8_LAS v4i_t*)(lds + (off)))
#define PG8_LDA(dst, b, h) do { _Pragma("unroll") for (int m = 0; m < 4; ++m) { if constexpr (FP8) dst##8[m] = __builtin_shufflevector(PG8_LD16(PG8_SA(b, h) + aoff + m * 2048), PG8_LD16(PG8_SA(b, h) + aoff + m * 2048 + 1024), 0, 1, 2, 3, 4, 5, 6, 7); \
        else { _Pragma("unroll") for (int k = 0; k < 2; ++k) dst[m][k] = *(const PG8_LAS bf16x8*)(lds + PG8_SA(b, h) + aoff + m * 2048 + k * 1024); } } } while (0)
#define PG8_LDB(dst, b, h) do { _Pragma("unroll") for (int n = 0; n < 2; ++n) { if constexpr (FP8) dst##8[n] = __builtin_shufflevector(PG8_LD16(PG8_SB(b, h) + boff + n * 2048), PG8_LD16(PG8_SB(b, h) + boff + n * 2048 + 1024), 0, 1, 2, 3, 4, 5, 6, 7); \
        else { _Pragma("unroll") for (int k = 0; k < 2; ++k) dst[n][k] = *(const PG8_LAS bf16x8*)(lds + PG8_SB(b, h) + boff + n * 2048 + k * 1024); } } } while (0)
#define PG8_MMA(ai, bj, At, Bt) do { __builtin_amdgcn_s_setprio(1); _Pragma("unroll") for (int m = 0; m < 4; ++m) _Pragma("unroll") for (int n = 0; n < 2; ++n) { \
        if constexpr (FP8) asm volatile("s_nop 1\n\tv_mfma_f32_16x16x128_f8f6f4 %0, %1, %2, %0" : "+v"(acc[ai][bj][m][n]) : "v"(Bt##8[n]), "v"(At##8[m]));   \
        else { _Pragma("unroll") for (int k = 0; k < 2; ++k) acc[ai][bj][m][n] = __builtin_amdgcn_mfma_f32_16x16x32_bf16(Bt[n][k], At[m][k], acc[ai][bj][m][n], 0, 0, 0); } } \
        __builtin_amdgcn_s_setprio(0); } while (0)
#define PG8_WAIT_V(n) asm volatile("s_waitcnt vmcnt(" #n ")" ::: "memory")
#define PG8_WAIT_L(n) asm volatile("s_waitcnt lgkmcnt(" #n ")" ::: "memory")
#define PG8_BAR __builtin_amdgcn_s_barrier()
#define PG8_SCHED __builtin_amdgcn_sched_barrier(0)
    Unit cur, nxt; int ui = 0;
    if (!S.next(0, cur)) return;
    f32x4 acc[2][2][4][2];
#pragma unroll
    for (int a = 0; a < 2; ++a)
#pragma unroll
        for (int b = 0; b < 2; ++b)
#pragma unroll
            for (int m = 0; m < 4; ++m)
#pragma unroll
                for (int n = 0; n < 2; ++n) acc[a][b][m][n] = (f32x4){0.f, 0.f, 0.f, 0.f};
    bf16x8 At[4][2], B0[2][2], B1[2][2]; v8i_t At8[4], B08[2], B18[2];
    const char* cA = GATHER ? (const char*)g.A : (const char*)g.A + (size_t)cur.pm * tstep; const char* cB = (const char*)g.Bt + cur.boff + (size_t)cur.pn * tstep;
    unsigned cv0[2], cv1[2], nv0[2], nv1[2];
#pragma unroll
    for (int i = 0; i < 2; ++i) { if constexpr (GATHER) { cv0[i] = tab[rsl[i]] + cby[i]; cv1[i] = tab[HALF + rsl[i]] + cby[i]; } else { cv0[i] = voffA[i]; cv1[i] = voffA[i]; } nv0[i] = cv0[i]; nv1[i] = cv1[i]; }
    PG8_STAGE(PG8_SB(0, 0), cB, voffB); PG8_STAGE(PG8_SB(0, 1), cB + hstep, voffB); PG8_STAGE(PG8_SA(0, 0), cA, cv0); PG8_STAGE(PG8_SA(0, 1), cA + ahstep, cv1);
    if (wr == 1) PG8_BAR;
    PG8_WAIT_V(2); PG8_BAR;
    PG8_STAGE(PG8_SB(1, 0), cB + kstep, voffB); PG8_STAGE(PG8_SA(1, 0), cA + kstep, cv0); PG8_STAGE(PG8_SB(1, 1), cB + hstep + kstep, voffB);
    PG8_WAIT_V(6); PG8_BAR;
    for (;;) {
        const bool has_next = S.next(ui + 1, nxt);
        const char* nA = has_next ? (GATHER ? (const char*)g.A : (const char*)g.A + (size_t)nxt.pm * tstep) : cA; const char* nB = has_next ? (const char*)g.Bt + nxt.boff + (size_t)nxt.pn * tstep : cB;
        if constexpr (GATHER) {
#pragma unroll
            for (int i = 0; i < 2; ++i) { if (has_next) { nv0[i] = tab[(ui + 1) * BM + rsl[i]] + cby[i]; nv1[i] = tab[(ui + 1) * BM + HALF + rsl[i]] + cby[i]; } else { nv0[i] = cv0[i]; nv1[i] = cv1[i]; } }
        }
        for (int t = 0; t < nt; t += 2) {
            const bool last = (t == nt - 2);
            const char* a1 = cA + (size_t)(t + 1) * kstep;
            const char* a2 = last ? nA : cA + (size_t)(t + 2) * kstep; const char* b2 = last ? nB : cB + (size_t)(t + 2) * kstep;
            const char* a3 = a2 + kstep; const char* b3 = b2 + kstep;
            unsigned s0[2], s1[2];
#pragma unroll
            for (int i = 0; i < 2; ++i) { s0[i] = last ? nv0[i] : cv0[i]; s1[i] = last ? nv1[i] : cv1[i]; }
            PG8_LDB(B0, 0, 0); PG8_LDB(B1, 0, 1); PG8_SCHED; PG8_LDA(At, 0, 0); PG8_STAGE(PG8_SA(1, 1), a1 + ahstep, cv1);
            PG8_WAIT_V(8); PG8_WAIT_L(0); PG8_BAR; PG8_MMA(0, 0, At, B0); PG8_MMA(0, 1, At, B1); PG8_BAR; PG8_SCHED;
            PG8_LDA(At, 0, 1); PG8_STAGE(PG8_SB(0, 0), b2, voffB); PG8_STAGE(PG8_SB(0, 1), b2 + hstep, voffB); PG8_STAGE(PG8_SA(0, 0), a2, s0);
            PG8_WAIT_V(8); PG8_WAIT_L(0); PG8_BAR; PG8_MMA(1, 0, At, B0); PG8_MMA(1, 1, At, B1); PG8_BAR; PG8_SCHED;
            PG8_LDB(B0, 1, 0); PG8_LDB(B1, 1, 1); PG8_SCHED; PG8_LDA(At, 1, 0); PG8_STAGE(PG8_SA(0, 1), a2 + ahstep, s1);
            PG8_WAIT_V(8); PG8_WAIT_L(0); PG8_BAR; PG8_MMA(0, 0, At, B0); PG8_MMA(0, 1, At, B1); PG8_BAR; PG8_SCHED;
            PG8_LDA(At, 1, 1); PG8_STAGE(PG8_SB(1, 0), b3, voffB); PG8_STAGE(PG8_SB(1, 1), b3 + hstep, voffB); PG8_STAGE(PG8_SA(1, 0), a3, s0);
            PG8_WAIT_V(8); PG8_WAIT_L(0); PG8_BAR; PG8_MMA(1, 0, At, B0); PG8_MMA(1, 1, At, B1); PG8_BAR; PG8_SCHED;
        }
        if constexpr (FP8) asm volatile("s_nop 15\n\ts_nop 7" ::: "memory");
        if constexpr (ALIGN_EPI) { if (wr == 0) PG8_BAR; }
        E(acc, cur, wr, wc, fr, fq);
        if (!has_next) break;
#pragma unroll
        for (int a = 0; a < 2; ++a)
#pragma unroll
            for (int b = 0; b < 2; ++b)
#pragma unroll
                for (int m = 0; m < 4; ++m)
#pragma unroll
                    for (int n = 0; n < 2; ++n) acc[a][b][m][n] = (f32x4){0.f, 0.f, 0.f, 0.f};
        cur = nxt; cA = nA; cB = nB; ++ui;
#pragma unroll
        for (int i = 0; i < 2; ++i) { cv0[i] = nv0[i]; cv1[i] = nv1[i]; }
        if constexpr (ALIGN_EPI) { if (wr == 1) PG8_BAR; }
    }
    PG8_WAIT_V(0);
    if constexpr (!ALIGN_EPI) { if (wr == 0) PG8_BAR; }
    PG8_BAR;
#undef PG8_SA
#undef PG8_SB
#undef PG8_STAGE
#undef PG8_LDA
#undef PG8_LD16
#undef PG8_LDB
#undef PG8_MMA
#undef PG8_WAIT_V
#undef PG8_WAIT_L
#undef PG8_BAR
#undef PG8_SCHED
}
}
#include <hip/hip_bf16.h>
#include <cmath>
namespace attn_body {
using bf16=__hip_bfloat16;
using bf16x8=__attribute__((ext_vector_type(8)))short;
using s16x4=__attribute__((ext_vector_type(4)))short;
using f32x16=__attribute__((ext_vector_type(16)))float;
using u32x4=__attribute__((ext_vector_type(4)))unsigned;
constexpr int BATCH=4,NHEAD=8,SEQ=8192,D=64,DM=NHEAD*D,ODM=1024;
constexpr int NW=8,QBLK=32,QB=QBLK*NW,KVBLK=64,NQB=SEQ/QB;
constexpr int ATTN_PITCH=DM, ATTN_UNIT_ROWS=QB;
__device__ __forceinline__ int crow(int r,int hi){return (r&3)+8*(r>>2)+4*hi;}
#define SBAR() __builtin_amdgcn_sched_barrier(0)
__device__ __forceinline__ void cmask(f32x16&p0,f32x16&p1,int jb,int qrel,int hi){
  const float NEG=-INFINITY; int kb=64*jb+4*hi;
  #pragma unroll
  for(int r=0;r<16;++r){int kv=kb+(r&3)+8*(r>>2); if(kv>qrel)p0[r]=NEG; if(kv+32>qrel)p1[r]=NEG;}
}

constexpr int NSLOT=3, SLOTB=8192;
constexpr int LDS_K=0, LDS_V=NSLOT*SLOTB, LDS_WS=2*NSLOT*SLOTB, LDS_OST=LDS_WS+NW*64*4, LDS_C2=LDS_OST+NW*4096, LDS_BYTES=LDS_C2+SEQ*4;
constexpr float C2=0.125f*1.4426950408889634f;
__device__ __forceinline__ void glds16(const void*gsrc,unsigned lds_dst){unsigned keep;
  asm volatile("s_mov_b32 %0, m0\n\ts_mov_b32 m0, %2\n\ts_nop 0\n\tglobal_load_lds_dwordx4 %1, off\n\ts_mov_b32 m0, %0":"=&s"(keep):"v"(gsrc),"s"(lds_dst):"memory");}
__device__ __forceinline__ float max3f(float a,float b,float c){float r;asm("v_max3_f32 %0, %1, %2, %3":"=v"(r):"v"(a),"v"(b),"v"(c));return r;}
__device__ __forceinline__ float max2f(float a,float b){float r;asm("v_max_f32_e32 %0, %1, %2":"=v"(r):"v"(a),"v"(b));return r;}
__device__ __forceinline__ float fadd_s(float a,float b){float r;asm("v_add_f32_e32 %0, %1, %2":"=v"(r):"v"(a),"v"(b));return r;}
__device__ __forceinline__ float fsub_s(float a,float b){float r;asm("v_sub_f32_e32 %0, %1, %2":"=v"(r):"v"(a),"v"(b));return r;}
typedef float f32x2_t __attribute__((ext_vector_type(2))); typedef float f32x4_t __attribute__((ext_vector_type(4))); typedef __bf16 bf16x2_t __attribute__((ext_vector_type(2)));
__device__ __forceinline__ unsigned cvtpk_s(float lo,float hi){f32x2_t v={lo,hi};bf16x2_t b=__builtin_convertvector(v,bf16x2_t);return __builtin_bit_cast(unsigned,b);}
#define WAIT_BAR(N) asm volatile("s_waitcnt vmcnt(" #N ") lgkmcnt(0)\n\ts_barrier":::"memory")

__device__ __forceinline__ void qkt(f32x16&p0,f32x16&p1,const char*Kslot,const bf16x8*qr,const f32x16&cin0,const f32x16&cin1,int r32,int hi){
  const char*kb=Kslot+hi*1024+r32*16;
  #pragma unroll
  for(int d0=0;d0<4;++d0){
    const bf16x8 b0=*reinterpret_cast<const bf16x8*>(kb+d0*2048);
    const bf16x8 b1=*reinterpret_cast<const bf16x8*>(kb+d0*2048+512);
    if(d0==0){p0=__builtin_amdgcn_mfma_f32_32x32x16_bf16(b0,qr[0],cin0,0,0,0);p1=__builtin_amdgcn_mfma_f32_32x32x16_bf16(b1,qr[0],cin1,0,0,0);}
    else{p0=__builtin_amdgcn_mfma_f32_32x32x16_bf16(b0,qr[d0],p0,0,0,0);p1=__builtin_amdgcn_mfma_f32_32x32x16_bf16(b1,qr[d0],p1,0,0,0);}}
}
typedef __attribute__((address_space(3))) const char* lds_cptr;
typedef short v4i16_t __attribute__((ext_vector_type(4)));
__device__ __forceinline__ void kload8(bf16x8*kf,lds_cptr kp){
  kf[0]=*(const __attribute__((address_space(3))) bf16x8*)(kp);      kf[1]=*(const __attribute__((address_space(3))) bf16x8*)(kp+512);
  kf[2]=*(const __attribute__((address_space(3))) bf16x8*)(kp+2048); kf[3]=*(const __attribute__((address_space(3))) bf16x8*)(kp+2560);
  kf[4]=*(const __attribute__((address_space(3))) bf16x8*)(kp+4096); kf[5]=*(const __attribute__((address_space(3))) bf16x8*)(kp+4608);
  kf[6]=*(const __attribute__((address_space(3))) bf16x8*)(kp+6144); kf[7]=*(const __attribute__((address_space(3))) bf16x8*)(kp+6656);
}
__device__ __forceinline__ void kload2(bf16x8*kf,lds_cptr kp,int j){ kf[2*j]=*(const __attribute__((address_space(3))) bf16x8*)(kp+j*2048); kf[2*j+1]=*(const __attribute__((address_space(3))) bf16x8*)(kp+j*2048+512); }
__device__ __forceinline__ s16x4 vtr(lds_cptr p){ return __builtin_bit_cast(s16x4,__builtin_amdgcn_ds_read_tr16_b64_v4i16((__attribute__((address_space(3))) v4i16_t*)p)); }
__device__ __forceinline__ float rowmax(const f32x16&p0,const f32x16&p1){
  float a=max3f(p0[0],p0[1],p1[0]),b=max3f(p0[2],p0[3],p1[1]);a=max3f(a,p1[2],p1[3]);
  #pragma unroll
  for(int r=4;r<16;r+=4){a=max3f(a,p0[r],p0[r+1]);b=max3f(b,p0[r+2],p0[r+3]);a=max3f(a,p1[r],p1[r+1]);b=max3f(b,p1[r+2],p1[r+3]);}
  const float m=max2f(a,b);
  auto rr=__builtin_amdgcn_permlane32_swap(__float_as_uint(m),__float_as_uint(m),false,false);
  return max2f(__uint_as_float(rr[0]),__uint_as_float(rr[1]));
}
__device__ __forceinline__ void pv(f32x16*o,int vb,bf16x8 pa0,bf16x8 pa1,bf16x8 pa2,bf16x8 pa3){
  #pragma unroll
  for(int d0=0;d0<2;++d0){s16x4 lo[4],hi[4];
    #pragma unroll
    for(int ks=0;ks<4;++ks){
      asm volatile("ds_read_b64_tr_b16 %0,%1 offset:%c2":"=&v"(lo[ks]):"v"(vb),"i"(d0*4096+ks*1024):"memory");
      asm volatile("ds_read_b64_tr_b16 %0,%1 offset:%c2":"=&v"(hi[ks]):"v"(vb),"i"(d0*4096+ks*1024+512):"memory");}
    asm volatile("s_waitcnt lgkmcnt(0)":::"memory");SBAR();
    #define PK(k) (bf16x8){lo[k][0],lo[k][1],lo[k][2],lo[k][3],hi[k][0],hi[k][1],hi[k][2],hi[k][3]}
    o[d0]=__builtin_amdgcn_mfma_f32_32x32x16_bf16(pa0,PK(0),o[d0],0,0,0);
    o[d0]=__builtin_amdgcn_mfma_f32_32x32x16_bf16(pa1,PK(1),o[d0],0,0,0);
    o[d0]=__builtin_amdgcn_mfma_f32_32x32x16_bf16(pa2,PK(2),o[d0],0,0,0);
    o[d0]=__builtin_amdgcn_mfma_f32_32x32x16_bf16(pa3,PK(3),o[d0],0,0,0);
    #undef PK
  }
}

#ifndef ATTN_STORE16
#define ATTN_STORE16(p,v) (*(u32x4*)(p)=(v))
#endif
template<int THRL> __device__ __forceinline__ void attn_unit(int b,int h,int qb,const bf16*Q,const bf16*__restrict__ K,const bf16*__restrict__ V,bf16*O,char*shm,float qkb2){
  const int tid=threadIdx.x,lane=tid&63,r32=lane&31,hi=lane>>5; const int wid=__builtin_amdgcn_readfirstlane(tid>>6);
  const long rowbase=(long)b*SEQ; const int q0=qb*QB;
  const bf16*Qw=Q+(rowbase+q0+wid*QBLK)*DM+h*D;
  const bf16*Kh=K+rowbase*DM+h*D,*Vh=V+rowbase*DM+h*D;
  const unsigned lds0=(unsigned)(uintptr_t)shm; const lds_cptr shm3=(lds_cptr)shm;
  float*wsf=(float*)(shm+LDS_WS)+wid*64;
  const bf16*ksrc=Kh+(long)lane*DM+wid*8;
  const bf16*vsrc=Vh+(long)(16*(wid&3)+(lane>>2))*DM+(wid>>2)*32+(lane&3)*8;
  const unsigned kdst=lds0+LDS_K+wid*1024, vdst=lds0+LDS_V+wid*1024;
  #define DMA_K(t,slot) glds16(ksrc+(long)(t)*KVBLK*DM,(unsigned)__builtin_amdgcn_readfirstlane(kdst+(slot)))
  #define DMA_V(t,slot) glds16(vsrc+(long)(t)*KVBLK*DM,(unsigned)__builtin_amdgcn_readfirstlane(vdst+(slot)))
  const int vb0=(int)(lds0+LDS_V)+((lane>>4)&1)*32+(lane&3)*8+(4*hi+((lane&15)>>2))*64;
  const char*Kbase=shm+LDS_K; bf16x8 kf[8];
  const lds_cptr kp0=shm3+LDS_K+hi*1024+r32*16; const lds_cptr vp0=shm3+LDS_V+((lane>>4)&1)*32+(lane&3)*8+(4*hi+((lane&15)>>2))*64;
  const int NT=(q0+QB)/KVBLK;
  int j0=0;
  { const __attribute__((address_space(3))) float* c2f=(const __attribute__((address_space(3))) float*)((lds_cptr)shm+LDS_C2); const float cq=c2f[q0]+qkb2+64.0f;
    int lo_=0,hi_=(NT-4)>>1;
    while(lo_<hi_){ const int mid=(lo_+hi_+1)>>1; if(cq-c2f[128*mid-1]<0.f)lo_=mid; else hi_=mid-1; }
    j0=__builtin_amdgcn_readfirstlane(2*lo_); }
  DMA_K(j0,0);DMA_V(j0,0);DMA_K(j0+1,SLOTB);
  bf16x8 qr[4];
  #pragma unroll
  for(int d0=0;d0<4;++d0)qr[d0]=*reinterpret_cast<const bf16x8*>(&Qw[(long)r32*DM+d0*16+hi*8]);
  float l_reg=0.f;f32x16 o[2];o[0]=f32x16{};o[1]=f32x16{};
  typedef __attribute__((address_space(3))) const f32x4_t* lds_f4ptr; const lds_f4ptr c2p=(lds_f4ptr)(shm3+LDS_C2)+hi;
  float ctm=((const __attribute__((address_space(3))) float*)(shm3+LDS_C2))[q0+wid*QBLK+r32];
  f32x16 cin0,cin1;
  #define CIN(t) do{ const lds_f4ptr cq_=c2p+16*(t); const f32x4_t a0_=cq_[0],a1_=cq_[2],a2_=cq_[4],a3_=cq_[6],b0_=cq_[8],b1_=cq_[10],b2_=cq_[12],b3_=cq_[14]; \
    _Pragma("unroll") for(int j_=0;j_<4;++j_){ cin0[j_]=ctm-a0_[j_];cin0[4+j_]=ctm-a1_[j_];cin0[8+j_]=ctm-a2_[j_];cin0[12+j_]=ctm-a3_[j_]; cin1[j_]=ctm-b0_[j_];cin1[4+j_]=ctm-b1_[j_];cin1[8+j_]=ctm-b2_[j_];cin1[12+j_]=ctm-b3_[j_]; } }while(0)
  const int qrel=wid*QBLK+r32;
  #define CMASK(P0,P1,t) do{int jb_=(t)-(NT-4); if(jb_>=0)cmask(P0,P1,jb_,qrel,hi);}while(0)
  bool resc=false;
  #define START(P0,P1) do{ const float rm=rowmax(P0,P1); resc=false; \
    if(__any(rm>(float)THRL)){ const float dl=__builtin_fmaxf(rm,0.f); ctm-=dl; \
      _Pragma("unroll") for(int r=0;r<16;++r){P0[r]-=dl;P1[r]-=dl;} } \
    _Pragma("unroll") for(int r=0;r<16;++r)P0[r]=__builtin_amdgcn_exp2f(P0[r]); }while(0)
  #define RESC() do{ if(resc){ asm volatile("s_waitcnt lgkmcnt(0)":::"memory"); \
      _Pragma("unroll") for(int d_=0;d_<2;++d_) _Pragma("unroll") for(int r=0;r<16;++r)o[d_][r]*=wsf[crow(r,hi)]; } }while(0)
  f32x16 pA0,pA1,pB0,pB1;
  int sl_prev=0,sl_cur=0,sl_next=SLOTB;
  #define ROT() do{sl_prev=sl_cur;sl_cur=sl_next;sl_next=(sl_next==(NSLOT-1)*SLOTB)?0:sl_next+SLOTB;}while(0)
  DMA_K(j0+2,2*SLOTB);
  WAIT_BAR(3);
  CIN(j0); qkt(pA0,pA1,Kbase,qr,cin0,cin1,r32,hi);asm volatile("s_nop 15\n\ts_nop 7":"+v"(pA0),"+v"(pA1));CMASK(pA0,pA1,j0);
  START(pA0,pA1);
  _Pragma("unroll") for(int r=0;r<16;++r)pA1[r]=__builtin_amdgcn_exp2f(pA1[r]);
  WAIT_BAR(0);
  DMA_K(j0+3,0);DMA_V(j0+1,SLOTB);
  ROT();
  kload8(kf,kp0+sl_cur);
  WAIT_BAR(2);
  s16x4 vlo[8],vhi[8]; u32x4 pw0,pw1,pw2,pw3;
  #define PKW(P,B) cvtpk_s(P[B],P[B+1])
  #define PAF(k) __builtin_bit_cast(bf16x8,pw##k)
  #define VFR(i) (bf16x8){vlo[i][0],vlo[i][1],vlo[i][2],vlo[i][3],vhi[i][0],vhi[i][1],vhi[i][2],vhi[i][3]}
  #define PIN(x) asm volatile("":"+v"(x))
  #define MX3(a,b,c) __builtin_fmaxf(__builtin_fmaxf((a),(b)),(c))
  #define GAPA(MF,A0,A1,A2,A3,W0,W1,PW) do{ MF; sacc+=A0; sacc+=A1; sacc+=A2; sacc+=A3; PIN(sacc); W0; W1; PIN(PW); SBAR(); }while(0)
  #define EX(v) __builtin_amdgcn_exp2f(v)
  #define GAPB(MF,X,B) do{ MF; X[B]=EX(X[B]); X[B+1]=EX(X[B+1]); X[B+2]=EX(X[B+2]); X[B+3]=EX(X[B+3]); PIN(X); SBAR(); }while(0)
  #define VRD(i) do{ vlo[i]=vtr(vp_+(((i)>>2)*4096+((i)&3)*1024)); vhi[i]=vtr(vp_+(((i)>>2)*4096+((i)&3)*1024+512)); }while(0)
  #define KRD(G,j) do{ if(G){ kload2(kf,kp0+sl_next,j); SBAR(); } }while(0)
  #define STEP(C0,C1,P0,P1,t,GK,GV,GL) do{ SBAR(); CIN(t); SBAR(); \
    const lds_cptr vp_=vp0+sl_prev; \
    VRD(0); SBAR(); float sacc=(P0[0]+P0[1]); \
    GAPA(C0=__builtin_amdgcn_mfma_f32_32x32x16_bf16(kf[0],qr[0],cin0,0,0,0), P0[2],P0[3],P0[4],P0[5],     pw0[0]=PKW(P0,0), pw0[1]=PKW(P0,2), pw0); \
    VRD(4); SBAR(); GAPA(C1=__builtin_amdgcn_mfma_f32_32x32x16_bf16(kf[1],qr[0],cin1,0,0,0), P0[6],P0[7],P0[8],P0[9],     pw0[2]=PKW(P0,4), pw0[3]=PKW(P0,6), pw0); \
    VRD(1); SBAR(); GAPA(C0=__builtin_amdgcn_mfma_f32_32x32x16_bf16(kf[2],qr[1],C0,0,0,0),   P0[10],P0[11],P0[12],P0[13], pw1[0]=PKW(P0,8), pw1[1]=PKW(P0,10), pw1); \
    VRD(5); SBAR(); GAPA(C1=__builtin_amdgcn_mfma_f32_32x32x16_bf16(kf[3],qr[1],C1,0,0,0),   P0[14],P0[15],P1[0],P1[1],   pw1[2]=PKW(P0,12),pw1[3]=PKW(P0,14), pw1); \
    VRD(2); SBAR(); GAPA(C0=__builtin_amdgcn_mfma_f32_32x32x16_bf16(kf[4],qr[2],C0,0,0,0),   P1[2],P1[3],P1[4],P1[5],     pw2[0]=PKW(P1,0), pw2[1]=PKW(P1,2), pw2); \
    VRD(6); SBAR(); GAPA(C1=__builtin_amdgcn_mfma_f32_32x32x16_bf16(kf[5],qr[2],C1,0,0,0),   P1[6],P1[7],P1[8],P1[9],     pw2[2]=PKW(P1,4), pw2[3]=PKW(P1,6), pw2); \
    VRD(3); SBAR(); GAPA(C0=__builtin_amdgcn_mfma_f32_32x32x16_bf16(kf[6],qr[3],C0,0,0,0),   P1[10],P1[11],P1[12],P1[13], pw3[0]=PKW(P1,8), pw3[1]=PKW(P1,10), pw3); \
    VRD(7); SBAR(); GAPA(C1=__builtin_amdgcn_mfma_f32_32x32x16_bf16(kf[7],qr[3],C1,0,0,0),   P1[14],P1[15],0.f,0.f,       pw3[2]=PKW(P1,12),pw3[3]=PKW(P1,14), pw3); \
    l_reg+=sacc; \
    if(GK){DMA_K((t)+3,sl_cur);} if(GV){DMA_V((t)+1,sl_next);} \
    CMASK(C0,C1,t); \
    { float a=MX3(C0[0],C0[1],C1[0]),b=MX3(C0[2],C0[3],C1[1]); a=MX3(a,C1[2],C1[3]); \
      _Pragma("unroll") for(int r=4;r<16;r+=4){a=MX3(a,C0[r],C0[r+1]);b=MX3(b,C0[r+2],C0[r+3]);a=MX3(a,C1[r],C1[r+1]);b=MX3(b,C1[r+2],C1[r+3]);} \
      float rm=__builtin_fmaxf(a,b); { auto rr=__builtin_amdgcn_permlane32_swap(__float_as_uint(rm),__float_as_uint(rm),false,false); rm=__builtin_fmaxf(__uint_as_float(rr[0]),__uint_as_float(rr[1])); } \
      resc=false; \
      if(__builtin_expect(__any(rm>(float)THRL),0)){ const float dl=__builtin_fmaxf(rm,0.f); ctm-=dl; \
        _Pragma("unroll") for(int r=0;r<16;++r){C0[r]-=dl;C1[r]-=dl;} \
        const float f=__builtin_amdgcn_exp2f(-dl); l_reg*=f; if(hi==0)wsf[r32]=f; resc=true; } } \
    SBAR(); \
    GAPB(o[0]=__builtin_amdgcn_mfma_f32_32x32x16_bf16(PAF(0),VFR(0),o[0],0,0,0), C0,0); \
    GAPB(o[1]=__builtin_amdgcn_mfma_f32_32x32x16_bf16(PAF(0),VFR(4),o[1],0,0,0), C0,4); \
    KRD(GL,0); GAPB(o[0]=__builtin_amdgcn_mfma_f32_32x32x16_bf16(PAF(1),VFR(1),o[0],0,0,0), C0,8); \
    KRD(GL,1); GAPB(o[1]=__builtin_amdgcn_mfma_f32_32x32x16_bf16(PAF(1),VFR(5),o[1],0,0,0), C0,12); \
    KRD(GL,2); GAPB(o[0]=__builtin_amdgcn_mfma_f32_32x32x16_bf16(PAF(2),VFR(2),o[0],0,0,0), C1,0); \
    KRD(GL,3); GAPB(o[1]=__builtin_amdgcn_mfma_f32_32x32x16_bf16(PAF(2),VFR(6),o[1],0,0,0), C1,4); \
    GAPB(o[0]=__builtin_amdgcn_mfma_f32_32x32x16_bf16(PAF(3),VFR(3),o[0],0,0,0), C1,8); \
    GAPB(o[1]=__builtin_amdgcn_mfma_f32_32x32x16_bf16(PAF(3),VFR(7),o[1],0,0,0), C1,12); \
    }while(0)
  int t=j0+1;
  #undef CMASK
  #define CMASK(P0,P1,t) do{}while(0)
  for(;t+5<NT;t+=2){
    STEP(pB0,pB1,pA0,pA1,t,true,true,true);     WAIT_BAR(2); RESC(); ROT();
    STEP(pA0,pA1,pB0,pB1,t+1,true,true,true);   WAIT_BAR(2); RESC(); ROT();
  }
  #undef CMASK
  #define CMASK(P0,P1,t) do{int jb_=(t)-(NT-4); if(jb_>=0)cmask(P0,P1,jb_,qrel,hi);}while(0)
  #define ENDW(tt) do{ if((tt)+3<NT){WAIT_BAR(2);} else if((tt)+2<NT){WAIT_BAR(1);} else {WAIT_BAR(0);} }while(0)
  for(;t+1<NT;t+=2){
    STEP(pB0,pB1,pA0,pA1,t,(t+3<NT),(t+1<NT),(t+1<NT));       ENDW(t);   RESC(); ROT();
    STEP(pA0,pA1,pB0,pB1,t+1,(t+4<NT),(t+2<NT),(t+2<NT));     ENDW(t+1); RESC(); ROT();
  }
  STEP(pB0,pB1,pA0,pA1,NT-1,false,false,false); RESC();
  { float sacc=pB0[0]+pB0[1]; _Pragma("unroll") for(int r=2;r<16;++r)sacc+=pB0[r]; _Pragma("unroll") for(int r=0;r<16;++r)sacc+=pB1[r]; l_reg+=sacc;
    pw0=(u32x4){PKW(pB0,0),PKW(pB0,2),PKW(pB0,4),PKW(pB0,6)};pw1=(u32x4){PKW(pB0,8),PKW(pB0,10),PKW(pB0,12),PKW(pB0,14)};pw2=(u32x4){PKW(pB1,0),PKW(pB1,2),PKW(pB1,4),PKW(pB1,6)};pw3=(u32x4){PKW(pB1,8),PKW(pB1,10),PKW(pB1,12),PKW(pB1,14)};
    SBAR(); pv(o,vb0+sl_cur,PAF(0),PAF(1),PAF(2),PAF(3)); }
  #undef PKW
  #undef PAF
  #undef VFR
  #undef PIN
  #undef MX3
  #undef GAPA
  #undef GAPB
  #undef EX
  #undef VRD
  #undef KRD
  #undef STEP
  #undef ENDW
  {auto rr=__builtin_amdgcn_permlane32_swap(__float_as_uint(l_reg),__float_as_uint(l_reg),false,false);l_reg=__uint_as_float(rr[0])+__uint_as_float(rr[1]);}
  if(hi==0)wsf[32+r32]=l_reg;asm volatile("s_waitcnt lgkmcnt(0)":::"memory");
  float rli[16];
  #pragma unroll
  for(int r=0;r<16;++r)rli[r]=__builtin_amdgcn_rcpf(wsf[32+crow(r,hi)]);
  bf16*Ow=O+(rowbase+q0+wid*QBLK)*ODM+h*D;
  { bf16*stg=(bf16*)(shm+LDS_OST)+wid*2048;
    #pragma unroll
    for(int r=0;r<16;++r){const int orow=crow(r,hi);
      #pragma unroll
      for(int d0=0;d0<2;++d0)stg[orow*64+d0*32+r32]=__float2bfloat16(o[d0][r]*rli[r]);}
    asm volatile("s_waitcnt lgkmcnt(0)":::"memory");
    #pragma unroll
    for(int i=0;i<4;++i){const int row=i*8+(lane>>3),ch=lane&7; const u32x4 v=*(const u32x4*)(stg+row*64+ch*8); ATTN_STORE16(Ow+(long)row*ODM+ch*8,v);} }
  asm volatile("s_waitcnt lgkmcnt(0)\n\ts_barrier":::"memory");
  #undef CIN
  #undef DMA_K
  #undef DMA_V
  #undef CMASK
  #undef START
  #undef RESC
  #undef ROT
}
constexpr int ATTN_LDS_BYTES=LDS_BYTES;
struct AttnTensors { const bf16* Q; const bf16* K; const bf16* V; bf16* O; };
struct AttnUnit { int bh; int qb; };
struct StaticOrder {
  int vcu;
  __device__ __forceinline__ explicit StaticOrder(int grid,int block):vcu((block%8)*(grid/8)+block/8){}
  __device__ __forceinline__ bool next(int i,AttnUnit&u)const{ if(i>=4)return false; const int s=vcu&7; u.bh=vcu>>3; u.qb=(i==0)?s:(i==1)?15-s:(i==2)?16+s:31-s; return true; }
  __device__ __forceinline__ void a_ready(const AttnUnit&)const{}
  __device__ __forceinline__ void done(const AttnUnit&)const{}
};
template<class Sched,int THRL=8> __device__ __forceinline__ void attn_phase(char*lds,const AttnTensors&T,const Sched&S,float qkb2){
  AttnUnit u;
  for(int i=0;S.next(i,u);++i){ S.a_ready(u); attn_unit<THRL>(u.bh/NHEAD,u.bh%NHEAD,u.qb,T.Q,T.K,T.V,T.O,lds,qkb2); S.done(u); }
}
#undef SBAR
#undef WAIT_BAR
}
#define GAS __attribute__((address_space(1)))
#define LAS __attribute__((address_space(3)))
typedef GAS unsigned gu32;
#define RLX_AGENT __ATOMIC_RELAXED, __HIP_MEMORY_SCOPE_AGENT
#define LDS_WAIT() asm volatile("s_waitcnt lgkmcnt(0)" ::: "memory")
#define VM_WAIT() asm volatile("s_waitcnt vmcnt(0)" ::: "memory")

constexpr int NWAVES = 8;
constexpr int N_PHASES = 8;
constexpr int RING_OFF = 0, RING_BYTES = 131072;
constexpr int TAB_OFF = 131072, TAB_UNITS = 17;
constexpr int RT_WROW = 36, RT_CHE = 1024 * RT_WROW * 4, RT_CHG = RT_CHE + 2048, RT_LCNT = RT_CHG + 2048, RT_LBASE = RT_LCNT + 128;
constexpr int LDS_TOTAL = 155648;
constexpr int LDSCTL_OFF = LDS_TOTAL - 1024;
static_assert(TAB_OFF + TAB_UNITS * 256 * 4 <= LDSCTL_OFF && RT_LBASE + 128 <= LDSCTL_OFF, "LDS map");
constexpr int CW_BAR = 4096;

#define XB_TMO      128
#define XB_XCNT(j)  (256  + 64 * (j))
#define XB_XSUB(j)  (1280 + 64 * (j))
#define XB_XGEN(j)  (2304 + 64 * (j))
#define XB_TOP      3328
#define XB_TOPGEN   3392
#define XCD_BAR_WORDS 3456
#define XB_SPIN_CAP (1u << 18)

__device__ __forceinline__ unsigned xb_ld(unsigned* p)              { return __hip_atomic_load(p, __ATOMIC_RELAXED, __HIP_MEMORY_SCOPE_AGENT); }
__device__ __forceinline__ unsigned xb_add(unsigned* p, unsigned v) { return __hip_atomic_fetch_add(p, v, __ATOMIC_RELAXED, __HIP_MEMORY_SCOPE_AGENT); }
__device__ __forceinline__ unsigned xb_xcc_id() { return (unsigned)__builtin_amdgcn_s_getreg((3 << 11) | 20) & 0xFu; }
#define XB_SPIN(cond, bar) do { unsigned _sp = 0; while (cond) { __builtin_amdgcn_s_sleep(1); \
    if ((++_sp & 255u) == 0u) { if (xb_ld(&(bar)[XB_TMO])) break; if (_sp > XB_SPIN_CAP) { atomicAdd(&(bar)[XB_TMO], 1u); break; } } } } while (0)

struct XcdBarrier {
    unsigned* bar; unsigned x;
    volatile LAS unsigned* st;
};

__device__ __forceinline__ XcdBarrier xcd_barrier_post(unsigned* bar, volatile LAS unsigned* st) {
    XcdBarrier b; b.bar = bar; b.x = xb_xcc_id(); b.st = st;
    if (threadIdx.x == 0) (void)xb_add(&bar[XB_XCNT(b.x)], 1u);
    return b;
}
__device__ __forceinline__ void xcd_barrier_complete(unsigned* bar, unsigned x, unsigned& nloc, unsigned& nx) {
    const unsigned G = gridDim.x * gridDim.y * gridDim.z;
    unsigned sum, cnt, mine, sp = 0u;
    for (;;) {
        sum = 0u; cnt = 0u; mine = 0u;
#pragma unroll
        for (unsigned j = 0; j < 16; ++j) { const unsigned c = xb_ld(&bar[XB_XCNT(j)]); sum += c; cnt += (c > 0u) ? 1u : 0u; mine = (j == x) ? c : mine; }
        if (sum == G) break;
        __builtin_amdgcn_s_sleep(1);
        if ((++sp & 255u) == 0u) { if (xb_ld(&bar[XB_TMO])) break; if (sp > XB_SPIN_CAP) { atomicAdd(&bar[XB_TMO], 1u); break; } }
    }
    nloc = mine > 0u ? mine : 1u; nx = cnt > 0u ? cnt : 1u;
}

__device__ __forceinline__ void xcd_barrier(const XcdBarrier& b) {
    asm volatile("s_waitcnt vmcnt(0)" ::: "memory");
    __syncthreads();
    if (threadIdx.x == 0) {
        unsigned* bar = b.bar;
        __builtin_amdgcn_s_waitcnt(0);
        unsigned nloc = b.st[0], nx = b.st[1];
        if (nloc == 0u) { xcd_barrier_complete(bar, b.x, nloc, nx); b.st[0] = nloc; b.st[1] = nx; }
        const unsigned old = xb_add(&bar[XB_XSUB(b.x)], 1u);
        const unsigned gen = old / nloc;
        if (old + 1u == (gen + 1u) * nloc) {
            __builtin_amdgcn_fence(__ATOMIC_RELEASE, "agent");
            asm volatile("s_waitcnt vmcnt(0)" ::: "memory");
            const unsigned og = xb_add(&bar[XB_TOP], 1u);
            const unsigned tg = og / nx;
            if (og + 1u == (tg + 1u) * nx) xb_add(&bar[XB_TOPGEN], 1u);
            else XB_SPIN(xb_ld(&bar[XB_TOPGEN]) == tg, bar);
            __builtin_amdgcn_fence(__ATOMIC_ACQUIRE, "agent");
            xb_add(&bar[XB_XGEN(b.x)], 1u);
            asm volatile("s_waitcnt vmcnt(0)" ::: "memory");
        } else {
            XB_SPIN(xb_ld(&bar[XB_XGEN(b.x)]) == gen, bar);
            __builtin_amdgcn_fence(__ATOMIC_ACQUIRE, "agent");
            asm volatile("s_waitcnt vmcnt(0)" ::: "memory");
        }
    }
    __syncthreads();
}


struct Args { const float* in[15]; float* out; unsigned char* ws; int ph_lo, ph_hi, use_bar, pad; };

__device__ __forceinline__ void p0_transpose_item(const float* W, int ldw, bf16* WT, int ldt, LAS float* scr, int lane) {
    float tv[32];
    const float* wp_ = W + (size_t)(lane >> 5) * ldw + (lane & 31);
#pragma unroll
    for (int i = 0; i < 32; ++i) tv[i] = wp_[(size_t)(2 * i) * ldw];
#pragma unroll
    for (int i = 0; i < 32; ++i) scr[(2 * i + (lane >> 5)) * 33 + (lane & 31)] = tv[i];
    LDS_WAIT(); asm volatile("" ::: "memory");
    const int c = lane & 7;
#pragma unroll
    for (int j = 0; j < 4; ++j) { const int n = (lane >> 3) + 8 * j; const LAS float* s = scr + (8 * c) * 33 + n;
        u32x4 o; o.x = pg8::cvt_pk_bf16(s[0 * 33], s[1 * 33]); o.y = pg8::cvt_pk_bf16(s[2 * 33], s[3 * 33]); o.z = pg8::cvt_pk_bf16(s[4 * 33], s[5 * 33]); o.w = pg8::cvt_pk_bf16(s[6 * 33], s[7 * 33]);
        *(GAS u32x4*)(WT + (size_t)n * ldt + 8 * c) = o; }
    LDS_WAIT(); asm volatile("" ::: "memory");
}
__device__ __forceinline__ void p0_transpose_item_fp8(const float* W, int ldw, unsigned char* WT, int ldt, LAS float* scr, int lane) {
    float tv[32];
    const float* wp_ = W + (size_t)(lane >> 5) * ldw + (lane & 31);
#pragma unroll
    for (int i = 0; i < 32; ++i) tv[i] = wp_[(size_t)(2 * i) * ldw];
#pragma unroll
    for (int i = 0; i < 32; ++i) scr[(2 * i + (lane >> 5)) * 33 + (lane & 31)] = tv[i];
    LDS_WAIT(); asm volatile("" ::: "memory");
    const int c = lane & 7;
#pragma unroll
    for (int j = 0; j < 4; ++j) { const int n = (lane >> 3) + 8 * j; const LAS float* s = scr + (8 * c) * 33 + n; const float k_ = pg8::FP8_SW;
        u32x2 o; o.x = pg8::pack4_fp8(s[0 * 33] * k_, s[1 * 33] * k_, s[2 * 33] * k_, s[3 * 33] * k_); o.y = pg8::pack4_fp8(s[4 * 33] * k_, s[5 * 33] * k_, s[6 * 33] * k_, s[7 * 33] * k_);
        *(GAS u32x2*)(WT + (size_t)n * ldt + 8 * c) = o; }
    LDS_WAIT(); asm volatile("" ::: "memory");
}
constexpr int I_WIN = 16 * 64, I_WO = 8 * 32, I_WEFF = 4 * 16 * 16, I_WU = 32 * 16 * 64, I_WD = 32 * 16 * 32;
constexpr int P0_ITEMS = I_WIN + I_WO + I_WEFF + I_WU + I_WD;

__device__ __forceinline__ void phase0(const Args& a, LAS unsigned char* L, int vcu, int G, int tid, int lane, int wave) {
    const float* w_in = a.in[2]; const float* w_pool = a.in[4]; const float* pscale = a.in[5]; const float* w_out = a.in[6]; const float* w_up = a.in[10]; const float* w_down = a.in[12];
    bf16* Win_t = (bf16*)(a.ws + WS_WIN); bf16* Wo_t = (bf16*)(a.ws + WS_WO); unsigned char* Wu8 = a.ws + WS_WU; unsigned char* Wd8 = a.ws + WS_WD;
    LAS float* scr = (LAS float*)(L + wave * 8448);
    LAS float* wf = (LAS float*)(L + 69632);
    for (int i = tid; i < 1024 * 8; i += 512) { const int d = i >> 3, p_ = ((d & 255) >> 2) + 64 * (4 * (d >> 8) + (d & 3)); wf[p_ * 12 + (i & 7)] = w_in[(size_t)d * INW + 2048 + (i & 7)]; }
    __syncthreads();
    const int gw = vcu * NWAVES + wave, NGW = G * NWAVES;
    {
        const float* x = a.in[0]; const float* g_mix = a.in[1]; const float* b_forget = a.in[3];
        bf16* XN = (bf16*)(a.ws + WS_XN); float* LOGF = (float*)(a.ws + WS_LOGF);
        f32x4 g[4];
#pragma unroll
        for (int j = 0; j < 4; ++j) g[j] = *(const f32x4*)(g_mix + 4 * lane + 256 * j);
        for (int m = gw; m < T; m += NGW) {
            const float* xr = x + (size_t)m * DM;
            f32x4 v[4]; float ss = 0.f;
#pragma unroll
            for (int j = 0; j < 4; ++j) { v[j] = *(const f32x4*)(xr + 4 * lane + 256 * j); ss += v[j].x * v[j].x + v[j].y * v[j].y + v[j].z * v[j].z + v[j].w * v[j].w; }
            const float rstd = rsqrtf(wave_sum(ss) * (1.f / DM) + RMS_EPS);
            float fl[8];
#pragma unroll
            for (int e = 0; e < 8; ++e) fl[e] = 0.f;
#pragma unroll
            for (int j = 0; j < 4; ++j) {
                v[j] = v[j] * rstd * g[j];
#pragma unroll
                for (int i = 0; i < 4; ++i) {
                    const int prow = lane + 64 * (4 * j + i); const float hv = v[j][i];
                    const f32x4 w0 = *(const LAS f32x4*)(wf + prow * 12), w1 = *(const LAS f32x4*)(wf + prow * 12 + 4);
                    fl[0] += hv * w0.x; fl[1] += hv * w0.y; fl[2] += hv * w0.z; fl[3] += hv * w0.w;
                    fl[4] += hv * w1.x; fl[5] += hv * w1.y; fl[6] += hv * w1.z; fl[7] += hv * w1.w;
                }
                u32x2 o; o.x = pk2(v[j].x, v[j].y); o.y = pk2(v[j].z, v[j].w);
                *(u32x2*)(XN + (size_t)m * DM + 4 * lane + 256 * j) = o;
            }
#pragma unroll
            for (int e = 0; e < 8; ++e) fl[e] = wave_sum(fl[e]);
            if (lane < 8) {
                float z = 0.f;
#pragma unroll
                for (int e = 0; e < 8; ++e) if (lane == e) z = fl[e];
                z += b_forget[lane];
                const float ls = fminf(z, 0.f) - log1pf(expf(-fabsf(z)));
                LOGF[((size_t)(m / SEQ) * NH + lane) * SEQ + (m % SEQ)] = ls;
            }
        }
    }
    for (int it = gw; it < P0_ITEMS; it += NGW) {
        int r = it;
        if (r < I_WIN) { const int kb = r >> 6, nb = r & 63; p0_transpose_item(w_in + (size_t)(64 * kb) * INW + 32 * nb, INW, Win_t + (size_t)(32 * nb) * DM + 64 * kb, DM, scr, lane); continue; } r -= I_WIN;
        if (r < I_WO) { const int kb = r >> 5, nb = r & 31; p0_transpose_item(w_out + (size_t)(512 + 64 * kb) * DM + 32 * nb, DM, Wo_t + (size_t)(32 * nb) * DM + 512 + 64 * kb, DM, scr, lane); continue; } r -= I_WO;
        if (r < I_WEFF) {
            const int g = r >> 8, nb = (r >> 4) & 15, kb = r & 15, n = nb * 64 + lane; float acc[8];
#pragma unroll
            for (int i = 0; i < 8; ++i) acc[i] = 0.f;
            const float* wp = w_pool + (size_t)g * 16384 + (size_t)(kb * 8) * 128;
#pragma unroll 2
            for (int d = 0; d < 128; d += 4) { f32x4 av;
#pragma unroll
                for (int q = 0; q < 4; ++q) av[q] = w_out[(size_t)(g * 128 + d + q) * DM + n];
                av = av * *(const f32x4*)(pscale + g * 128 + d);
#pragma unroll
                for (int i = 0; i < 8; ++i) { const f32x4 wv = *(const f32x4*)(wp + i * 128 + d); acc[i] += av.x * wv.x + av.y * wv.y + av.z * wv.z + av.w * wv.w; } }
            u32x4 o; o.x = pk2(acc[0], acc[1]); o.y = pk2(acc[2], acc[3]); o.z = pk2(acc[4], acc[5]); o.w = pk2(acc[6], acc[7]);
            *(GAS u32x4*)(Wo_t + (size_t)n * DM + g * 128 + kb * 8) = o; continue; } r -= I_WEFF;
        if (r < I_WU) { const int e = r >> 10, kb = (r >> 6) & 15, nb = r & 63, n0 = 32 * nb;
            const int rowp = n0 < 1024 ? (n0 >> 7) * 256 + (n0 & 127) : ((n0 - 1024) >> 7) * 256 + 128 + ((n0 - 1024) & 127);
            p0_transpose_item_fp8(w_up + (size_t)e * DM * 2048 + (size_t)(64 * kb) * 2048 + n0, 2048, Wu8 + ((size_t)e * 2048 + rowp) * DM + 64 * kb, DM, scr, lane); continue; } r -= I_WU;
        { const int e = r >> 9, kb = (r >> 5) & 15, nb = r & 31;
            p0_transpose_item_fp8(w_down + (size_t)e * DE * DM + (size_t)(64 * kb) * DM + 32 * nb, DM, Wd8 + ((size_t)e * DM + 32 * nb) * DE + 64 * kb, DE, scr, lane); }
    }
}

__device__ __forceinline__ void pool_pass(const Args& a, int vcu, int G, int tid) {
    const bf16* U = (const bf16*)(a.ws + WS_U); bf16* CAT = (bf16*)(a.ws + WS_CAT);
    const size_t total = (size_t)T * 64;
    for (size_t i = (size_t)vcu * 512 + tid; i < total; i += (size_t)G * 512) {
        const int row = (int)(i >> 6), ch = (int)(i & 63), c0 = ch * 8, g = c0 >> 7, w = 2 << g, t = row % SEQ;
        const int n = t + 1 < w ? t + 1 : w;
        float acc[8], self[8];
#pragma unroll
        for (int k = 0; k < 8; ++k) { acc[k] = 0.f; self[k] = 0.f; }
        for (int j = 0; j < n; ++j) {
            const u32x4 r = *(const u32x4*)(U + (size_t)(row - j) * PW + c0);
            const unsigned rr[4] = {r.x, r.y, r.z, r.w};
#pragma unroll
            for (int k = 0; k < 4; ++k) { const float lo = __builtin_bit_cast(float, rr[k] << 16), hi = __builtin_bit_cast(float, rr[k] & 0xffff0000u); acc[2 * k] += lo; acc[2 * k + 1] += hi;
                if (j == 0) { self[2 * k] = lo; self[2 * k + 1] = hi; } }
        }
        const float inv = 1.f / (float)n; u32x4 o;
        o.x = pk2(acc[0] * inv - self[0], acc[1] * inv - self[1]); o.y = pk2(acc[2] * inv - self[2], acc[3] * inv - self[3]);
        o.z = pk2(acc[4] * inv - self[4], acc[5] * inv - self[5]); o.w = pk2(acc[6] * inv - self[6], acc[7] * inv - self[7]);
        *(u32x4*)(CAT + (size_t)row * DM + c0) = o;
    }
}
__device__ __forceinline__ float slice_max_norm2(const bf16* base, LAS float* red, int tid, int lane, int wave) {
    float mx = 0.f; const int chunk = tid & 7, r0 = tid >> 3;
#pragma unroll 8
    for (int i = 0; i < SEQ / 64; ++i) { const u32x4 v = *(const u32x4*)(base + (size_t)(i * 64 + r0) * AW + chunk * 8); const unsigned w[4] = {v.x, v.y, v.z, v.w}; float s = 0.f;
#pragma unroll
        for (int k = 0; k < 4; ++k) { const float lo = __builtin_bit_cast(float, w[k] << 16), hi = __builtin_bit_cast(float, w[k] & 0xffff0000u); s += lo * lo + hi * hi; }
        s += __shfl_xor(s, 1); s += __shfl_xor(s, 2); s += __shfl_xor(s, 4); mx = fmaxf(mx, s); }
#pragma unroll
    for (int o = 8; o < 64; o <<= 1) mx = fmaxf(mx, __shfl_xor(mx, o));
    __syncthreads();
    if (lane == 0) red[wave] = mx;
    __syncthreads();
    float r = red[0];
#pragma unroll
    for (int w = 1; w < 8; ++w) r = fmaxf(r, red[w]);
    return r;
}
__device__ __forceinline__ void c2_scan(const Args& a, LAS unsigned char* L, int bh, int tid, int lane, int wave) {
    const float* src = (const float*)(a.ws + WS_LOGF) + (size_t)bh * SEQ + tid * 16;
    LAS double* wtot = (LAS double*)(L + 0);
    LAS float* c2s = (LAS float*)(L + attn_body::LDS_C2);
    float v[16]; double s = 0.0;
#pragma unroll
    for (int i = 0; i < 16; ++i) { v[i] = src[i]; s += (double)v[i]; }
    double inc = s;
#pragma unroll
    for (int o = 1; o < 64; o <<= 1) { const double t_ = __shfl_up(inc, o); if (lane >= o) inc += t_; }
    if (lane == 63) wtot[wave] = inc;
    __syncthreads();
    double base = inc - s;
    for (int w = 0; w < wave; ++w) base += wtot[w];
#pragma unroll
    for (int i = 0; i < 16; ++i) { base += (double)v[i]; c2s[tid * 16 + i] = (float)(base * (double)LOG2E); }
    __syncthreads();
}

__device__ __forceinline__ void router_phase(const Args& a, LAS unsigned char* L, int vcu, int G, int tid, int lane, int wave) {
    LAS float* wr = (LAS float*)L;
    LAS int* ch_e = (LAS int*)(L + RT_CHE); LAS float* ch_g = (LAS float*)(L + RT_CHG); LAS int* lcnt = (LAS int*)(L + RT_LCNT); LAS int* lbase = (LAS int*)(L + RT_LBASE);
    const float* w_router = a.in[8]; const float* b_router = a.in[9]; const float* g_ffn = a.in[7];
    for (int i = tid; i < 1024 * 32 / 4; i += 512) { const int d = i >> 3, c4 = i & 7, p_ = ((d & 255) >> 2) + 64 * (4 * (d >> 8) + (d & 3)); *(LAS f32x4*)(wr + p_ * RT_WROW + c4 * 4) = ((const f32x4*)w_router)[i]; }
    __syncthreads();
    const float* X1 = a.out; unsigned char* H2 = a.ws + WS_XN;
    int* cnt = (int*)(a.ws + WS_CTL) + CW_CNT; int* SEL = (int*)(a.ws + WS_SEL); int* LTK = (int*)(a.ws + WS_LTK); float* LGT = (float*)(a.ws + WS_LGT);
    f32x4 g[4];
#pragma unroll
    for (int j = 0; j < 4; ++j) g[j] = *(const f32x4*)(g_ffn + 4 * lane + 256 * j);
    const int myexp = ((lane >> 5) & 1) * 16 + ((lane >> 4) & 1) * 8 + ((lane >> 3) & 1) * 4 + ((lane >> 2) & 1) * 2 + ((lane >> 1) & 1);
    const float mybias = b_router[myexp];
    for (int grp = vcu; grp < T / 128; grp += G) {
        if (tid < 32) lcnt[tid] = 0;
        __syncthreads();
        for (int it = 0; it < 16; ++it) {
            const int lt = wave * 16 + it, m = grp * 128 + lt;
            const float* xr = X1 + (size_t)m * DM;
            f32x4 v[4]; float ss = 0.f;
#pragma unroll
            for (int j = 0; j < 4; ++j) { v[j] = *(const f32x4*)(xr + 4 * lane + 256 * j); ss += v[j].x * v[j].x + v[j].y * v[j].y + v[j].z * v[j].z + v[j].w * v[j].w; }
            const float rstd = rsqrtf(wave_sum(ss) * (1.f / DM) + RMS_EPS);
            float lg[32];
#pragma unroll
            for (int e = 0; e < 32; ++e) lg[e] = 0.f;
#pragma unroll
            for (int j = 0; j < 4; ++j) {
                v[j] = v[j] * rstd * g[j];
                *(unsigned*)(H2 + (size_t)m * DM + 4 * lane + 256 * j) = pg8::pack4_fp8(v[j].x * pg8::FP8_SA, v[j].y * pg8::FP8_SA, v[j].z * pg8::FP8_SA, v[j].w * pg8::FP8_SA);
#pragma unroll
                for (int i = 0; i < 4; ++i) { const int prow = lane + 64 * (4 * j + i); const float hv = v[j][i];
#pragma unroll
                    for (int e4 = 0; e4 < 8; ++e4) { const f32x4 w = *(const LAS f32x4*)(wr + prow * RT_WROW + e4 * 4);
                        lg[e4 * 4] += hv * w.x; lg[e4 * 4 + 1] += hv * w.y; lg[e4 * 4 + 2] += hv * w.z; lg[e4 * 4 + 3] += hv * w.w; }
                    asm volatile("" ::: "memory"); }
            }
            float mine;
            {
                float a16[16]; const bool up = lane >= 32;
#pragma unroll
                for (int e = 0; e < 16; ++e) { const float keep = up ? lg[16 + e] : lg[e], give = up ? lg[e] : lg[16 + e]; a16[e] = keep + __shfl_xor(give, 32); }
                float a8[8]; const bool u16 = (lane & 16) != 0;
#pragma unroll
                for (int e = 0; e < 8; ++e) { const float keep = u16 ? a16[8 + e] : a16[e], give = u16 ? a16[e] : a16[8 + e]; a8[e] = keep + __shfl_xor(give, 16); }
                float a4[4]; const bool u8 = (lane & 8) != 0;
#pragma unroll
                for (int e = 0; e < 4; ++e) { const float keep = u8 ? a8[4 + e] : a8[e], give = u8 ? a8[e] : a8[4 + e]; a4[e] = keep + __shfl_xor(give, 8); }
                float a2[2]; const bool u4 = (lane & 4) != 0;
#pragma unroll
                for (int e = 0; e < 2; ++e) { const float keep = u4 ? a4[2 + e] : a4[e], give = u4 ? a4[e] : a4[2 + e]; a2[e] = keep + __shfl_xor(give, 4); }
                const bool u2 = (lane & 2) != 0;
                float a1 = (u2 ? a2[1] : a2[0]) + __shfl_xor(u2 ? a2[0] : a2[1], 2);
                a1 += __shfl_xor(a1, 1);
                mine = a1;
            }
            float val = mine + mybias;
            if (lane & 1) val = -INFINITY;
            float tv[4]; int ti[4];
#pragma unroll
            for (int k = 0; k < 4; ++k) {
                float bv = val; int bi = myexp;
#pragma unroll
                for (int o = 1; o < 64; o <<= 1) { const float ov = __shfl_xor(bv, o); const int oi = __shfl_xor(bi, o); if (ov > bv || (ov == bv && oi < bi)) { bv = ov; bi = oi; } }
                tv[k] = bv; ti[k] = bi; if (myexp == bi) val = -INFINITY;
            }
            const float e0 = 1.f, e1 = expf(tv[1] - tv[0]), e2 = expf(tv[2] - tv[0]), e3 = expf(tv[3] - tv[0]); const float inv = 1.f / (e0 + e1 + e2 + e3);
            if (lane < 4) { const float gg = (lane == 0 ? e0 : lane == 1 ? e1 : lane == 2 ? e2 : e3) * inv; const int ee = lane == 0 ? ti[0] : lane == 1 ? ti[1] : lane == 2 ? ti[2] : ti[3];
                ch_e[lt * 4 + lane] = ee; ch_g[lt * 4 + lane] = gg; __hip_atomic_fetch_add(&lcnt[ee], 1, __ATOMIC_RELAXED, __HIP_MEMORY_SCOPE_WORKGROUP); }
        }
        __syncthreads();
        if (tid < 32) { lbase[tid] = atomicAdd(&cnt[tid], lcnt[tid]); lcnt[tid] = 0; }
        __syncthreads();
        { const int e = ch_e[tid]; const int slot = lbase[e] + __hip_atomic_fetch_add(&lcnt[e], 1, __ATOMIC_RELAXED, __HIP_MEMORY_SCOPE_WORKGROUP); const int tk = (grp * 128 + (tid >> 2)) * 4 + (tid & 3);
          LTK[(size_t)e * T + slot] = tk; LGT[(size_t)e * T + slot] = ch_g[tid]; SEL[tk] = (slot << 5) | e; }
        __syncthreads();
    }
}

__device__ __forceinline__ void expert_map(const Args& a, volatile LAS unsigned* MISC, int tid) {
    if (tid == 0) { const int* cnt = (const int*)(a.ws + WS_CTL) + CW_CNT; int acc = 0;
        for (int e = 0; e < 32; ++e) { const int c = __hip_atomic_load((int*)cnt + e, RLX_AGENT); MISC[64 + e] = (unsigned)c; MISC[96 + e] = (unsigned)acc; acc += (c + RT - 1) / RT; } MISC[128] = (unsigned)acc; }
    __syncthreads();
}

__device__ __forceinline__ void final_phase(const Args& a, volatile LAS unsigned* MISC, int vcu, int G, int lane, int wave) {
    const int* SEL = (const int*)(a.ws + WS_SEL); const bf16* Y = (const bf16*)(a.ws + WS_Y); const float* g_final = a.in[14];
    f32x4 g[4];
#pragma unroll
    for (int j = 0; j < 4; ++j) g[j] = *(const f32x4*)(g_final + 4 * lane + 256 * j);
    for (int m = vcu * 8 + wave; m < T; m += G * 8) {
        float* xr = a.out + (size_t)m * DM; f32x4 v[4];
#pragma unroll
        for (int j = 0; j < 4; ++j) v[j] = *(const f32x4*)(xr + 4 * lane + 256 * j);
#pragma unroll
        for (int k = 0; k < 4; ++k) { const int sv = SEL[m * 4 + k]; const int e = sv & 31, slot = sv >> 5; const bf16* yr = Y + ((size_t)MISC[96 + e] * RT + slot) * DM;
#pragma unroll
            for (int j = 0; j < 4; ++j) { const u32x2 y = *(const u32x2*)(yr + 4 * lane + 256 * j);
                v[j].x += __builtin_bit_cast(float, y.x << 16); v[j].y += __builtin_bit_cast(float, y.x & 0xffff0000u); v[j].z += __builtin_bit_cast(float, y.y << 16); v[j].w += __builtin_bit_cast(float, y.y & 0xffff0000u); } }
        float ss = 0.f;
#pragma unroll
        for (int j = 0; j < 4; ++j) ss += v[j].x * v[j].x + v[j].y * v[j].y + v[j].z * v[j].z + v[j].w * v[j].w;
        const float rstd = rsqrtf(wave_sum(ss) * (1.f / DM) + RMS_EPS);
#pragma unroll
        for (int j = 0; j < 4; ++j) *(f32x4*)(xr + 4 * lane + 256 * j) = v[j] * rstd * g[j];
    }
}

__global__ void __launch_bounds__(NWAVES * 64, 2) mk_fwd(Args args) {
    extern __shared__ __attribute__((aligned(16))) unsigned char lds[];
    LAS unsigned char* L = (LAS unsigned char*)lds;
    volatile LAS unsigned* MISC = (volatile LAS unsigned*)(L + LDSCTL_OFF);
    const int tid = threadIdx.x, lane = tid & 63, wave = __builtin_amdgcn_readfirstlane(tid >> 6);
    const int G = gridDim.x; const int bx = blockIdx.x; const int vcu = (G % 8 == 0) ? (bx % 8) * (G / 8) + bx / 8 : bx;
    unsigned char* ws = args.ws;
    for (int u = tid; u < (LDS_TOTAL - LDSCTL_OFF) / 4; u += NWAVES * 64) ((LAS unsigned*)(L + LDSCTL_OFF))[u] = 0u;
    __syncthreads();
    XcdBarrier bar; bar.bar = (unsigned*)(ws + WS_CTL) + CW_BAR; bar.x = 0; bar.st = nullptr;
    if (args.use_bar) bar = xcd_barrier_post((unsigned*)(ws + WS_CTL) + CW_BAR, MISC + 8);
    const int lo = args.ph_lo, hi = args.ph_hi;
#define IN(k) (lo <= (k) && (k) < hi)
#define SEAM(k) do { if (IN(k) && IN((k) + 1)) xcd_barrier(bar); } while (0)
#ifndef MK_DUP
#define MK_DUP -1
#endif
#ifndef MK_TPROBE
#define MK_TPROBE -1
#endif
#define TP0(k) do { if ((MK_TPROBE) == (k) && bx == 0 && tid == 0) { const unsigned long long t_ = __builtin_amdgcn_s_memrealtime(); MISC[16] = (unsigned)t_; MISC[17] = (unsigned)(t_ >> 32); } } while (0)
#define TP1(k) do { if ((MK_TPROBE) == (k) && bx == 0 && tid == 0) { const unsigned long long t_ = __builtin_amdgcn_s_memrealtime(); MISC[18] = (unsigned)t_; MISC[19] = (unsigned)(t_ >> 32); } } while (0)
#define REPS(k) for (int rep_ = 0; rep_ < ((MK_DUP) == (k) ? 2 : 1); ++rep_, ((MK_DUP) == (k) && rep_ == 1 ? xcd_barrier(bar) : (void)0))

    TP0(0);
    if (IN(0)) REPS(0) { phase0(args, L, vcu, G, tid, lane, wave); }
    SEAM(0); TP1(0); TP0(1);
    if (IN(1)) REPS(1) {
        pg8::Gemm g{(const bf16*)(ws + WS_XN), (const bf16*)(ws + WS_WIN), DM}; pg8::StaticOrder S; S.init(T, 2048, G, bx);
        pg8::EpiInproj E{(bf16*)(ws + WS_U), (size_t)(WS_Q - WS_U) / 2, C2};
        pg8::gemm_phase<pg8::EpiInproj, pg8::StaticOrder, true, false>(L + RING_OFF, g, S, E, nullptr);
    }
    SEAM(1); TP1(1); TP0(2);
    if (IN(2)) {
        pool_pass(args, vcu, G, tid);
        const attn_body::StaticOrder S(G, bx);
        const int bh = S.vcu >> 3; const size_t hoff = (size_t)(bh / NH) * SEQ * AW + (size_t)(bh % NH) * HD;
        const float mq2 = slice_max_norm2((const bf16*)(ws + WS_Q) + hoff, (LAS float*)(L + 256), tid, lane, wave);
        const float mk2 = slice_max_norm2((const bf16*)(ws + WS_K) + hoff, (LAS float*)(L + 512), tid, lane, wave);
        const float qkb2 = 2.0f * sqrtf(mq2 * mk2) * 1.001f;
        c2_scan(args, L, bh, tid, lane, wave);
        const attn_body::AttnTensors AT{(const attn_body::bf16*)(ws + WS_Q), (const attn_body::bf16*)(ws + WS_K), (const attn_body::bf16*)(ws + WS_V), (attn_body::bf16*)(ws + WS_CAT) + PW};
        attn_body::attn_phase<attn_body::StaticOrder>((char*)lds + RING_OFF, AT, S, qkb2);
    }
#if MK_DUP == 2
    xcd_barrier(bar);
    if (IN(2)) {
        pool_pass(args, vcu, G, tid);
        const attn_body::StaticOrder S(G, bx);
        const int bh = S.vcu >> 3; const size_t hoff = (size_t)(bh / NH) * SEQ * AW + (size_t)(bh % NH) * HD;
        const float mq2 = slice_max_norm2((const bf16*)(ws + WS_Q) + hoff, (LAS float*)(L + 256), tid, lane, wave);
        const float mk2 = slice_max_norm2((const bf16*)(ws + WS_K) + hoff, (LAS float*)(L + 512), tid, lane, wave);
        const float qkb2 = 2.0f * sqrtf(mq2 * mk2) * 1.001f;
        c2_scan(args, L, bh, tid, lane, wave);
        const attn_body::AttnTensors AT{(const attn_body::bf16*)(ws + WS_Q), (const attn_body::bf16*)(ws + WS_K), (const attn_body::bf16*)(ws + WS_V), (attn_body::bf16*)(ws + WS_CAT) + PW};
        attn_body::attn_phase<attn_body::StaticOrder>((char*)lds + RING_OFF, AT, S, qkb2);
    }
#endif
    SEAM(2); TP1(2); TP0(3);
    if (IN(3)) REPS(3) {
        pg8::Gemm g{(const bf16*)(ws + WS_CAT), (const bf16*)(ws + WS_WO), DM}; pg8::StaticOrder S; S.init(T, DM, G, bx);
        pg8::EpiResF32 E{args.in[0], args.out};
        pg8::gemm_phase<pg8::EpiResF32, pg8::StaticOrder, true, false>(L + RING_OFF, g, S, E, nullptr);
    }
    SEAM(3); TP1(3); TP0(4);
    if (IN(4)) { router_phase(args, L, vcu, G, tid, lane, wave); }
    SEAM(4); TP1(4); TP0(5);
    if (IN(5)) REPS(5) {
        expert_map(args, MISC, tid);
        const LAS int* pt = (const LAS int*)(L + LDSCTL_OFF + 96 * 4); const LAS int* cn = (const LAS int*)(L + LDSCTL_OFF + 64 * 4);
        LAS unsigned* tab = (LAS unsigned*)(L + TAB_OFF);
        const pg8::MoeOrder<8> S{pt, G, bx, (size_t)2048 * DM};
        { const int* LTK = (const int*)(ws + WS_LTK); pg8::Unit u;
          for (int i = 0; i < TAB_UNITS && S.next(i, u); ++i) { if (tid < 256) { const int slot = u.lrow0 + tid; const int tok = slot < cn[u.e] ? (LTK[(size_t)u.e * T + slot] >> 2) : 0; tab[i * 256 + tid] = (unsigned)tok * (unsigned)DM; } } }
        __syncthreads();
        pg8::Gemm g{(const bf16*)(ws + WS_XN), (const bf16*)(ws + WS_WU), DM / 2};
        pg8::EpiSwiglu8 E{ws + WS_ACT, args.in[11]};
        pg8::gemm_phase<pg8::EpiSwiglu8, pg8::MoeOrder<8>, true, true, true>(L + RING_OFF, g, S, E, tab);
    }
    SEAM(5); TP1(5); TP0(6);
    if (IN(6)) REPS(6) {
        expert_map(args, MISC, tid);
        const LAS int* pt = (const LAS int*)(L + LDSCTL_OFF + 96 * 4); const LAS int* cn = (const LAS int*)(L + LDSCTL_OFF + 64 * 4);
        const pg8::MoeOrder<4> S{pt, G, bx, (size_t)DM * DE};
        pg8::Gemm g{(const bf16*)(ws + WS_ACT), (const bf16*)(ws + WS_WD), DE / 2};
        pg8::EpiDown E{(bf16*)(ws + WS_Y), args.in[13], (const float*)(ws + WS_LGT), cn, T, pg8::FP8_INV};
        pg8::gemm_phase<pg8::EpiDown, pg8::MoeOrder<4>, true, false, true>(L + RING_OFF, g, S, E, nullptr);
    }
    SEAM(6); TP1(6); TP0(7);
    if (IN(7)) { expert_map(args, MISC, tid); final_phase(args, MISC, vcu, G, lane, wave); }
    TP1(7);
    if ((MK_TPROBE) >= 0 && bx == 0) { __syncthreads(); const unsigned long long ta = ((unsigned long long)MISC[17] << 32) | MISC[16], tb = ((unsigned long long)MISC[19] << 32) | MISC[18];
        const unsigned long long tend = __builtin_amdgcn_s_memrealtime() + (tb - ta); while (__builtin_amdgcn_s_memrealtime() < tend) __builtin_amdgcn_s_sleep(10); }
#undef IN
#undef SEAM
}
#ifndef MK_MODE
#define MK_MODE 1
#endif
#ifndef MK_NAIVE_MASK
#define MK_NAIVE_MASK 0
#endif
extern "C" void kernel_launch(void* const* d_in, const int* in_sizes, int n_in, void* d_out, int out_size, void* d_ws, size_t ws_size, hipStream_t stream) {
    if (n_in != 15 || out_size != T * DM || ws_size < WS_END) { fprintf(stderr, "kernel_launch: unexpected shapes (n_in %d out %d ws %zu)\n", n_in, out_size, ws_size); return; }
    Params p{};
    p.x = (const float*)d_in[0]; p.g_mix = (const float*)d_in[1]; p.w_in = (const float*)d_in[2]; p.b_forget = (const float*)d_in[3]; p.w_pool = (const float*)d_in[4];
    p.pool_scale = (const float*)d_in[5]; p.w_out = (const float*)d_in[6]; p.g_ffn = (const float*)d_in[7]; p.w_router = (const float*)d_in[8]; p.b_router = (const float*)d_in[9];
    p.w_up = (const float*)d_in[10]; p.b_up = (const float*)d_in[11]; p.w_down = (const float*)d_in[12]; p.b_down = (const float*)d_in[13]; p.g_final = (const float*)d_in[14];
    p.out = (float*)d_out; p.ws = (unsigned char*)d_ws;
    Args a{};
    for (int i = 0; i < 15; ++i) a.in[i] = (const float*)d_in[i];
    a.out = (float*)d_out; a.ws = (unsigned char*)d_ws;
    static bool attr_done = false;
    if (!attr_done) { if (hipFuncSetAttribute((const void*)mk_fwd, hipFuncAttributeMaxDynamicSharedMemorySize, LDS_TOTAL) != hipSuccess) fprintf(stderr, "kernel_launch: hipFuncSetAttribute failed\n"); attr_done = true; }
    (void)hipMemsetAsync((char*)d_ws + WS_CTL, 0, 1 * MiB, stream);
    const int GRID = 256;
#if MK_MODE == 2
    a.ph_lo = 0; a.ph_hi = N_PHASES; a.use_bar = 1;
    hipLaunchKernelGGL(mk_fwd, dim3(GRID), dim3(NWAVES * 64), LDS_TOTAL, stream, a);
#else
    const unsigned mask = (MK_MODE == 0) ? 0xffu : (unsigned)(MK_NAIVE_MASK);
    auto fast = [&](int k) { a.ph_lo = k; a.ph_hi = k + 1; a.use_bar = 0; hipLaunchKernelGGL(mk_fwd, dim3(GRID), dim3(NWAVES * 64), LDS_TOTAL, stream, a); };
    auto nv = [&](int k) { return (mask >> k) & 1u; };
    if (mask != 0xffu || !nv(0)) fast(0);
    if (nv(0)) k_prologue<<<1024, 512, 0, stream>>>(p);
    if (nv(1)) k_inproj_naive<<<2048, 512, 0, stream>>>(p); else fast(1);
    if (nv(2)) { k_cumsum<<<32, 512, 0, stream>>>(p); k_attn_naive<<<BATCH * NH * (SEQ / 64), 512, 0, stream>>>(p); if (!nv(3)) k_pool<<<2048, 512, 0, stream>>>(p, (bf16*)((unsigned char*)d_ws + WS_CAT), DM); }
    else fast(2);
    if (nv(3)) { k_pool<<<2048, 512, 0, stream>>>(p, (bf16*)((unsigned char*)d_ws + WS_P), PW); k_poolgemm_naive<<<2048, 512, 0, stream>>>(p); k_outproj_naive<<<2048, 512, 0, stream>>>(p); }
    else fast(3);
    if (nv(4)) k_router<<<256, 512, 0, stream>>>(p); else fast(4);
    if (nv(5)) k_up_naive<<<4096, 512, 0, stream>>>(p); else fast(5);
    if (nv(6)) k_down_naive<<<4096, 512, 0, stream>>>(p); else fast(6);
    if (nv(7)) k_final<<<1024, 512, 0, stream>>>(p); else fast(7);
#endif
}
```

```cpp
#define MK_MODE 2
#include <hip/hip_runtime.h>
#include <cstdio>
#include <cstdint>

constexpr int BATCH = 4, SEQ = 8192, DM = 1024, T = BATCH * SEQ;
constexpr int PW = 512, AW = 512, NH = 8, HD = 64, INW = PW + 3 * AW + NH;
constexpr int NE = 32, TOPK = 4, DE = 1024;
constexpr float RMS_EPS = 1e-5f, SW_LIMIT = 7.0f, SW_ALPHA = 1.702f;
constexpr float LOG2E = 1.4426950408889634f;
constexpr float C2 = 0.125f * LOG2E;
constexpr int RT = 256;
constexpr int NROWS_PAD = T * TOPK + NE * RT;

typedef unsigned short bf16;
typedef float f32x4 __attribute__((ext_vector_type(4)));
typedef unsigned u32x4 __attribute__((ext_vector_type(4)));
typedef unsigned u32x2 __attribute__((ext_vector_type(2)));

constexpr size_t MiB = 1u << 20;
constexpr size_t WS_CTL = 0;
constexpr size_t WS_LOGF = 1 * MiB;
constexpr size_t WS_CUM = 2 * MiB;
constexpr size_t WS_SEL = 3 * MiB;
constexpr size_t WS_LTK = 4 * MiB;
constexpr size_t WS_LGT = 8 * MiB;
constexpr size_t WS_XN = 12 * MiB;
constexpr size_t WS_WIN = 76 * MiB;
constexpr size_t WS_WO = 80 * MiB;
constexpr size_t WS_WU = 82 * MiB;
constexpr size_t WS_WD = 210 * MiB;
constexpr size_t WS_U = 274 * MiB;
constexpr size_t WS_Q = 306 * MiB;
constexpr size_t WS_K = 338 * MiB;
constexpr size_t WS_V = 370 * MiB;
constexpr size_t WS_CAT = 402 * MiB;
constexpr size_t WS_P = 466 * MiB;
constexpr size_t WS_ACT = 274 * MiB;
constexpr size_t WS_Y = 546 * MiB;
constexpr size_t WS_END = 818 * MiB;
static_assert(WS_ACT + (size_t)NROWS_PAD * 1024 * 2 <= WS_Y, "ACT overlay");
static_assert(WS_Y + (size_t)NROWS_PAD * 1024 * 2 <= WS_END, "Y");
constexpr int CW_CNT = 64;

struct Params {
    const float *x, *g_mix, *w_in, *b_forget, *w_pool, *pool_scale, *w_out, *g_ffn, *w_router, *b_router, *w_up, *b_up, *w_down, *b_down, *g_final;
    float* out; unsigned char* ws;
};

__device__ __forceinline__ unsigned f2bf(float f) { unsigned u = __builtin_bit_cast(unsigned, f); return (u + 0x7fffu + ((u >> 16) & 1u)) >> 16; }
__device__ __forceinline__ unsigned pk2(float lo, float hi) { return f2bf(lo) | (f2bf(hi) << 16); }
__device__ __forceinline__ float bf2f(unsigned short b) { return __builtin_bit_cast(float, (unsigned)b << 16); }
__device__ __forceinline__ float wave_sum(float v) {
#pragma unroll
    for (int o = 1; o < 64; o <<= 1) v += __shfl_xor(v, o);
    return v;
}

__global__ void __launch_bounds__(512) k_prologue(Params p) {
    __shared__ float wf[1024 * 8];
    const int tid = threadIdx.x, lane = tid & 63, wave = tid >> 6;
    for (int i = tid; i < 1024 * 8; i += 512) wf[i] = p.w_in[(size_t)(i >> 3) * INW + 2048 + (i & 7)];
    if (blockIdx.x == 0 && tid < 64) ((int*)(p.ws + WS_CTL))[CW_CNT + tid] = 0;
    __syncthreads();
    bf16* XN = (bf16*)(p.ws + WS_XN); float* LOGF = (float*)(p.ws + WS_LOGF);
    const int gw = blockIdx.x * 8 + wave, NGW = gridDim.x * 8;
    f32x4 g[4];
#pragma unroll
    for (int j = 0; j < 4; ++j) g[j] = *(const f32x4*)(p.g_mix + 4 * lane + 256 * j);
    for (int m = gw; m < T; m += NGW) {
        const float* xr = p.x + (size_t)m * DM;
        f32x4 v[4]; float ss = 0.f;
#pragma unroll
        for (int j = 0; j < 4; ++j) { v[j] = *(const f32x4*)(xr + 4 * lane + 256 * j); ss += v[j].x * v[j].x + v[j].y * v[j].y + v[j].z * v[j].z + v[j].w * v[j].w; }
        const float rstd = rsqrtf(wave_sum(ss) * (1.f / DM) + RMS_EPS);
        float fl[8];
#pragma unroll
        for (int e = 0; e < 8; ++e) fl[e] = 0.f;
#pragma unroll
        for (int j = 0; j < 4; ++j) {
            v[j] = v[j] * rstd * g[j];
#pragma unroll
            for (int i = 0; i < 4; ++i) {
                const int d = 4 * lane + 256 * j + i; const float hv = v[j][i];
                const f32x4 w0 = *(const f32x4*)(wf + d * 8), w1 = *(const f32x4*)(wf + d * 8 + 4);
                fl[0] += hv * w0.x; fl[1] += hv * w0.y; fl[2] += hv * w0.z; fl[3] += hv * w0.w;
                fl[4] += hv * w1.x; fl[5] += hv * w1.y; fl[6] += hv * w1.z; fl[7] += hv * w1.w;
            }
            u32x2 o; o.x = pk2(v[j].x, v[j].y); o.y = pk2(v[j].z, v[j].w);
            *(u32x2*)(XN + (size_t)m * DM + 4 * lane + 256 * j) = o;
        }
#pragma unroll
        for (int e = 0; e < 8; ++e) fl[e] = wave_sum(fl[e]);
        if (lane < 8) {
            float z = 0.f;
#pragma unroll
            for (int e = 0; e < 8; ++e) if (lane == e) z = fl[e];
            z += p.b_forget[lane];
            const float ls = fminf(z, 0.f) - log1pf(expf(-fabsf(z)));
            const int b = m / SEQ, s = m % SEQ;
            LOGF[((size_t)b * NH + lane) * SEQ + s] = ls;
        }
    }
}

__global__ void __launch_bounds__(512) k_cumsum(Params p) {
    __shared__ double part[512];
    const int tid = threadIdx.x;
    const float* LOGF = (const float*)(p.ws + WS_LOGF); float* CUM = (float*)(p.ws + WS_CUM);
    for (int bh = blockIdx.x; bh < BATCH * NH; bh += gridDim.x) {
        const float* src = LOGF + (size_t)bh * SEQ + tid * 16; float v[16]; double s = 0.0;
#pragma unroll
        for (int i = 0; i < 16; ++i) { v[i] = src[i]; s += (double)v[i]; }
        part[tid] = s; __syncthreads();
        if (tid == 0) { double a = 0.0; for (int i = 0; i < 512; ++i) { const double t_ = part[i]; part[i] = a; a += t_; } }
        __syncthreads();
        double a = part[tid];
        float* dst = CUM + (size_t)bh * SEQ + tid * 16;
#pragma unroll
        for (int i = 0; i < 16; ++i) { a += (double)v[i]; dst[i] = (float)(a * (double)LOG2E); }
        __syncthreads();
    }
}

__global__ void __launch_bounds__(512) k_pool(Params p, bf16* dst, int ldd) {
    const bf16* U = (const bf16*)(p.ws + WS_U);
    const size_t total = (size_t)T * 64;
    for (size_t i = (size_t)blockIdx.x * 512 + threadIdx.x; i < total; i += (size_t)gridDim.x * 512) {
        const int row = (int)(i >> 6), ch = (int)(i & 63), c0 = ch * 8, g = c0 >> 7, w = 2 << g, t = row % SEQ;
        const int n = t + 1 < w ? t + 1 : w;
        float acc[8], self[8];
#pragma unroll
        for (int k = 0; k < 8; ++k) acc[k] = 0.f;
        for (int j = 0; j < n; ++j) {
            const u32x4 r = *(const u32x4*)(U + (size_t)(row - j) * PW + c0);
            const unsigned rr[4] = {r.x, r.y, r.z, r.w};
#pragma unroll
            for (int k = 0; k < 4; ++k) { const float lo = __builtin_bit_cast(float, rr[k] << 16), hi = __builtin_bit_cast(float, rr[k] & 0xffff0000u); acc[2 * k] += lo; acc[2 * k + 1] += hi;
                if (j == 0) { self[2 * k] = lo; self[2 * k + 1] = hi; } }
        }
        const float inv = 1.f / (float)n; u32x4 o;
        o.x = pk2(acc[0] * inv - self[0], acc[1] * inv - self[1]); o.y = pk2(acc[2] * inv - self[2], acc[3] * inv - self[3]);
        o.z = pk2(acc[4] * inv - self[4], acc[5] * inv - self[5]); o.w = pk2(acc[6] * inv - self[6], acc[7] * inv - self[7]);
        *(u32x4*)(dst + (size_t)row * ldd + c0) = o;
    }
}

template <class ARow, class Epi, bool DUAL>
__device__ __forceinline__ void naive_tile(int tm, int tn, int K, const ARow& arow, const float* W, const float* W2, int ldw, const Epi& epi, float* lds) {
    float* As = lds;
    float* Ws = lds + 16 * 68;
    float* Ws2 = Ws + 16 * 128;
    const int tid = threadIdx.x, tx = tid & 31, ty = tid >> 5;
    float acc[4][4], acc2[4][4];
#pragma unroll
    for (int i = 0; i < 4; ++i)
#pragma unroll
        for (int j = 0; j < 4; ++j) { acc[i][j] = 0.f; acc2[i][j] = 0.f; }
    const int ar = tid >> 3, ak = (tid & 7) * 2;
    const bf16* aptr = arow(tm * 64 + ar);
    const int wk = tid >> 5, wc = (tid & 31) * 4;
    for (int k0 = 0; k0 < K; k0 += 16) {
        unsigned av = aptr ? *(const unsigned*)(aptr + k0 + ak) : 0u;
        const f32x4 wv = *(const f32x4*)(W + (size_t)(k0 + wk) * ldw + tn * 128 + wc);
        f32x4 wv2; if (DUAL) wv2 = *(const f32x4*)(W2 + (size_t)(k0 + wk) * ldw + tn * 128 + wc);
        __syncthreads();
        As[ak * 68 + ar] = __builtin_bit_cast(float, av << 16); As[(ak + 1) * 68 + ar] = __builtin_bit_cast(float, av & 0xffff0000u);
        *(f32x4*)(Ws + wk * 128 + wc) = wv; if (DUAL) *(f32x4*)(Ws2 + wk * 128 + wc) = wv2;
        __syncthreads();
#pragma unroll
        for (int k = 0; k < 16; ++k) {
            const f32x4 a = *(const f32x4*)(As + k * 68 + ty * 4), w = *(const f32x4*)(Ws + k * 128 + tx * 4);
#pragma unroll
            for (int i = 0; i < 4; ++i)
#pragma unroll
                for (int j = 0; j < 4; ++j) acc[i][j] += a[i] * w[j];
            if (DUAL) { const f32x4 w2 = *(const f32x4*)(Ws2 + k * 128 + tx * 4);
#pragma unroll
                for (int i = 0; i < 4; ++i)
#pragma unroll
                    for (int j = 0; j < 4; ++j) acc2[i][j] += a[i] * w2[j]; }
        }
    }
#pragma unroll
    for (int i = 0; i < 4; ++i) epi(tm * 64 + ty * 4 + i, tn * 128 + tx * 4, acc[i], acc2[i]);
}
constexpr int NAIVE_LDS_FLOATS = 16 * 68 + 2 * 16 * 128;

struct ARowPlain { const bf16* A; int lda; __device__ __forceinline__ const bf16* operator()(int r) const { return A + (size_t)r * lda; } };
struct EpiInproj { bf16* U; __device__ __forceinline__ void operator()(int r, int c, const float (&a)[4], const float (&)[4]) const {
        const int t = c >> 9, cc = c & 511; const float s = (t == 1) ? C2 : 1.f;
        u32x2 o; o.x = pk2(a[0] * s, a[1] * s); o.y = pk2(a[2] * s, a[3] * s);
        *(u32x2*)(U + (size_t)t * ((WS_Q - WS_U) / 2) + (size_t)r * 512 + cc) = o; } };
__global__ void __launch_bounds__(512) k_inproj_naive(Params p) {
    __shared__ __attribute__((aligned(16))) float lds[NAIVE_LDS_FLOATS];
    ARowPlain ar{(const bf16*)(p.ws + WS_XN), DM}; EpiInproj ep{(bf16*)(p.ws + WS_U)};
    const int nM = T / 64, nN = 2048 / 128;
    for (int u = blockIdx.x; u < nM * nN; u += gridDim.x) naive_tile<ARowPlain, EpiInproj, false>(u / nN, u % nN, DM, ar, p.w_in, nullptr, INW, ep, lds);
}
struct EpiPool { bf16* CAT; const float* ps; int g; __device__ __forceinline__ void operator()(int r, int c, const float (&a)[4], const float (&)[4]) const {
        const int cc = g * 128 + c; const f32x4 s = *(const f32x4*)(ps + cc);
        u32x2 o; o.x = pk2(a[0] * s.x, a[1] * s.y); o.y = pk2(a[2] * s.z, a[3] * s.w);
        *(u32x2*)(CAT + (size_t)r * DM + cc) = o; } };
__global__ void __launch_bounds__(512) k_poolgemm_naive(Params p) {
    __shared__ __attribute__((aligned(16))) float lds[NAIVE_LDS_FLOATS];
    const int nM = T / 64;
    for (int u = blockIdx.x; u < nM * 4; u += gridDim.x) { const int g = u & 3, tm = u >> 2;
        ARowPlain ar{(const bf16*)(p.ws + WS_P) + g * 128, PW}; EpiPool ep{(bf16*)(p.ws + WS_CAT), p.pool_scale, g};
        naive_tile<ARowPlain, EpiPool, false>(tm, 0, 128, ar, p.w_pool + (size_t)g * 128 * 128, nullptr, 128, ep, lds); }
}
struct EpiOut { const float* x; float* out; __device__ __forceinline__ void operator()(int r, int c, const float (&a)[4], const float (&)[4]) const {
        const f32x4 xv = *(const f32x4*)(x + (size_t)r * DM + c); f32x4 o = {xv.x + a[0], xv.y + a[1], xv.z + a[2], xv.w + a[3]};
        *(f32x4*)(out + (size_t)r * DM + c) = o; } };
__global__ void __launch_bounds__(512) k_outproj_naive(Params p) {
    __shared__ __attribute__((aligned(16))) float lds[NAIVE_LDS_FLOATS];
    ARowPlain ar{(const bf16*)(p.ws + WS_CAT), DM}; EpiOut ep{p.x, p.out};
    const int nM = T / 64, nN = DM / 128;
    for (int u = blockIdx.x; u < nM * nN; u += gridDim.x) naive_tile<ARowPlain, EpiOut, false>(u / nN, u % nN, DM, ar, p.w_out, nullptr, DM, ep, lds);
}

__global__ void __launch_bounds__(512) k_attn_naive(Params p) {
    __shared__ __attribute__((aligned(16))) float Ks[64 * 68];
    __shared__ __attribute__((aligned(16))) float Vs[64 * 64];
    __shared__ float Ss[64 * 65];
    __shared__ float cs[64];
    const bf16* Q = (const bf16*)(p.ws + WS_Q); const bf16* K = (const bf16*)(p.ws + WS_K); const bf16* V = (const bf16*)(p.ws + WS_V);
    bf16* CAT = (bf16*)(p.ws + WS_CAT); const float* CUM = (const float*)(p.ws + WS_CUM);
    const int tid = threadIdx.x, r = tid >> 3, part = tid & 7;
    for (int u = blockIdx.x; u < BATCH * NH * (SEQ / 64); u += gridDim.x) {
        const int qb = (SEQ / 64 - 1) - (u / (BATCH * NH)), bh = u % (BATCH * NH), b = bh / NH, h = bh % NH;
        const size_t rowbase = (size_t)b * SEQ; const int t = qb * 64 + r;
        float q[64];
        { const bf16* qp = Q + (rowbase + t) * AW + h * HD;
#pragma unroll
          for (int i = 0; i < 64; i += 2) { const unsigned v = *(const unsigned*)(qp + i); q[i] = __builtin_bit_cast(float, v << 16); q[i + 1] = __builtin_bit_cast(float, v & 0xffff0000u); } }
        const float ct = CUM[(size_t)bh * SEQ + t];
        float o[8]; float m = -INFINITY, l = 0.f;
#pragma unroll
        for (int i = 0; i < 8; ++i) o[i] = 0.f;
        for (int kt = 0; kt <= qb; ++kt) {
            __syncthreads();
            { const int kr = tid >> 3, kc = (tid & 7) * 8;
              const u32x4 kv = *(const u32x4*)(K + (rowbase + kt * 64 + kr) * AW + h * HD + kc), vv = *(const u32x4*)(V + (rowbase + kt * 64 + kr) * AW + h * HD + kc);
              const unsigned ka[4] = {kv.x, kv.y, kv.z, kv.w}, va[4] = {vv.x, vv.y, vv.z, vv.w};
#pragma unroll
              for (int i = 0; i < 4; ++i) { Ks[kr * 68 + kc + 2 * i] = __builtin_bit_cast(float, ka[i] << 16); Ks[kr * 68 + kc + 2 * i + 1] = __builtin_bit_cast(float, ka[i] & 0xffff0000u);
                  Vs[kr * 64 + kc + 2 * i] = __builtin_bit_cast(float, va[i] << 16); Vs[kr * 64 + kc + 2 * i + 1] = __builtin_bit_cast(float, va[i] & 0xffff0000u); }
              if (tid < 64) cs[tid] = CUM[(size_t)bh * SEQ + kt * 64 + tid]; }
            __syncthreads();
            float lg[8]; float mx = -INFINITY;
#pragma unroll
            for (int j = 0; j < 8; ++j) { const int s = part * 8 + j; float d = 0.f;
#pragma unroll
                for (int i = 0; i < 64; i += 4) { const f32x4 kk = *(const f32x4*)(Ks + s * 68 + i); d += q[i] * kk.x + q[i + 1] * kk.y + q[i + 2] * kk.z + q[i + 3] * kk.w; }
                d += ct - cs[s]; if (kt * 64 + s > t) d = -INFINITY; lg[j] = d; mx = fmaxf(mx, d); }
            mx = fmaxf(mx, __shfl_xor(mx, 1)); mx = fmaxf(mx, __shfl_xor(mx, 2)); mx = fmaxf(mx, __shfl_xor(mx, 4));
            const float mn = fmaxf(m, mx); const float alpha = exp2f(m - mn); float ps = 0.f;
#pragma unroll
            for (int j = 0; j < 8; ++j) { const float pv = exp2f(lg[j] - mn); ps += pv; Ss[r * 65 + part * 8 + j] = pv; }
            ps += __shfl_xor(ps, 1); ps += __shfl_xor(ps, 2); ps += __shfl_xor(ps, 4);
            l = l * alpha + ps; m = mn;
#pragma unroll
            for (int i = 0; i < 8; ++i) o[i] *= alpha;
            __syncthreads();
            for (int s = 0; s < 64; ++s) { const float pv = Ss[r * 65 + s]; const f32x4 v0 = *(const f32x4*)(Vs + s * 64 + part * 8), v1 = *(const f32x4*)(Vs + s * 64 + part * 8 + 4);
                o[0] += pv * v0.x; o[1] += pv * v0.y; o[2] += pv * v0.z; o[3] += pv * v0.w; o[4] += pv * v1.x; o[5] += pv * v1.y; o[6] += pv * v1.z; o[7] += pv * v1.w; }
        }
        const float il = 1.f / l; u32x4 ov;
        ov.x = pk2(o[0] * il, o[1] * il); ov.y = pk2(o[2] * il, o[3] * il); ov.z = pk2(o[4] * il, o[5] * il); ov.w = pk2(o[6] * il, o[7] * il);
        *(u32x4*)(CAT + (rowbase + t) * DM + PW + h * HD + part * 8) = ov;
    }
}

__global__ void __launch_bounds__(512) k_router(Params p) {
    __shared__ __attribute__((aligned(16))) float wr[1024 * 32];
    __shared__ int ch_e[128 * 4]; __shared__ float ch_g[128 * 4]; __shared__ int lcnt[32], lbase[32];
    const int tid = threadIdx.x, lane = tid & 63, wave = tid >> 6;
    for (int i = tid; i < 1024 * 32 / 4; i += 512) ((f32x4*)wr)[i] = ((const f32x4*)p.w_router)[i];
    __syncthreads();
    const float* X1 = p.out; bf16* H2 = (bf16*)(p.ws + WS_XN);
    int* cnt = (int*)(p.ws + WS_CTL) + CW_CNT; int* SEL = (int*)(p.ws + WS_SEL); int* LTK = (int*)(p.ws + WS_LTK); float* LGT = (float*)(p.ws + WS_LGT);
    f32x4 g[4];
#pragma unroll
    for (int j = 0; j < 4; ++j) g[j] = *(const f32x4*)(p.g_ffn + 4 * lane + 256 * j);
    const float br = p.b_router[lane & 31];
    for (int grp = blockIdx.x; grp < T / 128; grp += gridDim.x) {
        if (tid < 32) lcnt[tid] = 0;
        __syncthreads();
        for (int it = 0; it < 16; ++it) {
            const int lt = wave * 16 + it, m = grp * 128 + lt;
            const float* xr = X1 + (size_t)m * DM;
            f32x4 v[4]; float ss = 0.f;
#pragma unroll
            for (int j = 0; j < 4; ++j) { v[j] = *(const f32x4*)(xr + 4 * lane + 256 * j); ss += v[j].x * v[j].x + v[j].y * v[j].y + v[j].z * v[j].z + v[j].w * v[j].w; }
            const float rstd = rsqrtf(wave_sum(ss) * (1.f / DM) + RMS_EPS);
            float lg[32];
#pragma unroll
            for (int e = 0; e < 32; ++e) lg[e] = 0.f;
#pragma unroll
            for (int j = 0; j < 4; ++j) {
                v[j] = v[j] * rstd * g[j];
                u32x2 o; o.x = pk2(v[j].x, v[j].y); o.y = pk2(v[j].z, v[j].w);
                *(u32x2*)(H2 + (size_t)m * DM + 4 * lane + 256 * j) = o;
#pragma unroll
                for (int i = 0; i < 4; ++i) { const int d = 4 * lane + 256 * j + i; const float hv = v[j][i];
#pragma unroll
                    for (int e4 = 0; e4 < 8; ++e4) { const f32x4 w = *(const f32x4*)(wr + d * 32 + e4 * 4);
                        lg[e4 * 4] += hv * w.x; lg[e4 * 4 + 1] += hv * w.y; lg[e4 * 4 + 2] += hv * w.z; lg[e4 * 4 + 3] += hv * w.w; }
                    asm volatile("" ::: "memory"); }
            }
            float mine;
            {
                float a16[16];
                const bool up = lane >= 32;
#pragma unroll
                for (int e = 0; e < 16; ++e) { const float keep = up ? lg[16 + e] : lg[e], give = up ? lg[e] : lg[16 + e]; a16[e] = keep + __shfl_xor(give, 32); }
                float a8[8]; const bool u16 = (lane & 16) != 0;
#pragma unroll
                for (int e = 0; e < 8; ++e) { const float keep = u16 ? a16[8 + e] : a16[e], give = u16 ? a16[e] : a16[8 + e]; a8[e] = keep + __shfl_xor(give, 16); }
                float a4[4]; const bool u8 = (lane & 8) != 0;
#pragma unroll
                for (int e = 0; e < 4; ++e) { const float keep = u8 ? a8[4 + e] : a8[e], give = u8 ? a8[e] : a8[4 + e]; a4[e] = keep + __shfl_xor(give, 8); }
                float a2[2]; const bool u4 = (lane & 4) != 0;
#pragma unroll
                for (int e = 0; e < 2; ++e) { const float keep = u4 ? a4[2 + e] : a4[e], give = u4 ? a4[e] : a4[2 + e]; a2[e] = keep + __shfl_xor(give, 4); }
                const bool u2 = (lane & 2) != 0;
                float a1 = (u2 ? a2[1] : a2[0]) + __shfl_xor(u2 ? a2[0] : a2[1], 2);
                a1 += __shfl_xor(a1, 1);
                mine = a1;
            }
            const int myexp = ((lane >> 5) & 1) * 16 + ((lane >> 4) & 1) * 8 + ((lane >> 3) & 1) * 4 + ((lane >> 2) & 1) * 2 + ((lane >> 1) & 1);
            float val = mine + p.b_router[myexp]; (void)br;
            if (lane & 1) val = -INFINITY;
            float tv[4]; int ti[4];
#pragma unroll
            for (int k = 0; k < 4; ++k) {
                float bv = val; int bi = myexp;
#pragma unroll
                for (int o = 1; o < 64; o <<= 1) { const float ov = __shfl_xor(bv, o); const int oi = __shfl_xor(bi, o); if (ov > bv || (ov == bv && oi < bi)) { bv = ov; bi = oi; } }
                tv[k] = bv; ti[k] = bi; if (myexp == bi) val = -INFINITY;
            }
            const float e0 = 1.f, e1 = expf(tv[1] - tv[0]), e2 = expf(tv[2] - tv[0]), e3 = expf(tv[3] - tv[0]); const float inv = 1.f / (e0 + e1 + e2 + e3);
            if (lane < 4) { const float gg = (lane == 0 ? e0 : lane == 1 ? e1 : lane == 2 ? e2 : e3) * inv; const int ee = lane == 0 ? ti[0] : lane == 1 ? ti[1] : lane == 2 ? ti[2] : ti[3];
                ch_e[lt * 4 + lane] = ee; ch_g[lt * 4 + lane] = gg; atomicAdd(&lcnt[ee], 1); }
        }
        __syncthreads();
        if (tid < 32) { lbase[tid] = atomicAdd(&cnt[tid], lcnt[tid]); lcnt[tid] = 0; }
        __syncthreads();
        { const int e = ch_e[tid]; const int slot = lbase[e] + atomicAdd(&lcnt[e], 1); const int tk = (grp * 128 + (tid >> 2)) * 4 + (tid & 3);
          LTK[(size_t)e * T + slot] = tk; LGT[(size_t)e * T + slot] = ch_g[tid]; SEL[tk] = (slot << 5) | e; }
        __syncthreads();
    }
}

struct ExpertMap { int cnt[32]; int pstart[33]; };
__device__ __forceinline__ void load_expert_map(const int* cnt, int* s_cnt, int* s_ps) {
    if (threadIdx.x == 0) { int a = 0; for (int e = 0; e < 32; ++e) { const int c = cnt[e]; s_cnt[e] = c; s_ps[e] = a; a += ((c + RT - 1) / RT) * RT; } s_ps[32] = a; }
}
struct ARowGather { const bf16* H2; const int* ltk; int pstart, cnt; __device__ __forceinline__ const bf16* operator()(int r) const { const int s = r - pstart; return s < cnt ? H2 + (size_t)(ltk[s] >> 2) * DM : nullptr; } };
struct EpiUp { bf16* ACT; const float* bu; __device__ __forceinline__ void operator()(int r, int c, const float (&a)[4], const float (&a2)[4]) const {
        const f32x4 bg = *(const f32x4*)(bu + c), bl = *(const f32x4*)(bu + DE + c); float o[4];
#pragma unroll
        for (int i = 0; i < 4; ++i) { const float gl = fminf(a[i] + bg[i], SW_LIMIT), li = fminf(fmaxf(a2[i] + bl[i], -SW_LIMIT), SW_LIMIT); o[i] = gl * (1.f / (1.f + expf(-SW_ALPHA * gl))) * (li + 1.f); }
        u32x2 ov; ov.x = pk2(o[0], o[1]); ov.y = pk2(o[2], o[3]); *(u32x2*)(ACT + (size_t)r * DE + c) = ov; } };
__global__ void __launch_bounds__(512) k_up_naive(Params p) {
    __shared__ __attribute__((aligned(16))) float lds[NAIVE_LDS_FLOATS]; __shared__ int s_cnt[32], s_ps[33];
    load_expert_map((const int*)(p.ws + WS_CTL) + CW_CNT, s_cnt, s_ps); __syncthreads();
    const int ntm = s_ps[32] / 64, nN = DE / 128;
    for (int u = blockIdx.x; u < ntm * nN; u += gridDim.x) { const int tm = u / nN, tn = u % nN; int e = 0; while (s_ps[e + 1] <= tm * 64) ++e;
        if (tm * 64 - s_ps[e] >= s_cnt[e]) continue;
        ARowGather ar{(const bf16*)(p.ws + WS_XN), (const int*)(p.ws + WS_LTK) + (size_t)e * T, s_ps[e], s_cnt[e]}; EpiUp ep{(bf16*)(p.ws + WS_ACT), p.b_up + (size_t)e * 2 * DE};
        naive_tile<ARowGather, EpiUp, true>(tm, tn, DM, ar, p.w_up + (size_t)e * DM * 2 * DE, p.w_up + (size_t)e * DM * 2 * DE + DE, 2 * DE, ep, lds); }
}
struct ARowAct { const bf16* ACT; int pstart, cnt; __device__ __forceinline__ const bf16* operator()(int r) const { return (r - pstart) < cnt ? ACT + (size_t)r * DE : nullptr; } };
struct EpiDown { bf16* Y; const float* bd; const float* lgt; int pstart, cnt; __device__ __forceinline__ void operator()(int r, int c, const float (&a)[4], const float (&)[4]) const {
        const int s = r - pstart; if (s >= cnt) return; const float gt = lgt[s]; const f32x4 b = *(const f32x4*)(bd + c);
        u32x2 ov; ov.x = pk2((a[0] + b.x) * gt, (a[1] + b.y) * gt); ov.y = pk2((a[2] + b.z) * gt, (a[3] + b.w) * gt); *(u32x2*)(Y + (size_t)r * DM + c) = ov; } };
__global__ void __launch_bounds__(512) k_down_naive(Params p) {
    __shared__ __attribute__((aligned(16))) float lds[NAIVE_LDS_FLOATS]; __shared__ int s_cnt[32], s_ps[33];
    load_expert_map((const int*)(p.ws + WS_CTL) + CW_CNT, s_cnt, s_ps); __syncthreads();
    const int ntm = s_ps[32] / 64, nN = DM / 128;
    for (int u = blockIdx.x; u < ntm * nN; u += gridDim.x) { const int tm = u / nN, tn = u % nN; int e = 0; while (s_ps[e + 1] <= tm * 64) ++e;
        if (tm * 64 - s_ps[e] >= s_cnt[e]) continue;
        ARowAct ar{(const bf16*)(p.ws + WS_ACT), s_ps[e], s_cnt[e]}; EpiDown ep{(bf16*)(p.ws + WS_Y), p.b_down + (size_t)e * DM, (const float*)(p.ws + WS_LGT) + (size_t)e * T, s_ps[e], s_cnt[e]};
        naive_tile<ARowAct, EpiDown, false>(tm, tn, DE, ar, p.w_down + (size_t)e * DE * DM, nullptr, DM, ep, lds); }
}

__global__ void __launch_bounds__(512) k_final(Params p) {
    __shared__ int s_cnt[32], s_ps[33];
    load_expert_map((const int*)(p.ws + WS_CTL) + CW_CNT, s_cnt, s_ps); __syncthreads();
    const int tid = threadIdx.x, lane = tid & 63, wave = tid >> 6;
    const int* SEL = (const int*)(p.ws + WS_SEL); const bf16* Y = (const bf16*)(p.ws + WS_Y);
    f32x4 g[4];
#pragma unroll
    for (int j = 0; j < 4; ++j) g[j] = *(const f32x4*)(p.g_final + 4 * lane + 256 * j);
    for (int m = blockIdx.x * 8 + wave; m < T; m += gridDim.x * 8) {
        float* xr = p.out + (size_t)m * DM; f32x4 v[4];
#pragma unroll
        for (int j = 0; j < 4; ++j) v[j] = *(const f32x4*)(xr + 4 * lane + 256 * j);
#pragma unroll
        for (int k = 0; k < 4; ++k) { const int sv = SEL[m * 4 + k]; const int e = sv & 31, slot = sv >> 5; const bf16* yr = Y + (size_t)(s_ps[e] + slot) * DM;
#pragma unroll
            for (int j = 0; j < 4; ++j) { const u32x2 y = *(const u32x2*)(yr + 4 * lane + 256 * j);
                v[j].x += __builtin_bit_cast(float, y.x << 16); v[j].y += __builtin_bit_cast(float, y.x & 0xffff0000u); v[j].z += __builtin_bit_cast(float, y.y << 16); v[j].w += __builtin_bit_cast(float, y.y & 0xffff0000u); } }
        float ss = 0.f;
#pragma unroll
        for (int j = 0; j < 4; ++j) ss += v[j].x * v[j].x + v[j].y * v[j].y + v[j].z * v[j].z + v[j].w * v[j].w;
        const float rstd = rsqrtf(wave_sum(ss) * (1.f / DM) + RMS_EPS);
#pragma unroll
        for (int j = 0; j < 4; ++j) *(f32x4*)(xr + 4 * lane + 256 * j) = v[j] * rstd * g[j];
    }
}

namespace pg8 {
#define PG8_LAS __attribute__((address_space(3)))
typedef unsigned short bf16_t;
typedef short bf16x8 __attribute__((ext_vector_type(8)));
typedef float f32x4 __attribute__((ext_vector_type(4)));
typedef unsigned u32x4 __attribute__((ext_vector_type(4)));
constexpr int BM = 256, BK = 64, HALF = 128, HTB = HALF * BK * 2  , STAGE_BYTES = 8 * HTB, NXCD = 8, WGM = 8;

__host__ __device__ __forceinline__ int lds_byte(int r, int c) { const int st = (r >> 4) * 2 + (c >> 5), rr = r & 15, cc = c & 31, ob = rr * 64 + cc * 2; return st * 1024 + (ob ^ (((ob >> 9) & 1) << 5)); }
__host__ __device__ __forceinline__ void stage_rc(int b, int& R, int& C) { const int st = b / 1024, sb = b % 1024, swz = sb ^ (((sb >> 9) & 1) << 5); R = (st >> 1) * 16 + swz / 64; C = (st & 1) * 32 + (swz % 64) / 2; }
__host__ __device__ __forceinline__ int perm32(int rho) { const int n = rho >> 4, i = rho & 15; return 8 * (i >> 2) + 4 * n + (i & 3); }

struct Unit { int pm, pn, e, lrow0; size_t boff; };
struct Gemm { const bf16_t* A; const bf16_t* Bt; int K; };

struct StaticOrder {
    int nM, nN, nwg, G, c;
    __host__ __device__ void init(int M, int N, int G_, int c_) { nM = M / BM; nN = N / BM; nwg = nM * nN; G = G_; c = c_; }
    __host__ __device__ bool next(int i, Unit& u) const {
        const long L = (long)i * G + c; if (L >= nwg) return false;
        int wgid = (int)L; { const int q = nwg / NXCD, r = nwg % NXCD, xcd = wgid % NXCD, off = wgid / NXCD; wgid = (xcd < r ? xcd * (q + 1) : r * (q + 1) + (xcd - r) * q) + off; }
        const int nig = WGM * nN, gid = wgid / nig, fm = gid * WGM, gsz = (nM - fm) < WGM ? (nM - fm) : WGM;
        u.pm = fm + ((wgid % nig) % gsz); u.pn = (wgid % nig) / gsz; u.e = 0; u.lrow0 = 0; u.boff = 0; return true;
    }
};
template <int NCOL> struct MoeOrder {
    static constexpr int RG = 32 / NCOL;
    const PG8_LAS int* pt; int G, c; size_t bstride;
    __device__ __forceinline__ bool next(int i, Unit& u) const {
        const int nrt = pt[32]; const int x = c & 7, j = c >> 3;
        const int lo = (nrt * x) >> 3, hi = (nrt * (x + 1)) >> 3;
        const int rt = lo + RG * i + j / NCOL; if (rt >= hi) return false;
        int e = 0;
#pragma unroll 1
        for (int k = 1; k < 32; ++k) e += (pt[k] <= rt) ? 1 : 0;
        u.pm = rt; u.pn = j % NCOL; u.e = e; u.lrow0 = (rt - pt[e]) * BM; u.boff = (size_t)e * bstride; return true;
    }
};

__device__ __forceinline__ unsigned cvt_pk_bf16(float lo, float hi) { unsigned r; asm volatile("v_cvt_pk_bf16_f32 %0, %1, %2" : "=v"(r) : "v"(lo), "v"(hi)); return r; }

struct EpiInproj {
    static constexpr bool PERM = true;
    bf16_t* O; size_t split_stride; float qscale; unsigned* nrm;
    __device__ __forceinline__ void operator()(const f32x4 (&acc)[2][2][4][2], const Unit& u, int wr, int wc, int fr, int fq) const {
        const int row0 = u.pm * BM + wr * 64 + fr; int colt = u.pn * BM; const int t = colt >> 9; bf16_t* base = O + (size_t)t * split_stride; colt -= t * 512;
        const float sc = (t == 1) ? qscale : 1.f; const int col0 = colt + wc * 32 + 8 * fq;
#pragma unroll
        for (int ai = 0; ai < 2; ++ai)
#pragma unroll
            for (int m = 0; m < 4; ++m) { bf16_t* rowp = base + (size_t)(row0 + ai * HALF + m * 16) * 512 + col0;
#pragma unroll
                for (int bj = 0; bj < 2; ++bj) { const f32x4 v0 = acc[ai][bj][m][0] * sc, v1 = acc[ai][bj][m][1] * sc;
                    u32x4 w; w.x = cvt_pk_bf16(v0[0], v0[1]); w.y = cvt_pk_bf16(v0[2], v0[3]); w.z = cvt_pk_bf16(v1[0], v1[1]); w.w = cvt_pk_bf16(v1[2], v1[3]);
                    *(u32x4*)(rowp + bj * HALF) = w; } }
        if (t == 1 || t == 2) {
            float mx[2] = {0.f, 0.f};
#pragma unroll
            for (int ai = 0; ai < 2; ++ai)
#pragma unroll
                for (int m = 0; m < 4; ++m)
#pragma unroll
                    for (int bj = 0; bj < 2; ++bj) { const f32x4 v0 = acc[ai][bj][m][0] * sc, v1 = acc[ai][bj][m][1] * sc;
                        float s8 = v0[0] * v0[0] + v0[1] * v0[1] + v0[2] * v0[2] + v0[3] * v0[3] + v1[0] * v1[0] + v1[1] * v1[1] + v1[2] * v1[2] + v1[3] * v1[3];
                        s8 += __shfl_xor(s8, 16); s8 += __shfl_xor(s8, 32); mx[bj] = fmaxf(mx[bj], s8); }
#pragma unroll
            for (int bj = 0; bj < 2; ++bj) {
#pragma unroll
                for (int o = 1; o < 16; o <<= 1) mx[bj] = fmaxf(mx[bj], __shfl_xor(mx[bj], o));
                if ((threadIdx.x & 63) == 0) { const int head = ((u.pn & 1) * 256 + bj * HALF + wc * 32) >> 6, b = (u.pm * BM) >> 13;
                    atomicMax(nrm + (t - 1) * 32 + b * 8 + head, __float_as_uint(mx[bj] * 1.01f)); } }
        }
    }
};
struct EpiResBf16 {
    static constexpr bool PERM = true;
    const float* x; bf16_t* out;
    __device__ __forceinline__ void operator()(const f32x4 (&acc)[2][2][4][2], const Unit& u, int wr, int wc, int fr, int fq) const {
        const int row0 = u.pm * BM + wr * 64 + fr, col0 = u.pn * BM + wc * 32 + 8 * fq;
#pragma unroll
        for (int ai = 0; ai < 2; ++ai)
#pragma unroll
            for (int m = 0; m < 4; ++m) { const size_t off = (size_t)(row0 + ai * HALF + m * 16) * 1024 + col0;
#pragma unroll
                for (int bj = 0; bj < 2; ++bj) { const f32x4 v0 = *(const f32x4*)(x + off + bj * HALF) + acc[ai][bj][m][0], v1 = *(const f32x4*)(x + off + bj * HALF + 4) + acc[ai][bj][m][1];
                    u32x4 w; w.x = cvt_pk_bf16(v0[0], v0[1]); w.y = cvt_pk_bf16(v0[2], v0[3]); w.z = cvt_pk_bf16(v1[0], v1[1]); w.w = cvt_pk_bf16(v1[2], v1[3]);
                    *(u32x4*)(out + off + bj * HALF) = w; }
                if (m & 1) asm volatile("" ::: "memory"); }
    }
};
__device__ __forceinline__ float swiglu1(float g, float l) {
    const float gl = fminf(g, 7.0f), li = fminf(fmaxf(l, -7.0f), 7.0f);
    const float sg = __builtin_amdgcn_rcpf(1.0f + __builtin_amdgcn_exp2f(gl * (-1.702f * 1.4426950408889634f)));
    return gl * sg * (li + 1.0f);
}
struct EpiSwiglu {
    static constexpr bool PERM = true;
    bf16_t* ACT; const float* bup;
    __device__ __forceinline__ void operator()(const f32x4 (&acc)[2][2][4][2], const Unit& u, int wr, int wc, int fr, int fq) const {
        const int row0 = u.pm * BM + wr * 64 + fr, col0 = u.pn * HALF + wc * 32 + 8 * fq;
        const float* bb = bup + (size_t)u.e * 2048 + col0;
        f32x4 bg[2], bl[2];
#pragma unroll
        for (int n = 0; n < 2; ++n) { bg[n] = *(const f32x4*)(bb + 4 * n); bl[n] = *(const f32x4*)(bb + 1024 + 4 * n); }
#pragma unroll
        for (int ai = 0; ai < 2; ++ai)
#pragma unroll
            for (int m = 0; m < 4; ++m) { bf16_t* rowp = ACT + (size_t)(row0 + ai * HALF + m * 16) * 1024 + col0;
                const f32x4 g0 = acc[ai][0][m][0] + bg[0], g1 = acc[ai][0][m][1] + bg[1], l0 = acc[ai][1][m][0] + bl[0], l1 = acc[ai][1][m][1] + bl[1];
                u32x4 w; w.x = cvt_pk_bf16(swiglu1(g0[0], l0[0]), swiglu1(g0[1], l0[1])); w.y = cvt_pk_bf16(swiglu1(g0[2], l0[2]), swiglu1(g0[3], l0[3]));
                w.z = cvt_pk_bf16(swiglu1(g1[0], l1[0]), swiglu1(g1[1], l1[1])); w.w = cvt_pk_bf16(swiglu1(g1[2], l1[2]), swiglu1(g1[3], l1[3]));
                *(u32x4*)rowp = w; }
    }
};

constexpr float FP8_SA = 4.0f, FP8_SW = 256.0f, FP8_INV = 1.0f / (FP8_SA * FP8_SW), FP8_SY = 16.0f;
__device__ __forceinline__ unsigned pack4_fp8(float a, float b, float c, float d) { unsigned p = 0; p = __builtin_amdgcn_cvt_pk_fp8_f32(a, b, p, false); p = __builtin_amdgcn_cvt_pk_fp8_f32(c, d, p, true); return p; }
struct EpiSwiglu8 {
    static constexpr bool PERM = true;
    unsigned char* ACT; const float* bup;
    __device__ __forceinline__ void operator()(const f32x4 (&acc)[2][2][4][2], const Unit& u, int wr, int wc, int fr, int fq) const {
        const int row0 = u.pm * BM + wr * 64 + fr, col0 = u.pn * HALF + wc * 32 + 8 * fq;
        const float* bb = bup + (size_t)u.e * 2048 + col0;
        f32x4 bg[2], bl[2];
#pragma unroll
        for (int n = 0; n < 2; ++n) { bg[n] = *(const f32x4*)(bb + 4 * n); bl[n] = *(const f32x4*)(bb + 1024 + 4 * n); }
#pragma unroll
        for (int ai = 0; ai < 2; ++ai)
#pragma unroll
            for (int m = 0; m < 4; ++m) { unsigned char* rowp = ACT + (size_t)(row0 + ai * HALF + m * 16) * 1024 + col0;
                const f32x4 g0 = acc[ai][0][m][0] * FP8_INV + bg[0], g1 = acc[ai][0][m][1] * FP8_INV + bg[1], l0 = acc[ai][1][m][0] * FP8_INV + bl[0], l1 = acc[ai][1][m][1] * FP8_INV + bl[1];
                typedef unsigned u32x2_t __attribute__((ext_vector_type(2))); u32x2_t w;
                w.x = pack4_fp8(swiglu1(g0[0], l0[0]) * FP8_SA, swiglu1(g0[1], l0[1]) * FP8_SA, swiglu1(g0[2], l0[2]) * FP8_SA, swiglu1(g0[3], l0[3]) * FP8_SA);
                w.y = pack4_fp8(swiglu1(g1[0], l1[0]) * FP8_SA, swiglu1(g1[1], l1[1]) * FP8_SA, swiglu1(g1[2], l1[2]) * FP8_SA, swiglu1(g1[3], l1[3]) * FP8_SA);
                *(u32x2_t*)rowp = w; }
    }
};
struct EpiDown {
    static constexpr bool PERM = true;
    unsigned char* Y; const float* bdn; const float* lgt; const PG8_LAS int* cnt; int Ttok; float ascale;
    __device__ __forceinline__ void operator()(const f32x4 (&acc)[2][2][4][2], const Unit& u, int wr, int wc, int fr, int fq) const {
        const int rl = wr * 64 + fr, col0 = u.pn * BM + wc * 32 + 8 * fq; const int ce = cnt[u.e];
        const float* bb = bdn + (size_t)u.e * 1024 + col0; const float* gp = lgt + (size_t)u.e * Ttok + u.lrow0;
        f32x4 bv[2][2];
#pragma unroll
        for (int bj = 0; bj < 2; ++bj)
#pragma unroll
            for (int n = 0; n < 2; ++n) bv[bj][n] = *(const f32x4*)(bb + bj * HALF + 4 * n);
#pragma unroll
        for (int ai = 0; ai < 2; ++ai)
#pragma unroll
            for (int m = 0; m < 4; ++m) { const int r = rl + ai * HALF + m * 16; const float gt = (u.lrow0 + r < ce) ? gp[r] * FP8_SY : 0.f;
                unsigned char* rowp = Y + (size_t)(u.pm * BM + r) * 1024 + col0;
#pragma unroll
                for (int bj = 0; bj < 2; ++bj) { const f32x4 v0 = (acc[ai][bj][m][0] * ascale + bv[bj][0]) * gt, v1 = (acc[ai][bj][m][1] * ascale + bv[bj][1]) * gt;
                    typedef unsigned u32x2_t __attribute__((ext_vector_type(2))); u32x2_t w; w.x = pack4_fp8(v0[0], v0[1], v0[2], v0[3]); w.y = pack4_fp8(v1[0], v1[1], v1[2], v1[3]);
                    *(u32x2_t*)(rowp + bj * HALF) = w; } }
    }
};

typedef int v4i_t __attribute__((ext_vector_type(4)));
typedef int v8i_t __attribute__((ext_vector_type(8)));
template <class Epi, class Sched, bool ALIGN_EPI, bool GATHER, bool FP8 = false>
__device__ __forceinline__ void gemm_phase(PG8_LAS unsigned char* lds, const Gemm g, const Sched& S, const Epi& E, const PG8_LAS unsigned* tab, volatile PG8_LAS unsigned* prb = nullptr) {
    const int tid = threadIdx.x, wid = __builtin_amdgcn_readfirstlane(tid >> 6), lane = tid & 63, wr = wid >> 2, wc = wid & 3, fr = lane & 15, fq = lane >> 4;
    const int K = g.K, nt = K / BK;
    unsigned voffA[2], voffB[2], cby[2]; int rsl[2];
#pragma unroll
    for (int i = 0; i < 2; ++i) { int R, C; stage_rc(tid * 16 + i * 8192, R, C); const int Rb = Epi::PERM ? ((R & ~31) + perm32(R & 31)) : R;
        voffA[i] = (unsigned)(R * K + C) * 2u; voffB[i] = (unsigned)(Rb * K + C) * 2u; rsl[i] = R; cby[i] = (unsigned)C * 2u; }
    const size_t kstep = (size_t)(BK * 2);
    const size_t hstep = (size_t)HALF * K * 2;
    const size_t tstep = 2 * hstep;
    const size_t ahstep = GATHER ? 0 : hstep;
    const unsigned ldsw = (unsigned)wid * 1024u;
    const int aoff = lds_byte(wr * 64 + fr, fq * 8), boff = lds_byte(wc * 32 + fr, fq * 8);
#define PG8_SA(b, h) (((b) * 2 + (h)) * HTB)
#define PG8_SB(b, h) ((4 + (b) * 2 + (h)) * HTB)
#define PG8_STAGE(bufoff, gbase, voff) do { _Pragma("unroll") for (int _i = 0; _i < 2; ++_i) \
        __builtin_amdgcn_global_load_lds((const unsigned*)((const char*)(gbase) + (voff)[_i]), (PG8_LAS unsigned*)(lds + (bufoff) + ldsw + _i * 8192), 16, 0, 0); } while (0)
#define PG8_LD16(off) (*(const PG8_LAS v4i_t*)(lds + (off)))
#define PG8_LDA(dst, b, h) do { _Pragma("unroll") for (int m = 0; m < 4; ++m) { if constexpr (FP8) dst##8[m] = __builtin_shufflevector(PG8_LD16(PG8_SA(b, h) + aoff + m * 2048), PG8_LD16(PG8_SA(b, h) + aoff + m * 2048 + 1024), 0, 1, 2, 3, 4, 5, 6, 7); \
        else { _Pragma("unroll") for (int k = 0; k < 2; ++k) dst[m][k] = *(const PG8_LAS bf16x8*)(lds + PG8_SA(b, h) + aoff + m * 2048 + k * 1024); } } } while (0)
#define PG8_LDB(dst, b, h) do { _Pragma("unroll") for (int n = 0; n < 2; ++n) { if constexpr (FP8) dst##8[n] = __builtin_shufflevector(PG8_LD16(PG8_SB(b, h) + boff + n * 2048), PG8_LD16(PG8_SB(b, h) + boff + n * 2048 + 1024), 0, 1, 2, 3, 4, 5, 6, 7); \
        else { _Pragma("unroll") for (int k = 0; k < 2; ++k) dst[n][k] = *(const PG8_LAS bf16x8*)(lds + PG8_SB(b, h) + boff + n * 2048 + k * 1024); } } } while (0)
#define PG8_MMA(ai, bj, At, Bt) do { __builtin_amdgcn_s_setprio(1); _Pragma("unroll") for (int m = 0; m < 4; ++m) _Pragma("unroll") for (int n = 0; n < 2; ++n) { \
        if constexpr (FP8) asm volatile("s_nop 1\n\tv_mfma_f32_16x16x128_f8f6f4 %0, %1, %2, %0" : "+v"(acc[ai][bj][m][n]) : "v"(Bt##8[n]), "v"(At##8[m]));   \
        else { _Pragma("unroll") for (int k = 0; k < 2; ++k) acc[ai][bj][m][n] = __builtin_amdgcn_mfma_f32_16x16x32_bf16(Bt[n][k], At[m][k], acc[ai][bj][m][n], 0, 0, 0); } } \
        __builtin_amdgcn_s_setprio(0); } while (0)
#define PG8_WAIT_V(n) asm volatile("s_waitcnt vmcnt(" #n ")" ::: "memory")
#define PG8_WAIT_L(n) asm volatile("s_waitcnt lgkmcnt(" #n ")" ::: "memory")
#define PG8_BAR __builtin_amdgcn_s_barrier()
#define PG8_SCHED __builtin_amdgcn_sched_barrier(0)
    Unit cur, nxt; int ui = 0;
    if (!S.next(0, cur)) return;
    f32x4 acc[2][2][4][2];
#pragma unroll
    for (int a = 0; a < 2; ++a)
#pragma unroll
        for (int b = 0; b < 2; ++b)
#pragma unroll
            for (int m = 0; m < 4; ++m)
#pragma unroll
                for (int n = 0; n < 2; ++n) acc[a][b][m][n] = (f32x4){0.f, 0.f, 0.f, 0.f};
    bf16x8 At[4][2], B0[2][2], B1[2][2]; v8i_t At8[4], B08[2], B18[2];
    const char* cA = GATHER ? (const char*)g.A : (const char*)g.A + (size_t)cur.pm * tstep; const char* cB = (const char*)g.Bt + cur.boff + (size_t)cur.pn * tstep;
    unsigned cv0[2], cv1[2], nv0[2], nv1[2];
#pragma unroll
    for (int i = 0; i < 2; ++i) { if constexpr (GATHER) { cv0[i] = tab[rsl[i]] + cby[i]; cv1[i] = tab[HALF + rsl[i]] + cby[i]; } else { cv0[i] = voffA[i]; cv1[i] = voffA[i]; } nv0[i] = cv0[i]; nv1[i] = cv1[i]; }
    PG8_STAGE(PG8_SB(0, 0), cB, voffB); PG8_STAGE(PG8_SB(0, 1), cB + hstep, voffB); PG8_STAGE(PG8_SA(0, 0), cA, cv0); PG8_STAGE(PG8_SA(0, 1), cA + ahstep, cv1);
    if (wr == 1) PG8_BAR;
    PG8_WAIT_V(2); PG8_BAR;
    PG8_STAGE(PG8_SB(1, 0), cB + kstep, voffB); PG8_STAGE(PG8_SA(1, 0), cA + kstep, cv0); PG8_STAGE(PG8_SB(1, 1), cB + hstep + kstep, voffB);
    PG8_WAIT_V(6); PG8_BAR;
    for (;;) {
        const bool has_next = S.next(ui + 1, nxt);
        const char* nA = has_next ? (GATHER ? (const char*)g.A : (const char*)g.A + (size_t)nxt.pm * tstep) : cA; const char* nB = has_next ? (const char*)g.Bt + nxt.boff + (size_t)nxt.pn * tstep : cB;
        if constexpr (GATHER) {
#pragma unroll
            for (int i = 0; i < 2; ++i) { if (has_next) { nv0[i] = tab[(ui + 1) * BM + rsl[i]] + cby[i]; nv1[i] = tab[(ui + 1) * BM + HALF + rsl[i]] + cby[i]; } else { nv0[i] = cv0[i]; nv1[i] = cv1[i]; } }
        }
        for (int t = 0; t < nt; t += 2) {
            const bool last = (t == nt - 2);
            const char* a1 = cA + (size_t)(t + 1) * kstep;
            const char* a2 = last ? nA : cA + (size_t)(t + 2) * kstep; const char* b2 = last ? nB : cB + (size_t)(t + 2) * kstep;
            const char* a3 = a2 + kstep; const char* b3 = b2 + kstep;
            unsigned s0[2], s1[2];
#pragma unroll
            for (int i = 0; i < 2; ++i) { s0[i] = last ? nv0[i] : cv0[i]; s1[i] = last ? nv1[i] : cv1[i]; }
            PG8_LDB(B0, 0, 0); PG8_LDB(B1, 0, 1); PG8_SCHED; PG8_LDA(At, 0, 0); PG8_STAGE(PG8_SA(1, 1), a1 + ahstep, cv1);
            PG8_WAIT_V(8); PG8_WAIT_L(0); PG8_BAR; PG8_MMA(0, 0, At, B0); PG8_MMA(0, 1, At, B1); PG8_BAR; PG8_SCHED;
            PG8_LDA(At, 0, 1); PG8_STAGE(PG8_SB(0, 0), b2, voffB); PG8_STAGE(PG8_SB(0, 1), b2 + hstep, voffB); PG8_STAGE(PG8_SA(0, 0), a2, s0);
            PG8_WAIT_V(8); PG8_WAIT_L(0); PG8_BAR; PG8_MMA(1, 0, At, B0); PG8_MMA(1, 1, At, B1); PG8_BAR; PG8_SCHED;
            PG8_LDB(B0, 1, 0); PG8_LDB(B1, 1, 1); PG8_SCHED; PG8_LDA(At, 1, 0); PG8_STAGE(PG8_SA(0, 1), a2 + ahstep, s1);
            PG8_WAIT_V(8); PG8_WAIT_L(0); PG8_BAR; PG8_MMA(0, 0, At, B0); PG8_MMA(0, 1, At, B1); PG8_BAR; PG8_SCHED;
            PG8_LDA(At, 1, 1); PG8_STAGE(PG8_SB(1, 0), b3, voffB); PG8_STAGE(PG8_SB(1, 1), b3 + hstep, voffB); PG8_STAGE(PG8_SA(1, 0), a3, s0);
            PG8_WAIT_V(8); PG8_WAIT_L(0); PG8_BAR; PG8_MMA(1, 0, At, B0); PG8_MMA(1, 1, At, B1); PG8_BAR; PG8_SCHED;
        }
        unsigned long long pt0_ = 0; if (prb) pt0_ = __builtin_amdgcn_s_memrealtime();
        if constexpr (FP8) asm volatile("s_nop 15\n\ts_nop 7" ::: "memory");
        if constexpr (ALIGN_EPI) { if (wr == 0) PG8_BAR; }
        E(acc, cur, wr, wc, fr, fq);
        if (prb) { asm volatile("s_waitcnt vmcnt(0)" ::: "memory"); if (threadIdx.x == 0) prb[0] += (unsigned)(__builtin_amdgcn_s_memrealtime() - pt0_); }
        if (!has_next) break;
#pragma unroll
        for (int a = 0; a < 2; ++a)
#pragma unroll
            for (int b = 0; b < 2; ++b)
#pragma unroll
                for (int m = 0; m < 4; ++m)
#pragma unroll
                    for (int n = 0; n < 2; ++n) acc[a][b][m][n] = (f32x4){0.f, 0.f, 0.f, 0.f};
        cur = nxt; cA = nA; cB = nB; ++ui;
#pragma unroll
        for (int i = 0; i < 2; ++i) { cv0[i] = nv0[i]; cv1[i] = nv1[i]; }
        if constexpr (ALIGN_EPI) { if (wr == 1) PG8_BAR; }
    }
    PG8_WAIT_V(0);
    if constexpr (!ALIGN_EPI) { if (wr == 0) PG8_BAR; }
    PG8_BAR;
#undef PG8_SA
#undef PG8_SB
#undef PG8_STAGE
#undef PG8_LDA
#undef PG8_LD16
#undef PG8_LDB
#undef PG8_MMA
#undef PG8_WAIT_V
#undef PG8_WAIT_L
#undef PG8_BAR
#undef PG8_SCHED
}
}
#include <hip/hip_bf16.h>
#include <cmath>
namespace attn_body {
using bf16=__hip_bfloat16;
using bf16x8=__attribute__((ext_vector_type(8)))short;
using s16x4=__attribute__((ext_vector_type(4)))short;
using f32x16=__attribute__((ext_vector_type(16)))float;
using u32x4=__attribute__((ext_vector_type(4)))unsigned;
constexpr int BATCH=4,NHEAD=8,SEQ=8192,D=64,DM=NHEAD*D,ODM=1024;
constexpr int NW=8,QBLK=32,QB=QBLK*NW,KVBLK=64,NQB=SEQ/QB;
constexpr int ATTN_PITCH=DM, ATTN_UNIT_ROWS=QB;
__device__ __forceinline__ int crow(int r,int hi){return (r&3)+8*(r>>2)+4*hi;}
#define SBAR() __builtin_amdgcn_sched_barrier(0)
__device__ __forceinline__ void cmask(f32x16&p0,f32x16&p1,int jb,int qrel,int hi){
  const float NEG=-INFINITY; int kb=64*jb+4*hi;
  #pragma unroll
  for(int r=0;r<16;++r){int kv=kb+(r&3)+8*(r>>2); if(kv>qrel)p0[r]=NEG; if(kv+32>qrel)p1[r]=NEG;}
}

constexpr int NSLOT=3, SLOTB=8192;
constexpr int LDS_K=0, LDS_V=NSLOT*SLOTB, LDS_WS=2*NSLOT*SLOTB, LDS_OST=LDS_WS+NW*64*4, LDS_C2=LDS_OST+NW*4096, LDS_BYTES=LDS_C2+SEQ*4;
constexpr float C2=0.125f*1.4426950408889634f;
__device__ __forceinline__ void glds16(const void*gsrc,unsigned lds_dst){unsigned keep;
  asm volatile("s_mov_b32 %0, m0\n\ts_mov_b32 m0, %2\n\ts_nop 0\n\tglobal_load_lds_dwordx4 %1, off\n\ts_mov_b32 m0, %0":"=&s"(keep):"v"(gsrc),"s"(lds_dst):"memory");}
__device__ __forceinline__ float max3f(float a,float b,float c){float r;asm("v_max3_f32 %0, %1, %2, %3":"=v"(r):"v"(a),"v"(b),"v"(c));return r;}
__device__ __forceinline__ float max2f(float a,float b){float r;asm("v_max_f32_e32 %0, %1, %2":"=v"(r):"v"(a),"v"(b));return r;}
__device__ __forceinline__ float fadd_s(float a,float b){float r;asm("v_add_f32_e32 %0, %1, %2":"=v"(r):"v"(a),"v"(b));return r;}
__device__ __forceinline__ float fsub_s(float a,float b){float r;asm("v_sub_f32_e32 %0, %1, %2":"=v"(r):"v"(a),"v"(b));return r;}
typedef float f32x2_t __attribute__((ext_vector_type(2))); typedef float f32x4_t __attribute__((ext_vector_type(4))); typedef __bf16 bf16x2_t __attribute__((ext_vector_type(2)));
__device__ __forceinline__ unsigned cvtpk_s(float lo,float hi){f32x2_t v={lo,hi};bf16x2_t b=__builtin_convertvector(v,bf16x2_t);return __builtin_bit_cast(unsigned,b);}
#define WAIT_BAR(N) asm volatile("s_waitcnt vmcnt(" #N ") lgkmcnt(0)\n\ts_barrier":::"memory")

__device__ __forceinline__ void qkt(f32x16&p0,f32x16&p1,const char*Kslot,const bf16x8*qr,const f32x16&cin0,const f32x16&cin1,int r32,int hi){
  const char*kb=Kslot+hi*1024+r32*16;
  #pragma unroll
  for(int d0=0;d0<4;++d0){
    const bf16x8 b0=*reinterpret_cast<const bf16x8*>(kb+d0*2048);
    const bf16x8 b1=*reinterpret_cast<const bf16x8*>(kb+d0*2048+512);
    if(d0==0){p0=__builtin_amdgcn_mfma_f32_32x32x16_bf16(b0,qr[0],cin0,0,0,0);p1=__builtin_amdgcn_mfma_f32_32x32x16_bf16(b1,qr[0],cin1,0,0,0);}
    else{p0=__builtin_amdgcn_mfma_f32_32x32x16_bf16(b0,qr[d0],p0,0,0,0);p1=__builtin_amdgcn_mfma_f32_32x32x16_bf16(b1,qr[d0],p1,0,0,0);}}
}
typedef __attribute__((address_space(3))) const char* lds_cptr;
typedef short v4i16_t __attribute__((ext_vector_type(4)));
__device__ __forceinline__ void kload8(bf16x8*kf,lds_cptr kp){
  kf[0]=*(const __attribute__((address_space(3))) bf16x8*)(kp);      kf[1]=*(const __attribute__((address_space(3))) bf16x8*)(kp+512);
  kf[2]=*(const __attribute__((address_space(3))) bf16x8*)(kp+2048); kf[3]=*(const __attribute__((address_space(3))) bf16x8*)(kp+2560);
  kf[4]=*(const __attribute__((address_space(3))) bf16x8*)(kp+4096); kf[5]=*(const __attribute__((address_space(3))) bf16x8*)(kp+4608);
  kf[6]=*(const __attribute__((address_space(3))) bf16x8*)(kp+6144); kf[7]=*(const __attribute__((address_space(3))) bf16x8*)(kp+6656);
}
__device__ __forceinline__ void kload2(bf16x8*kf,lds_cptr kp,int j){ kf[2*j]=*(const __attribute__((address_space(3))) bf16x8*)(kp+j*2048); kf[2*j+1]=*(const __attribute__((address_space(3))) bf16x8*)(kp+j*2048+512); }
__device__ __forceinline__ s16x4 vtr(lds_cptr p){ return __builtin_bit_cast(s16x4,__builtin_amdgcn_ds_read_tr16_b64_v4i16((__attribute__((address_space(3))) v4i16_t*)p)); }
__device__ __forceinline__ float rowmax(const f32x16&p0,const f32x16&p1){
  float a=max3f(p0[0],p0[1],p1[0]),b=max3f(p0[2],p0[3],p1[1]);a=max3f(a,p1[2],p1[3]);
  #pragma unroll
  for(int r=4;r<16;r+=4){a=max3f(a,p0[r],p0[r+1]);b=max3f(b,p0[r+2],p0[r+3]);a=max3f(a,p1[r],p1[r+1]);b=max3f(b,p1[r+2],p1[r+3]);}
  const float m=max2f(a,b);
  auto rr=__builtin_amdgcn_permlane32_swap(__float_as_uint(m),__float_as_uint(m),false,false);
  return max2f(__uint_as_float(rr[0]),__uint_as_float(rr[1]));
}
__device__ __forceinline__ void pv(f32x16*o,int vb,bf16x8 pa0,bf16x8 pa1,bf16x8 pa2,bf16x8 pa3){
  #pragma unroll
  for(int d0=0;d0<2;++d0){s16x4 lo[4],hi[4];
    #pragma unroll
    for(int ks=0;ks<4;++ks){
      asm volatile("ds_read_b64_tr_b16 %0,%1 offset:%c2":"=&v"(lo[ks]):"v"(vb),"i"(d0*4096+ks*1024):"memory");
      asm volatile("ds_read_b64_tr_b16 %0,%1 offset:%c2":"=&v"(hi[ks]):"v"(vb),"i"(d0*4096+ks*1024+512):"memory");}
    asm volatile("s_waitcnt lgkmcnt(0)":::"memory");SBAR();
    #define PK(k) (bf16x8){lo[k][0],lo[k][1],lo[k][2],lo[k][3],hi[k][0],hi[k][1],hi[k][2],hi[k][3]}
    o[d0]=__builtin_amdgcn_mfma_f32_32x32x16_bf16(pa0,PK(0),o[d0],0,0,0);
    o[d0]=__builtin_amdgcn_mfma_f32_32x32x16_bf16(pa1,PK(1),o[d0],0,0,0);
    o[d0]=__builtin_amdgcn_mfma_f32_32x32x16_bf16(pa2,PK(2),o[d0],0,0,0);
    o[d0]=__builtin_amdgcn_mfma_f32_32x32x16_bf16(pa3,PK(3),o[d0],0,0,0);
    #undef PK
  }
}

#ifndef ATTN_STORE16
#define ATTN_STORE16(p,v) (*(u32x4*)(p)=(v))
#endif
template<int THRL> __device__ __forceinline__ void attn_unit(int b,int h,int qb,const bf16*Q,const bf16*__restrict__ K,const bf16*__restrict__ V,bf16*O,char*shm,float qkb2){
  const int tid=threadIdx.x,lane=tid&63,r32=lane&31,hi=lane>>5; const int wid=__builtin_amdgcn_readfirstlane(tid>>6);
  const long rowbase=(long)b*SEQ; const int q0=qb*QB;
  const bf16*Qw=Q+(rowbase+q0+wid*QBLK)*DM+h*D;
  const bf16*Kh=K+rowbase*DM+h*D,*Vh=V+rowbase*DM+h*D;
  const unsigned lds0=(unsigned)(uintptr_t)shm; const lds_cptr shm3=(lds_cptr)shm;
  float*wsf=(float*)(shm+LDS_WS)+wid*64;
  const bf16*ksrc=Kh+(long)lane*DM+wid*8;
  const bf16*vsrc=Vh+(long)(16*(wid&3)+(lane>>2))*DM+(wid>>2)*32+(lane&3)*8;
  const unsigned kdst=lds0+LDS_K+wid*1024, vdst=lds0+LDS_V+wid*1024;
  #define DMA_K(t,slot) glds16(ksrc+(long)(t)*KVBLK*DM,(unsigned)__builtin_amdgcn_readfirstlane(kdst+(slot)))
  #define DMA_V(t,slot) glds16(vsrc+(long)(t)*KVBLK*DM,(unsigned)__builtin_amdgcn_readfirstlane(vdst+(slot)))
  const int vb0=(int)(lds0+LDS_V)+((lane>>4)&1)*32+(lane&3)*8+(4*hi+((lane&15)>>2))*64;
  const char*Kbase=shm+LDS_K; bf16x8 kf[8];
  const lds_cptr kp0=shm3+LDS_K+hi*1024+r32*16; const lds_cptr vp0=shm3+LDS_V+((lane>>4)&1)*32+(lane&3)*8+(4*hi+((lane&15)>>2))*64;
  const int NT=(q0+QB)/KVBLK;
  int j0=0;
  { const __attribute__((address_space(3))) float* c2f=(const __attribute__((address_space(3))) float*)((lds_cptr)shm+LDS_C2); const float cq=c2f[q0]+qkb2+40.0f;
    int lo_=0,hi_=(NT-4)>>1;
    while(lo_<hi_){ const int mid=(lo_+hi_+1)>>1; if(cq-c2f[128*mid-1]<0.f)lo_=mid; else hi_=mid-1; }
    j0=__builtin_amdgcn_readfirstlane(2*lo_); }
  DMA_K(j0,0);DMA_V(j0,0);DMA_K(j0+1,SLOTB);
  bf16x8 qr[4];
  #pragma unroll
  for(int d0=0;d0<4;++d0)qr[d0]=*reinterpret_cast<const bf16x8*>(&Qw[(long)r32*DM+d0*16+hi*8]);
  float l_reg=0.f;f32x16 o[2];o[0]=f32x16{};o[1]=f32x16{};
  typedef __attribute__((address_space(3))) const f32x4_t* lds_f4ptr; const lds_f4ptr c2p=(lds_f4ptr)(shm3+LDS_C2)+hi;
  float ctm=((const __attribute__((address_space(3))) float*)(shm3+LDS_C2))[q0+wid*QBLK+r32];
  f32x16 cin0,cin1;
  #define CIN(t) do{ const lds_f4ptr cq_=c2p+16*(t); const f32x4_t a0_=cq_[0],a1_=cq_[2],a2_=cq_[4],a3_=cq_[6],b0_=cq_[8],b1_=cq_[10],b2_=cq_[12],b3_=cq_[14]; \
    _Pragma("unroll") for(int j_=0;j_<4;++j_){ cin0[j_]=ctm-a0_[j_];cin0[4+j_]=ctm-a1_[j_];cin0[8+j_]=ctm-a2_[j_];cin0[12+j_]=ctm-a3_[j_]; cin1[j_]=ctm-b0_[j_];cin1[4+j_]=ctm-b1_[j_];cin1[8+j_]=ctm-b2_[j_];cin1[12+j_]=ctm-b3_[j_]; } }while(0)
  const int qrel=wid*QBLK+r32;
  #define CMASK(P0,P1,t) do{int jb_=(t)-(NT-4); if(jb_>=0)cmask(P0,P1,jb_,qrel,hi);}while(0)
  bool resc=false;
  #define START(P0,P1) do{ const float rm=rowmax(P0,P1); resc=false; \
    if(__any(rm>(float)THRL)){ const float dl=__builtin_fmaxf(rm,0.f); ctm-=dl; \
      _Pragma("unroll") for(int r=0;r<16;++r){P0[r]-=dl;P1[r]-=dl;} } \
    _Pragma("unroll") for(int r=0;r<16;++r)P0[r]=__builtin_amdgcn_exp2f(P0[r]); }while(0)
  #define RESC() do{ if(resc){ asm volatile("s_waitcnt lgkmcnt(0)":::"memory"); \
      _Pragma("unroll") for(int d_=0;d_<2;++d_) _Pragma("unroll") for(int r=0;r<16;++r)o[d_][r]*=wsf[crow(r,hi)]; } }while(0)
  f32x16 pA0,pA1,pB0,pB1;
  int sl_prev=0,sl_cur=0,sl_next=SLOTB;
  #define ROT() do{sl_prev=sl_cur;sl_cur=sl_next;sl_next=(sl_next==(NSLOT-1)*SLOTB)?0:sl_next+SLOTB;}while(0)
  DMA_K(j0+2,2*SLOTB);
  WAIT_BAR(3);
  CIN(j0); qkt(pA0,pA1,Kbase,qr,cin0,cin1,r32,hi);asm volatile("s_nop 15\n\ts_nop 7":"+v"(pA0),"+v"(pA1));CMASK(pA0,pA1,j0);
  START(pA0,pA1);
  _Pragma("unroll") for(int r=0;r<16;++r)pA1[r]=__builtin_amdgcn_exp2f(pA1[r]);
  WAIT_BAR(0);
  DMA_K(j0+3,0);DMA_V(j0+1,SLOTB);
  ROT();
  kload8(kf,kp0+sl_cur);
  WAIT_BAR(2);
  s16x4 vlo[8],vhi[8]; u32x4 pw0,pw1,pw2,pw3;
  #define PKW(P,B) cvtpk_s(P[B],P[B+1])
  #define PAF(k) __builtin_bit_cast(bf16x8,pw##k)
  #define VFR(i) (bf16x8){vlo[i][0],vlo[i][1],vlo[i][2],vlo[i][3],vhi[i][0],vhi[i][1],vhi[i][2],vhi[i][3]}
  #define PIN(x) asm volatile("":"+v"(x))
  #define MX3(a,b,c) __builtin_fmaxf(__builtin_fmaxf((a),(b)),(c))
  #define GAPA(MF,A0,A1,A2,A3,W0,W1,PW) do{ MF; sacc+=A0; sacc+=A1; sacc+=A2; sacc+=A3; PIN(sacc); W0; W1; PIN(PW); SBAR(); }while(0)
  #define EX(v) __builtin_amdgcn_exp2f(v)
  #define GAPB(MF,X,B) do{ MF; X[B]=EX(X[B]); X[B+1]=EX(X[B+1]); X[B+2]=EX(X[B+2]); X[B+3]=EX(X[B+3]); PIN(X); SBAR(); }while(0)
  #define VRD(i) do{ vlo[i]=vtr(vp_+(((i)>>2)*4096+((i)&3)*1024)); vhi[i]=vtr(vp_+(((i)>>2)*4096+((i)&3)*1024+512)); }while(0)
  #define KRD(G,j) do{ if(G){ kload2(kf,kp0+sl_next,j); SBAR(); } }while(0)
  #define STEP(C0,C1,P0,P1,t,GK,GV,GL) do{ SBAR(); CIN(t); SBAR(); \
    const lds_cptr vp_=vp0+sl_prev; \
    VRD(0); SBAR(); float sacc=(P0[0]+P0[1]); \
    GAPA(C0=__builtin_amdgcn_mfma_f32_32x32x16_bf16(kf[0],qr[0],cin0,0,0,0), P0[2],P0[3],P0[4],P0[5],     pw0[0]=PKW(P0,0), pw0[1]=PKW(P0,2), pw0); \
    VRD(4); SBAR(); GAPA(C1=__builtin_amdgcn_mfma_f32_32x32x16_bf16(kf[1],qr[0],cin1,0,0,0), P0[6],P0[7],P0[8],P0[9],     pw0[2]=PKW(P0,4), pw0[3]=PKW(P0,6), pw0); \
    VRD(1); SBAR(); GAPA(C0=__builtin_amdgcn_mfma_f32_32x32x16_bf16(kf[2],qr[1],C0,0,0,0),   P0[10],P0[11],P0[12],P0[13], pw1[0]=PKW(P0,8), pw1[1]=PKW(P0,10), pw1); \
    VRD(5); SBAR(); GAPA(C1=__builtin_amdgcn_mfma_f32_32x32x16_bf16(kf[3],qr[1],C1,0,0,0),   P0[14],P0[15],P1[0],P1[1],   pw1[2]=PKW(P0,12),pw1[3]=PKW(P0,14), pw1); \
    VRD(2); SBAR(); GAPA(C0=__builtin_amdgcn_mfma_f32_32x32x16_bf16(kf[4],qr[2],C0,0,0,0),   P1[2],P1[3],P1[4],P1[5],     pw2[0]=PKW(P1,0), pw2[1]=PKW(P1,2), pw2); \
    VRD(6); SBAR(); GAPA(C1=__builtin_amdgcn_mfma_f32_32x32x16_bf16(kf[5],qr[2],C1,0,0,0),   P1[6],P1[7],P1[8],P1[9],     pw2[2]=PKW(P1,4), pw2[3]=PKW(P1,6), pw2); \
    VRD(3); SBAR(); GAPA(C0=__builtin_amdgcn_mfma_f32_32x32x16_bf16(kf[6],qr[3],C0,0,0,0),   P1[10],P1[11],P1[12],P1[13], pw3[0]=PKW(P1,8), pw3[1]=PKW(P1,10), pw3); \
    VRD(7); SBAR(); GAPA(C1=__builtin_amdgcn_mfma_f32_32x32x16_bf16(kf[7],qr[3],C1,0,0,0),   P1[14],P1[15],0.f,0.f,       pw3[2]=PKW(P1,12),pw3[3]=PKW(P1,14), pw3); \
    l_reg+=sacc; \
    if(GK){DMA_K((t)+3,sl_cur);} if(GV){DMA_V((t)+1,sl_next);} \
    CMASK(C0,C1,t); \
    { float a=MX3(C0[0],C0[1],C1[0]),b=MX3(C0[2],C0[3],C1[1]); a=MX3(a,C1[2],C1[3]); \
      _Pragma("unroll") for(int r=4;r<16;r+=4){a=MX3(a,C0[r],C0[r+1]);b=MX3(b,C0[r+2],C0[r+3]);a=MX3(a,C1[r],C1[r+1]);b=MX3(b,C1[r+2],C1[r+3]);} \
      float rm=__builtin_fmaxf(a,b); { auto rr=__builtin_amdgcn_permlane32_swap(__float_as_uint(rm),__float_as_uint(rm),false,false); rm=__builtin_fmaxf(__uint_as_float(rr[0]),__uint_as_float(rr[1])); } \
      resc=false; \
      if(__builtin_expect(__any(rm>(float)THRL),0)){ const float dl=__builtin_fmaxf(rm,0.f); ctm-=dl; \
        _Pragma("unroll") for(int r=0;r<16;++r){C0[r]-=dl;C1[r]-=dl;} \
        const float f=__builtin_amdgcn_exp2f(-dl); l_reg*=f; if(hi==0)wsf[r32]=f; resc=true; } } \
    SBAR(); \
    GAPB(o[0]=__builtin_amdgcn_mfma_f32_32x32x16_bf16(PAF(0),VFR(0),o[0],0,0,0), C0,0); \
    GAPB(o[1]=__builtin_amdgcn_mfma_f32_32x32x16_bf16(PAF(0),VFR(4),o[1],0,0,0), C0,4); \
    KRD(GL,0); GAPB(o[0]=__builtin_amdgcn_mfma_f32_32x32x16_bf16(PAF(1),VFR(1),o[0],0,0,0), C0,8); \
    KRD(GL,1); GAPB(o[1]=__builtin_amdgcn_mfma_f32_32x32x16_bf16(PAF(1),VFR(5),o[1],0,0,0), C0,12); \
    KRD(GL,2); GAPB(o[0]=__builtin_amdgcn_mfma_f32_32x32x16_bf16(PAF(2),VFR(2),o[0],0,0,0), C1,0); \
    KRD(GL,3); GAPB(o[1]=__builtin_amdgcn_mfma_f32_32x32x16_bf16(PAF(2),VFR(6),o[1],0,0,0), C1,4); \
    GAPB(o[0]=__builtin_amdgcn_mfma_f32_32x32x16_bf16(PAF(3),VFR(3),o[0],0,0,0), C1,8); \
    GAPB(o[1]=__builtin_amdgcn_mfma_f32_32x32x16_bf16(PAF(3),VFR(7),o[1],0,0,0), C1,12); \
    }while(0)
  int t=j0+1;
  #undef CMASK
  #define CMASK(P0,P1,t) do{}while(0)
  for(;t+5<NT;t+=2){
    STEP(pB0,pB1,pA0,pA1,t,true,true,true);     WAIT_BAR(2); RESC(); ROT();
    STEP(pA0,pA1,pB0,pB1,t+1,true,true,true);   WAIT_BAR(2); RESC(); ROT();
  }
  #undef CMASK
  #define CMASK(P0,P1,t) do{int jb_=(t)-(NT-4); if(jb_>=0)cmask(P0,P1,jb_,qrel,hi);}while(0)
  #define ENDW(tt) do{ if((tt)+3<NT){WAIT_BAR(2);} else if((tt)+2<NT){WAIT_BAR(1);} else {WAIT_BAR(0);} }while(0)
  for(;t+1<NT;t+=2){
    STEP(pB0,pB1,pA0,pA1,t,(t+3<NT),(t+1<NT),(t+1<NT));       ENDW(t);   RESC(); ROT();
    STEP(pA0,pA1,pB0,pB1,t+1,(t+4<NT),(t+2<NT),(t+2<NT));     ENDW(t+1); RESC(); ROT();
  }
  STEP(pB0,pB1,pA0,pA1,NT-1,false,false,false); RESC();
  { float sacc=pB0[0]+pB0[1]; _Pragma("unroll") for(int r=2;r<16;++r)sacc+=pB0[r]; _Pragma("unroll") for(int r=0;r<16;++r)sacc+=pB1[r]; l_reg+=sacc;
    pw0=(u32x4){PKW(pB0,0),PKW(pB0,2),PKW(pB0,4),PKW(pB0,6)};pw1=(u32x4){PKW(pB0,8),PKW(pB0,10),PKW(pB0,12),PKW(pB0,14)};pw2=(u32x4){PKW(pB1,0),PKW(pB1,2),PKW(pB1,4),PKW(pB1,6)};pw3=(u32x4){PKW(pB1,8),PKW(pB1,10),PKW(pB1,12),PKW(pB1,14)};
    SBAR(); pv(o,vb0+sl_cur,PAF(0),PAF(1),PAF(2),PAF(3)); }
  #undef PKW
  #undef PAF
  #undef VFR
  #undef PIN
  #undef MX3
  #undef GAPA
  #undef GAPB
  #undef EX
  #undef VRD
  #undef KRD
  #undef STEP
  #undef ENDW
  {auto rr=__builtin_amdgcn_permlane32_swap(__float_as_uint(l_reg),__float_as_uint(l_reg),false,false);l_reg=__uint_as_float(rr[0])+__uint_as_float(rr[1]);}
  if(hi==0)wsf[32+r32]=l_reg;asm volatile("s_waitcnt lgkmcnt(0)":::"memory");
  float rli[16];
  #pragma unroll
  for(int r=0;r<16;++r)rli[r]=__builtin_amdgcn_rcpf(wsf[32+crow(r,hi)]);
  bf16*Ow=O+(rowbase+q0+wid*QBLK)*ODM+h*D;
  { bf16*stg=(bf16*)(shm+LDS_OST)+wid*2048;
    #pragma unroll
    for(int r=0;r<16;++r){const int orow=crow(r,hi);
      #pragma unroll
      for(int d0=0;d0<2;++d0)stg[orow*64+d0*32+r32]=__float2bfloat16(o[d0][r]*rli[r]);}
    asm volatile("s_waitcnt lgkmcnt(0)":::"memory");
    #pragma unroll
    for(int i=0;i<4;++i){const int row=i*8+(lane>>3),ch=lane&7; const u32x4 v=*(const u32x4*)(stg+row*64+ch*8); ATTN_STORE16(Ow+(long)row*ODM+ch*8,v);} }
  asm volatile("s_waitcnt lgkmcnt(0)\n\ts_barrier":::"memory");
  #undef CIN
  #undef DMA_K
  #undef DMA_V
  #undef CMASK
  #undef START
  #undef RESC
  #undef ROT
}
constexpr int ATTN_LDS_BYTES=LDS_BYTES;
struct AttnTensors { const bf16* Q; const bf16* K; const bf16* V; bf16* O; };
struct AttnUnit { int bh; int qb; };
struct StaticOrder {
  int vcu;
  __device__ __forceinline__ explicit StaticOrder(int grid,int block):vcu((block%8)*(grid/8)+block/8){}
  __device__ __forceinline__ bool next(int i,AttnUnit&u)const{ if(i>=4)return false; const int s=vcu&7; u.bh=vcu>>3; u.qb=(i==0)?s:(i==1)?15-s:(i==2)?16+s:31-s; return true; }
  __device__ __forceinline__ void a_ready(const AttnUnit&)const{}
  __device__ __forceinline__ void done(const AttnUnit&)const{}
};
template<class Sched,int THRL=8> __device__ __forceinline__ void attn_phase(char*lds,const AttnTensors&T,const Sched&S,float qkb2){
  AttnUnit u;
  for(int i=0;S.next(i,u);++i){ S.a_ready(u); attn_unit<THRL>(u.bh/NHEAD,u.bh%NHEAD,u.qb,T.Q,T.K,T.V,T.O,lds,qkb2); S.done(u); }
}
#undef SBAR
#undef WAIT_BAR
}
#define GAS __attribute__((address_space(1)))
#define LAS __attribute__((address_space(3)))
typedef GAS unsigned gu32;
#define RLX_AGENT __ATOMIC_RELAXED, __HIP_MEMORY_SCOPE_AGENT
#define LDS_WAIT() asm volatile("s_waitcnt lgkmcnt(0)" ::: "memory")
#define VM_WAIT() asm volatile("s_waitcnt vmcnt(0)" ::: "memory")

constexpr int NWAVES = 8;
constexpr int N_PHASES = 8;
constexpr int RING_OFF = 0, RING_BYTES = 131072;
constexpr int TAB_OFF = 131072, TAB_UNITS = 17;
constexpr int RT_WROW = 36, RT_CHE = 1024 * RT_WROW * 4, RT_CHG = RT_CHE + 2048, RT_LCNT = RT_CHG + 2048, RT_LBASE = RT_LCNT + 128;
constexpr int LDS_TOTAL = 155648;
constexpr int LDSCTL_OFF = LDS_TOTAL - 1024;
static_assert(TAB_OFF + TAB_UNITS * 256 * 4 <= LDSCTL_OFF && RT_LBASE + 128 <= LDSCTL_OFF, "LDS map");
constexpr int CW_Q = 128, CW_NRM = 256;
constexpr size_t WS_X1B = WS_P;
constexpr size_t WS_TOT = WS_SEL + 768 * 1024;
constexpr int CW_BAR = 4096;

#define XB_TMO      128
#define XB_XCNT(j)  (256  + 64 * (j))
#define XB_XSUB(j)  (1280 + 64 * (j))
#define XB_XGEN(j)  (2304 + 64 * (j))
#define XB_TOP      3328
#define XB_TOPGEN   3392
#define XCD_BAR_WORDS 3456
#define XB_SPIN_CAP (1u << 18)

__device__ __forceinline__ unsigned xb_ld(unsigned* p)              { return __hip_atomic_load(p, __ATOMIC_RELAXED, __HIP_MEMORY_SCOPE_AGENT); }
__device__ __forceinline__ unsigned xb_add(unsigned* p, unsigned v) { return __hip_atomic_fetch_add(p, v, __ATOMIC_RELAXED, __HIP_MEMORY_SCOPE_AGENT); }
__device__ __forceinline__ unsigned xb_xcc_id() { return (unsigned)__builtin_amdgcn_s_getreg((3 << 11) | 20) & 0xFu; }
#define XB_SPIN(cond, bar) do { unsigned _sp = 0; while (cond) { __builtin_amdgcn_s_sleep(1); \
    if ((++_sp & 255u) == 0u) { if (xb_ld(&(bar)[XB_TMO])) break; if (_sp > XB_SPIN_CAP) { atomicAdd(&(bar)[XB_TMO], 1u); break; } } } } while (0)

struct XcdBarrier {
    unsigned* bar; unsigned x;
    volatile LAS unsigned* st;
};

__device__ __forceinline__ XcdBarrier xcd_barrier_post(unsigned* bar, volatile LAS unsigned* st) {
    XcdBarrier b; b.bar = bar; b.x = xb_xcc_id(); b.st = st;
    if (threadIdx.x == 0) (void)xb_add(&bar[XB_XCNT(b.x)], 1u);
    return b;
}
__device__ __forceinline__ void xcd_barrier_complete(unsigned* bar, unsigned x, unsigned& nloc, unsigned& nx) {
    const unsigned G = gridDim.x * gridDim.y * gridDim.z;
    unsigned sum, cnt, mine, sp = 0u;
    for (;;) {
        sum = 0u; cnt = 0u; mine = 0u;
#pragma unroll
        for (unsigned j = 0; j < 16; ++j) { const unsigned c = xb_ld(&bar[XB_XCNT(j)]); sum += c; cnt += (c > 0u) ? 1u : 0u; mine = (j == x) ? c : mine; }
        if (sum == G) break;
        __builtin_amdgcn_s_sleep(1);
        if ((++sp & 255u) == 0u) { if (xb_ld(&bar[XB_TMO])) break; if (sp > XB_SPIN_CAP) { atomicAdd(&bar[XB_TMO], 1u); break; } }
    }
    nloc = mine > 0u ? mine : 1u; nx = cnt > 0u ? cnt : 1u;
}

__device__ __forceinline__ void xcd_barrier(const XcdBarrier& b) {
    asm volatile("s_waitcnt vmcnt(0)" ::: "memory");
    __syncthreads();
    if (threadIdx.x == 0) {
        unsigned* bar = b.bar;
        __builtin_amdgcn_s_waitcnt(0);
        unsigned nloc = b.st[0], nx = b.st[1];
        if (nloc == 0u) { xcd_barrier_complete(bar, b.x, nloc, nx); b.st[0] = nloc; b.st[1] = nx; }
        const unsigned old = xb_add(&bar[XB_XSUB(b.x)], 1u);
        const unsigned gen = old / nloc;
        if (old + 1u == (gen + 1u) * nloc) {
            __builtin_amdgcn_fence(__ATOMIC_RELEASE, "agent");
            asm volatile("s_waitcnt vmcnt(0)" ::: "memory");
            const unsigned og = xb_add(&bar[XB_TOP], 1u);
            const unsigned tg = og / nx;
            if (og + 1u == (tg + 1u) * nx) xb_add(&bar[XB_TOPGEN], 1u);
            else XB_SPIN(xb_ld(&bar[XB_TOPGEN]) == tg, bar);
            __builtin_amdgcn_fence(__ATOMIC_ACQUIRE, "agent");
            xb_add(&bar[XB_XGEN(b.x)], 1u);
            asm volatile("s_waitcnt vmcnt(0)" ::: "memory");
        } else {
            XB_SPIN(xb_ld(&bar[XB_XGEN(b.x)]) == gen, bar);
            __builtin_amdgcn_fence(__ATOMIC_ACQUIRE, "agent");
            asm volatile("s_waitcnt vmcnt(0)" ::: "memory");
        }
    }
    __syncthreads();
}


struct Args { const float* in[15]; float* out; unsigned char* ws; int ph_lo, ph_hi, use_bar, pad; };

__device__ __forceinline__ void p0_transpose_item(const float* W, int ldw, bf16* WT, int ldt, LAS float* scr, int lane) {
    float tv[32];
    const float* wp_ = W + (size_t)(lane >> 5) * ldw + (lane & 31);
#pragma unroll
    for (int i = 0; i < 32; ++i) tv[i] = wp_[(size_t)(2 * i) * ldw];
#pragma unroll
    for (int i = 0; i < 32; ++i) scr[(2 * i + (lane >> 5)) * 33 + (lane & 31)] = tv[i];
    LDS_WAIT(); asm volatile("" ::: "memory");
    const int c = lane & 7;
#pragma unroll
    for (int j = 0; j < 4; ++j) { const int n = (lane >> 3) + 8 * j; const LAS float* s = scr + (8 * c) * 33 + n;
        u32x4 o; o.x = pg8::cvt_pk_bf16(s[0 * 33], s[1 * 33]); o.y = pg8::cvt_pk_bf16(s[2 * 33], s[3 * 33]); o.z = pg8::cvt_pk_bf16(s[4 * 33], s[5 * 33]); o.w = pg8::cvt_pk_bf16(s[6 * 33], s[7 * 33]);
        *(GAS u32x4*)(WT + (size_t)n * ldt + 8 * c) = o; }
    LDS_WAIT(); asm volatile("" ::: "memory");
}
__device__ __forceinline__ void p0_transpose_item_fp8(const float* W, int ldw, unsigned char* WT, int ldt, LAS float* scr, int lane) {
    float tv[32];
    const float* wp_ = W + (size_t)(lane >> 5) * ldw + (lane & 31);
#pragma unroll
    for (int i = 0; i < 32; ++i) tv[i] = wp_[(size_t)(2 * i) * ldw];
#pragma unroll
    for (int i = 0; i < 32; ++i) scr[(2 * i + (lane >> 5)) * 33 + (lane & 31)] = tv[i];
    LDS_WAIT(); asm volatile("" ::: "memory");
    const int c = lane & 7;
#pragma unroll
    for (int j = 0; j < 4; ++j) { const int n = (lane >> 3) + 8 * j; const LAS float* s = scr + (8 * c) * 33 + n; const float k_ = pg8::FP8_SW;
        u32x2 o; o.x = pg8::pack4_fp8(s[0 * 33] * k_, s[1 * 33] * k_, s[2 * 33] * k_, s[3 * 33] * k_); o.y = pg8::pack4_fp8(s[4 * 33] * k_, s[5 * 33] * k_, s[6 * 33] * k_, s[7 * 33] * k_);
        *(GAS u32x2*)(WT + (size_t)n * ldt + 8 * c) = o; }
    LDS_WAIT(); asm volatile("" ::: "memory");
}
constexpr int I_WIN = 16 * 64, I_WO = 8 * 32, I_WEFF = 4 * 16 * 16, I_WU = 32 * 16 * 64, I_WD = 32 * 16 * 32;
constexpr int P0_ITEMS = I_WIN + I_WO + I_WEFF;

__device__ __forceinline__ void phase0(const Args& a, LAS unsigned char* L, int vcu, int G, int tid, int lane, int wave) {
    const float* w_in = a.in[2]; const float* w_pool = a.in[4]; const float* pscale = a.in[5]; const float* w_out = a.in[6];
    bf16* Win_t = (bf16*)(a.ws + WS_WIN); bf16* Wo_t = (bf16*)(a.ws + WS_WO);
    LAS float* scr = (LAS float*)(L + wave * 8448);
    LAS float* wf = (LAS float*)(L + 69632);
    for (int i = tid; i < 1024 * 8; i += 512) { const int d = i >> 3, p_ = ((d & 255) >> 2) + 64 * (4 * (d >> 8) + (d & 3)); wf[p_ * 12 + (i & 7)] = w_in[(size_t)d * INW + 2048 + (i & 7)]; }
    __syncthreads();
    const int gw = vcu * NWAVES + wave, NGW = G * NWAVES;
    {
        const float* x = a.in[0]; const float* g_mix = a.in[1]; const float* b_forget = a.in[3];
        bf16* XN = (bf16*)(a.ws + WS_XN); float* LOGF = (float*)(a.ws + WS_LOGF);
        f32x4 g[4];
#pragma unroll
        for (int j = 0; j < 4; ++j) g[j] = *(const f32x4*)(g_mix + 4 * lane + 256 * j);
        for (int m = gw; m < T; m += NGW) {
            const float* xr = x + (size_t)m * DM;
            f32x4 v[4]; float ss = 0.f;
#pragma unroll
            for (int j = 0; j < 4; ++j) { v[j] = *(const f32x4*)(xr + 4 * lane + 256 * j); ss += v[j].x * v[j].x + v[j].y * v[j].y + v[j].z * v[j].z + v[j].w * v[j].w; }
            const float rstd = rsqrtf(wave_sum(ss) * (1.f / DM) + RMS_EPS);
            float fl[8];
#pragma unroll
            for (int e = 0; e < 8; ++e) fl[e] = 0.f;
#pragma unroll
            for (int j = 0; j < 4; ++j) {
                v[j] = v[j] * rstd * g[j];
#pragma unroll
                for (int i = 0; i < 4; ++i) {
                    const int prow = lane + 64 * (4 * j + i); const float hv = v[j][i];
                    const f32x4 w0 = *(const LAS f32x4*)(wf + prow * 12), w1 = *(const LAS f32x4*)(wf + prow * 12 + 4);
                    fl[0] += hv * w0.x; fl[1] += hv * w0.y; fl[2] += hv * w0.z; fl[3] += hv * w0.w;
                    fl[4] += hv * w1.x; fl[5] += hv * w1.y; fl[6] += hv * w1.z; fl[7] += hv * w1.w;
                }
                u32x2 o; o.x = pk2(v[j].x, v[j].y); o.y = pk2(v[j].z, v[j].w);
                *(u32x2*)(XN + (size_t)m * DM + 4 * lane + 256 * j) = o;
            }
#pragma unroll
            for (int e = 0; e < 8; ++e) fl[e] = wave_sum(fl[e]);
            if (lane < 8) {
                float z = 0.f;
#pragma unroll
                for (int e = 0; e < 8; ++e) if (lane == e) z = fl[e];
                z += b_forget[lane];
                const float ls = fminf(z, 0.f) - log1pf(expf(-fabsf(z)));
                LOGF[((size_t)(m / SEQ) * NH + lane) * SEQ + (m % SEQ)] = ls;
            }
        }
    }
    for (int it = gw; it < P0_ITEMS; it += NGW) {
        int r = it;
        if (r < I_WIN) { const int kb = r >> 6, nb = r & 63; p0_transpose_item(w_in + (size_t)(64 * kb) * INW + 32 * nb, INW, Win_t + (size_t)(32 * nb) * DM + 64 * kb, DM, scr, lane); continue; } r -= I_WIN;
        if (r < I_WO) { const int kb = r >> 5, nb = r & 31; p0_transpose_item(w_out + (size_t)(512 + 64 * kb) * DM + 32 * nb, DM, Wo_t + (size_t)(32 * nb) * DM + 512 + 64 * kb, DM, scr, lane); continue; } r -= I_WO;
        if (r < I_WEFF) {
            const int g = r >> 8, nb = (r >> 4) & 15, kb = r & 15, n = nb * 64 + lane; float acc[8];
#pragma unroll
            for (int i = 0; i < 8; ++i) acc[i] = 0.f;
            const float* wp = w_pool + (size_t)g * 16384 + (size_t)(kb * 8) * 128;
#pragma unroll 2
            for (int d = 0; d < 128; d += 4) { f32x4 av;
#pragma unroll
                for (int q = 0; q < 4; ++q) av[q] = w_out[(size_t)(g * 128 + d + q) * DM + n];
                av = av * *(const f32x4*)(pscale + g * 128 + d);
#pragma unroll
                for (int i = 0; i < 8; ++i) { const f32x4 wv = *(const f32x4*)(wp + i * 128 + d); acc[i] += av.x * wv.x + av.y * wv.y + av.z * wv.z + av.w * wv.w; } }
            u32x4 o; o.x = pk2(acc[0], acc[1]); o.y = pk2(acc[2], acc[3]); o.z = pk2(acc[4], acc[5]); o.w = pk2(acc[6], acc[7]);
            *(GAS u32x4*)(Wo_t + (size_t)n * DM + g * 128 + kb * 8) = o; continue; } r -= I_WEFF;
        }
}

constexpr int J_WU = 32 * 16 * 32, J_WD = 32 * 16 * 16;
struct ConvItem { const float* src; int ldw; unsigned char* dst; };
__device__ __forceinline__ ConvItem conv_item(const Args& a, int r) {
    ConvItem it;
    if (r < J_WU) { const int e = r >> 9, kb = (r >> 5) & 15, nb = r & 31, n0 = 64 * nb;
        const int rowp = n0 < 1024 ? (n0 >> 7) * 256 + (n0 & 127) : ((n0 - 1024) >> 7) * 256 + 128 + ((n0 - 1024) & 127);
        it.src = a.in[10] + (size_t)e * DM * 2048 + (size_t)(64 * kb) * 2048 + n0; it.ldw = 2048; it.dst = a.ws + WS_WU + ((size_t)e * 2048 + rowp) * DM + 64 * kb; return it; }
    r -= J_WU;
    { const int e = r >> 8, kb = (r >> 4) & 15, nb = r & 15;
      it.src = a.in[12] + (size_t)e * DE * DM + (size_t)(64 * kb) * DM + 64 * nb; it.ldw = DM; it.dst = a.ws + WS_WD + ((size_t)e * DM + 64 * nb) * DE + 64 * kb; return it; }
}
__device__ __forceinline__ void conv_load(f32x4 (&tv)[16], const ConvItem& it, int lane) {
    const float* p_ = it.src + (size_t)(lane >> 4) * it.ldw + 4 * (lane & 15);
#pragma unroll
    for (int i = 0; i < 16; ++i) tv[i] = *(const f32x4*)(p_ + (size_t)(4 * i) * it.ldw);
}
__device__ __forceinline__ void conv_finish(const f32x4 (&tv)[16], const ConvItem& it, LAS float* scr, int lane) {
#pragma unroll
    for (int i = 0; i < 16; ++i) { LAS float* d_ = scr + (4 * i + (lane >> 4)) * 65 + 4 * (lane & 15); d_[0] = tv[i].x; d_[1] = tv[i].y; d_[2] = tv[i].z; d_[3] = tv[i].w; }
    LDS_WAIT(); asm volatile("" ::: "memory");
    const int c = lane & 7; const float k_ = pg8::FP8_SW;
#pragma unroll
    for (int j = 0; j < 8; ++j) { const int n = (lane >> 3) + 8 * j; const LAS float* s = scr + (8 * c) * 65 + n;
        u32x2 o; o.x = pg8::pack4_fp8(s[0 * 65] * k_, s[1 * 65] * k_, s[2 * 65] * k_, s[3 * 65] * k_); o.y = pg8::pack4_fp8(s[4 * 65] * k_, s[5 * 65] * k_, s[6 * 65] * k_, s[7 * 65] * k_);
        *(GAS u32x2*)(it.dst + (size_t)n * DM + 8 * c) = o; }
    LDS_WAIT(); asm volatile("" ::: "memory");
}
__device__ __forceinline__ void conv_chunk(const Args& a, int cc, LAS float* scr, int lane, int wave) {
    const int r0 = cc * 24 + wave * 3;
    const ConvItem i0 = conv_item(a, r0), i1 = conv_item(a, r0 + 1), i2 = conv_item(a, r0 + 2);
    f32x4 ta[16], tb[16];
    conv_load(ta, i0, lane); conv_load(tb, i1, lane);
    conv_finish(ta, i0, scr, lane);
    conv_load(ta, i2, lane);
    conv_finish(tb, i1, scr, lane);
    conv_finish(ta, i2, scr, lane);
}

template <int W> __device__ __forceinline__ void pool_run(const bf16* U, bf16* CAT, int row0, int c0) {
    const int t0 = row0 % SEQ;
    u32x4 blk[8], tr[W - 1];
#pragma unroll
    for (int i = 0; i < 8; ++i) blk[i] = *(const u32x4*)(U + (size_t)(row0 + i) * PW + c0);
#pragma unroll
    for (int j = 1; j < W; ++j) tr[j - 1] = (t0 - j >= 0) ? *(const u32x4*)(U + (size_t)(row0 - j) * PW + c0) : (u32x4){0u, 0u, 0u, 0u};
    float S[8];
#pragma unroll
    for (int k = 0; k < 8; ++k) S[k] = 0.f;
#pragma unroll
    for (int j = 0; j < W - 1; ++j) { const unsigned rr[4] = {tr[j].x, tr[j].y, tr[j].z, tr[j].w};
#pragma unroll
        for (int k = 0; k < 4; ++k) { S[2 * k] += __builtin_bit_cast(float, rr[k] << 16); S[2 * k + 1] += __builtin_bit_cast(float, rr[k] & 0xffff0000u); } }
#pragma unroll
    for (int i = 0; i < 8; ++i) { const int t = t0 + i; float cur[8];
        { const unsigned rr[4] = {blk[i].x, blk[i].y, blk[i].z, blk[i].w};
#pragma unroll
          for (int k = 0; k < 4; ++k) { cur[2 * k] = __builtin_bit_cast(float, rr[k] << 16); cur[2 * k + 1] = __builtin_bit_cast(float, rr[k] & 0xffff0000u); } }
        const float inv = 1.f / (float)(t + 1 < W ? t + 1 : W); float o[8];
#pragma unroll
        for (int k = 0; k < 8; ++k) { S[k] += cur[k]; o[k] = S[k] * inv - cur[k]; }
        u32x4 ov; ov.x = pk2(o[0], o[1]); ov.y = pk2(o[2], o[3]); ov.z = pk2(o[4], o[5]); ov.w = pk2(o[6], o[7]);
        *(u32x4*)(CAT + (size_t)(row0 + i) * DM + c0) = ov;
        const u32x4 sb = (i - (W - 1) >= 0) ? blk[(i - (W - 1) >= 0) ? i - (W - 1) : 0] : tr[(i - (W - 1) >= 0) ? 0 : (W - 1) - i - 1];
        { const unsigned rr[4] = {sb.x, sb.y, sb.z, sb.w};
#pragma unroll
          for (int k = 0; k < 4; ++k) { S[2 * k] -= __builtin_bit_cast(float, rr[k] << 16); S[2 * k + 1] -= __builtin_bit_cast(float, rr[k] & 0xffff0000u); } }
    }
}
__device__ __forceinline__ void pool_chunk(const Args& a, int c, int tid) {
    const bf16* U = (const bf16*)(a.ws + WS_U); bf16* CAT = (bf16*)(a.ws + WS_CAT);
    const int ch = tid & 63, rb = tid >> 6, c0 = ch * 8, g = c0 >> 7;
#pragma unroll 1
    for (int hf = 0; hf < 2; ++hf) { const int row0 = 128 * c + 8 * (rb + 8 * hf);
        if (g == 0) pool_run<2>(U, CAT, row0, c0); else if (g == 1) pool_run<4>(U, CAT, row0, c0); else if (g == 2) pool_run<8>(U, CAT, row0, c0); else pool_run<16>(U, CAT, row0, c0); }
}
__device__ __forceinline__ void c2_local_scan(const Args& a, LAS unsigned char* L, int bx, int tid, int lane, int wave) {
    if (bx >= 256) return;
    const int bh = bx >> 3, blk = bx & 7; const size_t off = (size_t)bh * SEQ + blk * 1024 + tid * 2;
    const float* src = (const float*)(a.ws + WS_LOGF) + off; float* dst = (float*)(a.ws + WS_CUM) + off;
    LAS double* wtot = (LAS double*)(L + 0);
    const float v0 = src[0], v1 = src[1]; const double s = (double)v0 + (double)v1; double inc = s;
#pragma unroll
    for (int o = 1; o < 64; o <<= 1) { const double t_ = __shfl_up(inc, o); if (lane >= o) inc += t_; }
    if (lane == 63) wtot[wave] = inc;
    __syncthreads();
    double base = inc - s;
    for (int w = 0; w < wave; ++w) base += wtot[w];
    dst[0] = (float)((base + (double)v0) * (double)LOG2E); dst[1] = (float)((base + s) * (double)LOG2E);
    if (tid == 511) ((float*)(a.ws + WS_TOT))[bh * 8 + blk] = (float)((base + s) * (double)LOG2E);
    __syncthreads();
}
__device__ __forceinline__ void c2_load(const Args& a, LAS unsigned char* L, int bh, int tid, int wave) {
    const float* src = (const float*)(a.ws + WS_CUM) + (size_t)bh * SEQ + tid * 16; const float* tot = (const float*)(a.ws + WS_TOT) + bh * 8;
    LAS float* c2s = (LAS float*)(L + attn_body::LDS_C2);
    double base = 0.0;
    for (int w = 0; w < wave; ++w) base += (double)tot[w];
    const float bf = (float)base;
#pragma unroll
    for (int i = 0; i < 4; ++i) { f32x4 v = *(const f32x4*)(src + 4 * i); v = v + bf; *(LAS f32x4*)(c2s + tid * 16 + 4 * i) = v; }
    __syncthreads();
}

__device__ __forceinline__ void router_phase(const Args& a, LAS unsigned char* L, int vcu, int G, int tid, int lane, int wave) {
    LAS float* wr = (LAS float*)L;
    LAS int* ch_e = (LAS int*)(L + RT_CHE); LAS float* ch_g = (LAS float*)(L + RT_CHG); LAS int* lcnt = (LAS int*)(L + RT_LCNT); LAS int* lbase = (LAS int*)(L + RT_LBASE);
    const float* w_router = a.in[8]; const float* b_router = a.in[9]; const float* g_ffn = a.in[7];
    for (int i = tid; i < 1024 * 32 / 4; i += 512) { const int d = i >> 3, c4 = i & 7, p_ = ((d & 255) >> 2) + 64 * (4 * (d >> 8) + (d & 3)); *(LAS f32x4*)(wr + p_ * RT_WROW + c4 * 4) = ((const f32x4*)w_router)[i]; }
    __syncthreads();
    const bf16* X1 = (const bf16*)(a.ws + WS_X1B); unsigned char* H2 = a.ws + WS_XN;
    int* cnt = (int*)(a.ws + WS_CTL) + CW_CNT; int* SEL = (int*)(a.ws + WS_SEL); int* LTK = (int*)(a.ws + WS_LTK); float* LGT = (float*)(a.ws + WS_LGT);
    f32x4 g[4];
#pragma unroll
    for (int j = 0; j < 4; ++j) g[j] = *(const f32x4*)(g_ffn + 4 * lane + 256 * j);
    const int myexp = ((lane >> 5) & 1) * 16 + ((lane >> 4) & 1) * 8 + ((lane >> 3) & 1) * 4 + ((lane >> 2) & 1) * 2 + ((lane >> 1) & 1);
    const float mybias = b_router[myexp];
    for (int grp = vcu; grp < T / 128; grp += G) {
        if (tid < 32) lcnt[tid] = 0;
        __syncthreads();
        for (int it = 0; it < 16; ++it) {
            const int lt = wave * 16 + it, m = grp * 128 + lt;
            const bf16* xr = X1 + (size_t)m * DM;
            f32x4 v[4]; float ss = 0.f;
#pragma unroll
            for (int j = 0; j < 4; ++j) { const u32x2 xb = *(const u32x2*)(xr + 4 * lane + 256 * j);
                v[j].x = __builtin_bit_cast(float, xb.x << 16); v[j].y = __builtin_bit_cast(float, xb.x & 0xffff0000u); v[j].z = __builtin_bit_cast(float, xb.y << 16); v[j].w = __builtin_bit_cast(float, xb.y & 0xffff0000u);
                ss += v[j].x * v[j].x + v[j].y * v[j].y + v[j].z * v[j].z + v[j].w * v[j].w; }
            const float rstd = rsqrtf(wave_sum(ss) * (1.f / DM) + RMS_EPS);
            float lg[32];
#pragma unroll
            for (int e = 0; e < 32; ++e) lg[e] = 0.f;
#pragma unroll
            for (int j = 0; j < 4; ++j) {
                v[j] = v[j] * rstd * g[j];
                *(unsigned*)(H2 + (size_t)m * DM + 4 * lane + 256 * j) = pg8::pack4_fp8(v[j].x * pg8::FP8_SA, v[j].y * pg8::FP8_SA, v[j].z * pg8::FP8_SA, v[j].w * pg8::FP8_SA);
#pragma unroll
                for (int i = 0; i < 4; ++i) { const int prow = lane + 64 * (4 * j + i); const float hv = v[j][i];
#pragma unroll
                    for (int e4 = 0; e4 < 8; ++e4) { const f32x4 w = *(const LAS f32x4*)(wr + prow * RT_WROW + e4 * 4);
                        lg[e4 * 4] += hv * w.x; lg[e4 * 4 + 1] += hv * w.y; lg[e4 * 4 + 2] += hv * w.z; lg[e4 * 4 + 3] += hv * w.w; }
                    asm volatile("" ::: "memory"); }
            }
            float mine;
            {
                float a16[16]; const bool up = lane >= 32;
#pragma unroll
                for (int e = 0; e < 16; ++e) { const float keep = up ? lg[16 + e] : lg[e], give = up ? lg[e] : lg[16 + e]; a16[e] = keep + __shfl_xor(give, 32); }
                float a8[8]; const bool u16 = (lane & 16) != 0;
#pragma unroll
                for (int e = 0; e < 8; ++e) { const float keep = u16 ? a16[8 + e] : a16[e], give = u16 ? a16[e] : a16[8 + e]; a8[e] = keep + __shfl_xor(give, 16); }
                float a4[4]; const bool u8 = (lane & 8) != 0;
#pragma unroll
                for (int e = 0; e < 4; ++e) { const float keep = u8 ? a8[4 + e] : a8[e], give = u8 ? a8[e] : a8[4 + e]; a4[e] = keep + __shfl_xor(give, 8); }
                float a2[2]; const bool u4 = (lane & 4) != 0;
#pragma unroll
                for (int e = 0; e < 2; ++e) { const float keep = u4 ? a4[2 + e] : a4[e], give = u4 ? a4[e] : a4[2 + e]; a2[e] = keep + __shfl_xor(give, 4); }
                const bool u2 = (lane & 2) != 0;
                float a1 = (u2 ? a2[1] : a2[0]) + __shfl_xor(u2 ? a2[0] : a2[1], 2);
                a1 += __shfl_xor(a1, 1);
                mine = a1;
            }
            float val = mine + mybias;
            if (lane & 1) val = -INFINITY;
            float tv[4]; int ti[4];
#pragma unroll
            for (int k = 0; k < 4; ++k) {
                float bv = val; int bi = myexp;
#pragma unroll
                for (int o = 1; o < 64; o <<= 1) { const float ov = __shfl_xor(bv, o); const int oi = __shfl_xor(bi, o); if (ov > bv || (ov == bv && oi < bi)) { bv = ov; bi = oi; } }
                tv[k] = bv; ti[k] = bi; if (myexp == bi) val = -INFINITY;
            }
            const float e0 = 1.f, e1 = expf(tv[1] - tv[0]), e2 = expf(tv[2] - tv[0]), e3 = expf(tv[3] - tv[0]); const float inv = 1.f / (e0 + e1 + e2 + e3);
            if (lane < 4) { const float gg = (lane == 0 ? e0 : lane == 1 ? e1 : lane == 2 ? e2 : e3) * inv; const int ee = lane == 0 ? ti[0] : lane == 1 ? ti[1] : lane == 2 ? ti[2] : ti[3];
                ch_e[lt * 4 + lane] = ee; ch_g[lt * 4 + lane] = gg; __hip_atomic_fetch_add(&lcnt[ee], 1, __ATOMIC_RELAXED, __HIP_MEMORY_SCOPE_WORKGROUP); }
        }
        __syncthreads();
        if (tid < 32) { lbase[tid] = atomicAdd(&cnt[tid], lcnt[tid]); lcnt[tid] = 0; }
        __syncthreads();
        { const int e = ch_e[tid]; const int slot = lbase[e] + __hip_atomic_fetch_add(&lcnt[e], 1, __ATOMIC_RELAXED, __HIP_MEMORY_SCOPE_WORKGROUP); const int tk = (grp * 128 + (tid >> 2)) * 4 + (tid & 3);
          LTK[(size_t)e * T + slot] = tk; LGT[(size_t)e * T + slot] = ch_g[tid]; SEL[tk] = (slot << 5) | e; }
        __syncthreads();
    }
}

__device__ __forceinline__ void expert_map(const Args& a, volatile LAS unsigned* MISC, int tid) {
    if (tid == 0) { const int* cnt = (const int*)(a.ws + WS_CTL) + CW_CNT; int acc = 0;
        for (int e = 0; e < 32; ++e) { const int c = __hip_atomic_load((int*)cnt + e, RLX_AGENT); MISC[64 + e] = (unsigned)c; MISC[96 + e] = (unsigned)acc; acc += (c + RT - 1) / RT; } MISC[128] = (unsigned)acc; }
    __syncthreads();
}

__device__ __forceinline__ void final_phase(const Args& a, volatile LAS unsigned* MISC, int vcu, int G, int lane, int wave) {
    const int* SEL = (const int*)(a.ws + WS_SEL); const unsigned char* Y = a.ws + WS_Y; const bf16* X1 = (const bf16*)(a.ws + WS_X1B); const float* g_final = a.in[14];
    f32x4 g[4];
#pragma unroll
    for (int j = 0; j < 4; ++j) g[j] = *(const f32x4*)(g_final + 4 * lane + 256 * j);
    typedef float f32x2_t __attribute__((ext_vector_type(2)));
    for (int m = vcu * 8 + wave; m < T; m += G * 8) {
        const bf16* xr = X1 + (size_t)m * DM; f32x4 v[4]; int sv[4];
#pragma unroll
        for (int k = 0; k < 4; ++k) sv[k] = SEL[m * 4 + k];
#pragma unroll
        for (int j = 0; j < 4; ++j) { const u32x2 xb = *(const u32x2*)(xr + 4 * lane + 256 * j);
            v[j].x = __builtin_bit_cast(float, xb.x << 16); v[j].y = __builtin_bit_cast(float, xb.x & 0xffff0000u); v[j].z = __builtin_bit_cast(float, xb.y << 16); v[j].w = __builtin_bit_cast(float, xb.y & 0xffff0000u); }
        f32x4 ya[4];
#pragma unroll
        for (int j = 0; j < 4; ++j) ya[j] = (f32x4){0.f, 0.f, 0.f, 0.f};
#pragma unroll
        for (int k = 0; k < 4; ++k) { const int e = sv[k] & 31, slot = sv[k] >> 5; const unsigned char* yr = Y + ((size_t)MISC[96 + e] * RT + slot) * DM;
#pragma unroll
            for (int j = 0; j < 4; ++j) { const unsigned y = *(const unsigned*)(yr + 4 * lane + 256 * j);
                const f32x2_t lo = __builtin_amdgcn_cvt_pk_f32_fp8((int)y, false), hi = __builtin_amdgcn_cvt_pk_f32_fp8((int)y, true);
                ya[j].x += lo.x; ya[j].y += lo.y; ya[j].z += hi.x; ya[j].w += hi.y; } }
        float ss = 0.f;
#pragma unroll
        for (int j = 0; j < 4; ++j) { v[j] = v[j] + ya[j] * (1.0f / pg8::FP8_SY); ss += v[j].x * v[j].x + v[j].y * v[j].y + v[j].z * v[j].z + v[j].w * v[j].w; }
        const float rstd = rsqrtf(wave_sum(ss) * (1.f / DM) + RMS_EPS);
        float* orow = a.out + (size_t)m * DM;
#pragma unroll
        for (int j = 0; j < 4; ++j) *(f32x4*)(orow + 4 * lane + 256 * j) = v[j] * rstd * g[j];
    }
}

__global__ void __launch_bounds__(NWAVES * 64, 2) mk_fwd(Args args) {
    extern __shared__ __attribute__((aligned(16))) unsigned char lds[];
    LAS unsigned char* L = (LAS unsigned char*)lds;
    volatile LAS unsigned* MISC = (volatile LAS unsigned*)(L + LDSCTL_OFF);
    const int tid = threadIdx.x, lane = tid & 63, wave = __builtin_amdgcn_readfirstlane(tid >> 6);
    const int G = gridDim.x; const int bx = blockIdx.x; const int vcu = (G % 8 == 0) ? (bx % 8) * (G / 8) + bx / 8 : bx;
    unsigned char* ws = args.ws;
    for (int u = tid; u < (LDS_TOTAL - LDSCTL_OFF) / 4; u += NWAVES * 64) ((LAS unsigned*)(L + LDSCTL_OFF))[u] = 0u;
    __syncthreads();
    XcdBarrier bar; bar.bar = (unsigned*)(ws + WS_CTL) + CW_BAR; bar.x = 0; bar.st = nullptr;
    if (args.use_bar) bar = xcd_barrier_post((unsigned*)(ws + WS_CTL) + CW_BAR, MISC + 8);
    const int lo = args.ph_lo, hi = args.ph_hi;
#define IN(k) (lo <= (k) && (k) < hi)
#define SEAM(k) do { if (IN(k) && IN((k) + 1)) xcd_barrier(bar); } while (0)
#ifndef MK_DUP
#define MK_DUP -1
#endif
#ifndef MK_TPROBE
#define MK_TPROBE -1
#endif
#define TP0(k) do { if ((MK_TPROBE) == (k) && bx == 0 && tid == 0) { const unsigned long long t_ = __builtin_amdgcn_s_memrealtime(); MISC[16] = (unsigned)t_; MISC[17] = (unsigned)(t_ >> 32); } } while (0)
#define TP1(k) do { if ((MK_TPROBE) == (k) && bx == 0 && tid == 0) { const unsigned long long t_ = __builtin_amdgcn_s_memrealtime(); MISC[18] = (unsigned)t_; MISC[19] = (unsigned)(t_ >> 32); } } while (0)
#define REPS(k) for (int rep_ = 0; rep_ < ((MK_DUP) == (k) ? 2 : 1); ++rep_, ((MK_DUP) == (k) && rep_ == 1 ? xcd_barrier(bar) : (void)0))

    TP0(0);
    if (IN(0)) REPS(0) { phase0(args, L, vcu, G, tid, lane, wave); }
    SEAM(0); TP1(0); TP0(1);
    if (IN(1)) REPS(1) {
        pg8::Gemm g{(const bf16*)(ws + WS_XN), (const bf16*)(ws + WS_WIN), DM}; pg8::StaticOrder S; S.init(T, 2048, G, bx);
        c2_local_scan(args, L, bx, tid, lane, wave);
        pg8::EpiInproj E{(bf16*)(ws + WS_U), (size_t)(WS_Q - WS_U) / 2, C2, (unsigned*)(ws + WS_CTL) + CW_NRM};
        pg8::gemm_phase<pg8::EpiInproj, pg8::StaticOrder, true, false>(L + RING_OFF, g, S, E, nullptr);
    }
    SEAM(1); TP1(1); TP0(2);
    if (IN(2)) {
        constexpr unsigned NQ_POOL = T / 128, NQA = NQ_POOL + 1024, NQC = 1024;
        static_assert(1024 * 24 == J_WU + J_WD, "conversion chunks");
        unsigned* qhead = (unsigned*)(ws + WS_CTL) + CW_Q; const float* nrm = (const float*)(ws + WS_CTL) + CW_NRM;
        const attn_body::AttnTensors AT{(const attn_body::bf16*)(ws + WS_Q), (const attn_body::bf16*)(ws + WS_K), (const attn_body::bf16*)(ws + WS_V), (attn_body::bf16*)(ws + WS_CAT) + PW};
        const int pref = ((bx & 3) == 0) ? 1 : 0;
#define CONV_LOOP() for (;;) { int tid_ = threadIdx.x; asm volatile("" : "+v"(tid_));   \
            if (tid_ == 0) MISC[24] = atomicAdd(qhead + 64, 1u); __syncthreads(); const unsigned q = MISC[24]; if (q >= NQC) break; \
            conv_chunk(args, (int)q, (LAS float*)(L + (tid_ >> 6) * 16640), tid_ & 63, tid_ >> 6); __syncthreads(); }
        if (pref) { CONV_LOOP(); __syncthreads(); }
        for (;;) {
            int tid_ = threadIdx.x; asm volatile("" : "+v"(tid_));
            if (tid_ == 0) MISC[24] = atomicAdd(qhead, 1u);
            __syncthreads();
            const unsigned q = MISC[24];
            if (q >= NQA) break;
            if (q < NQ_POOL) { pool_chunk(args, (int)q, tid_); }
            else { const int grp = (int)(q - NQ_POOL), qb = 31 - (grp >> 5), bh = grp & 31;
                c2_load(args, L, bh, tid_, tid_ >> 6);
                const float qkb2 = 4.0f * sqrtf(nrm[bh] * nrm[32 + bh]) * 1.001f;
                attn_body::attn_unit<8>(bh / NH, bh % NH, qb, AT.Q, AT.K, AT.V, AT.O, (char*)lds + RING_OFF, qkb2); }
            __syncthreads();
        }
        __syncthreads();
        CONV_LOOP();
#undef CONV_LOOP
    }
    SEAM(2); TP1(2); TP0(3);
    if (IN(3)) REPS(3) {
        pg8::Gemm g{(const bf16*)(ws + WS_CAT), (const bf16*)(ws + WS_WO), DM}; pg8::StaticOrder S; S.init(T, DM, G, bx);
        pg8::EpiResBf16 E{args.in[0], (bf16*)(ws + WS_X1B)};
        pg8::gemm_phase<pg8::EpiResBf16, pg8::StaticOrder, true, false>(L + RING_OFF, g, S, E, nullptr);
    }
    SEAM(3); TP1(3); TP0(4);
    if (IN(4)) { router_phase(args, L, vcu, G, tid, lane, wave); }
    SEAM(4); TP1(4); TP0(5);
    if (IN(5)) REPS(5) {
        TP0(51); expert_map(args, MISC, tid);
        const LAS int* pt = (const LAS int*)(L + LDSCTL_OFF + 96 * 4); const LAS int* cn = (const LAS int*)(L + LDSCTL_OFF + 64 * 4);
        LAS unsigned* tab = (LAS unsigned*)(L + TAB_OFF);
        const pg8::MoeOrder<8> S{pt, G, bx, (size_t)2048 * DM};
        { const int* LTK = (const int*)(ws + WS_LTK); pg8::Unit u;
          for (int i = 0; i < TAB_UNITS && S.next(i, u); ++i) { if (tid < 256) { const int slot = u.lrow0 + tid; const int tok = slot < cn[u.e] ? (LTK[(size_t)u.e * T + slot] >> 2) : 0; tab[i * 256 + tid] = (unsigned)tok * (unsigned)DM; } } }
        __syncthreads(); TP1(51);
        pg8::Gemm g{(const bf16*)(ws + WS_XN), (const bf16*)(ws + WS_WU), DM / 2};
        pg8::EpiSwiglu8 E{ws + WS_ACT, args.in[11]};
        pg8::gemm_phase<pg8::EpiSwiglu8, pg8::MoeOrder<8>, true, true, true>(L + RING_OFF, g, S, E, tab, ((MK_TPROBE) == 52 && bx == 0) ? (volatile LAS unsigned*)(MISC + 20) : nullptr);
    }
    SEAM(5); TP1(5); TP0(6);
    if (IN(6)) REPS(6) {
        expert_map(args, MISC, tid);
        const LAS int* pt = (const LAS int*)(L + LDSCTL_OFF + 96 * 4); const LAS int* cn = (const LAS int*)(L + LDSCTL_OFF + 64 * 4);
        const pg8::MoeOrder<4> S{pt, G, bx, (size_t)DM * DE};
        pg8::Gemm g{(const bf16*)(ws + WS_ACT), (const bf16*)(ws + WS_WD), DE / 2};
        pg8::EpiDown E{ws + WS_Y, args.in[13], (const float*)(ws + WS_LGT), cn, T, pg8::FP8_INV};
        pg8::gemm_phase<pg8::EpiDown, pg8::MoeOrder<4>, true, false, true>(L + RING_OFF, g, S, E, nullptr);
    }
    SEAM(6); TP1(6); TP0(7); TP0(70);
    if (IN(7)) { expert_map(args, MISC, tid); final_phase(args, MISC, vcu, G, lane, wave); }
    if ((MK_TPROBE) == 70) { xcd_barrier(bar); }
    TP1(7); TP1(70);
    if ((MK_TPROBE) >= 0 && bx == 0) { __syncthreads(); const unsigned long long ta = ((unsigned long long)MISC[17] << 32) | MISC[16], tb = ((MK_TPROBE) == 52 || ((MK_TPROBE) >= 23 && (MK_TPROBE) <= 25)) ? ta + MISC[20] : (((unsigned long long)MISC[19] << 32) | MISC[18]);
        const unsigned long long tend = __builtin_amdgcn_s_memrealtime() + (tb - ta); while (__builtin_amdgcn_s_memrealtime() < tend) __builtin_amdgcn_s_sleep(10); }
#undef IN
#undef SEAM
}
#ifndef MK_MODE
#define MK_MODE 1
#endif
#ifndef MK_NAIVE_MASK
#define MK_NAIVE_MASK 0
#endif
extern "C" void kernel_launch(void* const* d_in, const int* in_sizes, int n_in, void* d_out, int out_size, void* d_ws, size_t ws_size, hipStream_t stream) {
    if (n_in != 15 || out_size != T * DM || ws_size < WS_END) { fprintf(stderr, "kernel_launch: unexpected shapes (n_in %d out %d ws %zu)\n", n_in, out_size, ws_size); return; }
    Params p{};
    p.x = (const float*)d_in[0]; p.g_mix = (const float*)d_in[1]; p.w_in = (const float*)d_in[2]; p.b_forget = (const float*)d_in[3]; p.w_pool = (const float*)d_in[4];
    p.pool_scale = (const float*)d_in[5]; p.w_out = (const float*)d_in[6]; p.g_ffn = (const float*)d_in[7]; p.w_router = (const float*)d_in[8]; p.b_router = (const float*)d_in[9];
    p.w_up = (const float*)d_in[10]; p.b_up = (const float*)d_in[11]; p.w_down = (const float*)d_in[12]; p.b_down = (const float*)d_in[13]; p.g_final = (const float*)d_in[14];
    p.out = (float*)d_out; p.ws = (unsigned char*)d_ws;
    Args a{};
    for (int i = 0; i < 15; ++i) a.in[i] = (const float*)d_in[i];
    a.out = (float*)d_out; a.ws = (unsigned char*)d_ws;
    static bool attr_done = false;
    if (!attr_done) { if (hipFuncSetAttribute((const void*)mk_fwd, hipFuncAttributeMaxDynamicSharedMemorySize, LDS_TOTAL) != hipSuccess) fprintf(stderr, "kernel_launch: hipFuncSetAttribute failed\n"); attr_done = true; }
    (void)hipMemsetAsync((char*)d_ws + WS_CTL, 0, 1 * MiB, stream);
    const int GRID = 256;
#if MK_MODE == 2
    a.ph_lo = 0; a.ph_hi = N_PHASES; a.use_bar = 1;
    hipLaunchKernelGGL(mk_fwd, dim3(GRID), dim3(NWAVES * 64), LDS_TOTAL, stream, a);
#else
    const unsigned mask = (MK_MODE == 0) ? 0xffu : (unsigned)(MK_NAIVE_MASK);
    auto fast = [&](int k) { a.ph_lo = k; a.ph_hi = k + 1; a.use_bar = 0; hipLaunchKernelGGL(mk_fwd, dim3(GRID), dim3(NWAVES * 64), LDS_TOTAL, stream, a); };
    auto nv = [&](int k) { return (mask >> k) & 1u; };
    if (mask != 0xffu || !nv(0)) fast(0);
    if (nv(0)) k_prologue<<<1024, 512, 0, stream>>>(p);
    if (nv(1)) k_inproj_naive<<<2048, 512, 0, stream>>>(p); else fast(1);
    if (nv(2)) { k_cumsum<<<32, 512, 0, stream>>>(p); k_attn_naive<<<BATCH * NH * (SEQ / 64), 512, 0, stream>>>(p); if (!nv(3)) k_pool<<<2048, 512, 0, stream>>>(p, (bf16*)((unsigned char*)d_ws + WS_CAT), DM); }
    else fast(2);
    if (nv(3)) { k_pool<<<2048, 512, 0, stream>>>(p, (bf16*)((unsigned char*)d_ws + WS_P), PW); k_poolgemm_naive<<<2048, 512, 0, stream>>>(p); k_outproj_naive<<<2048, 512, 0, stream>>>(p); }
    else fast(3);
    if (nv(4)) k_router<<<256, 512, 0, stream>>>(p); else fast(4);
    if (nv(5)) k_up_naive<<<4096, 512, 0, stream>>>(p); else fast(5);
    if (nv(6)) k_down_naive<<<4096, 512, 0, stream>>>(p); else fast(6);
    if (nv(7)) k_final<<<1024, 512, 0, stream>>>(p); else fast(7);
#endif
}
```

```cpp
#define MK_MODE 2
#include <hip/hip_runtime.h>
#include <cstdio>
#include <cstdint>

constexpr int BATCH = 4, SEQ = 8192, DM = 1024, T = BATCH * SEQ;
constexpr int PW = 512, AW = 512, NH = 8, HD = 64, INW = PW + 3 * AW + NH;
constexpr int NE = 32, TOPK = 4, DE = 1024;
constexpr float RMS_EPS = 1e-5f, SW_LIMIT = 7.0f, SW_ALPHA = 1.702f;
constexpr float LOG2E = 1.4426950408889634f;
constexpr float C2 = 0.125f * LOG2E;
constexpr int RT = 256;
constexpr int NROWS_PAD = T * TOPK + NE * RT;

typedef unsigned short bf16;
typedef float f32x4 __attribute__((ext_vector_type(4)));
typedef unsigned u32x4 __attribute__((ext_vector_type(4)));
typedef unsigned u32x2 __attribute__((ext_vector_type(2)));

constexpr size_t MiB = 1u << 20;
constexpr size_t WS_CTL = 0;
constexpr size_t WS_LOGF = 1 * MiB;
constexpr size_t WS_CUM = 2 * MiB;
constexpr size_t WS_SEL = 3 * MiB;
constexpr size_t WS_LTK = 4 * MiB;
constexpr size_t WS_LGT = 8 * MiB;
constexpr size_t WS_XN = 12 * MiB;
constexpr size_t WS_WIN = 76 * MiB;
constexpr size_t WS_WO = 80 * MiB;
constexpr size_t WS_WU = 82 * MiB;
constexpr size_t WS_WD = 210 * MiB;
constexpr size_t WS_U = 274 * MiB;
constexpr size_t WS_Q = 306 * MiB;
constexpr size_t WS_K = 338 * MiB;
constexpr size_t WS_V = 370 * MiB;
constexpr size_t WS_CAT = 402 * MiB;
constexpr size_t WS_P = 466 * MiB;
constexpr size_t WS_ACT = 274 * MiB;
constexpr size_t WS_Y = 546 * MiB;
constexpr size_t WS_END = 818 * MiB;
static_assert(WS_ACT + (size_t)NROWS_PAD * 1024 * 2 <= WS_Y, "ACT overlay");
static_assert(WS_Y + (size_t)NROWS_PAD * 1024 * 2 <= WS_END, "Y");
constexpr int CW_CNT = 64;

struct Params {
    const float *x, *g_mix, *w_in, *b_forget, *w_pool, *pool_scale, *w_out, *g_ffn, *w_router, *b_router, *w_up, *b_up, *w_down, *b_down, *g_final;
    float* out; unsigned char* ws;
};

__device__ __forceinline__ unsigned f2bf(float f) { unsigned u = __builtin_bit_cast(unsigned, f); return (u + 0x7fffu + ((u >> 16) & 1u)) >> 16; }
__device__ __forceinline__ unsigned pk2(float lo, float hi) { return f2bf(lo) | (f2bf(hi) << 16); }
__device__ __forceinline__ float bf2f(unsigned short b) { return __builtin_bit_cast(float, (unsigned)b << 16); }
__device__ __forceinline__ float wave_sum(float v) {
#pragma unroll
    for (int o = 1; o < 64; o <<= 1) v += __shfl_xor(v, o);
    return v;
}

__global__ void __launch_bounds__(512) k_prologue(Params p) {
    __shared__ float wf[1024 * 8];
    const int tid = threadIdx.x, lane = tid & 63, wave = tid >> 6;
    for (int i = tid; i < 1024 * 8; i += 512) wf[i] = p.w_in[(size_t)(i >> 3) * INW + 2048 + (i & 7)];
    if (blockIdx.x == 0 && tid < 64) ((int*)(p.ws + WS_CTL))[CW_CNT + tid] = 0;
    __syncthreads();
    bf16* XN = (bf16*)(p.ws + WS_XN); float* LOGF = (float*)(p.ws + WS_LOGF);
    const int gw = blockIdx.x * 8 + wave, NGW = gridDim.x * 8;
    f32x4 g[4];
#pragma unroll
    for (int j = 0; j < 4; ++j) g[j] = *(const f32x4*)(p.g_mix + 4 * lane + 256 * j);
    for (int m = gw; m < T; m += NGW) {
        const float* xr = p.x + (size_t)m * DM;
        f32x4 v[4]; float ss = 0.f;
#pragma unroll
        for (int j = 0; j < 4; ++j) { v[j] = *(const f32x4*)(xr + 4 * lane + 256 * j); ss += v[j].x * v[j].x + v[j].y * v[j].y + v[j].z * v[j].z + v[j].w * v[j].w; }
        const float rstd = rsqrtf(wave_sum(ss) * (1.f / DM) + RMS_EPS);
        float fl[8];
#pragma unroll
        for (int e = 0; e < 8; ++e) fl[e] = 0.f;
#pragma unroll
        for (int j = 0; j < 4; ++j) {
            v[j] = v[j] * rstd * g[j];
#pragma unroll
            for (int i = 0; i < 4; ++i) {
                const int d = 4 * lane + 256 * j + i; const float hv = v[j][i];
                const f32x4 w0 = *(const f32x4*)(wf + d * 8), w1 = *(const f32x4*)(wf + d * 8 + 4);
                fl[0] += hv * w0.x; fl[1] += hv * w0.y; fl[2] += hv * w0.z; fl[3] += hv * w0.w;
                fl[4] += hv * w1.x; fl[5] += hv * w1.y; fl[6] += hv * w1.z; fl[7] += hv * w1.w;
            }
            u32x2 o; o.x = pk2(v[j].x, v[j].y); o.y = pk2(v[j].z, v[j].w);
            *(u32x2*)(XN + (size_t)m * DM + 4 * lane + 256 * j) = o;
        }
#pragma unroll
        for (int e = 0; e < 8; ++e) fl[e] = wave_sum(fl[e]);
        if (lane < 8) {
            float z = 0.f;
#pragma unroll
            for (int e = 0; e < 8; ++e) if (lane == e) z = fl[e];
            z += p.b_forget[lane];
            const float ls = fminf(z, 0.f) - log1pf(expf(-fabsf(z)));
            const int b = m / SEQ, s = m % SEQ;
            LOGF[((size_t)b * NH + lane) * SEQ + s] = ls;
        }
    }
}

__global__ void __launch_bounds__(512) k_cumsum(Params p) {
    __shared__ double part[512];
    const int tid = threadIdx.x;
    const float* LOGF = (const float*)(p.ws + WS_LOGF); float* CUM = (float*)(p.ws + WS_CUM);
    for (int bh = blockIdx.x; bh < BATCH * NH; bh += gridDim.x) {
        const float* src = LOGF + (size_t)bh * SEQ + tid * 16; float v[16]; double s = 0.0;
#pragma unroll
        for (int i = 0; i < 16; ++i) { v[i] = src[i]; s += (double)v[i]; }
        part[tid] = s; __syncthreads();
        if (tid == 0) { double a = 0.0; for (int i = 0; i < 512; ++i) { const double t_ = part[i]; part[i] = a; a += t_; } }
        __syncthreads();
        double a = part[tid];
        float* dst = CUM + (size_t)bh * SEQ + tid * 16;
#pragma unroll
        for (int i = 0; i < 16; ++i) { a += (double)v[i]; dst[i] = (float)(a * (double)LOG2E); }
        __syncthreads();
    }
}

__global__ void __launch_bounds__(512) k_pool(Params p, bf16* dst, int ldd) {
    const bf16* U = (const bf16*)(p.ws + WS_U);
    const size_t total = (size_t)T * 64;
    for (size_t i = (size_t)blockIdx.x * 512 + threadIdx.x; i < total; i += (size_t)gridDim.x * 512) {
        const int row = (int)(i >> 6), ch = (int)(i & 63), c0 = ch * 8, g = c0 >> 7, w = 2 << g, t = row % SEQ;
        const int n = t + 1 < w ? t + 1 : w;
        float acc[8], self[8];
#pragma unroll
        for (int k = 0; k < 8; ++k) acc[k] = 0.f;
        for (int j = 0; j < n; ++j) {
            const u32x4 r = *(const u32x4*)(U + (size_t)(row - j) * PW + c0);
            const unsigned rr[4] = {r.x, r.y, r.z, r.w};
#pragma unroll
            for (int k = 0; k < 4; ++k) { const float lo = __builtin_bit_cast(float, rr[k] << 16), hi = __builtin_bit_cast(float, rr[k] & 0xffff0000u); acc[2 * k] += lo; acc[2 * k + 1] += hi;
                if (j == 0) { self[2 * k] = lo; self[2 * k + 1] = hi; } }
        }
        const float inv = 1.f / (float)n; u32x4 o;
        o.x = pk2(acc[0] * inv - self[0], acc[1] * inv - self[1]); o.y = pk2(acc[2] * inv - self[2], acc[3] * inv - self[3]);
        o.z = pk2(acc[4] * inv - self[4], acc[5] * inv - self[5]); o.w = pk2(acc[6] * inv - self[6], acc[7] * inv - self[7]);
        *(u32x4*)(dst + (size_t)row * ldd + c0) = o;
    }
}

template <class ARow, class Epi, bool DUAL>
__device__ __forceinline__ void naive_tile(int tm, int tn, int K, const ARow& arow, const float* W, const float* W2, int ldw, const Epi& epi, float* lds) {
    float* As = lds;
    float* Ws = lds + 16 * 68;
    float* Ws2 = Ws + 16 * 128;
    const int tid = threadIdx.x, tx = tid & 31, ty = tid >> 5;
    float acc[4][4], acc2[4][4];
#pragma unroll
    for (int i = 0; i < 4; ++i)
#pragma unroll
        for (int j = 0; j < 4; ++j) { acc[i][j] = 0.f; acc2[i][j] = 0.f; }
    const int ar = tid >> 3, ak = (tid & 7) * 2;
    const bf16* aptr = arow(tm * 64 + ar);
    const int wk = tid >> 5, wc = (tid & 31) * 4;
    for (int k0 = 0; k0 < K; k0 += 16) {
        unsigned av = aptr ? *(const unsigned*)(aptr + k0 + ak) : 0u;
        const f32x4 wv = *(const f32x4*)(W + (size_t)(k0 + wk) * ldw + tn * 128 + wc);
        f32x4 wv2; if (DUAL) wv2 = *(const f32x4*)(W2 + (size_t)(k0 + wk) * ldw + tn * 128 + wc);
        __syncthreads();
        As[ak * 68 + ar] = __builtin_bit_cast(float, av << 16); As[(ak + 1) * 68 + ar] = __builtin_bit_cast(float, av & 0xffff0000u);
        *(f32x4*)(Ws + wk * 128 + wc) = wv; if (DUAL) *(f32x4*)(Ws2 + wk * 128 + wc) = wv2;
        __syncthreads();
#pragma unroll
        for (int k = 0; k < 16; ++k) {
            const f32x4 a = *(const f32x4*)(As + k * 68 + ty * 4), w = *(const f32x4*)(Ws + k * 128 + tx * 4);
#pragma unroll
            for (int i = 0; i < 4; ++i)
#pragma unroll
                for (int j = 0; j < 4; ++j) acc[i][j] += a[i] * w[j];
            if (DUAL) { const f32x4 w2 = *(const f32x4*)(Ws2 + k * 128 + tx * 4);
#pragma unroll
                for (int i = 0; i < 4; ++i)
#pragma unroll
                    for (int j = 0; j < 4; ++j) acc2[i][j] += a[i] * w2[j]; }
        }
    }
#pragma unroll
    for (int i = 0; i < 4; ++i) epi(tm * 64 + ty * 4 + i, tn * 128 + tx * 4, acc[i], acc2[i]);
}
constexpr int NAIVE_LDS_FLOATS = 16 * 68 + 2 * 16 * 128;

struct ARowPlain { const bf16* A; int lda; __device__ __forceinline__ const bf16* operator()(int r) const { return A + (size_t)r * lda; } };
struct EpiInproj { bf16* U; __device__ __forceinline__ void operator()(int r, int c, const float (&a)[4], const float (&)[4]) const {
        const int t = c >> 9, cc = c & 511; const float s = (t == 1) ? C2 : 1.f;
        u32x2 o; o.x = pk2(a[0] * s, a[1] * s); o.y = pk2(a[2] * s, a[3] * s);
        *(u32x2*)(U + (size_t)t * ((WS_Q - WS_U) / 2) + (size_t)r * 512 + cc) = o; } };
__global__ void __launch_bounds__(512) k_inproj_naive(Params p) {
    __shared__ __attribute__((aligned(16))) float lds[NAIVE_LDS_FLOATS];
    ARowPlain ar{(const bf16*)(p.ws + WS_XN), DM}; EpiInproj ep{(bf16*)(p.ws + WS_U)};
    const int nM = T / 64, nN = 2048 / 128;
    for (int u = blockIdx.x; u < nM * nN; u += gridDim.x) naive_tile<ARowPlain, EpiInproj, false>(u / nN, u % nN, DM, ar, p.w_in, nullptr, INW, ep, lds);
}
struct EpiPool { bf16* CAT; const float* ps; int g; __device__ __forceinline__ void operator()(int r, int c, const float (&a)[4], const float (&)[4]) const {
        const int cc = g * 128 + c; const f32x4 s = *(const f32x4*)(ps + cc);
        u32x2 o; o.x = pk2(a[0] * s.x, a[1] * s.y); o.y = pk2(a[2] * s.z, a[3] * s.w);
        *(u32x2*)(CAT + (size_t)r * DM + cc) = o; } };
__global__ void __launch_bounds__(512) k_poolgemm_naive(Params p) {
    __shared__ __attribute__((aligned(16))) float lds[NAIVE_LDS_FLOATS];
    const int nM = T / 64;
    for (int u = blockIdx.x; u < nM * 4; u += gridDim.x) { const int g = u & 3, tm = u >> 2;
        ARowPlain ar{(const bf16*)(p.ws + WS_P) + g * 128, PW}; EpiPool ep{(bf16*)(p.ws + WS_CAT), p.pool_scale, g};
        naive_tile<ARowPlain, EpiPool, false>(tm, 0, 128, ar, p.w_pool + (size_t)g * 128 * 128, nullptr, 128, ep, lds); }
}
struct EpiOut { const float* x; float* out; __device__ __forceinline__ void operator()(int r, int c, const float (&a)[4], const float (&)[4]) const {
        const f32x4 xv = *(const f32x4*)(x + (size_t)r * DM + c); f32x4 o = {xv.x + a[0], xv.y + a[1], xv.z + a[2], xv.w + a[3]};
        *(f32x4*)(out + (size_t)r * DM + c) = o; } };
__global__ void __launch_bounds__(512) k_outproj_naive(Params p) {
    __shared__ __attribute__((aligned(16))) float lds[NAIVE_LDS_FLOATS];
    ARowPlain ar{(const bf16*)(p.ws + WS_CAT), DM}; EpiOut ep{p.x, p.out};
    const int nM = T / 64, nN = DM / 128;
    for (int u = blockIdx.x; u < nM * nN; u += gridDim.x) naive_tile<ARowPlain, EpiOut, false>(u / nN, u % nN, DM, ar, p.w_out, nullptr, DM, ep, lds);
}

__global__ void __launch_bounds__(512) k_attn_naive(Params p) {
    __shared__ __attribute__((aligned(16))) float Ks[64 * 68];
    __shared__ __attribute__((aligned(16))) float Vs[64 * 64];
    __shared__ float Ss[64 * 65];
    __shared__ float cs[64];
    const bf16* Q = (const bf16*)(p.ws + WS_Q); const bf16* K = (const bf16*)(p.ws + WS_K); const bf16* V = (const bf16*)(p.ws + WS_V);
    bf16* CAT = (bf16*)(p.ws + WS_CAT); const float* CUM = (const float*)(p.ws + WS_CUM);
    const int tid = threadIdx.x, r = tid >> 3, part = tid & 7;
    for (int u = blockIdx.x; u < BATCH * NH * (SEQ / 64); u += gridDim.x) {
        const int qb = (SEQ / 64 - 1) - (u / (BATCH * NH)), bh = u % (BATCH * NH), b = bh / NH, h = bh % NH;
        const size_t rowbase = (size_t)b * SEQ; const int t = qb * 64 + r;
        float q[64];
        { const bf16* qp = Q + (rowbase + t) * AW + h * HD;
#pragma unroll
          for (int i = 0; i < 64; i += 2) { const unsigned v = *(const unsigned*)(qp + i); q[i] = __builtin_bit_cast(float, v << 16); q[i + 1] = __builtin_bit_cast(float, v & 0xffff0000u); } }
        const float ct = CUM[(size_t)bh * SEQ + t];
        float o[8]; float m = -INFINITY, l = 0.f;
#pragma unroll
        for (int i = 0; i < 8; ++i) o[i] = 0.f;
        for (int kt = 0; kt <= qb; ++kt) {
            __syncthreads();
            { const int kr = tid >> 3, kc = (tid & 7) * 8;
              const u32x4 kv = *(const u32x4*)(K + (rowbase + kt * 64 + kr) * AW + h * HD + kc), vv = *(const u32x4*)(V + (rowbase + kt * 64 + kr) * AW + h * HD + kc);
              const unsigned ka[4] = {kv.x, kv.y, kv.z, kv.w}, va[4] = {vv.x, vv.y, vv.z, vv.w};
#pragma unroll
              for (int i = 0; i < 4; ++i) { Ks[kr * 68 + kc + 2 * i] = __builtin_bit_cast(float, ka[i] << 16); Ks[kr * 68 + kc + 2 * i + 1] = __builtin_bit_cast(float, ka[i] & 0xffff0000u);
                  Vs[kr * 64 + kc + 2 * i] = __builtin_bit_cast(float, va[i] << 16); Vs[kr * 64 + kc + 2 * i + 1] = __builtin_bit_cast(float, va[i] & 0xffff0000u); }
              if (tid < 64) cs[tid] = CUM[(size_t)bh * SEQ + kt * 64 + tid]; }
            __syncthreads();
            float lg[8]; float mx = -INFINITY;
#pragma unroll
            for (int j = 0; j < 8; ++j) { const int s = part * 8 + j; float d = 0.f;
#pragma unroll
                for (int i = 0; i < 64; i += 4) { const f32x4 kk = *(const f32x4*)(Ks + s * 68 + i); d += q[i] * kk.x + q[i + 1] * kk.y + q[i + 2] * kk.z + q[i + 3] * kk.w; }
                d += ct - cs[s]; if (kt * 64 + s > t) d = -INFINITY; lg[j] = d; mx = fmaxf(mx, d); }
            mx = fmaxf(mx, __shfl_xor(mx, 1)); mx = fmaxf(mx, __shfl_xor(mx, 2)); mx = fmaxf(mx, __shfl_xor(mx, 4));
            const float mn = fmaxf(m, mx); const float alpha = exp2f(m - mn); float ps = 0.f;
#pragma unroll
            for (int j = 0; j < 8; ++j) { const float pv = exp2f(lg[j] - mn); ps += pv; Ss[r * 65 + part * 8 + j] = pv; }
            ps += __shfl_xor(ps, 1); ps += __shfl_xor(ps, 2); ps += __shfl_xor(ps, 4);
            l = l * alpha + ps; m = mn;
#pragma unroll
            for (int i = 0; i < 8; ++i) o[i] *= alpha;
            __syncthreads();
            for (int s = 0; s < 64; ++s) { const float pv = Ss[r * 65 + s]; const f32x4 v0 = *(const f32x4*)(Vs + s * 64 + part * 8), v1 = *(const f32x4*)(Vs + s * 64 + part * 8 + 4);
                o[0] += pv * v0.x; o[1] += pv * v0.y; o[2] += pv * v0.z; o[3] += pv * v0.w; o[4] += pv * v1.x; o[5] += pv * v1.y; o[6] += pv * v1.z; o[7] += pv * v1.w; }
        }
        const float il = 1.f / l; u32x4 ov;
        ov.x = pk2(o[0] * il, o[1] * il); ov.y = pk2(o[2] * il, o[3] * il); ov.z = pk2(o[4] * il, o[5] * il); ov.w = pk2(o[6] * il, o[7] * il);
        *(u32x4*)(CAT + (rowbase + t) * DM + PW + h * HD + part * 8) = ov;
    }
}

__global__ void __launch_bounds__(512) k_router(Params p) {
    __shared__ __attribute__((aligned(16))) float wr[1024 * 32];
    __shared__ int ch_e[128 * 4]; __shared__ float ch_g[128 * 4]; __shared__ int lcnt[32], lbase[32];
    const int tid = threadIdx.x, lane = tid & 63, wave = tid >> 6;
    for (int i = tid; i < 1024 * 32 / 4; i += 512) ((f32x4*)wr)[i] = ((const f32x4*)p.w_router)[i];
    __syncthreads();
    const float* X1 = p.out; bf16* H2 = (bf16*)(p.ws + WS_XN);
    int* cnt = (int*)(p.ws + WS_CTL) + CW_CNT; int* SEL = (int*)(p.ws + WS_SEL); int* LTK = (int*)(p.ws + WS_LTK); float* LGT = (float*)(p.ws + WS_LGT);
    f32x4 g[4];
#pragma unroll
    for (int j = 0; j < 4; ++j) g[j] = *(const f32x4*)(p.g_ffn + 4 * lane + 256 * j);
    const float br = p.b_router[lane & 31];
    for (int grp = blockIdx.x; grp < T / 128; grp += gridDim.x) {
        if (tid < 32) lcnt[tid] = 0;
        __syncthreads();
        for (int it = 0; it < 16; ++it) {
            const int lt = wave * 16 + it, m = grp * 128 + lt;
            const float* xr = X1 + (size_t)m * DM;
            f32x4 v[4]; float ss = 0.f;
#pragma unroll
            for (int j = 0; j < 4; ++j) { v[j] = *(const f32x4*)(xr + 4 * lane + 256 * j); ss += v[j].x * v[j].x + v[j].y * v[j].y + v[j].z * v[j].z + v[j].w * v[j].w; }
            const float rstd = rsqrtf(wave_sum(ss) * (1.f / DM) + RMS_EPS);
            float lg[32];
#pragma unroll
            for (int e = 0; e < 32; ++e) lg[e] = 0.f;
#pragma unroll
            for (int j = 0; j < 4; ++j) {
                v[j] = v[j] * rstd * g[j];
                u32x2 o; o.x = pk2(v[j].x, v[j].y); o.y = pk2(v[j].z, v[j].w);
                *(u32x2*)(H2 + (size_t)m * DM + 4 * lane + 256 * j) = o;
#pragma unroll
                for (int i = 0; i < 4; ++i) { const int d = 4 * lane + 256 * j + i; const float hv = v[j][i];
#pragma unroll
                    for (int e4 = 0; e4 < 8; ++e4) { const f32x4 w = *(const f32x4*)(wr + d * 32 + e4 * 4);
                        lg[e4 * 4] += hv * w.x; lg[e4 * 4 + 1] += hv * w.y; lg[e4 * 4 + 2] += hv * w.z; lg[e4 * 4 + 3] += hv * w.w; }
                    asm volatile("" ::: "memory"); }
            }
            float mine;
            {
                float a16[16];
                const bool up = lane >= 32;
#pragma unroll
                for (int e = 0; e < 16; ++e) { const float keep = up ? lg[16 + e] : lg[e], give = up ? lg[e] : lg[16 + e]; a16[e] = keep + __shfl_xor(give, 32); }
                float a8[8]; const bool u16 = (lane & 16) != 0;
#pragma unroll
                for (int e = 0; e < 8; ++e) { const float keep = u16 ? a16[8 + e] : a16[e], give = u16 ? a16[e] : a16[8 + e]; a8[e] = keep + __shfl_xor(give, 16); }
                float a4[4]; const bool u8 = (lane & 8) != 0;
#pragma unroll
                for (int e = 0; e < 4; ++e) { const float keep = u8 ? a8[4 + e] : a8[e], give = u8 ? a8[e] : a8[4 + e]; a4[e] = keep + __shfl_xor(give, 8); }
                float a2[2]; const bool u4 = (lane & 4) != 0;
#pragma unroll
                for (int e = 0; e < 2; ++e) { const float keep = u4 ? a4[2 + e] : a4[e], give = u4 ? a4[e] : a4[2 + e]; a2[e] = keep + __shfl_xor(give, 4); }
                const bool u2 = (lane & 2) != 0;
                float a1 = (u2 ? a2[1] : a2[0]) + __shfl_xor(u2 ? a2[0] : a2[1], 2);
                a1 += __shfl_xor(a1, 1);
                mine = a1;
            }
            const int myexp = ((lane >> 5) & 1) * 16 + ((lane >> 4) & 1) * 8 + ((lane >> 3) & 1) * 4 + ((lane >> 2) & 1) * 2 + ((lane >> 1) & 1);
            float val = mine + p.b_router[myexp]; (void)br;
            if (lane & 1) val = -INFINITY;
            float tv[4]; int ti[4];
#pragma unroll
            for (int k = 0; k < 4; ++k) {
                float bv = val; int bi = myexp;
#pragma unroll
                for (int o = 1; o < 64; o <<= 1) { const float ov = __shfl_xor(bv, o); const int oi = __shfl_xor(bi, o); if (ov > bv || (ov == bv && oi < bi)) { bv = ov; bi = oi; } }
                tv[k] = bv; ti[k] = bi; if (myexp == bi) val = -INFINITY;
            }
            const float e0 = 1.f, e1 = expf(tv[1] - tv[0]), e2 = expf(tv[2] - tv[0]), e3 = expf(tv[3] - tv[0]); const float inv = 1.f / (e0 + e1 + e2 + e3);
            if (lane < 4) { const float gg = (lane == 0 ? e0 : lane == 1 ? e1 : lane == 2 ? e2 : e3) * inv; const int ee = lane == 0 ? ti[0] : lane == 1 ? ti[1] : lane == 2 ? ti[2] : ti[3];
                ch_e[lt * 4 + lane] = ee; ch_g[lt * 4 + lane] = gg; atomicAdd(&lcnt[ee], 1); }
        }
        __syncthreads();
        if (tid < 32) { lbase[tid] = atomicAdd(&cnt[tid], lcnt[tid]); lcnt[tid] = 0; }
        __syncthreads();
        { const int e = ch_e[tid]; const int slot = lbase[e] + atomicAdd(&lcnt[e], 1); const int tk = (grp * 128 + (tid >> 2)) * 4 + (tid & 3);
          LTK[(size_t)e * T + slot] = tk; LGT[(size_t)e * T + slot] = ch_g[tid]; SEL[tk] = (slot << 5) | e; }
        __syncthreads();
    }
}

struct ExpertMap { int cnt[32]; int pstart[33]; };
__device__ __forceinline__ void load_expert_map(const int* cnt, int* s_cnt, int* s_ps) {
    if (threadIdx.x == 0) { int a = 0; for (int e = 0; e < 32; ++e) { const int c = cnt[e]; s_cnt[e] = c; s_ps[e] = a; a += ((c + RT - 1) / RT) * RT; } s_ps[32] = a; }
}
struct ARowGather { const bf16* H2; const int* ltk; int pstart, cnt; __device__ __forceinline__ const bf16* operator()(int r) const { const int s = r - pstart; return s < cnt ? H2 + (size_t)(ltk[s] >> 2) * DM : nullptr; } };
struct EpiUp { bf16* ACT; const float* bu; __device__ __forceinline__ void operator()(int r, int c, const float (&a)[4], const float (&a2)[4]) const {
        const f32x4 bg = *(const f32x4*)(bu + c), bl = *(const f32x4*)(bu + DE + c); float o[4];
#pragma unroll
        for (int i = 0; i < 4; ++i) { const float gl = fminf(a[i] + bg[i], SW_LIMIT), li = fminf(fmaxf(a2[i] + bl[i], -SW_LIMIT), SW_LIMIT); o[i] = gl * (1.f / (1.f + expf(-SW_ALPHA * gl))) * (li + 1.f); }
        u32x2 ov; ov.x = pk2(o[0], o[1]); ov.y = pk2(o[2], o[3]); *(u32x2*)(ACT + (size_t)r * DE + c) = ov; } };
__global__ void __launch_bounds__(512) k_up_naive(Params p) {
    __shared__ __attribute__((aligned(16))) float lds[NAIVE_LDS_FLOATS]; __shared__ int s_cnt[32], s_ps[33];
    load_expert_map((const int*)(p.ws + WS_CTL) + CW_CNT, s_cnt, s_ps); __syncthreads();
    const int ntm = s_ps[32] / 64, nN = DE / 128;
    for (int u = blockIdx.x; u < ntm * nN; u += gridDim.x) { const int tm = u / nN, tn = u % nN; int e = 0; while (s_ps[e + 1] <= tm * 64) ++e;
        if (tm * 64 - s_ps[e] >= s_cnt[e]) continue;
        ARowGather ar{(const bf16*)(p.ws + WS_XN), (const int*)(p.ws + WS_LTK) + (size_t)e * T, s_ps[e], s_cnt[e]}; EpiUp ep{(bf16*)(p.ws + WS_ACT), p.b_up + (size_t)e * 2 * DE};
        naive_tile<ARowGather, EpiUp, true>(tm, tn, DM, ar, p.w_up + (size_t)e * DM * 2 * DE, p.w_up + (size_t)e * DM * 2 * DE + DE, 2 * DE, ep, lds); }
}
struct ARowAct { const bf16* ACT; int pstart, cnt; __device__ __forceinline__ const bf16* operator()(int r) const { return (r - pstart) < cnt ? ACT + (size_t)r * DE : nullptr; } };
struct EpiDown { bf16* Y; const float* bd; const float* lgt; int pstart, cnt; __device__ __forceinline__ void operator()(int r, int c, const float (&a)[4], const float (&)[4]) const {
        const int s = r - pstart; if (s >= cnt) return; const float gt = lgt[s]; const f32x4 b = *(const f32x4*)(bd + c);
        u32x2 ov; ov.x = pk2((a[0] + b.x) * gt, (a[1] + b.y) * gt); ov.y = pk2((a[2] + b.z) * gt, (a[3] + b.w) * gt); *(u32x2*)(Y + (size_t)r * DM + c) = ov; } };
__global__ void __launch_bounds__(512) k_down_naive(Params p) {
    __shared__ __attribute__((aligned(16))) float lds[NAIVE_LDS_FLOATS]; __shared__ int s_cnt[32], s_ps[33];
    load_expert_map((const int*)(p.ws + WS_CTL) + CW_CNT, s_cnt, s_ps); __syncthreads();
    const int ntm = s_ps[32] / 64, nN = DM / 128;
    for (int u = blockIdx.x; u < ntm * nN; u += gridDim.x) { const int tm = u / nN, tn = u % nN; int e = 0; while (s_ps[e + 1] <= tm * 64) ++e;
        if (tm * 64 - s_ps[e] >= s_cnt[e]) continue;
        ARowAct ar{(const bf16*)(p.ws + WS_ACT), s_ps[e], s_cnt[e]}; EpiDown ep{(bf16*)(p.ws + WS_Y), p.b_down + (size_t)e * DM, (const float*)(p.ws + WS_LGT) + (size_t)e * T, s_ps[e], s_cnt[e]};
        naive_tile<ARowAct, EpiDown, false>(tm, tn, DE, ar, p.w_down + (size_t)e * DE * DM, nullptr, DM, ep, lds); }
}

__global__ void __launch_bounds__(512) k_final(Params p) {
    __shared__ int s_cnt[32], s_ps[33];
    load_expert_map((const int*)(p.ws + WS_CTL) + CW_CNT, s_cnt, s_ps); __syncthreads();
    const int tid = threadIdx.x, lane = tid & 63, wave = tid >> 6;
    const int* SEL = (const int*)(p.ws + WS_SEL); const bf16* Y = (const bf16*)(p.ws + WS_Y);
    f32x4 g[4];
#pragma unroll
    for (int j = 0; j < 4; ++j) g[j] = *(const f32x4*)(p.g_final + 4 * lane + 256 * j);
    for (int m = blockIdx.x * 8 + wave; m < T; m += gridDim.x * 8) {
        float* xr = p.out + (size_t)m * DM; f32x4 v[4];
#pragma unroll
        for (int j = 0; j < 4; ++j) v[j] = *(const f32x4*)(xr + 4 * lane + 256 * j);
#pragma unroll
        for (int k = 0; k < 4; ++k) { const int sv = SEL[m * 4 + k]; const int e = sv & 31, slot = sv >> 5; const bf16* yr = Y + (size_t)(s_ps[e] + slot) * DM;
#pragma unroll
            for (int j = 0; j < 4; ++j) { const u32x2 y = *(const u32x2*)(yr + 4 * lane + 256 * j);
                v[j].x += __builtin_bit_cast(float, y.x << 16); v[j].y += __builtin_bit_cast(float, y.x & 0xffff0000u); v[j].z += __builtin_bit_cast(float, y.y << 16); v[j].w += __builtin_bit_cast(float, y.y & 0xffff0000u); } }
        float ss = 0.f;
#pragma unroll
        for (int j = 0; j < 4; ++j) ss += v[j].x * v[j].x + v[j].y * v[j].y + v[j].z * v[j].z + v[j].w * v[j].w;
        const float rstd = rsqrtf(wave_sum(ss) * (1.f / DM) + RMS_EPS);
#pragma unroll
        for (int j = 0; j < 4; ++j) *(f32x4*)(xr + 4 * lane + 256 * j) = v[j] * rstd * g[j];
    }
}

namespace pg8 {
#define PG8_LAS __attribute__((address_space(3)))
typedef unsigned short bf16_t;
typedef short bf16x8 __attribute__((ext_vector_type(8)));
typedef float f32x4 __attribute__((ext_vector_type(4)));
typedef unsigned u32x4 __attribute__((ext_vector_type(4)));
constexpr int BM = 256, BK = 64, HALF = 128, HTB = HALF * BK * 2  , STAGE_BYTES = 8 * HTB, NXCD = 8, WGM = 8;

__host__ __device__ __forceinline__ int lds_byte(int r, int c) { const int st = (r >> 4) * 2 + (c >> 5), rr = r & 15, cc = c & 31, ob = rr * 64 + cc * 2; return st * 1024 + (ob ^ (((ob >> 9) & 1) << 5)); }
__host__ __device__ __forceinline__ void stage_rc(int b, int& R, int& C) { const int st = b / 1024, sb = b % 1024, swz = sb ^ (((sb >> 9) & 1) << 5); R = (st >> 1) * 16 + swz / 64; C = (st & 1) * 32 + (swz % 64) / 2; }
__host__ __device__ __forceinline__ int perm32(int rho) { const int n = rho >> 4, i = rho & 15; return 8 * (i >> 2) + 4 * n + (i & 3); }

struct Unit { int pm, pn, e, lrow0; size_t boff; };
struct Gemm { const bf16_t* A; const bf16_t* Bt; int K; };

struct StaticOrder {
    int nM, nN, nwg, G, c;
    __host__ __device__ void init(int M, int N, int G_, int c_) { nM = M / BM; nN = N / BM; nwg = nM * nN; G = G_; c = c_; }
    __host__ __device__ bool next(int i, Unit& u) const {
        const long L = (long)i * G + c; if (L >= nwg) return false;
        int wgid = (int)L; { const int q = nwg / NXCD, r = nwg % NXCD, xcd = wgid % NXCD, off = wgid / NXCD; wgid = (xcd < r ? xcd * (q + 1) : r * (q + 1) + (xcd - r) * q) + off; }
        const int nig = WGM * nN, gid = wgid / nig, fm = gid * WGM, gsz = (nM - fm) < WGM ? (nM - fm) : WGM;
        u.pm = fm + ((wgid % nig) % gsz); u.pn = (wgid % nig) / gsz; u.e = 0; u.lrow0 = 0; u.boff = 0; return true;
    }
};
template <int NCOL> struct MoeOrder {
    static constexpr int RG = 32 / NCOL;
    const PG8_LAS int* ul; size_t bstride;
    static __device__ __forceinline__ void build(PG8_LAS int* ul, const PG8_LAS int* pt, int c, int tid) {
        const int nrt = pt[32]; const int x = c & 7, j = c >> 3;
        const int lo = (nrt * x) >> 3, hi = (nrt * (x + 1)) >> 3;
        if (tid < 32) { const int rt = lo + RG * tid + j / NCOL;
            if (rt < hi) { int e = 0; for (int k = 1; k < 32; ++k) e += (pt[k] <= rt) ? 1 : 0;
                ul[4 + 4 * tid] = rt; ul[5 + 4 * tid] = j % NCOL; ul[6 + 4 * tid] = e; ul[7 + 4 * tid] = (rt - pt[e]) * BM; } }
        if (tid == 0) { const int span = hi - (lo + j / NCOL); ul[0] = span > 0 ? (span + RG - 1) / RG : 0; }
        __syncthreads();
    }
    __device__ __forceinline__ bool next(int i, Unit& u) const {
        if (i >= ul[0]) return false;
        u.pm = ul[4 + 4 * i]; u.pn = ul[5 + 4 * i]; u.e = ul[6 + 4 * i]; u.lrow0 = ul[7 + 4 * i]; u.boff = (size_t)u.e * bstride; return true;
    }
};

__device__ __forceinline__ unsigned cvt_pk_bf16(float lo, float hi) { unsigned r; asm volatile("v_cvt_pk_bf16_f32 %0, %1, %2" : "=v"(r) : "v"(lo), "v"(hi)); return r; }

struct EpiInproj {
    static constexpr bool PERM = true;
    bf16_t* O; size_t split_stride; float qscale; unsigned* nrm;
    __device__ __forceinline__ void operator()(const f32x4 (&acc)[2][2][4][2], const Unit& u, int wr, int wc, int fr, int fq) const {
        const int row0 = u.pm * BM + wr * 64 + fr; int colt = u.pn * BM; const int t = colt >> 9; bf16_t* base = O + (size_t)t * split_stride; colt -= t * 512;
        const float sc = (t == 1) ? qscale : 1.f; const int col0 = colt + wc * 32 + 8 * fq;
#pragma unroll
        for (int ai = 0; ai < 2; ++ai)
#pragma unroll
            for (int m = 0; m < 4; ++m) { bf16_t* rowp = base + (size_t)(row0 + ai * HALF + m * 16) * 512 + col0;
#pragma unroll
                for (int bj = 0; bj < 2; ++bj) { const f32x4 v0 = acc[ai][bj][m][0] * sc, v1 = acc[ai][bj][m][1] * sc;
                    u32x4 w; w.x = cvt_pk_bf16(v0[0], v0[1]); w.y = cvt_pk_bf16(v0[2], v0[3]); w.z = cvt_pk_bf16(v1[0], v1[1]); w.w = cvt_pk_bf16(v1[2], v1[3]);
                    *(u32x4*)(rowp + bj * HALF) = w; } }
        if (t == 1 || t == 2) {
            float mx[2] = {0.f, 0.f};
#pragma unroll
            for (int ai = 0; ai < 2; ++ai)
#pragma unroll
                for (int m = 0; m < 4; ++m)
#pragma unroll
                    for (int bj = 0; bj < 2; ++bj) { const f32x4 v0 = acc[ai][bj][m][0] * sc, v1 = acc[ai][bj][m][1] * sc;
                        float s8 = v0[0] * v0[0] + v0[1] * v0[1] + v0[2] * v0[2] + v0[3] * v0[3] + v1[0] * v1[0] + v1[1] * v1[1] + v1[2] * v1[2] + v1[3] * v1[3];
                        s8 += __shfl_xor(s8, 16); s8 += __shfl_xor(s8, 32); mx[bj] = fmaxf(mx[bj], s8); }
#pragma unroll
            for (int bj = 0; bj < 2; ++bj) {
#pragma unroll
                for (int o = 1; o < 16; o <<= 1) mx[bj] = fmaxf(mx[bj], __shfl_xor(mx[bj], o));
                if ((threadIdx.x & 63) == 0) { const int head = ((u.pn & 1) * 256 + bj * HALF + wc * 32) >> 6, b = (u.pm * BM) >> 13;
                    atomicMax(nrm + (t - 1) * 32 + b * 8 + head, __float_as_uint(mx[bj] * 1.01f)); } }
        }
    }
};
struct EpiResBf16 {
    static constexpr bool PERM = true;
    const float* x; bf16_t* out;
    __device__ __forceinline__ void operator()(const f32x4 (&acc)[2][2][4][2], const Unit& u, int wr, int wc, int fr, int fq) const {
        const int row0 = u.pm * BM + wr * 64 + fr, col0 = u.pn * BM + wc * 32 + 8 * fq;
#pragma unroll
        for (int ai = 0; ai < 2; ++ai)
#pragma unroll
            for (int m = 0; m < 4; ++m) { const size_t off = (size_t)(row0 + ai * HALF + m * 16) * 1024 + col0;
#pragma unroll
                for (int bj = 0; bj < 2; ++bj) { const f32x4 v0 = *(const f32x4*)(x + off + bj * HALF) + acc[ai][bj][m][0], v1 = *(const f32x4*)(x + off + bj * HALF + 4) + acc[ai][bj][m][1];
                    u32x4 w; w.x = cvt_pk_bf16(v0[0], v0[1]); w.y = cvt_pk_bf16(v0[2], v0[3]); w.z = cvt_pk_bf16(v1[0], v1[1]); w.w = cvt_pk_bf16(v1[2], v1[3]);
                    *(u32x4*)(out + off + bj * HALF) = w; }
                if (m & 1) asm volatile("" ::: "memory"); }
    }
};
__device__ __forceinline__ float swiglu1(float g, float l) {
    const float gl = fminf(g, 7.0f), li = fminf(fmaxf(l, -7.0f), 7.0f);
    const float sg = __builtin_amdgcn_rcpf(1.0f + __builtin_amdgcn_exp2f(gl * (-1.702f * 1.4426950408889634f)));
    return gl * sg * (li + 1.0f);
}
struct EpiSwiglu {
    static constexpr bool PERM = true;
    bf16_t* ACT; const float* bup;
    __device__ __forceinline__ void operator()(const f32x4 (&acc)[2][2][4][2], const Unit& u, int wr, int wc, int fr, int fq) const {
        const int row0 = u.pm * BM + wr * 64 + fr, col0 = u.pn * HALF + wc * 32 + 8 * fq;
        const float* bb = bup + (size_t)u.e * 2048 + col0;
        f32x4 bg[2], bl[2];
#pragma unroll
        for (int n = 0; n < 2; ++n) { bg[n] = *(const f32x4*)(bb + 4 * n); bl[n] = *(const f32x4*)(bb + 1024 + 4 * n); }
#pragma unroll
        for (int ai = 0; ai < 2; ++ai)
#pragma unroll
            for (int m = 0; m < 4; ++m) { bf16_t* rowp = ACT + (size_t)(row0 + ai * HALF + m * 16) * 1024 + col0;
                const f32x4 g0 = acc[ai][0][m][0] + bg[0], g1 = acc[ai][0][m][1] + bg[1], l0 = acc[ai][1][m][0] + bl[0], l1 = acc[ai][1][m][1] + bl[1];
                u32x4 w; w.x = cvt_pk_bf16(swiglu1(g0[0], l0[0]), swiglu1(g0[1], l0[1])); w.y = cvt_pk_bf16(swiglu1(g0[2], l0[2]), swiglu1(g0[3], l0[3]));
                w.z = cvt_pk_bf16(swiglu1(g1[0], l1[0]), swiglu1(g1[1], l1[1])); w.w = cvt_pk_bf16(swiglu1(g1[2], l1[2]), swiglu1(g1[3], l1[3]));
                *(u32x4*)rowp = w; }
    }
};

constexpr float FP8_SA = 4.0f, FP8_SW = 256.0f, FP8_INV = 1.0f / (FP8_SA * FP8_SW), FP8_SY = 16.0f;
__device__ __forceinline__ unsigned pack4_fp8(float a, float b, float c, float d) { unsigned p = 0; p = __builtin_amdgcn_cvt_pk_fp8_f32(a, b, p, false); p = __builtin_amdgcn_cvt_pk_fp8_f32(c, d, p, true); return p; }
struct EpiSwiglu8 {
    static constexpr bool PERM = true;
    unsigned char* ACT; const float* bup;
    __device__ __forceinline__ void operator()(const f32x4 (&acc)[2][2][4][2], const Unit& u, int wr, int wc, int fr, int fq) const {
        const int row0 = u.pm * BM + wr * 64 + fr, col0 = u.pn * HALF + wc * 32 + 8 * fq;
        const float* bb = bup + (size_t)u.e * 2048 + col0;
        f32x4 bg[2], bl[2];
#pragma unroll
        for (int n = 0; n < 2; ++n) { bg[n] = *(const f32x4*)(bb + 4 * n); bl[n] = *(const f32x4*)(bb + 1024 + 4 * n); }
#pragma unroll
        for (int ai = 0; ai < 2; ++ai)
#pragma unroll
            for (int m = 0; m < 4; ++m) { unsigned char* rowp = ACT + (size_t)(row0 + ai * HALF + m * 16) * 1024 + col0;
                const f32x4 g0 = acc[ai][0][m][0] * FP8_INV + bg[0], g1 = acc[ai][0][m][1] * FP8_INV + bg[1], l0 = acc[ai][1][m][0] * FP8_INV + bl[0], l1 = acc[ai][1][m][1] * FP8_INV + bl[1];
                typedef unsigned u32x2_t __attribute__((ext_vector_type(2))); u32x2_t w;
                w.x = pack4_fp8(swiglu1(g0[0], l0[0]) * FP8_SA, swiglu1(g0[1], l0[1]) * FP8_SA, swiglu1(g0[2], l0[2]) * FP8_SA, swiglu1(g0[3], l0[3]) * FP8_SA);
                w.y = pack4_fp8(swiglu1(g1[0], l1[0]) * FP8_SA, swiglu1(g1[1], l1[1]) * FP8_SA, swiglu1(g1[2], l1[2]) * FP8_SA, swiglu1(g1[3], l1[3]) * FP8_SA);
                *(u32x2_t*)rowp = w; }
    }
};
struct EpiDown {
    static constexpr bool PERM = true;
    unsigned char* Y; const float* bdn; const float* lgt; const PG8_LAS int* cnt; int Ttok; float ascale;
    __device__ __forceinline__ void operator()(const f32x4 (&acc)[2][2][4][2], const Unit& u, int wr, int wc, int fr, int fq) const {
        const int rl = wr * 64 + fr, col0 = u.pn * BM + wc * 32 + 8 * fq; const int ce = cnt[u.e];
        const float* bb = bdn + (size_t)u.e * 1024 + col0; const float* gp = lgt + (size_t)u.e * Ttok + u.lrow0;
        f32x4 bv[2][2];
#pragma unroll
        for (int bj = 0; bj < 2; ++bj)
#pragma unroll
            for (int n = 0; n < 2; ++n) bv[bj][n] = *(const f32x4*)(bb + bj * HALF + 4 * n);
#pragma unroll
        for (int ai = 0; ai < 2; ++ai)
#pragma unroll
            for (int m = 0; m < 4; ++m) { const int r = rl + ai * HALF + m * 16; const float gt = (u.lrow0 + r < ce) ? gp[r] * FP8_SY : 0.f;
                unsigned char* rowp = Y + (size_t)(u.pm * BM + r) * 1024 + col0;
#pragma unroll
                for (int bj = 0; bj < 2; ++bj) { const f32x4 v0 = (acc[ai][bj][m][0] * ascale + bv[bj][0]) * gt, v1 = (acc[ai][bj][m][1] * ascale + bv[bj][1]) * gt;
                    typedef unsigned u32x2_t __attribute__((ext_vector_type(2))); u32x2_t w; w.x = pack4_fp8(v0[0], v0[1], v0[2], v0[3]); w.y = pack4_fp8(v1[0], v1[1], v1[2], v1[3]);
                    *(u32x2_t*)(rowp + bj * HALF) = w; } }
    }
};

typedef int v4i_t __attribute__((ext_vector_type(4)));
typedef int v8i_t __attribute__((ext_vector_type(8)));
template <class Epi, class Sched, bool ALIGN_EPI, bool GATHER, bool FP8 = false>
__device__ __forceinline__ void gemm_phase(PG8_LAS unsigned char* lds, const Gemm g, const Sched& S, const Epi& E, const PG8_LAS unsigned* tab, volatile PG8_LAS unsigned* prb = nullptr) {
    const int tid = threadIdx.x, wid = __builtin_amdgcn_readfirstlane(tid >> 6), lane = tid & 63, wr = wid >> 2, wc = wid & 3, fr = lane & 15, fq = lane >> 4;
    const int K = g.K, nt = K / BK;
    unsigned voffA[2], voffB[2], cby[2]; int rsl[2];
#pragma unroll
    for (int i = 0; i < 2; ++i) { int R, C; stage_rc(tid * 16 + i * 8192, R, C); const int Rb = Epi::PERM ? ((R & ~31) + perm32(R & 31)) : R;
        voffA[i] = (unsigned)(R * K + C) * 2u; voffB[i] = (unsigned)(Rb * K + C) * 2u; rsl[i] = R; cby[i] = (unsigned)C * 2u; }
    const size_t kstep = (size_t)(BK * 2);
    const size_t hstep = (size_t)HALF * K * 2;
    const size_t tstep = 2 * hstep;
    const size_t ahstep = GATHER ? 0 : hstep;
    const unsigned ldsw = (unsigned)wid * 1024u;
    const int aoff = lds_byte(wr * 64 + fr, fq * 8), boff = lds_byte(wc * 32 + fr, fq * 8);
#define PG8_SA(b, h) (((b) * 2 + (h)) * HTB)
#define PG8_SB(b, h) ((4 + (b) * 2 + (h)) * HTB)
#define PG8_STAGE(bufoff, gbase, voff) do { _Pragma("unroll") for (int _i = 0; _i < 2; ++_i) \
        __builtin_amdgcn_global_load_lds((const unsigned*)((const char*)(gbase) + (voff)[_i]), (PG8_LAS unsigned*)(lds + (bufoff) + ldsw + _i * 8192), 16, 0, 0); } while (0)
#define PG8_LD16(off) (*(const PG8_LAS v4i_t*)(lds + (off)))
#define PG8_LDA(dst, b, h) do { _Pragma("unroll") for (int m = 0; m < 4; ++m) { if constexpr (FP8) dst##8[m] = __builtin_shufflevector(PG8_LD16(PG8_SA(b, h) + aoff + m * 2048), PG8_LD16(PG8_SA(b, h) + aoff + m * 2048 + 1024), 0, 1, 2, 3, 4, 5, 6, 7); \
        else { _Pragma("unroll") for (int k = 0; k < 2; ++k) dst[m][k] = *(const PG8_LAS bf16x8*)(lds + PG8_SA(b, h) + aoff + m * 2048 + k * 1024); } } } while (0)
#define PG8_LDB(dst, b, h) do { _Pragma("unroll") for (int n = 0; n < 2; ++n) { if constexpr (FP8) dst##8[n] = __builtin_shufflevector(PG8_LD16(PG8_SB(b, h) + boff + n * 2048), PG8_LD16(PG8_SB(b, h) + boff + n * 2048 + 1024), 0, 1, 2, 3, 4, 5, 6, 7); \
        else { _Pragma("unroll") for (int k = 0; k < 2; ++k) dst[n][k] = *(const PG8_LAS bf16x8*)(lds + PG8_SB(b, h) + boff + n * 2048 + k * 1024); } } } while (0)
#define PG8_MMA(ai, bj, At, Bt) do { __builtin_amdgcn_s_setprio(1); _Pragma("unroll") for (int m = 0; m < 4; ++m) _Pragma("unroll") for (int n = 0; n < 2; ++n) { \
        if constexpr (FP8) asm volatile("v_mfma_f32_16x16x128_f8f6f4 %0, %1, %2, %0" : "+v"(acc[ai][bj][m][n]) : "v"(Bt##8[n]), "v"(At##8[m]));   \
        else { _Pragma("unroll") for (int k = 0; k < 2; ++k) acc[ai][bj][m][n] = __builtin_amdgcn_mfma_f32_16x16x32_bf16(Bt[n][k], At[m][k], acc[ai][bj][m][n], 0, 0, 0); } } \
        __builtin_amdgcn_s_setprio(0); } while (0)
#define PG8_WAIT_V(n) asm volatile("s_waitcnt vmcnt(" #n ")" ::: "memory")
#define PG8_WAIT_L(n) asm volatile("s_waitcnt lgkmcnt(" #n ")" ::: "memory")
#define PG8_BAR __builtin_amdgcn_s_barrier()
#define PG8_SCHED __builtin_amdgcn_sched_barrier(0)
    Unit cur, nxt; int ui = 0;
    if (!S.next(0, cur)) return;
    f32x4 acc[2][2][4][2];
#pragma unroll
    for (int a = 0; a < 2; ++a)
#pragma unroll
        for (int b = 0; b < 2; ++b)
#pragma unroll
            for (int m = 0; m < 4; ++m)
#pragma unroll
                for (int n = 0; n < 2; ++n) acc[a][b][m][n] = (f32x4){0.f, 0.f, 0.f, 0.f};
    bf16x8 At[4][2], B0[2][2], B1[2][2]; v8i_t At8[4], B08[2], B18[2];
    const char* cA = GATHER ? (const char*)g.A : (const char*)g.A + (size_t)cur.pm * tstep; const char* cB = (const char*)g.Bt + cur.boff + (size_t)cur.pn * tstep;
    unsigned cv0[2], cv1[2], nv0[2], nv1[2];
#pragma unroll
    for (int i = 0; i < 2; ++i) { if constexpr (GATHER) { cv0[i] = tab[rsl[i]] + cby[i]; cv1[i] = tab[HALF + rsl[i]] + cby[i]; } else { cv0[i] = voffA[i]; cv1[i] = voffA[i]; } nv0[i] = cv0[i]; nv1[i] = cv1[i]; }
    PG8_STAGE(PG8_SB(0, 0), cB, voffB); PG8_STAGE(PG8_SB(0, 1), cB + hstep, voffB); PG8_STAGE(PG8_SA(0, 0), cA, cv0); PG8_STAGE(PG8_SA(0, 1), cA + ahstep, cv1);
    if (wr == 1) PG8_BAR;
    PG8_WAIT_V(2); PG8_BAR;
    PG8_STAGE(PG8_SB(1, 0), cB + kstep, voffB); PG8_STAGE(PG8_SA(1, 0), cA + kstep, cv0); PG8_STAGE(PG8_SB(1, 1), cB + hstep + kstep, voffB);
    PG8_WAIT_V(6); PG8_BAR;
    for (;;) {
        const bool has_next = S.next(ui + 1, nxt);
        const char* nA = has_next ? (GATHER ? (const char*)g.A : (const char*)g.A + (size_t)nxt.pm * tstep) : cA; const char* nB = has_next ? (const char*)g.Bt + nxt.boff + (size_t)nxt.pn * tstep : cB;
        if constexpr (GATHER) {
#pragma unroll
            for (int i = 0; i < 2; ++i) { if (has_next) { nv0[i] = tab[(ui + 1) * BM + rsl[i]] + cby[i]; nv1[i] = tab[(ui + 1) * BM + HALF + rsl[i]] + cby[i]; } else { nv0[i] = cv0[i]; nv1[i] = cv1[i]; } }
        }
        for (int t = 0; t < nt; t += 2) {
            const bool last = (t == nt - 2);
            const char* a1 = cA + (size_t)(t + 1) * kstep;
            const char* a2 = last ? nA : cA + (size_t)(t + 2) * kstep; const char* b2 = last ? nB : cB + (size_t)(t + 2) * kstep;
            const char* a3 = a2 + kstep; const char* b3 = b2 + kstep;
            unsigned s0[2], s1[2];
#pragma unroll
            for (int i = 0; i < 2; ++i) { s0[i] = last ? nv0[i] : cv0[i]; s1[i] = last ? nv1[i] : cv1[i]; }
            PG8_LDB(B0, 0, 0); PG8_LDB(B1, 0, 1); PG8_SCHED; PG8_LDA(At, 0, 0); PG8_STAGE(PG8_SA(1, 1), a1 + ahstep, cv1);
            PG8_WAIT_V(8); PG8_WAIT_L(0); PG8_BAR; PG8_MMA(0, 0, At, B0); PG8_MMA(0, 1, At, B1); PG8_BAR; PG8_SCHED;
            PG8_LDA(At, 0, 1); PG8_STAGE(PG8_SB(0, 0), b2, voffB); PG8_STAGE(PG8_SB(0, 1), b2 + hstep, voffB); PG8_STAGE(PG8_SA(0, 0), a2, s0);
            PG8_WAIT_V(8); PG8_WAIT_L(0); PG8_BAR; PG8_MMA(1, 0, At, B0); PG8_MMA(1, 1, At, B1); PG8_BAR; PG8_SCHED;
            PG8_LDB(B0, 1, 0); PG8_LDB(B1, 1, 1); PG8_SCHED; PG8_LDA(At, 1, 0); PG8_STAGE(PG8_SA(0, 1), a2 + ahstep, s1);
            PG8_WAIT_V(8); PG8_WAIT_L(0); PG8_BAR; PG8_MMA(0, 0, At, B0); PG8_MMA(0, 1, At, B1); PG8_BAR; PG8_SCHED;
            PG8_LDA(At, 1, 1); PG8_STAGE(PG8_SB(1, 0), b3, voffB); PG8_STAGE(PG8_SB(1, 1), b3 + hstep, voffB); PG8_STAGE(PG8_SA(1, 0), a3, s0);
            PG8_WAIT_V(8); PG8_WAIT_L(0); PG8_BAR; PG8_MMA(1, 0, At, B0); PG8_MMA(1, 1, At, B1); PG8_BAR; PG8_SCHED;
        }
        unsigned long long pt0_ = 0; if (prb) pt0_ = __builtin_amdgcn_s_memrealtime();
        if constexpr (FP8) asm volatile("s_nop 15\n\ts_nop 7" ::: "memory");
        if constexpr (ALIGN_EPI) { if (wr == 0) PG8_BAR; }
        E(acc, cur, wr, wc, fr, fq);
        if (prb) { asm volatile("s_waitcnt vmcnt(0)" ::: "memory"); if (threadIdx.x == 0) prb[0] += (unsigned)(__builtin_amdgcn_s_memrealtime() - pt0_); }
        if (!has_next) break;
#pragma unroll
        for (int a = 0; a < 2; ++a)
#pragma unroll
            for (int b = 0; b < 2; ++b)
#pragma unroll
                for (int m = 0; m < 4; ++m)
#pragma unroll
                    for (int n = 0; n < 2; ++n) acc[a][b][m][n] = (f32x4){0.f, 0.f, 0.f, 0.f};
        cur = nxt; cA = nA; cB = nB; ++ui;
#pragma unroll
        for (int i = 0; i < 2; ++i) { cv0[i] = nv0[i]; cv1[i] = nv1[i]; }
        if constexpr (ALIGN_EPI) { if (wr == 1) PG8_BAR; }
    }
    PG8_WAIT_V(0);
    if constexpr (!ALIGN_EPI) { if (wr == 0) PG8_BAR; }
    PG8_BAR;
#undef PG8_SA
#undef PG8_SB
#undef PG8_STAGE
#undef PG8_LDA
#undef PG8_LD16
#undef PG8_LDB
#undef PG8_MMA
#undef PG8_WAIT_V
#undef PG8_WAIT_L
#undef PG8_BAR
#undef PG8_SCHED
}
}
#include <hip/hip_bf16.h>
#include <cmath>
namespace attn_body {
using bf16=__hip_bfloat16;
using bf16x8=__attribute__((ext_vector_type(8)))short;
using s16x4=__attribute__((ext_vector_type(4)))short;
using f32x16=__attribute__((ext_vector_type(16)))float;
using u32x4=__attribute__((ext_vector_type(4)))unsigned;
constexpr int BATCH=4,NHEAD=8,SEQ=8192,D=64,DM=NHEAD*D,ODM=1024;
constexpr int NW=8,QBLK=32,QB=QBLK*NW,KVBLK=64,NQB=SEQ/QB;
constexpr int ATTN_PITCH=DM, ATTN_UNIT_ROWS=QB;
__device__ __forceinline__ int crow(int r,int hi){return (r&3)+8*(r>>2)+4*hi;}
#define SBAR() __builtin_amdgcn_sched_barrier(0)
__device__ __forceinline__ void cmask(f32x16&p0,f32x16&p1,int jb,int qrel,int hi){
  const float NEG=-INFINITY; int kb=64*jb+4*hi;
  #pragma unroll
  for(int r=0;r<16;++r){int kv=kb+(r&3)+8*(r>>2); if(kv>qrel)p0[r]=NEG; if(kv+32>qrel)p1[r]=NEG;}
}

constexpr int NSLOT=3, SLOTB=8192;
constexpr int LDS_K=0, LDS_V=NSLOT*SLOTB, LDS_WS=2*NSLOT*SLOTB, LDS_OST=LDS_WS+NW*64*4, LDS_C2=LDS_OST+NW*4096, LDS_BYTES=LDS_C2+SEQ*4;
constexpr float C2=0.125f*1.4426950408889634f;
__device__ __forceinline__ void glds16(const void*gsrc,unsigned lds_dst){unsigned keep;
  asm volatile("s_mov_b32 %0, m0\n\ts_mov_b32 m0, %2\n\ts_nop 0\n\tglobal_load_lds_dwordx4 %1, off\n\ts_mov_b32 m0, %0":"=&s"(keep):"v"(gsrc),"s"(lds_dst):"memory");}
__device__ __forceinline__ float max3f(float a,float b,float c){float r;asm("v_max3_f32 %0, %1, %2, %3":"=v"(r):"v"(a),"v"(b),"v"(c));return r;}
__device__ __forceinline__ float max2f(float a,float b){float r;asm("v_max_f32_e32 %0, %1, %2":"=v"(r):"v"(a),"v"(b));return r;}
__device__ __forceinline__ float fadd_s(float a,float b){float r;asm("v_add_f32_e32 %0, %1, %2":"=v"(r):"v"(a),"v"(b));return r;}
__device__ __forceinline__ float fsub_s(float a,float b){float r;asm("v_sub_f32_e32 %0, %1, %2":"=v"(r):"v"(a),"v"(b));return r;}
typedef float f32x2_t __attribute__((ext_vector_type(2))); typedef float f32x4_t __attribute__((ext_vector_type(4))); typedef __bf16 bf16x2_t __attribute__((ext_vector_type(2)));
__device__ __forceinline__ unsigned cvtpk_s(float lo,float hi){f32x2_t v={lo,hi};bf16x2_t b=__builtin_convertvector(v,bf16x2_t);return __builtin_bit_cast(unsigned,b);}
#define WAIT_BAR(N) asm volatile("s_waitcnt vmcnt(" #N ") lgkmcnt(0)\n\ts_barrier":::"memory")

__device__ __forceinline__ void qkt(f32x16&p0,f32x16&p1,const char*Kslot,const bf16x8*qr,const f32x16&cin0,const f32x16&cin1,int r32,int hi){
  const char*kb=Kslot+hi*1024+r32*16;
  #pragma unroll
  for(int d0=0;d0<4;++d0){
    const bf16x8 b0=*reinterpret_cast<const bf16x8*>(kb+d0*2048);
    const bf16x8 b1=*reinterpret_cast<const bf16x8*>(kb+d0*2048+512);
    if(d0==0){p0=__builtin_amdgcn_mfma_f32_32x32x16_bf16(b0,qr[0],cin0,0,0,0);p1=__builtin_amdgcn_mfma_f32_32x32x16_bf16(b1,qr[0],cin1,0,0,0);}
    else{p0=__builtin_amdgcn_mfma_f32_32x32x16_bf16(b0,qr[d0],p0,0,0,0);p1=__builtin_amdgcn_mfma_f32_32x32x16_bf16(b1,qr[d0],p1,0,0,0);}}
}
typedef __attribute__((address_space(3))) const char* lds_cptr;
typedef short v4i16_t __attribute__((ext_vector_type(4)));
__device__ __forceinline__ void kload8(bf16x8*kf,lds_cptr kp){
  kf[0]=*(const __attribute__((address_space(3))) bf16x8*)(kp);      kf[1]=*(const __attribute__((address_space(3))) bf16x8*)(kp+512);
  kf[2]=*(const __attribute__((address_space(3))) bf16x8*)(kp+2048); kf[3]=*(const __attribute__((address_space(3))) bf16x8*)(kp+2560);
  kf[4]=*(const __attribute__((address_space(3))) bf16x8*)(kp+4096); kf[5]=*(const __attribute__((address_space(3))) bf16x8*)(kp+4608);
  kf[6]=*(const __attribute__((address_space(3))) bf16x8*)(kp+6144); kf[7]=*(const __attribute__((address_space(3))) bf16x8*)(kp+6656);
}
__device__ __forceinline__ void kload2(bf16x8*kf,lds_cptr kp,int j){ kf[2*j]=*(const __attribute__((address_space(3))) bf16x8*)(kp+j*2048); kf[2*j+1]=*(const __attribute__((address_space(3))) bf16x8*)(kp+j*2048+512); }
__device__ __forceinline__ s16x4 vtr(lds_cptr p){ return __builtin_bit_cast(s16x4,__builtin_amdgcn_ds_read_tr16_b64_v4i16((__attribute__((address_space(3))) v4i16_t*)p)); }
__device__ __forceinline__ float rowmax(const f32x16&p0,const f32x16&p1){
  float a=max3f(p0[0],p0[1],p1[0]),b=max3f(p0[2],p0[3],p1[1]);a=max3f(a,p1[2],p1[3]);
  #pragma unroll
  for(int r=4;r<16;r+=4){a=max3f(a,p0[r],p0[r+1]);b=max3f(b,p0[r+2],p0[r+3]);a=max3f(a,p1[r],p1[r+1]);b=max3f(b,p1[r+2],p1[r+3]);}
  const float m=max2f(a,b);
  auto rr=__builtin_amdgcn_permlane32_swap(__float_as_uint(m),__float_as_uint(m),false,false);
  return max2f(__uint_as_float(rr[0]),__uint_as_float(rr[1]));
}
__device__ __forceinline__ void pv(f32x16*o,int vb,bf16x8 pa0,bf16x8 pa1,bf16x8 pa2,bf16x8 pa3){
  #pragma unroll
  for(int d0=0;d0<2;++d0){s16x4 lo[4],hi[4];
    #pragma unroll
    for(int ks=0;ks<4;++ks){
      asm volatile("ds_read_b64_tr_b16 %0,%1 offset:%c2":"=&v"(lo[ks]):"v"(vb),"i"(d0*4096+ks*1024):"memory");
      asm volatile("ds_read_b64_tr_b16 %0,%1 offset:%c2":"=&v"(hi[ks]):"v"(vb),"i"(d0*4096+ks*1024+512):"memory");}
    asm volatile("s_waitcnt lgkmcnt(0)":::"memory");SBAR();
    #define PK(k) (bf16x8){lo[k][0],lo[k][1],lo[k][2],lo[k][3],hi[k][0],hi[k][1],hi[k][2],hi[k][3]}
    o[d0]=__builtin_amdgcn_mfma_f32_32x32x16_bf16(pa0,PK(0),o[d0],0,0,0);
    o[d0]=__builtin_amdgcn_mfma_f32_32x32x16_bf16(pa1,PK(1),o[d0],0,0,0);
    o[d0]=__builtin_amdgcn_mfma_f32_32x32x16_bf16(pa2,PK(2),o[d0],0,0,0);
    o[d0]=__builtin_amdgcn_mfma_f32_32x32x16_bf16(pa3,PK(3),o[d0],0,0,0);
    #undef PK
  }
}

#ifndef ATTN_STORE16
#define ATTN_STORE16(p,v) (*(u32x4*)(p)=(v))
#endif
template<int THRL> __device__ __forceinline__ void attn_unit(int b,int h,int qb,const bf16*Q,const bf16*__restrict__ K,const bf16*__restrict__ V,bf16*O,char*shm,float qkb2){
  const int tid=threadIdx.x,lane=tid&63,r32=lane&31,hi=lane>>5; const int wid=__builtin_amdgcn_readfirstlane(tid>>6);
  const long rowbase=(long)b*SEQ; const int q0=qb*QB;
  const bf16*Qw=Q+(rowbase+q0+wid*QBLK)*DM+h*D;
  const bf16*Kh=K+rowbase*DM+h*D,*Vh=V+rowbase*DM+h*D;
  const unsigned lds0=(unsigned)(uintptr_t)shm; const lds_cptr shm3=(lds_cptr)shm;
  float*wsf=(float*)(shm+LDS_WS)+wid*64;
  const bf16*ksrc=Kh+(long)lane*DM+wid*8;
  const bf16*vsrc=Vh+(long)(16*(wid&3)+(lane>>2))*DM+(wid>>2)*32+(lane&3)*8;
  const unsigned kdst=lds0+LDS_K+wid*1024, vdst=lds0+LDS_V+wid*1024;
  #define DMA_K(t,slot) glds16(ksrc+(long)(t)*KVBLK*DM,(unsigned)__builtin_amdgcn_readfirstlane(kdst+(slot)))
  #define DMA_V(t,slot) glds16(vsrc+(long)(t)*KVBLK*DM,(unsigned)__builtin_amdgcn_readfirstlane(vdst+(slot)))
  const int vb0=(int)(lds0+LDS_V)+((lane>>4)&1)*32+(lane&3)*8+(4*hi+((lane&15)>>2))*64;
  const char*Kbase=shm+LDS_K; bf16x8 kf[8];
  const lds_cptr kp0=shm3+LDS_K+hi*1024+r32*16; const lds_cptr vp0=shm3+LDS_V+((lane>>4)&1)*32+(lane&3)*8+(4*hi+((lane&15)>>2))*64;
  const int NT=(q0+QB)/KVBLK;
  int j0=0;
  { const __attribute__((address_space(3))) float* c2f=(const __attribute__((address_space(3))) float*)((lds_cptr)shm+LDS_C2); const float cq=c2f[q0]+qkb2+40.0f;
    int lo_=0,hi_=(NT-4)>>1;
    while(lo_<hi_){ const int mid=(lo_+hi_+1)>>1; if(cq-c2f[128*mid-1]<0.f)lo_=mid; else hi_=mid-1; }
    j0=__builtin_amdgcn_readfirstlane(2*lo_); }
  DMA_K(j0,0);DMA_V(j0,0);DMA_K(j0+1,SLOTB);
  bf16x8 qr[4];
  #pragma unroll
  for(int d0=0;d0<4;++d0)qr[d0]=*reinterpret_cast<const bf16x8*>(&Qw[(long)r32*DM+d0*16+hi*8]);
  float l_reg=0.f;f32x16 o[2];o[0]=f32x16{};o[1]=f32x16{};
  typedef __attribute__((address_space(3))) const f32x4_t* lds_f4ptr; const lds_f4ptr c2p=(lds_f4ptr)(shm3+LDS_C2)+hi;
  float ctm=((const __attribute__((address_space(3))) float*)(shm3+LDS_C2))[q0+wid*QBLK+r32];
  f32x16 cin0,cin1;
  #define CIN(t) do{ const lds_f4ptr cq_=c2p+16*(t); const f32x4_t a0_=cq_[0],a1_=cq_[2],a2_=cq_[4],a3_=cq_[6],b0_=cq_[8],b1_=cq_[10],b2_=cq_[12],b3_=cq_[14]; \
    _Pragma("unroll") for(int j_=0;j_<4;++j_){ cin0[j_]=ctm-a0_[j_];cin0[4+j_]=ctm-a1_[j_];cin0[8+j_]=ctm-a2_[j_];cin0[12+j_]=ctm-a3_[j_]; cin1[j_]=ctm-b0_[j_];cin1[4+j_]=ctm-b1_[j_];cin1[8+j_]=ctm-b2_[j_];cin1[12+j_]=ctm-b3_[j_]; } }while(0)
  const int qrel=wid*QBLK+r32;
  #define CMASK(P0,P1,t) do{int jb_=(t)-(NT-4); if(jb_>=0)cmask(P0,P1,jb_,qrel,hi);}while(0)
  bool resc=false;
  #define START(P0,P1) do{ const float rm=rowmax(P0,P1); resc=false; \
    if(__any(rm>(float)THRL)){ const float dl=__builtin_fmaxf(rm,0.f); ctm-=dl; \
      _Pragma("unroll") for(int r=0;r<16;++r){P0[r]-=dl;P1[r]-=dl;} } \
    _Pragma("unroll") for(int r=0;r<16;++r)P0[r]=__builtin_amdgcn_exp2f(P0[r]); }while(0)
  #define RESC() do{ if(resc){ asm volatile("s_waitcnt lgkmcnt(0)":::"memory"); \
      _Pragma("unroll") for(int d_=0;d_<2;++d_) _Pragma("unroll") for(int r=0;r<16;++r)o[d_][r]*=wsf[crow(r,hi)]; } }while(0)
  f32x16 pA0,pA1,pB0,pB1;
  int sl_prev=0,sl_cur=0,sl_next=SLOTB;
  #define ROT() do{sl_prev=sl_cur;sl_cur=sl_next;sl_next=(sl_next==(NSLOT-1)*SLOTB)?0:sl_next+SLOTB;}while(0)
  DMA_K(j0+2,2*SLOTB);
  WAIT_BAR(3);
  CIN(j0); qkt(pA0,pA1,Kbase,qr,cin0,cin1,r32,hi);asm volatile("s_nop 15\n\ts_nop 7":"+v"(pA0),"+v"(pA1));CMASK(pA0,pA1,j0);
  START(pA0,pA1);
  _Pragma("unroll") for(int r=0;r<16;++r)pA1[r]=__builtin_amdgcn_exp2f(pA1[r]);
  WAIT_BAR(0);
  DMA_K(j0+3,0);DMA_V(j0+1,SLOTB);
  ROT();
  kload8(kf,kp0+sl_cur);
  WAIT_BAR(2);
  s16x4 vlo[8],vhi[8]; u32x4 pw0,pw1,pw2,pw3;
  #define PKW(P,B) cvtpk_s(P[B],P[B+1])
  #define PAF(k) __builtin_bit_cast(bf16x8,pw##k)
  #define VFR(i) (bf16x8){vlo[i][0],vlo[i][1],vlo[i][2],vlo[i][3],vhi[i][0],vhi[i][1],vhi[i][2],vhi[i][3]}
  #define PIN(x) asm volatile("":"+v"(x))
  #define MX3(a,b,c) __builtin_fmaxf(__builtin_fmaxf((a),(b)),(c))
  #define GAPA(MF,A0,A1,A2,A3,W0,W1,PW) do{ MF; sacc+=A0; sacc+=A1; sacc+=A2; sacc+=A3; PIN(sacc); W0; W1; PIN(PW); SBAR(); }while(0)
  #define EX(v) __builtin_amdgcn_exp2f(v)
  #define GAPB(MF,X,B) do{ MF; X[B]=EX(X[B]); X[B+1]=EX(X[B+1]); X[B+2]=EX(X[B+2]); X[B+3]=EX(X[B+3]); PIN(X); SBAR(); }while(0)
  #define VRD(i) do{ vlo[i]=vtr(vp_+(((i)>>2)*4096+((i)&3)*1024)); vhi[i]=vtr(vp_+(((i)>>2)*4096+((i)&3)*1024+512)); }while(0)
  #define KRD(G,j) do{ if(G){ kload2(kf,kp0+sl_next,j); SBAR(); } }while(0)
  #define STEP(C0,C1,P0,P1,t,GK,GV,GL) do{ SBAR(); CIN(t); SBAR(); \
    const lds_cptr vp_=vp0+sl_prev; \
    VRD(0); SBAR(); float sacc=(P0[0]+P0[1]); \
    GAPA(C0=__builtin_amdgcn_mfma_f32_32x32x16_bf16(kf[0],qr[0],cin0,0,0,0), P0[2],P0[3],P0[4],P0[5],     pw0[0]=PKW(P0,0), pw0[1]=PKW(P0,2), pw0); \
    VRD(4); SBAR(); GAPA(C1=__builtin_amdgcn_mfma_f32_32x32x16_bf16(kf[1],qr[0],cin1,0,0,0), P0[6],P0[7],P0[8],P0[9],     pw0[2]=PKW(P0,4), pw0[3]=PKW(P0,6), pw0); \
    VRD(1); SBAR(); GAPA(C0=__builtin_amdgcn_mfma_f32_32x32x16_bf16(kf[2],qr[1],C0,0,0,0),   P0[10],P0[11],P0[12],P0[13], pw1[0]=PKW(P0,8), pw1[1]=PKW(P0,10), pw1); \
    VRD(5); SBAR(); GAPA(C1=__builtin_amdgcn_mfma_f32_32x32x16_bf16(kf[3],qr[1],C1,0,0,0),   P0[14],P0[15],P1[0],P1[1],   pw1[2]=PKW(P0,12),pw1[3]=PKW(P0,14), pw1); \
    VRD(2); SBAR(); GAPA(C0=__builtin_amdgcn_mfma_f32_32x32x16_bf16(kf[4],qr[2],C0,0,0,0),   P1[2],P1[3],P1[4],P1[5],     pw2[0]=PKW(P1,0), pw2[1]=PKW(P1,2), pw2); \
    VRD(6); SBAR(); GAPA(C1=__builtin_amdgcn_mfma_f32_32x32x16_bf16(kf[5],qr[2],C1,0,0,0),   P1[6],P1[7],P1[8],P1[9],     pw2[2]=PKW(P1,4), pw2[3]=PKW(P1,6), pw2); \
    VRD(3); SBAR(); GAPA(C0=__builtin_amdgcn_mfma_f32_32x32x16_bf16(kf[6],qr[3],C0,0,0,0),   P1[10],P1[11],P1[12],P1[13], pw3[0]=PKW(P1,8), pw3[1]=PKW(P1,10), pw3); \
    VRD(7); SBAR(); GAPA(C1=__builtin_amdgcn_mfma_f32_32x32x16_bf16(kf[7],qr[3],C1,0,0,0),   P1[14],P1[15],0.f,0.f,       pw3[2]=PKW(P1,12),pw3[3]=PKW(P1,14), pw3); \
    l_reg+=sacc; \
    if(GK){DMA_K((t)+3,sl_cur);} if(GV){DMA_V((t)+1,sl_next);} \
    CMASK(C0,C1,t); \
    { float a=MX3(C0[0],C0[1],C1[0]),b=MX3(C0[2],C0[3],C1[1]); a=MX3(a,C1[2],C1[3]); \
      _Pragma("unroll") for(int r=4;r<16;r+=4){a=MX3(a,C0[r],C0[r+1]);b=MX3(b,C0[r+2],C0[r+3]);a=MX3(a,C1[r],C1[r+1]);b=MX3(b,C1[r+2],C1[r+3]);} \
      float rm=__builtin_fmaxf(a,b); { auto rr=__builtin_amdgcn_permlane32_swap(__float_as_uint(rm),__float_as_uint(rm),false,false); rm=__builtin_fmaxf(__uint_as_float(rr[0]),__uint_as_float(rr[1])); } \
      resc=false; \
      if(__builtin_expect(__any(rm>(float)THRL),0)){ const float dl=__builtin_fmaxf(rm,0.f); ctm-=dl; \
        _Pragma("unroll") for(int r=0;r<16;++r){C0[r]-=dl;C1[r]-=dl;} \
        const float f=__builtin_amdgcn_exp2f(-dl); l_reg*=f; if(hi==0)wsf[r32]=f; resc=true; } } \
    SBAR(); \
    GAPB(o[0]=__builtin_amdgcn_mfma_f32_32x32x16_bf16(PAF(0),VFR(0),o[0],0,0,0), C0,0); \
    GAPB(o[1]=__builtin_amdgcn_mfma_f32_32x32x16_bf16(PAF(0),VFR(4),o[1],0,0,0), C0,4); \
    KRD(GL,0); GAPB(o[0]=__builtin_amdgcn_mfma_f32_32x32x16_bf16(PAF(1),VFR(1),o[0],0,0,0), C0,8); \
    KRD(GL,1); GAPB(o[1]=__builtin_amdgcn_mfma_f32_32x32x16_bf16(PAF(1),VFR(5),o[1],0,0,0), C0,12); \
    KRD(GL,2); GAPB(o[0]=__builtin_amdgcn_mfma_f32_32x32x16_bf16(PAF(2),VFR(2),o[0],0,0,0), C1,0); \
    KRD(GL,3); GAPB(o[1]=__builtin_amdgcn_mfma_f32_32x32x16_bf16(PAF(2),VFR(6),o[1],0,0,0), C1,4); \
    GAPB(o[0]=__builtin_amdgcn_mfma_f32_32x32x16_bf16(PAF(3),VFR(3),o[0],0,0,0), C1,8); \
    GAPB(o[1]=__builtin_amdgcn_mfma_f32_32x32x16_bf16(PAF(3),VFR(7),o[1],0,0,0), C1,12); \
    }while(0)
  int t=j0+1;
  #undef CMASK
  #define CMASK(P0,P1,t) do{}while(0)
  for(;t+5<NT;t+=2){
    STEP(pB0,pB1,pA0,pA1,t,true,true,true);     WAIT_BAR(2); RESC(); ROT();
    STEP(pA0,pA1,pB0,pB1,t+1,true,true,true);   WAIT_BAR(2); RESC(); ROT();
  }
  #undef CMASK
  #define CMASK(P0,P1,t) do{int jb_=(t)-(NT-4); if(jb_>=0)cmask(P0,P1,jb_,qrel,hi);}while(0)
  #define ENDW(tt) do{ if((tt)+3<NT){WAIT_BAR(2);} else if((tt)+2<NT){WAIT_BAR(1);} else {WAIT_BAR(0);} }while(0)
  for(;t+1<NT;t+=2){
    STEP(pB0,pB1,pA0,pA1,t,(t+3<NT),(t+1<NT),(t+1<NT));       ENDW(t);   RESC(); ROT();
    STEP(pA0,pA1,pB0,pB1,t+1,(t+4<NT),(t+2<NT),(t+2<NT));     ENDW(t+1); RESC(); ROT();
  }
  STEP(pB0,pB1,pA0,pA1,NT-1,false,false,false); RESC();
  { float sacc=pB0[0]+pB0[1]; _Pragma("unroll") for(int r=2;r<16;++r)sacc+=pB0[r]; _Pragma("unroll") for(int r=0;r<16;++r)sacc+=pB1[r]; l_reg+=sacc;
    pw0=(u32x4){PKW(pB0,0),PKW(pB0,2),PKW(pB0,4),PKW(pB0,6)};pw1=(u32x4){PKW(pB0,8),PKW(pB0,10),PKW(pB0,12),PKW(pB0,14)};pw2=(u32x4){PKW(pB1,0),PKW(pB1,2),PKW(pB1,4),PKW(pB1,6)};pw3=(u32x4){PKW(pB1,8),PKW(pB1,10),PKW(pB1,12),PKW(pB1,14)};
    SBAR(); pv(o,vb0+sl_cur,PAF(0),PAF(1),PAF(2),PAF(3)); }
  #undef PKW
  #undef PAF
  #undef VFR
  #undef PIN
  #undef MX3
  #undef GAPA
  #undef GAPB
  #undef EX
  #undef VRD
  #undef KRD
  #undef STEP
  #undef ENDW
  {auto rr=__builtin_amdgcn_permlane32_swap(__float_as_uint(l_reg),__float_as_uint(l_reg),false,false);l_reg=__uint_as_float(rr[0])+__uint_as_float(rr[1]);}
  if(hi==0)wsf[32+r32]=l_reg;asm volatile("s_waitcnt lgkmcnt(0)":::"memory");
  float rli[16];
  #pragma unroll
  for(int r=0;r<16;++r)rli[r]=__builtin_amdgcn_rcpf(wsf[32+crow(r,hi)]);
  bf16*Ow=O+(rowbase+q0+wid*QBLK)*ODM+h*D;
  { bf16*stg=(bf16*)(shm+LDS_OST)+wid*2048;
    #pragma unroll
    for(int r=0;r<16;++r){const int orow=crow(r,hi);
      #pragma unroll
      for(int d0=0;d0<2;++d0)stg[orow*64+d0*32+r32]=__float2bfloat16(o[d0][r]*rli[r]);}
    asm volatile("s_waitcnt lgkmcnt(0)":::"memory");
    #pragma unroll
    for(int i=0;i<4;++i){const int row=i*8+(lane>>3),ch=lane&7; const u32x4 v=*(const u32x4*)(stg+row*64+ch*8); ATTN_STORE16(Ow+(long)row*ODM+ch*8,v);} }
  asm volatile("s_waitcnt lgkmcnt(0)\n\ts_barrier":::"memory");
  #undef CIN
  #undef DMA_K
  #undef DMA_V
  #undef CMASK
  #undef START
  #undef RESC
  #undef ROT
}
constexpr int ATTN_LDS_BYTES=LDS_BYTES;
struct AttnTensors { const bf16* Q; const bf16* K; const bf16* V; bf16* O; };
struct AttnUnit { int bh; int qb; };
struct StaticOrder {
  int vcu;
  __device__ __forceinline__ explicit StaticOrder(int grid,int block):vcu((block%8)*(grid/8)+block/8){}
  __device__ __forceinline__ bool next(int i,AttnUnit&u)const{ if(i>=4)return false; const int s=vcu&7; u.bh=vcu>>3; u.qb=(i==0)?s:(i==1)?15-s:(i==2)?16+s:31-s; return true; }
  __device__ __forceinline__ void a_ready(const AttnUnit&)const{}
  __device__ __forceinline__ void done(const AttnUnit&)const{}
};
template<class Sched,int THRL=8> __device__ __forceinline__ void attn_phase(char*lds,const AttnTensors&T,const Sched&S,float qkb2){
  AttnUnit u;
  for(int i=0;S.next(i,u);++i){ S.a_ready(u); attn_unit<THRL>(u.bh/NHEAD,u.bh%NHEAD,u.qb,T.Q,T.K,T.V,T.O,lds,qkb2); S.done(u); }
}
#undef SBAR
#undef WAIT_BAR
}
#define GAS __attribute__((address_space(1)))
#define LAS __attribute__((address_space(3)))
typedef GAS unsigned gu32;
#define RLX_AGENT __ATOMIC_RELAXED, __HIP_MEMORY_SCOPE_AGENT
#define LDS_WAIT() asm volatile("s_waitcnt lgkmcnt(0)" ::: "memory")
#define VM_WAIT() asm volatile("s_waitcnt vmcnt(0)" ::: "memory")

constexpr int NWAVES = 8;
constexpr int N_PHASES = 8;
constexpr int RING_OFF = 0, RING_BYTES = 131072;
constexpr int TAB_OFF = 131072, TAB_UNITS = 17;
constexpr int LDS_TOTAL = 155648;
constexpr int LDSCTL_OFF = LDS_TOTAL - 1024;
static_assert(TAB_OFF + TAB_UNITS * 256 * 4 <= LDSCTL_OFF, "LDS map");
constexpr int CW_Q = 128, CW_NRM = 256;
constexpr size_t WS_X1B = WS_P;
constexpr size_t WS_TOT = WS_SEL + 768 * 1024;
constexpr int CW_BAR = 4096;

#define XB_TMO      128
#define XB_XCNT(j)  (256  + 64 * (j))
#define XB_XSUB(j)  (1280 + 64 * (j))
#define XB_XGEN(j)  (2304 + 64 * (j))
#define XB_TOP      3328
#define XB_TOPGEN   3392
#define XCD_BAR_WORDS 3456
#define XB_SPIN_CAP (1u << 18)

__device__ __forceinline__ unsigned xb_ld(unsigned* p)              { return __hip_atomic_load(p, __ATOMIC_RELAXED, __HIP_MEMORY_SCOPE_AGENT); }
__device__ __forceinline__ unsigned xb_add(unsigned* p, unsigned v) { return __hip_atomic_fetch_add(p, v, __ATOMIC_RELAXED, __HIP_MEMORY_SCOPE_AGENT); }
__device__ __forceinline__ unsigned xb_xcc_id() { return (unsigned)__builtin_amdgcn_s_getreg((3 << 11) | 20) & 0xFu; }
#define XB_SPIN(cond, bar) do { unsigned _sp = 0; while (cond) { __builtin_amdgcn_s_sleep(1); \
    if ((++_sp & 255u) == 0u) { if (xb_ld(&(bar)[XB_TMO])) break; if (_sp > XB_SPIN_CAP) { atomicAdd(&(bar)[XB_TMO], 1u); break; } } } } while (0)

struct XcdBarrier {
    unsigned* bar; unsigned x;
    volatile LAS unsigned* st;
};

__device__ __forceinline__ XcdBarrier xcd_barrier_post(unsigned* bar, volatile LAS unsigned* st) {
    XcdBarrier b; b.bar = bar; b.x = xb_xcc_id(); b.st = st;
    if (threadIdx.x == 0) (void)xb_add(&bar[XB_XCNT(b.x)], 1u);
    return b;
}
__device__ __forceinline__ void xcd_barrier_complete(unsigned* bar, unsigned x, unsigned& nloc, unsigned& nx) {
    const unsigned G = gridDim.x * gridDim.y * gridDim.z;
    unsigned sum, cnt, mine, sp = 0u;
    for (;;) {
        sum = 0u; cnt = 0u; mine = 0u;
#pragma unroll
        for (unsigned j = 0; j < 16; ++j) { const unsigned c = xb_ld(&bar[XB_XCNT(j)]); sum += c; cnt += (c > 0u) ? 1u : 0u; mine = (j == x) ? c : mine; }
        if (sum == G) break;
        __builtin_amdgcn_s_sleep(1);
        if ((++sp & 255u) == 0u) { if (xb_ld(&bar[XB_TMO])) break; if (sp > XB_SPIN_CAP) { atomicAdd(&bar[XB_TMO], 1u); break; } }
    }
    nloc = mine > 0u ? mine : 1u; nx = cnt > 0u ? cnt : 1u;
}

__device__ __forceinline__ void xcd_barrier(const XcdBarrier& b) {
    asm volatile("s_waitcnt vmcnt(0)" ::: "memory");
    __syncthreads();
    if (threadIdx.x == 0) {
        unsigned* bar = b.bar;
        __builtin_amdgcn_s_waitcnt(0);
        unsigned nloc = b.st[0], nx = b.st[1];
        if (nloc == 0u) { xcd_barrier_complete(bar, b.x, nloc, nx); b.st[0] = nloc; b.st[1] = nx; }
        const unsigned old = xb_add(&bar[XB_XSUB(b.x)], 1u);
        const unsigned gen = old / nloc;
        if (old + 1u == (gen + 1u) * nloc) {
            __builtin_amdgcn_fence(__ATOMIC_RELEASE, "agent");
            asm volatile("s_waitcnt vmcnt(0)" ::: "memory");
            const unsigned og = xb_add(&bar[XB_TOP], 1u);
            const unsigned tg = og / nx;
            if (og + 1u == (tg + 1u) * nx) xb_add(&bar[XB_TOPGEN], 1u);
            else XB_SPIN(xb_ld(&bar[XB_TOPGEN]) == tg, bar);
            __builtin_amdgcn_fence(__ATOMIC_ACQUIRE, "agent");
            xb_add(&bar[XB_XGEN(b.x)], 1u);
            asm volatile("s_waitcnt vmcnt(0)" ::: "memory");
        } else {
            XB_SPIN(xb_ld(&bar[XB_XGEN(b.x)]) == gen, bar);
            __builtin_amdgcn_fence(__ATOMIC_ACQUIRE, "agent");
            asm volatile("s_waitcnt vmcnt(0)" ::: "memory");
        }
    }
    __syncthreads();
}


struct Args { const float* in[15]; float* out; unsigned char* ws; int ph_lo, ph_hi, use_bar, pad; };

__device__ __forceinline__ void p0_transpose_item(const float* W, int ldw, bf16* WT, int ldt, LAS float* scr, int lane) {
    float tv[32];
    const float* wp_ = W + (size_t)(lane >> 5) * ldw + (lane & 31);
#pragma unroll
    for (int i = 0; i < 32; ++i) tv[i] = wp_[(size_t)(2 * i) * ldw];
#pragma unroll
    for (int i = 0; i < 32; ++i) scr[(2 * i + (lane >> 5)) * 33 + (lane & 31)] = tv[i];
    LDS_WAIT(); asm volatile("" ::: "memory");
    const int c = lane & 7;
#pragma unroll
    for (int j = 0; j < 4; ++j) { const int n = (lane >> 3) + 8 * j; const LAS float* s = scr + (8 * c) * 33 + n;
        u32x4 o; o.x = pg8::cvt_pk_bf16(s[0 * 33], s[1 * 33]); o.y = pg8::cvt_pk_bf16(s[2 * 33], s[3 * 33]); o.z = pg8::cvt_pk_bf16(s[4 * 33], s[5 * 33]); o.w = pg8::cvt_pk_bf16(s[6 * 33], s[7 * 33]);
        *(GAS u32x4*)(WT + (size_t)n * ldt + 8 * c) = o; }
    LDS_WAIT(); asm volatile("" ::: "memory");
}
__device__ __forceinline__ void p0_transpose_item_fp8(const float* W, int ldw, unsigned char* WT, int ldt, LAS float* scr, int lane) {
    float tv[32];
    const float* wp_ = W + (size_t)(lane >> 5) * ldw + (lane & 31);
#pragma unroll
    for (int i = 0; i < 32; ++i) tv[i] = wp_[(size_t)(2 * i) * ldw];
#pragma unroll
    for (int i = 0; i < 32; ++i) scr[(2 * i + (lane >> 5)) * 33 + (lane & 31)] = tv[i];
    LDS_WAIT(); asm volatile("" ::: "memory");
    const int c = lane & 7;
#pragma unroll
    for (int j = 0; j < 4; ++j) { const int n = (lane >> 3) + 8 * j; const LAS float* s = scr + (8 * c) * 33 + n; const float k_ = pg8::FP8_SW;
        u32x2 o; o.x = pg8::pack4_fp8(s[0 * 33] * k_, s[1 * 33] * k_, s[2 * 33] * k_, s[3 * 33] * k_); o.y = pg8::pack4_fp8(s[4 * 33] * k_, s[5 * 33] * k_, s[6 * 33] * k_, s[7 * 33] * k_);
        *(GAS u32x2*)(WT + (size_t)n * ldt + 8 * c) = o; }
    LDS_WAIT(); asm volatile("" ::: "memory");
}
constexpr int I_WIN = 16 * 64, I_WO = 8 * 32, I_WEFF = 4 * 16 * 16, I_WU = 32 * 16 * 64, I_WD = 32 * 16 * 32;
constexpr int P0_ITEMS = I_WIN + I_WO + I_WEFF;

__device__ __forceinline__ void phase0(const Args& a, LAS unsigned char* L, int vcu, int G, int tid, int lane, int wave) {
    const float* w_in = a.in[2]; const float* w_pool = a.in[4]; const float* pscale = a.in[5]; const float* w_out = a.in[6];
    bf16* Win_t = (bf16*)(a.ws + WS_WIN); bf16* Wo_t = (bf16*)(a.ws + WS_WO);
    LAS float* scr = (LAS float*)(L + wave * 8448);
    LAS float* wf = (LAS float*)(L + 69632);
    for (int i = tid; i < 1024 * 8; i += 512) { const int d = i >> 3, p_ = ((d & 255) >> 2) + 64 * (4 * (d >> 8) + (d & 3)); wf[p_ * 12 + (i & 7)] = w_in[(size_t)d * INW + 2048 + (i & 7)]; }
    __syncthreads();
    const int gw = vcu * NWAVES + wave, NGW = G * NWAVES;
    {
        const float* x = a.in[0]; const float* g_mix = a.in[1]; const float* b_forget = a.in[3];
        bf16* XN = (bf16*)(a.ws + WS_XN); float* LOGF = (float*)(a.ws + WS_LOGF);
        f32x4 g[4];
#pragma unroll
        for (int j = 0; j < 4; ++j) g[j] = *(const f32x4*)(g_mix + 4 * lane + 256 * j);
        f32x4 vn[4];
#pragma unroll
        for (int j = 0; j < 4; ++j) vn[j] = *(const f32x4*)(x + (size_t)gw * DM + 4 * lane + 256 * j);
        for (int m = gw; m < T; m += NGW) {
            f32x4 v[4]; float ss = 0.f;
#pragma unroll
            for (int j = 0; j < 4; ++j) { v[j] = vn[j]; ss += v[j].x * v[j].x + v[j].y * v[j].y + v[j].z * v[j].z + v[j].w * v[j].w; }
            { const int mn = (m + NGW < T) ? m + NGW : m;
#pragma unroll
              for (int j = 0; j < 4; ++j) vn[j] = *(const f32x4*)(x + (size_t)mn * DM + 4 * lane + 256 * j); }
            const float rstd = rsqrtf(wave_sum(ss) * (1.f / DM) + RMS_EPS);
            float fl[8];
#pragma unroll
            for (int e = 0; e < 8; ++e) fl[e] = 0.f;
#pragma unroll
            for (int j = 0; j < 4; ++j) {
                v[j] = v[j] * rstd * g[j];
#pragma unroll
                for (int i = 0; i < 4; ++i) {
                    const int prow = lane + 64 * (4 * j + i); const float hv = v[j][i];
                    const f32x4 w0 = *(const LAS f32x4*)(wf + prow * 12), w1 = *(const LAS f32x4*)(wf + prow * 12 + 4);
                    fl[0] += hv * w0.x; fl[1] += hv * w0.y; fl[2] += hv * w0.z; fl[3] += hv * w0.w;
                    fl[4] += hv * w1.x; fl[5] += hv * w1.y; fl[6] += hv * w1.z; fl[7] += hv * w1.w;
                }
                u32x2 o; o.x = pk2(v[j].x, v[j].y); o.y = pk2(v[j].z, v[j].w);
                *(u32x2*)(XN + (size_t)m * DM + 4 * lane + 256 * j) = o;
            }
            float z;
            { const bool u5 = lane >= 32; float a4[4];
#pragma unroll
              for (int e = 0; e < 4; ++e) { const float keep = u5 ? fl[4 + e] : fl[e], give = u5 ? fl[e] : fl[4 + e]; a4[e] = keep + __shfl_xor(give, 32); }
              const bool u4 = (lane & 16) != 0; float a2[2];
#pragma unroll
              for (int e = 0; e < 2; ++e) { const float keep = u4 ? a4[2 + e] : a4[e], give = u4 ? a4[e] : a4[2 + e]; a2[e] = keep + __shfl_xor(give, 16); }
              const bool u3 = (lane & 8) != 0;
              z = (u3 ? a2[1] : a2[0]) + __shfl_xor(u3 ? a2[0] : a2[1], 8);
              z += __shfl_xor(z, 4); z += __shfl_xor(z, 2); z += __shfl_xor(z, 1); }
            if ((lane & 7) == 0) {
                const int hd = lane >> 3; z += b_forget[hd];
                const float ls = fminf(z, 0.f) - log1pf(expf(-fabsf(z)));
                LOGF[((size_t)(m / SEQ) * NH + hd) * SEQ + (m % SEQ)] = ls;
            }
        }
    }
    for (int it = gw; it < P0_ITEMS; it += NGW) {
        int r = it;
        if (r < I_WIN) { const int kb = r >> 6, nb = r & 63; p0_transpose_item(w_in + (size_t)(64 * kb) * INW + 32 * nb, INW, Win_t + (size_t)(32 * nb) * DM + 64 * kb, DM, scr, lane); continue; } r -= I_WIN;
        if (r < I_WO) { const int kb = r >> 5, nb = r & 31; p0_transpose_item(w_out + (size_t)(512 + 64 * kb) * DM + 32 * nb, DM, Wo_t + (size_t)(32 * nb) * DM + 512 + 64 * kb, DM, scr, lane); continue; } r -= I_WO;
        if (r < I_WEFF) {
            const int g = r >> 8, nb = (r >> 4) & 15, kb = r & 15, n = nb * 64 + lane; float acc[8];
#pragma unroll
            for (int i = 0; i < 8; ++i) acc[i] = 0.f;
            const float* wp = w_pool + (size_t)g * 16384 + (size_t)(kb * 8) * 128;
#pragma unroll 2
            for (int d = 0; d < 128; d += 4) { f32x4 av;
#pragma unroll
                for (int q = 0; q < 4; ++q) av[q] = w_out[(size_t)(g * 128 + d + q) * DM + n];
                av = av * *(const f32x4*)(pscale + g * 128 + d);
#pragma unroll
                for (int i = 0; i < 8; ++i) { const f32x4 wv = *(const f32x4*)(wp + i * 128 + d); acc[i] += av.x * wv.x + av.y * wv.y + av.z * wv.z + av.w * wv.w; } }
            u32x4 o; o.x = pk2(acc[0], acc[1]); o.y = pk2(acc[2], acc[3]); o.z = pk2(acc[4], acc[5]); o.w = pk2(acc[6], acc[7]);
            *(GAS u32x4*)(Wo_t + (size_t)n * DM + g * 128 + kb * 8) = o; continue; } r -= I_WEFF;
        }
}

constexpr int J_WU = 32 * 16 * 32, J_WD = 32 * 16 * 16;
struct ConvItem { const float* src; int ldw; unsigned char* dst; };
__device__ __forceinline__ ConvItem conv_item(const Args& a, int r) {
    ConvItem it;
    if (r < J_WU) { const int e = r >> 9, kb = (r >> 5) & 15, nb = r & 31, n0 = 64 * nb;
        const int rowp = n0 < 1024 ? (n0 >> 7) * 256 + (n0 & 127) : ((n0 - 1024) >> 7) * 256 + 128 + ((n0 - 1024) & 127);
        it.src = a.in[10] + (size_t)e * DM * 2048 + (size_t)(64 * kb) * 2048 + n0; it.ldw = 2048; it.dst = a.ws + WS_WU + ((size_t)e * 2048 + rowp) * DM + 64 * kb; return it; }
    r -= J_WU;
    { const int e = r >> 8, kb = (r >> 4) & 15, nb = r & 15;
      it.src = a.in[12] + (size_t)e * DE * DM + (size_t)(64 * kb) * DM + 64 * nb; it.ldw = DM; it.dst = a.ws + WS_WD + ((size_t)e * DM + 64 * nb) * DE + 64 * kb; return it; }
}
__device__ __forceinline__ void conv_load(float (&tv)[64], const ConvItem& it, int lane) {
    const float* p_ = it.src + lane;
#pragma unroll
    for (int i = 0; i < 64; ++i) tv[i] = p_[(size_t)i * it.ldw];
}
__device__ __forceinline__ void conv_finish(const float (&tv)[64], const ConvItem& it, int lane) {
    const float k_ = pg8::FP8_SW; unsigned char* d_ = it.dst + (size_t)lane * DM;
#pragma unroll
    for (int q = 0; q < 4; ++q) { u32x4 o;
        o.x = pg8::pack4_fp8(tv[16 * q + 0] * k_, tv[16 * q + 1] * k_, tv[16 * q + 2] * k_, tv[16 * q + 3] * k_); o.y = pg8::pack4_fp8(tv[16 * q + 4] * k_, tv[16 * q + 5] * k_, tv[16 * q + 6] * k_, tv[16 * q + 7] * k_);
        o.z = pg8::pack4_fp8(tv[16 * q + 8] * k_, tv[16 * q + 9] * k_, tv[16 * q + 10] * k_, tv[16 * q + 11] * k_); o.w = pg8::pack4_fp8(tv[16 * q + 12] * k_, tv[16 * q + 13] * k_, tv[16 * q + 14] * k_, tv[16 * q + 15] * k_);
        *(GAS u32x4*)(d_ + 16 * q) = o; }
}
__device__ __forceinline__ void conv_chunk(const Args& a, int cc, int lane, int wave) {
    const int r0 = cc * 24 + wave * 3;
    const ConvItem i0 = conv_item(a, r0), i1 = conv_item(a, r0 + 1), i2 = conv_item(a, r0 + 2);
    float ta[64], tb[64];
    conv_load(ta, i0, lane); conv_load(tb, i1, lane);
    conv_finish(ta, i0, lane);
    conv_load(ta, i2, lane);
    conv_finish(tb, i1, lane);
    conv_finish(ta, i2, lane);
}

template <int W> __device__ __forceinline__ void pool_run(const bf16* U, bf16* CAT, int row0, int c0) {
    const int t0 = row0 % SEQ;
    u32x4 blk[8], tr[W - 1];
#pragma unroll
    for (int i = 0; i < 8; ++i) blk[i] = *(const u32x4*)(U + (size_t)(row0 + i) * PW + c0);
#pragma unroll
    for (int j = 1; j < W; ++j) { const u32x4 v_ = *(const u32x4*)(U + (size_t)(t0 - j >= 0 ? row0 - j : row0) * PW + c0); tr[j - 1] = (t0 - j >= 0) ? v_ : (u32x4){0u, 0u, 0u, 0u}; }
    float S[8];
#pragma unroll
    for (int k = 0; k < 8; ++k) S[k] = 0.f;
#pragma unroll
    for (int j = 0; j < W - 1; ++j) { const unsigned rr[4] = {tr[j].x, tr[j].y, tr[j].z, tr[j].w};
#pragma unroll
        for (int k = 0; k < 4; ++k) { S[2 * k] += __builtin_bit_cast(float, rr[k] << 16); S[2 * k + 1] += __builtin_bit_cast(float, rr[k] & 0xffff0000u); } }
#pragma unroll
    for (int i = 0; i < 8; ++i) { const int t = t0 + i; float cur[8];
        { const unsigned rr[4] = {blk[i].x, blk[i].y, blk[i].z, blk[i].w};
#pragma unroll
          for (int k = 0; k < 4; ++k) { cur[2 * k] = __builtin_bit_cast(float, rr[k] << 16); cur[2 * k + 1] = __builtin_bit_cast(float, rr[k] & 0xffff0000u); } }
        const float inv = 1.f / (float)(t + 1 < W ? t + 1 : W); float o[8];
#pragma unroll
        for (int k = 0; k < 8; ++k) { S[k] += cur[k]; o[k] = S[k] * inv - cur[k]; }
        u32x4 ov; ov.x = pk2(o[0], o[1]); ov.y = pk2(o[2], o[3]); ov.z = pk2(o[4], o[5]); ov.w = pk2(o[6], o[7]);
        *(u32x4*)(CAT + (size_t)(row0 + i) * DM + c0) = ov;
        const u32x4 sb = (i - (W - 1) >= 0) ? blk[(i - (W - 1) >= 0) ? i - (W - 1) : 0] : tr[(i - (W - 1) >= 0) ? 0 : (W - 1) - i - 1];
        { const unsigned rr[4] = {sb.x, sb.y, sb.z, sb.w};
#pragma unroll
          for (int k = 0; k < 4; ++k) { S[2 * k] -= __builtin_bit_cast(float, rr[k] << 16); S[2 * k + 1] -= __builtin_bit_cast(float, rr[k] & 0xffff0000u); } }
    }
}
__device__ __forceinline__ void pool_chunk(const Args& a, int c, int tid) {
    const bf16* U = (const bf16*)(a.ws + WS_U); bf16* CAT = (bf16*)(a.ws + WS_CAT);
    const int ch = tid & 63, rb = tid >> 6, c0 = ch * 8, g = c0 >> 7;
#pragma unroll 1
    for (int hf = 0; hf < 2; ++hf) { const int row0 = 128 * c + 8 * (rb + 8 * hf);
        if (g == 0) pool_run<2>(U, CAT, row0, c0); else if (g == 1) pool_run<4>(U, CAT, row0, c0); else if (g == 2) pool_run<8>(U, CAT, row0, c0); else pool_run<16>(U, CAT, row0, c0); }
}
__device__ __forceinline__ void c2_local_scan(const Args& a, LAS unsigned char* L, int bx, int tid, int lane, int wave) {
    if (bx >= 256) return;
    const int bh = bx >> 3, blk = bx & 7; const size_t off = (size_t)bh * SEQ + blk * 1024 + tid * 2;
    const float* src = (const float*)(a.ws + WS_LOGF) + off; float* dst = (float*)(a.ws + WS_CUM) + off;
    LAS double* wtot = (LAS double*)(L + 0);
    const float v0 = src[0], v1 = src[1]; const double s = (double)v0 + (double)v1; double inc = s;
#pragma unroll
    for (int o = 1; o < 64; o <<= 1) { const double t_ = __shfl_up(inc, o); if (lane >= o) inc += t_; }
    if (lane == 63) wtot[wave] = inc;
    __syncthreads();
    double base = inc - s;
    for (int w = 0; w < wave; ++w) base += wtot[w];
    dst[0] = (float)((base + (double)v0) * (double)LOG2E); dst[1] = (float)((base + s) * (double)LOG2E);
    if (tid == 511) ((float*)(a.ws + WS_TOT))[bh * 8 + blk] = (float)((base + s) * (double)LOG2E);
    __syncthreads();
}
__device__ __forceinline__ void c2_load(const Args& a, LAS unsigned char* L, int bh, int tid, int wave) {
    const float* src = (const float*)(a.ws + WS_CUM) + (size_t)bh * SEQ + tid * 16; const float* tot = (const float*)(a.ws + WS_TOT) + bh * 8;
    LAS float* c2s = (LAS float*)(L + attn_body::LDS_C2);
    double base = 0.0;
    for (int w = 0; w < wave; ++w) base += (double)tot[w];
    const float bf = (float)base;
#pragma unroll
    for (int i = 0; i < 4; ++i) { f32x4 v = *(const f32x4*)(src + 4 * i); v = v + bf; *(LAS f32x4*)(c2s + tid * 16 + 4 * i) = v; }
    __syncthreads();
}

constexpr int RT_GWH = 0, RT_GWL = 65536, RT_GF = 131072, RT_CHE = 135168, RT_CHG = RT_CHE + 2048, RT_LCNT = RT_CHG + 2048, RT_LBASE = RT_LCNT + 128;
static_assert(RT_LBASE + 128 <= LDSCTL_OFF, "router LDS map");
__device__ __forceinline__ void router_phase(const Args& a, LAS unsigned char* L, int vcu, int G, int tid, int lane, int wave) {
    typedef short bf16x8_t __attribute__((ext_vector_type(8))); typedef float f32x16_t __attribute__((ext_vector_type(16)));
    LAS unsigned short* gwh = (LAS unsigned short*)(L + RT_GWH); LAS unsigned short* gwl = (LAS unsigned short*)(L + RT_GWL); LAS float* gf = (LAS float*)(L + RT_GF);
    LAS int* ch_e = (LAS int*)(L + RT_CHE); LAS float* ch_g = (LAS float*)(L + RT_CHG); LAS int* lcnt = (LAS int*)(L + RT_LCNT); LAS int* lbase = (LAS int*)(L + RT_LBASE);
    const float* w_router = a.in[8]; const float* b_router = a.in[9]; const float* g_ffn = a.in[7];
    for (int idx = tid; idx < 1024 * 32; idx += 512) { const int k = idx >> 5, e = idx & 31; const float v = g_ffn[k] * w_router[idx];
        const unsigned hb = f2bf(v); const float hf = __builtin_bit_cast(float, hb << 16); const unsigned lb = f2bf(v - hf);
        const int pos = (((k >> 4) * 2 + ((k >> 3) & 1)) * 32 + e) * 8 + (k & 7); gwh[pos] = (unsigned short)hb; gwl[pos] = (unsigned short)lb; }
    for (int k = tid; k < 1024; k += 512) gf[k] = g_ffn[k];
    __syncthreads();
    const bf16* X1 = (const bf16*)(a.ws + WS_X1B); unsigned char* H2 = a.ws + WS_XN;
    int* cnt = (int*)(a.ws + WS_CTL) + CW_CNT; int* SEL = (int*)(a.ws + WS_SEL); int* LTK = (int*)(a.ws + WS_LTK); float* LGT = (float*)(a.ws + WS_LGT);
    const int j = lane & 31, hlf = lane >> 5;
    for (int grp = vcu; grp < T / 128; grp += G) {
        if (tid < 32) lcnt[tid] = 0;
        __syncthreads();
        if (wave < 4) {
            const int lt = wave * 32 + j, m = grp * 128 + lt;
            const bf16* xr = X1 + (size_t)m * DM + 8 * hlf;
            f32x16_t acc; float ss = 0.f;
#pragma unroll
            for (int r = 0; r < 16; ++r) acc[r] = 0.f;
#pragma unroll 8
            for (int s = 0; s < 64; ++s) {
                const u32x4 xb = *(const u32x4*)(xr + 16 * s);
                const bf16x8_t ah = *(const LAS bf16x8_t*)(gwh + ((s * 2 + hlf) * 32 + j) * 8), al = *(const LAS bf16x8_t*)(gwl + ((s * 2 + hlf) * 32 + j) * 8);
                const bf16x8_t xf = __builtin_bit_cast(bf16x8_t, xb);
                acc = __builtin_amdgcn_mfma_f32_32x32x16_bf16(ah, xf, acc, 0, 0, 0);
                acc = __builtin_amdgcn_mfma_f32_32x32x16_bf16(al, xf, acc, 0, 0, 0);
                const unsigned w_[4] = {xb.x, xb.y, xb.z, xb.w};
#pragma unroll
                for (int q = 0; q < 4; ++q) { const float lo = __builtin_bit_cast(float, w_[q] << 16), hi = __builtin_bit_cast(float, w_[q] & 0xffff0000u); ss += lo * lo + hi * hi; }
            }
            ss += __shfl_xor(ss, 32);
            const float rstd = rsqrtf(ss * (1.f / DM) + RMS_EPS);
            float lv[16];
#pragma unroll
            for (int r = 0; r < 16; ++r) lv[r] = acc[r] * rstd + b_router[(r & 3) + 8 * (r >> 2) + 4 * hlf];
            float tv[4]; int ti[4];
#pragma unroll
            for (int k = 0; k < 4; ++k) { float bv = -INFINITY; int bi = 64;
#pragma unroll
                for (int r = 0; r < 16; ++r) { const int ei = (r & 3) + 8 * (r >> 2) + 4 * hlf; if (lv[r] > bv) { bv = lv[r]; bi = ei; } }
                tv[k] = bv; ti[k] = bi;
#pragma unroll
                for (int r = 0; r < 16; ++r) { const int ei = (r & 3) + 8 * (r >> 2) + 4 * hlf; if (ei == bi) lv[r] = -INFINITY; } }
            float cv[8]; int ci[8];
#pragma unroll
            for (int k = 0; k < 4; ++k) { cv[k] = tv[k]; ci[k] = ti[k]; cv[4 + k] = __shfl_xor(tv[k], 32); ci[4 + k] = __shfl_xor(ti[k], 32); }
#pragma unroll
            for (int k = 0; k < 4; ++k) { float bv = -INFINITY; int bi = 64;
#pragma unroll
                for (int c = 0; c < 8; ++c) if (cv[c] > bv || (cv[c] == bv && ci[c] < bi)) { bv = cv[c]; bi = ci[c]; }
                tv[k] = bv; ti[k] = bi;
#pragma unroll
                for (int c = 0; c < 8; ++c) if (ci[c] == bi) cv[c] = -INFINITY; }
            const float e1 = expf(tv[1] - tv[0]), e2 = expf(tv[2] - tv[0]), e3 = expf(tv[3] - tv[0]); const float inv = 1.f / (1.f + e1 + e2 + e3);
            if (hlf == 0) { ch_e[lt * 4 + 0] = ti[0]; ch_e[lt * 4 + 1] = ti[1]; ch_e[lt * 4 + 2] = ti[2]; ch_e[lt * 4 + 3] = ti[3];
                ch_g[lt * 4 + 0] = inv; ch_g[lt * 4 + 1] = e1 * inv; ch_g[lt * 4 + 2] = e2 * inv; ch_g[lt * 4 + 3] = e3 * inv;
#pragma unroll
                for (int k = 0; k < 4; ++k) __hip_atomic_fetch_add(&lcnt[ti[k]], 1, __ATOMIC_RELAXED, __HIP_MEMORY_SCOPE_WORKGROUP); }
            unsigned char* hr = H2 + (size_t)m * DM + 8 * hlf; const float sc = rstd * pg8::FP8_SA;
#pragma unroll 8
            for (int s = 0; s < 64; ++s) {
                const u32x4 xb = *(const u32x4*)(xr + 16 * s); const unsigned w_[4] = {xb.x, xb.y, xb.z, xb.w};
                const f32x4 g0 = *(const LAS f32x4*)(gf + 16 * s + 8 * hlf), g1 = *(const LAS f32x4*)(gf + 16 * s + 8 * hlf + 4);
                float x_[8];
#pragma unroll
                for (int q = 0; q < 4; ++q) { x_[2 * q] = __builtin_bit_cast(float, w_[q] << 16); x_[2 * q + 1] = __builtin_bit_cast(float, w_[q] & 0xffff0000u); }
                u32x2 o; o.x = pg8::pack4_fp8(x_[0] * g0.x * sc, x_[1] * g0.y * sc, x_[2] * g0.z * sc, x_[3] * g0.w * sc); o.y = pg8::pack4_fp8(x_[4] * g1.x * sc, x_[5] * g1.y * sc, x_[6] * g1.z * sc, x_[7] * g1.w * sc);
                *(u32x2*)(hr + 16 * s) = o;
            }
        }
        __syncthreads();
        if (tid < 32) { lbase[tid] = atomicAdd(&cnt[tid], lcnt[tid]); lcnt[tid] = 0; }
        __syncthreads();
        { const int e = ch_e[tid]; const int slot = lbase[e] + __hip_atomic_fetch_add(&lcnt[e], 1, __ATOMIC_RELAXED, __HIP_MEMORY_SCOPE_WORKGROUP); const int tk = (grp * 128 + (tid >> 2)) * 4 + (tid & 3);
          LTK[(size_t)e * T + slot] = tk; LGT[(size_t)e * T + slot] = ch_g[tid]; SEL[tk] = (slot << 5) | e; }
        __syncthreads();
    }
}

__device__ __forceinline__ void expert_map(const Args& a, volatile LAS unsigned* MISC, int tid) {
    if (tid == 0) { const int* cnt = (const int*)(a.ws + WS_CTL) + CW_CNT; int acc = 0;
        for (int e = 0; e < 32; ++e) { const int c = __hip_atomic_load((int*)cnt + e, RLX_AGENT); MISC[64 + e] = (unsigned)c; MISC[96 + e] = (unsigned)acc; acc += (c + RT - 1) / RT; } MISC[128] = (unsigned)acc; }
    __syncthreads();
}

__device__ __forceinline__ void final_phase(const Args& a, volatile LAS unsigned* MISC, int vcu, int G, int lane, int wave) {
    const int* SEL = (const int*)(a.ws + WS_SEL); const unsigned char* Y = a.ws + WS_Y; const bf16* X1 = (const bf16*)(a.ws + WS_X1B); const float* g_final = a.in[14];
    f32x4 g[4];
#pragma unroll
    for (int j = 0; j < 4; ++j) g[j] = *(const f32x4*)(g_final + 4 * lane + 256 * j);
    typedef float f32x2_t __attribute__((ext_vector_type(2)));
    const int m0 = vcu * 8 + wave, MS = G * 8;
    int svn[4]; u32x2 xbn[4];
#pragma unroll
    for (int k = 0; k < 4; ++k) svn[k] = SEL[m0 * 4 + k];
#pragma unroll
    for (int j = 0; j < 4; ++j) xbn[j] = *(const u32x2*)(X1 + (size_t)m0 * DM + 4 * lane + 256 * j);
    for (int m = m0; m < T; m += MS) {
        f32x4 v[4]; unsigned yv[4][4];
#pragma unroll
        for (int k = 0; k < 4; ++k) { const int e = svn[k] & 31, slot = svn[k] >> 5; const unsigned char* yr = Y + ((size_t)MISC[96 + e] * RT + slot) * DM;
#pragma unroll
            for (int j = 0; j < 4; ++j) yv[k][j] = *(const unsigned*)(yr + 4 * lane + 256 * j); }
#pragma unroll
        for (int j = 0; j < 4; ++j) { const u32x2 xb = xbn[j];
            v[j].x = __builtin_bit_cast(float, xb.x << 16); v[j].y = __builtin_bit_cast(float, xb.x & 0xffff0000u); v[j].z = __builtin_bit_cast(float, xb.y << 16); v[j].w = __builtin_bit_cast(float, xb.y & 0xffff0000u); }
        { const int mn = (m + MS < T) ? m + MS : m;
#pragma unroll
          for (int k = 0; k < 4; ++k) svn[k] = SEL[mn * 4 + k];
#pragma unroll
          for (int j = 0; j < 4; ++j) xbn[j] = *(const u32x2*)(X1 + (size_t)mn * DM + 4 * lane + 256 * j); }
        f32x4 ya[4];
#pragma unroll
        for (int j = 0; j < 4; ++j) ya[j] = (f32x4){0.f, 0.f, 0.f, 0.f};
#pragma unroll
        for (int k = 0; k < 4; ++k)
#pragma unroll
            for (int j = 0; j < 4; ++j) { const unsigned y = yv[k][j];
                const f32x2_t lo = __builtin_amdgcn_cvt_pk_f32_fp8((int)y, false), hi = __builtin_amdgcn_cvt_pk_f32_fp8((int)y, true);
                ya[j].x += lo.x; ya[j].y += lo.y; ya[j].z += hi.x; ya[j].w += hi.y; }
        float ss = 0.f;
#pragma unroll
        for (int j = 0; j < 4; ++j) { v[j] = v[j] + ya[j] * (1.0f / pg8::FP8_SY); ss += v[j].x * v[j].x + v[j].y * v[j].y + v[j].z * v[j].z + v[j].w * v[j].w; }
        const float rstd = rsqrtf(wave_sum(ss) * (1.f / DM) + RMS_EPS);
        float* orow = a.out + (size_t)m * DM;
#pragma unroll
        for (int j = 0; j < 4; ++j) *(f32x4*)(orow + 4 * lane + 256 * j) = v[j] * rstd * g[j];
    }
}

__global__ void __launch_bounds__(NWAVES * 64, 2) mk_fwd(Args args) {
    extern __shared__ __attribute__((aligned(16))) unsigned char lds[];
    LAS unsigned char* L = (LAS unsigned char*)lds;
    volatile LAS unsigned* MISC = (volatile LAS unsigned*)(L + LDSCTL_OFF);
    const int tid = threadIdx.x, lane = tid & 63, wave = __builtin_amdgcn_readfirstlane(tid >> 6);
    const int G = gridDim.x; const int bx = blockIdx.x; const int vcu = (G % 8 == 0) ? (bx % 8) * (G / 8) + bx / 8 : bx;
    unsigned char* ws = args.ws;
    for (int u = tid; u < (LDS_TOTAL - LDSCTL_OFF) / 4; u += NWAVES * 64) ((LAS unsigned*)(L + LDSCTL_OFF))[u] = 0u;
    __syncthreads();
    XcdBarrier bar; bar.bar = (unsigned*)(ws + WS_CTL) + CW_BAR; bar.x = 0; bar.st = nullptr;
    if (args.use_bar) bar = xcd_barrier_post((unsigned*)(ws + WS_CTL) + CW_BAR, MISC + 8);
    const int lo = args.ph_lo, hi = args.ph_hi;
#define IN(k) (lo <= (k) && (k) < hi)
#define SEAM(k) do { if (IN(k) && IN((k) + 1)) xcd_barrier(bar); } while (0)
#ifndef MK_DUP
#define MK_DUP -1
#endif
#ifndef MK_TPROBE
#define MK_TPROBE -1
#endif
#define CK0(k) do { if ((MK_TPROBE) == 100 + (k) && bx == 0 && tid == 0) { const unsigned long long c_ = __builtin_amdgcn_s_memtime(); const unsigned long long t_ = __builtin_amdgcn_s_memrealtime(); MISC[28] = (unsigned)c_; MISC[29] = (unsigned)(c_ >> 32); MISC[16] = (unsigned)t_; MISC[17] = (unsigned)(t_ >> 32); } } while (0)
#define CK1(k) do { if ((MK_TPROBE) == 100 + (k) && bx == 0 && tid == 0) { const unsigned long long c_ = __builtin_amdgcn_s_memtime(); const unsigned long long t_ = __builtin_amdgcn_s_memrealtime(); const unsigned long long c0_ = ((unsigned long long)MISC[29] << 32) | MISC[28], t0_ = ((unsigned long long)MISC[17] << 32) | MISC[16]; \
    const unsigned long long spin_ = (c_ - c0_) * 1000ull / (t_ - t0_); MISC[18] = (unsigned)(t0_ + spin_); MISC[19] = (unsigned)((t0_ + spin_) >> 32); } } while (0)
#define TP0(k) do { if ((MK_TPROBE) == (k) && bx == 0 && tid == 0) { const unsigned long long t_ = __builtin_amdgcn_s_memrealtime(); MISC[16] = (unsigned)t_; MISC[17] = (unsigned)(t_ >> 32); } } while (0)
#define TP1(k) do { if ((MK_TPROBE) == (k) && bx == 0 && tid == 0) { const unsigned long long t_ = __builtin_amdgcn_s_memrealtime(); MISC[18] = (unsigned)t_; MISC[19] = (unsigned)(t_ >> 32); } } while (0)
#define REPS(k) for (int rep_ = 0; rep_ < ((MK_DUP) == (k) ? 2 : 1); ++rep_, ((MK_DUP) == (k) && rep_ == 1 ? xcd_barrier(bar) : (void)0))

    TP0(0); CK0(0); TP0(200);
    if (IN(0)) REPS(0) { phase0(args, L, vcu, G, tid, lane, wave); }
    CK1(0); SEAM(0); TP1(0); TP0(1); CK0(1);
    if (IN(1)) REPS(1) {
        pg8::Gemm g{(const bf16*)(ws + WS_XN), (const bf16*)(ws + WS_WIN), DM}; pg8::StaticOrder S; S.init(T, 2048, G, bx);
        c2_local_scan(args, L, bx, tid, lane, wave);
        pg8::EpiInproj E{(bf16*)(ws + WS_U), (size_t)(WS_Q - WS_U) / 2, C2, (unsigned*)(ws + WS_CTL) + CW_NRM};
        pg8::gemm_phase<pg8::EpiInproj, pg8::StaticOrder, true, false>(L + RING_OFF, g, S, E, nullptr);
    }
    CK1(1); SEAM(1); TP1(1); TP0(2); CK0(2);
    if (IN(2)) {
        constexpr unsigned NQ_POOL = T / 128, NQA = NQ_POOL + 1024, NQC = 1024;
        static_assert(1024 * 24 == J_WU + J_WD, "conversion chunks");
        unsigned* qhead = (unsigned*)(ws + WS_CTL) + CW_Q; const float* nrm = (const float*)(ws + WS_CTL) + CW_NRM;
        const attn_body::AttnTensors AT{(const attn_body::bf16*)(ws + WS_Q), (const attn_body::bf16*)(ws + WS_K), (const attn_body::bf16*)(ws + WS_V), (attn_body::bf16*)(ws + WS_CAT) + PW};
        const int pref = ((bx & 3) == 0) ? 1 : 0;
#define QT0() unsigned long long tq0_ = 0; if ((MK_TPROBE) >= 26 && (MK_TPROBE) <= 29 && threadIdx.x == 0) tq0_ = __builtin_amdgcn_s_memrealtime()
#define QT1(kind) do { if ((MK_TPROBE) == (kind) && threadIdx.x == 0) atomicAdd((unsigned*)(ws + WS_CTL) + 512, (unsigned)(__builtin_amdgcn_s_memrealtime() - tq0_)); } while (0)
#define CONV_LOOP() do { unsigned pend_ = 0; int sl_ = 0; if (threadIdx.x == 0) pend_ = atomicAdd(qhead + 64, 1u); \
        for (;;) { int tid_ = threadIdx.x; asm volatile("" : "+v"(tid_));   \
            if (tid_ == 0) MISC[24 + sl_] = pend_; __syncthreads(); const unsigned q = MISC[24 + sl_]; sl_ ^= 1; if (q >= NQC) break; \
            if (tid_ == 0) pend_ = atomicAdd(qhead + 64, 1u); \
            QT0(); conv_chunk(args, (int)q, tid_ & 63, tid_ >> 6); QT1(28); } } while (0)
        if (pref) { CONV_LOOP(); __syncthreads(); }
        { int sl_ = 0;
        for (;;) {
            int tid_ = threadIdx.x; asm volatile("" : "+v"(tid_));
            if (tid_ == 0) MISC[26 + sl_] = atomicAdd(qhead, 1u);
            __syncthreads();
            const unsigned q = MISC[26 + sl_]; sl_ ^= 1;
            if (q >= NQA) break;
            QT0();
            if (q < NQ_POOL) { pool_chunk(args, (int)q, tid_); }
            else { const int grp = (int)(q - NQ_POOL), qb = 31 - (grp >> 5), bh = grp & 31;
                c2_load(args, L, bh, tid_, tid_ >> 6);
                const float qkb2 = 4.0f * sqrtf(nrm[bh] * nrm[32 + bh]) * 1.001f;
                attn_body::attn_unit<8>(bh / NH, bh % NH, qb, AT.Q, AT.K, AT.V, AT.O, (char*)lds + RING_OFF, qkb2); }
            if (q < NQ_POOL) QT1(26); else QT1(27);
        } }
        __syncthreads();
        CONV_LOOP();
#undef CONV_LOOP
    }
    CK1(2); SEAM(2); TP1(2); TP0(3); CK0(3);
    if (IN(3)) REPS(3) {
        pg8::Gemm g{(const bf16*)(ws + WS_CAT), (const bf16*)(ws + WS_WO), DM}; pg8::StaticOrder S; S.init(T, DM, G, bx);
        pg8::EpiResBf16 E{args.in[0], (bf16*)(ws + WS_X1B)};
        pg8::gemm_phase<pg8::EpiResBf16, pg8::StaticOrder, true, false>(L + RING_OFF, g, S, E, nullptr);
    }
    CK1(3); SEAM(3); TP1(3); TP0(4); CK0(4);
    if (IN(4)) { router_phase(args, L, vcu, G, tid, lane, wave); }
    CK1(4); SEAM(4); TP1(4); TP0(5); CK0(5);
    if (IN(5)) REPS(5) {
        TP0(51); expert_map(args, MISC, tid);
        const LAS int* pt = (const LAS int*)(L + LDSCTL_OFF + 96 * 4); const LAS int* cn = (const LAS int*)(L + LDSCTL_OFF + 64 * 4);
        LAS unsigned* tab = (LAS unsigned*)(L + TAB_OFF);
        LAS int* ul = (LAS int*)(L + LDSCTL_OFF + 132 * 4);
        pg8::MoeOrder<8>::build(ul, pt, bx, tid);
        const pg8::MoeOrder<8> S{ul, (size_t)2048 * DM};
        { const int* LTK = (const int*)(ws + WS_LTK); const int nu = ul[0];
          for (int idx = tid; idx < nu * 256; idx += NWAVES * 64) { const int i = idx >> 8, r = idx & 255, e = ul[6 + 4 * i], slot = ul[7 + 4 * i] + r;
              const int tok = slot < cn[e] ? (LTK[(size_t)e * T + slot] >> 2) : 0; tab[idx] = (unsigned)tok * (unsigned)DM; } }
        __syncthreads(); TP1(51);
        pg8::Gemm g{(const bf16*)(ws + WS_XN), (const bf16*)(ws + WS_WU), DM / 2};
        pg8::EpiSwiglu8 E{ws + WS_ACT, args.in[11]};
        pg8::gemm_phase<pg8::EpiSwiglu8, pg8::MoeOrder<8>, true, true, true>(L + RING_OFF, g, S, E, tab, ((MK_TPROBE) == 52 && bx == 0) ? (volatile LAS unsigned*)(MISC + 20) : nullptr);
    }
    CK1(5); SEAM(5); TP1(5); TP0(6); CK0(6);
    if (IN(6)) REPS(6) {
        expert_map(args, MISC, tid);
        const LAS int* pt = (const LAS int*)(L + LDSCTL_OFF + 96 * 4); const LAS int* cn = (const LAS int*)(L + LDSCTL_OFF + 64 * 4);
        LAS int* ul = (LAS int*)(L + LDSCTL_OFF + 132 * 4);
        pg8::MoeOrder<4>::build(ul, pt, bx, tid);
        const pg8::MoeOrder<4> S{ul, (size_t)DM * DE};
        pg8::Gemm g{(const bf16*)(ws + WS_ACT), (const bf16*)(ws + WS_WD), DE / 2};
        pg8::EpiDown E{ws + WS_Y, args.in[13], (const float*)(ws + WS_LGT), cn, T, pg8::FP8_INV};
        pg8::gemm_phase<pg8::EpiDown, pg8::MoeOrder<4>, true, false, true>(L + RING_OFF, g, S, E, nullptr);
    }
    CK1(6); SEAM(6); TP1(6); TP0(7); CK0(7); TP0(70);
    if (IN(7)) { expert_map(args, MISC, tid); final_phase(args, MISC, vcu, G, lane, wave); }
    if ((MK_TPROBE) == 70) { xcd_barrier(bar); }
    TP1(7); TP1(70); TP1(200);
    if ((MK_TPROBE) >= 0 && bx == 0) { __syncthreads(); const unsigned long long ta = ((unsigned long long)MISC[17] << 32) | MISC[16], tb = ((MK_TPROBE) >= 26 && (MK_TPROBE) <= 29) ? ta + (__hip_atomic_load((unsigned*)(ws + WS_CTL) + 512, RLX_AGENT) >> 8) : ((MK_TPROBE) == 52 || ((MK_TPROBE) >= 23 && (MK_TPROBE) <= 25)) ? ta + MISC[20] : (((unsigned long long)MISC[19] << 32) | MISC[18]);
        const unsigned long long tend = __builtin_amdgcn_s_memrealtime() + (tb - ta); while (__builtin_amdgcn_s_memrealtime() < tend) __builtin_amdgcn_s_sleep(10); }
#undef IN
#undef SEAM
}
#ifndef MK_MODE
#define MK_MODE 1
#endif
#ifndef MK_NAIVE_MASK
#define MK_NAIVE_MASK 0
#endif
extern "C" void kernel_launch(void* const* d_in, const int* in_sizes, int n_in, void* d_out, int out_size, void* d_ws, size_t ws_size, hipStream_t stream) {
    if (n_in != 15 || out_size != T * DM || ws_size < WS_END) { fprintf(stderr, "kernel_launch: unexpected shapes (n_in %d out %d ws %zu)\n", n_in, out_size, ws_size); return; }
    Params p{};
    p.x = (const float*)d_in[0]; p.g_mix = (const float*)d_in[1]; p.w_in = (const float*)d_in[2]; p.b_forget = (const float*)d_in[3]; p.w_pool = (const float*)d_in[4];
    p.pool_scale = (const float*)d_in[5]; p.w_out = (const float*)d_in[6]; p.g_ffn = (const float*)d_in[7]; p.w_router = (const float*)d_in[8]; p.b_router = (const float*)d_in[9];
    p.w_up = (const float*)d_in[10]; p.b_up = (const float*)d_in[11]; p.w_down = (const float*)d_in[12]; p.b_down = (const float*)d_in[13]; p.g_final = (const float*)d_in[14];
    p.out = (float*)d_out; p.ws = (unsigned char*)d_ws;
    Args a{};
    for (int i = 0; i < 15; ++i) a.in[i] = (const float*)d_in[i];
    a.out = (float*)d_out; a.ws = (unsigned char*)d_ws;
    static bool attr_done = false;
    if (!attr_done) { if (hipFuncSetAttribute((const void*)mk_fwd, hipFuncAttributeMaxDynamicSharedMemorySize, LDS_TOTAL) != hipSuccess) fprintf(stderr, "kernel_launch: hipFuncSetAttribute failed\n"); attr_done = true; }
    (void)hipMemsetAsync((char*)d_ws + WS_CTL, 0, 1 * MiB, stream);
    const int GRID = 256;
#if MK_MODE == 2
    a.ph_lo = 0; a.ph_hi = N_PHASES; a.use_bar = 1;
    hipLaunchKernelGGL(mk_fwd, dim3(GRID), dim3(NWAVES * 64), LDS_TOTAL, stream, a);
#else
    const unsigned mask = (MK_MODE == 0) ? 0xffu : (unsigned)(MK_NAIVE_MASK);
    auto fast = [&](int k) { a.ph_lo = k; a.ph_hi = k + 1; a.use_bar = 0; hipLaunchKernelGGL(mk_fwd, dim3(GRID), dim3(NWAVES * 64), LDS_TOTAL, stream, a); };
    auto nv = [&](int k) { return (mask >> k) & 1u; };
    if (mask != 0xffu || !nv(0)) fast(0);
    if (nv(0)) k_prologue<<<1024, 512, 0, stream>>>(p);
    if (nv(1)) k_inproj_naive<<<2048, 512, 0, stream>>>(p); else fast(1);
    if (nv(2)) { k_cumsum<<<32, 512, 0, stream>>>(p); k_attn_naive<<<BATCH * NH * (SEQ / 64), 512, 0, stream>>>(p); if (!nv(3)) k_pool<<<2048, 512, 0, stream>>>(p, (bf16*)((unsigned char*)d_ws + WS_CAT), DM); }
    else fast(2);
    if (nv(3)) { k_pool<<<2048, 512, 0, stream>>>(p, (bf16*)((unsigned char*)d_ws + WS_P), PW); k_poolgemm_naive<<<2048, 512, 0, stream>>>(p); k_outproj_naive<<<2048, 512, 0, stream>>>(p); }
    else fast(3);
    if (nv(4)) k_router<<<256, 512, 0, stream>>>(p); else fast(4);
    if (nv(5)) k_up_naive<<<4096, 512, 0, stream>>>(p); else fast(5);
    if (nv(6)) k_down_naive<<<4096, 512, 0, stream>>>(p); else fast(6);
    if (nv(7)) k_final<<<1024, 512, 0, stream>>>(p); else fast(7);
#endif
}
```

```cpp
#define MK_MODE 2
#include <hip/hip_runtime.h>
#include <cstdio>
#include <cstdint>

constexpr int BATCH = 4, SEQ = 8192, DM = 1024, T = BATCH * SEQ;
constexpr int PW = 512, AW = 512, NH = 8, HD = 64, INW = PW + 3 * AW + NH;
constexpr int NE = 32, TOPK = 4, DE = 1024;
constexpr float RMS_EPS = 1e-5f, SW_LIMIT = 7.0f, SW_ALPHA = 1.702f;
constexpr float LOG2E = 1.4426950408889634f;
constexpr float C2 = 0.125f * LOG2E;
constexpr int RT = 256;
constexpr int NROWS_PAD = T * TOPK + NE * RT;

typedef unsigned short bf16;
typedef float f32x4 __attribute__((ext_vector_type(4)));
typedef unsigned u32x4 __attribute__((ext_vector_type(4)));
typedef unsigned u32x2 __attribute__((ext_vector_type(2)));

constexpr size_t MiB = 1u << 20;
constexpr size_t WS_CTL = 0;
constexpr size_t WS_LOGF = 1 * MiB;
constexpr size_t WS_CUM = 2 * MiB;
constexpr size_t WS_SEL = 3 * MiB;
constexpr size_t WS_LTK = 4 * MiB;
constexpr size_t WS_LGT = 8 * MiB;
constexpr size_t WS_XN = 12 * MiB;
constexpr size_t WS_WIN = 76 * MiB;
constexpr size_t WS_WO = 80 * MiB;
constexpr size_t WS_WU = 82 * MiB;
constexpr size_t WS_WD = 210 * MiB;
constexpr size_t WS_U = 274 * MiB;
constexpr size_t WS_Q = 306 * MiB;
constexpr size_t WS_K = 338 * MiB;
constexpr size_t WS_V = 370 * MiB;
constexpr size_t WS_CAT = 402 * MiB;
constexpr size_t WS_P = 466 * MiB;
constexpr size_t WS_ACT = 274 * MiB;
constexpr size_t WS_Y = 546 * MiB;
constexpr size_t WS_END = 818 * MiB;
static_assert(WS_ACT + (size_t)NROWS_PAD * 1024 * 2 <= WS_Y, "ACT overlay");
static_assert(WS_Y + (size_t)NROWS_PAD * 1024 * 2 <= WS_END, "Y");
constexpr int CW_CNT = 64;

struct Params {
    const float *x, *g_mix, *w_in, *b_forget, *w_pool, *pool_scale, *w_out, *g_ffn, *w_router, *b_router, *w_up, *b_up, *w_down, *b_down, *g_final;
    float* out; unsigned char* ws;
};

__device__ __forceinline__ unsigned f2bf(float f) { unsigned u = __builtin_bit_cast(unsigned, f); return (u + 0x7fffu + ((u >> 16) & 1u)) >> 16; }
__device__ __forceinline__ unsigned pk2(float lo, float hi) { return f2bf(lo) | (f2bf(hi) << 16); }
__device__ __forceinline__ float bf2f(unsigned short b) { return __builtin_bit_cast(float, (unsigned)b << 16); }
__device__ __forceinline__ float wave_sum(float v) {
#pragma unroll
    for (int o = 1; o < 64; o <<= 1) v += __shfl_xor(v, o);
    return v;
}

__global__ void __launch_bounds__(512) k_prologue(Params p) {
    __shared__ float wf[1024 * 8];
    const int tid = threadIdx.x, lane = tid & 63, wave = tid >> 6;
    for (int i = tid; i < 1024 * 8; i += 512) wf[i] = p.w_in[(size_t)(i >> 3) * INW + 2048 + (i & 7)];
    if (blockIdx.x == 0 && tid < 64) ((int*)(p.ws + WS_CTL))[CW_CNT + tid] = 0;
    __syncthreads();
    bf16* XN = (bf16*)(p.ws + WS_XN); float* LOGF = (float*)(p.ws + WS_LOGF);
    const int gw = blockIdx.x * 8 + wave, NGW = gridDim.x * 8;
    f32x4 g[4];
#pragma unroll
    for (int j = 0; j < 4; ++j) g[j] = *(const f32x4*)(p.g_mix + 4 * lane + 256 * j);
    for (int m = gw; m < T; m += NGW) {
        const float* xr = p.x + (size_t)m * DM;
        f32x4 v[4]; float ss = 0.f;
#pragma unroll
        for (int j = 0; j < 4; ++j) { v[j] = *(const f32x4*)(xr + 4 * lane + 256 * j); ss += v[j].x * v[j].x + v[j].y * v[j].y + v[j].z * v[j].z + v[j].w * v[j].w; }
        const float rstd = rsqrtf(wave_sum(ss) * (1.f / DM) + RMS_EPS);
        float fl[8];
#pragma unroll
        for (int e = 0; e < 8; ++e) fl[e] = 0.f;
#pragma unroll
        for (int j = 0; j < 4; ++j) {
            v[j] = v[j] * rstd * g[j];
#pragma unroll
            for (int i = 0; i < 4; ++i) {
                const int d = 4 * lane + 256 * j + i; const float hv = v[j][i];
                const f32x4 w0 = *(const f32x4*)(wf + d * 8), w1 = *(const f32x4*)(wf + d * 8 + 4);
                fl[0] += hv * w0.x; fl[1] += hv * w0.y; fl[2] += hv * w0.z; fl[3] += hv * w0.w;
                fl[4] += hv * w1.x; fl[5] += hv * w1.y; fl[6] += hv * w1.z; fl[7] += hv * w1.w;
            }
            u32x2 o; o.x = pk2(v[j].x, v[j].y); o.y = pk2(v[j].z, v[j].w);
            *(u32x2*)(XN + (size_t)m * DM + 4 * lane + 256 * j) = o;
        }
#pragma unroll
        for (int e = 0; e < 8; ++e) fl[e] = wave_sum(fl[e]);
        if (lane < 8) {
            float z = 0.f;
#pragma unroll
            for (int e = 0; e < 8; ++e) if (lane == e) z = fl[e];
            z += p.b_forget[lane];
            const float ls = fminf(z, 0.f) - log1pf(expf(-fabsf(z)));
            const int b = m / SEQ, s = m % SEQ;
            LOGF[((size_t)b * NH + lane) * SEQ + s] = ls;
        }
    }
}

__global__ void __launch_bounds__(512) k_cumsum(Params p) {
    __shared__ double part[512];
    const int tid = threadIdx.x;
    const float* LOGF = (const float*)(p.ws + WS_LOGF); float* CUM = (float*)(p.ws + WS_CUM);
    for (int bh = blockIdx.x; bh < BATCH * NH; bh += gridDim.x) {
        const float* src = LOGF + (size_t)bh * SEQ + tid * 16; float v[16]; double s = 0.0;
#pragma unroll
        for (int i = 0; i < 16; ++i) { v[i] = src[i]; s += (double)v[i]; }
        part[tid] = s; __syncthreads();
        if (tid == 0) { double a = 0.0; for (int i = 0; i < 512; ++i) { const double t_ = part[i]; part[i] = a; a += t_; } }
        __syncthreads();
        double a = part[tid];
        float* dst = CUM + (size_t)bh * SEQ + tid * 16;
#pragma unroll
        for (int i = 0; i < 16; ++i) { a += (double)v[i]; dst[i] = (float)(a * (double)LOG2E); }
        __syncthreads();
    }
}

__global__ void __launch_bounds__(512) k_pool(Params p, bf16* dst, int ldd) {
    const bf16* U = (const bf16*)(p.ws + WS_U);
    const size_t total = (size_t)T * 64;
    for (size_t i = (size_t)blockIdx.x * 512 + threadIdx.x; i < total; i += (size_t)gridDim.x * 512) {
        const int row = (int)(i >> 6), ch = (int)(i & 63), c0 = ch * 8, g = c0 >> 7, w = 2 << g, t = row % SEQ;
        const int n = t + 1 < w ? t + 1 : w;
        float acc[8], self[8];
#pragma unroll
        for (int k = 0; k < 8; ++k) acc[k] = 0.f;
        for (int j = 0; j < n; ++j) {
            const u32x4 r = *(const u32x4*)(U + (size_t)(row - j) * PW + c0);
            const unsigned rr[4] = {r.x, r.y, r.z, r.w};
#pragma unroll
            for (int k = 0; k < 4; ++k) { const float lo = __builtin_bit_cast(float, rr[k] << 16), hi = __builtin_bit_cast(float, rr[k] & 0xffff0000u); acc[2 * k] += lo; acc[2 * k + 1] += hi;
                if (j == 0) { self[2 * k] = lo; self[2 * k + 1] = hi; } }
        }
        const float inv = 1.f / (float)n; u32x4 o;
        o.x = pk2(acc[0] * inv - self[0], acc[1] * inv - self[1]); o.y = pk2(acc[2] * inv - self[2], acc[3] * inv - self[3]);
        o.z = pk2(acc[4] * inv - self[4], acc[5] * inv - self[5]); o.w = pk2(acc[6] * inv - self[6], acc[7] * inv - self[7]);
        *(u32x4*)(dst + (size_t)row * ldd + c0) = o;
    }
}

template <class ARow, class Epi, bool DUAL>
__device__ __forceinline__ void naive_tile(int tm, int tn, int K, const ARow& arow, const float* W, const float* W2, int ldw, const Epi& epi, float* lds) {
    float* As = lds;
    float* Ws = lds + 16 * 68;
    float* Ws2 = Ws + 16 * 128;
    const int tid = threadIdx.x, tx = tid & 31, ty = tid >> 5;
    float acc[4][4], acc2[4][4];
#pragma unroll
    for (int i = 0; i < 4; ++i)
#pragma unroll
        for (int j = 0; j < 4; ++j) { acc[i][j] = 0.f; acc2[i][j] = 0.f; }
    const int ar = tid >> 3, ak = (tid & 7) * 2;
    const bf16* aptr = arow(tm * 64 + ar);
    const int wk = tid >> 5, wc = (tid & 31) * 4;
    for (int k0 = 0; k0 < K; k0 += 16) {
        unsigned av = aptr ? *(const unsigned*)(aptr + k0 + ak) : 0u;
        const f32x4 wv = *(const f32x4*)(W + (size_t)(k0 + wk) * ldw + tn * 128 + wc);
        f32x4 wv2; if (DUAL) wv2 = *(const f32x4*)(W2 + (size_t)(k0 + wk) * ldw + tn * 128 + wc);
        __syncthreads();
        As[ak * 68 + ar] = __builtin_bit_cast(float, av << 16); As[(ak + 1) * 68 + ar] = __builtin_bit_cast(float, av & 0xffff0000u);
        *(f32x4*)(Ws + wk * 128 + wc) = wv; if (DUAL) *(f32x4*)(Ws2 + wk * 128 + wc) = wv2;
        __syncthreads();
#pragma unroll
        for (int k = 0; k < 16; ++k) {
            const f32x4 a = *(const f32x4*)(As + k * 68 + ty * 4), w = *(const f32x4*)(Ws + k * 128 + tx * 4);
#pragma unroll
            for (int i = 0; i < 4; ++i)
#pragma unroll
                for (int j = 0; j < 4; ++j) acc[i][j] += a[i] * w[j];
            if (DUAL) { const f32x4 w2 = *(const f32x4*)(Ws2 + k * 128 + tx * 4);
#pragma unroll
                for (int i = 0; i < 4; ++i)
#pragma unroll
                    for (int j = 0; j < 4; ++j) acc2[i][j] += a[i] * w2[j]; }
        }
    }
#pragma unroll
    for (int i = 0; i < 4; ++i) epi(tm * 64 + ty * 4 + i, tn * 128 + tx * 4, acc[i], acc2[i]);
}
constexpr int NAIVE_LDS_FLOATS = 16 * 68 + 2 * 16 * 128;

struct ARowPlain { const bf16* A; int lda; __device__ __forceinline__ const bf16* operator()(int r) const { return A + (size_t)r * lda; } };
struct EpiInproj { bf16* U; __device__ __forceinline__ void operator()(int r, int c, const float (&a)[4], const float (&)[4]) const {
        const int t = c >> 9, cc = c & 511; const float s = (t == 1) ? C2 : 1.f;
        u32x2 o; o.x = pk2(a[0] * s, a[1] * s); o.y = pk2(a[2] * s, a[3] * s);
        *(u32x2*)(U + (size_t)t * ((WS_Q - WS_U) / 2) + (size_t)r * 512 + cc) = o; } };
__global__ void __launch_bounds__(512) k_inproj_naive(Params p) {
    __shared__ __attribute__((aligned(16))) float lds[NAIVE_LDS_FLOATS];
    ARowPlain ar{(const bf16*)(p.ws + WS_XN), DM}; EpiInproj ep{(bf16*)(p.ws + WS_U)};
    const int nM = T / 64, nN = 2048 / 128;
    for (int u = blockIdx.x; u < nM * nN; u += gridDim.x) naive_tile<ARowPlain, EpiInproj, false>(u / nN, u % nN, DM, ar, p.w_in, nullptr, INW, ep, lds);
}
struct EpiPool { bf16* CAT; const float* ps; int g; __device__ __forceinline__ void operator()(int r, int c, const float (&a)[4], const float (&)[4]) const {
        const int cc = g * 128 + c; const f32x4 s = *(const f32x4*)(ps + cc);
        u32x2 o; o.x = pk2(a[0] * s.x, a[1] * s.y); o.y = pk2(a[2] * s.z, a[3] * s.w);
        *(u32x2*)(CAT + (size_t)r * DM + cc) = o; } };
__global__ void __launch_bounds__(512) k_poolgemm_naive(Params p) {
    __shared__ __attribute__((aligned(16))) float lds[NAIVE_LDS_FLOATS];
    const int nM = T / 64;
    for (int u = blockIdx.x; u < nM * 4; u += gridDim.x) { const int g = u & 3, tm = u >> 2;
        ARowPlain ar{(const bf16*)(p.ws + WS_P) + g * 128, PW}; EpiPool ep{(bf16*)(p.ws + WS_CAT), p.pool_scale, g};
        naive_tile<ARowPlain, EpiPool, false>(tm, 0, 128, ar, p.w_pool + (size_t)g * 128 * 128, nullptr, 128, ep, lds); }
}
struct EpiOut { const float* x; float* out; __device__ __forceinline__ void operator()(int r, int c, const float (&a)[4], const float (&)[4]) const {
        const f32x4 xv = *(const f32x4*)(x + (size_t)r * DM + c); f32x4 o = {xv.x + a[0], xv.y + a[1], xv.z + a[2], xv.w + a[3]};
        *(f32x4*)(out + (size_t)r * DM + c) = o; } };
__global__ void __launch_bounds__(512) k_outproj_naive(Params p) {
    __shared__ __attribute__((aligned(16))) float lds[NAIVE_LDS_FLOATS];
    ARowPlain ar{(const bf16*)(p.ws + WS_CAT), DM}; EpiOut ep{p.x, p.out};
    const int nM = T / 64, nN = DM / 128;
    for (int u = blockIdx.x; u < nM * nN; u += gridDim.x) naive_tile<ARowPlain, EpiOut, false>(u / nN, u % nN, DM, ar, p.w_out, nullptr, DM, ep, lds);
}

__global__ void __launch_bounds__(512) k_attn_naive(Params p) {
    __shared__ __attribute__((aligned(16))) float Ks[64 * 68];
    __shared__ __attribute__((aligned(16))) float Vs[64 * 64];
    __shared__ float Ss[64 * 65];
    __shared__ float cs[64];
    const bf16* Q = (const bf16*)(p.ws + WS_Q); const bf16* K = (const bf16*)(p.ws + WS_K); const bf16* V = (const bf16*)(p.ws + WS_V);
    bf16* CAT = (bf16*)(p.ws + WS_CAT); const float* CUM = (const float*)(p.ws + WS_CUM);
    const int tid = threadIdx.x, r = tid >> 3, part = tid & 7;
    for (int u = blockIdx.x; u < BATCH * NH * (SEQ / 64); u += gridDim.x) {
        const int qb = (SEQ / 64 - 1) - (u / (BATCH * NH)), bh = u % (BATCH * NH), b = bh / NH, h = bh % NH;
        const size_t rowbase = (size_t)b * SEQ; const int t = qb * 64 + r;
        float q[64];
        { const bf16* qp = Q + (rowbase + t) * AW + h * HD;
#pragma unroll
          for (int i = 0; i < 64; i += 2) { const unsigned v = *(const unsigned*)(qp + i); q[i] = __builtin_bit_cast(float, v << 16); q[i + 1] = __builtin_bit_cast(float, v & 0xffff0000u); } }
        const float ct = CUM[(size_t)bh * SEQ + t];
        float o[8]; float m = -INFINITY, l = 0.f;
#pragma unroll
        for (int i = 0; i < 8; ++i) o[i] = 0.f;
        for (int kt = 0; kt <= qb; ++kt) {
            __syncthreads();
            { const int kr = tid >> 3, kc = (tid & 7) * 8;
              const u32x4 kv = *(const u32x4*)(K + (rowbase + kt * 64 + kr) * AW + h * HD + kc), vv = *(const u32x4*)(V + (rowbase + kt * 64 + kr) * AW + h * HD + kc);
              const unsigned ka[4] = {kv.x, kv.y, kv.z, kv.w}, va[4] = {vv.x, vv.y, vv.z, vv.w};
#pragma unroll
              for (int i = 0; i < 4; ++i) { Ks[kr * 68 + kc + 2 * i] = __builtin_bit_cast(float, ka[i] << 16); Ks[kr * 68 + kc + 2 * i + 1] = __builtin_bit_cast(float, ka[i] & 0xffff0000u);
                  Vs[kr * 64 + kc + 2 * i] = __builtin_bit_cast(float, va[i] << 16); Vs[kr * 64 + kc + 2 * i + 1] = __builtin_bit_cast(float, va[i] & 0xffff0000u); }
              if (tid < 64) cs[tid] = CUM[(size_t)bh * SEQ + kt * 64 + tid]; }
            __syncthreads();
            float lg[8]; float mx = -INFINITY;
#pragma unroll
            for (int j = 0; j < 8; ++j) { const int s = part * 8 + j; float d = 0.f;
#pragma unroll
                for (int i = 0; i < 64; i += 4) { const f32x4 kk = *(const f32x4*)(Ks + s * 68 + i); d += q[i] * kk.x + q[i + 1] * kk.y + q[i + 2] * kk.z + q[i + 3] * kk.w; }
                d += ct - cs[s]; if (kt * 64 + s > t) d = -INFINITY; lg[j] = d; mx = fmaxf(mx, d); }
            mx = fmaxf(mx, __shfl_xor(mx, 1)); mx = fmaxf(mx, __shfl_xor(mx, 2)); mx = fmaxf(mx, __shfl_xor(mx, 4));
            const float mn = fmaxf(m, mx); const float alpha = exp2f(m - mn); float ps = 0.f;
#pragma unroll
            for (int j = 0; j < 8; ++j) { const float pv = exp2f(lg[j] - mn); ps += pv; Ss[r * 65 + part * 8 + j] = pv; }
            ps += __shfl_xor(ps, 1); ps += __shfl_xor(ps, 2); ps += __shfl_xor(ps, 4);
            l = l * alpha + ps; m = mn;
#pragma unroll
            for (int i = 0; i < 8; ++i) o[i] *= alpha;
            __syncthreads();
            for (int s = 0; s < 64; ++s) { const float pv = Ss[r * 65 + s]; const f32x4 v0 = *(const f32x4*)(Vs + s * 64 + part * 8), v1 = *(const f32x4*)(Vs + s * 64 + part * 8 + 4);
                o[0] += pv * v0.x; o[1] += pv * v0.y; o[2] += pv * v0.z; o[3] += pv * v0.w; o[4] += pv * v1.x; o[5] += pv * v1.y; o[6] += pv * v1.z; o[7] += pv * v1.w; }
        }
        const float il = 1.f / l; u32x4 ov;
        ov.x = pk2(o[0] * il, o[1] * il); ov.y = pk2(o[2] * il, o[3] * il); ov.z = pk2(o[4] * il, o[5] * il); ov.w = pk2(o[6] * il, o[7] * il);
        *(u32x4*)(CAT + (rowbase + t) * DM + PW + h * HD + part * 8) = ov;
    }
}

__global__ void __launch_bounds__(512) k_router(Params p) {
    __shared__ __attribute__((aligned(16))) float wr[1024 * 32];
    __shared__ int ch_e[128 * 4]; __shared__ float ch_g[128 * 4]; __shared__ int lcnt[32], lbase[32];
    const int tid = threadIdx.x, lane = tid & 63, wave = tid >> 6;
    for (int i = tid; i < 1024 * 32 / 4; i += 512) ((f32x4*)wr)[i] = ((const f32x4*)p.w_router)[i];
    __syncthreads();
    const float* X1 = p.out; bf16* H2 = (bf16*)(p.ws + WS_XN);
    int* cnt = (int*)(p.ws + WS_CTL) + CW_CNT; int* SEL = (int*)(p.ws + WS_SEL); int* LTK = (int*)(p.ws + WS_LTK); float* LGT = (float*)(p.ws + WS_LGT);
    f32x4 g[4];
#pragma unroll
    for (int j = 0; j < 4; ++j) g[j] = *(const f32x4*)(p.g_ffn + 4 * lane + 256 * j);
    const float br = p.b_router[lane & 31];
    for (int grp = blockIdx.x; grp < T / 128; grp += gridDim.x) {
        if (tid < 32) lcnt[tid] = 0;
        __syncthreads();
        for (int it = 0; it < 16; ++it) {
            const int lt = wave * 16 + it, m = grp * 128 + lt;
            const float* xr = X1 + (size_t)m * DM;
            f32x4 v[4]; float ss = 0.f;
#pragma unroll
            for (int j = 0; j < 4; ++j) { v[j] = *(const f32x4*)(xr + 4 * lane + 256 * j); ss += v[j].x * v[j].x + v[j].y * v[j].y + v[j].z * v[j].z + v[j].w * v[j].w; }
            const float rstd = rsqrtf(wave_sum(ss) * (1.f / DM) + RMS_EPS);
            float lg[32];
#pragma unroll
            for (int e = 0; e < 32; ++e) lg[e] = 0.f;
#pragma unroll
            for (int j = 0; j < 4; ++j) {
                v[j] = v[j] * rstd * g[j];
                u32x2 o; o.x = pk2(v[j].x, v[j].y); o.y = pk2(v[j].z, v[j].w);
                *(u32x2*)(H2 + (size_t)m * DM + 4 * lane + 256 * j) = o;
#pragma unroll
                for (int i = 0; i < 4; ++i) { const int d = 4 * lane + 256 * j + i; const float hv = v[j][i];
#pragma unroll
                    for (int e4 = 0; e4 < 8; ++e4) { const f32x4 w = *(const f32x4*)(wr + d * 32 + e4 * 4);
                        lg[e4 * 4] += hv * w.x; lg[e4 * 4 + 1] += hv * w.y; lg[e4 * 4 + 2] += hv * w.z; lg[e4 * 4 + 3] += hv * w.w; }
                    asm volatile("" ::: "memory"); }
            }
            float mine;
            {
                float a16[16];
                const bool up = lane >= 32;
#pragma unroll
                for (int e = 0; e < 16; ++e) { const float keep = up ? lg[16 + e] : lg[e], give = up ? lg[e] : lg[16 + e]; a16[e] = keep + __shfl_xor(give, 32); }
                float a8[8]; const bool u16 = (lane & 16) != 0;
#pragma unroll
                for (int e = 0; e < 8; ++e) { const float keep = u16 ? a16[8 + e] : a16[e], give = u16 ? a16[e] : a16[8 + e]; a8[e] = keep + __shfl_xor(give, 16); }
                float a4[4]; const bool u8 = (lane & 8) != 0;
#pragma unroll
                for (int e = 0; e < 4; ++e) { const float keep = u8 ? a8[4 + e] : a8[e], give = u8 ? a8[e] : a8[4 + e]; a4[e] = keep + __shfl_xor(give, 8); }
                float a2[2]; const bool u4 = (lane & 4) != 0;
#pragma unroll
                for (int e = 0; e < 2; ++e) { const float keep = u4 ? a4[2 + e] : a4[e], give = u4 ? a4[e] : a4[2 + e]; a2[e] = keep + __shfl_xor(give, 4); }
                const bool u2 = (lane & 2) != 0;
                float a1 = (u2 ? a2[1] : a2[0]) + __shfl_xor(u2 ? a2[0] : a2[1], 2);
                a1 += __shfl_xor(a1, 1);
                mine = a1;
            }
            const int myexp = ((lane >> 5) & 1) * 16 + ((lane >> 4) & 1) * 8 + ((lane >> 3) & 1) * 4 + ((lane >> 2) & 1) * 2 + ((lane >> 1) & 1);
            float val = mine + p.b_router[myexp]; (void)br;
            if (lane & 1) val = -INFINITY;
            float tv[4]; int ti[4];
#pragma unroll
            for (int k = 0; k < 4; ++k) {
                float bv = val; int bi = myexp;
#pragma unroll
                for (int o = 1; o < 64; o <<= 1) { const float ov = __shfl_xor(bv, o); const int oi = __shfl_xor(bi, o); if (ov > bv || (ov == bv && oi < bi)) { bv = ov; bi = oi; } }
                tv[k] = bv; ti[k] = bi; if (myexp == bi) val = -INFINITY;
            }
            const float e0 = 1.f, e1 = expf(tv[1] - tv[0]), e2 = expf(tv[2] - tv[0]), e3 = expf(tv[3] - tv[0]); const float inv = 1.f / (e0 + e1 + e2 + e3);
            if (lane < 4) { const float gg = (lane == 0 ? e0 : lane == 1 ? e1 : lane == 2 ? e2 : e3) * inv; const int ee = lane == 0 ? ti[0] : lane == 1 ? ti[1] : lane == 2 ? ti[2] : ti[3];
                ch_e[lt * 4 + lane] = ee; ch_g[lt * 4 + lane] = gg; atomicAdd(&lcnt[ee], 1); }
        }
        __syncthreads();
        if (tid < 32) { lbase[tid] = atomicAdd(&cnt[tid], lcnt[tid]); lcnt[tid] = 0; }
        __syncthreads();
        { const int e = ch_e[tid]; const int slot = lbase[e] + atomicAdd(&lcnt[e], 1); const int tk = (grp * 128 + (tid >> 2)) * 4 + (tid & 3);
          LTK[(size_t)e * T + slot] = tk; LGT[(size_t)e * T + slot] = ch_g[tid]; SEL[tk] = (slot << 5) | e; }
        __syncthreads();
    }
}

struct ExpertMap { int cnt[32]; int pstart[33]; };
__device__ __forceinline__ void load_expert_map(const int* cnt, int* s_cnt, int* s_ps) {
    if (threadIdx.x == 0) { int a = 0; for (int e = 0; e < 32; ++e) { const int c = cnt[e]; s_cnt[e] = c; s_ps[e] = a; a += ((c + RT - 1) / RT) * RT; } s_ps[32] = a; }
}
struct ARowGather { const bf16* H2; const int* ltk; int pstart, cnt; __device__ __forceinline__ const bf16* operator()(int r) const { const int s = r - pstart; return s < cnt ? H2 + (size_t)(ltk[s] >> 2) * DM : nullptr; } };
struct EpiUp { bf16* ACT; const float* bu; __device__ __forceinline__ void operator()(int r, int c, const float (&a)[4], const float (&a2)[4]) const {
        const f32x4 bg = *(const f32x4*)(bu + c), bl = *(const f32x4*)(bu + DE + c); float o[4];
#pragma unroll
        for (int i = 0; i < 4; ++i) { const float gl = fminf(a[i] + bg[i], SW_LIMIT), li = fminf(fmaxf(a2[i] + bl[i], -SW_LIMIT), SW_LIMIT); o[i] = gl * (1.f / (1.f + expf(-SW_ALPHA * gl))) * (li + 1.f); }
        u32x2 ov; ov.x = pk2(o[0], o[1]); ov.y = pk2(o[2], o[3]); *(u32x2*)(ACT + (size_t)r * DE + c) = ov; } };
__global__ void __launch_bounds__(512) k_up_naive(Params p) {
    __shared__ __attribute__((aligned(16))) float lds[NAIVE_LDS_FLOATS]; __shared__ int s_cnt[32], s_ps[33];
    load_expert_map((const int*)(p.ws + WS_CTL) + CW_CNT, s_cnt, s_ps); __syncthreads();
    const int ntm = s_ps[32] / 64, nN = DE / 128;
    for (int u = blockIdx.x; u < ntm * nN; u += gridDim.x) { const int tm = u / nN, tn = u % nN; int e = 0; while (s_ps[e + 1] <= tm * 64) ++e;
        if (tm * 64 - s_ps[e] >= s_cnt[e]) continue;
        ARowGather ar{(const bf16*)(p.ws + WS_XN), (const int*)(p.ws + WS_LTK) + (size_t)e * T, s_ps[e], s_cnt[e]}; EpiUp ep{(bf16*)(p.ws + WS_ACT), p.b_up + (size_t)e * 2 * DE};
        naive_tile<ARowGather, EpiUp, true>(tm, tn, DM, ar, p.w_up + (size_t)e * DM * 2 * DE, p.w_up + (size_t)e * DM * 2 * DE + DE, 2 * DE, ep, lds); }
}
struct ARowAct { const bf16* ACT; int pstart, cnt; __device__ __forceinline__ const bf16* operator()(int r) const { return (r - pstart) < cnt ? ACT + (size_t)r * DE : nullptr; } };
struct EpiDown { bf16* Y; const float* bd; const float* lgt; int pstart, cnt; __device__ __forceinline__ void operator()(int r, int c, const float (&a)[4], const float (&)[4]) const {
        const int s = r - pstart; if (s >= cnt) return; const float gt = lgt[s]; const f32x4 b = *(const f32x4*)(bd + c);
        u32x2 ov; ov.x = pk2((a[0] + b.x) * gt, (a[1] + b.y) * gt); ov.y = pk2((a[2] + b.z) * gt, (a[3] + b.w) * gt); *(u32x2*)(Y + (size_t)r * DM + c) = ov; } };
__global__ void __launch_bounds__(512) k_down_naive(Params p) {
    __shared__ __attribute__((aligned(16))) float lds[NAIVE_LDS_FLOATS]; __shared__ int s_cnt[32], s_ps[33];
    load_expert_map((const int*)(p.ws + WS_CTL) + CW_CNT, s_cnt, s_ps); __syncthreads();
    const int ntm = s_ps[32] / 64, nN = DM / 128;
    for (int u = blockIdx.x; u < ntm * nN; u += gridDim.x) { const int tm = u / nN, tn = u % nN; int e = 0; while (s_ps[e + 1] <= tm * 64) ++e;
        if (tm * 64 - s_ps[e] >= s_cnt[e]) continue;
        ARowAct ar{(const bf16*)(p.ws + WS_ACT), s_ps[e], s_cnt[e]}; EpiDown ep{(bf16*)(p.ws + WS_Y), p.b_down + (size_t)e * DM, (const float*)(p.ws + WS_LGT) + (size_t)e * T, s_ps[e], s_cnt[e]};
        naive_tile<ARowAct, EpiDown, false>(tm, tn, DE, ar, p.w_down + (size_t)e * DE * DM, nullptr, DM, ep, lds); }
}

__global__ void __launch_bounds__(512) k_final(Params p) {
    __shared__ int s_cnt[32], s_ps[33];
    load_expert_map((const int*)(p.ws + WS_CTL) + CW_CNT, s_cnt, s_ps); __syncthreads();
    const int tid = threadIdx.x, lane = tid & 63, wave = tid >> 6;
    const int* SEL = (const int*)(p.ws + WS_SEL); const bf16* Y = (const bf16*)(p.ws + WS_Y);
    f32x4 g[4];
#pragma unroll
    for (int j = 0; j < 4; ++j) g[j] = *(const f32x4*)(p.g_final + 4 * lane + 256 * j);
    for (int m = blockIdx.x * 8 + wave; m < T; m += gridDim.x * 8) {
        float* xr = p.out + (size_t)m * DM; f32x4 v[4];
#pragma unroll
        for (int j = 0; j < 4; ++j) v[j] = *(const f32x4*)(xr + 4 * lane + 256 * j);
#pragma unroll
        for (int k = 0; k < 4; ++k) { const int sv = SEL[m * 4 + k]; const int e = sv & 31, slot = sv >> 5; const bf16* yr = Y + (size_t)(s_ps[e] + slot) * DM;
#pragma unroll
            for (int j = 0; j < 4; ++j) { const u32x2 y = *(const u32x2*)(yr + 4 * lane + 256 * j);
                v[j].x += __builtin_bit_cast(float, y.x << 16); v[j].y += __builtin_bit_cast(float, y.x & 0xffff0000u); v[j].z += __builtin_bit_cast(float, y.y << 16); v[j].w += __builtin_bit_cast(float, y.y & 0xffff0000u); } }
        float ss = 0.f;
#pragma unroll
        for (int j = 0; j < 4; ++j) ss += v[j].x * v[j].x + v[j].y * v[j].y + v[j].z * v[j].z + v[j].w * v[j].w;
        const float rstd = rsqrtf(wave_sum(ss) * (1.f / DM) + RMS_EPS);
#pragma unroll
        for (int j = 0; j < 4; ++j) *(f32x4*)(xr + 4 * lane + 256 * j) = v[j] * rstd * g[j];
    }
}

namespace pg8 {
#define PG8_LAS __attribute__((address_space(3)))
typedef unsigned short bf16_t;
typedef short bf16x8 __attribute__((ext_vector_type(8)));
typedef float f32x4 __attribute__((ext_vector_type(4)));
typedef unsigned u32x4 __attribute__((ext_vector_type(4)));
constexpr int BM = 256, BK = 64, HALF = 128, HTB = HALF * BK * 2  , STAGE_BYTES = 8 * HTB, NXCD = 8, WGM = 8;

__host__ __device__ __forceinline__ int lds_byte(int r, int c) { const int ch = (c >> 3) ^ ((r >> 1) & 7); return (r >> 3) * 1024 + (r & 7) * 128 + ch * 16 + (c & 7) * 2; }
__host__ __device__ __forceinline__ void stage_rc(int b, int& R, int& C) { const int st = b >> 10, sb = b & 1023; R = st * 8 + (sb >> 7); C = ((((sb >> 4) & 7) ^ ((R >> 1) & 7)) * 8); }
__host__ __device__ __forceinline__ int perm32(int rho) { const int n = rho >> 4, i = rho & 15; return 8 * (i >> 2) + 4 * n + (i & 3); }

struct Unit { int pm, pn, e, lrow0; size_t boff; };
struct Gemm { const bf16_t* A; const bf16_t* Bt; int K; };

struct StaticOrder {
    int nM, nN, nwg, G, c;
    __host__ __device__ void init(int M, int N, int G_, int c_) { nM = M / BM; nN = N / BM; nwg = nM * nN; G = G_; c = c_; }
    __host__ __device__ bool next(int i, Unit& u) const {
        const long L = (long)i * G + c; if (L >= nwg) return false;
        int wgid = (int)L; { const int q = nwg / NXCD, r = nwg % NXCD, xcd = wgid % NXCD, off = wgid / NXCD; wgid = (xcd < r ? xcd * (q + 1) : r * (q + 1) + (xcd - r) * q) + off; }
        const int nig = WGM * nN, gid = wgid / nig, fm = gid * WGM, gsz = (nM - fm) < WGM ? (nM - fm) : WGM;
        u.pm = fm + ((wgid % nig) % gsz); u.pn = (wgid % nig) / gsz; u.e = 0; u.lrow0 = 0; u.boff = 0; return true;
    }
};
template <int NCOL> struct MoeOrder {
    static constexpr int RG = 32 / NCOL;
    const PG8_LAS int* ul; size_t bstride;
    static __device__ __forceinline__ void build(PG8_LAS int* ul, const PG8_LAS int* pt, int c, int tid) {
        const int nrt = pt[32]; const int x = c & 7, j = c >> 3;
        const int lo = (nrt * x) >> 3, hi = (nrt * (x + 1)) >> 3;
        if (tid < 32) { const int rt = lo + RG * tid + j / NCOL;
            if (rt < hi) { int e = 0; for (int k = 1; k < 32; ++k) e += (pt[k] <= rt) ? 1 : 0;
                ul[4 + 4 * tid] = rt; ul[5 + 4 * tid] = j % NCOL; ul[6 + 4 * tid] = e; ul[7 + 4 * tid] = (rt - pt[e]) * BM; } }
        if (tid == 0) { const int span = hi - (lo + j / NCOL); ul[0] = span > 0 ? (span + RG - 1) / RG : 0; }
        __syncthreads();
    }
    __device__ __forceinline__ bool next(int i, Unit& u) const {
        if (i >= ul[0]) return false;
        u.pm = ul[4 + 4 * i]; u.pn = ul[5 + 4 * i]; u.e = ul[6 + 4 * i]; u.lrow0 = ul[7 + 4 * i]; u.boff = (size_t)u.e * bstride; return true;
    }
};

__device__ __forceinline__ unsigned cvt_pk_bf16(float lo, float hi) { unsigned r; asm volatile("v_cvt_pk_bf16_f32 %0, %1, %2" : "=v"(r) : "v"(lo), "v"(hi)); return r; }

struct EpiInproj {
    static constexpr bool PERM = true; static constexpr int NST = 16;
    bf16_t* O; size_t split_stride; float qscale; unsigned* nrm;
    __device__ __forceinline__ void operator()(const f32x4 (&acc)[2][2][4][2], const Unit& u, int wr, int wc, int fr, int fq) const {
        const int row0 = u.pm * BM + wr * 64 + fr; int colt = u.pn * BM; const int t = colt >> 9; bf16_t* base = O + (size_t)t * split_stride; colt -= t * 512;
        const float sc = (t == 1) ? qscale : 1.f; const int col0 = colt + wc * 32 + 8 * fq;
#pragma unroll
        for (int ai = 0; ai < 2; ++ai)
#pragma unroll
            for (int m = 0; m < 4; ++m) { bf16_t* rowp = base + (size_t)(row0 + ai * HALF + m * 16) * 512 + col0;
#pragma unroll
                for (int bj = 0; bj < 2; ++bj) { const f32x4 v0 = acc[ai][bj][m][0] * sc, v1 = acc[ai][bj][m][1] * sc;
                    u32x4 w; w.x = cvt_pk_bf16(v0[0], v0[1]); w.y = cvt_pk_bf16(v0[2], v0[3]); w.z = cvt_pk_bf16(v1[0], v1[1]); w.w = cvt_pk_bf16(v1[2], v1[3]);
                    *(u32x4*)(rowp + bj * HALF) = w; } }
        if (t == 1 || t == 2) {
            float mx[2] = {0.f, 0.f};
#pragma unroll
            for (int ai = 0; ai < 2; ++ai)
#pragma unroll
                for (int m = 0; m < 4; ++m)
#pragma unroll
                    for (int bj = 0; bj < 2; ++bj) { const f32x4 v0 = acc[ai][bj][m][0] * sc, v1 = acc[ai][bj][m][1] * sc;
                        float s8 = v0[0] * v0[0] + v0[1] * v0[1] + v0[2] * v0[2] + v0[3] * v0[3] + v1[0] * v1[0] + v1[1] * v1[1] + v1[2] * v1[2] + v1[3] * v1[3];
                        s8 += __shfl_xor(s8, 16); s8 += __shfl_xor(s8, 32); mx[bj] = fmaxf(mx[bj], s8); }
#pragma unroll
            for (int bj = 0; bj < 2; ++bj) {
#pragma unroll
                for (int o = 1; o < 16; o <<= 1) mx[bj] = fmaxf(mx[bj], __shfl_xor(mx[bj], o));
                if ((threadIdx.x & 63) == 0) { const int head = ((u.pn & 1) * 256 + bj * HALF + wc * 32) >> 6, b = (u.pm * BM) >> 13;
                    atomicMax(nrm + (t - 1) * 32 + b * 8 + head, __float_as_uint(mx[bj] * 1.01f)); } }
        }
    }
};
struct EpiResBf16 {
    static constexpr bool PERM = true; static constexpr int NST = 16;
    const float* x; bf16_t* out;
    __device__ __forceinline__ void operator()(const f32x4 (&acc)[2][2][4][2], const Unit& u, int wr, int wc, int fr, int fq) const {
        const int row0 = u.pm * BM + wr * 64 + fr, col0 = u.pn * BM + wc * 32 + 8 * fq;
        f32x4 xa[2][2][2], xb[2][2][2];
#define PG8_XLOAD(dst, b) do { _Pragma("unroll") for (int mm = 0; mm < 2; ++mm) { const size_t off_ = (size_t)(row0 + ((b) >> 1) * HALF + (((b) & 1) * 2 + mm) * 16) * 1024 + col0; \
            _Pragma("unroll") for (int bj = 0; bj < 2; ++bj) { dst[mm][bj][0] = *(const f32x4*)(x + off_ + bj * HALF); dst[mm][bj][1] = *(const f32x4*)(x + off_ + bj * HALF + 4); } } } while (0)
#define PG8_XSTORE(src, b) do { _Pragma("unroll") for (int mm = 0; mm < 2; ++mm) { const int ai = (b) >> 1, m = ((b) & 1) * 2 + mm; const size_t off_ = (size_t)(row0 + ai * HALF + m * 16) * 1024 + col0; \
            _Pragma("unroll") for (int bj = 0; bj < 2; ++bj) { const f32x4 v0 = src[mm][bj][0] + acc[ai][bj][m][0], v1 = src[mm][bj][1] + acc[ai][bj][m][1]; \
                u32x4 w; w.x = cvt_pk_bf16(v0[0], v0[1]); w.y = cvt_pk_bf16(v0[2], v0[3]); w.z = cvt_pk_bf16(v1[0], v1[1]); w.w = cvt_pk_bf16(v1[2], v1[3]); *(u32x4*)(out + off_ + bj * HALF) = w; } } } while (0)
        PG8_XLOAD(xa, 0); PG8_XLOAD(xb, 1);
        asm volatile("" ::: "memory");
        PG8_XSTORE(xa, 0); PG8_XLOAD(xa, 2);
        asm volatile("" ::: "memory");
        PG8_XSTORE(xb, 1); PG8_XLOAD(xb, 3);
        asm volatile("" ::: "memory");
        PG8_XSTORE(xa, 2);
        PG8_XSTORE(xb, 3);
#undef PG8_XLOAD
#undef PG8_XSTORE
    }
};
__device__ __forceinline__ float swiglu1(float g, float l) {
    const float gl = fminf(g, 7.0f), li = fminf(fmaxf(l, -7.0f), 7.0f);
    const float sg = __builtin_amdgcn_rcpf(1.0f + __builtin_amdgcn_exp2f(gl * (-1.702f * 1.4426950408889634f)));
    return gl * sg * (li + 1.0f);
}
struct EpiSwiglu {
    static constexpr bool PERM = true; static constexpr int NST = 8;
    bf16_t* ACT; const float* bup;
    __device__ __forceinline__ void operator()(const f32x4 (&acc)[2][2][4][2], const Unit& u, int wr, int wc, int fr, int fq) const {
        const int row0 = u.pm * BM + wr * 64 + fr, col0 = u.pn * HALF + wc * 32 + 8 * fq;
        const float* bb = bup + (size_t)u.e * 2048 + col0;
        f32x4 bg[2], bl[2];
#pragma unroll
        for (int n = 0; n < 2; ++n) { bg[n] = *(const f32x4*)(bb + 4 * n); bl[n] = *(const f32x4*)(bb + 1024 + 4 * n); }
#pragma unroll
        for (int ai = 0; ai < 2; ++ai)
#pragma unroll
            for (int m = 0; m < 4; ++m) { bf16_t* rowp = ACT + (size_t)(row0 + ai * HALF + m * 16) * 1024 + col0;
                const f32x4 g0 = acc[ai][0][m][0] + bg[0], g1 = acc[ai][0][m][1] + bg[1], l0 = acc[ai][1][m][0] + bl[0], l1 = acc[ai][1][m][1] + bl[1];
                u32x4 w; w.x = cvt_pk_bf16(swiglu1(g0[0], l0[0]), swiglu1(g0[1], l0[1])); w.y = cvt_pk_bf16(swiglu1(g0[2], l0[2]), swiglu1(g0[3], l0[3]));
                w.z = cvt_pk_bf16(swiglu1(g1[0], l1[0]), swiglu1(g1[1], l1[1])); w.w = cvt_pk_bf16(swiglu1(g1[2], l1[2]), swiglu1(g1[3], l1[3]));
                *(u32x4*)rowp = w; }
    }
};

constexpr float FP8_SA = 4.0f, FP8_SW = 256.0f, FP8_INV = 1.0f / (FP8_SA * FP8_SW), FP8_SY = 16.0f;
__device__ __forceinline__ unsigned pack4_fp8(float a, float b, float c, float d) { unsigned p = 0; p = __builtin_amdgcn_cvt_pk_fp8_f32(a, b, p, false); p = __builtin_amdgcn_cvt_pk_fp8_f32(c, d, p, true); return p; }
struct EpiSwiglu8 {
    static constexpr bool PERM = true; static constexpr int NST = 8;
    unsigned char* ACT; const float* bup;
    __device__ __forceinline__ void operator()(const f32x4 (&acc)[2][2][4][2], const Unit& u, int wr, int wc, int fr, int fq) const {
        const int row0 = u.pm * BM + wr * 64 + fr, col0 = u.pn * HALF + wc * 32 + 8 * fq;
        const float* bb = bup + (size_t)u.e * 2048 + col0;
        f32x4 bg[2], bl[2];
#pragma unroll
        for (int n = 0; n < 2; ++n) { bg[n] = *(const f32x4*)(bb + 4 * n); bl[n] = *(const f32x4*)(bb + 1024 + 4 * n); }
#pragma unroll
        for (int ai = 0; ai < 2; ++ai)
#pragma unroll
            for (int m = 0; m < 4; ++m) { unsigned char* rowp = ACT + (size_t)(row0 + ai * HALF + m * 16) * 1024 + col0;
                const f32x4 g0 = acc[ai][0][m][0] * FP8_INV + bg[0], g1 = acc[ai][0][m][1] * FP8_INV + bg[1], l0 = acc[ai][1][m][0] * FP8_INV + bl[0], l1 = acc[ai][1][m][1] * FP8_INV + bl[1];
                typedef unsigned u32x2_t __attribute__((ext_vector_type(2))); u32x2_t w;
                w.x = pack4_fp8(swiglu1(g0[0], l0[0]) * FP8_SA, swiglu1(g0[1], l0[1]) * FP8_SA, swiglu1(g0[2], l0[2]) * FP8_SA, swiglu1(g0[3], l0[3]) * FP8_SA);
                w.y = pack4_fp8(swiglu1(g1[0], l1[0]) * FP8_SA, swiglu1(g1[1], l1[1]) * FP8_SA, swiglu1(g1[2], l1[2]) * FP8_SA, swiglu1(g1[3], l1[3]) * FP8_SA);
                *(u32x2_t*)rowp = w; }
    }
};
struct EpiDown {
    static constexpr bool PERM = true; static constexpr int NST = 16;
    unsigned char* Y; const float* bdn; const float* lgt; const PG8_LAS int* cnt; int Ttok; float ascale;
    __device__ __forceinline__ void operator()(const f32x4 (&acc)[2][2][4][2], const Unit& u, int wr, int wc, int fr, int fq) const {
        const int rl = wr * 64 + fr, col0 = u.pn * BM + wc * 32 + 8 * fq; const int ce = cnt[u.e];
        const float* bb = bdn + (size_t)u.e * 1024 + col0; const float* gp = lgt + (size_t)u.e * Ttok + u.lrow0;
        f32x4 bv[2][2];
#pragma unroll
        for (int bj = 0; bj < 2; ++bj)
#pragma unroll
            for (int n = 0; n < 2; ++n) bv[bj][n] = *(const f32x4*)(bb + bj * HALF + 4 * n);
#pragma unroll
        for (int ai = 0; ai < 2; ++ai)
#pragma unroll
            for (int m = 0; m < 4; ++m) { const int r = rl + ai * HALF + m * 16; const float gt = (u.lrow0 + r < ce) ? gp[r] * FP8_SY : 0.f;
                unsigned char* rowp = Y + (size_t)(u.pm * BM + r) * 1024 + col0;
#pragma unroll
                for (int bj = 0; bj < 2; ++bj) { const f32x4 v0 = (acc[ai][bj][m][0] * ascale + bv[bj][0]) * gt, v1 = (acc[ai][bj][m][1] * ascale + bv[bj][1]) * gt;
                    typedef unsigned u32x2_t __attribute__((ext_vector_type(2))); u32x2_t w; w.x = pack4_fp8(v0[0], v0[1], v0[2], v0[3]); w.y = pack4_fp8(v1[0], v1[1], v1[2], v1[3]);
                    *(u32x2_t*)(rowp + bj * HALF) = w; } }
    }
};

typedef int v4i_t __attribute__((ext_vector_type(4)));
typedef int v8i_t __attribute__((ext_vector_type(8)));
template <class Epi, class Sched, bool ALIGN_EPI, bool GATHER, bool FP8 = false>
__device__ __forceinline__ void gemm_phase(PG8_LAS unsigned char* lds, const Gemm g, const Sched& S, const Epi& E, const PG8_LAS unsigned* tab, volatile PG8_LAS unsigned* prb = nullptr) {
    const int tid = threadIdx.x, wid = __builtin_amdgcn_readfirstlane(tid >> 6), lane = tid & 63, wr = wid >> 2, wc = wid & 3, fr = lane & 15, fq = lane >> 4;
    const int K = g.K, nt = K / BK;
    unsigned voffA[2], voffB[2], cby[2]; int rsl[2];
#pragma unroll
    for (int i = 0; i < 2; ++i) { int R, C; stage_rc(tid * 16 + i * 8192, R, C); const int Rb = Epi::PERM ? ((R & ~31) + perm32(R & 31)) : R;
        voffA[i] = (unsigned)(R * K + C) * 2u; voffB[i] = (unsigned)(Rb * K + C) * 2u; rsl[i] = R; cby[i] = (unsigned)C * 2u; }
    const size_t kstep = (size_t)(BK * 2);
    const size_t hstep = (size_t)HALF * K * 2;
    const size_t tstep = 2 * hstep;
    const size_t ahstep = GATHER ? 0 : hstep;
    const unsigned ldsw = (unsigned)wid * 1024u;
    const int aoff0 = lds_byte(wr * 64 + fr, fq * 8), aoff1 = lds_byte(wr * 64 + fr, 32 + fq * 8), boff0 = lds_byte(wc * 32 + fr, fq * 8), boff1 = lds_byte(wc * 32 + fr, 32 + fq * 8);
#define PG8_SA(b, h) (((b) * 2 + (h)) * HTB)
#define PG8_SB(b, h) ((4 + (b) * 2 + (h)) * HTB)
#define PG8_STAGE(bufoff, gbase, voff) do { _Pragma("unroll") for (int _i = 0; _i < 2; ++_i) \
        __builtin_amdgcn_global_load_lds((const unsigned*)((const char*)(gbase) + (voff)[_i]), (PG8_LAS unsigned*)(lds + (bufoff) + ldsw + _i * 8192), 16, 0, 0); } while (0)
#define PG8_LD16(off) (*(const PG8_LAS v4i_t*)(lds + (off)))
#define PG8_LDA(dst, b, h) do { _Pragma("unroll") for (int m = 0; m < 4; ++m) { if constexpr (FP8) dst##8[m] = __builtin_shufflevector(PG8_LD16(PG8_SA(b, h) + aoff0 + m * 2048), PG8_LD16(PG8_SA(b, h) + aoff1 + m * 2048), 0, 1, 2, 3, 4, 5, 6, 7); \
        else { _Pragma("unroll") for (int k = 0; k < 2; ++k) dst[m][k] = *(const PG8_LAS bf16x8*)(lds + PG8_SA(b, h) + (k ? aoff1 : aoff0) + m * 2048); } } } while (0)
#define PG8_LDB(dst, b, h) do { _Pragma("unroll") for (int n = 0; n < 2; ++n) { if constexpr (FP8) dst##8[n] = __builtin_shufflevector(PG8_LD16(PG8_SB(b, h) + boff0 + n * 2048), PG8_LD16(PG8_SB(b, h) + boff1 + n * 2048), 0, 1, 2, 3, 4, 5, 6, 7); \
        else { _Pragma("unroll") for (int k = 0; k < 2; ++k) dst[n][k] = *(const PG8_LAS bf16x8*)(lds + PG8_SB(b, h) + (k ? boff1 : boff0) + n * 2048); } } } while (0)
#define PG8_MMA(ai, bj, At, Bt) do { __builtin_amdgcn_s_setprio(1); _Pragma("unroll") for (int m = 0; m < 4; ++m) _Pragma("unroll") for (int n = 0; n < 2; ++n) { \
        if constexpr (FP8) asm volatile("v_mfma_f32_16x16x128_f8f6f4 %0, %1, %2, %0" : "+v"(acc[ai][bj][m][n]) : "v"(Bt##8[n]), "v"(At##8[m]));   \
        else { _Pragma("unroll") for (int k = 0; k < 2; ++k) acc[ai][bj][m][n] = __builtin_amdgcn_mfma_f32_16x16x32_bf16(Bt[n][k], At[m][k], acc[ai][bj][m][n], 0, 0, 0); } } \
        __builtin_amdgcn_s_setprio(0); } while (0)
#define PG8_WAIT_V(n) asm volatile("s_waitcnt vmcnt(" #n ")" ::: "memory")
#define PG8_WAIT_L(n) asm volatile("s_waitcnt lgkmcnt(" #n ")" ::: "memory")
#define PG8_WAIT_V8X(relax) asm volatile("s_cmp_eq_u32 %0, 0\n\ts_cbranch_scc1 1f\n\ts_waitcnt vmcnt(%1)\n\ts_branch 2f\n1:\n\ts_waitcnt vmcnt(8)\n2:" :: "s"(relax), "n"(8 + Epi::NST) : "memory", "scc")
#define PG8_BAR __builtin_amdgcn_s_barrier()
#define PG8_SCHED __builtin_amdgcn_sched_barrier(0)
    Unit cur, nxt; int ui = 0;
    if (!S.next(0, cur)) return;
    f32x4 acc[2][2][4][2];
#pragma unroll
    for (int a = 0; a < 2; ++a)
#pragma unroll
        for (int b = 0; b < 2; ++b)
#pragma unroll
            for (int m = 0; m < 4; ++m)
#pragma unroll
                for (int n = 0; n < 2; ++n) acc[a][b][m][n] = (f32x4){0.f, 0.f, 0.f, 0.f};
    bf16x8 At[4][2], B0[2][2], B1[2][2]; v8i_t At8[4], B08[2], B18[2];
    const char* cA = GATHER ? (const char*)g.A : (const char*)g.A + (size_t)cur.pm * tstep; const char* cB = (const char*)g.Bt + cur.boff + (size_t)cur.pn * tstep;
    unsigned cv0[2], cv1[2], nv0[2], nv1[2];
#pragma unroll
    for (int i = 0; i < 2; ++i) { if constexpr (GATHER) { cv0[i] = tab[rsl[i]] + cby[i]; cv1[i] = tab[HALF + rsl[i]] + cby[i]; } else { cv0[i] = voffA[i]; cv1[i] = voffA[i]; } nv0[i] = cv0[i]; nv1[i] = cv1[i]; }
    PG8_STAGE(PG8_SB(0, 0), cB, voffB); PG8_STAGE(PG8_SB(0, 1), cB + hstep, voffB); PG8_STAGE(PG8_SA(0, 0), cA, cv0); PG8_STAGE(PG8_SA(0, 1), cA + ahstep, cv1);
    if (wr == 1) PG8_BAR;
    PG8_WAIT_V(2); PG8_BAR;
    PG8_STAGE(PG8_SB(1, 0), cB + kstep, voffB); PG8_STAGE(PG8_SA(1, 0), cA + kstep, cv0); PG8_STAGE(PG8_SB(1, 1), cB + hstep + kstep, voffB);
    PG8_WAIT_V(6); PG8_BAR;
    for (;;) {
        const bool has_next = S.next(ui + 1, nxt);
        const char* nA = has_next ? (GATHER ? (const char*)g.A : (const char*)g.A + (size_t)nxt.pm * tstep) : cA; const char* nB = has_next ? (const char*)g.Bt + nxt.boff + (size_t)nxt.pn * tstep : cB;
        if constexpr (GATHER) {
#pragma unroll
            for (int i = 0; i < 2; ++i) { if (has_next) { nv0[i] = tab[(ui + 1) * BM + rsl[i]] + cby[i]; nv1[i] = tab[(ui + 1) * BM + HALF + rsl[i]] + cby[i]; } else { nv0[i] = cv0[i]; nv1[i] = cv1[i]; } }
        }
        for (int t = 0; t < nt; t += 2) {
            const bool last = (t == nt - 2);
            const char* a1 = cA + (size_t)(t + 1) * kstep;
            const char* a2 = last ? nA : cA + (size_t)(t + 2) * kstep; const char* b2 = last ? nB : cB + (size_t)(t + 2) * kstep;
            const char* a3 = a2 + kstep; const char* b3 = b2 + kstep;
            unsigned s0[2], s1[2];
#pragma unroll
            for (int i = 0; i < 2; ++i) { s0[i] = last ? nv0[i] : cv0[i]; s1[i] = last ? nv1[i] : cv1[i]; }
            PG8_LDB(B0, 0, 0); PG8_LDB(B1, 0, 1); PG8_SCHED; PG8_LDA(At, 0, 0); PG8_STAGE(PG8_SA(1, 1), a1 + ahstep, cv1);
            PG8_WAIT_V(8); PG8_WAIT_L(0); PG8_BAR; PG8_MMA(0, 0, At, B0); PG8_MMA(0, 1, At, B1); PG8_BAR; PG8_SCHED;
            PG8_LDA(At, 0, 1); PG8_STAGE(PG8_SB(0, 0), b2, voffB); PG8_STAGE(PG8_SB(0, 1), b2 + hstep, voffB); PG8_STAGE(PG8_SA(0, 0), a2, s0);
            PG8_WAIT_V(8); PG8_WAIT_L(0); PG8_BAR; PG8_MMA(1, 0, At, B0); PG8_MMA(1, 1, At, B1); PG8_BAR; PG8_SCHED;
            PG8_LDB(B0, 1, 0); PG8_LDB(B1, 1, 1); PG8_SCHED; PG8_LDA(At, 1, 0); PG8_STAGE(PG8_SA(0, 1), a2 + ahstep, s1);
            PG8_WAIT_V(8); PG8_WAIT_L(0); PG8_BAR; PG8_MMA(0, 0, At, B0); PG8_MMA(0, 1, At, B1); PG8_BAR; PG8_SCHED;
            PG8_LDA(At, 1, 1); PG8_STAGE(PG8_SB(1, 0), b3, voffB); PG8_STAGE(PG8_SB(1, 1), b3 + hstep, voffB); PG8_STAGE(PG8_SA(1, 0), a3, s0);
            PG8_WAIT_V(8); PG8_WAIT_L(0); PG8_BAR; PG8_MMA(1, 0, At, B0); PG8_MMA(1, 1, At, B1); PG8_BAR; PG8_SCHED;
        }
        unsigned long long pt0_ = 0; if (prb) pt0_ = __builtin_amdgcn_s_memrealtime();
        if constexpr (FP8) asm volatile("s_nop 15\n\ts_nop 7" ::: "memory");
        if constexpr (ALIGN_EPI) { if (wr == 0) PG8_BAR; }
        E(acc, cur, wr, wc, fr, fq);
        if (prb) { asm volatile("s_waitcnt vmcnt(0)" ::: "memory"); if (threadIdx.x == 0) prb[0] += (unsigned)(__builtin_amdgcn_s_memrealtime() - pt0_); }
        if (!has_next) break;
#pragma unroll
        for (int a = 0; a < 2; ++a)
#pragma unroll
            for (int b = 0; b < 2; ++b)
#pragma unroll
                for (int m = 0; m < 4; ++m)
#pragma unroll
                    for (int n = 0; n < 2; ++n) acc[a][b][m][n] = (f32x4){0.f, 0.f, 0.f, 0.f};
        cur = nxt; cA = nA; cB = nB; ++ui;
#pragma unroll
        for (int i = 0; i < 2; ++i) { cv0[i] = nv0[i]; cv1[i] = nv1[i]; }
        if constexpr (ALIGN_EPI) { if (wr == 1) PG8_BAR; }
    }
    PG8_WAIT_V(0);
    if constexpr (!ALIGN_EPI) { if (wr == 0) PG8_BAR; }
    PG8_BAR;
#undef PG8_SA
#undef PG8_SB
#undef PG8_STAGE
#undef PG8_LDA
#undef PG8_LD16
#undef PG8_LDB
#undef PG8_MMA
#undef PG8_WAIT_V
#undef PG8_WAIT_L
#undef PG8_WAIT_V8X
#undef PG8_BAR
#undef PG8_SCHED
}
}
#include <hip/hip_bf16.h>
#include <cmath>
namespace attn_body {
using bf16=__hip_bfloat16;
using bf16x8=__attribute__((ext_vector_type(8)))short;
using s16x4=__attribute__((ext_vector_type(4)))short;
using f32x16=__attribute__((ext_vector_type(16)))float;
using u32x4=__attribute__((ext_vector_type(4)))unsigned;
constexpr int BATCH=4,NHEAD=8,SEQ=8192,D=64,DM=NHEAD*D,ODM=1024;
constexpr int NW=8,QBLK=32,QB=QBLK*NW,KVBLK=64,NQB=SEQ/QB;
constexpr int ATTN_PITCH=DM, ATTN_UNIT_ROWS=QB;
__device__ __forceinline__ int crow(int r,int hi){return (r&3)+8*(r>>2)+4*hi;}
#define SBAR() __builtin_amdgcn_sched_barrier(0)
__device__ __forceinline__ void cmask(f32x16&p0,f32x16&p1,int jb,int qrel,int hi){
  const float NEG=-INFINITY; int kb=64*jb+4*hi;
  #pragma unroll
  for(int r=0;r<16;++r){int kv=kb+(r&3)+8*(r>>2); if(kv>qrel)p0[r]=NEG; if(kv+32>qrel)p1[r]=NEG;}
}

constexpr int NSLOT=3, SLOTB=8192;
constexpr int LDS_K=0, LDS_V=NSLOT*SLOTB, LDS_WS=2*NSLOT*SLOTB, LDS_OST=LDS_WS+NW*64*4, LDS_C2=LDS_OST+NW*4096, LDS_BYTES=LDS_C2+SEQ*4;
constexpr float C2=0.125f*1.4426950408889634f;
__device__ __forceinline__ void glds16(const void*gsrc,unsigned lds_dst){unsigned keep;
  asm volatile("s_mov_b32 %0, m0\n\ts_mov_b32 m0, %2\n\ts_nop 0\n\tglobal_load_lds_dwordx4 %1, off\n\ts_mov_b32 m0, %0":"=&s"(keep):"v"(gsrc),"s"(lds_dst):"memory");}
__device__ __forceinline__ float max3f(float a,float b,float c){float r;asm("v_max3_f32 %0, %1, %2, %3":"=v"(r):"v"(a),"v"(b),"v"(c));return r;}
__device__ __forceinline__ float max2f(float a,float b){float r;asm("v_max_f32_e32 %0, %1, %2":"=v"(r):"v"(a),"v"(b));return r;}
__device__ __forceinline__ float fadd_s(float a,float b){float r;asm("v_add_f32_e32 %0, %1, %2":"=v"(r):"v"(a),"v"(b));return r;}
__device__ __forceinline__ float fsub_s(float a,float b){float r;asm("v_sub_f32_e32 %0, %1, %2":"=v"(r):"v"(a),"v"(b));return r;}
typedef float f32x2_t __attribute__((ext_vector_type(2))); typedef float f32x4_t __attribute__((ext_vector_type(4))); typedef __bf16 bf16x2_t __attribute__((ext_vector_type(2)));
__device__ __forceinline__ unsigned cvtpk_s(float lo,float hi){f32x2_t v={lo,hi};bf16x2_t b=__builtin_convertvector(v,bf16x2_t);return __builtin_bit_cast(unsigned,b);}
#define WAIT_BAR(N) asm volatile("s_waitcnt vmcnt(" #N ") lgkmcnt(0)\n\ts_barrier":::"memory")

__device__ __forceinline__ void qkt(f32x16&p0,f32x16&p1,const char*Kslot,const bf16x8*qr,const f32x16&cin0,const f32x16&cin1,int r32,int hi){
  const char*kb=Kslot+hi*1024+r32*16;
  #pragma unroll
  for(int d0=0;d0<4;++d0){
    const bf16x8 b0=*reinterpret_cast<const bf16x8*>(kb+d0*2048);
    const bf16x8 b1=*reinterpret_cast<const bf16x8*>(kb+d0*2048+512);
    if(d0==0){p0=__builtin_amdgcn_mfma_f32_32x32x16_bf16(b0,qr[0],cin0,0,0,0);p1=__builtin_amdgcn_mfma_f32_32x32x16_bf16(b1,qr[0],cin1,0,0,0);}
    else{p0=__builtin_amdgcn_mfma_f32_32x32x16_bf16(b0,qr[d0],p0,0,0,0);p1=__builtin_amdgcn_mfma_f32_32x32x16_bf16(b1,qr[d0],p1,0,0,0);}}
}
typedef __attribute__((address_space(3))) const char* lds_cptr;
typedef short v4i16_t __attribute__((ext_vector_type(4)));
__device__ __forceinline__ void kload8(bf16x8*kf,lds_cptr kp){
  kf[0]=*(const __attribute__((address_space(3))) bf16x8*)(kp);      kf[1]=*(const __attribute__((address_space(3))) bf16x8*)(kp+512);
  kf[2]=*(const __attribute__((address_space(3))) bf16x8*)(kp+2048); kf[3]=*(const __attribute__((address_space(3))) bf16x8*)(kp+2560);
  kf[4]=*(const __attribute__((address_space(3))) bf16x8*)(kp+4096); kf[5]=*(const __attribute__((address_space(3))) bf16x8*)(kp+4608);
  kf[6]=*(const __attribute__((address_space(3))) bf16x8*)(kp+6144); kf[7]=*(const __attribute__((address_space(3))) bf16x8*)(kp+6656);
}
__device__ __forceinline__ void kload2(bf16x8*kf,lds_cptr kp,int j){ kf[2*j]=*(const __attribute__((address_space(3))) bf16x8*)(kp+j*2048); kf[2*j+1]=*(const __attribute__((address_space(3))) bf16x8*)(kp+j*2048+512); }
__device__ __forceinline__ s16x4 vtr(lds_cptr p){ return __builtin_bit_cast(s16x4,__builtin_amdgcn_ds_read_tr16_b64_v4i16((__attribute__((address_space(3))) v4i16_t*)p)); }
__device__ __forceinline__ float rowmax(const f32x16&p0,const f32x16&p1){
  float a=max3f(p0[0],p0[1],p1[0]),b=max3f(p0[2],p0[3],p1[1]);a=max3f(a,p1[2],p1[3]);
  #pragma unroll
  for(int r=4;r<16;r+=4){a=max3f(a,p0[r],p0[r+1]);b=max3f(b,p0[r+2],p0[r+3]);a=max3f(a,p1[r],p1[r+1]);b=max3f(b,p1[r+2],p1[r+3]);}
  const float m=max2f(a,b);
  auto rr=__builtin_amdgcn_permlane32_swap(__float_as_uint(m),__float_as_uint(m),false,false);
  return max2f(__uint_as_float(rr[0]),__uint_as_float(rr[1]));
}
__device__ __forceinline__ void pv(f32x16*o,int vb,bf16x8 pa0,bf16x8 pa1,bf16x8 pa2,bf16x8 pa3){
  #pragma unroll
  for(int d0=0;d0<2;++d0){s16x4 lo[4],hi[4];
    #pragma unroll
    for(int ks=0;ks<4;++ks){
      asm volatile("ds_read_b64_tr_b16 %0,%1 offset:%c2":"=&v"(lo[ks]):"v"(vb),"i"(d0*4096+ks*1024):"memory");
      asm volatile("ds_read_b64_tr_b16 %0,%1 offset:%c2":"=&v"(hi[ks]):"v"(vb),"i"(d0*4096+ks*1024+512):"memory");}
    asm volatile("s_waitcnt lgkmcnt(0)":::"memory");SBAR();
    #define PK(k) (bf16x8){lo[k][0],lo[k][1],lo[k][2],lo[k][3],hi[k][0],hi[k][1],hi[k][2],hi[k][3]}
    o[d0]=__builtin_amdgcn_mfma_f32_32x32x16_bf16(pa0,PK(0),o[d0],0,0,0);
    o[d0]=__builtin_amdgcn_mfma_f32_32x32x16_bf16(pa1,PK(1),o[d0],0,0,0);
    o[d0]=__builtin_amdgcn_mfma_f32_32x32x16_bf16(pa2,PK(2),o[d0],0,0,0);
    o[d0]=__builtin_amdgcn_mfma_f32_32x32x16_bf16(pa3,PK(3),o[d0],0,0,0);
    #undef PK
  }
}

#ifndef ATTN_STORE16
#define ATTN_STORE16(p,v) (*(u32x4*)(p)=(v))
#endif
template<int THRL> __device__ __forceinline__ void attn_unit(int b,int h,int qb,const bf16*Q,const bf16*__restrict__ K,const bf16*__restrict__ V,bf16*O,char*shm,float qkb2){
  const int tid=threadIdx.x,lane=tid&63,r32=lane&31,hi=lane>>5; const int wid=__builtin_amdgcn_readfirstlane(tid>>6);
  const long rowbase=(long)b*SEQ; const int q0=qb*QB;
  const bf16*Qw=Q+(rowbase+q0+wid*QBLK)*DM+h*D;
  const bf16*Kh=K+rowbase*DM+h*D,*Vh=V+rowbase*DM+h*D;
  const unsigned lds0=(unsigned)(uintptr_t)shm; const lds_cptr shm3=(lds_cptr)shm;
  float*wsf=(float*)(shm+LDS_WS)+wid*64;
  const bf16*ksrc=Kh+(long)lane*DM+wid*8;
  const bf16*vsrc=Vh+(long)(16*(wid&3)+(lane>>2))*DM+(wid>>2)*32+(lane&3)*8;
  const unsigned kdst=lds0+LDS_K+wid*1024, vdst=lds0+LDS_V+wid*1024;
  #define DMA_K(t,slot) glds16(ksrc+(long)(t)*KVBLK*DM,(unsigned)__builtin_amdgcn_readfirstlane(kdst+(slot)))
  #define DMA_V(t,slot) glds16(vsrc+(long)(t)*KVBLK*DM,(unsigned)__builtin_amdgcn_readfirstlane(vdst+(slot)))
  const int vb0=(int)(lds0+LDS_V)+((lane>>4)&1)*32+(lane&3)*8+(4*hi+((lane&15)>>2))*64;
  const char*Kbase=shm+LDS_K; bf16x8 kf[8];
  const lds_cptr kp0=shm3+LDS_K+hi*1024+r32*16; const lds_cptr vp0=shm3+LDS_V+((lane>>4)&1)*32+(lane&3)*8+(4*hi+((lane&15)>>2))*64;
  const int NT=(q0+QB)/KVBLK;
  int j0=0;
  { const __attribute__((address_space(3))) float* c2f=(const __attribute__((address_space(3))) float*)((lds_cptr)shm+LDS_C2); const float cq=c2f[q0]+qkb2+40.0f;
    int lo_=0,hi_=(NT-4)>>1;
    while(lo_<hi_){ const int mid=(lo_+hi_+1)>>1; if(cq-c2f[128*mid-1]<0.f)lo_=mid; else hi_=mid-1; }
    j0=__builtin_amdgcn_readfirstlane(2*lo_); }
  DMA_K(j0,0);DMA_V(j0,0);DMA_K(j0+1,SLOTB);
  bf16x8 qr[4];
  #pragma unroll
  for(int d0=0;d0<4;++d0)qr[d0]=*reinterpret_cast<const bf16x8*>(&Qw[(long)r32*DM+d0*16+hi*8]);
  float l_reg=0.f;f32x16 o[2];o[0]=f32x16{};o[1]=f32x16{};
  typedef __attribute__((address_space(3))) const f32x4_t* lds_f4ptr; const lds_f4ptr c2p=(lds_f4ptr)(shm3+LDS_C2)+hi;
  float ctm=((const __attribute__((address_space(3))) float*)(shm3+LDS_C2))[q0+wid*QBLK+r32];
  f32x16 cin0,cin1;
  #define CIN(t) do{ const lds_f4ptr cq_=c2p+16*(t); const f32x4_t a0_=cq_[0],a1_=cq_[2],a2_=cq_[4],a3_=cq_[6],b0_=cq_[8],b1_=cq_[10],b2_=cq_[12],b3_=cq_[14]; \
    _Pragma("unroll") for(int j_=0;j_<4;++j_){ cin0[j_]=ctm-a0_[j_];cin0[4+j_]=ctm-a1_[j_];cin0[8+j_]=ctm-a2_[j_];cin0[12+j_]=ctm-a3_[j_]; cin1[j_]=ctm-b0_[j_];cin1[4+j_]=ctm-b1_[j_];cin1[8+j_]=ctm-b2_[j_];cin1[12+j_]=ctm-b3_[j_]; } }while(0)
  const int qrel=wid*QBLK+r32;
  #define CMASK(P0,P1,t) do{int jb_=(t)-(NT-4); if(jb_>=0)cmask(P0,P1,jb_,qrel,hi);}while(0)
  bool resc=false;
  #define START(P0,P1) do{ const float rm=rowmax(P0,P1); resc=false; \
    if(__any(rm>(float)THRL)){ const float dl=__builtin_fmaxf(rm,0.f); ctm-=dl; \
      _Pragma("unroll") for(int r=0;r<16;++r){P0[r]-=dl;P1[r]-=dl;} } \
    _Pragma("unroll") for(int r=0;r<16;++r)P0[r]=__builtin_amdgcn_exp2f(P0[r]); }while(0)
  #define RESC() do{ if(resc){ asm volatile("s_waitcnt lgkmcnt(0)":::"memory"); \
      _Pragma("unroll") for(int d_=0;d_<2;++d_) _Pragma("unroll") for(int r=0;r<16;++r)o[d_][r]*=wsf[crow(r,hi)]; } }while(0)
  f32x16 pA0,pA1,pB0,pB1;
  int sl_prev=0,sl_cur=0,sl_next=SLOTB;
  #define ROT() do{sl_prev=sl_cur;sl_cur=sl_next;sl_next=(sl_next==(NSLOT-1)*SLOTB)?0:sl_next+SLOTB;}while(0)
  DMA_K(j0+2,2*SLOTB);
  WAIT_BAR(3);
  CIN(j0); qkt(pA0,pA1,Kbase,qr,cin0,cin1,r32,hi);asm volatile("s_nop 15\n\ts_nop 7":"+v"(pA0),"+v"(pA1));CMASK(pA0,pA1,j0);
  START(pA0,pA1);
  _Pragma("unroll") for(int r=0;r<16;++r)pA1[r]=__builtin_amdgcn_exp2f(pA1[r]);
  WAIT_BAR(0);
  DMA_K(j0+3,0);DMA_V(j0+1,SLOTB);
  ROT();
  kload8(kf,kp0+sl_cur);
  WAIT_BAR(2);
  s16x4 vlo[8],vhi[8]; u32x4 pw0,pw1,pw2,pw3;
  #define PKW(P,B) cvtpk_s(P[B],P[B+1])
  #define PAF(k) __builtin_bit_cast(bf16x8,pw##k)
  #define VFR(i) (bf16x8){vlo[i][0],vlo[i][1],vlo[i][2],vlo[i][3],vhi[i][0],vhi[i][1],vhi[i][2],vhi[i][3]}
  #define PIN(x) asm volatile("":"+v"(x))
  #define MX3(a,b,c) __builtin_fmaxf(__builtin_fmaxf((a),(b)),(c))
  #define GAPA(MF,A0,A1,A2,A3,W0,W1,PW) do{ MF; sacc+=A0; sacc+=A1; sacc+=A2; sacc+=A3; PIN(sacc); W0; W1; PIN(PW); SBAR(); }while(0)
  #define EX(v) __builtin_amdgcn_exp2f(v)
  #define GAPB(MF,X,B) do{ MF; X[B]=EX(X[B]); X[B+1]=EX(X[B+1]); X[B+2]=EX(X[B+2]); X[B+3]=EX(X[B+3]); PIN(X); SBAR(); }while(0)
  #define VRD(i) do{ vlo[i]=vtr(vp_+(((i)>>2)*4096+((i)&3)*1024)); vhi[i]=vtr(vp_+(((i)>>2)*4096+((i)&3)*1024+512)); }while(0)
  #define KRD(G,j) do{ if(G){ kload2(kf,kp0+sl_next,j); SBAR(); } }while(0)
  #define STEP(C0,C1,P0,P1,t,GK,GV,GL) do{ SBAR(); CIN(t); SBAR(); \
    const lds_cptr vp_=vp0+sl_prev; \
    VRD(0); SBAR(); float sacc=(P0[0]+P0[1]); \
    GAPA(C0=__builtin_amdgcn_mfma_f32_32x32x16_bf16(kf[0],qr[0],cin0,0,0,0), P0[2],P0[3],P0[4],P0[5],     pw0[0]=PKW(P0,0), pw0[1]=PKW(P0,2), pw0); \
    VRD(4); SBAR(); GAPA(C1=__builtin_amdgcn_mfma_f32_32x32x16_bf16(kf[1],qr[0],cin1,0,0,0), P0[6],P0[7],P0[8],P0[9],     pw0[2]=PKW(P0,4), pw0[3]=PKW(P0,6), pw0); \
    VRD(1); SBAR(); GAPA(C0=__builtin_amdgcn_mfma_f32_32x32x16_bf16(kf[2],qr[1],C0,0,0,0),   P0[10],P0[11],P0[12],P0[13], pw1[0]=PKW(P0,8), pw1[1]=PKW(P0,10), pw1); \
    VRD(5); SBAR(); GAPA(C1=__builtin_amdgcn_mfma_f32_32x32x16_bf16(kf[3],qr[1],C1,0,0,0),   P0[14],P0[15],P1[0],P1[1],   pw1[2]=PKW(P0,12),pw1[3]=PKW(P0,14), pw1); \
    VRD(2); SBAR(); GAPA(C0=__builtin_amdgcn_mfma_f32_32x32x16_bf16(kf[4],qr[2],C0,0,0,0),   P1[2],P1[3],P1[4],P1[5],     pw2[0]=PKW(P1,0), pw2[1]=PKW(P1,2), pw2); \
    VRD(6); SBAR(); GAPA(C1=__builtin_amdgcn_mfma_f32_32x32x16_bf16(kf[5],qr[2],C1,0,0,0),   P1[6],P1[7],P1[8],P1[9],     pw2[2]=PKW(P1,4), pw2[3]=PKW(P1,6), pw2); \
    VRD(3); SBAR(); GAPA(C0=__builtin_amdgcn_mfma_f32_32x32x16_bf16(kf[6],qr[3],C0,0,0,0),   P1[10],P1[11],P1[12],P1[13], pw3[0]=PKW(P1,8), pw3[1]=PKW(P1,10), pw3); \
    VRD(7); SBAR(); GAPA(C1=__builtin_amdgcn_mfma_f32_32x32x16_bf16(kf[7],qr[3],C1,0,0,0),   P1[14],P1[15],0.f,0.f,       pw3[2]=PKW(P1,12),pw3[3]=PKW(P1,14), pw3); \
    l_reg+=sacc; \
    if(GK){DMA_K((t)+3,sl_cur);} if(GV){DMA_V((t)+1,sl_next);} \
    CMASK(C0,C1,t); \
    { float a=MX3(C0[0],C0[1],C1[0]),b=MX3(C0[2],C0[3],C1[1]); a=MX3(a,C1[2],C1[3]); \
      _Pragma("unroll") for(int r=4;r<16;r+=4){a=MX3(a,C0[r],C0[r+1]);b=MX3(b,C0[r+2],C0[r+3]);a=MX3(a,C1[r],C1[r+1]);b=MX3(b,C1[r+2],C1[r+3]);} \
      float rm=__builtin_fmaxf(a,b); { auto rr=__builtin_amdgcn_permlane32_swap(__float_as_uint(rm),__float_as_uint(rm),false,false); rm=__builtin_fmaxf(__uint_as_float(rr[0]),__uint_as_float(rr[1])); } \
      resc=false; \
      if(__builtin_expect(__any(rm>(float)THRL),0)){ const float dl=__builtin_fmaxf(rm,0.f); ctm-=dl; \
        _Pragma("unroll") for(int r=0;r<16;++r){C0[r]-=dl;C1[r]-=dl;} \
        const float f=__builtin_amdgcn_exp2f(-dl); l_reg*=f; if(hi==0)wsf[r32]=f; resc=true; } } \
    SBAR(); \
    GAPB(o[0]=__builtin_amdgcn_mfma_f32_32x32x16_bf16(PAF(0),VFR(0),o[0],0,0,0), C0,0); \
    GAPB(o[1]=__builtin_amdgcn_mfma_f32_32x32x16_bf16(PAF(0),VFR(4),o[1],0,0,0), C0,4); \
    KRD(GL,0); GAPB(o[0]=__builtin_amdgcn_mfma_f32_32x32x16_bf16(PAF(1),VFR(1),o[0],0,0,0), C0,8); \
    KRD(GL,1); GAPB(o[1]=__builtin_amdgcn_mfma_f32_32x32x16_bf16(PAF(1),VFR(5),o[1],0,0,0), C0,12); \
    KRD(GL,2); GAPB(o[0]=__builtin_amdgcn_mfma_f32_32x32x16_bf16(PAF(2),VFR(2),o[0],0,0,0), C1,0); \
    KRD(GL,3); GAPB(o[1]=__builtin_amdgcn_mfma_f32_32x32x16_bf16(PAF(2),VFR(6),o[1],0,0,0), C1,4); \
    GAPB(o[0]=__builtin_amdgcn_mfma_f32_32x32x16_bf16(PAF(3),VFR(3),o[0],0,0,0), C1,8); \
    GAPB(o[1]=__builtin_amdgcn_mfma_f32_32x32x16_bf16(PAF(3),VFR(7),o[1],0,0,0), C1,12); \
    }while(0)
  int t=j0+1;
  #undef CMASK
  #define CMASK(P0,P1,t) do{}while(0)
  for(;t+5<NT;t+=2){
    STEP(pB0,pB1,pA0,pA1,t,true,true,true);     WAIT_BAR(2); RESC(); ROT();
    STEP(pA0,pA1,pB0,pB1,t+1,true,true,true);   WAIT_BAR(2); RESC(); ROT();
  }
  #undef CMASK
  #define CMASK(P0,P1,t) do{int jb_=(t)-(NT-4); if(jb_>=0)cmask(P0,P1,jb_,qrel,hi);}while(0)
  #define ENDW(tt) do{ if((tt)+3<NT){WAIT_BAR(2);} else if((tt)+2<NT){WAIT_BAR(1);} else {WAIT_BAR(0);} }while(0)
  for(;t+1<NT;t+=2){
    STEP(pB0,pB1,pA0,pA1,t,(t+3<NT),(t+1<NT),(t+1<NT));       ENDW(t);   RESC(); ROT();
    STEP(pA0,pA1,pB0,pB1,t+1,(t+4<NT),(t+2<NT),(t+2<NT));     ENDW(t+1); RESC(); ROT();
  }
  STEP(pB0,pB1,pA0,pA1,NT-1,false,false,false); RESC();
  { float sacc=pB0[0]+pB0[1]; _Pragma("unroll") for(int r=2;r<16;++r)sacc+=pB0[r]; _Pragma("unroll") for(int r=0;r<16;++r)sacc+=pB1[r]; l_reg+=sacc;
    pw0=(u32x4){PKW(pB0,0),PKW(pB0,2),PKW(pB0,4),PKW(pB0,6)};pw1=(u32x4){PKW(pB0,8),PKW(pB0,10),PKW(pB0,12),PKW(pB0,14)};pw2=(u32x4){PKW(pB1,0),PKW(pB1,2),PKW(pB1,4),PKW(pB1,6)};pw3=(u32x4){PKW(pB1,8),PKW(pB1,10),PKW(pB1,12),PKW(pB1,14)};
    SBAR(); pv(o,vb0+sl_cur,PAF(0),PAF(1),PAF(2),PAF(3)); }
  #undef PKW
  #undef PAF
  #undef VFR
  #undef PIN
  #undef MX3
  #undef GAPA
  #undef GAPB
  #undef EX
  #undef VRD
  #undef KRD
  #undef STEP
  #undef ENDW
  {auto rr=__builtin_amdgcn_permlane32_swap(__float_as_uint(l_reg),__float_as_uint(l_reg),false,false);l_reg=__uint_as_float(rr[0])+__uint_as_float(rr[1]);}
  if(hi==0)wsf[32+r32]=l_reg;asm volatile("s_waitcnt lgkmcnt(0)":::"memory");
  float rli[16];
  #pragma unroll
  for(int r=0;r<16;++r)rli[r]=__builtin_amdgcn_rcpf(wsf[32+crow(r,hi)]);
  bf16*Ow=O+(rowbase+q0+wid*QBLK)*ODM+h*D;
  { bf16*stg=(bf16*)(shm+LDS_OST)+wid*2048;
    #pragma unroll
    for(int r=0;r<16;++r){const int orow=crow(r,hi);
      #pragma unroll
      for(int d0=0;d0<2;++d0)stg[orow*64+d0*32+r32]=__float2bfloat16(o[d0][r]*rli[r]);}
    asm volatile("s_waitcnt lgkmcnt(0)":::"memory");
    #pragma unroll
    for(int i=0;i<4;++i){const int row=i*8+(lane>>3),ch=lane&7; const u32x4 v=*(const u32x4*)(stg+row*64+ch*8); ATTN_STORE16(Ow+(long)row*ODM+ch*8,v);} }
  asm volatile("s_waitcnt lgkmcnt(0)\n\ts_barrier":::"memory");
  #undef CIN
  #undef DMA_K
  #undef DMA_V
  #undef CMASK
  #undef START
  #undef RESC
  #undef ROT
}
constexpr int ATTN_LDS_BYTES=LDS_BYTES;
struct AttnTensors { const bf16* Q; const bf16* K; const bf16* V; bf16* O; };
struct AttnUnit { int bh; int qb; };
struct StaticOrder {
  int vcu;
  __device__ __forceinline__ explicit StaticOrder(int grid,int block):vcu((block%8)*(grid/8)+block/8){}
  __device__ __forceinline__ bool next(int i,AttnUnit&u)const{ if(i>=4)return false; const int s=vcu&7; u.bh=vcu>>3; u.qb=(i==0)?s:(i==1)?15-s:(i==2)?16+s:31-s; return true; }
  __device__ __forceinline__ void a_ready(const AttnUnit&)const{}
  __device__ __forceinline__ void done(const AttnUnit&)const{}
};
template<class Sched,int THRL=8> __device__ __forceinline__ void attn_phase(char*lds,const AttnTensors&T,const Sched&S,float qkb2){
  AttnUnit u;
  for(int i=0;S.next(i,u);++i){ S.a_ready(u); attn_unit<THRL>(u.bh/NHEAD,u.bh%NHEAD,u.qb,T.Q,T.K,T.V,T.O,lds,qkb2); S.done(u); }
}
#undef SBAR
#undef WAIT_BAR
}
#define GAS __attribute__((address_space(1)))
#define LAS __attribute__((address_space(3)))
typedef GAS unsigned gu32;
#define RLX_AGENT __ATOMIC_RELAXED, __HIP_MEMORY_SCOPE_AGENT
#define LDS_WAIT() asm volatile("s_waitcnt lgkmcnt(0)" ::: "memory")
#define VM_WAIT() asm volatile("s_waitcnt vmcnt(0)" ::: "memory")

constexpr int NWAVES = 8;
constexpr int N_PHASES = 8;
constexpr int RING_OFF = 0, RING_BYTES = 131072;
constexpr int TAB_OFF = 131072, TAB_UNITS = 17;
constexpr int LDS_TOTAL = 155648;
constexpr int LDSCTL_OFF = LDS_TOTAL - 1024;
static_assert(TAB_OFF + TAB_UNITS * 256 * 4 <= LDSCTL_OFF, "LDS map");
constexpr int CW_Q = 128, CW_NRM = 256;
constexpr size_t WS_X1B = WS_P;
constexpr size_t WS_TOT = WS_SEL + 768 * 1024;
constexpr int CW_BAR = 4096;

#define XB_TMO      128
#define XB_XCNT(j)  (256  + 64 * (j))
#define XB_XSUB(j)  (1280 + 64 * (j))
#define XB_XGEN(j)  (2304 + 64 * (j))
#define XB_TOP      3328
#define XB_TOPGEN   3392
#define XCD_BAR_WORDS 3456
#define XB_SPIN_CAP (1u << 18)

__device__ __forceinline__ unsigned xb_ld(unsigned* p)              { return __hip_atomic_load(p, __ATOMIC_RELAXED, __HIP_MEMORY_SCOPE_AGENT); }
__device__ __forceinline__ unsigned xb_add(unsigned* p, unsigned v) { return __hip_atomic_fetch_add(p, v, __ATOMIC_RELAXED, __HIP_MEMORY_SCOPE_AGENT); }
__device__ __forceinline__ unsigned xb_xcc_id() { return (unsigned)__builtin_amdgcn_s_getreg((3 << 11) | 20) & 0xFu; }
#define XB_SPIN(cond, bar) do { unsigned _sp = 0; while (cond) { __builtin_amdgcn_s_sleep(1); \
    if ((++_sp & 255u) == 0u) { if (xb_ld(&(bar)[XB_TMO])) break; if (_sp > XB_SPIN_CAP) { atomicAdd(&(bar)[XB_TMO], 1u); break; } } } } while (0)

struct XcdBarrier {
    unsigned* bar; unsigned x;
    volatile LAS unsigned* st;
};

__device__ __forceinline__ XcdBarrier xcd_barrier_post(unsigned* bar, volatile LAS unsigned* st) {
    XcdBarrier b; b.bar = bar; b.x = xb_xcc_id(); b.st = st;
    if (threadIdx.x == 0) (void)xb_add(&bar[XB_XCNT(b.x)], 1u);
    return b;
}
__device__ __forceinline__ void xcd_barrier_complete(unsigned* bar, unsigned x, unsigned& nloc, unsigned& nx) {
    const unsigned G = gridDim.x * gridDim.y * gridDim.z;
    unsigned sum, cnt, mine, sp = 0u;
    for (;;) {
        sum = 0u; cnt = 0u; mine = 0u;
#pragma unroll
        for (unsigned j = 0; j < 16; ++j) { const unsigned c = xb_ld(&bar[XB_XCNT(j)]); sum += c; cnt += (c > 0u) ? 1u : 0u; mine = (j == x) ? c : mine; }
        if (sum == G) break;
        __builtin_amdgcn_s_sleep(1);
        if ((++sp & 255u) == 0u) { if (xb_ld(&bar[XB_TMO])) break; if (sp > XB_SPIN_CAP) { atomicAdd(&bar[XB_TMO], 1u); break; } }
    }
    nloc = mine > 0u ? mine : 1u; nx = cnt > 0u ? cnt : 1u;
}

__device__ __forceinline__ void xcd_barrier(const XcdBarrier& b) {
    asm volatile("s_waitcnt vmcnt(0)" ::: "memory");
    __syncthreads();
    if (threadIdx.x == 0) {
        unsigned* bar = b.bar;
        __builtin_amdgcn_s_waitcnt(0);
        unsigned nloc = b.st[0], nx = b.st[1];
        if (nloc == 0u) { xcd_barrier_complete(bar, b.x, nloc, nx); b.st[0] = nloc; b.st[1] = nx; }
        const unsigned old = xb_add(&bar[XB_XSUB(b.x)], 1u);
        const unsigned gen = old / nloc;
        if (old + 1u == (gen + 1u) * nloc) {
            __builtin_amdgcn_fence(__ATOMIC_RELEASE, "agent");
            asm volatile("s_waitcnt vmcnt(0)" ::: "memory");
            const unsigned og = xb_add(&bar[XB_TOP], 1u);
            const unsigned tg = og / nx;
            if (og + 1u == (tg + 1u) * nx) xb_add(&bar[XB_TOPGEN], 1u);
            else XB_SPIN(xb_ld(&bar[XB_TOPGEN]) == tg, bar);
            __builtin_amdgcn_fence(__ATOMIC_ACQUIRE, "agent");
            xb_add(&bar[XB_XGEN(b.x)], 1u);
            asm volatile("s_waitcnt vmcnt(0)" ::: "memory");
        } else {
            XB_SPIN(xb_ld(&bar[XB_XGEN(b.x)]) == gen, bar);
            __builtin_amdgcn_fence(__ATOMIC_ACQUIRE, "agent");
            asm volatile("s_waitcnt vmcnt(0)" ::: "memory");
        }
    }
    __syncthreads();
}


struct Args { const float* in[15]; float* out; unsigned char* ws; int ph_lo, ph_hi, use_bar, pad; };

__device__ __forceinline__ void p0_transpose_item(const float* W, int ldw, bf16* WT, int ldt, LAS float* scr, int lane) {
    float tv[32];
    const float* wp_ = W + (size_t)(lane >> 5) * ldw + (lane & 31);
#pragma unroll
    for (int i = 0; i < 32; ++i) tv[i] = wp_[(size_t)(2 * i) * ldw];
#pragma unroll
    for (int i = 0; i < 32; ++i) scr[(2 * i + (lane >> 5)) * 33 + (lane & 31)] = tv[i];
    LDS_WAIT(); asm volatile("" ::: "memory");
    const int c = lane & 7;
#pragma unroll
    for (int j = 0; j < 4; ++j) { const int n = (lane >> 3) + 8 * j; const LAS float* s = scr + (8 * c) * 33 + n;
        u32x4 o; o.x = pg8::cvt_pk_bf16(s[0 * 33], s[1 * 33]); o.y = pg8::cvt_pk_bf16(s[2 * 33], s[3 * 33]); o.z = pg8::cvt_pk_bf16(s[4 * 33], s[5 * 33]); o.w = pg8::cvt_pk_bf16(s[6 * 33], s[7 * 33]);
        *(GAS u32x4*)(WT + (size_t)n * ldt + 8 * c) = o; }
    LDS_WAIT(); asm volatile("" ::: "memory");
}
__device__ __forceinline__ void p0_transpose_item_fp8(const float* W, int ldw, unsigned char* WT, int ldt, LAS float* scr, int lane) {
    float tv[32];
    const float* wp_ = W + (size_t)(lane >> 5) * ldw + (lane & 31);
#pragma unroll
    for (int i = 0; i < 32; ++i) tv[i] = wp_[(size_t)(2 * i) * ldw];
#pragma unroll
    for (int i = 0; i < 32; ++i) scr[(2 * i + (lane >> 5)) * 33 + (lane & 31)] = tv[i];
    LDS_WAIT(); asm volatile("" ::: "memory");
    const int c = lane & 7;
#pragma unroll
    for (int j = 0; j < 4; ++j) { const int n = (lane >> 3) + 8 * j; const LAS float* s = scr + (8 * c) * 33 + n; const float k_ = pg8::FP8_SW;
        u32x2 o; o.x = pg8::pack4_fp8(s[0 * 33] * k_, s[1 * 33] * k_, s[2 * 33] * k_, s[3 * 33] * k_); o.y = pg8::pack4_fp8(s[4 * 33] * k_, s[5 * 33] * k_, s[6 * 33] * k_, s[7 * 33] * k_);
        *(GAS u32x2*)(WT + (size_t)n * ldt + 8 * c) = o; }
    LDS_WAIT(); asm volatile("" ::: "memory");
}
constexpr int I_WIN = 16 * 64, I_WO = 8 * 32, I_WEFF = 4 * 16 * 16, I_WU = 32 * 16 * 64, I_WD = 32 * 16 * 32;
constexpr int P0_ITEMS = I_WIN + I_WO + I_WEFF;

__device__ __forceinline__ void phase0(const Args& a, LAS unsigned char* L, int vcu, int G, int tid, int lane, int wave) {
    const float* w_in = a.in[2]; const float* w_pool = a.in[4]; const float* pscale = a.in[5]; const float* w_out = a.in[6];
    bf16* Win_t = (bf16*)(a.ws + WS_WIN); bf16* Wo_t = (bf16*)(a.ws + WS_WO);
    LAS float* scr = (LAS float*)(L + wave * 8448);
    LAS float* wf = (LAS float*)(L + 69632);
    for (int i = tid; i < 1024 * 8; i += 512) { const int d = i >> 3, p_ = ((d & 255) >> 2) + 64 * (4 * (d >> 8) + (d & 3)); wf[p_ * 12 + (i & 7)] = w_in[(size_t)d * INW + 2048 + (i & 7)]; }
    __syncthreads();
    const int gw = vcu * NWAVES + wave, NGW = G * NWAVES;
    {
        const float* x = a.in[0]; const float* g_mix = a.in[1]; const float* b_forget = a.in[3];
        bf16* XN = (bf16*)(a.ws + WS_XN); float* LOGF = (float*)(a.ws + WS_LOGF);
        f32x4 g[4];
#pragma unroll
        for (int j = 0; j < 4; ++j) g[j] = *(const f32x4*)(g_mix + 4 * lane + 256 * j);
        f32x4 vn[2][4];
#pragma unroll
        for (int q = 0; q < 2; ++q)
#pragma unroll
            for (int j = 0; j < 4; ++j) vn[q][j] = *(const f32x4*)(x + (size_t)(gw + q * NGW) * DM + 4 * lane + 256 * j);
        for (int m = gw; m < T; m += 2 * NGW) {
            f32x4 v[2][4]; float ss[2] = {0.f, 0.f};
#pragma unroll
            for (int q = 0; q < 2; ++q)
#pragma unroll
                for (int j = 0; j < 4; ++j) { v[q][j] = vn[q][j]; ss[q] += v[q][j].x * v[q][j].x + v[q][j].y * v[q][j].y + v[q][j].z * v[q][j].z + v[q][j].w * v[q][j].w; }
            { const int mn = (m + 2 * NGW < T) ? m + 2 * NGW : m;
#pragma unroll
              for (int q = 0; q < 2; ++q)
#pragma unroll
                  for (int j = 0; j < 4; ++j) vn[q][j] = *(const f32x4*)(x + (size_t)(mn + q * NGW) * DM + 4 * lane + 256 * j); }
#pragma unroll
            for (int o = 1; o < 64; o <<= 1) { ss[0] += __shfl_xor(ss[0], o); ss[1] += __shfl_xor(ss[1], o); }
            float fl[2][8];
#pragma unroll
            for (int q = 0; q < 2; ++q) { const float rstd = rsqrtf(ss[q] * (1.f / DM) + RMS_EPS);
#pragma unroll
                for (int e = 0; e < 8; ++e) fl[q][e] = 0.f;
#pragma unroll
                for (int j = 0; j < 4; ++j) v[q][j] = v[q][j] * rstd * g[j]; }
#pragma unroll
            for (int j = 0; j < 4; ++j) {
#pragma unroll
                for (int i = 0; i < 4; ++i) {
                    const int prow = lane + 64 * (4 * j + i);
                    const f32x4 w0 = *(const LAS f32x4*)(wf + prow * 12), w1 = *(const LAS f32x4*)(wf + prow * 12 + 4);
#pragma unroll
                    for (int q = 0; q < 2; ++q) { const float hv = v[q][j][i];
                        fl[q][0] += hv * w0.x; fl[q][1] += hv * w0.y; fl[q][2] += hv * w0.z; fl[q][3] += hv * w0.w;
                        fl[q][4] += hv * w1.x; fl[q][5] += hv * w1.y; fl[q][6] += hv * w1.z; fl[q][7] += hv * w1.w; }
                }
#pragma unroll
                for (int q = 0; q < 2; ++q) { u32x2 o; o.x = pk2(v[q][j].x, v[q][j].y); o.y = pk2(v[q][j].z, v[q][j].w);
                    *(u32x2*)(XN + (size_t)(m + q * NGW) * DM + 4 * lane + 256 * j) = o; }
            }
            float z[2];
            { const bool u5 = lane >= 32, u4 = (lane & 16) != 0, u3 = (lane & 8) != 0; float a4[2][4], a2[2][2];
#pragma unroll
              for (int q = 0; q < 2; ++q)
#pragma unroll
                  for (int e = 0; e < 4; ++e) { const float keep = u5 ? fl[q][4 + e] : fl[q][e], give = u5 ? fl[q][e] : fl[q][4 + e]; a4[q][e] = keep + __shfl_xor(give, 32); }
#pragma unroll
              for (int q = 0; q < 2; ++q)
#pragma unroll
                  for (int e = 0; e < 2; ++e) { const float keep = u4 ? a4[q][2 + e] : a4[q][e], give = u4 ? a4[q][e] : a4[q][2 + e]; a2[q][e] = keep + __shfl_xor(give, 16); }
#pragma unroll
              for (int q = 0; q < 2; ++q) z[q] = (u3 ? a2[q][1] : a2[q][0]) + __shfl_xor(u3 ? a2[q][0] : a2[q][1], 8);
#pragma unroll
              for (int o = 4; o >= 1; o >>= 1) { z[0] += __shfl_xor(z[0], o); z[1] += __shfl_xor(z[1], o); } }
            if ((lane & 7) == 0) {
                const int hd = lane >> 3; const float bfv = b_forget[hd];
#pragma unroll
                for (int q = 0; q < 2; ++q) { const int mm = m + q * NGW; const float zz = z[q] + bfv; const float ls = fminf(zz, 0.f) - log1pf(expf(-fabsf(zz)));
                    LOGF[((size_t)(mm / SEQ) * NH + hd) * SEQ + (mm % SEQ)] = ls; }
            }
        }
    }
    for (int it = gw; it < P0_ITEMS; it += NGW) {
        int r = it;
        if (r < I_WIN) { const int kb = r >> 6, nb = r & 63; p0_transpose_item(w_in + (size_t)(64 * kb) * INW + 32 * nb, INW, Win_t + (size_t)(32 * nb) * DM + 64 * kb, DM, scr, lane); continue; } r -= I_WIN;
        if (r < I_WO) { const int kb = r >> 5, nb = r & 31; p0_transpose_item(w_out + (size_t)(512 + 64 * kb) * DM + 32 * nb, DM, Wo_t + (size_t)(32 * nb) * DM + 512 + 64 * kb, DM, scr, lane); continue; } r -= I_WO;
        if (r < I_WEFF) {
            const int g = r >> 8, nb = (r >> 4) & 15, kb = r & 15, n = nb * 64 + lane; float acc[8];
#pragma unroll
            for (int i = 0; i < 8; ++i) acc[i] = 0.f;
            const float* wp = w_pool + (size_t)g * 16384 + (size_t)(kb * 8) * 128;
#pragma unroll 2
            for (int d = 0; d < 128; d += 4) { f32x4 av;
#pragma unroll
                for (int q = 0; q < 4; ++q) av[q] = w_out[(size_t)(g * 128 + d + q) * DM + n];
                av = av * *(const f32x4*)(pscale + g * 128 + d);
#pragma unroll
                for (int i = 0; i < 8; ++i) { const f32x4 wv = *(const f32x4*)(wp + i * 128 + d); acc[i] += av.x * wv.x + av.y * wv.y + av.z * wv.z + av.w * wv.w; } }
            u32x4 o; o.x = pk2(acc[0], acc[1]); o.y = pk2(acc[2], acc[3]); o.z = pk2(acc[4], acc[5]); o.w = pk2(acc[6], acc[7]);
            *(GAS u32x4*)(Wo_t + (size_t)n * DM + g * 128 + kb * 8) = o; continue; } r -= I_WEFF;
        }
}

constexpr int J_WU = 32 * 16 * 32, J_WD = 32 * 16 * 16;
struct ConvItem { const float* src; int ldw; unsigned char* dst; };
__device__ __forceinline__ ConvItem conv_item(const Args& a, int r) {
    ConvItem it;
    if (r < J_WU) { const int e = r >> 9, kb = (r >> 5) & 15, nb = r & 31, n0 = 64 * nb;
        const int rowp = n0 < 1024 ? (n0 >> 7) * 256 + (n0 & 127) : ((n0 - 1024) >> 7) * 256 + 128 + ((n0 - 1024) & 127);
        it.src = a.in[10] + (size_t)e * DM * 2048 + (size_t)(64 * kb) * 2048 + n0; it.ldw = 2048; it.dst = a.ws + WS_WU + ((size_t)e * 2048 + rowp) * DM + 64 * kb; return it; }
    r -= J_WU;
    { const int e = r >> 8, kb = (r >> 4) & 15, nb = r & 15;
      it.src = a.in[12] + (size_t)e * DE * DM + (size_t)(64 * kb) * DM + 64 * nb; it.ldw = DM; it.dst = a.ws + WS_WD + ((size_t)e * DM + 64 * nb) * DE + 64 * kb; return it; }
}
__device__ __forceinline__ void conv_load(float (&tv)[64], const ConvItem& it, int lane) {
    const float* p_ = it.src + lane;
#pragma unroll
    for (int i = 0; i < 64; ++i) tv[i] = p_[(size_t)i * it.ldw];
}
__device__ __forceinline__ void conv_finish(const float (&tv)[64], const ConvItem& it, int lane) {
    const float k_ = pg8::FP8_SW; unsigned char* d_ = it.dst + (size_t)lane * DM;
#pragma unroll
    for (int q = 0; q < 4; ++q) { u32x4 o;
        o.x = pg8::pack4_fp8(tv[16 * q + 0] * k_, tv[16 * q + 1] * k_, tv[16 * q + 2] * k_, tv[16 * q + 3] * k_); o.y = pg8::pack4_fp8(tv[16 * q + 4] * k_, tv[16 * q + 5] * k_, tv[16 * q + 6] * k_, tv[16 * q + 7] * k_);
        o.z = pg8::pack4_fp8(tv[16 * q + 8] * k_, tv[16 * q + 9] * k_, tv[16 * q + 10] * k_, tv[16 * q + 11] * k_); o.w = pg8::pack4_fp8(tv[16 * q + 12] * k_, tv[16 * q + 13] * k_, tv[16 * q + 14] * k_, tv[16 * q + 15] * k_);
        *(GAS u32x4*)(d_ + 16 * q) = o; }
}
constexpr int CONV_P2_CHUNKS = 1024, CONV_P4_PER_WAVE = 0;
static_assert(CONV_P2_CHUNKS * 24 + 256 * 4 * CONV_P4_PER_WAVE == J_WU + J_WD, "conversion split");
__device__ __forceinline__ void conv_triple(const Args& a, int r0, int lane) {
    const ConvItem i0 = conv_item(a, r0), i1 = conv_item(a, r0 + 1), i2 = conv_item(a, r0 + 2);
    float ta[64], tb[64];
    conv_load(ta, i0, lane); conv_load(tb, i1, lane);
    conv_finish(ta, i0, lane);
    conv_load(ta, i2, lane);
    conv_finish(tb, i1, lane);
    conv_finish(ta, i2, lane);
}
__device__ __forceinline__ void conv_chunk(const Args& a, int cc, int lane, int wave) { conv_triple(a, cc * 24 + wave * 3, lane); }

template <int W> __device__ __forceinline__ void pool_run(const bf16* U, bf16* CAT, int row0, int c0) {
    const int t0 = row0 % SEQ;
    u32x4 blk[8], tr[W - 1];
#pragma unroll
    for (int i = 0; i < 8; ++i) blk[i] = *(const u32x4*)(U + (size_t)(row0 + i) * PW + c0);
#pragma unroll
    for (int j = 1; j < W; ++j) { const u32x4 v_ = *(const u32x4*)(U + (size_t)(t0 - j >= 0 ? row0 - j : row0) * PW + c0); tr[j - 1] = (t0 - j >= 0) ? v_ : (u32x4){0u, 0u, 0u, 0u}; }
    float S[8];
#pragma unroll
    for (int k = 0; k < 8; ++k) S[k] = 0.f;
#pragma unroll
    for (int j = 0; j < W - 1; ++j) { const unsigned rr[4] = {tr[j].x, tr[j].y, tr[j].z, tr[j].w};
#pragma unroll
        for (int k = 0; k < 4; ++k) { S[2 * k] += __builtin_bit_cast(float, rr[k] << 16); S[2 * k + 1] += __builtin_bit_cast(float, rr[k] & 0xffff0000u); } }
#pragma unroll
    for (int i = 0; i < 8; ++i) { const int t = t0 + i; float cur[8];
        { const unsigned rr[4] = {blk[i].x, blk[i].y, blk[i].z, blk[i].w};
#pragma unroll
          for (int k = 0; k < 4; ++k) { cur[2 * k] = __builtin_bit_cast(float, rr[k] << 16); cur[2 * k + 1] = __builtin_bit_cast(float, rr[k] & 0xffff0000u); } }
        const float inv = 1.f / (float)(t + 1 < W ? t + 1 : W); float o[8];
#pragma unroll
        for (int k = 0; k < 8; ++k) { S[k] += cur[k]; o[k] = S[k] * inv - cur[k]; }
        u32x4 ov; ov.x = pk2(o[0], o[1]); ov.y = pk2(o[2], o[3]); ov.z = pk2(o[4], o[5]); ov.w = pk2(o[6], o[7]);
        *(u32x4*)(CAT + (size_t)(row0 + i) * DM + c0) = ov;
        const u32x4 sb = (i - (W - 1) >= 0) ? blk[(i - (W - 1) >= 0) ? i - (W - 1) : 0] : tr[(i - (W - 1) >= 0) ? 0 : (W - 1) - i - 1];
        { const unsigned rr[4] = {sb.x, sb.y, sb.z, sb.w};
#pragma unroll
          for (int k = 0; k < 4; ++k) { S[2 * k] -= __builtin_bit_cast(float, rr[k] << 16); S[2 * k + 1] -= __builtin_bit_cast(float, rr[k] & 0xffff0000u); } }
    }
}
__device__ __forceinline__ void pool_chunk(const Args& a, int c, int tid) {
    const bf16* U = (const bf16*)(a.ws + WS_U); bf16* CAT = (bf16*)(a.ws + WS_CAT);
    const int wv = tid >> 6, ln = tid & 63, g = wv & 3, ch = 16 * g + (ln & 15), c0 = ch * 8;
#pragma unroll 1
    for (int hf = 0; hf < 2; ++hf) { const int row0 = 128 * c + 8 * (hf * 8 + (wv >> 2) * 4 + (ln >> 4));
        if (g == 0) pool_run<2>(U, CAT, row0, c0); else if (g == 1) pool_run<4>(U, CAT, row0, c0); else if (g == 2) pool_run<8>(U, CAT, row0, c0); else pool_run<16>(U, CAT, row0, c0); }
}
__device__ __forceinline__ void c2_local_scan(const Args& a, LAS unsigned char* L, int bx, int tid, int lane, int wave) {
    if (bx >= 256) return;
    const int bh = bx >> 3, blk = bx & 7; const size_t off = (size_t)bh * SEQ + blk * 1024 + tid * 2;
    const float* src = (const float*)(a.ws + WS_LOGF) + off; float* dst = (float*)(a.ws + WS_CUM) + off;
    LAS double* wtot = (LAS double*)(L + 0);
    const float v0 = src[0], v1 = src[1]; const double s = (double)v0 + (double)v1; double inc = s;
#pragma unroll
    for (int o = 1; o < 64; o <<= 1) { const double t_ = __shfl_up(inc, o); if (lane >= o) inc += t_; }
    if (lane == 63) wtot[wave] = inc;
    __syncthreads();
    double base = inc - s;
    for (int w = 0; w < wave; ++w) base += wtot[w];
    dst[0] = (float)((base + (double)v0) * (double)LOG2E); dst[1] = (float)((base + s) * (double)LOG2E);
    if (tid == 511) ((float*)(a.ws + WS_TOT))[bh * 8 + blk] = (float)((base + s) * (double)LOG2E);
    __syncthreads();
}
__device__ __forceinline__ void c2_load(const Args& a, LAS unsigned char* L, int bh, int tid, int wave) {
    const float* src = (const float*)(a.ws + WS_CUM) + (size_t)bh * SEQ + tid * 16; const float* tot = (const float*)(a.ws + WS_TOT) + bh * 8;
    LAS float* c2s = (LAS float*)(L + attn_body::LDS_C2);
    double base = 0.0;
    for (int w = 0; w < wave; ++w) base += (double)tot[w];
    const float bf = (float)base;
#pragma unroll
    for (int i = 0; i < 4; ++i) { f32x4 v = *(const f32x4*)(src + 4 * i); v = v + bf; *(LAS f32x4*)(c2s + tid * 16 + 4 * i) = v; }
    __syncthreads();
}

constexpr int RT_GWH = 0, RT_GWL = 65536, RT_GF = 131072, RT_CHE = 135168, RT_CHG = RT_CHE + 2048, RT_LCNT = RT_CHG + 2048, RT_LBASE = RT_LCNT + 128;
static_assert(RT_LBASE + 128 <= LDSCTL_OFF, "router LDS map");
__device__ __forceinline__ void router_phase(const Args& a, LAS unsigned char* L, int vcu, int G, int tid, int lane, int wave) {
    typedef short bf16x8_t __attribute__((ext_vector_type(8))); typedef float f32x16_t __attribute__((ext_vector_type(16)));
    LAS unsigned short* gwh = (LAS unsigned short*)(L + RT_GWH); LAS unsigned short* gwl = (LAS unsigned short*)(L + RT_GWL); LAS float* gf = (LAS float*)(L + RT_GF);
    LAS int* ch_e = (LAS int*)(L + RT_CHE); LAS float* ch_g = (LAS float*)(L + RT_CHG); LAS int* lcnt = (LAS int*)(L + RT_LCNT); LAS int* lbase = (LAS int*)(L + RT_LBASE);
    const float* w_router = a.in[8]; const float* b_router = a.in[9]; const float* g_ffn = a.in[7];
    for (int idx = tid; idx < 1024 * 32; idx += 512) { const int k = idx >> 5, e = idx & 31; const float v = g_ffn[k] * w_router[idx];
        const unsigned hb = f2bf(v); const float hf = __builtin_bit_cast(float, hb << 16); const unsigned lb = f2bf(v - hf);
        const int pos = (((k >> 4) * 2 + ((k >> 3) & 1)) * 32 + e) * 8 + (k & 7); gwh[pos] = (unsigned short)hb; gwl[pos] = (unsigned short)lb; }
    for (int k = tid; k < 1024; k += 512) gf[k] = g_ffn[k];
    __syncthreads();
    const bf16* X1 = (const bf16*)(a.ws + WS_X1B); unsigned char* H2 = a.ws + WS_XN;
    int* cnt = (int*)(a.ws + WS_CTL) + CW_CNT; int* SEL = (int*)(a.ws + WS_SEL); int* LTK = (int*)(a.ws + WS_LTK); float* LGT = (float*)(a.ws + WS_LGT);
    const int j = lane & 31, hlf = lane >> 5;
    for (int grp = vcu; grp < T / 128; grp += G) {
        if (tid < 32) lcnt[tid] = 0;
        __syncthreads();
        if (wave < 4) {
            const int lt = wave * 32 + j, m = grp * 128 + lt;
            const bf16* xr = X1 + (size_t)m * DM + 8 * hlf;
            f32x16_t acc; float ss = 0.f;
#pragma unroll
            for (int r = 0; r < 16; ++r) acc[r] = 0.f;
#pragma unroll 8
            for (int s = 0; s < 64; ++s) {
                const u32x4 xb = *(const u32x4*)(xr + 16 * s);
                const bf16x8_t ah = *(const LAS bf16x8_t*)(gwh + ((s * 2 + hlf) * 32 + j) * 8), al = *(const LAS bf16x8_t*)(gwl + ((s * 2 + hlf) * 32 + j) * 8);
                const bf16x8_t xf = __builtin_bit_cast(bf16x8_t, xb);
                acc = __builtin_amdgcn_mfma_f32_32x32x16_bf16(ah, xf, acc, 0, 0, 0);
                acc = __builtin_amdgcn_mfma_f32_32x32x16_bf16(al, xf, acc, 0, 0, 0);
                const unsigned w_[4] = {xb.x, xb.y, xb.z, xb.w};
#pragma unroll
                for (int q = 0; q < 4; ++q) { const float lo = __builtin_bit_cast(float, w_[q] << 16), hi = __builtin_bit_cast(float, w_[q] & 0xffff0000u); ss += lo * lo + hi * hi; }
            }
            ss += __shfl_xor(ss, 32);
            const float rstd = rsqrtf(ss * (1.f / DM) + RMS_EPS);
            float lv[16];
#pragma unroll
            for (int r = 0; r < 16; ++r) lv[r] = acc[r] * rstd + b_router[(r & 3) + 8 * (r >> 2) + 4 * hlf];
            float tv[4]; int ti[4];
#pragma unroll
            for (int k = 0; k < 4; ++k) { float bv = -INFINITY; int bi = 64;
#pragma unroll
                for (int r = 0; r < 16; ++r) { const int ei = (r & 3) + 8 * (r >> 2) + 4 * hlf; if (lv[r] > bv) { bv = lv[r]; bi = ei; } }
                tv[k] = bv; ti[k] = bi;
#pragma unroll
                for (int r = 0; r < 16; ++r) { const int ei = (r & 3) + 8 * (r >> 2) + 4 * hlf; if (ei == bi) lv[r] = -INFINITY; } }
            float cv[8]; int ci[8];
#pragma unroll
            for (int k = 0; k < 4; ++k) { cv[k] = tv[k]; ci[k] = ti[k]; cv[4 + k] = __shfl_xor(tv[k], 32); ci[4 + k] = __shfl_xor(ti[k], 32); }
#pragma unroll
            for (int k = 0; k < 4; ++k) { float bv = -INFINITY; int bi = 64;
#pragma unroll
                for (int c = 0; c < 8; ++c) if (cv[c] > bv || (cv[c] == bv && ci[c] < bi)) { bv = cv[c]; bi = ci[c]; }
                tv[k] = bv; ti[k] = bi;
#pragma unroll
                for (int c = 0; c < 8; ++c) if (ci[c] == bi) cv[c] = -INFINITY; }
            const float e1 = expf(tv[1] - tv[0]), e2 = expf(tv[2] - tv[0]), e3 = expf(tv[3] - tv[0]); const float inv = 1.f / (1.f + e1 + e2 + e3);
            if (hlf == 0) { ch_e[lt * 4 + 0] = ti[0]; ch_e[lt * 4 + 1] = ti[1]; ch_e[lt * 4 + 2] = ti[2]; ch_e[lt * 4 + 3] = ti[3];
                ch_g[lt * 4 + 0] = inv; ch_g[lt * 4 + 1] = e1 * inv; ch_g[lt * 4 + 2] = e2 * inv; ch_g[lt * 4 + 3] = e3 * inv;
#pragma unroll
                for (int k = 0; k < 4; ++k) __hip_atomic_fetch_add(&lcnt[ti[k]], 1, __ATOMIC_RELAXED, __HIP_MEMORY_SCOPE_WORKGROUP); }
            unsigned char* hr = H2 + (size_t)m * DM + 8 * hlf; const float sc = rstd * pg8::FP8_SA;
#pragma unroll 8
            for (int s = 0; s < 64; ++s) {
                const u32x4 xb = *(const u32x4*)(xr + 16 * s); const unsigned w_[4] = {xb.x, xb.y, xb.z, xb.w};
                const f32x4 g0 = *(const LAS f32x4*)(gf + 16 * s + 8 * hlf), g1 = *(const LAS f32x4*)(gf + 16 * s + 8 * hlf + 4);
                float x_[8];
#pragma unroll
                for (int q = 0; q < 4; ++q) { x_[2 * q] = __builtin_bit_cast(float, w_[q] << 16); x_[2 * q + 1] = __builtin_bit_cast(float, w_[q] & 0xffff0000u); }
                u32x2 o; o.x = pg8::pack4_fp8(x_[0] * g0.x * sc, x_[1] * g0.y * sc, x_[2] * g0.z * sc, x_[3] * g0.w * sc); o.y = pg8::pack4_fp8(x_[4] * g1.x * sc, x_[5] * g1.y * sc, x_[6] * g1.z * sc, x_[7] * g1.w * sc);
                *(u32x2*)(hr + 16 * s) = o;
            }
        }
        __syncthreads();
        if (tid < 32) { lbase[tid] = atomicAdd(&cnt[tid], lcnt[tid]); lcnt[tid] = 0; }
        __syncthreads();
        { const int e = ch_e[tid]; const int slot = lbase[e] + __hip_atomic_fetch_add(&lcnt[e], 1, __ATOMIC_RELAXED, __HIP_MEMORY_SCOPE_WORKGROUP); const int tk = (grp * 128 + (tid >> 2)) * 4 + (tid & 3);
          LTK[(size_t)e * T + slot] = tk; LGT[(size_t)e * T + slot] = ch_g[tid]; SEL[tk] = (slot << 5) | e; }
        __syncthreads();
    }
}

__device__ __forceinline__ void expert_map(const Args& a, volatile LAS unsigned* MISC, int tid) {
    if (tid == 0) { const int* cnt = (const int*)(a.ws + WS_CTL) + CW_CNT; int acc = 0;
        for (int e = 0; e < 32; ++e) { const int c = __hip_atomic_load((int*)cnt + e, RLX_AGENT); MISC[64 + e] = (unsigned)c; MISC[96 + e] = (unsigned)acc; acc += (c + RT - 1) / RT; } MISC[128] = (unsigned)acc; }
    __syncthreads();
}

__device__ __forceinline__ void final_phase(const Args& a, volatile LAS unsigned* MISC, int vcu, int G, int lane, int wave) {
    const int* SEL = (const int*)(a.ws + WS_SEL); const unsigned char* Y = a.ws + WS_Y; const bf16* X1 = (const bf16*)(a.ws + WS_X1B); const float* g_final = a.in[14];
    f32x4 g[4];
#pragma unroll
    for (int j = 0; j < 4; ++j) g[j] = *(const f32x4*)(g_final + 4 * lane + 256 * j);
    typedef float f32x2_t __attribute__((ext_vector_type(2)));
    const int m0 = vcu * 8 + wave, MS = G * 8;
    int svn[4]; u32x2 xbn[4];
#pragma unroll
    for (int k = 0; k < 4; ++k) svn[k] = SEL[m0 * 4 + k];
#pragma unroll
    for (int j = 0; j < 4; ++j) xbn[j] = *(const u32x2*)(X1 + (size_t)m0 * DM + 4 * lane + 256 * j);
    for (int m = m0; m < T; m += MS) {
        f32x4 v[4]; unsigned yv[4][4];
#pragma unroll
        for (int k = 0; k < 4; ++k) { const int e = svn[k] & 31, slot = svn[k] >> 5; const unsigned char* yr = Y + ((size_t)MISC[96 + e] * RT + slot) * DM;
#pragma unroll
            for (int j = 0; j < 4; ++j) yv[k][j] = *(const unsigned*)(yr + 4 * lane + 256 * j); }
#pragma unroll
        for (int j = 0; j < 4; ++j) { const u32x2 xb = xbn[j];
            v[j].x = __builtin_bit_cast(float, xb.x << 16); v[j].y = __builtin_bit_cast(float, xb.x & 0xffff0000u); v[j].z = __builtin_bit_cast(float, xb.y << 16); v[j].w = __builtin_bit_cast(float, xb.y & 0xffff0000u); }
        { const int mn = (m + MS < T) ? m + MS : m;
#pragma unroll
          for (int k = 0; k < 4; ++k) svn[k] = SEL[mn * 4 + k];
#pragma unroll
          for (int j = 0; j < 4; ++j) xbn[j] = *(const u32x2*)(X1 + (size_t)mn * DM + 4 * lane + 256 * j); }
        f32x4 ya[4];
#pragma unroll
        for (int j = 0; j < 4; ++j) ya[j] = (f32x4){0.f, 0.f, 0.f, 0.f};
#pragma unroll
        for (int k = 0; k < 4; ++k)
#pragma unroll
            for (int j = 0; j < 4; ++j) { const unsigned y = yv[k][j];
                const f32x2_t lo = __builtin_amdgcn_cvt_pk_f32_fp8((int)y, false), hi = __builtin_amdgcn_cvt_pk_f32_fp8((int)y, true);
                ya[j].x += lo.x; ya[j].y += lo.y; ya[j].z += hi.x; ya[j].w += hi.y; }
        float ss = 0.f;
#pragma unroll
        for (int j = 0; j < 4; ++j) { v[j] = v[j] + ya[j] * (1.0f / pg8::FP8_SY); ss += v[j].x * v[j].x + v[j].y * v[j].y + v[j].z * v[j].z + v[j].w * v[j].w; }
        const float rstd = rsqrtf(wave_sum(ss) * (1.f / DM) + RMS_EPS);
        float* orow = a.out + (size_t)m * DM;
#pragma unroll
        for (int j = 0; j < 4; ++j) *(f32x4*)(orow + 4 * lane + 256 * j) = v[j] * rstd * g[j];
    }
}

__global__ void __launch_bounds__(NWAVES * 64, 2) mk_fwd(Args args) {
    extern __shared__ __attribute__((aligned(16))) unsigned char lds[];
    LAS unsigned char* L = (LAS unsigned char*)lds;
    volatile LAS unsigned* MISC = (volatile LAS unsigned*)(L + LDSCTL_OFF);
    const int tid = threadIdx.x, lane = tid & 63, wave = __builtin_amdgcn_readfirstlane(tid >> 6);
    const int G = gridDim.x; const int bx = blockIdx.x; const int vcu = (G % 8 == 0) ? (bx % 8) * (G / 8) + bx / 8 : bx;
    unsigned char* ws = args.ws;
    for (int u = tid; u < (LDS_TOTAL - LDSCTL_OFF) / 4; u += NWAVES * 64) ((LAS unsigned*)(L + LDSCTL_OFF))[u] = 0u;
    __syncthreads();
    XcdBarrier bar; bar.bar = (unsigned*)(ws + WS_CTL) + CW_BAR; bar.x = 0; bar.st = nullptr;
    if (args.use_bar) bar = xcd_barrier_post((unsigned*)(ws + WS_CTL) + CW_BAR, MISC + 8);
    const int lo = args.ph_lo, hi = args.ph_hi;
#define IN(k) (lo <= (k) && (k) < hi)
#define SEAM(k) do { if (IN(k) && IN((k) + 1)) xcd_barrier(bar); } while (0)
#ifndef MK_DUP
#define MK_DUP -1
#endif
#ifndef MK_TPROBE
#define MK_TPROBE -1
#endif
#define CK0(k) do { if ((MK_TPROBE) == 100 + (k) && bx == 0 && tid == 0) { const unsigned long long c_ = __builtin_amdgcn_s_memtime(); const unsigned long long t_ = __builtin_amdgcn_s_memrealtime(); MISC[28] = (unsigned)c_; MISC[29] = (unsigned)(c_ >> 32); MISC[16] = (unsigned)t_; MISC[17] = (unsigned)(t_ >> 32); } } while (0)
#define CK1(k) do { if ((MK_TPROBE) == 100 + (k) && bx == 0 && tid == 0) { const unsigned long long c_ = __builtin_amdgcn_s_memtime(); const unsigned long long t_ = __builtin_amdgcn_s_memrealtime(); const unsigned long long c0_ = ((unsigned long long)MISC[29] << 32) | MISC[28], t0_ = ((unsigned long long)MISC[17] << 32) | MISC[16]; \
    const unsigned long long spin_ = (c_ - c0_) * 1000ull / (t_ - t0_); MISC[18] = (unsigned)(t0_ + spin_); MISC[19] = (unsigned)((t0_ + spin_) >> 32); } } while (0)
#define TP0(k) do { if ((MK_TPROBE) == (k) && bx == 0 && tid == 0) { const unsigned long long t_ = __builtin_amdgcn_s_memrealtime(); MISC[16] = (unsigned)t_; MISC[17] = (unsigned)(t_ >> 32); } } while (0)
#define TP1(k) do { if ((MK_TPROBE) == (k) && bx == 0 && tid == 0) { const unsigned long long t_ = __builtin_amdgcn_s_memrealtime(); MISC[18] = (unsigned)t_; MISC[19] = (unsigned)(t_ >> 32); } } while (0)
#define REPS(k) for (int rep_ = 0; rep_ < ((MK_DUP) == (k) ? 2 : 1); ++rep_, ((MK_DUP) == (k) && rep_ == 1 ? xcd_barrier(bar) : (void)0))

    TP0(0); CK0(0); TP0(200);
    if ((MK_TPROBE) == 300 || (MK_TPROBE) == 301) {
        if (bx == 0 && tid < 64) { typedef int v8i_ __attribute__((ext_vector_type(8))); typedef short s8_ __attribute__((ext_vector_type(8)));
            pg8::f32x4 c0 = {0, 0, 0, 0}, c1 = c0, c2 = c0, c3 = c0; v8i_ a8 = {tid, 1, 2, 3, 4, 5, 6, 7}, b8 = {7, 6, 5, 4, 3, 2, 1, tid}; s8_ a4 = {1, 2, 3, 4, 5, 6, 7, 8}, b4 = a4;
            const unsigned long long t0_ = __builtin_amdgcn_s_memtime();
            for (int it = 0; it < 1024; ++it) {
                if ((MK_TPROBE) == 300) { asm volatile("v_mfma_f32_16x16x128_f8f6f4 %0, %1, %2, %0" : "+v"(c0) : "v"(a8), "v"(b8)); asm volatile("v_mfma_f32_16x16x128_f8f6f4 %0, %1, %2, %0" : "+v"(c1) : "v"(a8), "v"(b8));
                    asm volatile("v_mfma_f32_16x16x128_f8f6f4 %0, %1, %2, %0" : "+v"(c2) : "v"(a8), "v"(b8)); asm volatile("v_mfma_f32_16x16x128_f8f6f4 %0, %1, %2, %0" : "+v"(c3) : "v"(a8), "v"(b8)); }
                else { c0 = __builtin_amdgcn_mfma_f32_16x16x32_bf16(a4, b4, c0, 0, 0, 0); c1 = __builtin_amdgcn_mfma_f32_16x16x32_bf16(a4, b4, c1, 0, 0, 0); c2 = __builtin_amdgcn_mfma_f32_16x16x32_bf16(a4, b4, c2, 0, 0, 0); c3 = __builtin_amdgcn_mfma_f32_16x16x32_bf16(a4, b4, c3, 0, 0, 0); } }
            asm volatile("s_nop 15\n\ts_nop 15" ::: "memory");
            const unsigned long long t1_ = __builtin_amdgcn_s_memtime();
            asm volatile("" :: "v"(c0), "v"(c1), "v"(c2), "v"(c3));
            if (tid == 0) MISC[21] = (unsigned)((t1_ - t0_) * 1000ull / 4096ull); } }
    if (IN(0)) REPS(0) { phase0(args, L, vcu, G, tid, lane, wave); }
    CK1(0); SEAM(0); TP1(0); TP0(1); CK0(1);
    if (IN(1)) REPS(1) {
        pg8::Gemm g{(const bf16*)(ws + WS_XN), (const bf16*)(ws + WS_WIN), DM}; pg8::StaticOrder S; S.init(T, 2048, G, bx);
        c2_local_scan(args, L, bx, tid, lane, wave);
        pg8::EpiInproj E{(bf16*)(ws + WS_U), (size_t)(WS_Q - WS_U) / 2, C2, (unsigned*)(ws + WS_CTL) + CW_NRM};
        pg8::gemm_phase<pg8::EpiInproj, pg8::StaticOrder, true, false>(L + RING_OFF, g, S, E, nullptr);
    }
    CK1(1); SEAM(1); TP1(1); TP0(2); CK0(2);
    if (IN(2)) {
        constexpr unsigned NQ_POOL = T / 128, NQA = NQ_POOL + 1024, NQC = CONV_P2_CHUNKS;
        unsigned* qhead = (unsigned*)(ws + WS_CTL) + CW_Q; const float* nrm = (const float*)(ws + WS_CTL) + CW_NRM;
        const attn_body::AttnTensors AT{(const attn_body::bf16*)(ws + WS_Q), (const attn_body::bf16*)(ws + WS_K), (const attn_body::bf16*)(ws + WS_V), (attn_body::bf16*)(ws + WS_CAT) + PW};
        const int pref = ((bx & 3) == 0) ? 1 : 0;
#define QT0() unsigned long long tq0_ = 0; if ((MK_TPROBE) >= 26 && (MK_TPROBE) <= 29 && threadIdx.x == 0) tq0_ = __builtin_amdgcn_s_memrealtime()
#define QT1(kind) do { if ((MK_TPROBE) == (kind) && threadIdx.x == 0) atomicAdd((unsigned*)(ws + WS_CTL) + 512, (unsigned)(__builtin_amdgcn_s_memrealtime() - tq0_)); } while (0)
#define CONV_LOOP() do { unsigned pend_ = 0; int sl_ = 0; if (threadIdx.x == 0) pend_ = atomicAdd(qhead + 64, 1u); \
        for (;;) { int tid_ = threadIdx.x; asm volatile("" : "+v"(tid_));   \
            if (tid_ == 0) MISC[24 + sl_] = pend_; __syncthreads(); const unsigned q = MISC[24 + sl_]; sl_ ^= 1; if (q >= NQC) break; \
            if (tid_ == 0) pend_ = atomicAdd(qhead + 64, 1u); \
            QT0(); conv_chunk(args, (int)q, tid_ & 63, tid_ >> 6); QT1(28); } } while (0)
        if (pref) { CONV_LOOP(); __syncthreads(); }
        { int sl_ = 0;
        for (;;) {
            int tid_ = threadIdx.x; asm volatile("" : "+v"(tid_));
            if (tid_ == 0) MISC[26 + sl_] = atomicAdd(qhead, 1u);
            __syncthreads();
            const unsigned q = MISC[26 + sl_]; sl_ ^= 1;
            if (q >= NQA) break;
            QT0();
            if (q < NQ_POOL) { pool_chunk(args, (int)q, tid_); }
            else { const int grp = (int)(q - NQ_POOL), qb = 31 - (grp >> 5), bh = grp & 31;
                c2_load(args, L, bh, tid_, tid_ >> 6);
                const float qkb2 = 4.0f * sqrtf(nrm[bh] * nrm[32 + bh]) * 1.001f;
                attn_body::attn_unit<8>(bh / NH, bh % NH, qb, AT.Q, AT.K, AT.V, AT.O, (char*)lds + RING_OFF, qkb2); }
            if (q < NQ_POOL) QT1(26); else QT1(27);
        } }
        __syncthreads();
        CONV_LOOP();
#undef CONV_LOOP
    }
    CK1(2); SEAM(2); TP1(2); TP0(3); CK0(3);
    if (IN(3)) REPS(3) {
        pg8::Gemm g{(const bf16*)(ws + WS_CAT), (const bf16*)(ws + WS_WO), DM}; pg8::StaticOrder S; S.init(T, DM, G, bx);
        pg8::EpiResBf16 E{args.in[0], (bf16*)(ws + WS_X1B)};
        pg8::gemm_phase<pg8::EpiResBf16, pg8::StaticOrder, true, false>(L + RING_OFF, g, S, E, nullptr);
    }
    CK1(3); SEAM(3); TP1(3); TP0(4); CK0(4);
    if (IN(4)) { router_phase(args, L, vcu, G, tid, lane, wave); }
    CK1(4); SEAM(4); TP1(4); TP0(5); CK0(5);
    if (IN(5)) REPS(5) {
        TP0(51); expert_map(args, MISC, tid);
        const LAS int* pt = (const LAS int*)(L + LDSCTL_OFF + 96 * 4); const LAS int* cn = (const LAS int*)(L + LDSCTL_OFF + 64 * 4);
        LAS unsigned* tab = (LAS unsigned*)(L + TAB_OFF);
        LAS int* ul = (LAS int*)(L + LDSCTL_OFF + 132 * 4);
        pg8::MoeOrder<8>::build(ul, pt, bx, tid);
        const pg8::MoeOrder<8> S{ul, (size_t)2048 * DM};
        { const int* LTK = (const int*)(ws + WS_LTK); const int nu = ul[0];
          for (int idx = tid; idx < nu * 256; idx += NWAVES * 64) { const int i = idx >> 8, r = idx & 255, e = ul[6 + 4 * i], slot = ul[7 + 4 * i] + r;
              const int tok = slot < cn[e] ? (LTK[(size_t)e * T + slot] >> 2) : 0; tab[idx] = (unsigned)tok * (unsigned)DM; } }
        __syncthreads(); TP1(51);
        pg8::Gemm g{(const bf16*)(ws + WS_XN), (const bf16*)(ws + WS_WU), DM / 2};
        pg8::EpiSwiglu8 E{ws + WS_ACT, args.in[11]};
        pg8::gemm_phase<pg8::EpiSwiglu8, pg8::MoeOrder<8>, true, true, true>(L + RING_OFF, g, S, E, tab, ((MK_TPROBE) == 52 && bx == 0) ? (volatile LAS unsigned*)(MISC + 20) : nullptr);
    }
    CK1(5); SEAM(5); TP1(5); TP0(6); CK0(6);
    if (IN(6)) REPS(6) {
        expert_map(args, MISC, tid);
        const LAS int* pt = (const LAS int*)(L + LDSCTL_OFF + 96 * 4); const LAS int* cn = (const LAS int*)(L + LDSCTL_OFF + 64 * 4);
        LAS int* ul = (LAS int*)(L + LDSCTL_OFF + 132 * 4);
        pg8::MoeOrder<4>::build(ul, pt, bx, tid);
        const pg8::MoeOrder<4> S{ul, (size_t)DM * DE};
        pg8::Gemm g{(const bf16*)(ws + WS_ACT), (const bf16*)(ws + WS_WD), DE / 2};
        pg8::EpiDown E{ws + WS_Y, args.in[13], (const float*)(ws + WS_LGT), cn, T, pg8::FP8_INV};
        pg8::gemm_phase<pg8::EpiDown, pg8::MoeOrder<4>, true, false, true>(L + RING_OFF, g, S, E, nullptr);
    }
    CK1(6); SEAM(6); TP1(6); TP0(7); CK0(7); TP0(70);
    if (IN(7)) { expert_map(args, MISC, tid); final_phase(args, MISC, vcu, G, lane, wave); }
    if ((MK_TPROBE) == 70) { xcd_barrier(bar); }
    TP1(7); TP1(70); TP1(200);
    if ((MK_TPROBE) >= 0 && bx == 0) { __syncthreads(); const unsigned long long ta = ((unsigned long long)MISC[17] << 32) | MISC[16], tb = ((MK_TPROBE) == 300 || (MK_TPROBE) == 301) ? ta + MISC[21] : ((MK_TPROBE) >= 26 && (MK_TPROBE) <= 29) ? ta + (__hip_atomic_load((unsigned*)(ws + WS_CTL) + 512, RLX_AGENT) >> 8) : ((MK_TPROBE) == 52 || ((MK_TPROBE) >= 23 && (MK_TPROBE) <= 25)) ? ta + MISC[20] : (((unsigned long long)MISC[19] << 32) | MISC[18]);
        const unsigned long long tend = __builtin_amdgcn_s_memrealtime() + (tb - ta); while (__builtin_amdgcn_s_memrealtime() < tend) __builtin_amdgcn_s_sleep(10); }
#undef IN
#undef SEAM
}
#ifndef MK_MODE
#define MK_MODE 1
#endif
#ifndef MK_NAIVE_MASK
#define MK_NAIVE_MASK 0
#endif
extern "C" void kernel_launch(void* const* d_in, const int* in_sizes, int n_in, void* d_out, int out_size, void* d_ws, size_t ws_size, hipStream_t stream) {
    if (n_in != 15 || out_size != T * DM || ws_size < WS_END) { fprintf(stderr, "kernel_launch: unexpected shapes (n_in %d out %d ws %zu)\n", n_in, out_size, ws_size); return; }
    Params p{};
    p.x = (const float*)d_in[0]; p.g_mix = (const float*)d_in[1]; p.w_in = (const float*)d_in[2]; p.b_forget = (const float*)d_in[3]; p.w_pool = (const float*)d_in[4];
    p.pool_scale = (const float*)d_in[5]; p.w_out = (const float*)d_in[6]; p.g_ffn = (const float*)d_in[7]; p.w_router = (const float*)d_in[8]; p.b_router = (const float*)d_in[9];
    p.w_up = (const float*)d_in[10]; p.b_up = (const float*)d_in[11]; p.w_down = (const float*)d_in[12]; p.b_down = (const float*)d_in[13]; p.g_final = (const float*)d_in[14];
    p.out = (float*)d_out; p.ws = (unsigned char*)d_ws;
    Args a{};
    for (int i = 0; i < 15; ++i) a.in[i] = (const float*)d_in[i];
    a.out = (float*)d_out; a.ws = (unsigned char*)d_ws;
    static bool attr_done = false;
    if (!attr_done) { if (hipFuncSetAttribute((const void*)mk_fwd, hipFuncAttributeMaxDynamicSharedMemorySize, LDS_TOTAL) != hipSuccess) fprintf(stderr, "kernel_launch: hipFuncSetAttribute failed\n"); attr_done = true; }
    (void)hipMemsetAsync((char*)d_ws + WS_CTL, 0, 1 * MiB, stream);
    const int GRID = 256;
#if MK_MODE == 2
    a.ph_lo = 0; a.ph_hi = N_PHASES; a.use_bar = 1;
    hipLaunchKernelGGL(mk_fwd, dim3(GRID), dim3(NWAVES * 64), LDS_TOTAL, stream, a);
#else
    const unsigned mask = (MK_MODE == 0) ? 0xffu : (unsigned)(MK_NAIVE_MASK);
    auto fast = [&](int k) { a.ph_lo = k; a.ph_hi = k + 1; a.use_bar = 0; hipLaunchKernelGGL(mk_fwd, dim3(GRID), dim3(NWAVES * 64), LDS_TOTAL, stream, a); };
    auto nv = [&](int k) { return (mask >> k) & 1u; };
    if (mask != 0xffu || !nv(0)) fast(0);
    if (nv(0)) k_prologue<<<1024, 512, 0, stream>>>(p);
    if (nv(1)) k_inproj_naive<<<2048, 512, 0, stream>>>(p); else fast(1);
    if (nv(2)) { k_cumsum<<<32, 512, 0, stream>>>(p); k_attn_naive<<<BATCH * NH * (SEQ / 64), 512, 0, stream>>>(p); if (!nv(3)) k_pool<<<2048, 512, 0, stream>>>(p, (bf16*)((unsigned char*)d_ws + WS_CAT), DM); }
    else fast(2);
    if (nv(3)) { k_pool<<<2048, 512, 0, stream>>>(p, (bf16*)((unsigned char*)d_ws + WS_P), PW); k_poolgemm_naive<<<2048, 512, 0, stream>>>(p); k_outproj_naive<<<2048, 512, 0, stream>>>(p); }
    else fast(3);
    if (nv(4)) k_router<<<256, 512, 0, stream>>>(p); else fast(4);
    if (nv(5)) k_up_naive<<<4096, 512, 0, stream>>>(p); else fast(5);
    if (nv(6)) k_down_naive<<<4096, 512, 0, stream>>>(p); else fast(6);
    if (nv(7)) k_final<<<1024, 512, 0, stream>>>(p); else fast(7);
#endif
}
```

```cpp
#include <hip/hip_runtime.h>
#include <cstdio>
#include <cstdint>

constexpr int BATCH = 4, SEQ = 8192, DM = 1024, T = BATCH * SEQ;
constexpr int PW = 512, AW = 512, NH = 8, HD = 64, INW = PW + 3 * AW + NH;
constexpr int NE = 32, TOPK = 4, DE = 1024;
constexpr float RMS_EPS = 1e-5f, SW_LIMIT = 7.0f, SW_ALPHA = 1.702f;
constexpr float LOG2E = 1.4426950408889634f;
constexpr float C2 = 0.125f * LOG2E;
constexpr int RT = 256;
constexpr int NROWS_PAD = T * TOPK + NE * RT;

typedef unsigned short bf16;
typedef float f32x4 __attribute__((ext_vector_type(4)));
typedef unsigned u32x4 __attribute__((ext_vector_type(4)));
typedef unsigned u32x2 __attribute__((ext_vector_type(2)));

constexpr size_t MiB = 1u << 20;
constexpr size_t WS_CTL = 0;
constexpr size_t WS_LOGF = 1 * MiB;
constexpr size_t WS_CUM = 2 * MiB;
constexpr size_t WS_SEL = 3 * MiB;
constexpr size_t WS_LTK = 4 * MiB;
constexpr size_t WS_LGT = 8 * MiB;
constexpr size_t WS_XN = 12 * MiB;
constexpr size_t WS_WIN = 76 * MiB;
constexpr size_t WS_WO = 80 * MiB;
constexpr size_t WS_WU = 82 * MiB;
constexpr size_t WS_WD = 210 * MiB;
constexpr size_t WS_U = 274 * MiB;
constexpr size_t WS_Q = 306 * MiB;
constexpr size_t WS_K = 338 * MiB;
constexpr size_t WS_V = 370 * MiB;
constexpr size_t WS_CAT = 402 * MiB;
constexpr size_t WS_P = 466 * MiB;
constexpr size_t WS_ACT = 274 * MiB;
constexpr size_t WS_Y = 546 * MiB;
constexpr size_t WS_END = 818 * MiB;
static_assert(WS_ACT + (size_t)NROWS_PAD * 1024 * 2 <= WS_Y, "ACT overlay");
static_assert(WS_Y + (size_t)NROWS_PAD * 1024 * 2 <= WS_END, "Y");
constexpr int CW_CNT = 64;


__device__ __forceinline__ unsigned f2bf(float f) { unsigned u = __builtin_bit_cast(unsigned, f); return (u + 0x7fffu + ((u >> 16) & 1u)) >> 16; }
__device__ __forceinline__ unsigned pk2(float lo, float hi) { return f2bf(lo) | (f2bf(hi) << 16); }
__device__ __forceinline__ float bf2f(unsigned short b) { return __builtin_bit_cast(float, (unsigned)b << 16); }
__device__ __forceinline__ float wave_sum(float v) {
#pragma unroll
    for (int o = 1; o < 64; o <<= 1) v += __shfl_xor(v, o);
    return v;
}

namespace pg8 {
#define PG8_LAS __attribute__((address_space(3)))
typedef unsigned short bf16_t;
typedef short bf16x8 __attribute__((ext_vector_type(8)));
typedef float f32x4 __attribute__((ext_vector_type(4)));
typedef unsigned u32x4 __attribute__((ext_vector_type(4)));
constexpr int BM = 256, BK = 64, HALF = 128, HTB = HALF * BK * 2  , STAGE_BYTES = 8 * HTB, NXCD = 8, WGM = 8;

__host__ __device__ __forceinline__ int lds_byte(int r, int c) { const int ch = (c >> 3) ^ ((r >> 1) & 7); return (r >> 3) * 1024 + (r & 7) * 128 + ch * 16 + (c & 7) * 2; }
__host__ __device__ __forceinline__ void stage_rc(int b, int& R, int& C) { const int st = b >> 10, sb = b & 1023; R = st * 8 + (sb >> 7); C = ((((sb >> 4) & 7) ^ ((R >> 1) & 7)) * 8); }
__host__ __device__ __forceinline__ int perm32(int rho) { const int n = rho >> 4, i = rho & 15; return 8 * (i >> 2) + 4 * n + (i & 3); }

struct Unit { int pm, pn, e, lrow0; size_t boff; };
struct Gemm { const bf16_t* A; const bf16_t* Bt; int K; };

struct StaticOrder {
    int nM, nN, nwg, G, c;
    __host__ __device__ void init(int M, int N, int G_, int c_) { nM = M / BM; nN = N / BM; nwg = nM * nN; G = G_; c = c_; }
    __host__ __device__ bool next(int i, Unit& u) const {
        const long L = (long)i * G + c; if (L >= nwg) return false;
        int wgid = (int)L; { const int q = nwg / NXCD, r = nwg % NXCD, xcd = wgid % NXCD, off = wgid / NXCD; wgid = (xcd < r ? xcd * (q + 1) : r * (q + 1) + (xcd - r) * q) + off; }
        const int nig = WGM * nN, gid = wgid / nig, fm = gid * WGM, gsz = (nM - fm) < WGM ? (nM - fm) : WGM;
        u.pm = fm + ((wgid % nig) % gsz); u.pn = (wgid % nig) / gsz; u.e = 0; u.lrow0 = 0; u.boff = 0; return true;
    }
};
template <int NCOL> struct MoeOrder {
    static constexpr int RG = 32 / NCOL;
    const PG8_LAS int* ul; size_t bstride;
    static __device__ __forceinline__ void build(PG8_LAS int* ul, const PG8_LAS int* pt, int c, int tid) {
        const int nrt = pt[32]; const int x = c & 7, j = c >> 3;
        const int lo = (nrt * x) >> 3, hi = (nrt * (x + 1)) >> 3;
        if (tid < 32) { const int rt = lo + RG * tid + j / NCOL;
            if (rt < hi) { int e = 0; for (int k = 1; k < 32; ++k) e += (pt[k] <= rt) ? 1 : 0;
                ul[4 + 4 * tid] = rt; ul[5 + 4 * tid] = j % NCOL; ul[6 + 4 * tid] = e; ul[7 + 4 * tid] = (rt - pt[e]) * BM; } }
        if (tid == 0) { const int span = hi - (lo + j / NCOL); ul[0] = span > 0 ? (span + RG - 1) / RG : 0; }
        __syncthreads();
    }
    __device__ __forceinline__ bool next(int i, Unit& u) const {
        if (i >= ul[0]) return false;
        u.pm = ul[4 + 4 * i]; u.pn = ul[5 + 4 * i]; u.e = ul[6 + 4 * i]; u.lrow0 = ul[7 + 4 * i]; u.boff = (size_t)u.e * bstride; return true;
    }
};

__device__ __forceinline__ unsigned cvt_pk_bf16(float lo, float hi) { unsigned r; asm volatile("v_cvt_pk_bf16_f32 %0, %1, %2" : "=v"(r) : "v"(lo), "v"(hi)); return r; }

struct EpiInproj {
    static constexpr bool PERM = true; static constexpr int NST = 16;
    bf16_t* O; size_t split_stride; float qscale; unsigned* nrm;
    __device__ __forceinline__ void operator()(const f32x4 (&acc)[2][2][4][2], const Unit& u, int wr, int wc, int fr, int fq) const {
        const int row0 = u.pm * BM + wr * 64 + fr; int colt = u.pn * BM; const int t = colt >> 9; bf16_t* base = O + (size_t)t * split_stride; colt -= t * 512;
        const float sc = (t == 1) ? qscale : 1.f; const int col0 = colt + wc * 32 + 8 * fq;
#pragma unroll
        for (int ai = 0; ai < 2; ++ai)
#pragma unroll
            for (int m = 0; m < 4; ++m) { bf16_t* rowp = base + (size_t)(row0 + ai * HALF + m * 16) * 512 + col0;
#pragma unroll
                for (int bj = 0; bj < 2; ++bj) { const f32x4 v0 = acc[ai][bj][m][0] * sc, v1 = acc[ai][bj][m][1] * sc;
                    u32x4 w; w.x = cvt_pk_bf16(v0[0], v0[1]); w.y = cvt_pk_bf16(v0[2], v0[3]); w.z = cvt_pk_bf16(v1[0], v1[1]); w.w = cvt_pk_bf16(v1[2], v1[3]);
                    *(u32x4*)(rowp + bj * HALF) = w; } }
        if (t == 1 || t == 2) {
            float mx[2] = {0.f, 0.f};
#pragma unroll
            for (int ai = 0; ai < 2; ++ai)
#pragma unroll
                for (int m = 0; m < 4; ++m)
#pragma unroll
                    for (int bj = 0; bj < 2; ++bj) { const f32x4 v0 = acc[ai][bj][m][0] * sc, v1 = acc[ai][bj][m][1] * sc;
                        float s8 = v0[0] * v0[0] + v0[1] * v0[1] + v0[2] * v0[2] + v0[3] * v0[3] + v1[0] * v1[0] + v1[1] * v1[1] + v1[2] * v1[2] + v1[3] * v1[3];
                        s8 += __shfl_xor(s8, 16); s8 += __shfl_xor(s8, 32); mx[bj] = fmaxf(mx[bj], s8); }
#pragma unroll
            for (int bj = 0; bj < 2; ++bj) {
#pragma unroll
                for (int o = 1; o < 16; o <<= 1) mx[bj] = fmaxf(mx[bj], __shfl_xor(mx[bj], o));
                if ((threadIdx.x & 63) == 0) { const int head = ((u.pn & 1) * 256 + bj * HALF + wc * 32) >> 6, b = (u.pm * BM) >> 13;
                    atomicMax(nrm + (t - 1) * 32 + b * 8 + head, __float_as_uint(mx[bj] * 1.01f)); } }
        }
    }
};
struct EpiResBf16 {
    static constexpr bool PERM = true; static constexpr int NST = 16;
    const float* x; bf16_t* out;
    __device__ __forceinline__ void operator()(const f32x4 (&acc)[2][2][4][2], const Unit& u, int wr, int wc, int fr, int fq) const {
        const int row0 = u.pm * BM + wr * 64 + fr, col0 = u.pn * BM + wc * 32 + 8 * fq;
        f32x4 xa[2][2][2], xb[2][2][2];
#define PG8_XLOAD(dst, b) do { _Pragma("unroll") for (int mm = 0; mm < 2; ++mm) { const size_t off_ = (size_t)(row0 + ((b) >> 1) * HALF + (((b) & 1) * 2 + mm) * 16) * 1024 + col0; \
            _Pragma("unroll") for (int bj = 0; bj < 2; ++bj) { dst[mm][bj][0] = *(const f32x4*)(x + off_ + bj * HALF); dst[mm][bj][1] = *(const f32x4*)(x + off_ + bj * HALF + 4); } } } while (0)
#define PG8_XSTORE(src, b) do { _Pragma("unroll") for (int mm = 0; mm < 2; ++mm) { const int ai = (b) >> 1, m = ((b) & 1) * 2 + mm; const size_t off_ = (size_t)(row0 + ai * HALF + m * 16) * 1024 + col0; \
            _Pragma("unroll") for (int bj = 0; bj < 2; ++bj) { const f32x4 v0 = src[mm][bj][0] + acc[ai][bj][m][0], v1 = src[mm][bj][1] + acc[ai][bj][m][1]; \
                u32x4 w; w.x = cvt_pk_bf16(v0[0], v0[1]); w.y = cvt_pk_bf16(v0[2], v0[3]); w.z = cvt_pk_bf16(v1[0], v1[1]); w.w = cvt_pk_bf16(v1[2], v1[3]); *(u32x4*)(out + off_ + bj * HALF) = w; } } } while (0)
        PG8_XLOAD(xa, 0); PG8_XLOAD(xb, 1);
        asm volatile("" ::: "memory");
        PG8_XSTORE(xa, 0); PG8_XLOAD(xa, 2);
        asm volatile("" ::: "memory");
        PG8_XSTORE(xb, 1); PG8_XLOAD(xb, 3);
        asm volatile("" ::: "memory");
        PG8_XSTORE(xa, 2);
        PG8_XSTORE(xb, 3);
#undef PG8_XLOAD
#undef PG8_XSTORE
    }
};
__device__ __forceinline__ float swiglu1(float g, float l) {
    const float gl = fminf(g, 7.0f), li = fminf(fmaxf(l, -7.0f), 7.0f);
    const float sg = __builtin_amdgcn_rcpf(1.0f + __builtin_amdgcn_exp2f(gl * (-1.702f * 1.4426950408889634f)));
    return gl * sg * (li + 1.0f);
}
struct EpiSwiglu {
    static constexpr bool PERM = true; static constexpr int NST = 8;
    bf16_t* ACT; const float* bup;
    __device__ __forceinline__ void operator()(const f32x4 (&acc)[2][2][4][2], const Unit& u, int wr, int wc, int fr, int fq) const {
        const int row0 = u.pm * BM + wr * 64 + fr, col0 = u.pn * HALF + wc * 32 + 8 * fq;
        const float* bb = bup + (size_t)u.e * 2048 + col0;
        f32x4 bg[2], bl[2];
#pragma unroll
        for (int n = 0; n < 2; ++n) { bg[n] = *(const f32x4*)(bb + 4 * n); bl[n] = *(const f32x4*)(bb + 1024 + 4 * n); }
#pragma unroll
        for (int ai = 0; ai < 2; ++ai)
#pragma unroll
            for (int m = 0; m < 4; ++m) { bf16_t* rowp = ACT + (size_t)(row0 + ai * HALF + m * 16) * 1024 + col0;
                const f32x4 g0 = acc[ai][0][m][0] + bg[0], g1 = acc[ai][0][m][1] + bg[1], l0 = acc[ai][1][m][0] + bl[0], l1 = acc[ai][1][m][1] + bl[1];
                u32x4 w; w.x = cvt_pk_bf16(swiglu1(g0[0], l0[0]), swiglu1(g0[1], l0[1])); w.y = cvt_pk_bf16(swiglu1(g0[2], l0[2]), swiglu1(g0[3], l0[3]));
                w.z = cvt_pk_bf16(swiglu1(g1[0], l1[0]), swiglu1(g1[1], l1[1])); w.w = cvt_pk_bf16(swiglu1(g1[2], l1[2]), swiglu1(g1[3], l1[3]));
                *(u32x4*)rowp = w; }
    }
};

constexpr float FP8_SA = 4.0f, FP8_SW = 256.0f, FP8_INV = 1.0f / (FP8_SA * FP8_SW), FP8_SY = 16.0f;
__device__ __forceinline__ unsigned pack4_fp8(float a, float b, float c, float d) { unsigned p = 0; p = __builtin_amdgcn_cvt_pk_fp8_f32(a, b, p, false); p = __builtin_amdgcn_cvt_pk_fp8_f32(c, d, p, true); return p; }
struct EpiSwiglu8 {
    static constexpr bool PERM = true; static constexpr int NST = 8;
    unsigned char* ACT; const float* bup;
    __device__ __forceinline__ void operator()(const f32x4 (&acc)[2][2][4][2], const Unit& u, int wr, int wc, int fr, int fq) const {
        const int row0 = u.pm * BM + wr * 64 + fr, col0 = u.pn * HALF + wc * 32 + 8 * fq;
        const float* bb = bup + (size_t)u.e * 2048 + col0;
        f32x4 bg[2], bl[2];
#pragma unroll
        for (int n = 0; n < 2; ++n) { bg[n] = *(const f32x4*)(bb + 4 * n); bl[n] = *(const f32x4*)(bb + 1024 + 4 * n); }
#pragma unroll
        for (int ai = 0; ai < 2; ++ai)
#pragma unroll
            for (int m = 0; m < 4; ++m) { unsigned char* rowp = ACT + (size_t)(row0 + ai * HALF + m * 16) * 1024 + col0;
                const f32x4 g0 = acc[ai][0][m][0] * FP8_INV + bg[0], g1 = acc[ai][0][m][1] * FP8_INV + bg[1], l0 = acc[ai][1][m][0] * FP8_INV + bl[0], l1 = acc[ai][1][m][1] * FP8_INV + bl[1];
                typedef unsigned u32x2_t __attribute__((ext_vector_type(2))); u32x2_t w;
                w.x = pack4_fp8(swiglu1(g0[0], l0[0]) * FP8_SA, swiglu1(g0[1], l0[1]) * FP8_SA, swiglu1(g0[2], l0[2]) * FP8_SA, swiglu1(g0[3], l0[3]) * FP8_SA);
                w.y = pack4_fp8(swiglu1(g1[0], l1[0]) * FP8_SA, swiglu1(g1[1], l1[1]) * FP8_SA, swiglu1(g1[2], l1[2]) * FP8_SA, swiglu1(g1[3], l1[3]) * FP8_SA);
                *(u32x2_t*)rowp = w; }
    }
};
struct EpiDown {
    static constexpr bool PERM = true; static constexpr int NST = 16;
    unsigned char* Y; const float* bdn; const float* lgt; const PG8_LAS int* cnt; int Ttok; float ascale;
    __device__ __forceinline__ void operator()(const f32x4 (&acc)[2][2][4][2], const Unit& u, int wr, int wc, int fr, int fq) const {
        const int rl = wr * 64 + fr, col0 = u.pn * BM + wc * 32 + 8 * fq; const int ce = cnt[u.e];
        const float* bb = bdn + (size_t)u.e * 1024 + col0; const float* gp = lgt + (size_t)u.e * Ttok + u.lrow0;
        f32x4 bv[2][2];
#pragma unroll
        for (int bj = 0; bj < 2; ++bj)
#pragma unroll
            for (int n = 0; n < 2; ++n) bv[bj][n] = *(const f32x4*)(bb + bj * HALF + 4 * n);
#pragma unroll
        for (int ai = 0; ai < 2; ++ai)
#pragma unroll
            for (int m = 0; m < 4; ++m) { const int r = rl + ai * HALF + m * 16; const float gt = (u.lrow0 + r < ce) ? gp[r] * FP8_SY : 0.f;
                unsigned char* rowp = Y + (size_t)(u.pm * BM + r) * 1024 + col0;
#pragma unroll
                for (int bj = 0; bj < 2; ++bj) { const f32x4 v0 = (acc[ai][bj][m][0] * ascale + bv[bj][0]) * gt, v1 = (acc[ai][bj][m][1] * ascale + bv[bj][1]) * gt;
                    typedef unsigned u32x2_t __attribute__((ext_vector_type(2))); u32x2_t w; w.x = pack4_fp8(v0[0], v0[1], v0[2], v0[3]); w.y = pack4_fp8(v1[0], v1[1], v1[2], v1[3]);
                    *(u32x2_t*)(rowp + bj * HALF) = w; } }
    }
};

typedef int v4i_t __attribute__((ext_vector_type(4)));
typedef int v8i_t __attribute__((ext_vector_type(8)));
template <class Epi, class Sched, bool ALIGN_EPI, bool GATHER, bool FP8 = false>
__device__ __forceinline__ void gemm_phase(PG8_LAS unsigned char* lds, const Gemm g, const Sched& S, const Epi& E, const PG8_LAS unsigned* tab, volatile PG8_LAS unsigned* prb = nullptr) {
    const int tid = threadIdx.x, wid = __builtin_amdgcn_readfirstlane(tid >> 6), lane = tid & 63, wr = wid >> 2, wc = wid & 3, fr = lane & 15, fq = lane >> 4;
    const int K = g.K, nt = K / BK;
    unsigned voffA[2], voffB[2], cby[2]; int rsl[2];
#pragma unroll
    for (int i = 0; i < 2; ++i) { int R, C; stage_rc(tid * 16 + i * 8192, R, C); const int Rb = Epi::PERM ? ((R & ~31) + perm32(R & 31)) : R;
        voffA[i] = (unsigned)(R * K + C) * 2u; voffB[i] = (unsigned)(Rb * K + C) * 2u; rsl[i] = R; cby[i] = (unsigned)C * 2u; }
    const size_t kstep = (size_t)(BK * 2);
    const size_t hstep = (size_t)HALF * K * 2;
    const size_t tstep = 2 * hstep;
    const size_t ahstep = GATHER ? 0 : hstep;
    const unsigned ldsw = (unsigned)wid * 1024u;
    const int aoff0 = lds_byte(wr * 64 + fr, fq * 8), aoff1 = lds_byte(wr * 64 + fr, 32 + fq * 8), boff0 = lds_byte(wc * 32 + fr, fq * 8), boff1 = lds_byte(wc * 32 + fr, 32 + fq * 8);
#define PG8_SA(b, h) (((b) * 2 + (h)) * HTB)
#define PG8_SB(b, h) ((4 + (b) * 2 + (h)) * HTB)
#define PG8_STAGE(bufoff, gbase, voff) do { _Pragma("unroll") for (int _i = 0; _i < 2; ++_i) \
        __builtin_amdgcn_global_load_lds((const unsigned*)((const char*)(gbase) + (voff)[_i]), (PG8_LAS unsigned*)(lds + (bufoff) + ldsw + _i * 8192), 16, 0, 0); } while (0)
#define PG8_LD16(off) (*(const PG8_LAS v4i_t*)(lds + (off)))
#define PG8_LDA(dst, b, h) do { _Pragma("unroll") for (int m = 0; m < 4; ++m) { if constexpr (FP8) dst##8[m] = __builtin_shufflevector(PG8_LD16(PG8_SA(b, h) + aoff0 + m * 2048), PG8_LD16(PG8_SA(b, h) + aoff1 + m * 2048), 0, 1, 2, 3, 4, 5, 6, 7); \
        else { _Pragma("unroll") for (int k = 0; k < 2; ++k) dst[m][k] = *(const PG8_LAS bf16x8*)(lds + PG8_SA(b, h) + (k ? aoff1 : aoff0) + m * 2048); } } } while (0)
#define PG8_LDB(dst, b, h) do { _Pragma("unroll") for (int n = 0; n < 2; ++n) { if constexpr (FP8) dst##8[n] = __builtin_shufflevector(PG8_LD16(PG8_SB(b, h) + boff0 + n * 2048), PG8_LD16(PG8_SB(b, h) + boff1 + n * 2048), 0, 1, 2, 3, 4, 5, 6, 7); \
        else { _Pragma("unroll") for (int k = 0; k < 2; ++k) dst[n][k] = *(const PG8_LAS bf16x8*)(lds + PG8_SB(b, h) + (k ? boff1 : boff0) + n * 2048); } } } while (0)
#define PG8_MMA(ai, bj, At, Bt) do { __builtin_amdgcn_s_setprio(1); _Pragma("unroll") for (int m = 0; m < 4; ++m) _Pragma("unroll") for (int n = 0; n < 2; ++n) { \
        if constexpr (FP8) asm volatile("v_mfma_f32_16x16x128_f8f6f4 %0, %1, %2, %0" : "+v"(acc[ai][bj][m][n]) : "v"(Bt##8[n]), "v"(At##8[m]));   \
        else { _Pragma("unroll") for (int k = 0; k < 2; ++k) acc[ai][bj][m][n] = __builtin_amdgcn_mfma_f32_16x16x32_bf16(Bt[n][k], At[m][k], acc[ai][bj][m][n], 0, 0, 0); } } \
        __builtin_amdgcn_s_setprio(0); } while (0)
#define PG8_WAIT_V(n) asm volatile("s_waitcnt vmcnt(" #n ")" ::: "memory")
#define PG8_WAIT_L(n) asm volatile("s_waitcnt lgkmcnt(" #n ")" ::: "memory")
#define PG8_WAIT_V8X(relax) asm volatile("s_cmp_eq_u32 %0, 0\n\ts_cbranch_scc1 1f\n\ts_waitcnt vmcnt(%1)\n\ts_branch 2f\n1:\n\ts_waitcnt vmcnt(8)\n2:" :: "s"(relax), "n"(8 + Epi::NST) : "memory", "scc")
#define PG8_BAR __builtin_amdgcn_s_barrier()
#define PG8_SCHED __builtin_amdgcn_sched_barrier(0)
    Unit cur, nxt; int ui = 0;
    if (!S.next(0, cur)) return;
    f32x4 acc[2][2][4][2];
#pragma unroll
    for (int a = 0; a < 2; ++a)
#pragma unroll
        for (int b = 0; b < 2; ++b)
#pragma unroll
            for (int m = 0; m < 4; ++m)
#pragma unroll
                for (int n = 0; n < 2; ++n) acc[a][b][m][n] = (f32x4){0.f, 0.f, 0.f, 0.f};
    bf16x8 At[4][2], B0[2][2], B1[2][2]; v8i_t At8[4], B08[2], B18[2];
    const char* cA = GATHER ? (const char*)g.A : (const char*)g.A + (size_t)cur.pm * tstep; const char* cB = (const char*)g.Bt + cur.boff + (size_t)cur.pn * tstep;
    unsigned cv0[2], cv1[2], nv0[2], nv1[2];
#pragma unroll
    for (int i = 0; i < 2; ++i) { if constexpr (GATHER) { cv0[i] = tab[rsl[i]] + cby[i]; cv1[i] = tab[HALF + rsl[i]] + cby[i]; } else { cv0[i] = voffA[i]; cv1[i] = voffA[i]; } nv0[i] = cv0[i]; nv1[i] = cv1[i]; }
    PG8_STAGE(PG8_SB(0, 0), cB, voffB); PG8_STAGE(PG8_SB(0, 1), cB + hstep, voffB); PG8_STAGE(PG8_SA(0, 0), cA, cv0); PG8_STAGE(PG8_SA(0, 1), cA + ahstep, cv1);
    if (wr == 1) PG8_BAR;
    PG8_WAIT_V(2); PG8_BAR;
    PG8_STAGE(PG8_SB(1, 0), cB + kstep, voffB); PG8_STAGE(PG8_SA(1, 0), cA + kstep, cv0); PG8_STAGE(PG8_SB(1, 1), cB + hstep + kstep, voffB);
    PG8_WAIT_V(6); PG8_BAR;
    for (;;) {
        const bool has_next = S.next(ui + 1, nxt);
        const char* nA = has_next ? (GATHER ? (const char*)g.A : (const char*)g.A + (size_t)nxt.pm * tstep) : cA; const char* nB = has_next ? (const char*)g.Bt + nxt.boff + (size_t)nxt.pn * tstep : cB;
        if constexpr (GATHER) {
#pragma unroll
            for (int i = 0; i < 2; ++i) { if (has_next) { nv0[i] = tab[(ui + 1) * BM + rsl[i]] + cby[i]; nv1[i] = tab[(ui + 1) * BM + HALF + rsl[i]] + cby[i]; } else { nv0[i] = cv0[i]; nv1[i] = cv1[i]; } }
        }
        for (int t = 0; t < nt; t += 2) {
            const bool last = (t == nt - 2);
            const char* a1 = cA + (size_t)(t + 1) * kstep;
            const char* a2 = last ? nA : cA + (size_t)(t + 2) * kstep; const char* b2 = last ? nB : cB + (size_t)(t + 2) * kstep;
            const char* a3 = a2 + kstep; const char* b3 = b2 + kstep;
            unsigned s0[2], s1[2];
#pragma unroll
            for (int i = 0; i < 2; ++i) { s0[i] = last ? nv0[i] : cv0[i]; s1[i] = last ? nv1[i] : cv1[i]; }
            PG8_LDB(B0, 0, 0); PG8_LDB(B1, 0, 1); PG8_SCHED; PG8_LDA(At, 0, 0); PG8_STAGE(PG8_SA(1, 1), a1 + ahstep, cv1);
            PG8_WAIT_V(8); PG8_WAIT_L(0); PG8_BAR; PG8_MMA(0, 0, At, B0); PG8_MMA(0, 1, At, B1); PG8_BAR; PG8_SCHED;
            PG8_LDA(At, 0, 1); PG8_STAGE(PG8_SB(0, 0), b2, voffB); PG8_STAGE(PG8_SB(0, 1), b2 + hstep, voffB); PG8_STAGE(PG8_SA(0, 0), a2, s0);
            PG8_WAIT_V(8); PG8_WAIT_L(0); PG8_BAR; PG8_MMA(1, 0, At, B0); PG8_MMA(1, 1, At, B1); PG8_BAR; PG8_SCHED;
            PG8_LDB(B0, 1, 0); PG8_LDB(B1, 1, 1); PG8_SCHED; PG8_LDA(At, 1, 0); PG8_STAGE(PG8_SA(0, 1), a2 + ahstep, s1);
            PG8_WAIT_V(8); PG8_WAIT_L(0); PG8_BAR; PG8_MMA(0, 0, At, B0); PG8_MMA(0, 1, At, B1); PG8_BAR; PG8_SCHED;
            PG8_LDA(At, 1, 1); PG8_STAGE(PG8_SB(1, 0), b3, voffB); PG8_STAGE(PG8_SB(1, 1), b3 + hstep, voffB); PG8_STAGE(PG8_SA(1, 0), a3, s0);
            PG8_WAIT_V(8); PG8_WAIT_L(0); PG8_BAR; PG8_MMA(1, 0, At, B0); PG8_MMA(1, 1, At, B1); PG8_BAR; PG8_SCHED;
        }
        unsigned long long pt0_ = 0; if (prb) pt0_ = __builtin_amdgcn_s_memrealtime();
        if constexpr (FP8) asm volatile("s_nop 15\n\ts_nop 7" ::: "memory");
        if constexpr (ALIGN_EPI) { if (wr == 0) PG8_BAR; }
        E(acc, cur, wr, wc, fr, fq);
        if (prb) { asm volatile("s_waitcnt vmcnt(0)" ::: "memory"); if (threadIdx.x == 0) prb[0] += (unsigned)(__builtin_amdgcn_s_memrealtime() - pt0_); }
        if (!has_next) break;
#pragma unroll
        for (int a = 0; a < 2; ++a)
#pragma unroll
            for (int b = 0; b < 2; ++b)
#pragma unroll
                for (int m = 0; m < 4; ++m)
#pragma unroll
                    for (int n = 0; n < 2; ++n) acc[a][b][m][n] = (f32x4){0.f, 0.f, 0.f, 0.f};
        cur = nxt; cA = nA; cB = nB; ++ui;
#pragma unroll
        for (int i = 0; i < 2; ++i) { cv0[i] = nv0[i]; cv1[i] = nv1[i]; }
        if constexpr (ALIGN_EPI) { if (wr == 1) PG8_BAR; }
    }
    PG8_WAIT_V(0);
    if constexpr (!ALIGN_EPI) { if (wr == 0) PG8_BAR; }
    PG8_BAR;
#undef PG8_SA
#undef PG8_SB
#undef PG8_STAGE
#undef PG8_LDA
#undef PG8_LD16
#undef PG8_LDB
#undef PG8_MMA
#undef PG8_WAIT_V
#undef PG8_WAIT_L
#undef PG8_WAIT_V8X
#undef PG8_BAR
#undef PG8_SCHED
}
}
#include <hip/hip_bf16.h>
#include <cmath>
namespace attn_body {
using bf16=__hip_bfloat16;
using bf16x8=__attribute__((ext_vector_type(8)))short;
using s16x4=__attribute__((ext_vector_type(4)))short;
using f32x16=__attribute__((ext_vector_type(16)))float;
using u32x4=__attribute__((ext_vector_type(4)))unsigned;
constexpr int BATCH=4,NHEAD=8,SEQ=8192,D=64,DM=NHEAD*D,ODM=1024;
constexpr int NW=8,QBLK=32,QB=QBLK*NW,KVBLK=64,NQB=SEQ/QB;
constexpr int ATTN_PITCH=DM, ATTN_UNIT_ROWS=QB;
__device__ __forceinline__ int crow(int r,int hi){return (r&3)+8*(r>>2)+4*hi;}
#define SBAR() __builtin_amdgcn_sched_barrier(0)
__device__ __forceinline__ void cmask(f32x16&p0,f32x16&p1,int jb,int qrel,int hi){
  const float NEG=-INFINITY; int kb=64*jb+4*hi;
  #pragma unroll
  for(int r=0;r<16;++r){int kv=kb+(r&3)+8*(r>>2); if(kv>qrel)p0[r]=NEG; if(kv+32>qrel)p1[r]=NEG;}
}

constexpr int NSLOT=3, SLOTB=8192;
constexpr int LDS_K=0, LDS_V=NSLOT*SLOTB, LDS_WS=2*NSLOT*SLOTB, LDS_OST=LDS_WS+NW*64*4, LDS_C2=LDS_OST+NW*4096, LDS_BYTES=LDS_C2+SEQ*4;
constexpr float C2=0.125f*1.4426950408889634f;
__device__ __forceinline__ void glds16(const void*gsrc,unsigned lds_dst){unsigned keep;
  asm volatile("s_mov_b32 %0, m0\n\ts_mov_b32 m0, %2\n\ts_nop 0\n\tglobal_load_lds_dwordx4 %1, off\n\ts_mov_b32 m0, %0":"=&s"(keep):"v"(gsrc),"s"(lds_dst):"memory");}
__device__ __forceinline__ float max3f(float a,float b,float c){float r;asm("v_max3_f32 %0, %1, %2, %3":"=v"(r):"v"(a),"v"(b),"v"(c));return r;}
__device__ __forceinline__ float max2f(float a,float b){float r;asm("v_max_f32_e32 %0, %1, %2":"=v"(r):"v"(a),"v"(b));return r;}
__device__ __forceinline__ float fadd_s(float a,float b){float r;asm("v_add_f32_e32 %0, %1, %2":"=v"(r):"v"(a),"v"(b));return r;}
__device__ __forceinline__ float fsub_s(float a,float b){float r;asm("v_sub_f32_e32 %0, %1, %2":"=v"(r):"v"(a),"v"(b));return r;}
typedef float f32x2_t __attribute__((ext_vector_type(2))); typedef float f32x4_t __attribute__((ext_vector_type(4))); typedef __bf16 bf16x2_t __attribute__((ext_vector_type(2)));
__device__ __forceinline__ unsigned cvtpk_s(float lo,float hi){f32x2_t v={lo,hi};bf16x2_t b=__builtin_convertvector(v,bf16x2_t);return __builtin_bit_cast(unsigned,b);}
#define WAIT_BAR(N) asm volatile("s_waitcnt vmcnt(" #N ") lgkmcnt(0)\n\ts_barrier":::"memory")

__device__ __forceinline__ void qkt(f32x16&p0,f32x16&p1,const char*Kslot,const bf16x8*qr,const f32x16&cin0,const f32x16&cin1,int r32,int hi){
  const char*kb=Kslot+hi*1024+r32*16;
  #pragma unroll
  for(int d0=0;d0<4;++d0){
    const bf16x8 b0=*reinterpret_cast<const bf16x8*>(kb+d0*2048);
    const bf16x8 b1=*reinterpret_cast<const bf16x8*>(kb+d0*2048+512);
    if(d0==0){p0=__builtin_amdgcn_mfma_f32_32x32x16_bf16(b0,qr[0],cin0,0,0,0);p1=__builtin_amdgcn_mfma_f32_32x32x16_bf16(b1,qr[0],cin1,0,0,0);}
    else{p0=__builtin_amdgcn_mfma_f32_32x32x16_bf16(b0,qr[d0],p0,0,0,0);p1=__builtin_amdgcn_mfma_f32_32x32x16_bf16(b1,qr[d0],p1,0,0,0);}}
}
typedef __attribute__((address_space(3))) const char* lds_cptr;
typedef short v4i16_t __attribute__((ext_vector_type(4)));
__device__ __forceinline__ void kload8(bf16x8*kf,lds_cptr kp){
  kf[0]=*(const __attribute__((address_space(3))) bf16x8*)(kp);      kf[1]=*(const __attribute__((address_space(3))) bf16x8*)(kp+512);
  kf[2]=*(const __attribute__((address_space(3))) bf16x8*)(kp+2048); kf[3]=*(const __attribute__((address_space(3))) bf16x8*)(kp+2560);
  kf[4]=*(const __attribute__((address_space(3))) bf16x8*)(kp+4096); kf[5]=*(const __attribute__((address_space(3))) bf16x8*)(kp+4608);
  kf[6]=*(const __attribute__((address_space(3))) bf16x8*)(kp+6144); kf[7]=*(const __attribute__((address_space(3))) bf16x8*)(kp+6656);
}
__device__ __forceinline__ void kload2(bf16x8*kf,lds_cptr kp,int j){ kf[2*j]=*(const __attribute__((address_space(3))) bf16x8*)(kp+j*2048); kf[2*j+1]=*(const __attribute__((address_space(3))) bf16x8*)(kp+j*2048+512); }
__device__ __forceinline__ s16x4 vtr(lds_cptr p){ return __builtin_bit_cast(s16x4,__builtin_amdgcn_ds_read_tr16_b64_v4i16((__attribute__((address_space(3))) v4i16_t*)p)); }
__device__ __forceinline__ float rowmax(const f32x16&p0,const f32x16&p1){
  float a=max3f(p0[0],p0[1],p1[0]),b=max3f(p0[2],p0[3],p1[1]);a=max3f(a,p1[2],p1[3]);
  #pragma unroll
  for(int r=4;r<16;r+=4){a=max3f(a,p0[r],p0[r+1]);b=max3f(b,p0[r+2],p0[r+3]);a=max3f(a,p1[r],p1[r+1]);b=max3f(b,p1[r+2],p1[r+3]);}
  const float m=max2f(a,b);
  auto rr=__builtin_amdgcn_permlane32_swap(__float_as_uint(m),__float_as_uint(m),false,false);
  return max2f(__uint_as_float(rr[0]),__uint_as_float(rr[1]));
}
__device__ __forceinline__ void pv(f32x16*o,int vb,bf16x8 pa0,bf16x8 pa1,bf16x8 pa2,bf16x8 pa3){
  #pragma unroll
  for(int d0=0;d0<2;++d0){s16x4 lo[4],hi[4];
    #pragma unroll
    for(int ks=0;ks<4;++ks){
      asm volatile("ds_read_b64_tr_b16 %0,%1 offset:%c2":"=&v"(lo[ks]):"v"(vb),"i"(d0*4096+ks*1024):"memory");
      asm volatile("ds_read_b64_tr_b16 %0,%1 offset:%c2":"=&v"(hi[ks]):"v"(vb),"i"(d0*4096+ks*1024+512):"memory");}
    asm volatile("s_waitcnt lgkmcnt(0)":::"memory");SBAR();
    #define PK(k) (bf16x8){lo[k][0],lo[k][1],lo[k][2],lo[k][3],hi[k][0],hi[k][1],hi[k][2],hi[k][3]}
    o[d0]=__builtin_amdgcn_mfma_f32_32x32x16_bf16(pa0,PK(0),o[d0],0,0,0);
    o[d0]=__builtin_amdgcn_mfma_f32_32x32x16_bf16(pa1,PK(1),o[d0],0,0,0);
    o[d0]=__builtin_amdgcn_mfma_f32_32x32x16_bf16(pa2,PK(2),o[d0],0,0,0);
    o[d0]=__builtin_amdgcn_mfma_f32_32x32x16_bf16(pa3,PK(3),o[d0],0,0,0);
    #undef PK
  }
}

#ifndef ATTN_STORE16
#define ATTN_STORE16(p,v) (*(u32x4*)(p)=(v))
#endif
template<int THRL> __device__ __forceinline__ void attn_unit(int b,int h,int qb,const bf16*Q,const bf16*__restrict__ K,const bf16*__restrict__ V,bf16*O,char*shm,int j0,unsigned*attn_probe_ctr=nullptr){
  const int tid=threadIdx.x,lane=tid&63,r32=lane&31,hi=lane>>5; const int wid=__builtin_amdgcn_readfirstlane(tid>>6);
  const long rowbase=(long)b*SEQ; const int q0=qb*QB;
  const bf16*Qw=Q+(rowbase+q0+wid*QBLK)*DM+h*D;
  const bf16*Kh=K+rowbase*DM+h*D,*Vh=V+rowbase*DM+h*D;
  const unsigned lds0=(unsigned)(uintptr_t)shm; const lds_cptr shm3=(lds_cptr)shm;
  float*wsf=(float*)(shm+LDS_WS)+wid*64;
  const bf16*ksrc=Kh+(long)lane*DM+wid*8;
  const bf16*vsrc=Vh+(long)(16*(wid&3)+(lane>>2))*DM+(wid>>2)*32+(lane&3)*8;
  const unsigned kdst=lds0+LDS_K+wid*1024, vdst=lds0+LDS_V+wid*1024;
  #define DMA_K(t,slot) glds16(ksrc+(long)(t)*KVBLK*DM,(unsigned)__builtin_amdgcn_readfirstlane(kdst+(slot)))
  #define DMA_V(t,slot) glds16(vsrc+(long)(t)*KVBLK*DM,(unsigned)__builtin_amdgcn_readfirstlane(vdst+(slot)))
  const int vb0=(int)(lds0+LDS_V)+((lane>>4)&1)*32+(lane&3)*8+(4*hi+((lane&15)>>2))*64;
  const char*Kbase=shm+LDS_K; bf16x8 kf[8];
  const lds_cptr kp0=shm3+LDS_K+hi*1024+r32*16; const lds_cptr vp0=shm3+LDS_V+((lane>>4)&1)*32+(lane&3)*8+(4*hi+((lane&15)>>2))*64;
  const int NT=(q0+QB)/KVBLK;
  if(attn_probe_ctr && threadIdx.x==0) atomicAdd(attn_probe_ctr, (unsigned)(NT-j0));
  DMA_K(j0,0);DMA_V(j0,0);DMA_K(j0+1,SLOTB);
  bf16x8 qr[4];
  #pragma unroll
  for(int d0=0;d0<4;++d0)qr[d0]=*reinterpret_cast<const bf16x8*>(&Qw[(long)r32*DM+d0*16+hi*8]);
  float l_reg=0.f;f32x16 o[2];o[0]=f32x16{};o[1]=f32x16{};
  typedef __attribute__((address_space(3))) const f32x4_t* lds_f4ptr; const lds_f4ptr c2p=(lds_f4ptr)(shm3+LDS_C2)+hi;
  float ctm=((const __attribute__((address_space(3))) float*)(shm3+LDS_C2))[q0+wid*QBLK+r32];
  f32x16 cin0,cin1;
  #define CIN(t) do{ const lds_f4ptr cq_=c2p+16*(t); const f32x4_t a0_=cq_[0],a1_=cq_[2],a2_=cq_[4],a3_=cq_[6],b0_=cq_[8],b1_=cq_[10],b2_=cq_[12],b3_=cq_[14]; \
    _Pragma("unroll") for(int j_=0;j_<4;++j_){ cin0[j_]=ctm-a0_[j_];cin0[4+j_]=ctm-a1_[j_];cin0[8+j_]=ctm-a2_[j_];cin0[12+j_]=ctm-a3_[j_]; cin1[j_]=ctm-b0_[j_];cin1[4+j_]=ctm-b1_[j_];cin1[8+j_]=ctm-b2_[j_];cin1[12+j_]=ctm-b3_[j_]; } }while(0)
  const int qrel=wid*QBLK+r32;
  #define CMASK(P0,P1,t) do{int jb_=(t)-(NT-4); if(jb_>=0)cmask(P0,P1,jb_,qrel,hi);}while(0)
  bool resc=false;
  #define START(P0,P1) do{ const float rm=rowmax(P0,P1); resc=false; \
    if(__any(rm>(float)THRL)){ const float dl=__builtin_fmaxf(rm,0.f); ctm-=dl; \
      _Pragma("unroll") for(int r=0;r<16;++r){P0[r]-=dl;P1[r]-=dl;} } \
    _Pragma("unroll") for(int r=0;r<16;++r)P0[r]=__builtin_amdgcn_exp2f(P0[r]); }while(0)
  #define RESC() do{ if(resc){ asm volatile("s_waitcnt lgkmcnt(0)":::"memory"); \
      _Pragma("unroll") for(int d_=0;d_<2;++d_) _Pragma("unroll") for(int r=0;r<16;++r)o[d_][r]*=wsf[crow(r,hi)]; } }while(0)
  f32x16 pA0,pA1,pB0,pB1;
  int sl_prev=0,sl_cur=0,sl_next=SLOTB;
  #define ROT() do{sl_prev=sl_cur;sl_cur=sl_next;sl_next=(sl_next==(NSLOT-1)*SLOTB)?0:sl_next+SLOTB;}while(0)
  DMA_K(j0+2,2*SLOTB);
  WAIT_BAR(3);
  CIN(j0); qkt(pA0,pA1,Kbase,qr,cin0,cin1,r32,hi);asm volatile("s_nop 15\n\ts_nop 7":"+v"(pA0),"+v"(pA1));CMASK(pA0,pA1,j0);
  START(pA0,pA1);
  _Pragma("unroll") for(int r=0;r<16;++r)pA1[r]=__builtin_amdgcn_exp2f(pA1[r]);
  WAIT_BAR(0);
  DMA_K(j0+3,0);DMA_V(j0+1,SLOTB);
  ROT();
  kload8(kf,kp0+sl_cur);
  WAIT_BAR(2);
  s16x4 vlo[8],vhi[8]; u32x4 pw0,pw1,pw2,pw3;
  #define PKW(P,B) cvtpk_s(P[B],P[B+1])
  #define PAF(k) __builtin_bit_cast(bf16x8,pw##k)
  #define VFR(i) (bf16x8){vlo[i][0],vlo[i][1],vlo[i][2],vlo[i][3],vhi[i][0],vhi[i][1],vhi[i][2],vhi[i][3]}
  #define PIN(x) asm volatile("":"+v"(x))
  #define MX3(a,b,c) __builtin_fmaxf(__builtin_fmaxf((a),(b)),(c))
  #define GAPA(MF,A0,A1,A2,A3,W0,W1,PW) do{ MF; sacc+=A0; sacc+=A1; sacc+=A2; sacc+=A3; PIN(sacc); W0; W1; PIN(PW); SBAR(); }while(0)
  #define EX(v) __builtin_amdgcn_exp2f(v)
  #define GAPB(MF,X,B) do{ MF; X[B]=EX(X[B]); X[B+1]=EX(X[B+1]); X[B+2]=EX(X[B+2]); X[B+3]=EX(X[B+3]); PIN(X); SBAR(); }while(0)
  #define VRD(i) do{ vlo[i]=vtr(vp_+(((i)>>2)*4096+((i)&3)*1024)); vhi[i]=vtr(vp_+(((i)>>2)*4096+((i)&3)*1024+512)); }while(0)
  #define KRD(G,j) do{ if(G){ kload2(kf,kp0+sl_next,j); SBAR(); } }while(0)
  #define STEP(C0,C1,P0,P1,t,GK,GV,GL) do{ SBAR(); CIN(t); SBAR(); \
    const lds_cptr vp_=vp0+sl_prev; \
    VRD(0); SBAR(); float sacc=(P0[0]+P0[1]); \
    GAPA(C0=__builtin_amdgcn_mfma_f32_32x32x16_bf16(kf[0],qr[0],cin0,0,0,0), P0[2],P0[3],P0[4],P0[5],     pw0[0]=PKW(P0,0), pw0[1]=PKW(P0,2), pw0); \
    VRD(4); SBAR(); GAPA(C1=__builtin_amdgcn_mfma_f32_32x32x16_bf16(kf[1],qr[0],cin1,0,0,0), P0[6],P0[7],P0[8],P0[9],     pw0[2]=PKW(P0,4), pw0[3]=PKW(P0,6), pw0); \
    VRD(1); SBAR(); GAPA(C0=__builtin_amdgcn_mfma_f32_32x32x16_bf16(kf[2],qr[1],C0,0,0,0),   P0[10],P0[11],P0[12],P0[13], pw1[0]=PKW(P0,8), pw1[1]=PKW(P0,10), pw1); \
    VRD(5); SBAR(); GAPA(C1=__builtin_amdgcn_mfma_f32_32x32x16_bf16(kf[3],qr[1],C1,0,0,0),   P0[14],P0[15],P1[0],P1[1],   pw1[2]=PKW(P0,12),pw1[3]=PKW(P0,14), pw1); \
    VRD(2); SBAR(); GAPA(C0=__builtin_amdgcn_mfma_f32_32x32x16_bf16(kf[4],qr[2],C0,0,0,0),   P1[2],P1[3],P1[4],P1[5],     pw2[0]=PKW(P1,0), pw2[1]=PKW(P1,2), pw2); \
    VRD(6); SBAR(); GAPA(C1=__builtin_amdgcn_mfma_f32_32x32x16_bf16(kf[5],qr[2],C1,0,0,0),   P1[6],P1[7],P1[8],P1[9],     pw2[2]=PKW(P1,4), pw2[3]=PKW(P1,6), pw2); \
    VRD(3); SBAR(); GAPA(C0=__builtin_amdgcn_mfma_f32_32x32x16_bf16(kf[6],qr[3],C0,0,0,0),   P1[10],P1[11],P1[12],P1[13], pw3[0]=PKW(P1,8), pw3[1]=PKW(P1,10), pw3); \
    VRD(7); SBAR(); GAPA(C1=__builtin_amdgcn_mfma_f32_32x32x16_bf16(kf[7],qr[3],C1,0,0,0),   P1[14],P1[15],0.f,0.f,       pw3[2]=PKW(P1,12),pw3[3]=PKW(P1,14), pw3); \
    l_reg+=sacc; \
    if(GK){DMA_K((t)+3,sl_cur);} if(GV){DMA_V((t)+1,sl_next);} \
    CMASK(C0,C1,t); \
    { float a=MX3(C0[0],C0[1],C1[0]),b=MX3(C0[2],C0[3],C1[1]); a=MX3(a,C1[2],C1[3]); \
      _Pragma("unroll") for(int r=4;r<16;r+=4){a=MX3(a,C0[r],C0[r+1]);b=MX3(b,C0[r+2],C0[r+3]);a=MX3(a,C1[r],C1[r+1]);b=MX3(b,C1[r+2],C1[r+3]);} \
      float rm=__builtin_fmaxf(a,b); { auto rr=__builtin_amdgcn_permlane32_swap(__float_as_uint(rm),__float_as_uint(rm),false,false); rm=__builtin_fmaxf(__uint_as_float(rr[0]),__uint_as_float(rr[1])); } \
      resc=false; \
      if(__builtin_expect(__any(rm>(float)THRL),0)){ const float dl=__builtin_fmaxf(rm,0.f); ctm-=dl; \
        _Pragma("unroll") for(int r=0;r<16;++r){C0[r]-=dl;C1[r]-=dl;} \
        const float f=__builtin_amdgcn_exp2f(-dl); l_reg*=f; if(hi==0)wsf[r32]=f; resc=true; } } \
    SBAR(); \
    GAPB(o[0]=__builtin_amdgcn_mfma_f32_32x32x16_bf16(PAF(0),VFR(0),o[0],0,0,0), C0,0); \
    GAPB(o[1]=__builtin_amdgcn_mfma_f32_32x32x16_bf16(PAF(0),VFR(4),o[1],0,0,0), C0,4); \
    KRD(GL,0); GAPB(o[0]=__builtin_amdgcn_mfma_f32_32x32x16_bf16(PAF(1),VFR(1),o[0],0,0,0), C0,8); \
    KRD(GL,1); GAPB(o[1]=__builtin_amdgcn_mfma_f32_32x32x16_bf16(PAF(1),VFR(5),o[1],0,0,0), C0,12); \
    KRD(GL,2); GAPB(o[0]=__builtin_amdgcn_mfma_f32_32x32x16_bf16(PAF(2),VFR(2),o[0],0,0,0), C1,0); \
    KRD(GL,3); GAPB(o[1]=__builtin_amdgcn_mfma_f32_32x32x16_bf16(PAF(2),VFR(6),o[1],0,0,0), C1,4); \
    GAPB(o[0]=__builtin_amdgcn_mfma_f32_32x32x16_bf16(PAF(3),VFR(3),o[0],0,0,0), C1,8); \
    GAPB(o[1]=__builtin_amdgcn_mfma_f32_32x32x16_bf16(PAF(3),VFR(7),o[1],0,0,0), C1,12); \
    }while(0)
  int t=j0+1;
  #undef CMASK
  #define CMASK(P0,P1,t) do{}while(0)
  for(;t+5<NT;t+=2){
    STEP(pB0,pB1,pA0,pA1,t,true,true,true);     WAIT_BAR(2); RESC(); ROT();
    STEP(pA0,pA1,pB0,pB1,t+1,true,true,true);   WAIT_BAR(2); RESC(); ROT();
  }
  #undef CMASK
  #define CMASK(P0,P1,t) do{int jb_=(t)-(NT-4); if(jb_>=0)cmask(P0,P1,jb_,qrel,hi);}while(0)
  #define ENDW(tt) do{ if((tt)+3<NT){WAIT_BAR(2);} else if((tt)+2<NT){WAIT_BAR(1);} else {WAIT_BAR(0);} }while(0)
  for(;t+1<NT;t+=2){
    STEP(pB0,pB1,pA0,pA1,t,(t+3<NT),(t+1<NT),(t+1<NT));       ENDW(t);   RESC(); ROT();
    STEP(pA0,pA1,pB0,pB1,t+1,(t+4<NT),(t+2<NT),(t+2<NT));     ENDW(t+1); RESC(); ROT();
  }
  STEP(pB0,pB1,pA0,pA1,NT-1,false,false,false); RESC();
  { float sacc=pB0[0]+pB0[1]; _Pragma("unroll") for(int r=2;r<16;++r)sacc+=pB0[r]; _Pragma("unroll") for(int r=0;r<16;++r)sacc+=pB1[r]; l_reg+=sacc;
    pw0=(u32x4){PKW(pB0,0),PKW(pB0,2),PKW(pB0,4),PKW(pB0,6)};pw1=(u32x4){PKW(pB0,8),PKW(pB0,10),PKW(pB0,12),PKW(pB0,14)};pw2=(u32x4){PKW(pB1,0),PKW(pB1,2),PKW(pB1,4),PKW(pB1,6)};pw3=(u32x4){PKW(pB1,8),PKW(pB1,10),PKW(pB1,12),PKW(pB1,14)};
    SBAR(); pv(o,vb0+sl_cur,PAF(0),PAF(1),PAF(2),PAF(3)); }
  #undef PKW
  #undef PAF
  #undef VFR
  #undef PIN
  #undef MX3
  #undef GAPA
  #undef GAPB
  #undef EX
  #undef VRD
  #undef KRD
  #undef STEP
  #undef ENDW
  {auto rr=__builtin_amdgcn_permlane32_swap(__float_as_uint(l_reg),__float_as_uint(l_reg),false,false);l_reg=__uint_as_float(rr[0])+__uint_as_float(rr[1]);}
  if(hi==0)wsf[32+r32]=l_reg;asm volatile("s_waitcnt lgkmcnt(0)":::"memory");
  float rli[16];
  #pragma unroll
  for(int r=0;r<16;++r)rli[r]=__builtin_amdgcn_rcpf(wsf[32+crow(r,hi)]);
  bf16*Ow=O+(rowbase+q0+wid*QBLK)*ODM+h*D;
  { bf16*stg=(bf16*)(shm+LDS_OST)+wid*2048;
    #pragma unroll
    for(int r=0;r<16;++r){const int orow=crow(r,hi);
      #pragma unroll
      for(int d0=0;d0<2;++d0)stg[orow*64+d0*32+r32]=__float2bfloat16(o[d0][r]*rli[r]);}
    asm volatile("s_waitcnt lgkmcnt(0)":::"memory");
    #pragma unroll
    for(int i=0;i<4;++i){const int row=i*8+(lane>>3),ch=lane&7; const u32x4 v=*(const u32x4*)(stg+row*64+ch*8); ATTN_STORE16(Ow+(long)row*ODM+ch*8,v);} }
  asm volatile("s_waitcnt lgkmcnt(0)\n\ts_barrier":::"memory");
  #undef CIN
  #undef DMA_K
  #undef DMA_V
  #undef CMASK
  #undef START
  #undef RESC
  #undef ROT
}
constexpr int ATTN_LDS_BYTES=LDS_BYTES;
struct AttnTensors { const bf16* Q; const bf16* K; const bf16* V; bf16* O; };
struct AttnUnit { int bh; int qb; };
struct StaticOrder {
  int vcu;
  __device__ __forceinline__ explicit StaticOrder(int grid,int block):vcu((block%8)*(grid/8)+block/8){}
  __device__ __forceinline__ bool next(int i,AttnUnit&u)const{ if(i>=4)return false; const int s=vcu&7; u.bh=vcu>>3; u.qb=(i==0)?s:(i==1)?15-s:(i==2)?16+s:31-s; return true; }
  __device__ __forceinline__ void a_ready(const AttnUnit&)const{}
  __device__ __forceinline__ void done(const AttnUnit&)const{}
};
template<class Sched,int THRL=8> __device__ __forceinline__ void attn_phase(char*lds,const AttnTensors&T,const Sched&S,float qkb2){
  AttnUnit u;
  for(int i=0;S.next(i,u);++i){ S.a_ready(u); attn_unit<THRL>(u.bh/NHEAD,u.bh%NHEAD,u.qb,T.Q,T.K,T.V,T.O,lds,qkb2); S.done(u); }
}
#undef SBAR
#undef WAIT_BAR
}
#define GAS __attribute__((address_space(1)))
#define LAS __attribute__((address_space(3)))
typedef GAS unsigned gu32;
#define RLX_AGENT __ATOMIC_RELAXED, __HIP_MEMORY_SCOPE_AGENT
#define LDS_WAIT() asm volatile("s_waitcnt lgkmcnt(0)" ::: "memory")
#define VM_WAIT() asm volatile("s_waitcnt vmcnt(0)" ::: "memory")

constexpr int NWAVES = 8;
constexpr int N_PHASES = 8;
constexpr int RING_OFF = 0, RING_BYTES = 131072;
constexpr int TAB_OFF = 131072, TAB_UNITS = 17;
constexpr int LDS_TOTAL = 155648;
constexpr int LDSCTL_OFF = LDS_TOTAL - 1024;
static_assert(TAB_OFF + TAB_UNITS * 256 * 4 <= LDSCTL_OFF, "LDS map");
constexpr int CW_Q = 128, CW_NRM = 256;
constexpr size_t WS_X1B = WS_P;
constexpr size_t WS_TOT = WS_SEL + 768 * 1024;
constexpr int CW_BAR = 4096;

#define XB_TMO      128
#define XB_XCNT(j)  (256  + 64 * (j))
#define XB_XSUB(j)  (1280 + 64 * (j))
#define XB_XGEN(j)  (2304 + 64 * (j))
#define XB_TOP      3328
#define XB_TOPGEN   3392
#define XCD_BAR_WORDS 3456
#define XB_SPIN_CAP (1u << 18)

__device__ __forceinline__ unsigned xb_ld(unsigned* p)              { return __hip_atomic_load(p, __ATOMIC_RELAXED, __HIP_MEMORY_SCOPE_AGENT); }
__device__ __forceinline__ unsigned xb_add(unsigned* p, unsigned v) { return __hip_atomic_fetch_add(p, v, __ATOMIC_RELAXED, __HIP_MEMORY_SCOPE_AGENT); }
__device__ __forceinline__ unsigned xb_xcc_id() { return (unsigned)__builtin_amdgcn_s_getreg((3 << 11) | 20) & 0xFu; }
#define XB_SPIN(cond, bar) do { unsigned _sp = 0; while (cond) { __builtin_amdgcn_s_sleep(1); \
    if ((++_sp & 255u) == 0u) { if (xb_ld(&(bar)[XB_TMO])) break; if (_sp > XB_SPIN_CAP) { atomicAdd(&(bar)[XB_TMO], 1u); break; } } } } while (0)

struct XcdBarrier {
    unsigned* bar; unsigned x;
    volatile LAS unsigned* st;
};

__device__ __forceinline__ XcdBarrier xcd_barrier_post(unsigned* bar, volatile LAS unsigned* st) {
    XcdBarrier b; b.bar = bar; b.x = xb_xcc_id(); b.st = st;
    if (threadIdx.x == 0) (void)xb_add(&bar[XB_XCNT(b.x)], 1u);
    return b;
}
__device__ __forceinline__ void xcd_barrier_complete(unsigned* bar, unsigned x, unsigned& nloc, unsigned& nx) {
    const unsigned G = gridDim.x * gridDim.y * gridDim.z;
    unsigned sum, cnt, mine, sp = 0u;
    for (;;) {
        sum = 0u; cnt = 0u; mine = 0u;
#pragma unroll
        for (unsigned j = 0; j < 16; ++j) { const unsigned c = xb_ld(&bar[XB_XCNT(j)]); sum += c; cnt += (c > 0u) ? 1u : 0u; mine = (j == x) ? c : mine; }
        if (sum == G) break;
        __builtin_amdgcn_s_sleep(1);
        if ((++sp & 255u) == 0u) { if (xb_ld(&bar[XB_TMO])) break; if (sp > XB_SPIN_CAP) { atomicAdd(&bar[XB_TMO], 1u); break; } }
    }
    nloc = mine > 0u ? mine : 1u; nx = cnt > 0u ? cnt : 1u;
}

__device__ __forceinline__ void xcd_barrier(const XcdBarrier& b) {
    asm volatile("s_waitcnt vmcnt(0)" ::: "memory");
    __syncthreads();
    if (threadIdx.x == 0) {
        unsigned* bar = b.bar;
        __builtin_amdgcn_s_waitcnt(0);
        unsigned nloc = b.st[0], nx = b.st[1];
        if (nloc == 0u) { xcd_barrier_complete(bar, b.x, nloc, nx); b.st[0] = nloc; b.st[1] = nx; }
        const unsigned old = xb_add(&bar[XB_XSUB(b.x)], 1u);
        const unsigned gen = old / nloc;
        if (old + 1u == (gen + 1u) * nloc) {
            __builtin_amdgcn_fence(__ATOMIC_RELEASE, "agent");
            asm volatile("s_waitcnt vmcnt(0)" ::: "memory");
            const unsigned og = xb_add(&bar[XB_TOP], 1u);
            const unsigned tg = og / nx;
            if (og + 1u == (tg + 1u) * nx) xb_add(&bar[XB_TOPGEN], 1u);
            else XB_SPIN(xb_ld(&bar[XB_TOPGEN]) == tg, bar);
            __builtin_amdgcn_fence(__ATOMIC_ACQUIRE, "agent");
            xb_add(&bar[XB_XGEN(b.x)], 1u);
            asm volatile("s_waitcnt vmcnt(0)" ::: "memory");
        } else {
            XB_SPIN(xb_ld(&bar[XB_XGEN(b.x)]) == gen, bar);
            __builtin_amdgcn_fence(__ATOMIC_ACQUIRE, "agent");
            asm volatile("s_waitcnt vmcnt(0)" ::: "memory");
        }
    }
    __syncthreads();
}


struct Args { const float* in[15]; float* out; unsigned char* ws; int ph_lo, ph_hi, use_bar, pad; };

__device__ __forceinline__ void p0_transpose_item(const float* W, int ldw, bf16* WT, int ldt, LAS float* scr, int lane) {
    float tv[32];
    const float* wp_ = W + (size_t)(lane >> 5) * ldw + (lane & 31);
#pragma unroll
    for (int i = 0; i < 32; ++i) tv[i] = wp_[(size_t)(2 * i) * ldw];
#pragma unroll
    for (int i = 0; i < 32; ++i) scr[(2 * i + (lane >> 5)) * 33 + (lane & 31)] = tv[i];
    LDS_WAIT(); asm volatile("" ::: "memory");
    const int c = lane & 7;
#pragma unroll
    for (int j = 0; j < 4; ++j) { const int n = (lane >> 3) + 8 * j; const LAS float* s = scr + (8 * c) * 33 + n;
        u32x4 o; o.x = pg8::cvt_pk_bf16(s[0 * 33], s[1 * 33]); o.y = pg8::cvt_pk_bf16(s[2 * 33], s[3 * 33]); o.z = pg8::cvt_pk_bf16(s[4 * 33], s[5 * 33]); o.w = pg8::cvt_pk_bf16(s[6 * 33], s[7 * 33]);
        *(GAS u32x4*)(WT + (size_t)n * ldt + 8 * c) = o; }
    LDS_WAIT(); asm volatile("" ::: "memory");
}
__device__ __forceinline__ void p0_transpose_item_fp8(const float* W, int ldw, unsigned char* WT, int ldt, LAS float* scr, int lane) {
    float tv[32];
    const float* wp_ = W + (size_t)(lane >> 5) * ldw + (lane & 31);
#pragma unroll
    for (int i = 0; i < 32; ++i) tv[i] = wp_[(size_t)(2 * i) * ldw];
#pragma unroll
    for (int i = 0; i < 32; ++i) scr[(2 * i + (lane >> 5)) * 33 + (lane & 31)] = tv[i];
    LDS_WAIT(); asm volatile("" ::: "memory");
    const int c = lane & 7;
#pragma unroll
    for (int j = 0; j < 4; ++j) { const int n = (lane >> 3) + 8 * j; const LAS float* s = scr + (8 * c) * 33 + n; const float k_ = pg8::FP8_SW;
        u32x2 o; o.x = pg8::pack4_fp8(s[0 * 33] * k_, s[1 * 33] * k_, s[2 * 33] * k_, s[3 * 33] * k_); o.y = pg8::pack4_fp8(s[4 * 33] * k_, s[5 * 33] * k_, s[6 * 33] * k_, s[7 * 33] * k_);
        *(GAS u32x2*)(WT + (size_t)n * ldt + 8 * c) = o; }
    LDS_WAIT(); asm volatile("" ::: "memory");
}
constexpr int I_WIN = 16 * 64, I_WO = 8 * 32, I_WEFF = 4 * 16 * 16, I_WU = 32 * 16 * 64, I_WD = 32 * 16 * 32;
constexpr int P0_ITEMS = I_WIN + I_WO + I_WEFF;

__device__ __forceinline__ void phase0(const Args& a, LAS unsigned char* L, int vcu, int G, int tid, int lane, int wave) {
    const float* w_in = a.in[2]; const float* w_pool = a.in[4]; const float* pscale = a.in[5]; const float* w_out = a.in[6];
    bf16* Win_t = (bf16*)(a.ws + WS_WIN); bf16* Wo_t = (bf16*)(a.ws + WS_WO);
    LAS float* scr = (LAS float*)(L + wave * 8448);
    LAS float* wf = (LAS float*)(L + 69632);
    for (int i = tid; i < 1024 * 8; i += 512) { const int d = i >> 3, p_ = ((d & 255) >> 2) + 64 * (4 * (d >> 8) + (d & 3)); wf[p_ * 12 + (i & 7)] = w_in[(size_t)d * INW + 2048 + (i & 7)]; }
    __syncthreads();
    const int gw = vcu * NWAVES + wave, NGW = G * NWAVES;
    {
        const float* x = a.in[0]; const float* g_mix = a.in[1]; const float* b_forget = a.in[3];
        bf16* XN = (bf16*)(a.ws + WS_XN); float* LOGF = (float*)(a.ws + WS_LOGF);
        f32x4 g[4];
#pragma unroll
        for (int j = 0; j < 4; ++j) g[j] = *(const f32x4*)(g_mix + 4 * lane + 256 * j);
        f32x4 vn[2][4];
#pragma unroll
        for (int q = 0; q < 2; ++q)
#pragma unroll
            for (int j = 0; j < 4; ++j) vn[q][j] = *(const f32x4*)(x + (size_t)(gw + q * NGW) * DM + 4 * lane + 256 * j);
        for (int m = gw; m < T; m += 2 * NGW) {
            f32x4 v[2][4]; float ss[2] = {0.f, 0.f};
#pragma unroll
            for (int q = 0; q < 2; ++q)
#pragma unroll
                for (int j = 0; j < 4; ++j) { v[q][j] = vn[q][j]; ss[q] += v[q][j].x * v[q][j].x + v[q][j].y * v[q][j].y + v[q][j].z * v[q][j].z + v[q][j].w * v[q][j].w; }
            { const int mn = (m + 2 * NGW < T) ? m + 2 * NGW : m;
#pragma unroll
              for (int q = 0; q < 2; ++q)
#pragma unroll
                  for (int j = 0; j < 4; ++j) vn[q][j] = *(const f32x4*)(x + (size_t)(mn + q * NGW) * DM + 4 * lane + 256 * j); }
#pragma unroll
            for (int o = 1; o < 64; o <<= 1) { ss[0] += __shfl_xor(ss[0], o); ss[1] += __shfl_xor(ss[1], o); }
            float fl[2][8];
#pragma unroll
            for (int q = 0; q < 2; ++q) { const float rstd = rsqrtf(ss[q] * (1.f / DM) + RMS_EPS);
#pragma unroll
                for (int e = 0; e < 8; ++e) fl[q][e] = 0.f;
#pragma unroll
                for (int j = 0; j < 4; ++j) v[q][j] = v[q][j] * rstd * g[j]; }
#pragma unroll
            for (int j = 0; j < 4; ++j) {
#pragma unroll
                for (int i = 0; i < 4; ++i) {
                    const int prow = lane + 64 * (4 * j + i);
                    const f32x4 w0 = *(const LAS f32x4*)(wf + prow * 12), w1 = *(const LAS f32x4*)(wf + prow * 12 + 4);
#pragma unroll
                    for (int q = 0; q < 2; ++q) { const float hv = v[q][j][i];
                        fl[q][0] += hv * w0.x; fl[q][1] += hv * w0.y; fl[q][2] += hv * w0.z; fl[q][3] += hv * w0.w;
                        fl[q][4] += hv * w1.x; fl[q][5] += hv * w1.y; fl[q][6] += hv * w1.z; fl[q][7] += hv * w1.w; }
                }
#pragma unroll
                for (int q = 0; q < 2; ++q) { u32x2 o; o.x = pk2(v[q][j].x, v[q][j].y); o.y = pk2(v[q][j].z, v[q][j].w);
                    *(u32x2*)(XN + (size_t)(m + q * NGW) * DM + 4 * lane + 256 * j) = o; }
            }
            float z[2];
            { const bool u5 = lane >= 32, u4 = (lane & 16) != 0, u3 = (lane & 8) != 0; float a4[2][4], a2[2][2];
#pragma unroll
              for (int q = 0; q < 2; ++q)
#pragma unroll
                  for (int e = 0; e < 4; ++e) { const float keep = u5 ? fl[q][4 + e] : fl[q][e], give = u5 ? fl[q][e] : fl[q][4 + e]; a4[q][e] = keep + __shfl_xor(give, 32); }
#pragma unroll
              for (int q = 0; q < 2; ++q)
#pragma unroll
                  for (int e = 0; e < 2; ++e) { const float keep = u4 ? a4[q][2 + e] : a4[q][e], give = u4 ? a4[q][e] : a4[q][2 + e]; a2[q][e] = keep + __shfl_xor(give, 16); }
#pragma unroll
              for (int q = 0; q < 2; ++q) z[q] = (u3 ? a2[q][1] : a2[q][0]) + __shfl_xor(u3 ? a2[q][0] : a2[q][1], 8);
#pragma unroll
              for (int o = 4; o >= 1; o >>= 1) { z[0] += __shfl_xor(z[0], o); z[1] += __shfl_xor(z[1], o); } }
            if ((lane & 7) == 0) {
                const int hd = lane >> 3; const float bfv = b_forget[hd];
#pragma unroll
                for (int q = 0; q < 2; ++q) { const int mm = m + q * NGW; const float zz = z[q] + bfv; const float ls = fminf(zz, 0.f) - log1pf(expf(-fabsf(zz)));
                    LOGF[((size_t)(mm / SEQ) * NH + hd) * SEQ + (mm % SEQ)] = ls; }
            }
        }
    }
    for (int it = gw; it < P0_ITEMS; it += NGW) {
        int r = it;
        if (r < I_WIN) { const int kb = r >> 6, nb = r & 63; p0_transpose_item(w_in + (size_t)(64 * kb) * INW + 32 * nb, INW, Win_t + (size_t)(32 * nb) * DM + 64 * kb, DM, scr, lane); continue; } r -= I_WIN;
        if (r < I_WO) { const int kb = r >> 5, nb = r & 31; p0_transpose_item(w_out + (size_t)(512 + 64 * kb) * DM + 32 * nb, DM, Wo_t + (size_t)(32 * nb) * DM + 512 + 64 * kb, DM, scr, lane); continue; } r -= I_WO;
        if (r < I_WEFF) {
            const int g = r >> 8, nb = (r >> 4) & 15, kb = r & 15, n = nb * 64 + lane; float acc[8];
#pragma unroll
            for (int i = 0; i < 8; ++i) acc[i] = 0.f;
            const float* wp = w_pool + (size_t)g * 16384 + (size_t)(kb * 8) * 128;
#pragma unroll 2
            for (int d = 0; d < 128; d += 4) { f32x4 av;
#pragma unroll
                for (int q = 0; q < 4; ++q) av[q] = w_out[(size_t)(g * 128 + d + q) * DM + n];
                av = av * *(const f32x4*)(pscale + g * 128 + d);
#pragma unroll
                for (int i = 0; i < 8; ++i) { const f32x4 wv = *(const f32x4*)(wp + i * 128 + d); acc[i] += av.x * wv.x + av.y * wv.y + av.z * wv.z + av.w * wv.w; } }
            u32x4 o; o.x = pk2(acc[0], acc[1]); o.y = pk2(acc[2], acc[3]); o.z = pk2(acc[4], acc[5]); o.w = pk2(acc[6], acc[7]);
            *(GAS u32x4*)(Wo_t + (size_t)n * DM + g * 128 + kb * 8) = o; continue; } r -= I_WEFF;
        }
}

constexpr int J_WU = 32 * 16 * 32, J_WD = 32 * 16 * 16;
struct ConvItem { const float* src; int ldw; unsigned char* dst; };
__device__ __forceinline__ ConvItem conv_item(const Args& a, int r) {
    ConvItem it;
    if (r < J_WU) { const int e = r >> 9, kb = (r >> 5) & 15, nb = r & 31, n0 = 64 * nb;
        const int rowp = n0 < 1024 ? (n0 >> 7) * 256 + (n0 & 127) : ((n0 - 1024) >> 7) * 256 + 128 + ((n0 - 1024) & 127);
        it.src = a.in[10] + (size_t)e * DM * 2048 + (size_t)(64 * kb) * 2048 + n0; it.ldw = 2048; it.dst = a.ws + WS_WU + ((size_t)e * 2048 + rowp) * DM + 64 * kb; return it; }
    r -= J_WU;
    { const int e = r >> 8, kb = (r >> 4) & 15, nb = r & 15;
      it.src = a.in[12] + (size_t)e * DE * DM + (size_t)(64 * kb) * DM + 64 * nb; it.ldw = DM; it.dst = a.ws + WS_WD + ((size_t)e * DM + 64 * nb) * DE + 64 * kb; return it; }
}
__device__ __forceinline__ void conv_load(float (&tv)[64], const ConvItem& it, int lane) {
    const float* p_ = it.src + lane;
#pragma unroll
    for (int i = 0; i < 64; ++i) tv[i] = p_[(size_t)i * it.ldw];
}
__device__ __forceinline__ void conv_finish(const float (&tv)[64], const ConvItem& it, int lane) {
    const float k_ = pg8::FP8_SW; unsigned char* d_ = it.dst + (size_t)lane * DM;
#pragma unroll
    for (int q = 0; q < 4; ++q) { u32x4 o;
        o.x = pg8::pack4_fp8(tv[16 * q + 0] * k_, tv[16 * q + 1] * k_, tv[16 * q + 2] * k_, tv[16 * q + 3] * k_); o.y = pg8::pack4_fp8(tv[16 * q + 4] * k_, tv[16 * q + 5] * k_, tv[16 * q + 6] * k_, tv[16 * q + 7] * k_);
        o.z = pg8::pack4_fp8(tv[16 * q + 8] * k_, tv[16 * q + 9] * k_, tv[16 * q + 10] * k_, tv[16 * q + 11] * k_); o.w = pg8::pack4_fp8(tv[16 * q + 12] * k_, tv[16 * q + 13] * k_, tv[16 * q + 14] * k_, tv[16 * q + 15] * k_);
        *(GAS u32x4*)(d_ + 16 * q) = o; }
}
constexpr int CONV_P2_CHUNKS = 1024, CONV_P4_PER_WAVE = 0;
static_assert(CONV_P2_CHUNKS * 24 + 256 * 4 * CONV_P4_PER_WAVE == J_WU + J_WD, "conversion split");
__device__ __forceinline__ void conv_triple(const Args& a, int r0, int lane) {
    const ConvItem i0 = conv_item(a, r0), i1 = conv_item(a, r0 + 1), i2 = conv_item(a, r0 + 2);
    float ta[64], tb[64];
    conv_load(ta, i0, lane); conv_load(tb, i1, lane);
    conv_finish(ta, i0, lane);
    conv_load(ta, i2, lane);
    conv_finish(tb, i1, lane);
    conv_finish(ta, i2, lane);
}
__device__ __forceinline__ void conv_chunk(const Args& a, int cc, int lane, int wave) { conv_triple(a, cc * 24 + wave * 3, lane); }

template <int W> __device__ __forceinline__ void pool_run(const bf16* U, bf16* CAT, int row0, int c0) {
    const int t0 = row0 % SEQ;
    u32x4 blk[8], tr[W - 1];
#pragma unroll
    for (int i = 0; i < 8; ++i) blk[i] = *(const u32x4*)(U + (size_t)(row0 + i) * PW + c0);
#pragma unroll
    for (int j = 1; j < W; ++j) { const u32x4 v_ = *(const u32x4*)(U + (size_t)(t0 - j >= 0 ? row0 - j : row0) * PW + c0); tr[j - 1] = (t0 - j >= 0) ? v_ : (u32x4){0u, 0u, 0u, 0u}; }
    float S[8];
#pragma unroll
    for (int k = 0; k < 8; ++k) S[k] = 0.f;
#pragma unroll
    for (int j = 0; j < W - 1; ++j) { const unsigned rr[4] = {tr[j].x, tr[j].y, tr[j].z, tr[j].w};
#pragma unroll
        for (int k = 0; k < 4; ++k) { S[2 * k] += __builtin_bit_cast(float, rr[k] << 16); S[2 * k + 1] += __builtin_bit_cast(float, rr[k] & 0xffff0000u); } }
#pragma unroll
    for (int i = 0; i < 8; ++i) { const int t = t0 + i; float cur[8];
        { const unsigned rr[4] = {blk[i].x, blk[i].y, blk[i].z, blk[i].w};
#pragma unroll
          for (int k = 0; k < 4; ++k) { cur[2 * k] = __builtin_bit_cast(float, rr[k] << 16); cur[2 * k + 1] = __builtin_bit_cast(float, rr[k] & 0xffff0000u); } }
        const float inv = 1.f / (float)(t + 1 < W ? t + 1 : W); float o[8];
#pragma unroll
        for (int k = 0; k < 8; ++k) { S[k] += cur[k]; o[k] = S[k] * inv - cur[k]; }
        u32x4 ov; ov.x = pk2(o[0], o[1]); ov.y = pk2(o[2], o[3]); ov.z = pk2(o[4], o[5]); ov.w = pk2(o[6], o[7]);
        *(u32x4*)(CAT + (size_t)(row0 + i) * DM + c0) = ov;
        const u32x4 sb = (i - (W - 1) >= 0) ? blk[(i - (W - 1) >= 0) ? i - (W - 1) : 0] : tr[(i - (W - 1) >= 0) ? 0 : (W - 1) - i - 1];
        { const unsigned rr[4] = {sb.x, sb.y, sb.z, sb.w};
#pragma unroll
          for (int k = 0; k < 4; ++k) { S[2 * k] -= __builtin_bit_cast(float, rr[k] << 16); S[2 * k + 1] -= __builtin_bit_cast(float, rr[k] & 0xffff0000u); } }
    }
}
__device__ __forceinline__ void pool_chunk(const Args& a, int c, int tid) {
    const bf16* U = (const bf16*)(a.ws + WS_U); bf16* CAT = (bf16*)(a.ws + WS_CAT);
    const int wv = tid >> 6, ln = tid & 63, g = wv & 3, ch = 16 * g + (ln & 15), c0 = ch * 8;
#pragma unroll 1
    for (int hf = 0; hf < 2; ++hf) { const int row0 = 128 * c + 8 * (hf * 8 + (wv >> 2) * 4 + (ln >> 4));
        if (g == 0) pool_run<2>(U, CAT, row0, c0); else if (g == 1) pool_run<4>(U, CAT, row0, c0); else if (g == 2) pool_run<8>(U, CAT, row0, c0); else pool_run<16>(U, CAT, row0, c0); }
}
__device__ __forceinline__ void c2_local_scan(const Args& a, LAS unsigned char* L, int bx, int tid, int lane, int wave) {
    if (bx >= 256) return;
    const int bh = bx >> 3, blk = bx & 7; const size_t off = (size_t)bh * SEQ + blk * 1024 + tid * 2;
    const float* src = (const float*)(a.ws + WS_LOGF) + off; float* dst = (float*)(a.ws + WS_CUM) + off;
    LAS double* wtot = (LAS double*)(L + 0);
    const float v0 = src[0], v1 = src[1]; const double s = (double)v0 + (double)v1; double inc = s;
#pragma unroll
    for (int o = 1; o < 64; o <<= 1) { const double t_ = __shfl_up(inc, o); if (lane >= o) inc += t_; }
    if (lane == 63) wtot[wave] = inc;
    __syncthreads();
    double base = inc - s;
    for (int w = 0; w < wave; ++w) base += wtot[w];
    dst[0] = (float)((base + (double)v0) * (double)LOG2E); dst[1] = (float)((base + s) * (double)LOG2E);
    if (tid == 511) ((float*)(a.ws + WS_TOT))[bh * 8 + blk] = (float)((base + s) * (double)LOG2E);
    __syncthreads();
}
__device__ __forceinline__ int c2_prepare(const Args& a, LAS unsigned char* L, int bh, int qb, float qkb2, int tid) {
    const float* cum = (const float*)(a.ws + WS_CUM) + (size_t)bh * SEQ; const float* tot = (const float*)(a.ws + WS_TOT) + bh * 8;
    LAS float* c2s = (LAS float*)(L + attn_body::LDS_C2);
    float pre[8]; { double b_ = 0.0;
#pragma unroll
        for (int w = 0; w < 8; ++w) { pre[w] = (float)b_; b_ += (double)tot[w]; } }
    const int q0 = qb * 256, NT = 4 * qb + 4, lane = tid & 63;
    float pq = 0.f;
#pragma unroll
    for (int w = 0; w < 8; ++w) if ((q0 >> 10) == w) pq = pre[w];
    const float cq = cum[q0] + pq + qkb2 + 40.0f;
    int j0;
    { const int m = lane; bool sk = false;
      if (m >= 1 && m <= ((NT - 4) >> 1)) { const int pos = 128 * m - 1; float pp = 0.f;
#pragma unroll
          for (int w = 0; w < 8; ++w) if ((pos >> 10) == w) pp = pre[w];
          sk = (cq - (cum[pos] + pp)) < 0.f; }
      const unsigned long long bal = __ballot(sk) >> 1;
      j0 = 2 * (int)__builtin_ctzll(~bal); }
    for (int idx = 64 * j0 + 4 * tid; idx < q0 + 256; idx += 4 * 512) { float pp = 0.f;
#pragma unroll
        for (int w = 0; w < 8; ++w) if ((idx >> 10) == w) pp = pre[w];
        f32x4 v = *(const f32x4*)(cum + idx); v = v + pp; *(LAS f32x4*)(c2s + idx) = v; }
    __syncthreads();
    return __builtin_amdgcn_readfirstlane(j0);
}

constexpr int RT_GWH = 0, RT_GWL = 65536, RT_GF = 131072, RT_CHE = 135168, RT_CHG = RT_CHE + 2048, RT_LCNT = RT_CHG + 2048, RT_LBASE = RT_LCNT + 128;
static_assert(RT_LBASE + 128 <= LDSCTL_OFF, "router LDS map");
__device__ __forceinline__ void router_phase(const Args& a, LAS unsigned char* L, int vcu, int G, int tid, int lane, int wave) {
    typedef short bf16x8_t __attribute__((ext_vector_type(8))); typedef float f32x16_t __attribute__((ext_vector_type(16)));
    LAS unsigned short* gwh = (LAS unsigned short*)(L + RT_GWH); LAS unsigned short* gwl = (LAS unsigned short*)(L + RT_GWL); LAS float* gf = (LAS float*)(L + RT_GF);
    LAS int* ch_e = (LAS int*)(L + RT_CHE); LAS float* ch_g = (LAS float*)(L + RT_CHG); LAS int* lcnt = (LAS int*)(L + RT_LCNT); LAS int* lbase = (LAS int*)(L + RT_LBASE);
    const float* w_router = a.in[8]; const float* b_router = a.in[9]; const float* g_ffn = a.in[7];
    for (int idx = tid; idx < 1024 * 32; idx += 512) { const int k = idx >> 5, e = idx & 31; const float v = g_ffn[k] * w_router[idx];
        const unsigned hb = f2bf(v); const float hf = __builtin_bit_cast(float, hb << 16); const unsigned lb = f2bf(v - hf);
        const int pos = (((k >> 4) * 2 + ((k >> 3) & 1)) * 32 + e) * 8 + (k & 7); gwh[pos] = (unsigned short)hb; gwl[pos] = (unsigned short)lb; }
    for (int k = tid; k < 1024; k += 512) gf[k] = g_ffn[k];
    __syncthreads();
    const bf16* X1 = (const bf16*)(a.ws + WS_X1B); unsigned char* H2 = a.ws + WS_XN;
    int* cnt = (int*)(a.ws + WS_CTL) + CW_CNT; int* SEL = (int*)(a.ws + WS_SEL); int* LTK = (int*)(a.ws + WS_LTK); float* LGT = (float*)(a.ws + WS_LGT);
    const int j = lane & 31, hlf = lane >> 5;
    for (int grp = vcu; grp < T / 128; grp += G) {
        if (tid < 32) lcnt[tid] = 0;
        __syncthreads();
        if (wave < 4) {
            const int lt = wave * 32 + j, m = grp * 128 + lt;
            const bf16* xr = X1 + (size_t)m * DM + 8 * hlf;
            f32x16_t acc; float ss = 0.f;
#pragma unroll
            for (int r = 0; r < 16; ++r) acc[r] = 0.f;
#pragma unroll 8
            for (int s = 0; s < 64; ++s) {
                const u32x4 xb = *(const u32x4*)(xr + 16 * s);
                const bf16x8_t ah = *(const LAS bf16x8_t*)(gwh + ((s * 2 + hlf) * 32 + j) * 8), al = *(const LAS bf16x8_t*)(gwl + ((s * 2 + hlf) * 32 + j) * 8);
                const bf16x8_t xf = __builtin_bit_cast(bf16x8_t, xb);
                acc = __builtin_amdgcn_mfma_f32_32x32x16_bf16(ah, xf, acc, 0, 0, 0);
                acc = __builtin_amdgcn_mfma_f32_32x32x16_bf16(al, xf, acc, 0, 0, 0);
                const unsigned w_[4] = {xb.x, xb.y, xb.z, xb.w};
#pragma unroll
                for (int q = 0; q < 4; ++q) { const float lo = __builtin_bit_cast(float, w_[q] << 16), hi = __builtin_bit_cast(float, w_[q] & 0xffff0000u); ss += lo * lo + hi * hi; }
            }
            ss += __shfl_xor(ss, 32);
            const float rstd = rsqrtf(ss * (1.f / DM) + RMS_EPS);
            float lv[16];
#pragma unroll
            for (int r = 0; r < 16; ++r) lv[r] = acc[r] * rstd + b_router[(r & 3) + 8 * (r >> 2) + 4 * hlf];
            float tv[4]; int ti[4];
#pragma unroll
            for (int k = 0; k < 4; ++k) { float bv = -INFINITY; int bi = 64;
#pragma unroll
                for (int r = 0; r < 16; ++r) { const int ei = (r & 3) + 8 * (r >> 2) + 4 * hlf; if (lv[r] > bv) { bv = lv[r]; bi = ei; } }
                tv[k] = bv; ti[k] = bi;
#pragma unroll
                for (int r = 0; r < 16; ++r) { const int ei = (r & 3) + 8 * (r >> 2) + 4 * hlf; if (ei == bi) lv[r] = -INFINITY; } }
            float cv[8]; int ci[8];
#pragma unroll
            for (int k = 0; k < 4; ++k) { cv[k] = tv[k]; ci[k] = ti[k]; cv[4 + k] = __shfl_xor(tv[k], 32); ci[4 + k] = __shfl_xor(ti[k], 32); }
#pragma unroll
            for (int k = 0; k < 4; ++k) { float bv = -INFINITY; int bi = 64;
#pragma unroll
                for (int c = 0; c < 8; ++c) if (cv[c] > bv || (cv[c] == bv && ci[c] < bi)) { bv = cv[c]; bi = ci[c]; }
                tv[k] = bv; ti[k] = bi;
#pragma unroll
                for (int c = 0; c < 8; ++c) if (ci[c] == bi) cv[c] = -INFINITY; }
            const float e1 = expf(tv[1] - tv[0]), e2 = expf(tv[2] - tv[0]), e3 = expf(tv[3] - tv[0]); const float inv = 1.f / (1.f + e1 + e2 + e3);
            if (hlf == 0) { ch_e[lt * 4 + 0] = ti[0]; ch_e[lt * 4 + 1] = ti[1]; ch_e[lt * 4 + 2] = ti[2]; ch_e[lt * 4 + 3] = ti[3];
                ch_g[lt * 4 + 0] = inv; ch_g[lt * 4 + 1] = e1 * inv; ch_g[lt * 4 + 2] = e2 * inv; ch_g[lt * 4 + 3] = e3 * inv;
#pragma unroll
                for (int k = 0; k < 4; ++k) __hip_atomic_fetch_add(&lcnt[ti[k]], 1, __ATOMIC_RELAXED, __HIP_MEMORY_SCOPE_WORKGROUP); }
            unsigned char* hr = H2 + (size_t)m * DM + 8 * hlf; const float sc = rstd * pg8::FP8_SA;
#pragma unroll 8
            for (int s = 0; s < 64; ++s) {
                const u32x4 xb = *(const u32x4*)(xr + 16 * s); const unsigned w_[4] = {xb.x, xb.y, xb.z, xb.w};
                const f32x4 g0 = *(const LAS f32x4*)(gf + 16 * s + 8 * hlf), g1 = *(const LAS f32x4*)(gf + 16 * s + 8 * hlf + 4);
                float x_[8];
#pragma unroll
                for (int q = 0; q < 4; ++q) { x_[2 * q] = __builtin_bit_cast(float, w_[q] << 16); x_[2 * q + 1] = __builtin_bit_cast(float, w_[q] & 0xffff0000u); }
                u32x2 o; o.x = pg8::pack4_fp8(x_[0] * g0.x * sc, x_[1] * g0.y * sc, x_[2] * g0.z * sc, x_[3] * g0.w * sc); o.y = pg8::pack4_fp8(x_[4] * g1.x * sc, x_[5] * g1.y * sc, x_[6] * g1.z * sc, x_[7] * g1.w * sc);
                *(u32x2*)(hr + 16 * s) = o;
            }
        }
        __syncthreads();
        if (tid < 32) { lbase[tid] = atomicAdd(&cnt[tid], lcnt[tid]); lcnt[tid] = 0; }
        __syncthreads();
        { const int e = ch_e[tid]; const int slot = lbase[e] + __hip_atomic_fetch_add(&lcnt[e], 1, __ATOMIC_RELAXED, __HIP_MEMORY_SCOPE_WORKGROUP); const int tk = (grp * 128 + (tid >> 2)) * 4 + (tid & 3);
          LTK[(size_t)e * T + slot] = tk; LGT[(size_t)e * T + slot] = ch_g[tid]; SEL[tk] = (slot << 5) | e; }
        __syncthreads();
    }
}

__device__ __forceinline__ void expert_map(const Args& a, volatile LAS unsigned* MISC, int tid) {
    if (tid == 0) { const int* cnt = (const int*)(a.ws + WS_CTL) + CW_CNT; int acc = 0;
        for (int e = 0; e < 32; ++e) { const int c = __hip_atomic_load((int*)cnt + e, RLX_AGENT); MISC[64 + e] = (unsigned)c; MISC[96 + e] = (unsigned)acc; acc += (c + RT - 1) / RT; } MISC[128] = (unsigned)acc; }
    __syncthreads();
}

__device__ __forceinline__ void final_phase(const Args& a, volatile LAS unsigned* MISC, int vcu, int G, int lane, int wave) {
    const int* SEL = (const int*)(a.ws + WS_SEL); const unsigned char* Y = a.ws + WS_Y; const bf16* X1 = (const bf16*)(a.ws + WS_X1B); const float* g_final = a.in[14];
    f32x4 g[4];
#pragma unroll
    for (int j = 0; j < 4; ++j) g[j] = *(const f32x4*)(g_final + 4 * lane + 256 * j);
    typedef float f32x2_t __attribute__((ext_vector_type(2)));
    const int m0 = vcu * 8 + wave, MS = G * 8;
    int svn[4]; u32x2 xbn[4];
#pragma unroll
    for (int k = 0; k < 4; ++k) svn[k] = SEL[m0 * 4 + k];
#pragma unroll
    for (int j = 0; j < 4; ++j) xbn[j] = *(const u32x2*)(X1 + (size_t)m0 * DM + 4 * lane + 256 * j);
    for (int m = m0; m < T; m += MS) {
        f32x4 v[4]; unsigned yv[4][4];
#pragma unroll
        for (int k = 0; k < 4; ++k) { const int e = svn[k] & 31, slot = svn[k] >> 5; const unsigned char* yr = Y + ((size_t)MISC[96 + e] * RT + slot) * DM;
#pragma unroll
            for (int j = 0; j < 4; ++j) yv[k][j] = *(const unsigned*)(yr + 4 * lane + 256 * j); }
#pragma unroll
        for (int j = 0; j < 4; ++j) { const u32x2 xb = xbn[j];
            v[j].x = __builtin_bit_cast(float, xb.x << 16); v[j].y = __builtin_bit_cast(float, xb.x & 0xffff0000u); v[j].z = __builtin_bit_cast(float, xb.y << 16); v[j].w = __builtin_bit_cast(float, xb.y & 0xffff0000u); }
        { const int mn = (m + MS < T) ? m + MS : m;
#pragma unroll
          for (int k = 0; k < 4; ++k) svn[k] = SEL[mn * 4 + k];
#pragma unroll
          for (int j = 0; j < 4; ++j) xbn[j] = *(const u32x2*)(X1 + (size_t)mn * DM + 4 * lane + 256 * j); }
        f32x4 ya[4];
#pragma unroll
        for (int j = 0; j < 4; ++j) ya[j] = (f32x4){0.f, 0.f, 0.f, 0.f};
#pragma unroll
        for (int k = 0; k < 4; ++k)
#pragma unroll
            for (int j = 0; j < 4; ++j) { const unsigned y = yv[k][j];
                const f32x2_t lo = __builtin_amdgcn_cvt_pk_f32_fp8((int)y, false), hi = __builtin_amdgcn_cvt_pk_f32_fp8((int)y, true);
                ya[j].x += lo.x; ya[j].y += lo.y; ya[j].z += hi.x; ya[j].w += hi.y; }
        float ss = 0.f;
#pragma unroll
        for (int j = 0; j < 4; ++j) { v[j] = v[j] + ya[j] * (1.0f / pg8::FP8_SY); ss += v[j].x * v[j].x + v[j].y * v[j].y + v[j].z * v[j].z + v[j].w * v[j].w; }
        const float rstd = rsqrtf(wave_sum(ss) * (1.f / DM) + RMS_EPS);
        float* orow = a.out + (size_t)m * DM;
#pragma unroll
        for (int j = 0; j < 4; ++j) *(f32x4*)(orow + 4 * lane + 256 * j) = v[j] * rstd * g[j];
    }
}

__global__ void __launch_bounds__(NWAVES * 64, 2) mk_fwd(Args args) {
    extern __shared__ __attribute__((aligned(16))) unsigned char lds[];
    LAS unsigned char* L = (LAS unsigned char*)lds;
    volatile LAS unsigned* MISC = (volatile LAS unsigned*)(L + LDSCTL_OFF);
    const int tid = threadIdx.x, lane = tid & 63, wave = __builtin_amdgcn_readfirstlane(tid >> 6);
    const int G = gridDim.x; const int bx = blockIdx.x; const int vcu = (G % 8 == 0) ? (bx % 8) * (G / 8) + bx / 8 : bx;
    unsigned char* ws = args.ws;
    for (int u = tid; u < (LDS_TOTAL - LDSCTL_OFF) / 4; u += NWAVES * 64) ((LAS unsigned*)(L + LDSCTL_OFF))[u] = 0u;
    __syncthreads();
    XcdBarrier bar; bar.bar = (unsigned*)(ws + WS_CTL) + CW_BAR; bar.x = 0; bar.st = nullptr;
    if (args.use_bar) bar = xcd_barrier_post((unsigned*)(ws + WS_CTL) + CW_BAR, MISC + 8);
    const int lo = args.ph_lo, hi = args.ph_hi;
#define IN(k) (lo <= (k) && (k) < hi)
#define SEAM(k) do { if (IN(k) && IN((k) + 1)) xcd_barrier(bar); } while (0)
#ifndef MK_DUP
#define MK_DUP -1
#endif
#ifndef MK_TPROBE
#define MK_TPROBE -1
#endif
#define CK0(k) do { if ((MK_TPROBE) == 100 + (k) && bx == 0 && tid == 0) { const unsigned long long c_ = __builtin_amdgcn_s_memtime(); const unsigned long long t_ = __builtin_amdgcn_s_memrealtime(); MISC[28] = (unsigned)c_; MISC[29] = (unsigned)(c_ >> 32); MISC[16] = (unsigned)t_; MISC[17] = (unsigned)(t_ >> 32); } } while (0)
#define CK1(k) do { if ((MK_TPROBE) == 100 + (k) && bx == 0 && tid == 0) { const unsigned long long c_ = __builtin_amdgcn_s_memtime(); const unsigned long long t_ = __builtin_amdgcn_s_memrealtime(); const unsigned long long c0_ = ((unsigned long long)MISC[29] << 32) | MISC[28], t0_ = ((unsigned long long)MISC[17] << 32) | MISC[16]; \
    const unsigned long long spin_ = (c_ - c0_) * 1000ull / (t_ - t0_); MISC[18] = (unsigned)(t0_ + spin_); MISC[19] = (unsigned)((t0_ + spin_) >> 32); } } while (0)
#define TP0(k) do { if ((MK_TPROBE) == (k) && bx == 0 && tid == 0) { const unsigned long long t_ = __builtin_amdgcn_s_memrealtime(); MISC[16] = (unsigned)t_; MISC[17] = (unsigned)(t_ >> 32); } } while (0)
#define TP1(k) do { if ((MK_TPROBE) == (k) && bx == 0 && tid == 0) { const unsigned long long t_ = __builtin_amdgcn_s_memrealtime(); MISC[18] = (unsigned)t_; MISC[19] = (unsigned)(t_ >> 32); } } while (0)
#define REPS(k) for (int rep_ = 0; rep_ < ((MK_DUP) == (k) ? 2 : 1); ++rep_, ((MK_DUP) == (k) && rep_ == 1 ? xcd_barrier(bar) : (void)0))

    TP0(0); CK0(0); TP0(200);
    if ((MK_TPROBE) == 300 || (MK_TPROBE) == 301) {
        if (bx == 0 && tid < 64) { typedef int v8i_ __attribute__((ext_vector_type(8))); typedef short s8_ __attribute__((ext_vector_type(8)));
            pg8::f32x4 c0 = {0, 0, 0, 0}, c1 = c0, c2 = c0, c3 = c0; v8i_ a8 = {tid, 1, 2, 3, 4, 5, 6, 7}, b8 = {7, 6, 5, 4, 3, 2, 1, tid}; s8_ a4 = {1, 2, 3, 4, 5, 6, 7, 8}, b4 = a4;
            const unsigned long long t0_ = __builtin_amdgcn_s_memtime();
            for (int it = 0; it < 1024; ++it) {
                if ((MK_TPROBE) == 300) { asm volatile("v_mfma_f32_16x16x128_f8f6f4 %0, %1, %2, %0" : "+v"(c0) : "v"(a8), "v"(b8)); asm volatile("v_mfma_f32_16x16x128_f8f6f4 %0, %1, %2, %0" : "+v"(c1) : "v"(a8), "v"(b8));
                    asm volatile("v_mfma_f32_16x16x128_f8f6f4 %0, %1, %2, %0" : "+v"(c2) : "v"(a8), "v"(b8)); asm volatile("v_mfma_f32_16x16x128_f8f6f4 %0, %1, %2, %0" : "+v"(c3) : "v"(a8), "v"(b8)); }
                else { c0 = __builtin_amdgcn_mfma_f32_16x16x32_bf16(a4, b4, c0, 0, 0, 0); c1 = __builtin_amdgcn_mfma_f32_16x16x32_bf16(a4, b4, c1, 0, 0, 0); c2 = __builtin_amdgcn_mfma_f32_16x16x32_bf16(a4, b4, c2, 0, 0, 0); c3 = __builtin_amdgcn_mfma_f32_16x16x32_bf16(a4, b4, c3, 0, 0, 0); } }
            asm volatile("s_nop 15\n\ts_nop 15" ::: "memory");
            const unsigned long long t1_ = __builtin_amdgcn_s_memtime();
            asm volatile("" :: "v"(c0), "v"(c1), "v"(c2), "v"(c3));
            if (tid == 0) MISC[21] = (unsigned)((t1_ - t0_) * 1000ull / 4096ull); } }
    if (IN(0)) REPS(0) { phase0(args, L, vcu, G, tid, lane, wave); }
    CK1(0); SEAM(0); TP1(0); TP0(1); CK0(1);
    if (IN(1)) REPS(1) {
        pg8::Gemm g{(const bf16*)(ws + WS_XN), (const bf16*)(ws + WS_WIN), DM}; pg8::StaticOrder S; S.init(T, 2048, G, bx);
        c2_local_scan(args, L, bx, tid, lane, wave);
        pg8::EpiInproj E{(bf16*)(ws + WS_U), (size_t)(WS_Q - WS_U) / 2, C2, (unsigned*)(ws + WS_CTL) + CW_NRM};
        pg8::gemm_phase<pg8::EpiInproj, pg8::StaticOrder, true, false>(L + RING_OFF, g, S, E, nullptr);
    }
    CK1(1); SEAM(1); TP1(1); TP0(2); CK0(2);
    if (IN(2)) {
        constexpr unsigned NQ_POOL = T / 128, NQA = NQ_POOL + 1024, NQC = CONV_P2_CHUNKS;
        unsigned* qhead = (unsigned*)(ws + WS_CTL) + CW_Q; const float* nrm = (const float*)(ws + WS_CTL) + CW_NRM;
        const attn_body::AttnTensors AT{(const attn_body::bf16*)(ws + WS_Q), (const attn_body::bf16*)(ws + WS_K), (const attn_body::bf16*)(ws + WS_V), (attn_body::bf16*)(ws + WS_CAT) + PW};
        #ifndef MK_CONV_MASK
#define MK_CONV_MASK 3
#endif
        const int pref = ((bx & (MK_CONV_MASK)) == 0) ? 1 : 0;
#define QT0() unsigned long long tq0_ = 0; if ((MK_TPROBE) >= 26 && (MK_TPROBE) <= 29 && threadIdx.x == 0) tq0_ = __builtin_amdgcn_s_memrealtime()
#define QT1(kind) do { if ((MK_TPROBE) == (kind) && threadIdx.x == 0) atomicAdd((unsigned*)(ws + WS_CTL) + 512, (unsigned)(__builtin_amdgcn_s_memrealtime() - tq0_)); } while (0)
#define CONV_LOOP() do { unsigned pend_ = 0; int sl_ = 0; if (threadIdx.x == 0) pend_ = atomicAdd(qhead + 64, 1u); \
        for (;;) { int tid_ = threadIdx.x; asm volatile("" : "+v"(tid_));   \
            if (tid_ == 0) MISC[24 + sl_] = pend_; __syncthreads(); const unsigned q = MISC[24 + sl_]; sl_ ^= 1; if (q >= NQC) break; \
            if (tid_ == 0) pend_ = atomicAdd(qhead + 64, 1u); \
            QT0(); conv_chunk(args, (int)q, tid_ & 63, tid_ >> 6); QT1(28); } } while (0)
        if (pref) { CONV_LOOP(); __syncthreads(); }
        { int sl_ = 0;
        for (;;) {
            int tid_ = threadIdx.x; asm volatile("" : "+v"(tid_));
            if (tid_ == 0) MISC[26 + sl_] = atomicAdd(qhead, 1u);
            __syncthreads();
            const unsigned q = MISC[26 + sl_]; sl_ ^= 1;
            if (q >= NQA) break;
            QT0();
            if (q < NQ_POOL) { pool_chunk(args, (int)q, tid_); }
            else { const int grp = (int)(q - NQ_POOL), qb = 31 - (grp >> 5), bh = grp & 31;
                const float qkb2 = 4.0f * sqrtf(nrm[bh] * nrm[32 + bh]) * 1.001f;
                attn_body::attn_unit<8>(bh / NH, bh % NH, qb, AT.Q, AT.K, AT.V, AT.O, (char*)lds + RING_OFF, c2_prepare(args, L, bh, qb, qkb2, tid_), ((MK_TPROBE) == 400) ? (unsigned*)(ws + WS_CTL) + 513 : nullptr); }
            if (q < NQ_POOL) QT1(26); else QT1(27);
        } }
#ifndef MK_CONV_HELP
#define MK_CONV_HELP 1
#endif
        if (MK_CONV_HELP) { __syncthreads(); CONV_LOOP(); }
#undef CONV_LOOP
    }
    CK1(2); SEAM(2); TP1(2); TP0(3); CK0(3);
    if (IN(3)) REPS(3) {
        pg8::Gemm g{(const bf16*)(ws + WS_CAT), (const bf16*)(ws + WS_WO), DM}; pg8::StaticOrder S; S.init(T, DM, G, bx);
        pg8::EpiResBf16 E{args.in[0], (bf16*)(ws + WS_X1B)};
        pg8::gemm_phase<pg8::EpiResBf16, pg8::StaticOrder, true, false>(L + RING_OFF, g, S, E, nullptr);
    }
    CK1(3); SEAM(3); TP1(3); TP0(4); CK0(4);
    if (IN(4)) { router_phase(args, L, vcu, G, tid, lane, wave); }
    CK1(4); SEAM(4); TP1(4); TP0(5); CK0(5);
    if (IN(5)) REPS(5) {
        TP0(51); expert_map(args, MISC, tid);
        const LAS int* pt = (const LAS int*)(L + LDSCTL_OFF + 96 * 4); const LAS int* cn = (const LAS int*)(L + LDSCTL_OFF + 64 * 4);
        LAS unsigned* tab = (LAS unsigned*)(L + TAB_OFF);
        LAS int* ul = (LAS int*)(L + LDSCTL_OFF + 132 * 4);
        pg8::MoeOrder<8>::build(ul, pt, bx, tid);
        const pg8::MoeOrder<8> S{ul, (size_t)2048 * DM};
        { const int* LTK = (const int*)(ws + WS_LTK); const int nu = ul[0];
          for (int idx = tid; idx < nu * 256; idx += NWAVES * 64) { const int i = idx >> 8, r = idx & 255, e = ul[6 + 4 * i], slot = ul[7 + 4 * i] + r;
              const int tok = slot < cn[e] ? (LTK[(size_t)e * T + slot] >> 2) : 0; tab[idx] = (unsigned)tok * (unsigned)DM; } }
        __syncthreads(); TP1(51);
        pg8::Gemm g{(const bf16*)(ws + WS_XN), (const bf16*)(ws + WS_WU), DM / 2};
        pg8::EpiSwiglu8 E{ws + WS_ACT, args.in[11]};
        pg8::gemm_phase<pg8::EpiSwiglu8, pg8::MoeOrder<8>, true, true, true>(L + RING_OFF, g, S, E, tab, ((MK_TPROBE) == 52 && bx == 0) ? (volatile LAS unsigned*)(MISC + 20) : nullptr);
    }
    CK1(5); SEAM(5); TP1(5); TP0(6); CK0(6);
    if (IN(6)) REPS(6) {
        expert_map(args, MISC, tid);
        const LAS int* pt = (const LAS int*)(L + LDSCTL_OFF + 96 * 4); const LAS int* cn = (const LAS int*)(L + LDSCTL_OFF + 64 * 4);
        LAS int* ul = (LAS int*)(L + LDSCTL_OFF + 132 * 4);
        pg8::MoeOrder<4>::build(ul, pt, bx, tid);
        const pg8::MoeOrder<4> S{ul, (size_t)DM * DE};
        pg8::Gemm g{(const bf16*)(ws + WS_ACT), (const bf16*)(ws + WS_WD), DE / 2};
        pg8::EpiDown E{ws + WS_Y, args.in[13], (const float*)(ws + WS_LGT), cn, T, pg8::FP8_INV};
        pg8::gemm_phase<pg8::EpiDown, pg8::MoeOrder<4>, true, false, true>(L + RING_OFF, g, S, E, nullptr);
    }
    CK1(6); SEAM(6); TP1(6); TP0(7); CK0(7); TP0(70);
    if (IN(7)) { expert_map(args, MISC, tid); final_phase(args, MISC, vcu, G, lane, wave); }
    if ((MK_TPROBE) == 70) { xcd_barrier(bar); }
    TP1(7); TP1(70); TP1(200);
    if ((MK_TPROBE) >= 0 && bx == 0) { __syncthreads(); const unsigned long long ta = ((unsigned long long)MISC[17] << 32) | MISC[16], tb = ((MK_TPROBE) == 400) ? ta + (__hip_atomic_load((unsigned*)(ws + WS_CTL) + 513, RLX_AGENT) * 1000u >> 10) : ((MK_TPROBE) == 300 || (MK_TPROBE) == 301) ? ta + MISC[21] : ((MK_TPROBE) >= 26 && (MK_TPROBE) <= 29) ? ta + (__hip_atomic_load((unsigned*)(ws + WS_CTL) + 512, RLX_AGENT) >> 8) : ((MK_TPROBE) == 52 || ((MK_TPROBE) >= 23 && (MK_TPROBE) <= 25)) ? ta + MISC[20] : (((unsigned long long)MISC[19] << 32) | MISC[18]);
        const unsigned long long tend = __builtin_amdgcn_s_memrealtime() + (tb - ta); while (__builtin_amdgcn_s_memrealtime() < tend) __builtin_amdgcn_s_sleep(10); }
#undef IN
#undef SEAM
}
extern "C" void kernel_launch(void* const* d_in, const int* in_sizes, int n_in, void* d_out, int out_size, void* d_ws, size_t ws_size, hipStream_t stream) {
    if (n_in != 15 || out_size != T * DM || ws_size < WS_END) { fprintf(stderr, "kernel_launch: unexpected shapes (n_in %d out %d ws %zu)\n", n_in, out_size, ws_size); return; }
    Args a{};
    for (int i = 0; i < 15; ++i) a.in[i] = (const float*)d_in[i];
    a.out = (float*)d_out; a.ws = (unsigned char*)d_ws;
    static bool attr_done = false;
    if (!attr_done) { if (hipFuncSetAttribute((const void*)mk_fwd, hipFuncAttributeMaxDynamicSharedMemorySize, LDS_TOTAL) != hipSuccess) fprintf(stderr, "kernel_launch: hipFuncSetAttribute failed\n"); attr_done = true; }
    (void)hipMemsetAsync((char*)d_ws + WS_CTL, 0, 1 * MiB, stream);
    a.ph_lo = 0; a.ph_hi = N_PHASES; a.use_bar = 1;
    hipLaunchKernelGGL(mk_fwd, dim3(256), dim3(NWAVES * 64), LDS_TOTAL, stream, a);
}
```

```cpp
#include <hip/hip_runtime.h>
#include <cstdio>
#include <cstdint>

constexpr int BATCH = 4, SEQ = 8192, DM = 1024, T = BATCH * SEQ;
constexpr int PW = 512, AW = 512, NH = 8, HD = 64, INW = PW + 3 * AW + NH;
constexpr int NE = 32, TOPK = 4, DE = 1024;
constexpr float RMS_EPS = 1e-5f, SW_LIMIT = 7.0f, SW_ALPHA = 1.702f;
constexpr float LOG2E = 1.4426950408889634f;
constexpr float C2 = 0.125f * LOG2E;
constexpr int RT = 256;
constexpr int NROWS_PAD = T * TOPK + NE * RT;

typedef unsigned short bf16;
typedef float f32x4 __attribute__((ext_vector_type(4)));
typedef unsigned u32x4 __attribute__((ext_vector_type(4)));
typedef unsigned u32x2 __attribute__((ext_vector_type(2)));

constexpr size_t MiB = 1u << 20;
constexpr size_t WS_CTL = 0;
constexpr size_t WS_LOGF = 1 * MiB;
constexpr size_t WS_CUM = 2 * MiB;
constexpr size_t WS_SEL = 3 * MiB;
constexpr size_t WS_LTK = 4 * MiB;
constexpr size_t WS_LGT = 8 * MiB;
constexpr size_t WS_XN = 12 * MiB;
constexpr size_t WS_WIN = 76 * MiB;
constexpr size_t WS_WO = 80 * MiB;
constexpr size_t WS_WU = 82 * MiB;
constexpr size_t WS_WD = 210 * MiB;
constexpr size_t WS_U = 274 * MiB;
constexpr size_t WS_Q = 306 * MiB;
constexpr size_t WS_K = 338 * MiB;
constexpr size_t WS_V = 370 * MiB;
constexpr size_t WS_CAT = 402 * MiB;
constexpr size_t WS_P = 466 * MiB;
constexpr size_t WS_ACT = 274 * MiB;
constexpr size_t WS_Y = 546 * MiB;
constexpr size_t WS_END = 818 * MiB;
static_assert(WS_ACT + (size_t)NROWS_PAD * 1024 * 2 <= WS_Y, "ACT overlay");
static_assert(WS_Y + (size_t)NROWS_PAD * 1024 * 2 <= WS_END, "Y");
constexpr int CW_CNT = 64;


__device__ __forceinline__ unsigned f2bf(float f) { unsigned u = __builtin_bit_cast(unsigned, f); return (u + 0x7fffu + ((u >> 16) & 1u)) >> 16; }
__device__ __forceinline__ unsigned pk2(float lo, float hi) { return f2bf(lo) | (f2bf(hi) << 16); }
__device__ __forceinline__ float bf2f(unsigned short b) { return __builtin_bit_cast(float, (unsigned)b << 16); }
__device__ __forceinline__ float wave_sum(float v) {
#pragma unroll
    for (int o = 1; o < 64; o <<= 1) v += __shfl_xor(v, o);
    return v;
}

namespace pg8 {
#define PG8_LAS __attribute__((address_space(3)))
typedef unsigned short bf16_t;
typedef short bf16x8 __attribute__((ext_vector_type(8)));
typedef float f32x4 __attribute__((ext_vector_type(4)));
typedef unsigned u32x4 __attribute__((ext_vector_type(4)));
constexpr int BM = 256, BK = 64, HALF = 128, HTB = HALF * BK * 2  , STAGE_BYTES = 8 * HTB, NXCD = 8, WGM = 8;

__host__ __device__ __forceinline__ int lds_byte(int r, int c) { const int ch = (c >> 3) ^ ((r >> 1) & 7); return (r >> 3) * 1024 + (r & 7) * 128 + ch * 16 + (c & 7) * 2; }
__host__ __device__ __forceinline__ void stage_rc(int b, int& R, int& C) { const int st = b >> 10, sb = b & 1023; R = st * 8 + (sb >> 7); C = ((((sb >> 4) & 7) ^ ((R >> 1) & 7)) * 8); }
__host__ __device__ __forceinline__ int perm32(int rho) { const int n = rho >> 4, i = rho & 15; return 8 * (i >> 2) + 4 * n + (i & 3); }

struct Unit { int pm, pn, e, lrow0; size_t boff; };
struct Gemm { const bf16_t* A; const bf16_t* Bt; int K; };

struct StaticOrder {
    int nM, nN, nwg, G, c;
    __host__ __device__ void init(int M, int N, int G_, int c_) { nM = M / BM; nN = N / BM; nwg = nM * nN; G = G_; c = c_; }
    __host__ __device__ bool next(int i, Unit& u) const {
        const long L = (long)i * G + c; if (L >= nwg) return false;
        int wgid = (int)L; { const int q = nwg / NXCD, r = nwg % NXCD, xcd = wgid % NXCD, off = wgid / NXCD; wgid = (xcd < r ? xcd * (q + 1) : r * (q + 1) + (xcd - r) * q) + off; }
        const int nig = WGM * nN, gid = wgid / nig, fm = gid * WGM, gsz = (nM - fm) < WGM ? (nM - fm) : WGM;
        u.pm = fm + ((wgid % nig) % gsz); u.pn = (wgid % nig) / gsz; u.e = 0; u.lrow0 = 0; u.boff = 0; return true;
    }
};
template <int NCOL> struct MoeOrder {
    static constexpr int RG = 32 / NCOL;
    const PG8_LAS int* ul; size_t bstride;
    static __device__ __forceinline__ void build(PG8_LAS int* ul, const PG8_LAS int* pt, int c, int tid) {
        const int nrt = pt[32]; const int x = c & 7, j = c >> 3;
        const int lo = (nrt * x) >> 3, hi = (nrt * (x + 1)) >> 3;
        if (tid < 32) { const int rt = lo + RG * tid + j / NCOL;
            if (rt < hi) { int e = 0; for (int k = 1; k < 32; ++k) e += (pt[k] <= rt) ? 1 : 0;
                ul[4 + 4 * tid] = rt; ul[5 + 4 * tid] = j % NCOL; ul[6 + 4 * tid] = e; ul[7 + 4 * tid] = (rt - pt[e]) * BM; } }
        if (tid == 0) { const int span = hi - (lo + j / NCOL); ul[0] = span > 0 ? (span + RG - 1) / RG : 0; }
        __syncthreads();
    }
    __device__ __forceinline__ bool next(int i, Unit& u) const {
        if (i >= ul[0]) return false;
        u.pm = ul[4 + 4 * i]; u.pn = ul[5 + 4 * i]; u.e = ul[6 + 4 * i]; u.lrow0 = ul[7 + 4 * i]; u.boff = (size_t)u.e * bstride; return true;
    }
};

__device__ __forceinline__ unsigned cvt_pk_bf16(float lo, float hi) { unsigned r; asm volatile("v_cvt_pk_bf16_f32 %0, %1, %2" : "=v"(r) : "v"(lo), "v"(hi)); return r; }

struct EpiInproj {
    static constexpr bool PERM = true; static constexpr int NST = 16;
    bf16_t* O; size_t split_stride; float qscale; unsigned* nrm;
    __device__ __forceinline__ void operator()(const f32x4 (&acc)[2][2][4][2], const Unit& u, int wr, int wc, int fr, int fq) const {
        const int row0 = u.pm * BM + wr * 64 + fr; int colt = u.pn * BM; const int t = colt >> 9; bf16_t* base = O + (size_t)t * split_stride; colt -= t * 512;
        const float sc = (t == 1) ? qscale : 1.f; const int col0 = colt + wc * 32 + 8 * fq;
#pragma unroll
        for (int ai = 0; ai < 2; ++ai)
#pragma unroll
            for (int m = 0; m < 4; ++m) { bf16_t* rowp = base + (size_t)(row0 + ai * HALF + m * 16) * 512 + col0;
#pragma unroll
                for (int bj = 0; bj < 2; ++bj) { const f32x4 v0 = acc[ai][bj][m][0] * sc, v1 = acc[ai][bj][m][1] * sc;
                    u32x4 w; w.x = cvt_pk_bf16(v0[0], v0[1]); w.y = cvt_pk_bf16(v0[2], v0[3]); w.z = cvt_pk_bf16(v1[0], v1[1]); w.w = cvt_pk_bf16(v1[2], v1[3]);
                    *(u32x4*)(rowp + bj * HALF) = w; } }
        if (t == 1 || t == 2) {
            float mx[2] = {0.f, 0.f};
#pragma unroll
            for (int ai = 0; ai < 2; ++ai)
#pragma unroll
                for (int m = 0; m < 4; ++m)
#pragma unroll
                    for (int bj = 0; bj < 2; ++bj) { const f32x4 v0 = acc[ai][bj][m][0] * sc, v1 = acc[ai][bj][m][1] * sc;
                        float s8 = v0[0] * v0[0] + v0[1] * v0[1] + v0[2] * v0[2] + v0[3] * v0[3] + v1[0] * v1[0] + v1[1] * v1[1] + v1[2] * v1[2] + v1[3] * v1[3];
                        s8 += __shfl_xor(s8, 16); s8 += __shfl_xor(s8, 32); mx[bj] = fmaxf(mx[bj], s8); }
#pragma unroll
            for (int bj = 0; bj < 2; ++bj) {
#pragma unroll
                for (int o = 1; o < 16; o <<= 1) mx[bj] = fmaxf(mx[bj], __shfl_xor(mx[bj], o));
                if ((threadIdx.x & 63) == 0) { const int head = ((u.pn & 1) * 256 + bj * HALF + wc * 32) >> 6, b = (u.pm * BM) >> 13;
                    atomicMax(nrm + (t - 1) * 32 + b * 8 + head, __float_as_uint(mx[bj] * 1.01f)); } }
        }
    }
};
struct EpiResBf16 {
    static constexpr bool PERM = true; static constexpr int NST = 16;
    const float* x; bf16_t* out;
    __device__ __forceinline__ void operator()(const f32x4 (&acc)[2][2][4][2], const Unit& u, int wr, int wc, int fr, int fq) const {
        const int row0 = u.pm * BM + wr * 64 + fr, col0 = u.pn * BM + wc * 32 + 8 * fq;
        f32x4 xa[2][2][2], xb[2][2][2];
#define PG8_XLOAD(dst, b) do { _Pragma("unroll") for (int mm = 0; mm < 2; ++mm) { const size_t off_ = (size_t)(row0 + ((b) >> 1) * HALF + (((b) & 1) * 2 + mm) * 16) * 1024 + col0; \
            _Pragma("unroll") for (int bj = 0; bj < 2; ++bj) { dst[mm][bj][0] = *(const f32x4*)(x + off_ + bj * HALF); dst[mm][bj][1] = *(const f32x4*)(x + off_ + bj * HALF + 4); } } } while (0)
#define PG8_XSTORE(src, b) do { _Pragma("unroll") for (int mm = 0; mm < 2; ++mm) { const int ai = (b) >> 1, m = ((b) & 1) * 2 + mm; const size_t off_ = (size_t)(row0 + ai * HALF + m * 16) * 1024 + col0; \
            _Pragma("unroll") for (int bj = 0; bj < 2; ++bj) { const f32x4 v0 = src[mm][bj][0] + acc[ai][bj][m][0], v1 = src[mm][bj][1] + acc[ai][bj][m][1]; \
                u32x4 w; w.x = cvt_pk_bf16(v0[0], v0[1]); w.y = cvt_pk_bf16(v0[2], v0[3]); w.z = cvt_pk_bf16(v1[0], v1[1]); w.w = cvt_pk_bf16(v1[2], v1[3]); *(u32x4*)(out + off_ + bj * HALF) = w; } } } while (0)
        PG8_XLOAD(xa, 0); PG8_XLOAD(xb, 1);
        asm volatile("" ::: "memory");
        PG8_XSTORE(xa, 0); PG8_XLOAD(xa, 2);
        asm volatile("" ::: "memory");
        PG8_XSTORE(xb, 1); PG8_XLOAD(xb, 3);
        asm volatile("" ::: "memory");
        PG8_XSTORE(xa, 2);
        PG8_XSTORE(xb, 3);
#undef PG8_XLOAD
#undef PG8_XSTORE
    }
};
__device__ __forceinline__ float swiglu1(float g, float l) {
    const float gl = fminf(g, 7.0f), li = fminf(fmaxf(l, -7.0f), 7.0f);
    const float sg = __builtin_amdgcn_rcpf(1.0f + __builtin_amdgcn_exp2f(gl * (-1.702f * 1.4426950408889634f)));
    return gl * sg * (li + 1.0f);
}
struct EpiSwiglu {
    static constexpr bool PERM = true; static constexpr int NST = 8;
    bf16_t* ACT; const float* bup;
    __device__ __forceinline__ void operator()(const f32x4 (&acc)[2][2][4][2], const Unit& u, int wr, int wc, int fr, int fq) const {
        const int row0 = u.pm * BM + wr * 64 + fr, col0 = u.pn * HALF + wc * 32 + 8 * fq;
        const float* bb = bup + (size_t)u.e * 2048 + col0;
        f32x4 bg[2], bl[2];
#pragma unroll
        for (int n = 0; n < 2; ++n) { bg[n] = *(const f32x4*)(bb + 4 * n); bl[n] = *(const f32x4*)(bb + 1024 + 4 * n); }
#pragma unroll
        for (int ai = 0; ai < 2; ++ai)
#pragma unroll
            for (int m = 0; m < 4; ++m) { bf16_t* rowp = ACT + (size_t)(row0 + ai * HALF + m * 16) * 1024 + col0;
                const f32x4 g0 = acc[ai][0][m][0] + bg[0], g1 = acc[ai][0][m][1] + bg[1], l0 = acc[ai][1][m][0] + bl[0], l1 = acc[ai][1][m][1] + bl[1];
                u32x4 w; w.x = cvt_pk_bf16(swiglu1(g0[0], l0[0]), swiglu1(g0[1], l0[1])); w.y = cvt_pk_bf16(swiglu1(g0[2], l0[2]), swiglu1(g0[3], l0[3]));
                w.z = cvt_pk_bf16(swiglu1(g1[0], l1[0]), swiglu1(g1[1], l1[1])); w.w = cvt_pk_bf16(swiglu1(g1[2], l1[2]), swiglu1(g1[3], l1[3]));
                *(u32x4*)rowp = w; }
    }
};

constexpr float FP8_SA = 4.0f, FP8_SW = 256.0f, FP8_INV = 1.0f / (FP8_SA * FP8_SW), FP8_SY = 16.0f;
__device__ __forceinline__ unsigned pack4_fp8(float a, float b, float c, float d) { unsigned p = 0; p = __builtin_amdgcn_cvt_pk_fp8_f32(a, b, p, false); p = __builtin_amdgcn_cvt_pk_fp8_f32(c, d, p, true); return p; }
struct EpiSwiglu8 {
    static constexpr bool PERM = true; static constexpr int NST = 8;
    unsigned char* ACT; const float* bup;
    __device__ __forceinline__ void operator()(const f32x4 (&acc)[2][2][4][2], const Unit& u, int wr, int wc, int fr, int fq) const {
        const int row0 = u.pm * BM + wr * 64 + fr, col0 = u.pn * HALF + wc * 32 + 8 * fq;
        const float* bb = bup + (size_t)u.e * 2048 + col0;
        f32x4 bg[2], bl[2];
#pragma unroll
        for (int n = 0; n < 2; ++n) { bg[n] = *(const f32x4*)(bb + 4 * n); bl[n] = *(const f32x4*)(bb + 1024 + 4 * n); }
#pragma unroll
        for (int ai = 0; ai < 2; ++ai)
#pragma unroll
            for (int m = 0; m < 4; ++m) { unsigned char* rowp = ACT + (size_t)(row0 + ai * HALF + m * 16) * 1024 + col0;
                const f32x4 g0 = acc[ai][0][m][0] * FP8_INV + bg[0], g1 = acc[ai][0][m][1] * FP8_INV + bg[1], l0 = acc[ai][1][m][0] * FP8_INV + bl[0], l1 = acc[ai][1][m][1] * FP8_INV + bl[1];
                typedef unsigned u32x2_t __attribute__((ext_vector_type(2))); u32x2_t w;
                w.x = pack4_fp8(swiglu1(g0[0], l0[0]) * FP8_SA, swiglu1(g0[1], l0[1]) * FP8_SA, swiglu1(g0[2], l0[2]) * FP8_SA, swiglu1(g0[3], l0[3]) * FP8_SA);
                w.y = pack4_fp8(swiglu1(g1[0], l1[0]) * FP8_SA, swiglu1(g1[1], l1[1]) * FP8_SA, swiglu1(g1[2], l1[2]) * FP8_SA, swiglu1(g1[3], l1[3]) * FP8_SA);
                *(u32x2_t*)rowp = w; }
    }
};
struct EpiDown {
    static constexpr bool PERM = true; static constexpr int NST = 16;
    unsigned char* Y; const float* bdn; const float* lgt; const PG8_LAS int* cnt; int Ttok; float ascale;
    __device__ __forceinline__ void operator()(const f32x4 (&acc)[2][2][4][2], const Unit& u, int wr, int wc, int fr, int fq) const {
        const int rl = wr * 64 + fr, col0 = u.pn * BM + wc * 32 + 8 * fq; const int ce = cnt[u.e];
        const float* bb = bdn + (size_t)u.e * 1024 + col0; const float* gp = lgt + (size_t)u.e * Ttok + u.lrow0;
        f32x4 bv[2][2];
#pragma unroll
        for (int bj = 0; bj < 2; ++bj)
#pragma unroll
            for (int n = 0; n < 2; ++n) bv[bj][n] = *(const f32x4*)(bb + bj * HALF + 4 * n);
#pragma unroll
        for (int ai = 0; ai < 2; ++ai)
#pragma unroll
            for (int m = 0; m < 4; ++m) { const int r = rl + ai * HALF + m * 16; const float gt = (u.lrow0 + r < ce) ? gp[r] * FP8_SY : 0.f;
                unsigned char* rowp = Y + (size_t)(u.pm * BM + r) * 1024 + col0;
#pragma unroll
                for (int bj = 0; bj < 2; ++bj) { const f32x4 v0 = (acc[ai][bj][m][0] * ascale + bv[bj][0]) * gt, v1 = (acc[ai][bj][m][1] * ascale + bv[bj][1]) * gt;
                    typedef unsigned u32x2_t __attribute__((ext_vector_type(2))); u32x2_t w; w.x = pack4_fp8(v0[0], v0[1], v0[2], v0[3]); w.y = pack4_fp8(v1[0], v1[1], v1[2], v1[3]);
                    *(u32x2_t*)(rowp + bj * HALF) = w; } }
    }
};

typedef int v4i_t __attribute__((ext_vector_type(4)));
typedef int v8i_t __attribute__((ext_vector_type(8)));
template <class Epi, class Sched, bool ALIGN_EPI, bool GATHER, bool FP8 = false, int ABL = 0, bool SP2 = true>
__device__ __forceinline__ void gemm_phase(PG8_LAS unsigned char* lds, const Gemm g, const Sched& S, const Epi& E, const PG8_LAS unsigned* tab, volatile PG8_LAS unsigned* prb = nullptr) {
    const int tid = threadIdx.x, wid = __builtin_amdgcn_readfirstlane(tid >> 6), lane = tid & 63, wr = wid >> 2, wc = wid & 3, fr = lane & 15, fq = lane >> 4;
    const int K = g.K, nt = K / BK;
    unsigned voffA[2], voffB[2], cby[2]; int rsl[2];
#pragma unroll
    for (int i = 0; i < 2; ++i) { int R, C; stage_rc(tid * 16 + i * 8192, R, C); const int Rb = Epi::PERM ? ((R & ~31) + perm32(R & 31)) : R;
        voffA[i] = (unsigned)(R * K + C) * 2u; voffB[i] = (unsigned)(Rb * K + C) * 2u; rsl[i] = R; cby[i] = (unsigned)C * 2u; }
    const size_t kstep = (size_t)(BK * 2);
    const size_t hstep = (size_t)HALF * K * 2;
    const size_t tstep = 2 * hstep;
    const size_t ahstep = GATHER ? 0 : hstep;
    const unsigned ldsw = (unsigned)wid * 1024u;
    const int aoff0 = lds_byte(wr * 64 + fr, fq * 8), aoff1 = lds_byte(wr * 64 + fr, 32 + fq * 8), boff0 = lds_byte(wc * 32 + fr, fq * 8), boff1 = lds_byte(wc * 32 + fr, 32 + fq * 8);
#define PG8_SA(b, h) (((b) * 2 + (h)) * HTB)
#define PG8_SB(b, h) ((4 + (b) * 2 + (h)) * HTB)
#define PG8_STAGE(bufoff, gbase, voff) do { if constexpr (ABL != 2 && ABL != 4) _Pragma("unroll") for (int _i = 0; _i < 2; ++_i) \
        __builtin_amdgcn_global_load_lds((const unsigned*)((const char*)(gbase) + (voff)[_i]), (PG8_LAS unsigned*)(lds + (bufoff) + ldsw + _i * 8192), 16, 0, 0); } while (0)
#define PG8_LD16(off) (*(const PG8_LAS v4i_t*)(lds + (off)))
#define PG8_LDA(dst, b, h) do { if constexpr (ABL != 3 && ABL != 4) _Pragma("unroll") for (int m = 0; m < 4; ++m) { if constexpr (FP8) dst##8[m] = __builtin_shufflevector(PG8_LD16(PG8_SA(b, h) + aoff0 + m * 2048), PG8_LD16(PG8_SA(b, h) + aoff1 + m * 2048), 0, 1, 2, 3, 4, 5, 6, 7); \
        else { _Pragma("unroll") for (int k = 0; k < 2; ++k) dst[m][k] = *(const PG8_LAS bf16x8*)(lds + PG8_SA(b, h) + (k ? aoff1 : aoff0) + m * 2048); } } } while (0)
#define PG8_LDB(dst, b, h) do { if constexpr (ABL != 3 && ABL != 4) _Pragma("unroll") for (int n = 0; n < 2; ++n) { if constexpr (FP8) dst##8[n] = __builtin_shufflevector(PG8_LD16(PG8_SB(b, h) + boff0 + n * 2048), PG8_LD16(PG8_SB(b, h) + boff1 + n * 2048), 0, 1, 2, 3, 4, 5, 6, 7); \
        else { _Pragma("unroll") for (int k = 0; k < 2; ++k) dst[n][k] = *(const PG8_LAS bf16x8*)(lds + PG8_SB(b, h) + (k ? boff1 : boff0) + n * 2048); } } } while (0)
#define PG8_MMA(ai, bj, At, Bt) do { if constexpr (ABL == 1) { if constexpr (FP8) { _Pragma("unroll") for (int m = 0; m < 4; ++m) asm volatile("" :: "v"(At##8[m])); _Pragma("unroll") for (int n = 0; n < 2; ++n) asm volatile("" :: "v"(Bt##8[n])); } } else { \
        __builtin_amdgcn_s_setprio(1); _Pragma("unroll") for (int m = 0; m < 4; ++m) _Pragma("unroll") for (int n = 0; n < 2; ++n) { \
        if constexpr (FP8) asm volatile("v_mfma_f32_16x16x128_f8f6f4 %0, %1, %2, %0" : "+v"(acc[ai][bj][m][n]) : "v"(Bt##8[n]), "v"(At##8[m]));   \
        else { _Pragma("unroll") for (int k = 0; k < 2; ++k) acc[ai][bj][m][n] = __builtin_amdgcn_mfma_f32_16x16x32_bf16(Bt[n][k], At[m][k], acc[ai][bj][m][n], 0, 0, 0); } } \
        __builtin_amdgcn_s_setprio(0); } } while (0)
#define PG8_WAIT_V(n) asm volatile("s_waitcnt vmcnt(" #n ")" ::: "memory")
#define PG8_WAIT_L(n) asm volatile("s_waitcnt lgkmcnt(" #n ")" ::: "memory")
#define PG8_WAIT_V8X(relax) asm volatile("s_cmp_eq_u32 %0, 0\n\ts_cbranch_scc1 1f\n\ts_waitcnt vmcnt(%1)\n\ts_branch 2f\n1:\n\ts_waitcnt vmcnt(8)\n2:" :: "s"(relax), "n"(8 + Epi::NST) : "memory", "scc")
#define PG8_BAR __builtin_amdgcn_s_barrier()
#define PG8_SCHED __builtin_amdgcn_sched_barrier(0)
    Unit cur, nxt; int ui = 0;
    if (!S.next(0, cur)) return;
    f32x4 acc[2][2][4][2];
#pragma unroll
    for (int a = 0; a < 2; ++a)
#pragma unroll
        for (int b = 0; b < 2; ++b)
#pragma unroll
            for (int m = 0; m < 4; ++m)
#pragma unroll
                for (int n = 0; n < 2; ++n) acc[a][b][m][n] = (f32x4){0.f, 0.f, 0.f, 0.f};
    bf16x8 At[4][2] = {}, B0[2][2] = {}, B1[2][2] = {}; v8i_t At8[4] = {}, B08[2] = {}, B18[2] = {};
    const char* cA = GATHER ? (const char*)g.A : (const char*)g.A + (size_t)cur.pm * tstep; const char* cB = (const char*)g.Bt + cur.boff + (size_t)cur.pn * tstep;
    unsigned cv0[2], cv1[2], nv0[2], nv1[2];
#pragma unroll
    for (int i = 0; i < 2; ++i) { if constexpr (GATHER) { cv0[i] = tab[rsl[i]] + cby[i]; cv1[i] = tab[HALF + rsl[i]] + cby[i]; } else { cv0[i] = voffA[i]; cv1[i] = voffA[i]; } nv0[i] = cv0[i]; nv1[i] = cv1[i]; }
    if constexpr (SP2) { PG8_STAGE(PG8_SB(0, 0), cB, voffB); PG8_STAGE(PG8_SB(0, 1), cB + hstep, voffB); PG8_STAGE(PG8_SA(0, 0), cA, cv0); PG8_STAGE(PG8_SA(0, 1), cA + ahstep, cv1);
        if (wr == 1) PG8_BAR;
        PG8_WAIT_V(2); PG8_BAR; }
    else { PG8_STAGE(PG8_SB(0, 0), cB, voffB); PG8_STAGE(PG8_SA(0, 0), cA, cv0); PG8_STAGE(PG8_SB(0, 1), cB + hstep, voffB); PG8_STAGE(PG8_SA(0, 1), cA + ahstep, cv1);
        if (wr == 1) PG8_BAR;
        PG8_WAIT_V(4); PG8_BAR; }
    PG8_STAGE(PG8_SB(1, 0), cB + kstep, voffB); PG8_STAGE(PG8_SA(1, 0), cA + kstep, cv0); PG8_STAGE(PG8_SB(1, 1), cB + hstep + kstep, voffB);
    PG8_WAIT_V(6); PG8_BAR;
    for (;;) {
        const bool has_next = S.next(ui + 1, nxt);
        const char* nA = has_next ? (GATHER ? (const char*)g.A : (const char*)g.A + (size_t)nxt.pm * tstep) : cA; const char* nB = has_next ? (const char*)g.Bt + nxt.boff + (size_t)nxt.pn * tstep : cB;
        if constexpr (GATHER) {
#pragma unroll
            for (int i = 0; i < 2; ++i) { if (has_next) { nv0[i] = tab[(ui + 1) * BM + rsl[i]] + cby[i]; nv1[i] = tab[(ui + 1) * BM + HALF + rsl[i]] + cby[i]; } else { nv0[i] = cv0[i]; nv1[i] = cv1[i]; } }
        }
        for (int t = 0; t < nt; t += 2) {
            const bool last = (t == nt - 2);
            const char* a1 = cA + (size_t)(t + 1) * kstep;
            const char* a2 = last ? nA : cA + (size_t)(t + 2) * kstep; const char* b2 = last ? nB : cB + (size_t)(t + 2) * kstep;
            const char* a3 = a2 + kstep; const char* b3 = b2 + kstep;
            unsigned s0[2], s1[2];
#pragma unroll
            for (int i = 0; i < 2; ++i) { s0[i] = last ? nv0[i] : cv0[i]; s1[i] = last ? nv1[i] : cv1[i]; }
            if constexpr (SP2) {
            PG8_LDB(B0, 0, 0); PG8_LDB(B1, 0, 1); PG8_SCHED; PG8_LDA(At, 0, 0); PG8_STAGE(PG8_SA(1, 1), a1 + ahstep, cv1);
            PG8_WAIT_V(8); PG8_WAIT_L(0); PG8_BAR; PG8_MMA(0, 0, At, B0); PG8_MMA(0, 1, At, B1); PG8_BAR; PG8_SCHED;
            PG8_LDA(At, 0, 1); PG8_STAGE(PG8_SB(0, 0), b2, voffB); PG8_STAGE(PG8_SB(0, 1), b2 + hstep, voffB); PG8_STAGE(PG8_SA(0, 0), a2, s0);
            PG8_WAIT_V(8); PG8_WAIT_L(0); PG8_BAR; PG8_MMA(1, 0, At, B0); PG8_MMA(1, 1, At, B1); PG8_BAR; PG8_SCHED;
            PG8_LDB(B0, 1, 0); PG8_LDB(B1, 1, 1); PG8_SCHED; PG8_LDA(At, 1, 0); PG8_STAGE(PG8_SA(0, 1), a2 + ahstep, s1);
            PG8_WAIT_V(8); PG8_WAIT_L(0); PG8_BAR; PG8_MMA(0, 0, At, B0); PG8_MMA(0, 1, At, B1); PG8_BAR; PG8_SCHED;
            PG8_LDA(At, 1, 1); PG8_STAGE(PG8_SB(1, 0), b3, voffB); PG8_STAGE(PG8_SB(1, 1), b3 + hstep, voffB); PG8_STAGE(PG8_SA(1, 0), a3, s0);
            PG8_WAIT_V(8); PG8_WAIT_L(0); PG8_BAR; PG8_MMA(1, 0, At, B0); PG8_MMA(1, 1, At, B1); PG8_BAR; PG8_SCHED;
            } else {
            PG8_LDB(B0, 0, 0); PG8_SCHED; PG8_LDA(At, 0, 0); PG8_STAGE(PG8_SA(1, 1), a1 + ahstep, cv1);
            PG8_WAIT_L(8); PG8_BAR; PG8_WAIT_L(0); PG8_MMA(0, 0, At, B0); PG8_BAR; PG8_SCHED;
            PG8_LDB(B1, 0, 1); PG8_STAGE(PG8_SB(0, 0), b2, voffB);
            PG8_BAR; PG8_WAIT_L(0); PG8_MMA(0, 1, At, B1); PG8_BAR;
            PG8_LDA(At, 0, 1); PG8_STAGE(PG8_SA(0, 0), a2, s0);
            PG8_BAR; PG8_WAIT_L(0); PG8_MMA(1, 0, At, B0); PG8_BAR; PG8_SCHED;
            PG8_STAGE(PG8_SB(0, 1), b2 + hstep, voffB);
            PG8_WAIT_V(6); PG8_BAR; PG8_MMA(1, 1, At, B1); PG8_BAR;
            PG8_LDB(B0, 1, 0); PG8_SCHED; PG8_LDA(At, 1, 0); PG8_STAGE(PG8_SA(0, 1), a2 + ahstep, s1);
            PG8_WAIT_L(8); PG8_BAR; PG8_WAIT_L(0); PG8_MMA(0, 0, At, B0); PG8_BAR; PG8_SCHED;
            PG8_LDB(B1, 1, 1); PG8_STAGE(PG8_SB(1, 0), b3, voffB);
            PG8_BAR; PG8_WAIT_L(0); PG8_MMA(0, 1, At, B1); PG8_BAR;
            PG8_LDA(At, 1, 1); PG8_STAGE(PG8_SA(1, 0), a3, s0);
            PG8_BAR; PG8_WAIT_L(0); PG8_MMA(1, 0, At, B0); PG8_BAR; PG8_SCHED;
            PG8_STAGE(PG8_SB(1, 1), b3 + hstep, voffB);
            PG8_WAIT_V(6); PG8_BAR; PG8_MMA(1, 1, At, B1); PG8_BAR;
            }
        }
        unsigned long long pt0_ = 0; if (prb) pt0_ = __builtin_amdgcn_s_memrealtime();
        if constexpr (FP8) asm volatile("s_nop 15\n\ts_nop 7" ::: "memory");
        if constexpr (ALIGN_EPI) { if (wr == 0) PG8_BAR; }
        E(acc, cur, wr, wc, fr, fq);
        if (prb) { asm volatile("s_waitcnt vmcnt(0)" ::: "memory"); if (threadIdx.x == 0) prb[0] += (unsigned)(__builtin_amdgcn_s_memrealtime() - pt0_); }
        if (!has_next) break;
#pragma unroll
        for (int a = 0; a < 2; ++a)
#pragma unroll
            for (int b = 0; b < 2; ++b)
#pragma unroll
                for (int m = 0; m < 4; ++m)
#pragma unroll
                    for (int n = 0; n < 2; ++n) acc[a][b][m][n] = (f32x4){0.f, 0.f, 0.f, 0.f};
        cur = nxt; cA = nA; cB = nB; ++ui;
#pragma unroll
        for (int i = 0; i < 2; ++i) { cv0[i] = nv0[i]; cv1[i] = nv1[i]; }
        if constexpr (ALIGN_EPI) { if (wr == 1) PG8_BAR; }
    }
    PG8_WAIT_V(0);
    if constexpr (!ALIGN_EPI) { if (wr == 0) PG8_BAR; }
    PG8_BAR;
#undef PG8_SA
#undef PG8_SB
#undef PG8_STAGE
#undef PG8_LDA
#undef PG8_LD16
#undef PG8_LDB
#undef PG8_MMA
#undef PG8_WAIT_V
#undef PG8_WAIT_L
#undef PG8_WAIT_V8X
#undef PG8_BAR
#undef PG8_SCHED
}
}
#include <hip/hip_bf16.h>
#include <cmath>
namespace attn_body {
using bf16=__hip_bfloat16;
using bf16x8=__attribute__((ext_vector_type(8)))short;
using s16x4=__attribute__((ext_vector_type(4)))short;
using f32x16=__attribute__((ext_vector_type(16)))float;
using u32x4=__attribute__((ext_vector_type(4)))unsigned;
constexpr int BATCH=4,NHEAD=8,SEQ=8192,D=64,DM=NHEAD*D,ODM=1024;
constexpr int NW=8,QBLK=32,QB=QBLK*NW,KVBLK=64,NQB=SEQ/QB;
constexpr int ATTN_PITCH=DM, ATTN_UNIT_ROWS=QB;
__device__ __forceinline__ int crow(int r,int hi){return (r&3)+8*(r>>2)+4*hi;}
#define SBAR() __builtin_amdgcn_sched_barrier(0)
__device__ __forceinline__ void cmask(f32x16&p0,f32x16&p1,int jb,int qrel,int hi){
  const float NEG=-INFINITY; int kb=64*jb+4*hi;
  #pragma unroll
  for(int r=0;r<16;++r){int kv=kb+(r&3)+8*(r>>2); if(kv>qrel)p0[r]=NEG; if(kv+32>qrel)p1[r]=NEG;}
}

constexpr int NSLOT=3, SLOTB=8192;
constexpr int LDS_K=0, LDS_V=NSLOT*SLOTB, LDS_WS=2*NSLOT*SLOTB, LDS_OST=LDS_WS+NW*64*4, LDS_C2=LDS_OST+NW*4096, LDS_BYTES=LDS_C2+SEQ*4;
constexpr float C2=0.125f*1.4426950408889634f;
__device__ __forceinline__ void glds16(const void*gsrc,unsigned lds_dst){unsigned keep;
  asm volatile("s_mov_b32 %0, m0\n\ts_mov_b32 m0, %2\n\ts_nop 0\n\tglobal_load_lds_dwordx4 %1, off\n\ts_mov_b32 m0, %0":"=&s"(keep):"v"(gsrc),"s"(lds_dst):"memory");}
__device__ __forceinline__ float max3f(float a,float b,float c){float r;asm("v_max3_f32 %0, %1, %2, %3":"=v"(r):"v"(a),"v"(b),"v"(c));return r;}
__device__ __forceinline__ float max2f(float a,float b){float r;asm("v_max_f32_e32 %0, %1, %2":"=v"(r):"v"(a),"v"(b));return r;}
__device__ __forceinline__ float fadd_s(float a,float b){float r;asm("v_add_f32_e32 %0, %1, %2":"=v"(r):"v"(a),"v"(b));return r;}
__device__ __forceinline__ float fsub_s(float a,float b){float r;asm("v_sub_f32_e32 %0, %1, %2":"=v"(r):"v"(a),"v"(b));return r;}
typedef float f32x2_t __attribute__((ext_vector_type(2))); typedef float f32x4_t __attribute__((ext_vector_type(4))); typedef __bf16 bf16x2_t __attribute__((ext_vector_type(2)));
__device__ __forceinline__ unsigned cvtpk_s(float lo,float hi){f32x2_t v={lo,hi};bf16x2_t b=__builtin_convertvector(v,bf16x2_t);return __builtin_bit_cast(unsigned,b);}
#define WAIT_BAR(N) asm volatile("s_waitcnt vmcnt(" #N ") lgkmcnt(0)\n\ts_barrier":::"memory")

__device__ __forceinline__ void qkt(f32x16&p0,f32x16&p1,const char*Kslot,const bf16x8*qr,const f32x16&cin0,const f32x16&cin1,int r32,int hi){
  const char*kb=Kslot+hi*1024+r32*16;
  #pragma unroll
  for(int d0=0;d0<4;++d0){
    const bf16x8 b0=*reinterpret_cast<const bf16x8*>(kb+d0*2048);
    const bf16x8 b1=*reinterpret_cast<const bf16x8*>(kb+d0*2048+512);
    if(d0==0){p0=__builtin_amdgcn_mfma_f32_32x32x16_bf16(b0,qr[0],cin0,0,0,0);p1=__builtin_amdgcn_mfma_f32_32x32x16_bf16(b1,qr[0],cin1,0,0,0);}
    else{p0=__builtin_amdgcn_mfma_f32_32x32x16_bf16(b0,qr[d0],p0,0,0,0);p1=__builtin_amdgcn_mfma_f32_32x32x16_bf16(b1,qr[d0],p1,0,0,0);}}
}
typedef __attribute__((address_space(3))) const char* lds_cptr;
typedef short v4i16_t __attribute__((ext_vector_type(4)));
__device__ __forceinline__ void kload8(bf16x8*kf,lds_cptr kp){
  kf[0]=*(const __attribute__((address_space(3))) bf16x8*)(kp);      kf[1]=*(const __attribute__((address_space(3))) bf16x8*)(kp+512);
  kf[2]=*(const __attribute__((address_space(3))) bf16x8*)(kp+2048); kf[3]=*(const __attribute__((address_space(3))) bf16x8*)(kp+2560);
  kf[4]=*(const __attribute__((address_space(3))) bf16x8*)(kp+4096); kf[5]=*(const __attribute__((address_space(3))) bf16x8*)(kp+4608);
  kf[6]=*(const __attribute__((address_space(3))) bf16x8*)(kp+6144); kf[7]=*(const __attribute__((address_space(3))) bf16x8*)(kp+6656);
}
__device__ __forceinline__ void kload2(bf16x8*kf,lds_cptr kp,int j){ kf[2*j]=*(const __attribute__((address_space(3))) bf16x8*)(kp+j*2048); kf[2*j+1]=*(const __attribute__((address_space(3))) bf16x8*)(kp+j*2048+512); }
__device__ __forceinline__ s16x4 vtr(lds_cptr p){ return __builtin_bit_cast(s16x4,__builtin_amdgcn_ds_read_tr16_b64_v4i16((__attribute__((address_space(3))) v4i16_t*)p)); }
__device__ __forceinline__ float rowmax(const f32x16&p0,const f32x16&p1){
  float a=max3f(p0[0],p0[1],p1[0]),b=max3f(p0[2],p0[3],p1[1]);a=max3f(a,p1[2],p1[3]);
  #pragma unroll
  for(int r=4;r<16;r+=4){a=max3f(a,p0[r],p0[r+1]);b=max3f(b,p0[r+2],p0[r+3]);a=max3f(a,p1[r],p1[r+1]);b=max3f(b,p1[r+2],p1[r+3]);}
  const float m=max2f(a,b);
  auto rr=__builtin_amdgcn_permlane32_swap(__float_as_uint(m),__float_as_uint(m),false,false);
  return max2f(__uint_as_float(rr[0]),__uint_as_float(rr[1]));
}
__device__ __forceinline__ void pv(f32x16*o,int vb,bf16x8 pa0,bf16x8 pa1,bf16x8 pa2,bf16x8 pa3){
  #pragma unroll
  for(int d0=0;d0<2;++d0){s16x4 lo[4],hi[4];
    #pragma unroll
    for(int ks=0;ks<4;++ks){
      asm volatile("ds_read_b64_tr_b16 %0,%1 offset:%c2":"=&v"(lo[ks]):"v"(vb),"i"(d0*4096+ks*1024):"memory");
      asm volatile("ds_read_b64_tr_b16 %0,%1 offset:%c2":"=&v"(hi[ks]):"v"(vb),"i"(d0*4096+ks*1024+512):"memory");}
    asm volatile("s_waitcnt lgkmcnt(0)":::"memory");SBAR();
    #define PK(k) (bf16x8){lo[k][0],lo[k][1],lo[k][2],lo[k][3],hi[k][0],hi[k][1],hi[k][2],hi[k][3]}
    o[d0]=__builtin_amdgcn_mfma_f32_32x32x16_bf16(pa0,PK(0),o[d0],0,0,0);
    o[d0]=__builtin_amdgcn_mfma_f32_32x32x16_bf16(pa1,PK(1),o[d0],0,0,0);
    o[d0]=__builtin_amdgcn_mfma_f32_32x32x16_bf16(pa2,PK(2),o[d0],0,0,0);
    o[d0]=__builtin_amdgcn_mfma_f32_32x32x16_bf16(pa3,PK(3),o[d0],0,0,0);
    #undef PK
  }
}

#ifndef ATTN_STORE16
#define ATTN_STORE16(p,v) (*(u32x4*)(p)=(v))
#endif
template<int THRL> __device__ __forceinline__ void attn_unit(int b,int h,int qb,const bf16*Q,const bf16*__restrict__ K,const bf16*__restrict__ V,bf16*O,char*shm,int j0,unsigned*attn_probe_ctr=nullptr){
  const int tid=threadIdx.x,lane=tid&63,r32=lane&31,hi=lane>>5; const int wid=__builtin_amdgcn_readfirstlane(tid>>6);
  const long rowbase=(long)b*SEQ; const int q0=qb*QB;
  const bf16*Qw=Q+(rowbase+q0+wid*QBLK)*DM+h*D;
  const bf16*Kh=K+rowbase*DM+h*D,*Vh=V+rowbase*DM+h*D;
  const unsigned lds0=(unsigned)(uintptr_t)shm; const lds_cptr shm3=(lds_cptr)shm;
  float*wsf=(float*)(shm+LDS_WS)+wid*64;
  const bf16*ksrc=Kh+(long)lane*DM+wid*8;
  const bf16*vsrc=Vh+(long)(16*(wid&3)+(lane>>2))*DM+(wid>>2)*32+(lane&3)*8;
  const unsigned kdst=lds0+LDS_K+wid*1024, vdst=lds0+LDS_V+wid*1024;
  #define DMA_K(t,slot) glds16(ksrc+(long)(t)*KVBLK*DM,(unsigned)__builtin_amdgcn_readfirstlane(kdst+(slot)))
  #define DMA_V(t,slot) glds16(vsrc+(long)(t)*KVBLK*DM,(unsigned)__builtin_amdgcn_readfirstlane(vdst+(slot)))
  const int vb0=(int)(lds0+LDS_V)+((lane>>4)&1)*32+(lane&3)*8+(4*hi+((lane&15)>>2))*64;
  const char*Kbase=shm+LDS_K; bf16x8 kf[8];
  const lds_cptr kp0=shm3+LDS_K+hi*1024+r32*16; const lds_cptr vp0=shm3+LDS_V+((lane>>4)&1)*32+(lane&3)*8+(4*hi+((lane&15)>>2))*64;
  const int NT=(q0+QB)/KVBLK;
  if(attn_probe_ctr && threadIdx.x==0) atomicAdd(attn_probe_ctr, (unsigned)(NT-j0));
  DMA_K(j0,0);DMA_V(j0,0);DMA_K(j0+1,SLOTB);
  bf16x8 qr[4];
  #pragma unroll
  for(int d0=0;d0<4;++d0)qr[d0]=*reinterpret_cast<const bf16x8*>(&Qw[(long)r32*DM+d0*16+hi*8]);
  float l_reg=0.f;f32x16 o[2];o[0]=f32x16{};o[1]=f32x16{};
  typedef __attribute__((address_space(3))) const f32x4_t* lds_f4ptr; const lds_f4ptr c2p=(lds_f4ptr)(shm3+LDS_C2)+hi;
  float ctm=((const __attribute__((address_space(3))) float*)(shm3+LDS_C2))[q0+wid*QBLK+r32];
  f32x16 cin0,cin1;
  #define CIN(t) do{ const lds_f4ptr cq_=c2p+16*(t); const f32x4_t a0_=cq_[0],a1_=cq_[2],a2_=cq_[4],a3_=cq_[6],b0_=cq_[8],b1_=cq_[10],b2_=cq_[12],b3_=cq_[14]; \
    _Pragma("unroll") for(int j_=0;j_<4;++j_){ cin0[j_]=ctm-a0_[j_];cin0[4+j_]=ctm-a1_[j_];cin0[8+j_]=ctm-a2_[j_];cin0[12+j_]=ctm-a3_[j_]; cin1[j_]=ctm-b0_[j_];cin1[4+j_]=ctm-b1_[j_];cin1[8+j_]=ctm-b2_[j_];cin1[12+j_]=ctm-b3_[j_]; } }while(0)
  const int qrel=wid*QBLK+r32;
  #define CMASK(P0,P1,t) do{int jb_=(t)-(NT-4); if(jb_>=0)cmask(P0,P1,jb_,qrel,hi);}while(0)
  bool resc=false;
  #define START(P0,P1) do{ const float rm=rowmax(P0,P1); resc=false; \
    if(__any(rm>(float)THRL)){ const float dl=__builtin_fmaxf(rm,0.f); ctm-=dl; \
      _Pragma("unroll") for(int r=0;r<16;++r){P0[r]-=dl;P1[r]-=dl;} } \
    _Pragma("unroll") for(int r=0;r<16;++r)P0[r]=__builtin_amdgcn_exp2f(P0[r]); }while(0)
  #define RESC() do{ if(resc){ asm volatile("s_waitcnt lgkmcnt(0)":::"memory"); \
      _Pragma("unroll") for(int d_=0;d_<2;++d_) _Pragma("unroll") for(int r=0;r<16;++r)o[d_][r]*=wsf[crow(r,hi)]; } }while(0)
  f32x16 pA0,pA1,pB0,pB1;
  int sl_prev=0,sl_cur=0,sl_next=SLOTB;
  #define ROT() do{sl_prev=sl_cur;sl_cur=sl_next;sl_next=(sl_next==(NSLOT-1)*SLOTB)?0:sl_next+SLOTB;}while(0)
  DMA_K(j0+2,2*SLOTB);
  WAIT_BAR(3);
  CIN(j0); qkt(pA0,pA1,Kbase,qr,cin0,cin1,r32,hi);asm volatile("s_nop 15\n\ts_nop 7":"+v"(pA0),"+v"(pA1));CMASK(pA0,pA1,j0);
  START(pA0,pA1);
  _Pragma("unroll") for(int r=0;r<16;++r)pA1[r]=__builtin_amdgcn_exp2f(pA1[r]);
  WAIT_BAR(0);
  DMA_K(j0+3,0);DMA_V(j0+1,SLOTB);
  ROT();
  kload8(kf,kp0+sl_cur);
  WAIT_BAR(2);
  s16x4 vlo[8],vhi[8]; u32x4 pw0,pw1,pw2,pw3;
  #define PKW(P,B) cvtpk_s(P[B],P[B+1])
  #define PAF(k) __builtin_bit_cast(bf16x8,pw##k)
  #define VFR(i) (bf16x8){vlo[i][0],vlo[i][1],vlo[i][2],vlo[i][3],vhi[i][0],vhi[i][1],vhi[i][2],vhi[i][3]}
  #define PIN(x) asm volatile("":"+v"(x))
  #define MX3(a,b,c) __builtin_fmaxf(__builtin_fmaxf((a),(b)),(c))
  #define GAPA(MF,A0,A1,A2,A3,W0,W1,PW) do{ MF; sacc+=A0; sacc+=A1; sacc+=A2; sacc+=A3; PIN(sacc); W0; W1; PIN(PW); SBAR(); }while(0)
  #define EX(v) __builtin_amdgcn_exp2f(v)
  #define GAPB(MF,X,B) do{ MF; X[B]=EX(X[B]); X[B+1]=EX(X[B+1]); X[B+2]=EX(X[B+2]); X[B+3]=EX(X[B+3]); PIN(X); SBAR(); }while(0)
  #define VRD(i) do{ vlo[i]=vtr(vp_+(((i)>>2)*4096+((i)&3)*1024)); vhi[i]=vtr(vp_+(((i)>>2)*4096+((i)&3)*1024+512)); }while(0)
  #define KRD(G,j) do{ if(G){ kload2(kf,kp0+sl_next,j); SBAR(); } }while(0)
  #define STEP(C0,C1,P0,P1,t,GK,GV,GL) do{ SBAR(); CIN(t); SBAR(); \
    const lds_cptr vp_=vp0+sl_prev; \
    VRD(0); SBAR(); float sacc=(P0[0]+P0[1]); \
    GAPA(C0=__builtin_amdgcn_mfma_f32_32x32x16_bf16(kf[0],qr[0],cin0,0,0,0), P0[2],P0[3],P0[4],P0[5],     pw0[0]=PKW(P0,0), pw0[1]=PKW(P0,2), pw0); \
    VRD(4); SBAR(); GAPA(C1=__builtin_amdgcn_mfma_f32_32x32x16_bf16(kf[1],qr[0],cin1,0,0,0), P0[6],P0[7],P0[8],P0[9],     pw0[2]=PKW(P0,4), pw0[3]=PKW(P0,6), pw0); \
    VRD(1); SBAR(); GAPA(C0=__builtin_amdgcn_mfma_f32_32x32x16_bf16(kf[2],qr[1],C0,0,0,0),   P0[10],P0[11],P0[12],P0[13], pw1[0]=PKW(P0,8), pw1[1]=PKW(P0,10), pw1); \
    VRD(5); SBAR(); GAPA(C1=__builtin_amdgcn_mfma_f32_32x32x16_bf16(kf[3],qr[1],C1,0,0,0),   P0[14],P0[15],P1[0],P1[1],   pw1[2]=PKW(P0,12),pw1[3]=PKW(P0,14), pw1); \
    VRD(2); SBAR(); GAPA(C0=__builtin_amdgcn_mfma_f32_32x32x16_bf16(kf[4],qr[2],C0,0,0,0),   P1[2],P1[3],P1[4],P1[5],     pw2[0]=PKW(P1,0), pw2[1]=PKW(P1,2), pw2); \
    VRD(6); SBAR(); GAPA(C1=__builtin_amdgcn_mfma_f32_32x32x16_bf16(kf[5],qr[2],C1,0,0,0),   P1[6],P1[7],P1[8],P1[9],     pw2[2]=PKW(P1,4), pw2[3]=PKW(P1,6), pw2); \
    VRD(3); SBAR(); GAPA(C0=__builtin_amdgcn_mfma_f32_32x32x16_bf16(kf[6],qr[3],C0,0,0,0),   P1[10],P1[11],P1[12],P1[13], pw3[0]=PKW(P1,8), pw3[1]=PKW(P1,10), pw3); \
    VRD(7); SBAR(); GAPA(C1=__builtin_amdgcn_mfma_f32_32x32x16_bf16(kf[7],qr[3],C1,0,0,0),   P1[14],P1[15],0.f,0.f,       pw3[2]=PKW(P1,12),pw3[3]=PKW(P1,14), pw3); \
    l_reg+=sacc; \
    if(GK){DMA_K((t)+3,sl_cur);} if(GV){DMA_V((t)+1,sl_next);} \
    CMASK(C0,C1,t); \
    { float a=MX3(C0[0],C0[1],C1[0]),b=MX3(C0[2],C0[3],C1[1]); a=MX3(a,C1[2],C1[3]); \
      _Pragma("unroll") for(int r=4;r<16;r+=4){a=MX3(a,C0[r],C0[r+1]);b=MX3(b,C0[r+2],C0[r+3]);a=MX3(a,C1[r],C1[r+1]);b=MX3(b,C1[r+2],C1[r+3]);} \
      float rm=__builtin_fmaxf(a,b); { auto rr=__builtin_amdgcn_permlane32_swap(__float_as_uint(rm),__float_as_uint(rm),false,false); rm=__builtin_fmaxf(__uint_as_float(rr[0]),__uint_as_float(rr[1])); } \
      resc=false; \
      if(__builtin_expect(__any(rm>(float)THRL),0)){ const float dl=__builtin_fmaxf(rm,0.f); ctm-=dl; \
        _Pragma("unroll") for(int r=0;r<16;++r){C0[r]-=dl;C1[r]-=dl;} \
        const float f=__builtin_amdgcn_exp2f(-dl); l_reg*=f; if(hi==0)wsf[r32]=f; resc=true; } } \
    SBAR(); \
    GAPB(o[0]=__builtin_amdgcn_mfma_f32_32x32x16_bf16(PAF(0),VFR(0),o[0],0,0,0), C0,0); \
    GAPB(o[1]=__builtin_amdgcn_mfma_f32_32x32x16_bf16(PAF(0),VFR(4),o[1],0,0,0), C0,4); \
    KRD(GL,0); GAPB(o[0]=__builtin_amdgcn_mfma_f32_32x32x16_bf16(PAF(1),VFR(1),o[0],0,0,0), C0,8); \
    KRD(GL,1); GAPB(o[1]=__builtin_amdgcn_mfma_f32_32x32x16_bf16(PAF(1),VFR(5),o[1],0,0,0), C0,12); \
    KRD(GL,2); GAPB(o[0]=__builtin_amdgcn_mfma_f32_32x32x16_bf16(PAF(2),VFR(2),o[0],0,0,0), C1,0); \
    KRD(GL,3); GAPB(o[1]=__builtin_amdgcn_mfma_f32_32x32x16_bf16(PAF(2),VFR(6),o[1],0,0,0), C1,4); \
    GAPB(o[0]=__builtin_amdgcn_mfma_f32_32x32x16_bf16(PAF(3),VFR(3),o[0],0,0,0), C1,8); \
    GAPB(o[1]=__builtin_amdgcn_mfma_f32_32x32x16_bf16(PAF(3),VFR(7),o[1],0,0,0), C1,12); \
    }while(0)
  int t=j0+1;
  #undef CMASK
  #define CMASK(P0,P1,t) do{}while(0)
  for(;t+5<NT;t+=2){
    STEP(pB0,pB1,pA0,pA1,t,true,true,true);     WAIT_BAR(2); RESC(); ROT();
    STEP(pA0,pA1,pB0,pB1,t+1,true,true,true);   WAIT_BAR(2); RESC(); ROT();
  }
  #undef CMASK
  #define CMASK(P0,P1,t) do{int jb_=(t)-(NT-4); if(jb_>=0)cmask(P0,P1,jb_,qrel,hi);}while(0)
  #define ENDW(tt) do{ if((tt)+3<NT){WAIT_BAR(2);} else if((tt)+2<NT){WAIT_BAR(1);} else {WAIT_BAR(0);} }while(0)
  for(;t+1<NT;t+=2){
    STEP(pB0,pB1,pA0,pA1,t,(t+3<NT),(t+1<NT),(t+1<NT));       ENDW(t);   RESC(); ROT();
    STEP(pA0,pA1,pB0,pB1,t+1,(t+4<NT),(t+2<NT),(t+2<NT));     ENDW(t+1); RESC(); ROT();
  }
  STEP(pB0,pB1,pA0,pA1,NT-1,false,false,false); RESC();
  { float sacc=pB0[0]+pB0[1]; _Pragma("unroll") for(int r=2;r<16;++r)sacc+=pB0[r]; _Pragma("unroll") for(int r=0;r<16;++r)sacc+=pB1[r]; l_reg+=sacc;
    pw0=(u32x4){PKW(pB0,0),PKW(pB0,2),PKW(pB0,4),PKW(pB0,6)};pw1=(u32x4){PKW(pB0,8),PKW(pB0,10),PKW(pB0,12),PKW(pB0,14)};pw2=(u32x4){PKW(pB1,0),PKW(pB1,2),PKW(pB1,4),PKW(pB1,6)};pw3=(u32x4){PKW(pB1,8),PKW(pB1,10),PKW(pB1,12),PKW(pB1,14)};
    SBAR(); pv(o,vb0+sl_cur,PAF(0),PAF(1),PAF(2),PAF(3)); }
  #undef PKW
  #undef PAF
  #undef VFR
  #undef PIN
  #undef MX3
  #undef GAPA
  #undef GAPB
  #undef EX
  #undef VRD
  #undef KRD
  #undef STEP
  #undef ENDW
  {auto rr=__builtin_amdgcn_permlane32_swap(__float_as_uint(l_reg),__float_as_uint(l_reg),false,false);l_reg=__uint_as_float(rr[0])+__uint_as_float(rr[1]);}
  if(hi==0)wsf[32+r32]=l_reg;asm volatile("s_waitcnt lgkmcnt(0)":::"memory");
  float rli[16];
  #pragma unroll
  for(int r=0;r<16;++r)rli[r]=__builtin_amdgcn_rcpf(wsf[32+crow(r,hi)]);
  bf16*Ow=O+(rowbase+q0+wid*QBLK)*ODM+h*D;
  { bf16*stg=(bf16*)(shm+LDS_OST)+wid*2048;
    #pragma unroll
    for(int r=0;r<16;++r){const int orow=crow(r,hi);
      #pragma unroll
      for(int d0=0;d0<2;++d0)stg[orow*64+d0*32+r32]=__float2bfloat16(o[d0][r]*rli[r]);}
    asm volatile("s_waitcnt lgkmcnt(0)":::"memory");
    #pragma unroll
    for(int i=0;i<4;++i){const int row=i*8+(lane>>3),ch=lane&7; const u32x4 v=*(const u32x4*)(stg+row*64+ch*8); ATTN_STORE16(Ow+(long)row*ODM+ch*8,v);} }
  asm volatile("s_waitcnt lgkmcnt(0)\n\ts_barrier":::"memory");
  #undef CIN
  #undef DMA_K
  #undef DMA_V
  #undef CMASK
  #undef START
  #undef RESC
  #undef ROT
}
constexpr int ATTN_LDS_BYTES=LDS_BYTES;
struct AttnTensors { const bf16* Q; const bf16* K; const bf16* V; bf16* O; };
struct AttnUnit { int bh; int qb; };
struct StaticOrder {
  int vcu;
  __device__ __forceinline__ explicit StaticOrder(int grid,int block):vcu((block%8)*(grid/8)+block/8){}
  __device__ __forceinline__ bool next(int i,AttnUnit&u)const{ if(i>=4)return false; const int s=vcu&7; u.bh=vcu>>3; u.qb=(i==0)?s:(i==1)?15-s:(i==2)?16+s:31-s; return true; }
  __device__ __forceinline__ void a_ready(const AttnUnit&)const{}
  __device__ __forceinline__ void done(const AttnUnit&)const{}
};
template<class Sched,int THRL=8> __device__ __forceinline__ void attn_phase(char*lds,const AttnTensors&T,const Sched&S,float qkb2){
  AttnUnit u;
  for(int i=0;S.next(i,u);++i){ S.a_ready(u); attn_unit<THRL>(u.bh/NHEAD,u.bh%NHEAD,u.qb,T.Q,T.K,T.V,T.O,lds,qkb2); S.done(u); }
}
#undef SBAR
#undef WAIT_BAR
}
#define GAS __attribute__((address_space(1)))
#define LAS __attribute__((address_space(3)))
typedef GAS unsigned gu32;
#define RLX_AGENT __ATOMIC_RELAXED, __HIP_MEMORY_SCOPE_AGENT
#define LDS_WAIT() asm volatile("s_waitcnt lgkmcnt(0)" ::: "memory")
#define VM_WAIT() asm volatile("s_waitcnt vmcnt(0)" ::: "memory")

constexpr int NWAVES = 8;
constexpr int N_PHASES = 8;
constexpr int RING_OFF = 0, RING_BYTES = 131072;
constexpr int TAB_OFF = 131072, TAB_UNITS = 17;
constexpr int LDS_TOTAL = 155648;
constexpr int LDSCTL_OFF = LDS_TOTAL - 1024;
static_assert(TAB_OFF + TAB_UNITS * 256 * 4 <= LDSCTL_OFF, "LDS map");
constexpr int CW_Q = 128, CW_NRM = 256;
constexpr size_t WS_X1B = WS_P;
constexpr size_t WS_TOT = WS_SEL + 768 * 1024;
constexpr int CW_BAR = 4096;

#define XB_TMO      128
#define XB_XCNT(j)  (256  + 64 * (j))
#define XB_XSUB(j)  (1280 + 64 * (j))
#define XB_XGEN(j)  (2304 + 64 * (j))
#define XB_TOP      3328
#define XB_TOPGEN   3392
#define XCD_BAR_WORDS 3456
#define XB_SPIN_CAP (1u << 18)

__device__ __forceinline__ unsigned xb_ld(unsigned* p)              { return __hip_atomic_load(p, __ATOMIC_RELAXED, __HIP_MEMORY_SCOPE_AGENT); }
__device__ __forceinline__ unsigned xb_add(unsigned* p, unsigned v) { return __hip_atomic_fetch_add(p, v, __ATOMIC_RELAXED, __HIP_MEMORY_SCOPE_AGENT); }
__device__ __forceinline__ unsigned xb_xcc_id() { return (unsigned)__builtin_amdgcn_s_getreg((3 << 11) | 20) & 0xFu; }
#define XB_SPIN(cond, bar) do { unsigned _sp = 0; while (cond) { __builtin_amdgcn_s_sleep(1); \
    if ((++_sp & 255u) == 0u) { if (xb_ld(&(bar)[XB_TMO])) break; if (_sp > XB_SPIN_CAP) { atomicAdd(&(bar)[XB_TMO], 1u); break; } } } } while (0)

struct XcdBarrier {
    unsigned* bar; unsigned x;
    volatile LAS unsigned* st;
};

__device__ __forceinline__ XcdBarrier xcd_barrier_post(unsigned* bar, volatile LAS unsigned* st) {
    XcdBarrier b; b.bar = bar; b.x = xb_xcc_id(); b.st = st;
    if (threadIdx.x == 0) (void)xb_add(&bar[XB_XCNT(b.x)], 1u);
    return b;
}
__device__ __forceinline__ void xcd_barrier_complete(unsigned* bar, unsigned x, unsigned& nloc, unsigned& nx) {
    const unsigned G = gridDim.x * gridDim.y * gridDim.z;
    unsigned sum, cnt, mine, sp = 0u;
    for (;;) {
        sum = 0u; cnt = 0u; mine = 0u;
#pragma unroll
        for (unsigned j = 0; j < 16; ++j) { const unsigned c = xb_ld(&bar[XB_XCNT(j)]); sum += c; cnt += (c > 0u) ? 1u : 0u; mine = (j == x) ? c : mine; }
        if (sum == G) break;
        __builtin_amdgcn_s_sleep(1);
        if ((++sp & 255u) == 0u) { if (xb_ld(&bar[XB_TMO])) break; if (sp > XB_SPIN_CAP) { atomicAdd(&bar[XB_TMO], 1u); break; } }
    }
    nloc = mine > 0u ? mine : 1u; nx = cnt > 0u ? cnt : 1u;
}

__device__ __forceinline__ void xcd_barrier(const XcdBarrier& b) {
    asm volatile("s_waitcnt vmcnt(0)" ::: "memory");
    __syncthreads();
    if (threadIdx.x == 0) {
        unsigned* bar = b.bar;
        __builtin_amdgcn_s_waitcnt(0);
        unsigned nloc = b.st[0], nx = b.st[1];
        if (nloc == 0u) { xcd_barrier_complete(bar, b.x, nloc, nx); b.st[0] = nloc; b.st[1] = nx; }
        const unsigned old = xb_add(&bar[XB_XSUB(b.x)], 1u);
        const unsigned gen = old / nloc;
        if (old + 1u == (gen + 1u) * nloc) {
            __builtin_amdgcn_fence(__ATOMIC_RELEASE, "agent");
            asm volatile("s_waitcnt vmcnt(0)" ::: "memory");
            const unsigned og = xb_add(&bar[XB_TOP], 1u);
            const unsigned tg = og / nx;
            if (og + 1u == (tg + 1u) * nx) xb_add(&bar[XB_TOPGEN], 1u);
            else XB_SPIN(xb_ld(&bar[XB_TOPGEN]) == tg, bar);
            __builtin_amdgcn_fence(__ATOMIC_ACQUIRE, "agent");
            xb_add(&bar[XB_XGEN(b.x)], 1u);
            asm volatile("s_waitcnt vmcnt(0)" ::: "memory");
        } else {
            XB_SPIN(xb_ld(&bar[XB_XGEN(b.x)]) == gen, bar);
            __builtin_amdgcn_fence(__ATOMIC_ACQUIRE, "agent");
            asm volatile("s_waitcnt vmcnt(0)" ::: "memory");
        }
    }
    __syncthreads();
}


#ifndef MK_SP2
#define MK_SP2 true
#endif
struct Args { const float* in[15]; float* out; unsigned char* ws; int ph_lo, ph_hi, use_bar, pad; };

__device__ __forceinline__ void p0_transpose_item(const float* W, int ldw, bf16* WT, int ldt, LAS float* scr, int lane) {
    float tv[32];
    const float* wp_ = W + (size_t)(lane >> 5) * ldw + (lane & 31);
#pragma unroll
    for (int i = 0; i < 32; ++i) tv[i] = wp_[(size_t)(2 * i) * ldw];
#pragma unroll
    for (int i = 0; i < 32; ++i) scr[(2 * i + (lane >> 5)) * 33 + (lane & 31)] = tv[i];
    LDS_WAIT(); asm volatile("" ::: "memory");
    const int c = lane & 7;
#pragma unroll
    for (int j = 0; j < 4; ++j) { const int n = (lane >> 3) + 8 * j; const LAS float* s = scr + (8 * c) * 33 + n;
        u32x4 o; o.x = pg8::cvt_pk_bf16(s[0 * 33], s[1 * 33]); o.y = pg8::cvt_pk_bf16(s[2 * 33], s[3 * 33]); o.z = pg8::cvt_pk_bf16(s[4 * 33], s[5 * 33]); o.w = pg8::cvt_pk_bf16(s[6 * 33], s[7 * 33]);
        *(GAS u32x4*)(WT + (size_t)n * ldt + 8 * c) = o; }
    LDS_WAIT(); asm volatile("" ::: "memory");
}
__device__ __forceinline__ void p0_transpose_item_fp8(const float* W, int ldw, unsigned char* WT, int ldt, LAS float* scr, int lane) {
    float tv[32];
    const float* wp_ = W + (size_t)(lane >> 5) * ldw + (lane & 31);
#pragma unroll
    for (int i = 0; i < 32; ++i) tv[i] = wp_[(size_t)(2 * i) * ldw];
#pragma unroll
    for (int i = 0; i < 32; ++i) scr[(2 * i + (lane >> 5)) * 33 + (lane & 31)] = tv[i];
    LDS_WAIT(); asm volatile("" ::: "memory");
    const int c = lane & 7;
#pragma unroll
    for (int j = 0; j < 4; ++j) { const int n = (lane >> 3) + 8 * j; const LAS float* s = scr + (8 * c) * 33 + n; const float k_ = pg8::FP8_SW;
        u32x2 o; o.x = pg8::pack4_fp8(s[0 * 33] * k_, s[1 * 33] * k_, s[2 * 33] * k_, s[3 * 33] * k_); o.y = pg8::pack4_fp8(s[4 * 33] * k_, s[5 * 33] * k_, s[6 * 33] * k_, s[7 * 33] * k_);
        *(GAS u32x2*)(WT + (size_t)n * ldt + 8 * c) = o; }
    LDS_WAIT(); asm volatile("" ::: "memory");
}
constexpr int I_WIN = 16 * 64, I_WO = 8 * 32, I_WEFF = 4 * 16 * 16, I_WU = 32 * 16 * 64, I_WD = 32 * 16 * 32;
constexpr int P0_ITEMS = I_WIN + I_WO + I_WEFF;

__device__ __forceinline__ void phase0(const Args& a, LAS unsigned char* L, int vcu, int G, int tid, int lane, int wave) {
    const float* w_in = a.in[2]; const float* w_pool = a.in[4]; const float* pscale = a.in[5]; const float* w_out = a.in[6];
    bf16* Win_t = (bf16*)(a.ws + WS_WIN); bf16* Wo_t = (bf16*)(a.ws + WS_WO);
    LAS float* scr = (LAS float*)(L + wave * 8448);
    LAS float* wf = (LAS float*)(L + 69632);
    for (int i = tid; i < 1024 * 8; i += 512) { const int d = i >> 3, p_ = ((d & 255) >> 2) + 64 * (4 * (d >> 8) + (d & 3)); wf[p_ * 12 + (i & 7)] = w_in[(size_t)d * INW + 2048 + (i & 7)]; }
    __syncthreads();
    const int gw = vcu * NWAVES + wave, NGW = G * NWAVES;
    {
        const float* x = a.in[0]; const float* g_mix = a.in[1]; const float* b_forget = a.in[3];
        bf16* XN = (bf16*)(a.ws + WS_XN); float* LOGF = (float*)(a.ws + WS_LOGF);
        f32x4 g[4];
#pragma unroll
        for (int j = 0; j < 4; ++j) g[j] = *(const f32x4*)(g_mix + 4 * lane + 256 * j);
        f32x4 vn[2][4];
#pragma unroll
        for (int q = 0; q < 2; ++q)
#pragma unroll
            for (int j = 0; j < 4; ++j) vn[q][j] = *(const f32x4*)(x + (size_t)(gw + q * NGW) * DM + 4 * lane + 256 * j);
        for (int m = gw; m < T; m += 2 * NGW) {
            f32x4 v[2][4]; float ss[2] = {0.f, 0.f};
#pragma unroll
            for (int q = 0; q < 2; ++q)
#pragma unroll
                for (int j = 0; j < 4; ++j) { v[q][j] = vn[q][j]; ss[q] += v[q][j].x * v[q][j].x + v[q][j].y * v[q][j].y + v[q][j].z * v[q][j].z + v[q][j].w * v[q][j].w; }
            { const int mn = (m + 2 * NGW < T) ? m + 2 * NGW : m;
#pragma unroll
              for (int q = 0; q < 2; ++q)
#pragma unroll
                  for (int j = 0; j < 4; ++j) vn[q][j] = *(const f32x4*)(x + (size_t)(mn + q * NGW) * DM + 4 * lane + 256 * j); }
#pragma unroll
            for (int o = 1; o < 64; o <<= 1) { ss[0] += __shfl_xor(ss[0], o); ss[1] += __shfl_xor(ss[1], o); }
            float fl[2][8];
#pragma unroll
            for (int q = 0; q < 2; ++q) { const float rstd = rsqrtf(ss[q] * (1.f / DM) + RMS_EPS);
#pragma unroll
                for (int e = 0; e < 8; ++e) fl[q][e] = 0.f;
#pragma unroll
                for (int j = 0; j < 4; ++j) v[q][j] = v[q][j] * rstd * g[j]; }
#pragma unroll
            for (int j = 0; j < 4; ++j) {
#pragma unroll
                for (int i = 0; i < 4; ++i) {
                    const int prow = lane + 64 * (4 * j + i);
                    const f32x4 w0 = *(const LAS f32x4*)(wf + prow * 12), w1 = *(const LAS f32x4*)(wf + prow * 12 + 4);
#pragma unroll
                    for (int q = 0; q < 2; ++q) { const float hv = v[q][j][i];
                        fl[q][0] += hv * w0.x; fl[q][1] += hv * w0.y; fl[q][2] += hv * w0.z; fl[q][3] += hv * w0.w;
                        fl[q][4] += hv * w1.x; fl[q][5] += hv * w1.y; fl[q][6] += hv * w1.z; fl[q][7] += hv * w1.w; }
                }
#pragma unroll
                for (int q = 0; q < 2; ++q) { u32x2 o; o.x = pk2(v[q][j].x, v[q][j].y); o.y = pk2(v[q][j].z, v[q][j].w);
                    *(u32x2*)(XN + (size_t)(m + q * NGW) * DM + 4 * lane + 256 * j) = o; }
            }
            float z[2];
            { const bool u5 = lane >= 32, u4 = (lane & 16) != 0, u3 = (lane & 8) != 0; float a4[2][4], a2[2][2];
#pragma unroll
              for (int q = 0; q < 2; ++q)
#pragma unroll
                  for (int e = 0; e < 4; ++e) { const float keep = u5 ? fl[q][4 + e] : fl[q][e], give = u5 ? fl[q][e] : fl[q][4 + e]; a4[q][e] = keep + __shfl_xor(give, 32); }
#pragma unroll
              for (int q = 0; q < 2; ++q)
#pragma unroll
                  for (int e = 0; e < 2; ++e) { const float keep = u4 ? a4[q][2 + e] : a4[q][e], give = u4 ? a4[q][e] : a4[q][2 + e]; a2[q][e] = keep + __shfl_xor(give, 16); }
#pragma unroll
              for (int q = 0; q < 2; ++q) z[q] = (u3 ? a2[q][1] : a2[q][0]) + __shfl_xor(u3 ? a2[q][0] : a2[q][1], 8);
#pragma unroll
              for (int o = 4; o >= 1; o >>= 1) { z[0] += __shfl_xor(z[0], o); z[1] += __shfl_xor(z[1], o); } }
            if ((lane & 7) == 0) {
                const int hd = lane >> 3; const float bfv = b_forget[hd];
#pragma unroll
                for (int q = 0; q < 2; ++q) { const int mm = m + q * NGW; const float zz = z[q] + bfv; const float ls = fminf(zz, 0.f) - log1pf(expf(-fabsf(zz)));
                    LOGF[((size_t)(mm / SEQ) * NH + hd) * SEQ + (mm % SEQ)] = ls; }
            }
        }
    }
    for (int it = gw; it < P0_ITEMS; it += NGW) {
        int r = it;
        if (r < I_WIN) { const int kb = r >> 6, nb = r & 63; p0_transpose_item(w_in + (size_t)(64 * kb) * INW + 32 * nb, INW, Win_t + (size_t)(32 * nb) * DM + 64 * kb, DM, scr, lane); continue; } r -= I_WIN;
        if (r < I_WO) { const int kb = r >> 5, nb = r & 31; p0_transpose_item(w_out + (size_t)(512 + 64 * kb) * DM + 32 * nb, DM, Wo_t + (size_t)(32 * nb) * DM + 512 + 64 * kb, DM, scr, lane); continue; } r -= I_WO;
        if (r < I_WEFF) {
            const int g = r >> 8, nb = (r >> 4) & 15, kb = r & 15, n = nb * 64 + lane; float acc[8];
#pragma unroll
            for (int i = 0; i < 8; ++i) acc[i] = 0.f;
            const float* wp = w_pool + (size_t)g * 16384 + (size_t)(kb * 8) * 128;
#pragma unroll 2
            for (int d = 0; d < 128; d += 4) { f32x4 av;
#pragma unroll
                for (int q = 0; q < 4; ++q) av[q] = w_out[(size_t)(g * 128 + d + q) * DM + n];
                av = av * *(const f32x4*)(pscale + g * 128 + d);
#pragma unroll
                for (int i = 0; i < 8; ++i) { const f32x4 wv = *(const f32x4*)(wp + i * 128 + d); acc[i] += av.x * wv.x + av.y * wv.y + av.z * wv.z + av.w * wv.w; } }
            u32x4 o; o.x = pk2(acc[0], acc[1]); o.y = pk2(acc[2], acc[3]); o.z = pk2(acc[4], acc[5]); o.w = pk2(acc[6], acc[7]);
            *(GAS u32x4*)(Wo_t + (size_t)n * DM + g * 128 + kb * 8) = o; continue; } r -= I_WEFF;
        }
}

constexpr int J_WU = 32 * 16 * 32, J_WD = 32 * 16 * 16;
struct ConvItem { const float* src; int ldw; unsigned char* dst; };
__device__ __forceinline__ ConvItem conv_item(const Args& a, int r) {
    ConvItem it;
    if (r < J_WU) { const int e = r >> 9, kb = (r >> 5) & 15, nb = r & 31, n0 = 64 * nb;
        const int rowp = n0 < 1024 ? (n0 >> 7) * 256 + (n0 & 127) : ((n0 - 1024) >> 7) * 256 + 128 + ((n0 - 1024) & 127);
        it.src = a.in[10] + (size_t)e * DM * 2048 + (size_t)(64 * kb) * 2048 + n0; it.ldw = 2048; it.dst = a.ws + WS_WU + ((size_t)e * 2048 + rowp) * DM + 64 * kb; return it; }
    r -= J_WU;
    { const int e = r >> 8, kb = (r >> 4) & 15, nb = r & 15;
      it.src = a.in[12] + (size_t)e * DE * DM + (size_t)(64 * kb) * DM + 64 * nb; it.ldw = DM; it.dst = a.ws + WS_WD + ((size_t)e * DM + 64 * nb) * DE + 64 * kb; return it; }
}
__device__ __forceinline__ void conv_load(float (&tv)[64], const ConvItem& it, int lane) {
    const float* p_ = it.src + lane;
#pragma unroll
    for (int i = 0; i < 64; ++i) tv[i] = p_[(size_t)i * it.ldw];
}
__device__ __forceinline__ void conv_finish(const float (&tv)[64], const ConvItem& it, int lane) {
    const float k_ = pg8::FP8_SW; unsigned char* d_ = it.dst + (size_t)lane * DM;
#pragma unroll
    for (int q = 0; q < 4; ++q) { u32x4 o;
        o.x = pg8::pack4_fp8(tv[16 * q + 0] * k_, tv[16 * q + 1] * k_, tv[16 * q + 2] * k_, tv[16 * q + 3] * k_); o.y = pg8::pack4_fp8(tv[16 * q + 4] * k_, tv[16 * q + 5] * k_, tv[16 * q + 6] * k_, tv[16 * q + 7] * k_);
        o.z = pg8::pack4_fp8(tv[16 * q + 8] * k_, tv[16 * q + 9] * k_, tv[16 * q + 10] * k_, tv[16 * q + 11] * k_); o.w = pg8::pack4_fp8(tv[16 * q + 12] * k_, tv[16 * q + 13] * k_, tv[16 * q + 14] * k_, tv[16 * q + 15] * k_);
        *(GAS u32x4*)(d_ + 16 * q) = o; }
}
constexpr int CONV_P2_CHUNKS = 1024, CONV_P4_PER_WAVE = 0;
static_assert(CONV_P2_CHUNKS * 24 + 256 * 4 * CONV_P4_PER_WAVE == J_WU + J_WD, "conversion split");
__device__ __forceinline__ void conv_triple(const Args& a, int r0, int lane) {
    const ConvItem i0 = conv_item(a, r0), i1 = conv_item(a, r0 + 1), i2 = conv_item(a, r0 + 2);
    float ta[64], tb[64];
    conv_load(ta, i0, lane); conv_load(tb, i1, lane);
    conv_finish(ta, i0, lane);
    conv_load(ta, i2, lane);
    conv_finish(tb, i1, lane);
    conv_finish(ta, i2, lane);
}
__device__ __forceinline__ void conv_chunk(const Args& a, int cc, int lane, int wave) { conv_triple(a, cc * 24 + wave * 3, lane); }

template <int W> __device__ __forceinline__ void pool_run(const bf16* U, bf16* CAT, int row0, int c0) {
    const int t0 = row0 % SEQ;
    u32x4 blk[8], tr[W - 1];
#pragma unroll
    for (int i = 0; i < 8; ++i) blk[i] = *(const u32x4*)(U + (size_t)(row0 + i) * PW + c0);
#pragma unroll
    for (int j = 1; j < W; ++j) { const u32x4 v_ = *(const u32x4*)(U + (size_t)(t0 - j >= 0 ? row0 - j : row0) * PW + c0); tr[j - 1] = (t0 - j >= 0) ? v_ : (u32x4){0u, 0u, 0u, 0u}; }
    float S[8];
#pragma unroll
    for (int k = 0; k < 8; ++k) S[k] = 0.f;
#pragma unroll
    for (int j = 0; j < W - 1; ++j) { const unsigned rr[4] = {tr[j].x, tr[j].y, tr[j].z, tr[j].w};
#pragma unroll
        for (int k = 0; k < 4; ++k) { S[2 * k] += __builtin_bit_cast(float, rr[k] << 16); S[2 * k + 1] += __builtin_bit_cast(float, rr[k] & 0xffff0000u); } }
#pragma unroll
    for (int i = 0; i < 8; ++i) { const int t = t0 + i; float cur[8];
        { const unsigned rr[4] = {blk[i].x, blk[i].y, blk[i].z, blk[i].w};
#pragma unroll
          for (int k = 0; k < 4; ++k) { cur[2 * k] = __builtin_bit_cast(float, rr[k] << 16); cur[2 * k + 1] = __builtin_bit_cast(float, rr[k] & 0xffff0000u); } }
        const float inv = 1.f / (float)(t + 1 < W ? t + 1 : W); float o[8];
#pragma unroll
        for (int k = 0; k < 8; ++k) { S[k] += cur[k]; o[k] = S[k] * inv - cur[k]; }
        u32x4 ov; ov.x = pk2(o[0], o[1]); ov.y = pk2(o[2], o[3]); ov.z = pk2(o[4], o[5]); ov.w = pk2(o[6], o[7]);
        *(u32x4*)(CAT + (size_t)(row0 + i) * DM + c0) = ov;
        const u32x4 sb = (i - (W - 1) >= 0) ? blk[(i - (W - 1) >= 0) ? i - (W - 1) : 0] : tr[(i - (W - 1) >= 0) ? 0 : (W - 1) - i - 1];
        { const unsigned rr[4] = {sb.x, sb.y, sb.z, sb.w};
#pragma unroll
          for (int k = 0; k < 4; ++k) { S[2 * k] -= __builtin_bit_cast(float, rr[k] << 16); S[2 * k + 1] -= __builtin_bit_cast(float, rr[k] & 0xffff0000u); } }
    }
}
__device__ __forceinline__ void pool_chunk(const Args& a, int c, int tid) {
    const bf16* U = (const bf16*)(a.ws + WS_U); bf16* CAT = (bf16*)(a.ws + WS_CAT);
    const int wv = tid >> 6, ln = tid & 63, g = wv & 3, ch = 16 * g + (ln & 15), c0 = ch * 8;
#pragma unroll 1
    for (int hf = 0; hf < 2; ++hf) { const int row0 = 128 * c + 8 * (hf * 8 + (wv >> 2) * 4 + (ln >> 4));
        if (g == 0) pool_run<2>(U, CAT, row0, c0); else if (g == 1) pool_run<4>(U, CAT, row0, c0); else if (g == 2) pool_run<8>(U, CAT, row0, c0); else pool_run<16>(U, CAT, row0, c0); }
}
__device__ __forceinline__ void c2_local_scan(const Args& a, LAS unsigned char* L, int bx, int tid, int lane, int wave) {
    if (bx >= 256) return;
    const int bh = bx >> 3, blk = bx & 7; const size_t off = (size_t)bh * SEQ + blk * 1024 + tid * 2;
    const float* src = (const float*)(a.ws + WS_LOGF) + off; float* dst = (float*)(a.ws + WS_CUM) + off;
    LAS double* wtot = (LAS double*)(L + 0);
    const float v0 = src[0], v1 = src[1]; const double s = (double)v0 + (double)v1; double inc = s;
#pragma unroll
    for (int o = 1; o < 64; o <<= 1) { const double t_ = __shfl_up(inc, o); if (lane >= o) inc += t_; }
    if (lane == 63) wtot[wave] = inc;
    __syncthreads();
    double base = inc - s;
    for (int w = 0; w < wave; ++w) base += wtot[w];
    dst[0] = (float)((base + (double)v0) * (double)LOG2E); dst[1] = (float)((base + s) * (double)LOG2E);
    if (tid == 511) ((float*)(a.ws + WS_TOT))[bh * 8 + blk] = (float)((base + s) * (double)LOG2E);
    __syncthreads();
}
__device__ __forceinline__ int c2_prepare(const Args& a, LAS unsigned char* L, int bh, int qb, float qkb2, int tid) {
    const float* cum = (const float*)(a.ws + WS_CUM) + (size_t)bh * SEQ; const float* tot = (const float*)(a.ws + WS_TOT) + bh * 8;
    LAS float* c2s = (LAS float*)(L + attn_body::LDS_C2);
    float pre[8]; { double b_ = 0.0;
#pragma unroll
        for (int w = 0; w < 8; ++w) { pre[w] = (float)b_; b_ += (double)tot[w]; } }
    const int q0 = qb * 256, NT = 4 * qb + 4, lane = tid & 63;
    float pq = 0.f;
#pragma unroll
    for (int w = 0; w < 8; ++w) if ((q0 >> 10) == w) pq = pre[w];
    const float cq = cum[q0] + pq + qkb2 + 40.0f;
    int j0;
    { const int m = lane; bool sk = false;
      if (m >= 1 && m <= ((NT - 4) >> 1)) { const int pos = 128 * m - 1; float pp = 0.f;
#pragma unroll
          for (int w = 0; w < 8; ++w) if ((pos >> 10) == w) pp = pre[w];
          sk = (cq - (cum[pos] + pp)) < 0.f; }
      const unsigned long long bal = __ballot(sk) >> 1;
      j0 = 2 * (int)__builtin_ctzll(~bal); }
    for (int idx = 64 * j0 + 4 * tid; idx < q0 + 256; idx += 4 * 512) { float pp = 0.f;
#pragma unroll
        for (int w = 0; w < 8; ++w) if ((idx >> 10) == w) pp = pre[w];
        f32x4 v = *(const f32x4*)(cum + idx); v = v + pp; *(LAS f32x4*)(c2s + idx) = v; }
    __syncthreads();
    return __builtin_amdgcn_readfirstlane(j0);
}

constexpr int RT_GWH = 0, RT_GWL = 65536, RT_GF = 131072, RT_CHE = 135168, RT_CHG = RT_CHE + 2048, RT_LCNT = RT_CHG + 2048, RT_LBASE = RT_LCNT + 128;
static_assert(RT_LBASE + 128 <= LDSCTL_OFF, "router LDS map");
__device__ __forceinline__ void router_phase(const Args& a, LAS unsigned char* L, int vcu, int G, int tid, int lane, int wave) {
    typedef short bf16x8_t __attribute__((ext_vector_type(8)));
    LAS unsigned short* gwh = (LAS unsigned short*)(L + RT_GWH); LAS unsigned short* gwl = (LAS unsigned short*)(L + RT_GWL); LAS float* gf = (LAS float*)(L + RT_GF);
    LAS int* ch_e = (LAS int*)(L + RT_CHE); LAS float* ch_g = (LAS float*)(L + RT_CHG); LAS int* lcnt = (LAS int*)(L + RT_LCNT); LAS int* lbase = (LAS int*)(L + RT_LBASE);
    const float* w_router = a.in[8]; const float* b_router = a.in[9]; const float* g_ffn = a.in[7];
    for (int idx = tid; idx < 1024 * 32; idx += 512) { const int k = idx >> 5, e = idx & 31; const float v = g_ffn[k] * w_router[idx];
        const unsigned hb = f2bf(v); const float hf = __builtin_bit_cast(float, hb << 16); const unsigned lb = f2bf(v - hf);
        const int pos = (((k >> 5) * 4 + ((k >> 3) & 3)) * 32 + e) * 8 + (k & 7); gwh[pos] = (unsigned short)hb; gwl[pos] = (unsigned short)lb; }
    for (int k = tid; k < 1024; k += 512) gf[k] = g_ffn[k];
    __syncthreads();
    const bf16* X1 = (const bf16*)(a.ws + WS_X1B); unsigned char* H2 = a.ws + WS_XN;
    int* cnt = (int*)(a.ws + WS_CTL) + CW_CNT; int* SEL = (int*)(a.ws + WS_SEL); int* LTK = (int*)(a.ws + WS_LTK); float* LGT = (float*)(a.ws + WS_LGT);
    const int j = lane & 15, q = lane >> 4;
    for (int grp = vcu; grp < T / 128; grp += G) {
        if (tid < 32) lcnt[tid] = 0;
        __syncthreads();
        {
            const int lt = wave * 16 + j, m = grp * 128 + lt;
            const bf16* xr = X1 + (size_t)m * DM + 8 * q;
            pg8::f32x4 acc0 = {0.f, 0.f, 0.f, 0.f}, acc1 = {0.f, 0.f, 0.f, 0.f}; float ss = 0.f;
#pragma unroll 8
            for (int s = 0; s < 32; ++s) {
                const u32x4 xb = *(const u32x4*)(xr + 32 * s);
                const LAS unsigned short* wp = gwh + ((s * 4 + q) * 32 + j) * 8; const LAS unsigned short* wl = gwl + ((s * 4 + q) * 32 + j) * 8;
                const bf16x8_t ah0 = *(const LAS bf16x8_t*)wp, ah1 = *(const LAS bf16x8_t*)(wp + 128), al0 = *(const LAS bf16x8_t*)wl, al1 = *(const LAS bf16x8_t*)(wl + 128);
                const bf16x8_t xf = __builtin_bit_cast(bf16x8_t, xb);
                acc0 = __builtin_amdgcn_mfma_f32_16x16x32_bf16(ah0, xf, acc0, 0, 0, 0); acc1 = __builtin_amdgcn_mfma_f32_16x16x32_bf16(ah1, xf, acc1, 0, 0, 0);
                acc0 = __builtin_amdgcn_mfma_f32_16x16x32_bf16(al0, xf, acc0, 0, 0, 0); acc1 = __builtin_amdgcn_mfma_f32_16x16x32_bf16(al1, xf, acc1, 0, 0, 0);
                const unsigned w_[4] = {xb.x, xb.y, xb.z, xb.w};
#pragma unroll
                for (int c = 0; c < 4; ++c) { const float lo = __builtin_bit_cast(float, w_[c] << 16), hi = __builtin_bit_cast(float, w_[c] & 0xffff0000u); ss += lo * lo + hi * hi; }
            }
            ss += __shfl_xor(ss, 16); ss += __shfl_xor(ss, 32);
            const float rstd = rsqrtf(ss * (1.f / DM) + RMS_EPS);
            float lv[8]; int li[8];
#pragma unroll
            for (int r = 0; r < 4; ++r) { li[r] = 4 * q + r; lv[r] = acc0[r] * rstd + b_router[li[r]]; li[4 + r] = 16 + 4 * q + r; lv[4 + r] = acc1[r] * rstd + b_router[li[4 + r]]; }
            float tv[4]; int ti[4];
#pragma unroll
            for (int k = 0; k < 4; ++k) { float bv = -INFINITY; int bi = 64;
#pragma unroll
                for (int r = 0; r < 8; ++r) if (lv[r] > bv) { bv = lv[r]; bi = li[r]; }
                tv[k] = bv; ti[k] = bi;
#pragma unroll
                for (int r = 0; r < 8; ++r) if (li[r] == bi) lv[r] = -INFINITY; }
#pragma unroll
            for (int st = 16; st <= 32; st <<= 1) {
                float cv[8]; int ci[8];
#pragma unroll
                for (int k = 0; k < 4; ++k) { cv[k] = tv[k]; ci[k] = ti[k]; cv[4 + k] = __shfl_xor(tv[k], st); ci[4 + k] = __shfl_xor(ti[k], st); }
#pragma unroll
                for (int k = 0; k < 4; ++k) { float bv = -INFINITY; int bi = 64;
#pragma unroll
                    for (int c = 0; c < 8; ++c) if (cv[c] > bv || (cv[c] == bv && ci[c] < bi)) { bv = cv[c]; bi = ci[c]; }
                    tv[k] = bv; ti[k] = bi;
#pragma unroll
                    for (int c = 0; c < 8; ++c) if (ci[c] == bi) cv[c] = -INFINITY; } }
            const float e1 = expf(tv[1] - tv[0]), e2 = expf(tv[2] - tv[0]), e3 = expf(tv[3] - tv[0]); const float inv = 1.f / (1.f + e1 + e2 + e3);
            if (q == 0) { ch_e[lt * 4 + 0] = ti[0]; ch_e[lt * 4 + 1] = ti[1]; ch_e[lt * 4 + 2] = ti[2]; ch_e[lt * 4 + 3] = ti[3];
                ch_g[lt * 4 + 0] = inv; ch_g[lt * 4 + 1] = e1 * inv; ch_g[lt * 4 + 2] = e2 * inv; ch_g[lt * 4 + 3] = e3 * inv;
#pragma unroll
                for (int k = 0; k < 4; ++k) __hip_atomic_fetch_add(&lcnt[ti[k]], 1, __ATOMIC_RELAXED, __HIP_MEMORY_SCOPE_WORKGROUP); }
            unsigned char* hr = H2 + (size_t)m * DM + 8 * q; const float sc = rstd * pg8::FP8_SA;
#pragma unroll 8
            for (int s = 0; s < 32; ++s) {
                const u32x4 xb = *(const u32x4*)(xr + 32 * s); const unsigned w_[4] = {xb.x, xb.y, xb.z, xb.w};
                const f32x4 g0 = *(const LAS f32x4*)(gf + 32 * s + 8 * q), g1 = *(const LAS f32x4*)(gf + 32 * s + 8 * q + 4);
                float x_[8];
#pragma unroll
                for (int c = 0; c < 4; ++c) { x_[2 * c] = __builtin_bit_cast(float, w_[c] << 16); x_[2 * c + 1] = __builtin_bit_cast(float, w_[c] & 0xffff0000u); }
                u32x2 o; o.x = pg8::pack4_fp8(x_[0] * g0.x * sc, x_[1] * g0.y * sc, x_[2] * g0.z * sc, x_[3] * g0.w * sc); o.y = pg8::pack4_fp8(x_[4] * g1.x * sc, x_[5] * g1.y * sc, x_[6] * g1.z * sc, x_[7] * g1.w * sc);
                *(u32x2*)(hr + 32 * s) = o;
            }
        }
        __syncthreads();
        if (tid < 32) { lbase[tid] = atomicAdd(&cnt[tid], lcnt[tid]); lcnt[tid] = 0; }
        __syncthreads();
        { const int e = ch_e[tid]; const int slot = lbase[e] + __hip_atomic_fetch_add(&lcnt[e], 1, __ATOMIC_RELAXED, __HIP_MEMORY_SCOPE_WORKGROUP); const int tk = (grp * 128 + (tid >> 2)) * 4 + (tid & 3);
          LTK[(size_t)e * T + slot] = tk; LGT[(size_t)e * T + slot] = ch_g[tid]; SEL[tk] = (slot << 5) | e; }
        __syncthreads();
    }
}

__device__ __forceinline__ void expert_map(const Args& a, volatile LAS unsigned* MISC, int tid) {
    if (tid == 0) { const int* cnt = (const int*)(a.ws + WS_CTL) + CW_CNT; int acc = 0;
        for (int e = 0; e < 32; ++e) { const int c = __hip_atomic_load((int*)cnt + e, RLX_AGENT); MISC[64 + e] = (unsigned)c; MISC[96 + e] = (unsigned)acc; acc += (c + RT - 1) / RT; } MISC[128] = (unsigned)acc; }
    __syncthreads();
}

__device__ __forceinline__ void final_phase(const Args& a, volatile LAS unsigned* MISC, int vcu, int G, int lane, int wave) {
    const int* SEL = (const int*)(a.ws + WS_SEL); const unsigned char* Y = a.ws + WS_Y; const bf16* X1 = (const bf16*)(a.ws + WS_X1B); const float* g_final = a.in[14];
    f32x4 g[4];
#pragma unroll
    for (int j = 0; j < 4; ++j) g[j] = *(const f32x4*)(g_final + 4 * lane + 256 * j);
    typedef float f32x2_t __attribute__((ext_vector_type(2)));
    const int m0 = vcu * 8 + wave, MS = G * 8;
    int svn[4]; u32x2 xbn[4];
#pragma unroll
    for (int k = 0; k < 4; ++k) svn[k] = SEL[m0 * 4 + k];
#pragma unroll
    for (int j = 0; j < 4; ++j) xbn[j] = *(const u32x2*)(X1 + (size_t)m0 * DM + 4 * lane + 256 * j);
    for (int m = m0; m < T; m += MS) {
        f32x4 v[4]; unsigned yv[4][4];
#pragma unroll
        for (int k = 0; k < 4; ++k) { const int e = svn[k] & 31, slot = svn[k] >> 5; const unsigned char* yr = Y + ((size_t)MISC[96 + e] * RT + slot) * DM;
#pragma unroll
            for (int j = 0; j < 4; ++j) yv[k][j] = *(const unsigned*)(yr + 4 * lane + 256 * j); }
#pragma unroll
        for (int j = 0; j < 4; ++j) { const u32x2 xb = xbn[j];
            v[j].x = __builtin_bit_cast(float, xb.x << 16); v[j].y = __builtin_bit_cast(float, xb.x & 0xffff0000u); v[j].z = __builtin_bit_cast(float, xb.y << 16); v[j].w = __builtin_bit_cast(float, xb.y & 0xffff0000u); }
        { const int mn = (m + MS < T) ? m + MS : m;
#pragma unroll
          for (int k = 0; k < 4; ++k) svn[k] = SEL[mn * 4 + k];
#pragma unroll
          for (int j = 0; j < 4; ++j) xbn[j] = *(const u32x2*)(X1 + (size_t)mn * DM + 4 * lane + 256 * j); }
        f32x4 ya[4];
#pragma unroll
        for (int j = 0; j < 4; ++j) ya[j] = (f32x4){0.f, 0.f, 0.f, 0.f};
#pragma unroll
        for (int k = 0; k < 4; ++k)
#pragma unroll
            for (int j = 0; j < 4; ++j) { const unsigned y = yv[k][j];
                const f32x2_t lo = __builtin_amdgcn_cvt_pk_f32_fp8((int)y, false), hi = __builtin_amdgcn_cvt_pk_f32_fp8((int)y, true);
                ya[j].x += lo.x; ya[j].y += lo.y; ya[j].z += hi.x; ya[j].w += hi.y; }
        float ss = 0.f;
#pragma unroll
        for (int j = 0; j < 4; ++j) { v[j] = v[j] + ya[j] * (1.0f / pg8::FP8_SY); ss += v[j].x * v[j].x + v[j].y * v[j].y + v[j].z * v[j].z + v[j].w * v[j].w; }
        const float rstd = rsqrtf(wave_sum(ss) * (1.f / DM) + RMS_EPS);
        float* orow = a.out + (size_t)m * DM;
#pragma unroll
        for (int j = 0; j < 4; ++j) *(f32x4*)(orow + 4 * lane + 256 * j) = v[j] * rstd * g[j];
    }
}

__global__ void __launch_bounds__(NWAVES * 64, 2) mk_fwd(Args args) {
    extern __shared__ __attribute__((aligned(16))) unsigned char lds[];
    LAS unsigned char* L = (LAS unsigned char*)lds;
    volatile LAS unsigned* MISC = (volatile LAS unsigned*)(L + LDSCTL_OFF);
    const int tid = threadIdx.x, lane = tid & 63, wave = __builtin_amdgcn_readfirstlane(tid >> 6);
    const int G = gridDim.x; const int bx = blockIdx.x; const int vcu = (G % 8 == 0) ? (bx % 8) * (G / 8) + bx / 8 : bx;
    unsigned char* ws = args.ws;
    for (int u = tid; u < (LDS_TOTAL - LDSCTL_OFF) / 4; u += NWAVES * 64) ((LAS unsigned*)(L + LDSCTL_OFF))[u] = 0u;
    __syncthreads();
    XcdBarrier bar; bar.bar = (unsigned*)(ws + WS_CTL) + CW_BAR; bar.x = 0; bar.st = nullptr;
    if (args.use_bar) bar = xcd_barrier_post((unsigned*)(ws + WS_CTL) + CW_BAR, MISC + 8);
    const int lo = args.ph_lo, hi = args.ph_hi;
#define IN(k) (lo <= (k) && (k) < hi)
#define SEAM(k) do { if (IN(k) && IN((k) + 1)) xcd_barrier(bar); } while (0)
#ifndef MK_DUP
#define MK_DUP -1
#endif
#ifndef MK_TPROBE
#define MK_TPROBE -1
#endif
#define CK0(k) do { if ((MK_TPROBE) == 100 + (k) && bx == 0 && tid == 0) { const unsigned long long c_ = __builtin_amdgcn_s_memtime(); const unsigned long long t_ = __builtin_amdgcn_s_memrealtime(); MISC[28] = (unsigned)c_; MISC[29] = (unsigned)(c_ >> 32); MISC[16] = (unsigned)t_; MISC[17] = (unsigned)(t_ >> 32); } } while (0)
#define CK1(k) do { if ((MK_TPROBE) == 100 + (k) && bx == 0 && tid == 0) { const unsigned long long c_ = __builtin_amdgcn_s_memtime(); const unsigned long long t_ = __builtin_amdgcn_s_memrealtime(); const unsigned long long c0_ = ((unsigned long long)MISC[29] << 32) | MISC[28], t0_ = ((unsigned long long)MISC[17] << 32) | MISC[16]; \
    const unsigned long long spin_ = (c_ - c0_) * 1000ull / (t_ - t0_); MISC[18] = (unsigned)(t0_ + spin_); MISC[19] = (unsigned)((t0_ + spin_) >> 32); } } while (0)
#define TP0(k) do { if ((MK_TPROBE) == (k) && bx == 0 && tid == 0) { const unsigned long long t_ = __builtin_amdgcn_s_memrealtime(); MISC[16] = (unsigned)t_; MISC[17] = (unsigned)(t_ >> 32); } } while (0)
#define TP1(k) do { if ((MK_TPROBE) == (k) && bx == 0 && tid == 0) { const unsigned long long t_ = __builtin_amdgcn_s_memrealtime(); MISC[18] = (unsigned)t_; MISC[19] = (unsigned)(t_ >> 32); } } while (0)
#define REPS(k) for (int rep_ = 0; rep_ < ((MK_DUP) == (k) ? 2 : 1); ++rep_, ((MK_DUP) == (k) && rep_ == 1 ? xcd_barrier(bar) : (void)0))

    TP0(0); CK0(0); TP0(200);
    if ((MK_TPROBE) == 300 || (MK_TPROBE) == 301) {
        if (bx == 0 && tid < 64) { typedef int v8i_ __attribute__((ext_vector_type(8))); typedef short s8_ __attribute__((ext_vector_type(8)));
            pg8::f32x4 c0 = {0, 0, 0, 0}, c1 = c0, c2 = c0, c3 = c0; v8i_ a8 = {tid, 1, 2, 3, 4, 5, 6, 7}, b8 = {7, 6, 5, 4, 3, 2, 1, tid}; s8_ a4 = {1, 2, 3, 4, 5, 6, 7, 8}, b4 = a4;
            const unsigned long long t0_ = __builtin_amdgcn_s_memtime();
            for (int it = 0; it < 1024; ++it) {
                if ((MK_TPROBE) == 300) { asm volatile("v_mfma_f32_16x16x128_f8f6f4 %0, %1, %2, %0" : "+v"(c0) : "v"(a8), "v"(b8)); asm volatile("v_mfma_f32_16x16x128_f8f6f4 %0, %1, %2, %0" : "+v"(c1) : "v"(a8), "v"(b8));
                    asm volatile("v_mfma_f32_16x16x128_f8f6f4 %0, %1, %2, %0" : "+v"(c2) : "v"(a8), "v"(b8)); asm volatile("v_mfma_f32_16x16x128_f8f6f4 %0, %1, %2, %0" : "+v"(c3) : "v"(a8), "v"(b8)); }
                else { c0 = __builtin_amdgcn_mfma_f32_16x16x32_bf16(a4, b4, c0, 0, 0, 0); c1 = __builtin_amdgcn_mfma_f32_16x16x32_bf16(a4, b4, c1, 0, 0, 0); c2 = __builtin_amdgcn_mfma_f32_16x16x32_bf16(a4, b4, c2, 0, 0, 0); c3 = __builtin_amdgcn_mfma_f32_16x16x32_bf16(a4, b4, c3, 0, 0, 0); } }
            asm volatile("s_nop 15\n\ts_nop 15" ::: "memory");
            const unsigned long long t1_ = __builtin_amdgcn_s_memtime();
            asm volatile("" :: "v"(c0), "v"(c1), "v"(c2), "v"(c3));
            if (tid == 0) MISC[21] = (unsigned)((t1_ - t0_) * 1000ull / 4096ull); } }
    if (IN(0)) REPS(0) { phase0(args, L, vcu, G, tid, lane, wave); }
    CK1(0); SEAM(0); TP1(0); TP0(1); CK0(1);
    if (IN(1)) REPS(1) {
        pg8::Gemm g{(const bf16*)(ws + WS_XN), (const bf16*)(ws + WS_WIN), DM}; pg8::StaticOrder S; S.init(T, 2048, G, bx);
        c2_local_scan(args, L, bx, tid, lane, wave);
        pg8::EpiInproj E{(bf16*)(ws + WS_U), (size_t)(WS_Q - WS_U) / 2, C2, (unsigned*)(ws + WS_CTL) + CW_NRM};
        pg8::gemm_phase<pg8::EpiInproj, pg8::StaticOrder, true, false>(L + RING_OFF, g, S, E, nullptr);
    }
    CK1(1); SEAM(1); TP1(1); TP0(2); CK0(2);
    if (IN(2)) {
        constexpr unsigned NQ_POOL = T / 128, NQA = NQ_POOL + 1024, NQC = CONV_P2_CHUNKS;
        unsigned* qhead = (unsigned*)(ws + WS_CTL) + CW_Q; const float* nrm = (const float*)(ws + WS_CTL) + CW_NRM;
        const attn_body::AttnTensors AT{(const attn_body::bf16*)(ws + WS_Q), (const attn_body::bf16*)(ws + WS_K), (const attn_body::bf16*)(ws + WS_V), (attn_body::bf16*)(ws + WS_CAT) + PW};
        #ifndef MK_CONV_MASK
#define MK_CONV_MASK 3
#endif
        const int pref = ((bx & (MK_CONV_MASK)) == 0) ? 1 : 0;
#define QT0() unsigned long long tq0_ = 0; if ((MK_TPROBE) >= 26 && (MK_TPROBE) <= 29 && threadIdx.x == 0) tq0_ = __builtin_amdgcn_s_memrealtime()
#define QT1(kind) do { if ((MK_TPROBE) == (kind) && threadIdx.x == 0) atomicAdd((unsigned*)(ws + WS_CTL) + 512, (unsigned)(__builtin_amdgcn_s_memrealtime() - tq0_)); } while (0)
#define CONV_LOOP() do { unsigned pend_ = 0; int sl_ = 0; if (threadIdx.x == 0) pend_ = atomicAdd(qhead + 64, 1u); \
        for (;;) { int tid_ = threadIdx.x; asm volatile("" : "+v"(tid_));   \
            if (tid_ == 0) MISC[24 + sl_] = pend_; __syncthreads(); const unsigned q = MISC[24 + sl_]; sl_ ^= 1; if (q >= NQC) break; \
            if (tid_ == 0) pend_ = atomicAdd(qhead + 64, 1u); \
            QT0(); conv_chunk(args, (int)q, tid_ & 63, tid_ >> 6); QT1(28); } } while (0)
        if (pref) { CONV_LOOP(); __syncthreads(); }
        { int sl_ = 0;
        for (;;) {
            int tid_ = threadIdx.x; asm volatile("" : "+v"(tid_));
            if (tid_ == 0) MISC[26 + sl_] = atomicAdd(qhead, 1u);
            __syncthreads();
            const unsigned q = MISC[26 + sl_]; sl_ ^= 1;
            if (q >= NQA) break;
            QT0();
            if (q < NQ_POOL) { pool_chunk(args, (int)q, tid_); }
            else { const int grp = (int)(q - NQ_POOL), qb = 31 - (grp >> 5), bh = grp & 31;
                const float qkb2 = 4.0f * sqrtf(nrm[bh] * nrm[32 + bh]) * 1.001f;
                attn_body::attn_unit<8>(bh / NH, bh % NH, qb, AT.Q, AT.K, AT.V, AT.O, (char*)lds + RING_OFF, c2_prepare(args, L, bh, qb, qkb2, tid_), ((MK_TPROBE) == 400) ? (unsigned*)(ws + WS_CTL) + 513 : nullptr); }
            if (q < NQ_POOL) QT1(26); else QT1(27);
        } }
#ifndef MK_CONV_HELP
#define MK_CONV_HELP 1
#endif
        if (MK_CONV_HELP) { __syncthreads(); CONV_LOOP(); }
#undef CONV_LOOP
    }
    CK1(2); SEAM(2); TP1(2); TP0(3); CK0(3);
    if (IN(3)) REPS(3) {
        pg8::Gemm g{(const bf16*)(ws + WS_CAT), (const bf16*)(ws + WS_WO), DM}; pg8::StaticOrder S; S.init(T, DM, G, bx);
        pg8::EpiResBf16 E{args.in[0], (bf16*)(ws + WS_X1B)};
        pg8::gemm_phase<pg8::EpiResBf16, pg8::StaticOrder, true, false>(L + RING_OFF, g, S, E, nullptr);
    }
    CK1(3); SEAM(3); TP1(3); TP0(4); CK0(4);
    if (IN(4)) { router_phase(args, L, vcu, G, tid, lane, wave); }
    CK1(4); SEAM(4); TP1(4); TP0(5); CK0(5);
    if (IN(5)) REPS(5) {
        TP0(51); expert_map(args, MISC, tid);
        const LAS int* pt = (const LAS int*)(L + LDSCTL_OFF + 96 * 4); const LAS int* cn = (const LAS int*)(L + LDSCTL_OFF + 64 * 4);
        LAS unsigned* tab = (LAS unsigned*)(L + TAB_OFF);
        LAS int* ul = (LAS int*)(L + LDSCTL_OFF + 132 * 4);
        pg8::MoeOrder<8>::build(ul, pt, bx, tid);
        const pg8::MoeOrder<8> S{ul, (size_t)2048 * DM};
        { const int* LTK = (const int*)(ws + WS_LTK); const int nu = ul[0];
          for (int idx = tid; idx < nu * 256; idx += NWAVES * 64) { const int i = idx >> 8, r = idx & 255, e = ul[6 + 4 * i], slot = ul[7 + 4 * i] + r;
              const int tok = slot < cn[e] ? (LTK[(size_t)e * T + slot] >> 2) : 0; tab[idx] = (unsigned)tok * (unsigned)DM; } }
        __syncthreads(); TP1(51);
        pg8::Gemm g{(const bf16*)(ws + WS_XN), (const bf16*)(ws + WS_WU), DM / 2};
        pg8::EpiSwiglu8 E{ws + WS_ACT, args.in[11]};
        pg8::gemm_phase<pg8::EpiSwiglu8, pg8::MoeOrder<8>, true, true, true, 0, MK_SP2>(L + RING_OFF, g, S, E, tab, ((MK_TPROBE) == 52 && bx == 0) ? (volatile LAS unsigned*)(MISC + 20) : nullptr);
    }
#ifdef MK_ABL
    {
        xcd_barrier(bar);
        const pg8::MoeOrder<8> S2{(const LAS int*)(L + LDSCTL_OFF + 132 * 4), (size_t)2048 * DM};
        pg8::Gemm g2{(const bf16*)(ws + WS_XN), (const bf16*)(ws + WS_WU), DM / 2}; pg8::EpiSwiglu8 E2{ws + WS_Y, args.in[11]};
        pg8::gemm_phase<pg8::EpiSwiglu8, pg8::MoeOrder<8>, true, true, true, MK_ABL>(L + RING_OFF, g2, S2, E2, (const LAS unsigned*)(L + TAB_OFF));
    }
#endif
    CK1(5); SEAM(5); TP1(5); TP0(6); CK0(6);
    if (IN(6)) REPS(6) {
        expert_map(args, MISC, tid);
        const LAS int* pt = (const LAS int*)(L + LDSCTL_OFF + 96 * 4); const LAS int* cn = (const LAS int*)(L + LDSCTL_OFF + 64 * 4);
        LAS int* ul = (LAS int*)(L + LDSCTL_OFF + 132 * 4);
        pg8::MoeOrder<4>::build(ul, pt, bx, tid);
        const pg8::MoeOrder<4> S{ul, (size_t)DM * DE};
        pg8::Gemm g{(const bf16*)(ws + WS_ACT), (const bf16*)(ws + WS_WD), DE / 2};
        pg8::EpiDown E{ws + WS_Y, args.in[13], (const float*)(ws + WS_LGT), cn, T, pg8::FP8_INV};
        pg8::gemm_phase<pg8::EpiDown, pg8::MoeOrder<4>, true, false, true, 0, MK_SP2>(L + RING_OFF, g, S, E, nullptr);
    }
    CK1(6); SEAM(6); TP1(6); TP0(7); CK0(7); TP0(70);
    if (IN(7)) { expert_map(args, MISC, tid); final_phase(args, MISC, vcu, G, lane, wave); }
    if ((MK_TPROBE) == 70) { xcd_barrier(bar); }
    TP1(7); TP1(70); TP1(200);
    if ((MK_TPROBE) >= 0 && bx == 0) { __syncthreads(); const unsigned long long ta = ((unsigned long long)MISC[17] << 32) | MISC[16], tb = ((MK_TPROBE) == 400) ? ta + (__hip_atomic_load((unsigned*)(ws + WS_CTL) + 513, RLX_AGENT) * 1000u >> 10) : ((MK_TPROBE) == 300 || (MK_TPROBE) == 301) ? ta + MISC[21] : ((MK_TPROBE) >= 26 && (MK_TPROBE) <= 29) ? ta + (__hip_atomic_load((unsigned*)(ws + WS_CTL) + 512, RLX_AGENT) >> 8) : ((MK_TPROBE) == 52 || ((MK_TPROBE) >= 23 && (MK_TPROBE) <= 25)) ? ta + MISC[20] : (((unsigned long long)MISC[19] << 32) | MISC[18]);
        const unsigned long long tend = __builtin_amdgcn_s_memrealtime() + (tb - ta); while (__builtin_amdgcn_s_memrealtime() < tend) __builtin_amdgcn_s_sleep(10); }
#undef IN
#undef SEAM
}
extern "C" void kernel_launch(void* const* d_in, const int* in_sizes, int n_in, void* d_out, int out_size, void* d_ws, size_t ws_size, hipStream_t stream) {
    if (n_in != 15 || out_size != T * DM || ws_size < WS_END) { fprintf(stderr, "kernel_launch: unexpected shapes (n_in %d out %d ws %zu)\n", n_in, out_size, ws_size); return; }
    Args a{};
    for (int i = 0; i < 15; ++i) a.in[i] = (const float*)d_in[i];
    a.out = (float*)d_out; a.ws = (unsigned char*)d_ws;
    static bool attr_done = false;
    if (!attr_done) { if (hipFuncSetAttribute((const void*)mk_fwd, hipFuncAttributeMaxDynamicSharedMemorySize, LDS_TOTAL) != hipSuccess) fprintf(stderr, "kernel_launch: hipFuncSetAttribute failed\n"); attr_done = true; }
    (void)hipMemsetAsync((char*)d_ws + WS_CTL, 0, 1 * MiB, stream);
    a.ph_lo = 0; a.ph_hi = N_PHASES; a.use_bar = 1;
    hipLaunchKernelGGL(mk_fwd, dim3(256), dim3(NWAVES * 64), LDS_TOTAL, stream, a);
}
```

```cpp
#include <hip/hip_runtime.h>
#include <cstdio>
#include <cstdint>

constexpr int BATCH = 4, SEQ = 8192, DM = 1024, T = BATCH * SEQ;
constexpr int PW = 512, AW = 512, NH = 8, HD = 64, INW = PW + 3 * AW + NH;
constexpr int NE = 32, TOPK = 4, DE = 1024;
constexpr float RMS_EPS = 1e-5f, SW_LIMIT = 7.0f, SW_ALPHA = 1.702f;
constexpr float LOG2E = 1.4426950408889634f;
constexpr float C2 = 0.125f * LOG2E;
constexpr int RT = 256;
constexpr int NROWS_PAD = T * TOPK + NE * RT;

typedef unsigned short bf16;
typedef float f32x4 __attribute__((ext_vector_type(4)));
typedef unsigned u32x4 __attribute__((ext_vector_type(4)));
typedef unsigned u32x2 __attribute__((ext_vector_type(2)));

constexpr size_t MiB = 1u << 20;
constexpr size_t WS_CTL = 0;
constexpr size_t WS_LOGF = 1 * MiB;
constexpr size_t WS_CUM = 2 * MiB;
constexpr size_t WS_SEL = 3 * MiB;
constexpr size_t WS_LTK = 4 * MiB;
constexpr size_t WS_LGT = 8 * MiB;
constexpr size_t WS_XN = 12 * MiB;
constexpr size_t WS_WIN = 76 * MiB;
constexpr size_t WS_WO = 80 * MiB;
constexpr size_t WS_WU = 82 * MiB;
constexpr size_t WS_WD = 210 * MiB;
constexpr size_t WS_U = 274 * MiB;
constexpr size_t WS_Q = 306 * MiB;
constexpr size_t WS_K = 338 * MiB;
constexpr size_t WS_V = 370 * MiB;
constexpr size_t WS_CAT = 402 * MiB;
constexpr size_t WS_P = 466 * MiB;
constexpr size_t WS_ACT = 274 * MiB;
constexpr size_t WS_Y = 546 * MiB;
constexpr size_t WS_END = 818 * MiB;
static_assert(WS_ACT + (size_t)NROWS_PAD * 1024 * 2 <= WS_Y, "ACT overlay");
static_assert(WS_Y + (size_t)NROWS_PAD * 1024 * 2 <= WS_END, "Y");
constexpr int CW_CNT = 64;


__device__ __forceinline__ unsigned f2bf(float f) { unsigned u = __builtin_bit_cast(unsigned, f); return (u + 0x7fffu + ((u >> 16) & 1u)) >> 16; }
__device__ __forceinline__ unsigned pk2(float lo, float hi) { return f2bf(lo) | (f2bf(hi) << 16); }
__device__ __forceinline__ float bf2f(unsigned short b) { return __builtin_bit_cast(float, (unsigned)b << 16); }
__device__ __forceinline__ float wave_sum(float v) {
#pragma unroll
    for (int o = 1; o < 64; o <<= 1) v += __shfl_xor(v, o);
    return v;
}

namespace pg8 {
#define PG8_LAS __attribute__((address_space(3)))
typedef unsigned short bf16_t;
typedef short bf16x8 __attribute__((ext_vector_type(8)));
typedef float f32x4 __attribute__((ext_vector_type(4)));
typedef unsigned u32x4 __attribute__((ext_vector_type(4)));
constexpr int BM = 256, BK = 64, HALF = 128, HTB = HALF * BK * 2  , STAGE_BYTES = 8 * HTB, NXCD = 8, WGM = 8;

__host__ __device__ __forceinline__ int lds_byte(int r, int c) { const int ch = (c >> 3) ^ ((r >> 1) & 7); return (r >> 3) * 1024 + (r & 7) * 128 + ch * 16 + (c & 7) * 2; }
__host__ __device__ __forceinline__ void stage_rc(int b, int& R, int& C) { const int st = b >> 10, sb = b & 1023; R = st * 8 + (sb >> 7); C = ((((sb >> 4) & 7) ^ ((R >> 1) & 7)) * 8); }
__host__ __device__ __forceinline__ int perm32(int rho) { const int n = rho >> 4, i = rho & 15; return 8 * (i >> 2) + 4 * n + (i & 3); }

struct Unit { int pm, pn, e, lrow0; size_t boff; };
struct Gemm { const bf16_t* A; const bf16_t* Bt; int K; };

struct StaticOrder {
    int nM, nN, nwg, G, c;
    __host__ __device__ void init(int M, int N, int G_, int c_) { nM = M / BM; nN = N / BM; nwg = nM * nN; G = G_; c = c_; }
    __host__ __device__ bool next(int i, Unit& u) const {
        const long L = (long)i * G + c; if (L >= nwg) return false;
        int wgid = (int)L; { const int q = nwg / NXCD, r = nwg % NXCD, xcd = wgid % NXCD, off = wgid / NXCD; wgid = (xcd < r ? xcd * (q + 1) : r * (q + 1) + (xcd - r) * q) + off; }
        const int nig = WGM * nN, gid = wgid / nig, fm = gid * WGM, gsz = (nM - fm) < WGM ? (nM - fm) : WGM;
        u.pm = fm + ((wgid % nig) % gsz); u.pn = (wgid % nig) / gsz; u.e = 0; u.lrow0 = 0; u.boff = 0; return true;
    }
};
template <int NCOL> struct MoeOrder {
    static constexpr int RG = 32 / NCOL;
    const PG8_LAS int* ul; size_t bstride;
    static __device__ __forceinline__ void build(PG8_LAS int* ul, const PG8_LAS int* pt, int c, int tid) {
        const int nrt = pt[32]; const int x = c & 7, j = c >> 3;
        const int lo = (nrt * x) >> 3, hi = (nrt * (x + 1)) >> 3;
        if (tid < 32) { const int rt = lo + RG * tid + j / NCOL;
            if (rt < hi) { int e = 0; for (int k = 1; k < 32; ++k) e += (pt[k] <= rt) ? 1 : 0;
                ul[4 + 4 * tid] = rt; ul[5 + 4 * tid] = j % NCOL; ul[6 + 4 * tid] = e; ul[7 + 4 * tid] = (rt - pt[e]) * BM; } }
        if (tid == 0) { const int span = hi - (lo + j / NCOL); ul[0] = span > 0 ? (span + RG - 1) / RG : 0; }
        __syncthreads();
    }
    __device__ __forceinline__ bool next(int i, Unit& u) const {
        if (i >= ul[0]) return false;
        u.pm = ul[4 + 4 * i]; u.pn = ul[5 + 4 * i]; u.e = ul[6 + 4 * i]; u.lrow0 = ul[7 + 4 * i]; u.boff = (size_t)u.e * bstride; return true;
    }
};

__device__ __forceinline__ unsigned cvt_pk_bf16(float lo, float hi) { unsigned r; asm volatile("v_cvt_pk_bf16_f32 %0, %1, %2" : "=v"(r) : "v"(lo), "v"(hi)); return r; }

struct EpiInproj {
    static constexpr bool PERM = true; static constexpr int NST = 16;
    bf16_t* O; size_t split_stride; float qscale; unsigned* nrm;
    __device__ __forceinline__ void operator()(const f32x4 (&acc)[2][2][4][2], const Unit& u, int wr, int wc, int fr, int fq) const {
        const int row0 = u.pm * BM + wr * 64 + fr; int colt = u.pn * BM; const int t = colt >> 9; bf16_t* base = O + (size_t)t * split_stride; colt -= t * 512;
        const float sc = (t == 1) ? qscale : 1.f; const int col0 = colt + wc * 32 + 8 * fq;
#pragma unroll
        for (int ai = 0; ai < 2; ++ai)
#pragma unroll
            for (int m = 0; m < 4; ++m) { bf16_t* rowp = base + (size_t)(row0 + ai * HALF + m * 16) * 512 + col0;
#pragma unroll
                for (int bj = 0; bj < 2; ++bj) { const f32x4 v0 = acc[ai][bj][m][0] * sc, v1 = acc[ai][bj][m][1] * sc;
                    u32x4 w; w.x = cvt_pk_bf16(v0[0], v0[1]); w.y = cvt_pk_bf16(v0[2], v0[3]); w.z = cvt_pk_bf16(v1[0], v1[1]); w.w = cvt_pk_bf16(v1[2], v1[3]);
                    *(u32x4*)(rowp + bj * HALF) = w; } }
        if (t == 1 || t == 2) {
            float mx[2] = {0.f, 0.f};
#pragma unroll
            for (int ai = 0; ai < 2; ++ai)
#pragma unroll
                for (int m = 0; m < 4; ++m)
#pragma unroll
                    for (int bj = 0; bj < 2; ++bj) { const f32x4 v0 = acc[ai][bj][m][0] * sc, v1 = acc[ai][bj][m][1] * sc;
                        float s8 = v0[0] * v0[0] + v0[1] * v0[1] + v0[2] * v0[2] + v0[3] * v0[3] + v1[0] * v1[0] + v1[1] * v1[1] + v1[2] * v1[2] + v1[3] * v1[3];
                        s8 += __shfl_xor(s8, 16); s8 += __shfl_xor(s8, 32); mx[bj] = fmaxf(mx[bj], s8); }
#pragma unroll
            for (int bj = 0; bj < 2; ++bj) {
#pragma unroll
                for (int o = 1; o < 16; o <<= 1) mx[bj] = fmaxf(mx[bj], __shfl_xor(mx[bj], o));
                if ((threadIdx.x & 63) == 0) { const int head = ((u.pn & 1) * 256 + bj * HALF + wc * 32) >> 6, b = (u.pm * BM) >> 13;
                    atomicMax(nrm + (t - 1) * 32 + b * 8 + head, __float_as_uint(mx[bj] * 1.01f)); } }
        }
    }
};
struct EpiResBf16 {
    static constexpr bool PERM = true; static constexpr int NST = 16;
    const float* x; bf16_t* out;
    __device__ __forceinline__ void operator()(const f32x4 (&acc)[2][2][4][2], const Unit& u, int wr, int wc, int fr, int fq) const {
        const int row0 = u.pm * BM + wr * 64 + fr, col0 = u.pn * BM + wc * 32 + 8 * fq;
        f32x4 xa[2][2][2], xb[2][2][2];
#define PG8_XLOAD(dst, b) do { _Pragma("unroll") for (int mm = 0; mm < 2; ++mm) { const size_t off_ = (size_t)(row0 + ((b) >> 1) * HALF + (((b) & 1) * 2 + mm) * 16) * 1024 + col0; \
            _Pragma("unroll") for (int bj = 0; bj < 2; ++bj) { dst[mm][bj][0] = *(const f32x4*)(x + off_ + bj * HALF); dst[mm][bj][1] = *(const f32x4*)(x + off_ + bj * HALF + 4); } } } while (0)
#define PG8_XSTORE(src, b) do { _Pragma("unroll") for (int mm = 0; mm < 2; ++mm) { const int ai = (b) >> 1, m = ((b) & 1) * 2 + mm; const size_t off_ = (size_t)(row0 + ai * HALF + m * 16) * 1024 + col0; \
            _Pragma("unroll") for (int bj = 0; bj < 2; ++bj) { const f32x4 v0 = src[mm][bj][0] + acc[ai][bj][m][0], v1 = src[mm][bj][1] + acc[ai][bj][m][1]; \
                u32x4 w; w.x = cvt_pk_bf16(v0[0], v0[1]); w.y = cvt_pk_bf16(v0[2], v0[3]); w.z = cvt_pk_bf16(v1[0], v1[1]); w.w = cvt_pk_bf16(v1[2], v1[3]); *(u32x4*)(out + off_ + bj * HALF) = w; } } } while (0)
        PG8_XLOAD(xa, 0); PG8_XLOAD(xb, 1);
        asm volatile("" ::: "memory");
        PG8_XSTORE(xa, 0); PG8_XLOAD(xa, 2);
        asm volatile("" ::: "memory");
        PG8_XSTORE(xb, 1); PG8_XLOAD(xb, 3);
        asm volatile("" ::: "memory");
        PG8_XSTORE(xa, 2);
        PG8_XSTORE(xb, 3);
#undef PG8_XLOAD
#undef PG8_XSTORE
    }
};
__device__ __forceinline__ float swiglu1(float g, float l) {
    const float gl = fminf(g, 7.0f), li = fminf(fmaxf(l, -7.0f), 7.0f);
    const float sg = __builtin_amdgcn_rcpf(1.0f + __builtin_amdgcn_exp2f(gl * (-1.702f * 1.4426950408889634f)));
    return gl * sg * (li + 1.0f);
}
struct EpiSwiglu {
    static constexpr bool PERM = true; static constexpr int NST = 8;
    bf16_t* ACT; const float* bup;
    __device__ __forceinline__ void operator()(const f32x4 (&acc)[2][2][4][2], const Unit& u, int wr, int wc, int fr, int fq) const {
        const int row0 = u.pm * BM + wr * 64 + fr, col0 = u.pn * HALF + wc * 32 + 8 * fq;
        const float* bb = bup + (size_t)u.e * 2048 + col0;
        f32x4 bg[2], bl[2];
#pragma unroll
        for (int n = 0; n < 2; ++n) { bg[n] = *(const f32x4*)(bb + 4 * n); bl[n] = *(const f32x4*)(bb + 1024 + 4 * n); }
#pragma unroll
        for (int ai = 0; ai < 2; ++ai)
#pragma unroll
            for (int m = 0; m < 4; ++m) { bf16_t* rowp = ACT + (size_t)(row0 + ai * HALF + m * 16) * 1024 + col0;
                const f32x4 g0 = acc[ai][0][m][0] + bg[0], g1 = acc[ai][0][m][1] + bg[1], l0 = acc[ai][1][m][0] + bl[0], l1 = acc[ai][1][m][1] + bl[1];
                u32x4 w; w.x = cvt_pk_bf16(swiglu1(g0[0], l0[0]), swiglu1(g0[1], l0[1])); w.y = cvt_pk_bf16(swiglu1(g0[2], l0[2]), swiglu1(g0[3], l0[3]));
                w.z = cvt_pk_bf16(swiglu1(g1[0], l1[0]), swiglu1(g1[1], l1[1])); w.w = cvt_pk_bf16(swiglu1(g1[2], l1[2]), swiglu1(g1[3], l1[3]));
                *(u32x4*)rowp = w; }
    }
};

constexpr float FP8_SA = 4.0f, FP8_SW = 256.0f, FP8_INV = 1.0f / (FP8_SA * FP8_SW), FP8_SY = 16.0f;
__device__ __forceinline__ unsigned pack4_fp8(float a, float b, float c, float d) { unsigned p = 0; p = __builtin_amdgcn_cvt_pk_fp8_f32(a, b, p, false); p = __builtin_amdgcn_cvt_pk_fp8_f32(c, d, p, true); return p; }
struct EpiSwiglu8 {
    static constexpr bool PERM = true; static constexpr int NST = 8;
    unsigned char* ACT; const float* bup;
    __device__ __forceinline__ void operator()(const f32x4 (&acc)[2][2][4][2], const Unit& u, int wr, int wc, int fr, int fq) const {
        const int row0 = u.pm * BM + wr * 64 + fr, col0 = u.pn * HALF + wc * 32 + 8 * fq;
        const float* bb = bup + (size_t)u.e * 2048 + col0;
        f32x4 bg[2], bl[2];
#pragma unroll
        for (int n = 0; n < 2; ++n) { bg[n] = *(const f32x4*)(bb + 4 * n); bl[n] = *(const f32x4*)(bb + 1024 + 4 * n); }
#pragma unroll
        for (int ai = 0; ai < 2; ++ai)
#pragma unroll
            for (int m = 0; m < 4; ++m) { unsigned char* rowp = ACT + (size_t)(row0 + ai * HALF + m * 16) * 1024 + col0;
                const f32x4 g0 = acc[ai][0][m][0] * FP8_INV + bg[0], g1 = acc[ai][0][m][1] * FP8_INV + bg[1], l0 = acc[ai][1][m][0] * FP8_INV + bl[0], l1 = acc[ai][1][m][1] * FP8_INV + bl[1];
                typedef unsigned u32x2_t __attribute__((ext_vector_type(2))); u32x2_t w;
                w.x = pack4_fp8(swiglu1(g0[0], l0[0]) * FP8_SA, swiglu1(g0[1], l0[1]) * FP8_SA, swiglu1(g0[2], l0[2]) * FP8_SA, swiglu1(g0[3], l0[3]) * FP8_SA);
                w.y = pack4_fp8(swiglu1(g1[0], l1[0]) * FP8_SA, swiglu1(g1[1], l1[1]) * FP8_SA, swiglu1(g1[2], l1[2]) * FP8_SA, swiglu1(g1[3], l1[3]) * FP8_SA);
                *(u32x2_t*)rowp = w; }
    }
};
struct EpiDown {
    static constexpr bool PERM = true; static constexpr int NST = 16;
    unsigned char* Y; const float* bdn; const float* lgt; const PG8_LAS int* cnt; int Ttok; float ascale;
    __device__ __forceinline__ void operator()(const f32x4 (&acc)[2][2][4][2], const Unit& u, int wr, int wc, int fr, int fq) const {
        const int rl = wr * 64 + fr, col0 = u.pn * BM + wc * 32 + 8 * fq; const int ce = cnt[u.e];
        const float* bb = bdn + (size_t)u.e * 1024 + col0; const float* gp = lgt + (size_t)u.e * Ttok + u.lrow0;
        f32x4 bv[2][2];
#pragma unroll
        for (int bj = 0; bj < 2; ++bj)
#pragma unroll
            for (int n = 0; n < 2; ++n) bv[bj][n] = *(const f32x4*)(bb + bj * HALF + 4 * n);
#pragma unroll
        for (int ai = 0; ai < 2; ++ai)
#pragma unroll
            for (int m = 0; m < 4; ++m) { const int r = rl + ai * HALF + m * 16; const float gt = (u.lrow0 + r < ce) ? gp[r] * FP8_SY : 0.f;
                unsigned char* rowp = Y + (size_t)(u.pm * BM + r) * 1024 + col0;
#pragma unroll
                for (int bj = 0; bj < 2; ++bj) { const f32x4 v0 = (acc[ai][bj][m][0] * ascale + bv[bj][0]) * gt, v1 = (acc[ai][bj][m][1] * ascale + bv[bj][1]) * gt;
                    typedef unsigned u32x2_t __attribute__((ext_vector_type(2))); u32x2_t w; w.x = pack4_fp8(v0[0], v0[1], v0[2], v0[3]); w.y = pack4_fp8(v1[0], v1[1], v1[2], v1[3]);
                    *(u32x2_t*)(rowp + bj * HALF) = w; } }
    }
};

typedef int v4i_t __attribute__((ext_vector_type(4)));
typedef int v8i_t __attribute__((ext_vector_type(8)));
template <class Epi, class Sched, bool ALIGN_EPI, bool GATHER, bool FP8 = false, int ABL = 0, bool SP2 = true>
__device__ __forceinline__ void gemm_phase(PG8_LAS unsigned char* lds, const Gemm g, const Sched& S, const Epi& E, const PG8_LAS unsigned* tab, volatile PG8_LAS unsigned* prb = nullptr) {
    const int tid = threadIdx.x, wid = __builtin_amdgcn_readfirstlane(tid >> 6), lane = tid & 63, wr = wid >> 2, wc = wid & 3, fr = lane & 15, fq = lane >> 4;
    const int K = g.K, nt = K / BK;
    unsigned voffA[2], voffB[2], cby[2]; int rsl[2];
#pragma unroll
    for (int i = 0; i < 2; ++i) { int R, C; stage_rc(tid * 16 + i * 8192, R, C); const int Rb = Epi::PERM ? ((R & ~31) + perm32(R & 31)) : R;
        voffA[i] = (unsigned)(R * K + C) * 2u; voffB[i] = (unsigned)(Rb * K + C) * 2u; rsl[i] = R; cby[i] = (unsigned)C * 2u; }
    const size_t kstep = (size_t)(BK * 2);
    const size_t hstep = (size_t)HALF * K * 2;
    const size_t tstep = 2 * hstep;
    const size_t ahstep = GATHER ? 0 : hstep;
    const unsigned ldsw = (unsigned)wid * 1024u;
    const int aoff0 = lds_byte(wr * 64 + fr, fq * 8), aoff1 = lds_byte(wr * 64 + fr, 32 + fq * 8), boff0 = lds_byte(wc * 32 + fr, fq * 8), boff1 = lds_byte(wc * 32 + fr, 32 + fq * 8);
#define PG8_SA(b, h) (((b) * 2 + (h)) * HTB)
#define PG8_SB(b, h) ((4 + (b) * 2 + (h)) * HTB)
#define PG8_STAGE(bufoff, gbase, voff) do { if constexpr (ABL != 2 && ABL != 4) _Pragma("unroll") for (int _i = 0; _i < 2; ++_i) \
        __builtin_amdgcn_global_load_lds((const unsigned*)((const char*)(gbase) + (voff)[_i]), (PG8_LAS unsigned*)(lds + (bufoff) + ldsw + _i * 8192), 16, 0, 0); } while (0)
#define PG8_LD16(off) (*(const PG8_LAS v4i_t*)(lds + (off)))
#define PG8_LDA(dst, b, h) do { if constexpr (ABL != 3 && ABL != 4) _Pragma("unroll") for (int m = 0; m < 4; ++m) { if constexpr (FP8) dst##8[m] = __builtin_shufflevector(PG8_LD16(PG8_SA(b, h) + aoff0 + m * 2048), PG8_LD16(PG8_SA(b, h) + aoff1 + m * 2048), 0, 1, 2, 3, 4, 5, 6, 7); \
        else { _Pragma("unroll") for (int k = 0; k < 2; ++k) dst[m][k] = *(const PG8_LAS bf16x8*)(lds + PG8_SA(b, h) + (k ? aoff1 : aoff0) + m * 2048); } } } while (0)
#define PG8_LDB(dst, b, h) do { if constexpr (ABL != 3 && ABL != 4) _Pragma("unroll") for (int n = 0; n < 2; ++n) { if constexpr (FP8) dst##8[n] = __builtin_shufflevector(PG8_LD16(PG8_SB(b, h) + boff0 + n * 2048), PG8_LD16(PG8_SB(b, h) + boff1 + n * 2048), 0, 1, 2, 3, 4, 5, 6, 7); \
        else { _Pragma("unroll") for (int k = 0; k < 2; ++k) dst[n][k] = *(const PG8_LAS bf16x8*)(lds + PG8_SB(b, h) + (k ? boff1 : boff0) + n * 2048); } } } while (0)
#define PG8_MMA(ai, bj, At, Bt) do { if constexpr (ABL == 1) { if constexpr (FP8) { _Pragma("unroll") for (int m = 0; m < 4; ++m) asm volatile("" :: "v"(At##8[m])); _Pragma("unroll") for (int n = 0; n < 2; ++n) asm volatile("" :: "v"(Bt##8[n])); } } else { \
        __builtin_amdgcn_s_setprio(1); _Pragma("unroll") for (int m = 0; m < 4; ++m) _Pragma("unroll") for (int n = 0; n < 2; ++n) { \
        if constexpr (FP8) asm volatile("v_mfma_f32_16x16x128_f8f6f4 %0, %1, %2, %0" : "+v"(acc[ai][bj][m][n]) : "v"(Bt##8[n]), "v"(At##8[m]));   \
        else { _Pragma("unroll") for (int k = 0; k < 2; ++k) acc[ai][bj][m][n] = __builtin_amdgcn_mfma_f32_16x16x32_bf16(Bt[n][k], At[m][k], acc[ai][bj][m][n], 0, 0, 0); } } \
        __builtin_amdgcn_s_setprio(0); } } while (0)
#define PG8_WAIT_V(n) asm volatile("s_waitcnt vmcnt(" #n ")" ::: "memory")
#define PG8_WAIT_L(n) asm volatile("s_waitcnt lgkmcnt(" #n ")" ::: "memory")
#define PG8_WAIT_V8X(relax) asm volatile("s_cmp_eq_u32 %0, 0\n\ts_cbranch_scc1 1f\n\ts_waitcnt vmcnt(%1)\n\ts_branch 2f\n1:\n\ts_waitcnt vmcnt(8)\n2:" :: "s"(relax), "n"(8 + Epi::NST) : "memory", "scc")
#define PG8_BAR __builtin_amdgcn_s_barrier()
#define PG8_SCHED __builtin_amdgcn_sched_barrier(0)
    Unit cur, nxt; int ui = 0;
    if (!S.next(0, cur)) return;
    f32x4 acc[2][2][4][2];
#pragma unroll
    for (int a = 0; a < 2; ++a)
#pragma unroll
        for (int b = 0; b < 2; ++b)
#pragma unroll
            for (int m = 0; m < 4; ++m)
#pragma unroll
                for (int n = 0; n < 2; ++n) acc[a][b][m][n] = (f32x4){0.f, 0.f, 0.f, 0.f};
    bf16x8 At[4][2] = {}, B0[2][2] = {}, B1[2][2] = {}; v8i_t At8[4] = {}, B08[2] = {}, B18[2] = {};
    const char* cA = GATHER ? (const char*)g.A : (const char*)g.A + (size_t)cur.pm * tstep; const char* cB = (const char*)g.Bt + cur.boff + (size_t)cur.pn * tstep;
    unsigned cv0[2], cv1[2], nv0[2], nv1[2];
#pragma unroll
    for (int i = 0; i < 2; ++i) { if constexpr (GATHER) { cv0[i] = tab[rsl[i]] + cby[i]; cv1[i] = tab[HALF + rsl[i]] + cby[i]; } else { cv0[i] = voffA[i]; cv1[i] = voffA[i]; } nv0[i] = cv0[i]; nv1[i] = cv1[i]; }
    if constexpr (SP2) { PG8_STAGE(PG8_SB(0, 0), cB, voffB); PG8_STAGE(PG8_SB(0, 1), cB + hstep, voffB); PG8_STAGE(PG8_SA(0, 0), cA, cv0); PG8_STAGE(PG8_SA(0, 1), cA + ahstep, cv1);
        if (wr == 1) PG8_BAR;
        PG8_WAIT_V(2); PG8_BAR; }
    else { PG8_STAGE(PG8_SB(0, 0), cB, voffB); PG8_STAGE(PG8_SA(0, 0), cA, cv0); PG8_STAGE(PG8_SB(0, 1), cB + hstep, voffB); PG8_STAGE(PG8_SA(0, 1), cA + ahstep, cv1);
        if (wr == 1) PG8_BAR;
        PG8_WAIT_V(4); PG8_BAR; }
    PG8_STAGE(PG8_SB(1, 0), cB + kstep, voffB); PG8_STAGE(PG8_SA(1, 0), cA + kstep, cv0); PG8_STAGE(PG8_SB(1, 1), cB + hstep + kstep, voffB);
    PG8_WAIT_V(6); PG8_BAR;
    for (;;) {
        const bool has_next = S.next(ui + 1, nxt);
        const char* nA = has_next ? (GATHER ? (const char*)g.A : (const char*)g.A + (size_t)nxt.pm * tstep) : cA; const char* nB = has_next ? (const char*)g.Bt + nxt.boff + (size_t)nxt.pn * tstep : cB;
        if constexpr (GATHER) {
#pragma unroll
            for (int i = 0; i < 2; ++i) { if (has_next) { nv0[i] = tab[(ui + 1) * BM + rsl[i]] + cby[i]; nv1[i] = tab[(ui + 1) * BM + HALF + rsl[i]] + cby[i]; } else { nv0[i] = cv0[i]; nv1[i] = cv1[i]; } }
        }
        for (int t = 0; t < nt; t += 2) {
            const bool last = (t == nt - 2);
            const char* a1 = cA + (size_t)(t + 1) * kstep;
            const char* a2 = last ? nA : cA + (size_t)(t + 2) * kstep; const char* b2 = last ? nB : cB + (size_t)(t + 2) * kstep;
            const char* a3 = a2 + kstep; const char* b3 = b2 + kstep;
            unsigned s0[2], s1[2];
#pragma unroll
            for (int i = 0; i < 2; ++i) { s0[i] = last ? nv0[i] : cv0[i]; s1[i] = last ? nv1[i] : cv1[i]; }
            if constexpr (SP2) {
            PG8_LDB(B0, 0, 0); PG8_LDB(B1, 0, 1); PG8_SCHED; PG8_LDA(At, 0, 0); PG8_STAGE(PG8_SA(1, 1), a1 + ahstep, cv1);
            PG8_WAIT_V(8); PG8_WAIT_L(0); PG8_BAR; PG8_MMA(0, 0, At, B0); PG8_MMA(0, 1, At, B1); PG8_BAR; PG8_SCHED;
            PG8_LDA(At, 0, 1); PG8_STAGE(PG8_SB(0, 0), b2, voffB); PG8_STAGE(PG8_SB(0, 1), b2 + hstep, voffB); PG8_STAGE(PG8_SA(0, 0), a2, s0);
            PG8_WAIT_V(8); PG8_WAIT_L(0); PG8_BAR; PG8_MMA(1, 0, At, B0); PG8_MMA(1, 1, At, B1); PG8_BAR; PG8_SCHED;
            PG8_LDB(B0, 1, 0); PG8_LDB(B1, 1, 1); PG8_SCHED; PG8_LDA(At, 1, 0); PG8_STAGE(PG8_SA(0, 1), a2 + ahstep, s1);
            PG8_WAIT_V(8); PG8_WAIT_L(0); PG8_BAR; PG8_MMA(0, 0, At, B0); PG8_MMA(0, 1, At, B1); PG8_BAR; PG8_SCHED;
            PG8_LDA(At, 1, 1); PG8_STAGE(PG8_SB(1, 0), b3, voffB); PG8_STAGE(PG8_SB(1, 1), b3 + hstep, voffB); PG8_STAGE(PG8_SA(1, 0), a3, s0);
            PG8_WAIT_V(8); PG8_WAIT_L(0); PG8_BAR; PG8_MMA(1, 0, At, B0); PG8_MMA(1, 1, At, B1); PG8_BAR; PG8_SCHED;
            } else {
            PG8_LDB(B0, 0, 0); PG8_SCHED; PG8_LDA(At, 0, 0); PG8_STAGE(PG8_SA(1, 1), a1 + ahstep, cv1);
            PG8_WAIT_L(8); PG8_BAR; PG8_WAIT_L(0); PG8_MMA(0, 0, At, B0); PG8_BAR; PG8_SCHED;
            PG8_LDB(B1, 0, 1); PG8_STAGE(PG8_SB(0, 0), b2, voffB);
            PG8_BAR; PG8_WAIT_L(0); PG8_MMA(0, 1, At, B1); PG8_BAR;
            PG8_LDA(At, 0, 1); PG8_STAGE(PG8_SA(0, 0), a2, s0);
            PG8_BAR; PG8_WAIT_L(0); PG8_MMA(1, 0, At, B0); PG8_BAR; PG8_SCHED;
            PG8_STAGE(PG8_SB(0, 1), b2 + hstep, voffB);
            PG8_WAIT_V(6); PG8_BAR; PG8_MMA(1, 1, At, B1); PG8_BAR;
            PG8_LDB(B0, 1, 0); PG8_SCHED; PG8_LDA(At, 1, 0); PG8_STAGE(PG8_SA(0, 1), a2 + ahstep, s1);
            PG8_WAIT_L(8); PG8_BAR; PG8_WAIT_L(0); PG8_MMA(0, 0, At, B0); PG8_BAR; PG8_SCHED;
            PG8_LDB(B1, 1, 1); PG8_STAGE(PG8_SB(1, 0), b3, voffB);
            PG8_BAR; PG8_WAIT_L(0); PG8_MMA(0, 1, At, B1); PG8_BAR;
            PG8_LDA(At, 1, 1); PG8_STAGE(PG8_SA(1, 0), a3, s0);
            PG8_BAR; PG8_WAIT_L(0); PG8_MMA(1, 0, At, B0); PG8_BAR; PG8_SCHED;
            PG8_STAGE(PG8_SB(1, 1), b3 + hstep, voffB);
            PG8_WAIT_V(6); PG8_BAR; PG8_MMA(1, 1, At, B1); PG8_BAR;
            }
        }
        unsigned long long pt0_ = 0; if (prb) pt0_ = __builtin_amdgcn_s_memrealtime();
        if constexpr (FP8) asm volatile("s_nop 15\n\ts_nop 7" ::: "memory");
        if constexpr (ALIGN_EPI) { if (wr == 0) PG8_BAR; }
        E(acc, cur, wr, wc, fr, fq);
        if (prb) { asm volatile("s_waitcnt vmcnt(0)" ::: "memory"); if (threadIdx.x == 0) prb[0] += (unsigned)(__builtin_amdgcn_s_memrealtime() - pt0_); }
        if (!has_next) break;
#pragma unroll
        for (int a = 0; a < 2; ++a)
#pragma unroll
            for (int b = 0; b < 2; ++b)
#pragma unroll
                for (int m = 0; m < 4; ++m)
#pragma unroll
                    for (int n = 0; n < 2; ++n) acc[a][b][m][n] = (f32x4){0.f, 0.f, 0.f, 0.f};
        cur = nxt; cA = nA; cB = nB; ++ui;
#pragma unroll
        for (int i = 0; i < 2; ++i) { cv0[i] = nv0[i]; cv1[i] = nv1[i]; }
        if constexpr (ALIGN_EPI) { if (wr == 1) PG8_BAR; }
    }
    PG8_WAIT_V(0);
    if constexpr (!ALIGN_EPI) { if (wr == 0) PG8_BAR; }
    PG8_BAR;
#undef PG8_SA
#undef PG8_SB
#undef PG8_STAGE
#undef PG8_LDA
#undef PG8_LD16
#undef PG8_LDB
#undef PG8_MMA
#undef PG8_WAIT_V
#undef PG8_WAIT_L
#undef PG8_WAIT_V8X
#undef PG8_BAR
#undef PG8_SCHED
}
}
#include <hip/hip_bf16.h>
#include <cmath>
namespace attn_body {
using bf16=__hip_bfloat16;
using bf16x8=__attribute__((ext_vector_type(8)))short;
using s16x4=__attribute__((ext_vector_type(4)))short;
using f32x16=__attribute__((ext_vector_type(16)))float;
using u32x4=__attribute__((ext_vector_type(4)))unsigned;
constexpr int BATCH=4,NHEAD=8,SEQ=8192,D=64,DM=NHEAD*D,ODM=1024;
constexpr int NW=8,QBLK=32,QB=QBLK*NW,KVBLK=64,NQB=SEQ/QB;
constexpr int ATTN_PITCH=DM, ATTN_UNIT_ROWS=QB;
__device__ __forceinline__ int crow(int r,int hi){return (r&3)+8*(r>>2)+4*hi;}
#define SBAR() __builtin_amdgcn_sched_barrier(0)
__device__ __forceinline__ void cmask(f32x16&p0,f32x16&p1,int jb,int qrel,int hi){
  const float NEG=-INFINITY; int kb=64*jb+4*hi;
  #pragma unroll
  for(int r=0;r<16;++r){int kv=kb+(r&3)+8*(r>>2); if(kv>qrel)p0[r]=NEG; if(kv+32>qrel)p1[r]=NEG;}
}

constexpr int NSLOT=3, SLOTB=8192;
constexpr int LDS_K=0, LDS_V=NSLOT*SLOTB, LDS_WS=2*NSLOT*SLOTB, LDS_OST=LDS_WS+NW*64*4, LDS_C2=LDS_OST+NW*4096, LDS_BYTES=LDS_C2+SEQ*4;
constexpr float C2=0.125f*1.4426950408889634f;
__device__ __forceinline__ void glds16(const void*gsrc,unsigned lds_dst){unsigned keep;
  asm volatile("s_mov_b32 %0, m0\n\ts_mov_b32 m0, %2\n\ts_nop 0\n\tglobal_load_lds_dwordx4 %1, off\n\ts_mov_b32 m0, %0":"=&s"(keep):"v"(gsrc),"s"(lds_dst):"memory");}
__device__ __forceinline__ float max3f(float a,float b,float c){float r;asm("v_max3_f32 %0, %1, %2, %3":"=v"(r):"v"(a),"v"(b),"v"(c));return r;}
__device__ __forceinline__ float max2f(float a,float b){float r;asm("v_max_f32_e32 %0, %1, %2":"=v"(r):"v"(a),"v"(b));return r;}
__device__ __forceinline__ float fadd_s(float a,float b){float r;asm("v_add_f32_e32 %0, %1, %2":"=v"(r):"v"(a),"v"(b));return r;}
__device__ __forceinline__ float fsub_s(float a,float b){float r;asm("v_sub_f32_e32 %0, %1, %2":"=v"(r):"v"(a),"v"(b));return r;}
typedef float f32x2_t __attribute__((ext_vector_type(2))); typedef float f32x4_t __attribute__((ext_vector_type(4))); typedef __bf16 bf16x2_t __attribute__((ext_vector_type(2)));
__device__ __forceinline__ unsigned cvtpk_s(float lo,float hi){f32x2_t v={lo,hi};bf16x2_t b=__builtin_convertvector(v,bf16x2_t);return __builtin_bit_cast(unsigned,b);}
#define WAIT_BAR(N) asm volatile("s_waitcnt vmcnt(" #N ") lgkmcnt(0)\n\ts_barrier":::"memory")

__device__ __forceinline__ void qkt(f32x16&p0,f32x16&p1,const char*Kslot,const bf16x8*qr,const f32x16&cin0,const f32x16&cin1,int r32,int hi){
  const char*kb=Kslot+hi*1024+r32*16;
  #pragma unroll
  for(int d0=0;d0<4;++d0){
    const bf16x8 b0=*reinterpret_cast<const bf16x8*>(kb+d0*2048);
    const bf16x8 b1=*reinterpret_cast<const bf16x8*>(kb+d0*2048+512);
    if(d0==0){p0=__builtin_amdgcn_mfma_f32_32x32x16_bf16(b0,qr[0],cin0,0,0,0);p1=__builtin_amdgcn_mfma_f32_32x32x16_bf16(b1,qr[0],cin1,0,0,0);}
    else{p0=__builtin_amdgcn_mfma_f32_32x32x16_bf16(b0,qr[d0],p0,0,0,0);p1=__builtin_amdgcn_mfma_f32_32x32x16_bf16(b1,qr[d0],p1,0,0,0);}}
}
typedef __attribute__((address_space(3))) const char* lds_cptr;
typedef short v4i16_t __attribute__((ext_vector_type(4)));
__device__ __forceinline__ void kload8(bf16x8*kf,lds_cptr kp){
  kf[0]=*(const __attribute__((address_space(3))) bf16x8*)(kp);      kf[1]=*(const __attribute__((address_space(3))) bf16x8*)(kp+512);
  kf[2]=*(const __attribute__((address_space(3))) bf16x8*)(kp+2048); kf[3]=*(const __attribute__((address_space(3))) bf16x8*)(kp+2560);
  kf[4]=*(const __attribute__((address_space(3))) bf16x8*)(kp+4096); kf[5]=*(const __attribute__((address_space(3))) bf16x8*)(kp+4608);
  kf[6]=*(const __attribute__((address_space(3))) bf16x8*)(kp+6144); kf[7]=*(const __attribute__((address_space(3))) bf16x8*)(kp+6656);
}
__device__ __forceinline__ void kload2(bf16x8*kf,lds_cptr kp,int j){ kf[2*j]=*(const __attribute__((address_space(3))) bf16x8*)(kp+j*2048); kf[2*j+1]=*(const __attribute__((address_space(3))) bf16x8*)(kp+j*2048+512); }
__device__ __forceinline__ s16x4 vtr(lds_cptr p){ return __builtin_bit_cast(s16x4,__builtin_amdgcn_ds_read_tr16_b64_v4i16((__attribute__((address_space(3))) v4i16_t*)p)); }
__device__ __forceinline__ float rowmax(const f32x16&p0,const f32x16&p1){
  float a=max3f(p0[0],p0[1],p1[0]),b=max3f(p0[2],p0[3],p1[1]);a=max3f(a,p1[2],p1[3]);
  #pragma unroll
  for(int r=4;r<16;r+=4){a=max3f(a,p0[r],p0[r+1]);b=max3f(b,p0[r+2],p0[r+3]);a=max3f(a,p1[r],p1[r+1]);b=max3f(b,p1[r+2],p1[r+3]);}
  const float m=max2f(a,b);
  auto rr=__builtin_amdgcn_permlane32_swap(__float_as_uint(m),__float_as_uint(m),false,false);
  return max2f(__uint_as_float(rr[0]),__uint_as_float(rr[1]));
}
__device__ __forceinline__ void pv(f32x16*o,int vb,bf16x8 pa0,bf16x8 pa1,bf16x8 pa2,bf16x8 pa3){
  #pragma unroll
  for(int d0=0;d0<2;++d0){s16x4 lo[4],hi[4];
    #pragma unroll
    for(int ks=0;ks<4;++ks){
      asm volatile("ds_read_b64_tr_b16 %0,%1 offset:%c2":"=&v"(lo[ks]):"v"(vb),"i"(d0*4096+ks*1024):"memory");
      asm volatile("ds_read_b64_tr_b16 %0,%1 offset:%c2":"=&v"(hi[ks]):"v"(vb),"i"(d0*4096+ks*1024+512):"memory");}
    asm volatile("s_waitcnt lgkmcnt(0)":::"memory");SBAR();
    #define PK(k) (bf16x8){lo[k][0],lo[k][1],lo[k][2],lo[k][3],hi[k][0],hi[k][1],hi[k][2],hi[k][3]}
    o[d0]=__builtin_amdgcn_mfma_f32_32x32x16_bf16(pa0,PK(0),o[d0],0,0,0);
    o[d0]=__builtin_amdgcn_mfma_f32_32x32x16_bf16(pa1,PK(1),o[d0],0,0,0);
    o[d0]=__builtin_amdgcn_mfma_f32_32x32x16_bf16(pa2,PK(2),o[d0],0,0,0);
    o[d0]=__builtin_amdgcn_mfma_f32_32x32x16_bf16(pa3,PK(3),o[d0],0,0,0);
    #undef PK
  }
}

#ifndef ATTN_STORE16
#define ATTN_STORE16(p,v) (*(u32x4*)(p)=(v))
#endif
template<int THRL> __device__ __forceinline__ void attn_unit(int b,int h,int qb,const bf16*Q,const bf16*__restrict__ K,const bf16*__restrict__ V,bf16*O,char*shm,int j0,unsigned*attn_probe_ctr=nullptr){
  const int tid=threadIdx.x,lane=tid&63,r32=lane&31,hi=lane>>5; const int wid=__builtin_amdgcn_readfirstlane(tid>>6);
  const long rowbase=(long)b*SEQ; const int q0=qb*QB;
  const bf16*Qw=Q+(rowbase+q0+wid*QBLK)*DM+h*D;
  const bf16*Kh=K+rowbase*DM+h*D,*Vh=V+rowbase*DM+h*D;
  const unsigned lds0=(unsigned)(uintptr_t)shm; const lds_cptr shm3=(lds_cptr)shm;
  float*wsf=(float*)(shm+LDS_WS)+wid*64;
  const bf16*ksrc=Kh+(long)lane*DM+wid*8;
  const bf16*vsrc=Vh+(long)(16*(wid&3)+(lane>>2))*DM+(wid>>2)*32+(lane&3)*8;
  const unsigned kdst=lds0+LDS_K+wid*1024, vdst=lds0+LDS_V+wid*1024;
  #define DMA_K(t,slot) glds16(ksrc+(long)(t)*KVBLK*DM,(unsigned)__builtin_amdgcn_readfirstlane(kdst+(slot)))
  #define DMA_V(t,slot) glds16(vsrc+(long)(t)*KVBLK*DM,(unsigned)__builtin_amdgcn_readfirstlane(vdst+(slot)))
  const int vb0=(int)(lds0+LDS_V)+((lane>>4)&1)*32+(lane&3)*8+(4*hi+((lane&15)>>2))*64;
  const char*Kbase=shm+LDS_K; bf16x8 kf[8];
  const lds_cptr kp0=shm3+LDS_K+hi*1024+r32*16; const lds_cptr vp0=shm3+LDS_V+((lane>>4)&1)*32+(lane&3)*8+(4*hi+((lane&15)>>2))*64;
  const int NT=(q0+QB)/KVBLK;
  if(attn_probe_ctr && threadIdx.x==0) atomicAdd(attn_probe_ctr, (unsigned)(NT-j0));
  DMA_K(j0,0);DMA_V(j0,0);DMA_K(j0+1,SLOTB);
  bf16x8 qr[4];
  #pragma unroll
  for(int d0=0;d0<4;++d0)qr[d0]=*reinterpret_cast<const bf16x8*>(&Qw[(long)r32*DM+d0*16+hi*8]);
  float l_reg=0.f;f32x16 o[2];o[0]=f32x16{};o[1]=f32x16{};
  typedef __attribute__((address_space(3))) const f32x4_t* lds_f4ptr; const lds_f4ptr c2p=(lds_f4ptr)(shm3+LDS_C2)+hi;
  float ctm=((const __attribute__((address_space(3))) float*)(shm3+LDS_C2))[q0+wid*QBLK+r32];
  f32x16 cin0,cin1;
  #define CIN(t) do{ const lds_f4ptr cq_=c2p+16*(t); const f32x4_t a0_=cq_[0],a1_=cq_[2],a2_=cq_[4],a3_=cq_[6],b0_=cq_[8],b1_=cq_[10],b2_=cq_[12],b3_=cq_[14]; \
    _Pragma("unroll") for(int j_=0;j_<4;++j_){ cin0[j_]=ctm-a0_[j_];cin0[4+j_]=ctm-a1_[j_];cin0[8+j_]=ctm-a2_[j_];cin0[12+j_]=ctm-a3_[j_]; cin1[j_]=ctm-b0_[j_];cin1[4+j_]=ctm-b1_[j_];cin1[8+j_]=ctm-b2_[j_];cin1[12+j_]=ctm-b3_[j_]; } }while(0)
  const int qrel=wid*QBLK+r32;
  #define CMASK(P0,P1,t) do{int jb_=(t)-(NT-4); if(jb_>=0)cmask(P0,P1,jb_,qrel,hi);}while(0)
  bool resc=false;
  #define START(P0,P1) do{ const float rm=rowmax(P0,P1); resc=false; \
    if(__any(rm>(float)THRL)){ const float dl=__builtin_fmaxf(rm,0.f); ctm-=dl; \
      _Pragma("unroll") for(int r=0;r<16;++r){P0[r]-=dl;P1[r]-=dl;} } \
    _Pragma("unroll") for(int r=0;r<16;++r)P0[r]=__builtin_amdgcn_exp2f(P0[r]); }while(0)
  #define RESC() do{ if(resc){ asm volatile("s_waitcnt lgkmcnt(0)":::"memory"); \
      _Pragma("unroll") for(int d_=0;d_<2;++d_) _Pragma("unroll") for(int r=0;r<16;++r)o[d_][r]*=wsf[crow(r,hi)]; } }while(0)
  f32x16 pA0,pA1,pB0,pB1;
  int sl_prev=0,sl_cur=0,sl_next=SLOTB;
  #define ROT() do{sl_prev=sl_cur;sl_cur=sl_next;sl_next=(sl_next==(NSLOT-1)*SLOTB)?0:sl_next+SLOTB;}while(0)
  DMA_K(j0+2,2*SLOTB);
  WAIT_BAR(3);
  CIN(j0); qkt(pA0,pA1,Kbase,qr,cin0,cin1,r32,hi);asm volatile("s_nop 15\n\ts_nop 7":"+v"(pA0),"+v"(pA1));CMASK(pA0,pA1,j0);
  START(pA0,pA1);
  _Pragma("unroll") for(int r=0;r<16;++r)pA1[r]=__builtin_amdgcn_exp2f(pA1[r]);
  WAIT_BAR(0);
  DMA_K(j0+3,0);DMA_V(j0+1,SLOTB);
  ROT();
  kload8(kf,kp0+sl_cur);
  WAIT_BAR(2);
  s16x4 vlo[8],vhi[8]; u32x4 pw0,pw1,pw2,pw3;
  #define PKW(P,B) cvtpk_s(P[B],P[B+1])
  #define PAF(k) __builtin_bit_cast(bf16x8,pw##k)
  #define VFR(i) (bf16x8){vlo[i][0],vlo[i][1],vlo[i][2],vlo[i][3],vhi[i][0],vhi[i][1],vhi[i][2],vhi[i][3]}
  #define PIN(x) asm volatile("":"+v"(x))
  #define MX3(a,b,c) __builtin_fmaxf(__builtin_fmaxf((a),(b)),(c))
  #define GAPA(MF,A0,A1,A2,A3,W0,W1,PW) do{ MF; sacc+=A0; sacc+=A1; sacc+=A2; sacc+=A3; PIN(sacc); W0; W1; PIN(PW); SBAR(); }while(0)
  #define EX(v) __builtin_amdgcn_exp2f(v)
  #define GAPB(MF,X,B) do{ MF; X[B]=EX(X[B]); X[B+1]=EX(X[B+1]); X[B+2]=EX(X[B+2]); X[B+3]=EX(X[B+3]); PIN(X); SBAR(); }while(0)
  #define VRD(i) do{ vlo[i]=vtr(vp_+(((i)>>2)*4096+((i)&3)*1024)); vhi[i]=vtr(vp_+(((i)>>2)*4096+((i)&3)*1024+512)); }while(0)
  #define KRD(G,j) do{ if(G){ kload2(kf,kp0+sl_next,j); SBAR(); } }while(0)
  #define STEP(C0,C1,P0,P1,t,GK,GV,GL) do{ SBAR(); CIN(t); SBAR(); \
    const lds_cptr vp_=vp0+sl_prev; \
    VRD(0); SBAR(); float sacc=(P0[0]+P0[1]); \
    GAPA(C0=__builtin_amdgcn_mfma_f32_32x32x16_bf16(kf[0],qr[0],cin0,0,0,0), P0[2],P0[3],P0[4],P0[5],     pw0[0]=PKW(P0,0), pw0[1]=PKW(P0,2), pw0); \
    VRD(4); SBAR(); GAPA(C1=__builtin_amdgcn_mfma_f32_32x32x16_bf16(kf[1],qr[0],cin1,0,0,0), P0[6],P0[7],P0[8],P0[9],     pw0[2]=PKW(P0,4), pw0[3]=PKW(P0,6), pw0); \
    VRD(1); SBAR(); GAPA(C0=__builtin_amdgcn_mfma_f32_32x32x16_bf16(kf[2],qr[1],C0,0,0,0),   P0[10],P0[11],P0[12],P0[13], pw1[0]=PKW(P0,8), pw1[1]=PKW(P0,10), pw1); \
    VRD(5); SBAR(); GAPA(C1=__builtin_amdgcn_mfma_f32_32x32x16_bf16(kf[3],qr[1],C1,0,0,0),   P0[14],P0[15],P1[0],P1[1],   pw1[2]=PKW(P0,12),pw1[3]=PKW(P0,14), pw1); \
    VRD(2); SBAR(); GAPA(C0=__builtin_amdgcn_mfma_f32_32x32x16_bf16(kf[4],qr[2],C0,0,0,0),   P1[2],P1[3],P1[4],P1[5],     pw2[0]=PKW(P1,0), pw2[1]=PKW(P1,2), pw2); \
    VRD(6); SBAR(); GAPA(C1=__builtin_amdgcn_mfma_f32_32x32x16_bf16(kf[5],qr[2],C1,0,0,0),   P1[6],P1[7],P1[8],P1[9],     pw2[2]=PKW(P1,4), pw2[3]=PKW(P1,6), pw2); \
    VRD(3); SBAR(); GAPA(C0=__builtin_amdgcn_mfma_f32_32x32x16_bf16(kf[6],qr[3],C0,0,0,0),   P1[10],P1[11],P1[12],P1[13], pw3[0]=PKW(P1,8), pw3[1]=PKW(P1,10), pw3); \
    VRD(7); SBAR(); GAPA(C1=__builtin_amdgcn_mfma_f32_32x32x16_bf16(kf[7],qr[3],C1,0,0,0),   P1[14],P1[15],0.f,0.f,       pw3[2]=PKW(P1,12),pw3[3]=PKW(P1,14), pw3); \
    l_reg+=sacc; \
    if(GK){DMA_K((t)+3,sl_cur);} if(GV){DMA_V((t)+1,sl_next);} \
    CMASK(C0,C1,t); \
    { float a=MX3(C0[0],C0[1],C1[0]),b=MX3(C0[2],C0[3],C1[1]); a=MX3(a,C1[2],C1[3]); \
      _Pragma("unroll") for(int r=4;r<16;r+=4){a=MX3(a,C0[r],C0[r+1]);b=MX3(b,C0[r+2],C0[r+3]);a=MX3(a,C1[r],C1[r+1]);b=MX3(b,C1[r+2],C1[r+3]);} \
      float rm=__builtin_fmaxf(a,b); { auto rr=__builtin_amdgcn_permlane32_swap(__float_as_uint(rm),__float_as_uint(rm),false,false); rm=__builtin_fmaxf(__uint_as_float(rr[0]),__uint_as_float(rr[1])); } \
      resc=false; \
      if(__builtin_expect(__any(rm>(float)THRL),0)){ const float dl=__builtin_fmaxf(rm,0.f); ctm-=dl; \
        _Pragma("unroll") for(int r=0;r<16;++r){C0[r]-=dl;C1[r]-=dl;} \
        const float f=__builtin_amdgcn_exp2f(-dl); l_reg*=f; if(hi==0)wsf[r32]=f; resc=true; } } \
    SBAR(); \
    GAPB(o[0]=__builtin_amdgcn_mfma_f32_32x32x16_bf16(PAF(0),VFR(0),o[0],0,0,0), C0,0); \
    GAPB(o[1]=__builtin_amdgcn_mfma_f32_32x32x16_bf16(PAF(0),VFR(4),o[1],0,0,0), C0,4); \
    KRD(GL,0); GAPB(o[0]=__builtin_amdgcn_mfma_f32_32x32x16_bf16(PAF(1),VFR(1),o[0],0,0,0), C0,8); \
    KRD(GL,1); GAPB(o[1]=__builtin_amdgcn_mfma_f32_32x32x16_bf16(PAF(1),VFR(5),o[1],0,0,0), C0,12); \
    KRD(GL,2); GAPB(o[0]=__builtin_amdgcn_mfma_f32_32x32x16_bf16(PAF(2),VFR(2),o[0],0,0,0), C1,0); \
    KRD(GL,3); GAPB(o[1]=__builtin_amdgcn_mfma_f32_32x32x16_bf16(PAF(2),VFR(6),o[1],0,0,0), C1,4); \
    GAPB(o[0]=__builtin_amdgcn_mfma_f32_32x32x16_bf16(PAF(3),VFR(3),o[0],0,0,0), C1,8); \
    GAPB(o[1]=__builtin_amdgcn_mfma_f32_32x32x16_bf16(PAF(3),VFR(7),o[1],0,0,0), C1,12); \
    }while(0)
  int t=j0+1;
  #undef CMASK
  #define CMASK(P0,P1,t) do{}while(0)
  for(;t+5<NT;t+=2){
    STEP(pB0,pB1,pA0,pA1,t,true,true,true);     WAIT_BAR(2); RESC(); ROT();
    STEP(pA0,pA1,pB0,pB1,t+1,true,true,true);   WAIT_BAR(2); RESC(); ROT();
  }
  #undef CMASK
  #define CMASK(P0,P1,t) do{int jb_=(t)-(NT-4); if(jb_>=0)cmask(P0,P1,jb_,qrel,hi);}while(0)
  #define ENDW(tt) do{ if((tt)+3<NT){WAIT_BAR(2);} else if((tt)+2<NT){WAIT_BAR(1);} else {WAIT_BAR(0);} }while(0)
  for(;t+1<NT;t+=2){
    STEP(pB0,pB1,pA0,pA1,t,(t+3<NT),(t+1<NT),(t+1<NT));       ENDW(t);   RESC(); ROT();
    STEP(pA0,pA1,pB0,pB1,t+1,(t+4<NT),(t+2<NT),(t+2<NT));     ENDW(t+1); RESC(); ROT();
  }
  STEP(pB0,pB1,pA0,pA1,NT-1,false,false,false); RESC();
  { float sacc=pB0[0]+pB0[1]; _Pragma("unroll") for(int r=2;r<16;++r)sacc+=pB0[r]; _Pragma("unroll") for(int r=0;r<16;++r)sacc+=pB1[r]; l_reg+=sacc;
    pw0=(u32x4){PKW(pB0,0),PKW(pB0,2),PKW(pB0,4),PKW(pB0,6)};pw1=(u32x4){PKW(pB0,8),PKW(pB0,10),PKW(pB0,12),PKW(pB0,14)};pw2=(u32x4){PKW(pB1,0),PKW(pB1,2),PKW(pB1,4),PKW(pB1,6)};pw3=(u32x4){PKW(pB1,8),PKW(pB1,10),PKW(pB1,12),PKW(pB1,14)};
    SBAR(); pv(o,vb0+sl_cur,PAF(0),PAF(1),PAF(2),PAF(3)); }
  #undef PKW
  #undef PAF
  #undef VFR
  #undef PIN
  #undef MX3
  #undef GAPA
  #undef GAPB
  #undef EX
  #undef VRD
  #undef KRD
  #undef STEP
  #undef ENDW
  {auto rr=__builtin_amdgcn_permlane32_swap(__float_as_uint(l_reg),__float_as_uint(l_reg),false,false);l_reg=__uint_as_float(rr[0])+__uint_as_float(rr[1]);}
  if(hi==0)wsf[32+r32]=l_reg;asm volatile("s_waitcnt lgkmcnt(0)":::"memory");
  float rli[16];
  #pragma unroll
  for(int r=0;r<16;++r)rli[r]=__builtin_amdgcn_rcpf(wsf[32+crow(r,hi)]);
  bf16*Ow=O+(rowbase+q0+wid*QBLK)*ODM+h*D;
  { bf16*stg=(bf16*)(shm+LDS_OST)+wid*2048;
    #pragma unroll
    for(int r=0;r<16;++r){const int orow=crow(r,hi);
      #pragma unroll
      for(int d0=0;d0<2;++d0)stg[orow*64+d0*32+r32]=__float2bfloat16(o[d0][r]*rli[r]);}
    asm volatile("s_waitcnt lgkmcnt(0)":::"memory");
    #pragma unroll
    for(int i=0;i<4;++i){const int row=i*8+(lane>>3),ch=lane&7; const u32x4 v=*(const u32x4*)(stg+row*64+ch*8); ATTN_STORE16(Ow+(long)row*ODM+ch*8,v);} }
  asm volatile("s_waitcnt lgkmcnt(0)\n\ts_barrier":::"memory");
  #undef CIN
  #undef DMA_K
  #undef DMA_V
  #undef CMASK
  #undef START
  #undef RESC
  #undef ROT
}
constexpr int ATTN_LDS_BYTES=LDS_BYTES;
struct AttnTensors { const bf16* Q; const bf16* K; const bf16* V; bf16* O; };
struct AttnUnit { int bh; int qb; };
struct StaticOrder {
  int vcu;
  __device__ __forceinline__ explicit StaticOrder(int grid,int block):vcu((block%8)*(grid/8)+block/8){}
  __device__ __forceinline__ bool next(int i,AttnUnit&u)const{ if(i>=4)return false; const int s=vcu&7; u.bh=vcu>>3; u.qb=(i==0)?s:(i==1)?15-s:(i==2)?16+s:31-s; return true; }
  __device__ __forceinline__ void a_ready(const AttnUnit&)const{}
  __device__ __forceinline__ void done(const AttnUnit&)const{}
};
template<class Sched,int THRL=8> __device__ __forceinline__ void attn_phase(char*lds,const AttnTensors&T,const Sched&S,float qkb2){
  AttnUnit u;
  for(int i=0;S.next(i,u);++i){ S.a_ready(u); attn_unit<THRL>(u.bh/NHEAD,u.bh%NHEAD,u.qb,T.Q,T.K,T.V,T.O,lds,qkb2); S.done(u); }
}
#undef SBAR
#undef WAIT_BAR
}
#define GAS __attribute__((address_space(1)))
#define LAS __attribute__((address_space(3)))
typedef GAS unsigned gu32;
#define RLX_AGENT __ATOMIC_RELAXED, __HIP_MEMORY_SCOPE_AGENT
#define LDS_WAIT() asm volatile("s_waitcnt lgkmcnt(0)" ::: "memory")
#define VM_WAIT() asm volatile("s_waitcnt vmcnt(0)" ::: "memory")

constexpr int NWAVES = 8;
constexpr int N_PHASES = 8;
constexpr int RING_OFF = 0, RING_BYTES = 131072;
constexpr int TAB_OFF = 131072, TAB_UNITS = 17;
constexpr int LDS_TOTAL = 155648;
constexpr int LDSCTL_OFF = LDS_TOTAL - 1024;
static_assert(TAB_OFF + TAB_UNITS * 256 * 4 <= LDSCTL_OFF, "LDS map");
constexpr int CW_Q = 128, CW_NRM = 256;
constexpr size_t WS_X1B = WS_P;
constexpr size_t WS_TOT = WS_SEL + 768 * 1024;
constexpr int CW_BAR = 4096;

#define XB_TMO      128
#define XB_XCNT(j)  (256  + 64 * (j))
#define XB_XSUB(j)  (1280 + 64 * (j))
#define XB_XGEN(j)  (2304 + 64 * (j))
#define XB_TOP      3328
#define XB_TOPGEN   3392
#define XCD_BAR_WORDS 3456
#define XB_SPIN_CAP (1u << 18)

__device__ __forceinline__ unsigned xb_ld(unsigned* p)              { return __hip_atomic_load(p, __ATOMIC_RELAXED, __HIP_MEMORY_SCOPE_AGENT); }
__device__ __forceinline__ unsigned xb_add(unsigned* p, unsigned v) { return __hip_atomic_fetch_add(p, v, __ATOMIC_RELAXED, __HIP_MEMORY_SCOPE_AGENT); }
__device__ __forceinline__ unsigned xb_xcc_id() { return (unsigned)__builtin_amdgcn_s_getreg((3 << 11) | 20) & 0xFu; }
#define XB_SPIN(cond, bar) do { unsigned _sp = 0; while (cond) { __builtin_amdgcn_s_sleep(1); \
    if ((++_sp & 255u) == 0u) { if (xb_ld(&(bar)[XB_TMO])) break; if (_sp > XB_SPIN_CAP) { atomicAdd(&(bar)[XB_TMO], 1u); break; } } } } while (0)

struct XcdBarrier {
    unsigned* bar; unsigned x;
    volatile LAS unsigned* st;
};

__device__ __forceinline__ XcdBarrier xcd_barrier_post(unsigned* bar, volatile LAS unsigned* st) {
    XcdBarrier b; b.bar = bar; b.x = xb_xcc_id(); b.st = st;
    if (threadIdx.x == 0) (void)xb_add(&bar[XB_XCNT(b.x)], 1u);
    return b;
}
__device__ __forceinline__ void xcd_barrier_complete(unsigned* bar, unsigned x, unsigned& nloc, unsigned& nx) {
    const unsigned G = gridDim.x * gridDim.y * gridDim.z;
    unsigned sum, cnt, mine, sp = 0u;
    for (;;) {
        sum = 0u; cnt = 0u; mine = 0u;
#pragma unroll
        for (unsigned j = 0; j < 16; ++j) { const unsigned c = xb_ld(&bar[XB_XCNT(j)]); sum += c; cnt += (c > 0u) ? 1u : 0u; mine = (j == x) ? c : mine; }
        if (sum == G) break;
        __builtin_amdgcn_s_sleep(1);
        if ((++sp & 255u) == 0u) { if (xb_ld(&bar[XB_TMO])) break; if (sp > XB_SPIN_CAP) { atomicAdd(&bar[XB_TMO], 1u); break; } }
    }
    nloc = mine > 0u ? mine : 1u; nx = cnt > 0u ? cnt : 1u;
}

__device__ __forceinline__ void xcd_barrier(const XcdBarrier& b) {
    asm volatile("s_waitcnt vmcnt(0)" ::: "memory");
    __syncthreads();
    if (threadIdx.x == 0) {
        unsigned* bar = b.bar;
        __builtin_amdgcn_s_waitcnt(0);
        unsigned nloc = b.st[0], nx = b.st[1];
        if (nloc == 0u) { xcd_barrier_complete(bar, b.x, nloc, nx); b.st[0] = nloc; b.st[1] = nx; }
        const unsigned old = xb_add(&bar[XB_XSUB(b.x)], 1u);
        const unsigned gen = old / nloc;
        if (old + 1u == (gen + 1u) * nloc) {
            __builtin_amdgcn_fence(__ATOMIC_RELEASE, "agent");
            asm volatile("s_waitcnt vmcnt(0)" ::: "memory");
            const unsigned og = xb_add(&bar[XB_TOP], 1u);
            const unsigned tg = og / nx;
            if (og + 1u == (tg + 1u) * nx) xb_add(&bar[XB_TOPGEN], 1u);
            else XB_SPIN(xb_ld(&bar[XB_TOPGEN]) == tg, bar);
            __builtin_amdgcn_fence(__ATOMIC_ACQUIRE, "agent");
            xb_add(&bar[XB_XGEN(b.x)], 1u);
            asm volatile("s_waitcnt vmcnt(0)" ::: "memory");
        } else {
            XB_SPIN(xb_ld(&bar[XB_XGEN(b.x)]) == gen, bar);
            __builtin_amdgcn_fence(__ATOMIC_ACQUIRE, "agent");
            asm volatile("s_waitcnt vmcnt(0)" ::: "memory");
        }
    }
    __syncthreads();
}


#ifndef MK_SP2
#define MK_SP2 true
#endif
#ifndef MK_THRL
#define MK_THRL 8
#endif
struct Args { const float* in[15]; float* out; unsigned char* ws; int ph_lo, ph_hi, use_bar, pad; };

__device__ __forceinline__ void p0_transpose_item(const float* W, int ldw, bf16* WT, int ldt, LAS float* scr, int lane) {
    float tv[32];
    const float* wp_ = W + (size_t)(lane >> 5) * ldw + (lane & 31);
#pragma unroll
    for (int i = 0; i < 32; ++i) tv[i] = wp_[(size_t)(2 * i) * ldw];
#pragma unroll
    for (int i = 0; i < 32; ++i) scr[(2 * i + (lane >> 5)) * 33 + (lane & 31)] = tv[i];
    LDS_WAIT(); asm volatile("" ::: "memory");
    const int c = lane & 7;
#pragma unroll
    for (int j = 0; j < 4; ++j) { const int n = (lane >> 3) + 8 * j; const LAS float* s = scr + (8 * c) * 33 + n;
        u32x4 o; o.x = pg8::cvt_pk_bf16(s[0 * 33], s[1 * 33]); o.y = pg8::cvt_pk_bf16(s[2 * 33], s[3 * 33]); o.z = pg8::cvt_pk_bf16(s[4 * 33], s[5 * 33]); o.w = pg8::cvt_pk_bf16(s[6 * 33], s[7 * 33]);
        *(GAS u32x4*)(WT + (size_t)n * ldt + 8 * c) = o; }
    LDS_WAIT(); asm volatile("" ::: "memory");
}
__device__ __forceinline__ void p0_transpose_item_fp8(const float* W, int ldw, unsigned char* WT, int ldt, LAS float* scr, int lane) {
    float tv[32];
    const float* wp_ = W + (size_t)(lane >> 5) * ldw + (lane & 31);
#pragma unroll
    for (int i = 0; i < 32; ++i) tv[i] = wp_[(size_t)(2 * i) * ldw];
#pragma unroll
    for (int i = 0; i < 32; ++i) scr[(2 * i + (lane >> 5)) * 33 + (lane & 31)] = tv[i];
    LDS_WAIT(); asm volatile("" ::: "memory");
    const int c = lane & 7;
#pragma unroll
    for (int j = 0; j < 4; ++j) { const int n = (lane >> 3) + 8 * j; const LAS float* s = scr + (8 * c) * 33 + n; const float k_ = pg8::FP8_SW;
        u32x2 o; o.x = pg8::pack4_fp8(s[0 * 33] * k_, s[1 * 33] * k_, s[2 * 33] * k_, s[3 * 33] * k_); o.y = pg8::pack4_fp8(s[4 * 33] * k_, s[5 * 33] * k_, s[6 * 33] * k_, s[7 * 33] * k_);
        *(GAS u32x2*)(WT + (size_t)n * ldt + 8 * c) = o; }
    LDS_WAIT(); asm volatile("" ::: "memory");
}
constexpr int I_WIN = 16 * 64, I_WO = 8 * 32, I_WEFF = 4 * 16 * 16, I_WU = 32 * 16 * 64, I_WD = 32 * 16 * 32;
constexpr int P0_ITEMS = I_WIN + I_WO + I_WEFF;

__device__ __forceinline__ void phase0(const Args& a, LAS unsigned char* L, int vcu, int G, int tid, int lane, int wave) {
    const float* w_in = a.in[2]; const float* w_pool = a.in[4]; const float* pscale = a.in[5]; const float* w_out = a.in[6];
    bf16* Win_t = (bf16*)(a.ws + WS_WIN); bf16* Wo_t = (bf16*)(a.ws + WS_WO);
    LAS float* scr = (LAS float*)(L + wave * 8448);
    LAS float* wf = (LAS float*)(L + 69632);
    for (int i = tid; i < 1024 * 8; i += 512) { const int d = i >> 3, p_ = ((d & 255) >> 2) + 64 * (4 * (d >> 8) + (d & 3)); wf[p_ * 12 + (i & 7)] = w_in[(size_t)d * INW + 2048 + (i & 7)]; }
    __syncthreads();
    const int gw = vcu * NWAVES + wave, NGW = G * NWAVES;
    {
        const float* x = a.in[0]; const float* g_mix = a.in[1]; const float* b_forget = a.in[3];
        bf16* XN = (bf16*)(a.ws + WS_XN); float* LOGF = (float*)(a.ws + WS_LOGF);
        f32x4 g[4];
#pragma unroll
        for (int j = 0; j < 4; ++j) g[j] = *(const f32x4*)(g_mix + 4 * lane + 256 * j);
        f32x4 vn[2][4];
#pragma unroll
        for (int q = 0; q < 2; ++q)
#pragma unroll
            for (int j = 0; j < 4; ++j) vn[q][j] = *(const f32x4*)(x + (size_t)(gw + q * NGW) * DM + 4 * lane + 256 * j);
        for (int m = gw; m < T; m += 2 * NGW) {
            f32x4 v[2][4]; float ss[2] = {0.f, 0.f};
#pragma unroll
            for (int q = 0; q < 2; ++q)
#pragma unroll
                for (int j = 0; j < 4; ++j) { v[q][j] = vn[q][j]; ss[q] += v[q][j].x * v[q][j].x + v[q][j].y * v[q][j].y + v[q][j].z * v[q][j].z + v[q][j].w * v[q][j].w; }
            { const int mn = (m + 2 * NGW < T) ? m + 2 * NGW : m;
#pragma unroll
              for (int q = 0; q < 2; ++q)
#pragma unroll
                  for (int j = 0; j < 4; ++j) vn[q][j] = *(const f32x4*)(x + (size_t)(mn + q * NGW) * DM + 4 * lane + 256 * j); }
#pragma unroll
            for (int o = 1; o < 64; o <<= 1) { ss[0] += __shfl_xor(ss[0], o); ss[1] += __shfl_xor(ss[1], o); }
            float fl[2][8];
#pragma unroll
            for (int q = 0; q < 2; ++q) { const float rstd = rsqrtf(ss[q] * (1.f / DM) + RMS_EPS);
#pragma unroll
                for (int e = 0; e < 8; ++e) fl[q][e] = 0.f;
#pragma unroll
                for (int j = 0; j < 4; ++j) v[q][j] = v[q][j] * rstd * g[j]; }
#pragma unroll
            for (int j = 0; j < 4; ++j) {
#pragma unroll
                for (int i = 0; i < 4; ++i) {
                    const int prow = lane + 64 * (4 * j + i);
                    const f32x4 w0 = *(const LAS f32x4*)(wf + prow * 12), w1 = *(const LAS f32x4*)(wf + prow * 12 + 4);
#pragma unroll
                    for (int q = 0; q < 2; ++q) { const float hv = v[q][j][i];
                        fl[q][0] += hv * w0.x; fl[q][1] += hv * w0.y; fl[q][2] += hv * w0.z; fl[q][3] += hv * w0.w;
                        fl[q][4] += hv * w1.x; fl[q][5] += hv * w1.y; fl[q][6] += hv * w1.z; fl[q][7] += hv * w1.w; }
                }
#pragma unroll
                for (int q = 0; q < 2; ++q) { u32x2 o; o.x = pk2(v[q][j].x, v[q][j].y); o.y = pk2(v[q][j].z, v[q][j].w);
                    *(u32x2*)(XN + (size_t)(m + q * NGW) * DM + 4 * lane + 256 * j) = o; }
            }
            float z[2];
            { const bool u5 = lane >= 32, u4 = (lane & 16) != 0, u3 = (lane & 8) != 0; float a4[2][4], a2[2][2];
#pragma unroll
              for (int q = 0; q < 2; ++q)
#pragma unroll
                  for (int e = 0; e < 4; ++e) { const float keep = u5 ? fl[q][4 + e] : fl[q][e], give = u5 ? fl[q][e] : fl[q][4 + e]; a4[q][e] = keep + __shfl_xor(give, 32); }
#pragma unroll
              for (int q = 0; q < 2; ++q)
#pragma unroll
                  for (int e = 0; e < 2; ++e) { const float keep = u4 ? a4[q][2 + e] : a4[q][e], give = u4 ? a4[q][e] : a4[q][2 + e]; a2[q][e] = keep + __shfl_xor(give, 16); }
#pragma unroll
              for (int q = 0; q < 2; ++q) z[q] = (u3 ? a2[q][1] : a2[q][0]) + __shfl_xor(u3 ? a2[q][0] : a2[q][1], 8);
#pragma unroll
              for (int o = 4; o >= 1; o >>= 1) { z[0] += __shfl_xor(z[0], o); z[1] += __shfl_xor(z[1], o); } }
            if ((lane & 7) == 0) {
                const int hd = lane >> 3; const float bfv = b_forget[hd];
#pragma unroll
                for (int q = 0; q < 2; ++q) { const int mm = m + q * NGW; const float zz = z[q] + bfv; const float ls = fminf(zz, 0.f) - log1pf(expf(-fabsf(zz)));
                    LOGF[((size_t)(mm / SEQ) * NH + hd) * SEQ + (mm % SEQ)] = ls; }
            }
        }
    }
    for (int it = gw; it < P0_ITEMS; it += NGW) {
        int r = it;
        if (r < I_WIN) { const int kb = r >> 6, nb = r & 63; p0_transpose_item(w_in + (size_t)(64 * kb) * INW + 32 * nb, INW, Win_t + (size_t)(32 * nb) * DM + 64 * kb, DM, scr, lane); continue; } r -= I_WIN;
        if (r < I_WO) { const int kb = r >> 5, nb = r & 31; p0_transpose_item(w_out + (size_t)(512 + 64 * kb) * DM + 32 * nb, DM, Wo_t + (size_t)(32 * nb) * DM + 512 + 64 * kb, DM, scr, lane); continue; } r -= I_WO;
        if (r < I_WEFF) {
            const int g = r >> 8, nb = (r >> 4) & 15, kb = r & 15, n = nb * 64 + lane; float acc[8];
#pragma unroll
            for (int i = 0; i < 8; ++i) acc[i] = 0.f;
            const float* wp = w_pool + (size_t)g * 16384 + (size_t)(kb * 8) * 128;
#pragma unroll 2
            for (int d = 0; d < 128; d += 4) { f32x4 av;
#pragma unroll
                for (int q = 0; q < 4; ++q) av[q] = w_out[(size_t)(g * 128 + d + q) * DM + n];
                av = av * *(const f32x4*)(pscale + g * 128 + d);
#pragma unroll
                for (int i = 0; i < 8; ++i) { const f32x4 wv = *(const f32x4*)(wp + i * 128 + d); acc[i] += av.x * wv.x + av.y * wv.y + av.z * wv.z + av.w * wv.w; } }
            u32x4 o; o.x = pk2(acc[0], acc[1]); o.y = pk2(acc[2], acc[3]); o.z = pk2(acc[4], acc[5]); o.w = pk2(acc[6], acc[7]);
            *(GAS u32x4*)(Wo_t + (size_t)n * DM + g * 128 + kb * 8) = o; continue; } r -= I_WEFF;
        }
}

constexpr int J_WU = 32 * 16 * 32, J_WD = 32 * 16 * 16;
struct ConvItem { const float* src; int ldw; unsigned char* dst; };
__device__ __forceinline__ ConvItem conv_item(const Args& a, int r) {
    ConvItem it;
    if (r < J_WU) { const int e = r >> 9, kb = (r >> 5) & 15, nb = r & 31, n0 = 64 * nb;
        const int rowp = n0 < 1024 ? (n0 >> 7) * 256 + (n0 & 127) : ((n0 - 1024) >> 7) * 256 + 128 + ((n0 - 1024) & 127);
        it.src = a.in[10] + (size_t)e * DM * 2048 + (size_t)(64 * kb) * 2048 + n0; it.ldw = 2048; it.dst = a.ws + WS_WU + ((size_t)e * 2048 + rowp) * DM + 64 * kb; return it; }
    r -= J_WU;
    { const int e = r >> 8, kb = (r >> 4) & 15, nb = r & 15;
      it.src = a.in[12] + (size_t)e * DE * DM + (size_t)(64 * kb) * DM + 64 * nb; it.ldw = DM; it.dst = a.ws + WS_WD + ((size_t)e * DM + 64 * nb) * DE + 64 * kb; return it; }
}
__device__ __forceinline__ void conv_load(float (&tv)[64], const ConvItem& it, int lane) {
    const float* p_ = it.src + lane;
#pragma unroll
    for (int i = 0; i < 64; ++i) tv[i] = p_[(size_t)i * it.ldw];
}
__device__ __forceinline__ void conv_finish(const float (&tv)[64], const ConvItem& it, int lane) {
    const float k_ = pg8::FP8_SW; unsigned char* d_ = it.dst + (size_t)lane * DM;
#pragma unroll
    for (int q = 0; q < 4; ++q) { u32x4 o;
        o.x = pg8::pack4_fp8(tv[16 * q + 0] * k_, tv[16 * q + 1] * k_, tv[16 * q + 2] * k_, tv[16 * q + 3] * k_); o.y = pg8::pack4_fp8(tv[16 * q + 4] * k_, tv[16 * q + 5] * k_, tv[16 * q + 6] * k_, tv[16 * q + 7] * k_);
        o.z = pg8::pack4_fp8(tv[16 * q + 8] * k_, tv[16 * q + 9] * k_, tv[16 * q + 10] * k_, tv[16 * q + 11] * k_); o.w = pg8::pack4_fp8(tv[16 * q + 12] * k_, tv[16 * q + 13] * k_, tv[16 * q + 14] * k_, tv[16 * q + 15] * k_);
        *(GAS u32x4*)(d_ + 16 * q) = o; }
}
constexpr int CONV_P2_CHUNKS = 1024, CONV_P4_PER_WAVE = 0;
static_assert(CONV_P2_CHUNKS * 24 + 256 * 4 * CONV_P4_PER_WAVE == J_WU + J_WD, "conversion split");
__device__ __forceinline__ void conv_triple(const Args& a, int r0, int lane) {
    const ConvItem i0 = conv_item(a, r0), i1 = conv_item(a, r0 + 1), i2 = conv_item(a, r0 + 2);
    float ta[64], tb[64];
    conv_load(ta, i0, lane); conv_load(tb, i1, lane);
    conv_finish(ta, i0, lane);
    conv_load(ta, i2, lane);
    conv_finish(tb, i1, lane);
    conv_finish(ta, i2, lane);
}
__device__ __forceinline__ void conv_chunk(const Args& a, int cc, int lane, int wave) { conv_triple(a, cc * 24 + wave * 3, lane); }

template <int W> __device__ __forceinline__ void pool_run(const bf16* U, bf16* CAT, int row0, int c0) {
    const int t0 = row0 % SEQ;
    u32x4 blk[8], tr[W - 1];
#pragma unroll
    for (int i = 0; i < 8; ++i) blk[i] = *(const u32x4*)(U + (size_t)(row0 + i) * PW + c0);
#pragma unroll
    for (int j = 1; j < W; ++j) { const u32x4 v_ = *(const u32x4*)(U + (size_t)(t0 - j >= 0 ? row0 - j : row0) * PW + c0); tr[j - 1] = (t0 - j >= 0) ? v_ : (u32x4){0u, 0u, 0u, 0u}; }
    float S[8];
#pragma unroll
    for (int k = 0; k < 8; ++k) S[k] = 0.f;
#pragma unroll
    for (int j = 0; j < W - 1; ++j) { const unsigned rr[4] = {tr[j].x, tr[j].y, tr[j].z, tr[j].w};
#pragma unroll
        for (int k = 0; k < 4; ++k) { S[2 * k] += __builtin_bit_cast(float, rr[k] << 16); S[2 * k + 1] += __builtin_bit_cast(float, rr[k] & 0xffff0000u); } }
#pragma unroll
    for (int i = 0; i < 8; ++i) { const int t = t0 + i; float cur[8];
        { const unsigned rr[4] = {blk[i].x, blk[i].y, blk[i].z, blk[i].w};
#pragma unroll
          for (int k = 0; k < 4; ++k) { cur[2 * k] = __builtin_bit_cast(float, rr[k] << 16); cur[2 * k + 1] = __builtin_bit_cast(float, rr[k] & 0xffff0000u); } }
        const float inv = 1.f / (float)(t + 1 < W ? t + 1 : W); float o[8];
#pragma unroll
        for (int k = 0; k < 8; ++k) { S[k] += cur[k]; o[k] = S[k] * inv - cur[k]; }
        u32x4 ov; ov.x = pk2(o[0], o[1]); ov.y = pk2(o[2], o[3]); ov.z = pk2(o[4], o[5]); ov.w = pk2(o[6], o[7]);
        *(u32x4*)(CAT + (size_t)(row0 + i) * DM + c0) = ov;
        const u32x4 sb = (i - (W - 1) >= 0) ? blk[(i - (W - 1) >= 0) ? i - (W - 1) : 0] : tr[(i - (W - 1) >= 0) ? 0 : (W - 1) - i - 1];
        { const unsigned rr[4] = {sb.x, sb.y, sb.z, sb.w};
#pragma unroll
          for (int k = 0; k < 4; ++k) { S[2 * k] -= __builtin_bit_cast(float, rr[k] << 16); S[2 * k + 1] -= __builtin_bit_cast(float, rr[k] & 0xffff0000u); } }
    }
}
__device__ __forceinline__ void pool_chunk(const Args& a, int c, int tid) {
    const bf16* U = (const bf16*)(a.ws + WS_U); bf16* CAT = (bf16*)(a.ws + WS_CAT);
    const int wv = tid >> 6, ln = tid & 63, g = wv & 3, ch = 16 * g + (ln & 15), c0 = ch * 8;
#pragma unroll 1
    for (int hf = 0; hf < 2; ++hf) { const int row0 = 128 * c + 8 * (hf * 8 + (wv >> 2) * 4 + (ln >> 4));
        if (g == 0) pool_run<2>(U, CAT, row0, c0); else if (g == 1) pool_run<4>(U, CAT, row0, c0); else if (g == 2) pool_run<8>(U, CAT, row0, c0); else pool_run<16>(U, CAT, row0, c0); }
}
__device__ __forceinline__ void c2_local_scan(const Args& a, LAS unsigned char* L, int bx, int tid, int lane, int wave) {
    if (bx >= 256) return;
    const int bh = bx >> 3, blk = bx & 7; const size_t off = (size_t)bh * SEQ + blk * 1024 + tid * 2;
    const float* src = (const float*)(a.ws + WS_LOGF) + off; float* dst = (float*)(a.ws + WS_CUM) + off;
    LAS double* wtot = (LAS double*)(L + 0);
    const float v0 = src[0], v1 = src[1]; const double s = (double)v0 + (double)v1; double inc = s;
#pragma unroll
    for (int o = 1; o < 64; o <<= 1) { const double t_ = __shfl_up(inc, o); if (lane >= o) inc += t_; }
    if (lane == 63) wtot[wave] = inc;
    __syncthreads();
    double base = inc - s;
    for (int w = 0; w < wave; ++w) base += wtot[w];
    dst[0] = (float)((base + (double)v0) * (double)LOG2E); dst[1] = (float)((base + s) * (double)LOG2E);
    if (tid == 511) ((float*)(a.ws + WS_TOT))[bh * 8 + blk] = (float)((base + s) * (double)LOG2E);
    __syncthreads();
}
__device__ __forceinline__ int c2_prepare(const Args& a, LAS unsigned char* L, int bh, int qb, float qkb2, int tid) {
    const float* cum = (const float*)(a.ws + WS_CUM) + (size_t)bh * SEQ; const float* tot = (const float*)(a.ws + WS_TOT) + bh * 8;
    LAS float* c2s = (LAS float*)(L + attn_body::LDS_C2);
    float pre[8]; { double b_ = 0.0;
#pragma unroll
        for (int w = 0; w < 8; ++w) { pre[w] = (float)b_; b_ += (double)tot[w]; } }
    const int q0 = qb * 256, NT = 4 * qb + 4, lane = tid & 63;
    float pq = 0.f;
#pragma unroll
    for (int w = 0; w < 8; ++w) if ((q0 >> 10) == w) pq = pre[w];
    const float cq = cum[q0] + pq + qkb2 + 40.0f;
    int j0;
    { const int m = lane; bool sk = false;
      if (m >= 1 && m <= ((NT - 4) >> 1)) { const int pos = 128 * m - 1; float pp = 0.f;
#pragma unroll
          for (int w = 0; w < 8; ++w) if ((pos >> 10) == w) pp = pre[w];
          sk = (cq - (cum[pos] + pp)) < 0.f; }
      const unsigned long long bal = __ballot(sk) >> 1;
      j0 = 2 * (int)__builtin_ctzll(~bal); }
    for (int idx = 64 * j0 + 4 * tid; idx < q0 + 256; idx += 4 * 512) { float pp = 0.f;
#pragma unroll
        for (int w = 0; w < 8; ++w) if ((idx >> 10) == w) pp = pre[w];
        f32x4 v = *(const f32x4*)(cum + idx); v = v + pp; *(LAS f32x4*)(c2s + idx) = v; }
    __syncthreads();
    return __builtin_amdgcn_readfirstlane(j0);
}

constexpr int RT_GWH = 0, RT_GWL = 65536, RT_GF = 131072, RT_CHE = 135168, RT_CHG = RT_CHE + 2048, RT_LCNT = RT_CHG + 2048, RT_LBASE = RT_LCNT + 128;
static_assert(RT_LBASE + 128 <= LDSCTL_OFF, "router LDS map");
__device__ __forceinline__ void router_phase(const Args& a, LAS unsigned char* L, int vcu, int G, int tid, int lane, int wave) {
    typedef short bf16x8_t __attribute__((ext_vector_type(8)));
    LAS unsigned short* gwh = (LAS unsigned short*)(L + RT_GWH); LAS unsigned short* gwl = (LAS unsigned short*)(L + RT_GWL); LAS float* gf = (LAS float*)(L + RT_GF);
    LAS int* ch_e = (LAS int*)(L + RT_CHE); LAS float* ch_g = (LAS float*)(L + RT_CHG); LAS int* lcnt = (LAS int*)(L + RT_LCNT); LAS int* lbase = (LAS int*)(L + RT_LBASE);
    const float* w_router = a.in[8]; const float* b_router = a.in[9]; const float* g_ffn = a.in[7];
    for (int idx = tid; idx < 1024 * 32; idx += 512) { const int k = idx >> 5, e = idx & 31; const float v = g_ffn[k] * w_router[idx];
        const unsigned hb = f2bf(v); const float hf = __builtin_bit_cast(float, hb << 16); const unsigned lb = f2bf(v - hf);
        const int pos = (((k >> 5) * 4 + ((k >> 3) & 3)) * 32 + e) * 8 + (k & 7); gwh[pos] = (unsigned short)hb; gwl[pos] = (unsigned short)lb; }
    for (int k = tid; k < 1024; k += 512) gf[k] = g_ffn[k];
    __syncthreads();
    const bf16* X1 = (const bf16*)(a.ws + WS_X1B); unsigned char* H2 = a.ws + WS_XN;
    int* cnt = (int*)(a.ws + WS_CTL) + CW_CNT; int* SEL = (int*)(a.ws + WS_SEL); int* LTK = (int*)(a.ws + WS_LTK); float* LGT = (float*)(a.ws + WS_LGT);
    const int j = lane & 15, q = lane >> 4;
    for (int grp = vcu; grp < T / 128; grp += G) {
        if (tid < 32) lcnt[tid] = 0;
        __syncthreads();
        {
            const int lt = wave * 16 + j, m = grp * 128 + lt;
            const bf16* xr = X1 + (size_t)m * DM + 8 * q;
            pg8::f32x4 acc0 = {0.f, 0.f, 0.f, 0.f}, acc1 = {0.f, 0.f, 0.f, 0.f}; float ss = 0.f;
#pragma unroll 8
            for (int s = 0; s < 32; ++s) {
                const u32x4 xb = *(const u32x4*)(xr + 32 * s);
                const LAS unsigned short* wp = gwh + ((s * 4 + q) * 32 + j) * 8; const LAS unsigned short* wl = gwl + ((s * 4 + q) * 32 + j) * 8;
                const bf16x8_t ah0 = *(const LAS bf16x8_t*)wp, ah1 = *(const LAS bf16x8_t*)(wp + 128), al0 = *(const LAS bf16x8_t*)wl, al1 = *(const LAS bf16x8_t*)(wl + 128);
                const bf16x8_t xf = __builtin_bit_cast(bf16x8_t, xb);
                acc0 = __builtin_amdgcn_mfma_f32_16x16x32_bf16(ah0, xf, acc0, 0, 0, 0); acc1 = __builtin_amdgcn_mfma_f32_16x16x32_bf16(ah1, xf, acc1, 0, 0, 0);
                acc0 = __builtin_amdgcn_mfma_f32_16x16x32_bf16(al0, xf, acc0, 0, 0, 0); acc1 = __builtin_amdgcn_mfma_f32_16x16x32_bf16(al1, xf, acc1, 0, 0, 0);
                const unsigned w_[4] = {xb.x, xb.y, xb.z, xb.w};
#pragma unroll
                for (int c = 0; c < 4; ++c) { const float lo = __builtin_bit_cast(float, w_[c] << 16), hi = __builtin_bit_cast(float, w_[c] & 0xffff0000u); ss += lo * lo + hi * hi; }
            }
            ss += __shfl_xor(ss, 16); ss += __shfl_xor(ss, 32);
            const float rstd = rsqrtf(ss * (1.f / DM) + RMS_EPS);
            float lv[8]; int li[8];
#pragma unroll
            for (int r = 0; r < 4; ++r) { li[r] = 4 * q + r; lv[r] = acc0[r] * rstd + b_router[li[r]]; li[4 + r] = 16 + 4 * q + r; lv[4 + r] = acc1[r] * rstd + b_router[li[4 + r]]; }
            float tv[4]; int ti[4];
#pragma unroll
            for (int k = 0; k < 4; ++k) { float bv = -INFINITY; int bi = 64;
#pragma unroll
                for (int r = 0; r < 8; ++r) if (lv[r] > bv) { bv = lv[r]; bi = li[r]; }
                tv[k] = bv; ti[k] = bi;
#pragma unroll
                for (int r = 0; r < 8; ++r) if (li[r] == bi) lv[r] = -INFINITY; }
#pragma unroll
            for (int st = 16; st <= 32; st <<= 1) {
                float cv[8]; int ci[8];
#pragma unroll
                for (int k = 0; k < 4; ++k) { cv[k] = tv[k]; ci[k] = ti[k]; cv[4 + k] = __shfl_xor(tv[k], st); ci[4 + k] = __shfl_xor(ti[k], st); }
#pragma unroll
                for (int k = 0; k < 4; ++k) { float bv = -INFINITY; int bi = 64;
#pragma unroll
                    for (int c = 0; c < 8; ++c) if (cv[c] > bv || (cv[c] == bv && ci[c] < bi)) { bv = cv[c]; bi = ci[c]; }
                    tv[k] = bv; ti[k] = bi;
#pragma unroll
                    for (int c = 0; c < 8; ++c) if (ci[c] == bi) cv[c] = -INFINITY; } }
            const float e1 = expf(tv[1] - tv[0]), e2 = expf(tv[2] - tv[0]), e3 = expf(tv[3] - tv[0]); const float inv = 1.f / (1.f + e1 + e2 + e3);
            if (q == 0) { ch_e[lt * 4 + 0] = ti[0]; ch_e[lt * 4 + 1] = ti[1]; ch_e[lt * 4 + 2] = ti[2]; ch_e[lt * 4 + 3] = ti[3];
                ch_g[lt * 4 + 0] = inv; ch_g[lt * 4 + 1] = e1 * inv; ch_g[lt * 4 + 2] = e2 * inv; ch_g[lt * 4 + 3] = e3 * inv;
#pragma unroll
                for (int k = 0; k < 4; ++k) __hip_atomic_fetch_add(&lcnt[ti[k]], 1, __ATOMIC_RELAXED, __HIP_MEMORY_SCOPE_WORKGROUP); }
            unsigned char* hr = H2 + (size_t)m * DM + 8 * q; const float sc = rstd * pg8::FP8_SA;
#pragma unroll 8
            for (int s = 0; s < 32; ++s) {
                const u32x4 xb = *(const u32x4*)(xr + 32 * s); const unsigned w_[4] = {xb.x, xb.y, xb.z, xb.w};
                const f32x4 g0 = *(const LAS f32x4*)(gf + 32 * s + 8 * q), g1 = *(const LAS f32x4*)(gf + 32 * s + 8 * q + 4);
                float x_[8];
#pragma unroll
                for (int c = 0; c < 4; ++c) { x_[2 * c] = __builtin_bit_cast(float, w_[c] << 16); x_[2 * c + 1] = __builtin_bit_cast(float, w_[c] & 0xffff0000u); }
                u32x2 o; o.x = pg8::pack4_fp8(x_[0] * g0.x * sc, x_[1] * g0.y * sc, x_[2] * g0.z * sc, x_[3] * g0.w * sc); o.y = pg8::pack4_fp8(x_[4] * g1.x * sc, x_[5] * g1.y * sc, x_[6] * g1.z * sc, x_[7] * g1.w * sc);
                *(u32x2*)(hr + 32 * s) = o;
            }
        }
        __syncthreads();
        if (tid < 32) { lbase[tid] = atomicAdd(&cnt[tid], lcnt[tid]); lcnt[tid] = 0; }
        __syncthreads();
        { const int e = ch_e[tid]; const int slot = lbase[e] + __hip_atomic_fetch_add(&lcnt[e], 1, __ATOMIC_RELAXED, __HIP_MEMORY_SCOPE_WORKGROUP); const int tk = (grp * 128 + (tid >> 2)) * 4 + (tid & 3);
          LTK[(size_t)e * T + slot] = tk; LGT[(size_t)e * T + slot] = ch_g[tid]; SEL[tk] = (slot << 5) | e; }
        __syncthreads();
    }
}

__device__ __forceinline__ void expert_map(const Args& a, volatile LAS unsigned* MISC, int tid) {
    if (tid == 0) { const int* cnt = (const int*)(a.ws + WS_CTL) + CW_CNT; int acc = 0;
        for (int e = 0; e < 32; ++e) { const int c = __hip_atomic_load((int*)cnt + e, RLX_AGENT); MISC[64 + e] = (unsigned)c; MISC[96 + e] = (unsigned)acc; acc += (c + RT - 1) / RT; } MISC[128] = (unsigned)acc; }
    __syncthreads();
}

__device__ __forceinline__ void final_phase(const Args& a, volatile LAS unsigned* MISC, int vcu, int G, int lane, int wave) {
    const int* SEL = (const int*)(a.ws + WS_SEL); const unsigned char* Y = a.ws + WS_Y; const bf16* X1 = (const bf16*)(a.ws + WS_X1B); const float* g_final = a.in[14];
    f32x4 g[4];
#pragma unroll
    for (int j = 0; j < 4; ++j) g[j] = *(const f32x4*)(g_final + 4 * lane + 256 * j);
    typedef float f32x2_t __attribute__((ext_vector_type(2)));
    const int m0 = vcu * 8 + wave, MS = G * 8;
    int svn[4]; u32x2 xbn[4];
#pragma unroll
    for (int k = 0; k < 4; ++k) svn[k] = SEL[m0 * 4 + k];
#pragma unroll
    for (int j = 0; j < 4; ++j) xbn[j] = *(const u32x2*)(X1 + (size_t)m0 * DM + 4 * lane + 256 * j);
    for (int m = m0; m < T; m += MS) {
        f32x4 v[4]; unsigned yv[4][4];
#pragma unroll
        for (int k = 0; k < 4; ++k) { const int e = svn[k] & 31, slot = svn[k] >> 5; const unsigned char* yr = Y + ((size_t)MISC[96 + e] * RT + slot) * DM;
#pragma unroll
            for (int j = 0; j < 4; ++j) yv[k][j] = *(const unsigned*)(yr + 4 * lane + 256 * j); }
#pragma unroll
        for (int j = 0; j < 4; ++j) { const u32x2 xb = xbn[j];
            v[j].x = __builtin_bit_cast(float, xb.x << 16); v[j].y = __builtin_bit_cast(float, xb.x & 0xffff0000u); v[j].z = __builtin_bit_cast(float, xb.y << 16); v[j].w = __builtin_bit_cast(float, xb.y & 0xffff0000u); }
        { const int mn = (m + MS < T) ? m + MS : m;
#pragma unroll
          for (int k = 0; k < 4; ++k) svn[k] = SEL[mn * 4 + k];
#pragma unroll
          for (int j = 0; j < 4; ++j) xbn[j] = *(const u32x2*)(X1 + (size_t)mn * DM + 4 * lane + 256 * j); }
        f32x4 ya[4];
#pragma unroll
        for (int j = 0; j < 4; ++j) ya[j] = (f32x4){0.f, 0.f, 0.f, 0.f};
#pragma unroll
        for (int k = 0; k < 4; ++k)
#pragma unroll
            for (int j = 0; j < 4; ++j) { const unsigned y = yv[k][j];
                const f32x2_t lo = __builtin_amdgcn_cvt_pk_f32_fp8((int)y, false), hi = __builtin_amdgcn_cvt_pk_f32_fp8((int)y, true);
                ya[j].x += lo.x; ya[j].y += lo.y; ya[j].z += hi.x; ya[j].w += hi.y; }
        float ss = 0.f;
#pragma unroll
        for (int j = 0; j < 4; ++j) { v[j] = v[j] + ya[j] * (1.0f / pg8::FP8_SY); ss += v[j].x * v[j].x + v[j].y * v[j].y + v[j].z * v[j].z + v[j].w * v[j].w; }
        const float rstd = rsqrtf(wave_sum(ss) * (1.f / DM) + RMS_EPS);
        float* orow = a.out + (size_t)m * DM;
#pragma unroll
        for (int j = 0; j < 4; ++j) *(f32x4*)(orow + 4 * lane + 256 * j) = v[j] * rstd * g[j];
    }
}

__global__ void __launch_bounds__(NWAVES * 64, 2) mk_fwd(Args args) {
    extern __shared__ __attribute__((aligned(16))) unsigned char lds[];
    LAS unsigned char* L = (LAS unsigned char*)lds;
    volatile LAS unsigned* MISC = (volatile LAS unsigned*)(L + LDSCTL_OFF);
    const int tid = threadIdx.x, lane = tid & 63, wave = __builtin_amdgcn_readfirstlane(tid >> 6);
    const int G = gridDim.x; const int bx = blockIdx.x; const int vcu = (G % 8 == 0) ? (bx % 8) * (G / 8) + bx / 8 : bx;
    unsigned char* ws = args.ws;
    for (int u = tid; u < (LDS_TOTAL - LDSCTL_OFF) / 4; u += NWAVES * 64) ((LAS unsigned*)(L + LDSCTL_OFF))[u] = 0u;
    __syncthreads();
    XcdBarrier bar; bar.bar = (unsigned*)(ws + WS_CTL) + CW_BAR; bar.x = 0; bar.st = nullptr;
    if (args.use_bar) bar = xcd_barrier_post((unsigned*)(ws + WS_CTL) + CW_BAR, MISC + 8);
    const int lo = args.ph_lo, hi = args.ph_hi;
#define IN(k) (lo <= (k) && (k) < hi)
#define SEAM(k) do { if (IN(k) && IN((k) + 1)) xcd_barrier(bar); } while (0)
#ifndef MK_DUP
#define MK_DUP -1
#endif
#ifndef MK_TPROBE
#define MK_TPROBE -1
#endif
#define CK0(k) do { if ((MK_TPROBE) == 100 + (k) && bx == 0 && tid == 0) { const unsigned long long c_ = __builtin_amdgcn_s_memtime(); const unsigned long long t_ = __builtin_amdgcn_s_memrealtime(); MISC[28] = (unsigned)c_; MISC[29] = (unsigned)(c_ >> 32); MISC[16] = (unsigned)t_; MISC[17] = (unsigned)(t_ >> 32); } } while (0)
#define CK1(k) do { if ((MK_TPROBE) == 100 + (k) && bx == 0 && tid == 0) { const unsigned long long c_ = __builtin_amdgcn_s_memtime(); const unsigned long long t_ = __builtin_amdgcn_s_memrealtime(); const unsigned long long c0_ = ((unsigned long long)MISC[29] << 32) | MISC[28], t0_ = ((unsigned long long)MISC[17] << 32) | MISC[16]; \
    const unsigned long long spin_ = (c_ - c0_) * 1000ull / (t_ - t0_); MISC[18] = (unsigned)(t0_ + spin_); MISC[19] = (unsigned)((t0_ + spin_) >> 32); } } while (0)
#define TP0(k) do { if ((MK_TPROBE) == (k) && bx == 0 && tid == 0) { const unsigned long long t_ = __builtin_amdgcn_s_memrealtime(); MISC[16] = (unsigned)t_; MISC[17] = (unsigned)(t_ >> 32); } } while (0)
#define TP1(k) do { if ((MK_TPROBE) == (k) && bx == 0 && tid == 0) { const unsigned long long t_ = __builtin_amdgcn_s_memrealtime(); MISC[18] = (unsigned)t_; MISC[19] = (unsigned)(t_ >> 32); } } while (0)
#define REPS(k) for (int rep_ = 0; rep_ < ((MK_DUP) == (k) ? 2 : 1); ++rep_, ((MK_DUP) == (k) && rep_ == 1 ? xcd_barrier(bar) : (void)0))

    TP0(0); CK0(0); TP0(200);
    if ((MK_TPROBE) == 300 || (MK_TPROBE) == 301) {
        if (bx == 0 && tid < 64) { typedef int v8i_ __attribute__((ext_vector_type(8))); typedef short s8_ __attribute__((ext_vector_type(8)));
            pg8::f32x4 c0 = {0, 0, 0, 0}, c1 = c0, c2 = c0, c3 = c0; v8i_ a8 = {tid, 1, 2, 3, 4, 5, 6, 7}, b8 = {7, 6, 5, 4, 3, 2, 1, tid}; s8_ a4 = {1, 2, 3, 4, 5, 6, 7, 8}, b4 = a4;
            const unsigned long long t0_ = __builtin_amdgcn_s_memtime();
            for (int it = 0; it < 1024; ++it) {
                if ((MK_TPROBE) == 300) { asm volatile("v_mfma_f32_16x16x128_f8f6f4 %0, %1, %2, %0" : "+v"(c0) : "v"(a8), "v"(b8)); asm volatile("v_mfma_f32_16x16x128_f8f6f4 %0, %1, %2, %0" : "+v"(c1) : "v"(a8), "v"(b8));
                    asm volatile("v_mfma_f32_16x16x128_f8f6f4 %0, %1, %2, %0" : "+v"(c2) : "v"(a8), "v"(b8)); asm volatile("v_mfma_f32_16x16x128_f8f6f4 %0, %1, %2, %0" : "+v"(c3) : "v"(a8), "v"(b8)); }
                else { c0 = __builtin_amdgcn_mfma_f32_16x16x32_bf16(a4, b4, c0, 0, 0, 0); c1 = __builtin_amdgcn_mfma_f32_16x16x32_bf16(a4, b4, c1, 0, 0, 0); c2 = __builtin_amdgcn_mfma_f32_16x16x32_bf16(a4, b4, c2, 0, 0, 0); c3 = __builtin_amdgcn_mfma_f32_16x16x32_bf16(a4, b4, c3, 0, 0, 0); } }
            asm volatile("s_nop 15\n\ts_nop 15" ::: "memory");
            const unsigned long long t1_ = __builtin_amdgcn_s_memtime();
            asm volatile("" :: "v"(c0), "v"(c1), "v"(c2), "v"(c3));
            if (tid == 0) MISC[21] = (unsigned)((t1_ - t0_) * 1000ull / 4096ull); } }
    if (IN(0)) REPS(0) { phase0(args, L, vcu, G, tid, lane, wave); }
    CK1(0); SEAM(0); TP1(0); TP0(1); CK0(1);
    if (IN(1)) REPS(1) {
        pg8::Gemm g{(const bf16*)(ws + WS_XN), (const bf16*)(ws + WS_WIN), DM}; pg8::StaticOrder S; S.init(T, 2048, G, bx);
        c2_local_scan(args, L, bx, tid, lane, wave);
        pg8::EpiInproj E{(bf16*)(ws + WS_U), (size_t)(WS_Q - WS_U) / 2, C2, (unsigned*)(ws + WS_CTL) + CW_NRM};
        pg8::gemm_phase<pg8::EpiInproj, pg8::StaticOrder, true, false>(L + RING_OFF, g, S, E, nullptr);
    }
    CK1(1); SEAM(1); TP1(1); TP0(2); CK0(2);
    if (IN(2)) {
        constexpr unsigned NQ_POOL = T / 128, NQA = NQ_POOL + 1024, NQC = CONV_P2_CHUNKS;
        unsigned* qhead = (unsigned*)(ws + WS_CTL) + CW_Q; const float* nrm = (const float*)(ws + WS_CTL) + CW_NRM;
        const attn_body::AttnTensors AT{(const attn_body::bf16*)(ws + WS_Q), (const attn_body::bf16*)(ws + WS_K), (const attn_body::bf16*)(ws + WS_V), (attn_body::bf16*)(ws + WS_CAT) + PW};
        #ifndef MK_CONV_MASK
#define MK_CONV_MASK 3
#endif
        const int pref = ((bx & (MK_CONV_MASK)) == 0) ? 1 : 0;
#define QT0() unsigned long long tq0_ = 0; if ((MK_TPROBE) >= 26 && (MK_TPROBE) <= 29 && threadIdx.x == 0) tq0_ = __builtin_amdgcn_s_memrealtime()
#define QT1(kind) do { if ((MK_TPROBE) == (kind) && threadIdx.x == 0) atomicAdd((unsigned*)(ws + WS_CTL) + 512, (unsigned)(__builtin_amdgcn_s_memrealtime() - tq0_)); } while (0)
#define CONV_LOOP() do { unsigned pend_ = 0; int sl_ = 0; if (threadIdx.x == 0) pend_ = atomicAdd(qhead + 64, 1u); \
        for (;;) { int tid_ = threadIdx.x; asm volatile("" : "+v"(tid_));   \
            if (tid_ == 0) MISC[24 + sl_] = pend_; __syncthreads(); const unsigned q = MISC[24 + sl_]; sl_ ^= 1; if (q >= NQC) break; \
            if (tid_ == 0) pend_ = atomicAdd(qhead + 64, 1u); \
            QT0(); conv_chunk(args, (int)q, tid_ & 63, tid_ >> 6); QT1(28); } } while (0)
        if (pref) { CONV_LOOP(); __syncthreads(); }
        { int sl_ = 0;
        for (;;) {
            int tid_ = threadIdx.x; asm volatile("" : "+v"(tid_));
            if (tid_ == 0) MISC[26 + sl_] = atomicAdd(qhead, 1u);
            __syncthreads();
            const unsigned q = MISC[26 + sl_]; sl_ ^= 1;
            if (q >= NQA) break;
            QT0();
            if (q < NQ_POOL) { pool_chunk(args, (int)q, tid_); }
            else { const int grp = (int)(q - NQ_POOL), qb = 31 - (grp >> 5), bh = grp & 31;
                const float qkb2 = 4.0f * sqrtf(nrm[bh] * nrm[32 + bh]) * 1.001f;
                attn_body::attn_unit<MK_THRL>(bh / NH, bh % NH, qb, AT.Q, AT.K, AT.V, AT.O, (char*)lds + RING_OFF, c2_prepare(args, L, bh, qb, qkb2, tid_), ((MK_TPROBE) == 400) ? (unsigned*)(ws + WS_CTL) + 513 : nullptr); }
            if (q < NQ_POOL) QT1(26); else QT1(27);
        } }
#ifndef MK_CONV_HELP
#define MK_CONV_HELP 1
#endif
        if (MK_CONV_HELP) { __syncthreads(); CONV_LOOP(); }
#undef CONV_LOOP
    }
    CK1(2); SEAM(2); TP1(2); TP0(3); CK0(3);
    if (IN(3)) REPS(3) {
        pg8::Gemm g{(const bf16*)(ws + WS_CAT), (const bf16*)(ws + WS_WO), DM}; pg8::StaticOrder S; S.init(T, DM, G, bx);
        pg8::EpiResBf16 E{args.in[0], (bf16*)(ws + WS_X1B)};
        pg8::gemm_phase<pg8::EpiResBf16, pg8::StaticOrder, true, false>(L + RING_OFF, g, S, E, nullptr);
    }
    CK1(3); SEAM(3); TP1(3); TP0(4); CK0(4);
    if (IN(4)) { router_phase(args, L, vcu, G, tid, lane, wave); }
    CK1(4); SEAM(4); TP1(4); TP0(5); CK0(5);
    if (IN(5)) REPS(5) {
        TP0(51); expert_map(args, MISC, tid);
        const LAS int* pt = (const LAS int*)(L + LDSCTL_OFF + 96 * 4); const LAS int* cn = (const LAS int*)(L + LDSCTL_OFF + 64 * 4);
        LAS unsigned* tab = (LAS unsigned*)(L + TAB_OFF);
        LAS int* ul = (LAS int*)(L + LDSCTL_OFF + 132 * 4);
        pg8::MoeOrder<8>::build(ul, pt, bx, tid);
        const pg8::MoeOrder<8> S{ul, (size_t)2048 * DM};
        { const int* LTK = (const int*)(ws + WS_LTK); const int nu = ul[0];
          for (int idx = tid; idx < nu * 256; idx += NWAVES * 64) { const int i = idx >> 8, r = idx & 255, e = ul[6 + 4 * i], slot = ul[7 + 4 * i] + r;
              const int tok = slot < cn[e] ? (LTK[(size_t)e * T + slot] >> 2) : 0; tab[idx] = (unsigned)tok * (unsigned)DM; } }
        __syncthreads(); TP1(51);
        pg8::Gemm g{(const bf16*)(ws + WS_XN), (const bf16*)(ws + WS_WU), DM / 2};
        pg8::EpiSwiglu8 E{ws + WS_ACT, args.in[11]};
        pg8::gemm_phase<pg8::EpiSwiglu8, pg8::MoeOrder<8>, true, true, true, 0, MK_SP2>(L + RING_OFF, g, S, E, tab, ((MK_TPROBE) == 52 && bx == 0) ? (volatile LAS unsigned*)(MISC + 20) : nullptr);
    }
#ifdef MK_ABL
    {
        xcd_barrier(bar);
        const pg8::MoeOrder<8> S2{(const LAS int*)(L + LDSCTL_OFF + 132 * 4), (size_t)2048 * DM};
        pg8::Gemm g2{(const bf16*)(ws + WS_XN), (const bf16*)(ws + WS_WU), DM / 2}; pg8::EpiSwiglu8 E2{ws + WS_Y, args.in[11]};
        pg8::gemm_phase<pg8::EpiSwiglu8, pg8::MoeOrder<8>, true, true, true, MK_ABL>(L + RING_OFF, g2, S2, E2, (const LAS unsigned*)(L + TAB_OFF));
    }
#endif
    CK1(5); SEAM(5); TP1(5); TP0(6); CK0(6);
    if (IN(6)) REPS(6) {
        expert_map(args, MISC, tid);
        const LAS int* pt = (const LAS int*)(L + LDSCTL_OFF + 96 * 4); const LAS int* cn = (const LAS int*)(L + LDSCTL_OFF + 64 * 4);
        LAS int* ul = (LAS int*)(L + LDSCTL_OFF + 132 * 4);
        pg8::MoeOrder<4>::build(ul, pt, bx, tid);
        const pg8::MoeOrder<4> S{ul, (size_t)DM * DE};
        pg8::Gemm g{(const bf16*)(ws + WS_ACT), (const bf16*)(ws + WS_WD), DE / 2};
        pg8::EpiDown E{ws + WS_Y, args.in[13], (const float*)(ws + WS_LGT), cn, T, pg8::FP8_INV};
        pg8::gemm_phase<pg8::EpiDown, pg8::MoeOrder<4>, true, false, true, 0, MK_SP2>(L + RING_OFF, g, S, E, nullptr);
    }
    CK1(6); SEAM(6); TP1(6); TP0(7); CK0(7); TP0(70);
    if (IN(7)) { expert_map(args, MISC, tid); final_phase(args, MISC, vcu, G, lane, wave); }
    if ((MK_TPROBE) == 70) { xcd_barrier(bar); }
    TP1(7); TP1(70); TP1(200);
    if ((MK_TPROBE) >= 0 && bx == 0) { __syncthreads(); const unsigned long long ta = ((unsigned long long)MISC[17] << 32) | MISC[16], tb = ((MK_TPROBE) == 400) ? ta + (__hip_atomic_load((unsigned*)(ws + WS_CTL) + 513, RLX_AGENT) * 1000u >> 10) : ((MK_TPROBE) == 300 || (MK_TPROBE) == 301) ? ta + MISC[21] : ((MK_TPROBE) >= 26 && (MK_TPROBE) <= 29) ? ta + (__hip_atomic_load((unsigned*)(ws + WS_CTL) + 512, RLX_AGENT) >> 8) : ((MK_TPROBE) == 52 || ((MK_TPROBE) >= 23 && (MK_TPROBE) <= 25)) ? ta + MISC[20] : (((unsigned long long)MISC[19] << 32) | MISC[18]);
        const unsigned long long tend = __builtin_amdgcn_s_memrealtime() + (tb - ta); while (__builtin_amdgcn_s_memrealtime() < tend) __builtin_amdgcn_s_sleep(10); }
#undef IN
#undef SEAM
}
extern "C" void kernel_launch(void* const* d_in, const int* in_sizes, int n_in, void* d_out, int out_size, void* d_ws, size_t ws_size, hipStream_t stream) {
    if (n_in != 15 || out_size != T * DM || ws_size < WS_END) { fprintf(stderr, "kernel_launch: unexpected shapes (n_in %d out %d ws %zu)\n", n_in, out_size, ws_size); return; }
    Args a{};
    for (int i = 0; i < 15; ++i) a.in[i] = (const float*)d_in[i];
    a.out = (float*)d_out; a.ws = (unsigned char*)d_ws;
    static bool attr_done = false;
    if (!attr_done) { if (hipFuncSetAttribute((const void*)mk_fwd, hipFuncAttributeMaxDynamicSharedMemorySize, LDS_TOTAL) != hipSuccess) fprintf(stderr, "kernel_launch: hipFuncSetAttribute failed\n"); attr_done = true; }
    (void)hipMemsetAsync((char*)d_ws + WS_CTL, 0, 64 * 1024, stream);
    a.ph_lo = 0; a.ph_hi = N_PHASES; a.use_bar = 1;
    hipLaunchKernelGGL(mk_fwd, dim3(256), dim3(NWAVES * 64), LDS_TOTAL, stream, a);
}
```

```cpp
#include <hip/hip_runtime.h>
#include <cstdio>
#include <cstdint>

constexpr int BATCH = 4, SEQ = 8192, DM = 1024, T = BATCH * SEQ;
constexpr int PW = 512, AW = 512, NH = 8, HD = 64, INW = PW + 3 * AW + NH;
constexpr int NE = 32, TOPK = 4, DE = 1024;
constexpr float RMS_EPS = 1e-5f, SW_LIMIT = 7.0f, SW_ALPHA = 1.702f;
constexpr float LOG2E = 1.4426950408889634f;
constexpr float C2 = 0.125f * LOG2E;
constexpr int RT = 256;
constexpr int NROWS_PAD = T * TOPK + NE * RT;

typedef unsigned short bf16;
typedef float f32x4 __attribute__((ext_vector_type(4)));
typedef unsigned u32x4 __attribute__((ext_vector_type(4)));
typedef unsigned u32x2 __attribute__((ext_vector_type(2)));

constexpr size_t MiB = 1u << 20;
constexpr size_t WS_CTL = 0;
constexpr size_t WS_LOGF = 1 * MiB;
constexpr size_t WS_CUM = 2 * MiB;
constexpr size_t WS_SEL = 3 * MiB;
constexpr size_t WS_LTK = 4 * MiB;
constexpr size_t WS_LGT = 8 * MiB;
constexpr size_t WS_XN = 12 * MiB;
constexpr size_t WS_WIN = 76 * MiB;
constexpr size_t WS_WO = 80 * MiB;
constexpr size_t WS_WU = 82 * MiB;
constexpr size_t WS_WD = 210 * MiB;
constexpr size_t WS_U = 274 * MiB;
constexpr size_t WS_Q = 306 * MiB;
constexpr size_t WS_K = 338 * MiB;
constexpr size_t WS_V = 370 * MiB;
constexpr size_t WS_CAT = 402 * MiB;
constexpr size_t WS_P = 466 * MiB;
constexpr size_t WS_ACT = 274 * MiB;
constexpr size_t WS_Y = 546 * MiB;
constexpr size_t WS_END = 818 * MiB;
static_assert(WS_ACT + (size_t)NROWS_PAD * 1024 * 2 <= WS_Y, "ACT overlay");
static_assert(WS_Y + (size_t)NROWS_PAD * 1024 * 2 <= WS_END, "Y");
constexpr int CW_CNT = 64;


__device__ __forceinline__ unsigned f2bf(float f) { unsigned u = __builtin_bit_cast(unsigned, f); return (u + 0x7fffu + ((u >> 16) & 1u)) >> 16; }
__device__ __forceinline__ unsigned pk2(float lo, float hi) { return f2bf(lo) | (f2bf(hi) << 16); }
__device__ __forceinline__ float bf2f(unsigned short b) { return __builtin_bit_cast(float, (unsigned)b << 16); }
__device__ __forceinline__ float wave_sum(float v) {
#pragma unroll
    for (int o = 1; o < 64; o <<= 1) v += __shfl_xor(v, o);
    return v;
}

namespace pg8 {
#define PG8_LAS __attribute__((address_space(3)))
typedef unsigned short bf16_t;
typedef short bf16x8 __attribute__((ext_vector_type(8)));
typedef float f32x4 __attribute__((ext_vector_type(4)));
typedef unsigned u32x4 __attribute__((ext_vector_type(4)));
constexpr int BM = 256, BK = 64, HALF = 128, HTB = HALF * BK * 2  , STAGE_BYTES = 8 * HTB, NXCD = 8, WGM = 8;

__host__ __device__ __forceinline__ int lds_byte(int r, int c) { const int ch = (c >> 3) ^ ((r >> 1) & 7); return (r >> 3) * 1024 + (r & 7) * 128 + ch * 16 + (c & 7) * 2; }
__host__ __device__ __forceinline__ void stage_rc(int b, int& R, int& C) { const int st = b >> 10, sb = b & 1023; R = st * 8 + (sb >> 7); C = ((((sb >> 4) & 7) ^ ((R >> 1) & 7)) * 8); }
__host__ __device__ __forceinline__ int perm32(int rho) { const int n = rho >> 4, i = rho & 15; return 8 * (i >> 2) + 4 * n + (i & 3); }

struct Unit { int pm, pn, e, lrow0; size_t boff; };
struct Gemm { const bf16_t* A; const bf16_t* Bt; int K; };

struct StaticOrder {
    int nM, nN, nwg, G, c;
    __host__ __device__ void init(int M, int N, int G_, int c_) { nM = M / BM; nN = N / BM; nwg = nM * nN; G = G_; c = c_; }
    __host__ __device__ bool next(int i, Unit& u) const {
        const long L = (long)i * G + c; if (L >= nwg) return false;
        int wgid = (int)L; { const int q = nwg / NXCD, r = nwg % NXCD, xcd = wgid % NXCD, off = wgid / NXCD; wgid = (xcd < r ? xcd * (q + 1) : r * (q + 1) + (xcd - r) * q) + off; }
        const int nig = WGM * nN, gid = wgid / nig, fm = gid * WGM, gsz = (nM - fm) < WGM ? (nM - fm) : WGM;
        u.pm = fm + ((wgid % nig) % gsz); u.pn = (wgid % nig) / gsz; u.e = 0; u.lrow0 = 0; u.boff = 0; return true;
    }
};
template <int NCOL> struct MoeOrder {
    static constexpr int RG = 32 / NCOL;
    const PG8_LAS int* ul; size_t bstride;
    static __device__ __forceinline__ void build(PG8_LAS int* ul, const PG8_LAS int* pt, int c, int tid) {
        const int nrt = pt[32]; const int x = c & 7, j = c >> 3;
        const int lo = (nrt * x) >> 3, hi = (nrt * (x + 1)) >> 3;
        if (tid < 32) { const int rt = lo + RG * tid + j / NCOL;
            if (rt < hi) { int e = 0; for (int k = 1; k < 32; ++k) e += (pt[k] <= rt) ? 1 : 0;
                ul[4 + 4 * tid] = rt; ul[5 + 4 * tid] = j % NCOL; ul[6 + 4 * tid] = e; ul[7 + 4 * tid] = (rt - pt[e]) * BM; } }
        if (tid == 0) { const int span = hi - (lo + j / NCOL); ul[0] = span > 0 ? (span + RG - 1) / RG : 0; }
        __syncthreads();
    }
    __device__ __forceinline__ bool next(int i, Unit& u) const {
        if (i >= ul[0]) return false;
        u.pm = ul[4 + 4 * i]; u.pn = ul[5 + 4 * i]; u.e = ul[6 + 4 * i]; u.lrow0 = ul[7 + 4 * i]; u.boff = (size_t)u.e * bstride; return true;
    }
};

__device__ __forceinline__ unsigned cvt_pk_bf16(float lo, float hi) { unsigned r; asm volatile("v_cvt_pk_bf16_f32 %0, %1, %2" : "=v"(r) : "v"(lo), "v"(hi)); return r; }

struct EpiInproj {
    static constexpr bool PERM = true; static constexpr int NST = 16;
    bf16_t* O; size_t split_stride; float qscale; unsigned* nrm;
    __device__ __forceinline__ void operator()(const f32x4 (&acc)[2][2][4][2], const Unit& u, int wr, int wc, int fr, int fq) const {
        const int row0 = u.pm * BM + wr * 64 + fr; int colt = u.pn * BM; const int t = colt >> 9; bf16_t* base = O + (size_t)t * split_stride; colt -= t * 512;
        const float sc = (t == 1) ? qscale : 1.f; const int col0 = colt + wc * 32 + 8 * fq;
#pragma unroll
        for (int ai = 0; ai < 2; ++ai)
#pragma unroll
            for (int m = 0; m < 4; ++m) { bf16_t* rowp = base + (size_t)(row0 + ai * HALF + m * 16) * 512 + col0;
#pragma unroll
                for (int bj = 0; bj < 2; ++bj) { const f32x4 v0 = acc[ai][bj][m][0] * sc, v1 = acc[ai][bj][m][1] * sc;
                    u32x4 w; w.x = cvt_pk_bf16(v0[0], v0[1]); w.y = cvt_pk_bf16(v0[2], v0[3]); w.z = cvt_pk_bf16(v1[0], v1[1]); w.w = cvt_pk_bf16(v1[2], v1[3]);
                    *(u32x4*)(rowp + bj * HALF) = w; } }
        if (t == 1 || t == 2) {
            float mx[2] = {0.f, 0.f};
#pragma unroll
            for (int ai = 0; ai < 2; ++ai)
#pragma unroll
                for (int m = 0; m < 4; ++m)
#pragma unroll
                    for (int bj = 0; bj < 2; ++bj) { const f32x4 v0 = acc[ai][bj][m][0] * sc, v1 = acc[ai][bj][m][1] * sc;
                        float s8 = v0[0] * v0[0] + v0[1] * v0[1] + v0[2] * v0[2] + v0[3] * v0[3] + v1[0] * v1[0] + v1[1] * v1[1] + v1[2] * v1[2] + v1[3] * v1[3];
                        s8 += __shfl_xor(s8, 16); s8 += __shfl_xor(s8, 32); mx[bj] = fmaxf(mx[bj], s8); }
#pragma unroll
            for (int bj = 0; bj < 2; ++bj) {
#pragma unroll
                for (int o = 1; o < 16; o <<= 1) mx[bj] = fmaxf(mx[bj], __shfl_xor(mx[bj], o));
                if ((threadIdx.x & 63) == 0) { const int head = ((u.pn & 1) * 256 + bj * HALF + wc * 32) >> 6, b = (u.pm * BM) >> 13;
                    atomicMax(nrm + (t - 1) * 32 + b * 8 + head, __float_as_uint(mx[bj] * 1.01f)); } }
        }
    }
};
struct EpiResBf16 {
    static constexpr bool PERM = true; static constexpr int NST = 16;
    const float* x; bf16_t* out;
    __device__ __forceinline__ void operator()(const f32x4 (&acc)[2][2][4][2], const Unit& u, int wr, int wc, int fr, int fq) const {
        const int row0 = u.pm * BM + wr * 64 + fr, col0 = u.pn * BM + wc * 32 + 8 * fq;
        f32x4 xa[2][2][2], xb[2][2][2];
#define PG8_XLOAD(dst, b) do { _Pragma("unroll") for (int mm = 0; mm < 2; ++mm) { const size_t off_ = (size_t)(row0 + ((b) >> 1) * HALF + (((b) & 1) * 2 + mm) * 16) * 1024 + col0; \
            _Pragma("unroll") for (int bj = 0; bj < 2; ++bj) { dst[mm][bj][0] = *(const f32x4*)(x + off_ + bj * HALF); dst[mm][bj][1] = *(const f32x4*)(x + off_ + bj * HALF + 4); } } } while (0)
#define PG8_XSTORE(src, b) do { _Pragma("unroll") for (int mm = 0; mm < 2; ++mm) { const int ai = (b) >> 1, m = ((b) & 1) * 2 + mm; const size_t off_ = (size_t)(row0 + ai * HALF + m * 16) * 1024 + col0; \
            _Pragma("unroll") for (int bj = 0; bj < 2; ++bj) { const f32x4 v0 = src[mm][bj][0] + acc[ai][bj][m][0], v1 = src[mm][bj][1] + acc[ai][bj][m][1]; \
                u32x4 w; w.x = cvt_pk_bf16(v0[0], v0[1]); w.y = cvt_pk_bf16(v0[2], v0[3]); w.z = cvt_pk_bf16(v1[0], v1[1]); w.w = cvt_pk_bf16(v1[2], v1[3]); *(u32x4*)(out + off_ + bj * HALF) = w; } } } while (0)
        PG8_XLOAD(xa, 0); PG8_XLOAD(xb, 1);
        asm volatile("" ::: "memory");
        PG8_XSTORE(xa, 0); PG8_XLOAD(xa, 2);
        asm volatile("" ::: "memory");
        PG8_XSTORE(xb, 1); PG8_XLOAD(xb, 3);
        asm volatile("" ::: "memory");
        PG8_XSTORE(xa, 2);
        PG8_XSTORE(xb, 3);
#undef PG8_XLOAD
#undef PG8_XSTORE
    }
};
__device__ __forceinline__ float swiglu1(float g, float l) {
    const float gl = fminf(g, 7.0f), li = fminf(fmaxf(l, -7.0f), 7.0f);
    const float sg = __builtin_amdgcn_rcpf(1.0f + __builtin_amdgcn_exp2f(gl * (-1.702f * 1.4426950408889634f)));
    return gl * sg * (li + 1.0f);
}
struct EpiSwiglu {
    static constexpr bool PERM = true; static constexpr int NST = 8;
    bf16_t* ACT; const float* bup;
    __device__ __forceinline__ void operator()(const f32x4 (&acc)[2][2][4][2], const Unit& u, int wr, int wc, int fr, int fq) const {
        const int row0 = u.pm * BM + wr * 64 + fr, col0 = u.pn * HALF + wc * 32 + 8 * fq;
        const float* bb = bup + (size_t)u.e * 2048 + col0;
        f32x4 bg[2], bl[2];
#pragma unroll
        for (int n = 0; n < 2; ++n) { bg[n] = *(const f32x4*)(bb + 4 * n); bl[n] = *(const f32x4*)(bb + 1024 + 4 * n); }
#pragma unroll
        for (int ai = 0; ai < 2; ++ai)
#pragma unroll
            for (int m = 0; m < 4; ++m) { bf16_t* rowp = ACT + (size_t)(row0 + ai * HALF + m * 16) * 1024 + col0;
                const f32x4 g0 = acc[ai][0][m][0] + bg[0], g1 = acc[ai][0][m][1] + bg[1], l0 = acc[ai][1][m][0] + bl[0], l1 = acc[ai][1][m][1] + bl[1];
                u32x4 w; w.x = cvt_pk_bf16(swiglu1(g0[0], l0[0]), swiglu1(g0[1], l0[1])); w.y = cvt_pk_bf16(swiglu1(g0[2], l0[2]), swiglu1(g0[3], l0[3]));
                w.z = cvt_pk_bf16(swiglu1(g1[0], l1[0]), swiglu1(g1[1], l1[1])); w.w = cvt_pk_bf16(swiglu1(g1[2], l1[2]), swiglu1(g1[3], l1[3]));
                *(u32x4*)rowp = w; }
    }
};

constexpr float FP8_SA = 4.0f, FP8_SW = 256.0f, FP8_INV = 1.0f / (FP8_SA * FP8_SW), FP8_SY = 16.0f;
__device__ __forceinline__ unsigned pack4_fp8(float a, float b, float c, float d) { unsigned p = 0; p = __builtin_amdgcn_cvt_pk_fp8_f32(a, b, p, false); p = __builtin_amdgcn_cvt_pk_fp8_f32(c, d, p, true); return p; }
struct EpiSwiglu8 {
    static constexpr bool PERM = true; static constexpr int NST = 8;
    unsigned char* ACT; const float* bup;
    __device__ __forceinline__ void operator()(const f32x4 (&acc)[2][2][4][2], const Unit& u, int wr, int wc, int fr, int fq) const {
        const int row0 = u.pm * BM + wr * 64 + fr, col0 = u.pn * HALF + wc * 32 + 8 * fq;
        const float* bb = bup + (size_t)u.e * 2048 + col0;
        f32x4 bg[2], bl[2];
#pragma unroll
        for (int n = 0; n < 2; ++n) { bg[n] = *(const f32x4*)(bb + 4 * n); bl[n] = *(const f32x4*)(bb + 1024 + 4 * n); }
#pragma unroll
        for (int ai = 0; ai < 2; ++ai)
#pragma unroll
            for (int m = 0; m < 4; ++m) { unsigned char* rowp = ACT + (size_t)(row0 + ai * HALF + m * 16) * 1024 + col0;
                const f32x4 g0 = acc[ai][0][m][0] * FP8_INV + bg[0], g1 = acc[ai][0][m][1] * FP8_INV + bg[1], l0 = acc[ai][1][m][0] * FP8_INV + bl[0], l1 = acc[ai][1][m][1] * FP8_INV + bl[1];
                typedef unsigned u32x2_t __attribute__((ext_vector_type(2))); u32x2_t w;
                w.x = pack4_fp8(swiglu1(g0[0], l0[0]) * FP8_SA, swiglu1(g0[1], l0[1]) * FP8_SA, swiglu1(g0[2], l0[2]) * FP8_SA, swiglu1(g0[3], l0[3]) * FP8_SA);
                w.y = pack4_fp8(swiglu1(g1[0], l1[0]) * FP8_SA, swiglu1(g1[1], l1[1]) * FP8_SA, swiglu1(g1[2], l1[2]) * FP8_SA, swiglu1(g1[3], l1[3]) * FP8_SA);
                *(u32x2_t*)rowp = w; }
    }
};
struct EpiDown {
    static constexpr bool PERM = true; static constexpr int NST = 16;
    unsigned char* Y; const float* bdn; const float* lgt; const PG8_LAS int* cnt; int Ttok; float ascale;
    __device__ __forceinline__ void operator()(const f32x4 (&acc)[2][2][4][2], const Unit& u, int wr, int wc, int fr, int fq) const {
        const int rl = wr * 64 + fr, col0 = u.pn * BM + wc * 32 + 8 * fq; const int ce = cnt[u.e];
        const float* bb = bdn + (size_t)u.e * 1024 + col0; const float* gp = lgt + (size_t)u.e * Ttok + u.lrow0;
        f32x4 bv[2][2];
#pragma unroll
        for (int bj = 0; bj < 2; ++bj)
#pragma unroll
            for (int n = 0; n < 2; ++n) bv[bj][n] = *(const f32x4*)(bb + bj * HALF + 4 * n);
#pragma unroll
        for (int ai = 0; ai < 2; ++ai)
#pragma unroll
            for (int m = 0; m < 4; ++m) { const int r = rl + ai * HALF + m * 16; const float gt = (u.lrow0 + r < ce) ? gp[r] * FP8_SY : 0.f;
                unsigned char* rowp = Y + (size_t)(u.pm * BM + r) * 1024 + col0;
#pragma unroll
                for (int bj = 0; bj < 2; ++bj) { const f32x4 v0 = (acc[ai][bj][m][0] * ascale + bv[bj][0]) * gt, v1 = (acc[ai][bj][m][1] * ascale + bv[bj][1]) * gt;
                    typedef unsigned u32x2_t __attribute__((ext_vector_type(2))); u32x2_t w; w.x = pack4_fp8(v0[0], v0[1], v0[2], v0[3]); w.y = pack4_fp8(v1[0], v1[1], v1[2], v1[3]);
                    *(u32x2_t*)(rowp + bj * HALF) = w; } }
    }
};

typedef int v4i_t __attribute__((ext_vector_type(4)));
typedef int v8i_t __attribute__((ext_vector_type(8)));
template <class Epi, class Sched, bool ALIGN_EPI, bool GATHER, bool FP8 = false, int ABL = 0, bool SP2 = true>
__device__ __forceinline__ void gemm_phase(PG8_LAS unsigned char* lds, const Gemm g, const Sched& S, const Epi& E, const PG8_LAS unsigned* tab, volatile PG8_LAS unsigned* prb = nullptr) {
    const int tid = threadIdx.x, wid = __builtin_amdgcn_readfirstlane(tid >> 6), lane = tid & 63, wr = wid >> 2, wc = wid & 3, fr = lane & 15, fq = lane >> 4;
    const int K = g.K, nt = K / BK;
    unsigned voffA[2], voffB[2], cby[2]; int rsl[2];
#pragma unroll
    for (int i = 0; i < 2; ++i) { int R, C; stage_rc(tid * 16 + i * 8192, R, C); const int Rb = Epi::PERM ? ((R & ~31) + perm32(R & 31)) : R;
        voffA[i] = (unsigned)(R * K + C) * 2u; voffB[i] = (unsigned)(Rb * K + C) * 2u; rsl[i] = R; cby[i] = (unsigned)C * 2u; }
    const size_t kstep = (size_t)(BK * 2);
    const size_t hstep = (size_t)HALF * K * 2;
    const size_t tstep = 2 * hstep;
    const size_t ahstep = GATHER ? 0 : hstep;
    const unsigned ldsw = (unsigned)wid * 1024u;
    const int aoff0 = lds_byte(wr * 64 + fr, fq * 8), aoff1 = lds_byte(wr * 64 + fr, 32 + fq * 8), boff0 = lds_byte(wc * 32 + fr, fq * 8), boff1 = lds_byte(wc * 32 + fr, 32 + fq * 8);
#define PG8_SA(b, h) (((b) * 2 + (h)) * HTB)
#define PG8_SB(b, h) ((4 + (b) * 2 + (h)) * HTB)
#define PG8_STAGE(bufoff, gbase, voff) do { if constexpr (ABL != 2 && ABL != 4) _Pragma("unroll") for (int _i = 0; _i < 2; ++_i) \
        __builtin_amdgcn_global_load_lds((const unsigned*)((const char*)(gbase) + (voff)[_i]), (PG8_LAS unsigned*)(lds + (bufoff) + ldsw + _i * 8192), 16, 0, 0); } while (0)
#define PG8_LD16(off) (*(const PG8_LAS v4i_t*)(lds + (off)))
#define PG8_LDA(dst, b, h) do { if constexpr (ABL != 3 && ABL != 4) _Pragma("unroll") for (int m = 0; m < 4; ++m) { if constexpr (FP8) dst##8[m] = __builtin_shufflevector(PG8_LD16(PG8_SA(b, h) + aoff0 + m * 2048), PG8_LD16(PG8_SA(b, h) + aoff1 + m * 2048), 0, 1, 2, 3, 4, 5, 6, 7); \
        else { _Pragma("unroll") for (int k = 0; k < 2; ++k) dst[m][k] = *(const PG8_LAS bf16x8*)(lds + PG8_SA(b, h) + (k ? aoff1 : aoff0) + m * 2048); } } } while (0)
#define PG8_LDB(dst, b, h) do { if constexpr (ABL != 3 && ABL != 4) _Pragma("unroll") for (int n = 0; n < 2; ++n) { if constexpr (FP8) dst##8[n] = __builtin_shufflevector(PG8_LD16(PG8_SB(b, h) + boff0 + n * 2048), PG8_LD16(PG8_SB(b, h) + boff1 + n * 2048), 0, 1, 2, 3, 4, 5, 6, 7); \
        else { _Pragma("unroll") for (int k = 0; k < 2; ++k) dst[n][k] = *(const PG8_LAS bf16x8*)(lds + PG8_SB(b, h) + (k ? boff1 : boff0) + n * 2048); } } } while (0)
#define PG8_MMA(ai, bj, At, Bt) do { if constexpr (ABL == 1) { if constexpr (FP8) { _Pragma("unroll") for (int m = 0; m < 4; ++m) asm volatile("" :: "v"(At##8[m])); _Pragma("unroll") for (int n = 0; n < 2; ++n) asm volatile("" :: "v"(Bt##8[n])); } } else { \
        __builtin_amdgcn_s_setprio(1); _Pragma("unroll") for (int m = 0; m < 4; ++m) _Pragma("unroll") for (int n = 0; n < 2; ++n) { \
        if constexpr (FP8) asm volatile("v_mfma_f32_16x16x128_f8f6f4 %0, %1, %2, %0" : "+v"(acc[ai][bj][m][n]) : "v"(Bt##8[n]), "v"(At##8[m]));   \
        else { _Pragma("unroll") for (int k = 0; k < 2; ++k) acc[ai][bj][m][n] = __builtin_amdgcn_mfma_f32_16x16x32_bf16(Bt[n][k], At[m][k], acc[ai][bj][m][n], 0, 0, 0); } } \
        __builtin_amdgcn_s_setprio(0); } } while (0)
#define PG8_WAIT_V(n) asm volatile("s_waitcnt vmcnt(" #n ")" ::: "memory")
#define PG8_WAIT_L(n) asm volatile("s_waitcnt lgkmcnt(" #n ")" ::: "memory")
#define PG8_WAIT_V8X(relax) asm volatile("s_cmp_eq_u32 %0, 0\n\ts_cbranch_scc1 1f\n\ts_waitcnt vmcnt(%1)\n\ts_branch 2f\n1:\n\ts_waitcnt vmcnt(8)\n2:" :: "s"(relax), "n"(8 + Epi::NST) : "memory", "scc")
#define PG8_BAR __builtin_amdgcn_s_barrier()
#define PG8_SCHED __builtin_amdgcn_sched_barrier(0)
    Unit cur, nxt; int ui = 0;
    if (!S.next(0, cur)) return;
    f32x4 acc[2][2][4][2];
#pragma unroll
    for (int a = 0; a < 2; ++a)
#pragma unroll
        for (int b = 0; b < 2; ++b)
#pragma unroll
            for (int m = 0; m < 4; ++m)
#pragma unroll
                for (int n = 0; n < 2; ++n) acc[a][b][m][n] = (f32x4){0.f, 0.f, 0.f, 0.f};
    bf16x8 At[4][2] = {}, B0[2][2] = {}, B1[2][2] = {}; v8i_t At8[4] = {}, B08[2] = {}, B18[2] = {};
    const char* cA = GATHER ? (const char*)g.A : (const char*)g.A + (size_t)cur.pm * tstep; const char* cB = (const char*)g.Bt + cur.boff + (size_t)cur.pn * tstep;
    unsigned cv0[2], cv1[2], nv0[2], nv1[2];
#pragma unroll
    for (int i = 0; i < 2; ++i) { if constexpr (GATHER) { cv0[i] = tab[rsl[i]] + cby[i]; cv1[i] = tab[HALF + rsl[i]] + cby[i]; } else { cv0[i] = voffA[i]; cv1[i] = voffA[i]; } nv0[i] = cv0[i]; nv1[i] = cv1[i]; }
    if constexpr (SP2) { PG8_STAGE(PG8_SB(0, 0), cB, voffB); PG8_STAGE(PG8_SB(0, 1), cB + hstep, voffB); PG8_STAGE(PG8_SA(0, 0), cA, cv0); PG8_STAGE(PG8_SA(0, 1), cA + ahstep, cv1);
        if (wr == 1) PG8_BAR;
        PG8_WAIT_V(2); PG8_BAR; }
    else { PG8_STAGE(PG8_SB(0, 0), cB, voffB); PG8_STAGE(PG8_SA(0, 0), cA, cv0); PG8_STAGE(PG8_SB(0, 1), cB + hstep, voffB); PG8_STAGE(PG8_SA(0, 1), cA + ahstep, cv1);
        if (wr == 1) PG8_BAR;
        PG8_WAIT_V(4); PG8_BAR; }
    PG8_STAGE(PG8_SB(1, 0), cB + kstep, voffB); PG8_STAGE(PG8_SA(1, 0), cA + kstep, cv0); PG8_STAGE(PG8_SB(1, 1), cB + hstep + kstep, voffB);
    PG8_WAIT_V(6); PG8_BAR;
    for (;;) {
        const bool has_next = S.next(ui + 1, nxt);
        const char* nA = has_next ? (GATHER ? (const char*)g.A : (const char*)g.A + (size_t)nxt.pm * tstep) : cA; const char* nB = has_next ? (const char*)g.Bt + nxt.boff + (size_t)nxt.pn * tstep : cB;
        if constexpr (GATHER) {
#pragma unroll
            for (int i = 0; i < 2; ++i) { if (has_next) { nv0[i] = tab[(ui + 1) * BM + rsl[i]] + cby[i]; nv1[i] = tab[(ui + 1) * BM + HALF + rsl[i]] + cby[i]; } else { nv0[i] = cv0[i]; nv1[i] = cv1[i]; } }
        }
        for (int t = 0; t < nt; t += 2) {
            const bool last = (t == nt - 2);
            const char* a1 = cA + (size_t)(t + 1) * kstep;
            const char* a2 = last ? nA : cA + (size_t)(t + 2) * kstep; const char* b2 = last ? nB : cB + (size_t)(t + 2) * kstep;
            const char* a3 = a2 + kstep; const char* b3 = b2 + kstep;
            unsigned s0[2], s1[2];
#pragma unroll
            for (int i = 0; i < 2; ++i) { s0[i] = last ? nv0[i] : cv0[i]; s1[i] = last ? nv1[i] : cv1[i]; }
            if constexpr (SP2) {
            PG8_LDB(B0, 0, 0); PG8_LDB(B1, 0, 1); PG8_SCHED; PG8_LDA(At, 0, 0); PG8_STAGE(PG8_SA(1, 1), a1 + ahstep, cv1);
            PG8_WAIT_V(8); PG8_WAIT_L(0); PG8_BAR; PG8_MMA(0, 0, At, B0); PG8_MMA(0, 1, At, B1); PG8_BAR; PG8_SCHED;
            PG8_LDA(At, 0, 1); PG8_STAGE(PG8_SB(0, 0), b2, voffB); PG8_STAGE(PG8_SB(0, 1), b2 + hstep, voffB); PG8_STAGE(PG8_SA(0, 0), a2, s0);
            PG8_WAIT_V(8); PG8_WAIT_L(0); PG8_BAR; PG8_MMA(1, 0, At, B0); PG8_MMA(1, 1, At, B1); PG8_BAR; PG8_SCHED;
            PG8_LDB(B0, 1, 0); PG8_LDB(B1, 1, 1); PG8_SCHED; PG8_LDA(At, 1, 0); PG8_STAGE(PG8_SA(0, 1), a2 + ahstep, s1);
            PG8_WAIT_V(8); PG8_WAIT_L(0); PG8_BAR; PG8_MMA(0, 0, At, B0); PG8_MMA(0, 1, At, B1); PG8_BAR; PG8_SCHED;
            PG8_LDA(At, 1, 1); PG8_STAGE(PG8_SB(1, 0), b3, voffB); PG8_STAGE(PG8_SB(1, 1), b3 + hstep, voffB); PG8_STAGE(PG8_SA(1, 0), a3, s0);
            PG8_WAIT_V(8); PG8_WAIT_L(0); PG8_BAR; PG8_MMA(1, 0, At, B0); PG8_MMA(1, 1, At, B1); PG8_BAR; PG8_SCHED;
            } else {
            PG8_LDB(B0, 0, 0); PG8_SCHED; PG8_LDA(At, 0, 0); PG8_STAGE(PG8_SA(1, 1), a1 + ahstep, cv1);
            PG8_WAIT_L(8); PG8_BAR; PG8_WAIT_L(0); PG8_MMA(0, 0, At, B0); PG8_BAR; PG8_SCHED;
            PG8_LDB(B1, 0, 1); PG8_STAGE(PG8_SB(0, 0), b2, voffB);
            PG8_BAR; PG8_WAIT_L(0); PG8_MMA(0, 1, At, B1); PG8_BAR;
            PG8_LDA(At, 0, 1); PG8_STAGE(PG8_SA(0, 0), a2, s0);
            PG8_BAR; PG8_WAIT_L(0); PG8_MMA(1, 0, At, B0); PG8_BAR; PG8_SCHED;
            PG8_STAGE(PG8_SB(0, 1), b2 + hstep, voffB);
            PG8_WAIT_V(6); PG8_BAR; PG8_MMA(1, 1, At, B1); PG8_BAR;
            PG8_LDB(B0, 1, 0); PG8_SCHED; PG8_LDA(At, 1, 0); PG8_STAGE(PG8_SA(0, 1), a2 + ahstep, s1);
            PG8_WAIT_L(8); PG8_BAR; PG8_WAIT_L(0); PG8_MMA(0, 0, At, B0); PG8_BAR; PG8_SCHED;
            PG8_LDB(B1, 1, 1); PG8_STAGE(PG8_SB(1, 0), b3, voffB);
            PG8_BAR; PG8_WAIT_L(0); PG8_MMA(0, 1, At, B1); PG8_BAR;
            PG8_LDA(At, 1, 1); PG8_STAGE(PG8_SA(1, 0), a3, s0);
            PG8_BAR; PG8_WAIT_L(0); PG8_MMA(1, 0, At, B0); PG8_BAR; PG8_SCHED;
            PG8_STAGE(PG8_SB(1, 1), b3 + hstep, voffB);
            PG8_WAIT_V(6); PG8_BAR; PG8_MMA(1, 1, At, B1); PG8_BAR;
            }
        }
        unsigned long long pt0_ = 0; if (prb) pt0_ = __builtin_amdgcn_s_memrealtime();
        if constexpr (FP8) asm volatile("s_nop 15\n\ts_nop 7" ::: "memory");
        if constexpr (ALIGN_EPI) { if (wr == 0) PG8_BAR; }
        E(acc, cur, wr, wc, fr, fq);
        if (prb) { asm volatile("s_waitcnt vmcnt(0)" ::: "memory"); if (threadIdx.x == 0) prb[0] += (unsigned)(__builtin_amdgcn_s_memrealtime() - pt0_); }
        if (!has_next) break;
#pragma unroll
        for (int a = 0; a < 2; ++a)
#pragma unroll
            for (int b = 0; b < 2; ++b)
#pragma unroll
                for (int m = 0; m < 4; ++m)
#pragma unroll
                    for (int n = 0; n < 2; ++n) acc[a][b][m][n] = (f32x4){0.f, 0.f, 0.f, 0.f};
        cur = nxt; cA = nA; cB = nB; ++ui;
#pragma unroll
        for (int i = 0; i < 2; ++i) { cv0[i] = nv0[i]; cv1[i] = nv1[i]; }
        if constexpr (ALIGN_EPI) { if (wr == 1) PG8_BAR; }
    }
    PG8_WAIT_V(0);
    if constexpr (!ALIGN_EPI) { if (wr == 0) PG8_BAR; }
    PG8_BAR;
#undef PG8_SA
#undef PG8_SB
#undef PG8_STAGE
#undef PG8_LDA
#undef PG8_LD16
#undef PG8_LDB
#undef PG8_MMA
#undef PG8_WAIT_V
#undef PG8_WAIT_L
#undef PG8_WAIT_V8X
#undef PG8_BAR
#undef PG8_SCHED
}
}
#include <hip/hip_bf16.h>
#include <cmath>
namespace attn_body {
using bf16=__hip_bfloat16;
using bf16x8=__attribute__((ext_vector_type(8)))short;
using s16x4=__attribute__((ext_vector_type(4)))short;
using f32x16=__attribute__((ext_vector_type(16)))float;
using u32x4=__attribute__((ext_vector_type(4)))unsigned;
constexpr int BATCH=4,NHEAD=8,SEQ=8192,D=64,DM=NHEAD*D,ODM=1024;
constexpr int NW=8,QBLK=32,QB=QBLK*NW,KVBLK=64,NQB=SEQ/QB;
constexpr int ATTN_PITCH=DM, ATTN_UNIT_ROWS=QB;
__device__ __forceinline__ int crow(int r,int hi){return (r&3)+8*(r>>2)+4*hi;}
#define SBAR() __builtin_amdgcn_sched_barrier(0)
__device__ __forceinline__ void cmask(f32x16&p0,f32x16&p1,int jb,int qrel,int hi){
  const float NEG=-INFINITY; int kb=64*jb+4*hi;
  #pragma unroll
  for(int r=0;r<16;++r){int kv=kb+(r&3)+8*(r>>2); if(kv>qrel)p0[r]=NEG; if(kv+32>qrel)p1[r]=NEG;}
}

constexpr int NSLOT=3, SLOTB=8192;
constexpr int LDS_K=0, LDS_V=NSLOT*SLOTB, LDS_WS=2*NSLOT*SLOTB, LDS_OST=LDS_WS+NW*64*4, LDS_C2=LDS_OST+NW*4096, LDS_BYTES=LDS_C2+SEQ*4;
constexpr float C2=0.125f*1.4426950408889634f;
__device__ __forceinline__ void glds16(const void*gsrc,unsigned lds_dst){unsigned keep;
  asm volatile("s_mov_b32 %0, m0\n\ts_mov_b32 m0, %2\n\ts_nop 0\n\tglobal_load_lds_dwordx4 %1, off\n\ts_mov_b32 m0, %0":"=&s"(keep):"v"(gsrc),"s"(lds_dst):"memory");}
__device__ __forceinline__ float max3f(float a,float b,float c){float r;asm("v_max3_f32 %0, %1, %2, %3":"=v"(r):"v"(a),"v"(b),"v"(c));return r;}
__device__ __forceinline__ float max2f(float a,float b){float r;asm("v_max_f32_e32 %0, %1, %2":"=v"(r):"v"(a),"v"(b));return r;}
__device__ __forceinline__ float fadd_s(float a,float b){float r;asm("v_add_f32_e32 %0, %1, %2":"=v"(r):"v"(a),"v"(b));return r;}
__device__ __forceinline__ float fsub_s(float a,float b){float r;asm("v_sub_f32_e32 %0, %1, %2":"=v"(r):"v"(a),"v"(b));return r;}
typedef float f32x2_t __attribute__((ext_vector_type(2))); typedef float f32x4_t __attribute__((ext_vector_type(4))); typedef __bf16 bf16x2_t __attribute__((ext_vector_type(2)));
__device__ __forceinline__ unsigned cvtpk_s(float lo,float hi){f32x2_t v={lo,hi};bf16x2_t b=__builtin_convertvector(v,bf16x2_t);return __builtin_bit_cast(unsigned,b);}
#define WAIT_BAR(N) asm volatile("s_waitcnt vmcnt(" #N ") lgkmcnt(0)\n\ts_barrier":::"memory")

__device__ __forceinline__ void qkt(f32x16&p0,f32x16&p1,const char*Kslot,const bf16x8*qr,const f32x16&cin0,const f32x16&cin1,int r32,int hi){
  const char*kb=Kslot+hi*1024+r32*16;
  #pragma unroll
  for(int d0=0;d0<4;++d0){
    const bf16x8 b0=*reinterpret_cast<const bf16x8*>(kb+d0*2048);
    const bf16x8 b1=*reinterpret_cast<const bf16x8*>(kb+d0*2048+512);
    if(d0==0){p0=__builtin_amdgcn_mfma_f32_32x32x16_bf16(b0,qr[0],cin0,0,0,0);p1=__builtin_amdgcn_mfma_f32_32x32x16_bf16(b1,qr[0],cin1,0,0,0);}
    else{p0=__builtin_amdgcn_mfma_f32_32x32x16_bf16(b0,qr[d0],p0,0,0,0);p1=__builtin_amdgcn_mfma_f32_32x32x16_bf16(b1,qr[d0],p1,0,0,0);}}
}
typedef __attribute__((address_space(3))) const char* lds_cptr;
typedef short v4i16_t __attribute__((ext_vector_type(4)));
__device__ __forceinline__ void kload8(bf16x8*kf,lds_cptr kp){
  kf[0]=*(const __attribute__((address_space(3))) bf16x8*)(kp);      kf[1]=*(const __attribute__((address_space(3))) bf16x8*)(kp+512);
  kf[2]=*(const __attribute__((address_space(3))) bf16x8*)(kp+2048); kf[3]=*(const __attribute__((address_space(3))) bf16x8*)(kp+2560);
  kf[4]=*(const __attribute__((address_space(3))) bf16x8*)(kp+4096); kf[5]=*(const __attribute__((address_space(3))) bf16x8*)(kp+4608);
  kf[6]=*(const __attribute__((address_space(3))) bf16x8*)(kp+6144); kf[7]=*(const __attribute__((address_space(3))) bf16x8*)(kp+6656);
}
__device__ __forceinline__ void kload2(bf16x8*kf,lds_cptr kp,int j){ kf[2*j]=*(const __attribute__((address_space(3))) bf16x8*)(kp+j*2048); kf[2*j+1]=*(const __attribute__((address_space(3))) bf16x8*)(kp+j*2048+512); }
__device__ __forceinline__ s16x4 vtr(lds_cptr p){ return __builtin_bit_cast(s16x4,__builtin_amdgcn_ds_read_tr16_b64_v4i16((__attribute__((address_space(3))) v4i16_t*)p)); }
__device__ __forceinline__ float rowmax(const f32x16&p0,const f32x16&p1){
  float a=max3f(p0[0],p0[1],p1[0]),b=max3f(p0[2],p0[3],p1[1]);a=max3f(a,p1[2],p1[3]);
  #pragma unroll
  for(int r=4;r<16;r+=4){a=max3f(a,p0[r],p0[r+1]);b=max3f(b,p0[r+2],p0[r+3]);a=max3f(a,p1[r],p1[r+1]);b=max3f(b,p1[r+2],p1[r+3]);}
  const float m=max2f(a,b);
  auto rr=__builtin_amdgcn_permlane32_swap(__float_as_uint(m),__float_as_uint(m),false,false);
  return max2f(__uint_as_float(rr[0]),__uint_as_float(rr[1]));
}
__device__ __forceinline__ void pv(f32x16*o,int vb,bf16x8 pa0,bf16x8 pa1,bf16x8 pa2,bf16x8 pa3){
  #pragma unroll
  for(int d0=0;d0<2;++d0){s16x4 lo[4],hi[4];
    #pragma unroll
    for(int ks=0;ks<4;++ks){
      asm volatile("ds_read_b64_tr_b16 %0,%1 offset:%c2":"=&v"(lo[ks]):"v"(vb),"i"(d0*4096+ks*1024):"memory");
      asm volatile("ds_read_b64_tr_b16 %0,%1 offset:%c2":"=&v"(hi[ks]):"v"(vb),"i"(d0*4096+ks*1024+512):"memory");}
    asm volatile("s_waitcnt lgkmcnt(0)":::"memory");SBAR();
    #define PK(k) (bf16x8){lo[k][0],lo[k][1],lo[k][2],lo[k][3],hi[k][0],hi[k][1],hi[k][2],hi[k][3]}
    o[d0]=__builtin_amdgcn_mfma_f32_32x32x16_bf16(pa0,PK(0),o[d0],0,0,0);
    o[d0]=__builtin_amdgcn_mfma_f32_32x32x16_bf16(pa1,PK(1),o[d0],0,0,0);
    o[d0]=__builtin_amdgcn_mfma_f32_32x32x16_bf16(pa2,PK(2),o[d0],0,0,0);
    o[d0]=__builtin_amdgcn_mfma_f32_32x32x16_bf16(pa3,PK(3),o[d0],0,0,0);
    #undef PK
  }
}

#ifndef ATTN_STORE16
#define ATTN_STORE16(p,v) (*(u32x4*)(p)=(v))
#endif
template<int THRL> __device__ __forceinline__ void attn_unit(int b,int h,int qb,const bf16*Q,const bf16*__restrict__ K,const bf16*__restrict__ V,bf16*O,char*shm,int j0,unsigned*attn_probe_ctr=nullptr){
  const int tid=threadIdx.x,lane=tid&63,r32=lane&31,hi=lane>>5; const int wid=__builtin_amdgcn_readfirstlane(tid>>6);
  const long rowbase=(long)b*SEQ; const int q0=qb*QB;
  const bf16*Qw=Q+(rowbase+q0+wid*QBLK)*DM+h*D;
  const bf16*Kh=K+rowbase*DM+h*D,*Vh=V+rowbase*DM+h*D;
  const unsigned lds0=(unsigned)(uintptr_t)shm; const lds_cptr shm3=(lds_cptr)shm;
  float*wsf=(float*)(shm+LDS_WS)+wid*64;
  const bf16*ksrc=Kh+(long)lane*DM+wid*8;
  const bf16*vsrc=Vh+(long)(16*(wid&3)+(lane>>2))*DM+(wid>>2)*32+(lane&3)*8;
  const unsigned kdst=lds0+LDS_K+wid*1024, vdst=lds0+LDS_V+wid*1024;
  #define DMA_K(t,slot) glds16(ksrc+(long)(t)*KVBLK*DM,(unsigned)__builtin_amdgcn_readfirstlane(kdst+(slot)))
  #define DMA_V(t,slot) glds16(vsrc+(long)(t)*KVBLK*DM,(unsigned)__builtin_amdgcn_readfirstlane(vdst+(slot)))
  const int vb0=(int)(lds0+LDS_V)+((lane>>4)&1)*32+(lane&3)*8+(4*hi+((lane&15)>>2))*64;
  const char*Kbase=shm+LDS_K; bf16x8 kf[8];
  const lds_cptr kp0=shm3+LDS_K+hi*1024+r32*16; const lds_cptr vp0=shm3+LDS_V+((lane>>4)&1)*32+(lane&3)*8+(4*hi+((lane&15)>>2))*64;
  const int NT=(q0+QB)/KVBLK;
  if(attn_probe_ctr && threadIdx.x==0) atomicAdd(attn_probe_ctr, (unsigned)(NT-j0));
  DMA_K(j0,0);DMA_V(j0,0);DMA_K(j0+1,SLOTB);
  bf16x8 qr[4];
  #pragma unroll
  for(int d0=0;d0<4;++d0)qr[d0]=*reinterpret_cast<const bf16x8*>(&Qw[(long)r32*DM+d0*16+hi*8]);
  float l_reg=0.f;f32x16 o[2];o[0]=f32x16{};o[1]=f32x16{};
  typedef __attribute__((address_space(3))) const f32x4_t* lds_f4ptr; const lds_f4ptr c2p=(lds_f4ptr)(shm3+LDS_C2)+hi;
  float ctm=((const __attribute__((address_space(3))) float*)(shm3+LDS_C2))[q0+wid*QBLK+r32];
  f32x16 cin0,cin1;
  #define CIN(t) do{ const lds_f4ptr cq_=c2p+16*(t); const f32x4_t a0_=cq_[0],a1_=cq_[2],a2_=cq_[4],a3_=cq_[6],b0_=cq_[8],b1_=cq_[10],b2_=cq_[12],b3_=cq_[14]; \
    _Pragma("unroll") for(int j_=0;j_<4;++j_){ cin0[j_]=ctm-a0_[j_];cin0[4+j_]=ctm-a1_[j_];cin0[8+j_]=ctm-a2_[j_];cin0[12+j_]=ctm-a3_[j_]; cin1[j_]=ctm-b0_[j_];cin1[4+j_]=ctm-b1_[j_];cin1[8+j_]=ctm-b2_[j_];cin1[12+j_]=ctm-b3_[j_]; } }while(0)
  const int qrel=wid*QBLK+r32;
  #define CMASK(P0,P1,t) do{int jb_=(t)-(NT-4); if(jb_>=0)cmask(P0,P1,jb_,qrel,hi);}while(0)
  bool resc=false;
  #define START(P0,P1) do{ const float rm=rowmax(P0,P1); resc=false; \
    if(__any(rm>(float)THRL)){ const float dl=__builtin_fmaxf(rm,0.f); ctm-=dl; \
      _Pragma("unroll") for(int r=0;r<16;++r){P0[r]-=dl;P1[r]-=dl;} } \
    _Pragma("unroll") for(int r=0;r<16;++r)P0[r]=__builtin_amdgcn_exp2f(P0[r]); }while(0)
  #define RESC() do{ if(resc){ asm volatile("s_waitcnt lgkmcnt(0)":::"memory"); \
      _Pragma("unroll") for(int d_=0;d_<2;++d_) _Pragma("unroll") for(int r=0;r<16;++r)o[d_][r]*=wsf[crow(r,hi)]; } }while(0)
  f32x16 pA0,pA1,pB0,pB1;
  int sl_prev=0,sl_cur=0,sl_next=SLOTB;
  #define ROT() do{sl_prev=sl_cur;sl_cur=sl_next;sl_next=(sl_next==(NSLOT-1)*SLOTB)?0:sl_next+SLOTB;}while(0)
  DMA_K(j0+2,2*SLOTB);
  WAIT_BAR(3);
  CIN(j0); qkt(pA0,pA1,Kbase,qr,cin0,cin1,r32,hi);asm volatile("s_nop 15\n\ts_nop 7":"+v"(pA0),"+v"(pA1));CMASK(pA0,pA1,j0);
  START(pA0,pA1);
  _Pragma("unroll") for(int r=0;r<16;++r)pA1[r]=__builtin_amdgcn_exp2f(pA1[r]);
  WAIT_BAR(0);
  DMA_K(j0+3,0);DMA_V(j0+1,SLOTB);
  ROT();
  kload8(kf,kp0+sl_cur);
  WAIT_BAR(2);
  s16x4 vlo[8],vhi[8]; u32x4 pw0,pw1,pw2,pw3;
  #define PKW(P,B) cvtpk_s(P[B],P[B+1])
  #define PAF(k) __builtin_bit_cast(bf16x8,pw##k)
  #define VFR(i) (bf16x8){vlo[i][0],vlo[i][1],vlo[i][2],vlo[i][3],vhi[i][0],vhi[i][1],vhi[i][2],vhi[i][3]}
  #define PIN(x) asm volatile("":"+v"(x))
  #define MX3(a,b,c) __builtin_fmaxf(__builtin_fmaxf((a),(b)),(c))
  #define GAPA(MF,A0,A1,A2,A3,W0,W1,PW) do{ MF; sacc+=A0; sacc+=A1; sacc+=A2; sacc+=A3; PIN(sacc); W0; W1; PIN(PW); SBAR(); }while(0)
  #define EX(v) __builtin_amdgcn_exp2f(v)
  #define GAPB(MF,X,B) do{ MF; X[B]=EX(X[B]); X[B+1]=EX(X[B+1]); X[B+2]=EX(X[B+2]); X[B+3]=EX(X[B+3]); PIN(X); SBAR(); }while(0)
  #define VRD(i) do{ vlo[i]=vtr(vp_+(((i)>>2)*4096+((i)&3)*1024)); vhi[i]=vtr(vp_+(((i)>>2)*4096+((i)&3)*1024+512)); }while(0)
  #define KRD(G,j) do{ if(G){ kload2(kf,kp0+sl_next,j); SBAR(); } }while(0)
  #define STEP(C0,C1,P0,P1,t,GK,GV,GL) do{ SBAR(); CIN(t); SBAR(); \
    const lds_cptr vp_=vp0+sl_prev; \
    VRD(0); SBAR(); float sacc=(P0[0]+P0[1]); \
    GAPA(C0=__builtin_amdgcn_mfma_f32_32x32x16_bf16(kf[0],qr[0],cin0,0,0,0), P0[2],P0[3],P0[4],P0[5],     pw0[0]=PKW(P0,0), pw0[1]=PKW(P0,2), pw0); \
    VRD(4); SBAR(); GAPA(C1=__builtin_amdgcn_mfma_f32_32x32x16_bf16(kf[1],qr[0],cin1,0,0,0), P0[6],P0[7],P0[8],P0[9],     pw0[2]=PKW(P0,4), pw0[3]=PKW(P0,6), pw0); \
    VRD(1); SBAR(); GAPA(C0=__builtin_amdgcn_mfma_f32_32x32x16_bf16(kf[2],qr[1],C0,0,0,0),   P0[10],P0[11],P0[12],P0[13], pw1[0]=PKW(P0,8), pw1[1]=PKW(P0,10), pw1); \
    VRD(5); SBAR(); GAPA(C1=__builtin_amdgcn_mfma_f32_32x32x16_bf16(kf[3],qr[1],C1,0,0,0),   P0[14],P0[15],P1[0],P1[1],   pw1[2]=PKW(P0,12),pw1[3]=PKW(P0,14), pw1); \
    VRD(2); SBAR(); GAPA(C0=__builtin_amdgcn_mfma_f32_32x32x16_bf16(kf[4],qr[2],C0,0,0,0),   P1[2],P1[3],P1[4],P1[5],     pw2[0]=PKW(P1,0), pw2[1]=PKW(P1,2), pw2); \
    VRD(6); SBAR(); GAPA(C1=__builtin_amdgcn_mfma_f32_32x32x16_bf16(kf[5],qr[2],C1,0,0,0),   P1[6],P1[7],P1[8],P1[9],     pw2[2]=PKW(P1,4), pw2[3]=PKW(P1,6), pw2); \
    VRD(3); SBAR(); GAPA(C0=__builtin_amdgcn_mfma_f32_32x32x16_bf16(kf[6],qr[3],C0,0,0,0),   P1[10],P1[11],P1[12],P1[13], pw3[0]=PKW(P1,8), pw3[1]=PKW(P1,10), pw3); \
    VRD(7); SBAR(); GAPA(C1=__builtin_amdgcn_mfma_f32_32x32x16_bf16(kf[7],qr[3],C1,0,0,0),   P1[14],P1[15],0.f,0.f,       pw3[2]=PKW(P1,12),pw3[3]=PKW(P1,14), pw3); \
    l_reg+=sacc; \
    if(GK){DMA_K((t)+3,sl_cur);} if(GV){DMA_V((t)+1,sl_next);} \
    CMASK(C0,C1,t); \
    { float a=MX3(C0[0],C0[1],C1[0]),b=MX3(C0[2],C0[3],C1[1]); a=MX3(a,C1[2],C1[3]); \
      _Pragma("unroll") for(int r=4;r<16;r+=4){a=MX3(a,C0[r],C0[r+1]);b=MX3(b,C0[r+2],C0[r+3]);a=MX3(a,C1[r],C1[r+1]);b=MX3(b,C1[r+2],C1[r+3]);} \
      float rm=__builtin_fmaxf(a,b); { auto rr=__builtin_amdgcn_permlane32_swap(__float_as_uint(rm),__float_as_uint(rm),false,false); rm=__builtin_fmaxf(__uint_as_float(rr[0]),__uint_as_float(rr[1])); } \
      resc=false; \
      if(__builtin_expect(__any(rm>(float)THRL),0)){ const float dl=__builtin_fmaxf(rm,0.f); ctm-=dl; \
        _Pragma("unroll") for(int r=0;r<16;++r){C0[r]-=dl;C1[r]-=dl;} \
        const float f=__builtin_amdgcn_exp2f(-dl); l_reg*=f; if(hi==0)wsf[r32]=f; resc=true; } } \
    SBAR(); \
    GAPB(o[0]=__builtin_amdgcn_mfma_f32_32x32x16_bf16(PAF(0),VFR(0),o[0],0,0,0), C0,0); \
    GAPB(o[1]=__builtin_amdgcn_mfma_f32_32x32x16_bf16(PAF(0),VFR(4),o[1],0,0,0), C0,4); \
    KRD(GL,0); GAPB(o[0]=__builtin_amdgcn_mfma_f32_32x32x16_bf16(PAF(1),VFR(1),o[0],0,0,0), C0,8); \
    KRD(GL,1); GAPB(o[1]=__builtin_amdgcn_mfma_f32_32x32x16_bf16(PAF(1),VFR(5),o[1],0,0,0), C0,12); \
    KRD(GL,2); GAPB(o[0]=__builtin_amdgcn_mfma_f32_32x32x16_bf16(PAF(2),VFR(2),o[0],0,0,0), C1,0); \
    KRD(GL,3); GAPB(o[1]=__builtin_amdgcn_mfma_f32_32x32x16_bf16(PAF(2),VFR(6),o[1],0,0,0), C1,4); \
    GAPB(o[0]=__builtin_amdgcn_mfma_f32_32x32x16_bf16(PAF(3),VFR(3),o[0],0,0,0), C1,8); \
    GAPB(o[1]=__builtin_amdgcn_mfma_f32_32x32x16_bf16(PAF(3),VFR(7),o[1],0,0,0), C1,12); \
    }while(0)
  int t=j0+1;
  #undef CMASK
  #define CMASK(P0,P1,t) do{}while(0)
  for(;t+5<NT;t+=2){
    STEP(pB0,pB1,pA0,pA1,t,true,true,true);     WAIT_BAR(2); RESC(); ROT();
    STEP(pA0,pA1,pB0,pB1,t+1,true,true,true);   WAIT_BAR(2); RESC(); ROT();
  }
  #undef CMASK
  #define CMASK(P0,P1,t) do{int jb_=(t)-(NT-4); if(jb_>=0)cmask(P0,P1,jb_,qrel,hi);}while(0)
  #define ENDW(tt) do{ if((tt)+3<NT){WAIT_BAR(2);} else if((tt)+2<NT){WAIT_BAR(1);} else {WAIT_BAR(0);} }while(0)
  for(;t+1<NT;t+=2){
    STEP(pB0,pB1,pA0,pA1,t,(t+3<NT),(t+1<NT),(t+1<NT));       ENDW(t);   RESC(); ROT();
    STEP(pA0,pA1,pB0,pB1,t+1,(t+4<NT),(t+2<NT),(t+2<NT));     ENDW(t+1); RESC(); ROT();
  }
  STEP(pB0,pB1,pA0,pA1,NT-1,false,false,false); RESC();
  { float sacc=pB0[0]+pB0[1]; _Pragma("unroll") for(int r=2;r<16;++r)sacc+=pB0[r]; _Pragma("unroll") for(int r=0;r<16;++r)sacc+=pB1[r]; l_reg+=sacc;
    pw0=(u32x4){PKW(pB0,0),PKW(pB0,2),PKW(pB0,4),PKW(pB0,6)};pw1=(u32x4){PKW(pB0,8),PKW(pB0,10),PKW(pB0,12),PKW(pB0,14)};pw2=(u32x4){PKW(pB1,0),PKW(pB1,2),PKW(pB1,4),PKW(pB1,6)};pw3=(u32x4){PKW(pB1,8),PKW(pB1,10),PKW(pB1,12),PKW(pB1,14)};
    SBAR(); pv(o,vb0+sl_cur,PAF(0),PAF(1),PAF(2),PAF(3)); }
  #undef PKW
  #undef PAF
  #undef VFR
  #undef PIN
  #undef MX3
  #undef GAPA
  #undef GAPB
  #undef EX
  #undef VRD
  #undef KRD
  #undef STEP
  #undef ENDW
  {auto rr=__builtin_amdgcn_permlane32_swap(__float_as_uint(l_reg),__float_as_uint(l_reg),false,false);l_reg=__uint_as_float(rr[0])+__uint_as_float(rr[1]);}
  if(hi==0)wsf[32+r32]=l_reg;asm volatile("s_waitcnt lgkmcnt(0)":::"memory");
  float rli[16];
  #pragma unroll
  for(int r=0;r<16;++r)rli[r]=__builtin_amdgcn_rcpf(wsf[32+crow(r,hi)]);
  bf16*Ow=O+(rowbase+q0+wid*QBLK)*ODM+h*D;
  { bf16*stg=(bf16*)(shm+LDS_OST)+wid*2048;
    #pragma unroll
    for(int r=0;r<16;++r){const int orow=crow(r,hi);
      #pragma unroll
      for(int d0=0;d0<2;++d0)stg[orow*64+d0*32+r32]=__float2bfloat16(o[d0][r]*rli[r]);}
    asm volatile("s_waitcnt lgkmcnt(0)":::"memory");
    #pragma unroll
    for(int i=0;i<4;++i){const int row=i*8+(lane>>3),ch=lane&7; const u32x4 v=*(const u32x4*)(stg+row*64+ch*8); ATTN_STORE16(Ow+(long)row*ODM+ch*8,v);} }
  asm volatile("s_waitcnt lgkmcnt(0)\n\ts_barrier":::"memory");
  #undef CIN
  #undef DMA_K
  #undef DMA_V
  #undef CMASK
  #undef START
  #undef RESC
  #undef ROT
}
constexpr int ATTN_LDS_BYTES=LDS_BYTES;
struct AttnTensors { const bf16* Q; const bf16* K; const bf16* V; bf16* O; };
struct AttnUnit { int bh; int qb; };
struct StaticOrder {
  int vcu;
  __device__ __forceinline__ explicit StaticOrder(int grid,int block):vcu((block%8)*(grid/8)+block/8){}
  __device__ __forceinline__ bool next(int i,AttnUnit&u)const{ if(i>=4)return false; const int s=vcu&7; u.bh=vcu>>3; u.qb=(i==0)?s:(i==1)?15-s:(i==2)?16+s:31-s; return true; }
  __device__ __forceinline__ void a_ready(const AttnUnit&)const{}
  __device__ __forceinline__ void done(const AttnUnit&)const{}
};
template<class Sched,int THRL=8> __device__ __forceinline__ void attn_phase(char*lds,const AttnTensors&T,const Sched&S,float qkb2){
  AttnUnit u;
  for(int i=0;S.next(i,u);++i){ S.a_ready(u); attn_unit<THRL>(u.bh/NHEAD,u.bh%NHEAD,u.qb,T.Q,T.K,T.V,T.O,lds,qkb2); S.done(u); }
}
#undef SBAR
#undef WAIT_BAR
}
#define GAS __attribute__((address_space(1)))
#define LAS __attribute__((address_space(3)))
typedef GAS unsigned gu32;
#define RLX_AGENT __ATOMIC_RELAXED, __HIP_MEMORY_SCOPE_AGENT
#define LDS_WAIT() asm volatile("s_waitcnt lgkmcnt(0)" ::: "memory")
#define VM_WAIT() asm volatile("s_waitcnt vmcnt(0)" ::: "memory")

constexpr int NWAVES = 8;
constexpr int N_PHASES = 8;
constexpr int RING_OFF = 0, RING_BYTES = 131072;
constexpr int TAB_OFF = 131072, TAB_UNITS = 17;
constexpr int LDS_TOTAL = 155648;
constexpr int LDSCTL_OFF = LDS_TOTAL - 1024;
static_assert(TAB_OFF + TAB_UNITS * 256 * 4 <= LDSCTL_OFF, "LDS map");
constexpr int CW_Q = 128, CW_NRM = 256;
constexpr size_t WS_X1B = WS_P;
constexpr size_t WS_TOT = WS_SEL + 768 * 1024;
constexpr int CW_BAR = 4096;

#define XB_TMO      128
#define XB_XCNT(j)  (256  + 64 * (j))
#define XB_XSUB(j)  (1280 + 64 * (j))
#define XB_XGEN(j)  (2304 + 64 * (j))
#define XB_TOP      3328
#define XB_TOPGEN   3392
#define XCD_BAR_WORDS 3456
#define XB_SPIN_CAP (1u << 18)

__device__ __forceinline__ unsigned xb_ld(unsigned* p)              { return __hip_atomic_load(p, __ATOMIC_RELAXED, __HIP_MEMORY_SCOPE_AGENT); }
__device__ __forceinline__ unsigned xb_add(unsigned* p, unsigned v) { return __hip_atomic_fetch_add(p, v, __ATOMIC_RELAXED, __HIP_MEMORY_SCOPE_AGENT); }
__device__ __forceinline__ unsigned xb_xcc_id() { return (unsigned)__builtin_amdgcn_s_getreg((3 << 11) | 20) & 0xFu; }
#define XB_SPIN(cond, bar) do { unsigned _sp = 0; while (cond) { __builtin_amdgcn_s_sleep(1); \
    if ((++_sp & 255u) == 0u) { if (xb_ld(&(bar)[XB_TMO])) break; if (_sp > XB_SPIN_CAP) { atomicAdd(&(bar)[XB_TMO], 1u); break; } } } } while (0)

struct XcdBarrier {
    unsigned* bar; unsigned x;
    volatile LAS unsigned* st;
};

__device__ __forceinline__ XcdBarrier xcd_barrier_post(unsigned* bar, volatile LAS unsigned* st) {
    XcdBarrier b; b.bar = bar; b.x = xb_xcc_id(); b.st = st;
    if (threadIdx.x == 0) (void)xb_add(&bar[XB_XCNT(b.x)], 1u);
    return b;
}
__device__ __forceinline__ void xcd_barrier_complete(unsigned* bar, unsigned x, unsigned& nloc, unsigned& nx) {
    const unsigned G = gridDim.x * gridDim.y * gridDim.z;
    unsigned sum, cnt, mine, sp = 0u;
    for (;;) {
        sum = 0u; cnt = 0u; mine = 0u;
#pragma unroll
        for (unsigned j = 0; j < 16; ++j) { const unsigned c = xb_ld(&bar[XB_XCNT(j)]); sum += c; cnt += (c > 0u) ? 1u : 0u; mine = (j == x) ? c : mine; }
        if (sum == G) break;
        __builtin_amdgcn_s_sleep(1);
        if ((++sp & 255u) == 0u) { if (xb_ld(&bar[XB_TMO])) break; if (sp > XB_SPIN_CAP) { atomicAdd(&bar[XB_TMO], 1u); break; } }
    }
    nloc = mine > 0u ? mine : 1u; nx = cnt > 0u ? cnt : 1u;
}

__device__ __forceinline__ void xcd_barrier(const XcdBarrier& b) {
    asm volatile("s_waitcnt vmcnt(0)" ::: "memory");
    __syncthreads();
    if (threadIdx.x == 0) {
        unsigned* bar = b.bar;
        __builtin_amdgcn_s_waitcnt(0);
        unsigned nloc = b.st[0], nx = b.st[1];
        if (nloc == 0u) { xcd_barrier_complete(bar, b.x, nloc, nx); b.st[0] = nloc; b.st[1] = nx; }
        const unsigned old = xb_add(&bar[XB_XSUB(b.x)], 1u);
        const unsigned gen = old / nloc;
        if (old + 1u == (gen + 1u) * nloc) {
            __builtin_amdgcn_fence(__ATOMIC_RELEASE, "agent");
            asm volatile("s_waitcnt vmcnt(0)" ::: "memory");
            const unsigned og = xb_add(&bar[XB_TOP], 1u);
            const unsigned tg = og / nx;
            if (og + 1u == (tg + 1u) * nx) xb_add(&bar[XB_TOPGEN], 1u);
            else XB_SPIN(xb_ld(&bar[XB_TOPGEN]) == tg, bar);
            __builtin_amdgcn_fence(__ATOMIC_ACQUIRE, "agent");
            xb_add(&bar[XB_XGEN(b.x)], 1u);
            asm volatile("s_waitcnt vmcnt(0)" ::: "memory");
        } else {
            XB_SPIN(xb_ld(&bar[XB_XGEN(b.x)]) == gen, bar);
            __builtin_amdgcn_fence(__ATOMIC_ACQUIRE, "agent");
            asm volatile("s_waitcnt vmcnt(0)" ::: "memory");
        }
    }
    __syncthreads();
}


#ifndef MK_SP2
#define MK_SP2 true
#endif
#ifndef MK_THRL
#define MK_THRL 8
#endif
struct Args { const float* in[15]; float* out; unsigned char* ws; int ph_lo, ph_hi, use_bar, pad; };

__device__ __forceinline__ void p0_transpose_item(const float* W, int ldw, bf16* WT, int ldt, LAS float* scr, int lane) {
    float tv[32];
    const float* wp_ = W + (size_t)(lane >> 5) * ldw + (lane & 31);
#pragma unroll
    for (int i = 0; i < 32; ++i) tv[i] = wp_[(size_t)(2 * i) * ldw];
#pragma unroll
    for (int i = 0; i < 32; ++i) scr[(2 * i + (lane >> 5)) * 33 + (lane & 31)] = tv[i];
    LDS_WAIT(); asm volatile("" ::: "memory");
    const int c = lane & 7;
#pragma unroll
    for (int j = 0; j < 4; ++j) { const int n = (lane >> 3) + 8 * j; const LAS float* s = scr + (8 * c) * 33 + n;
        u32x4 o; o.x = pg8::cvt_pk_bf16(s[0 * 33], s[1 * 33]); o.y = pg8::cvt_pk_bf16(s[2 * 33], s[3 * 33]); o.z = pg8::cvt_pk_bf16(s[4 * 33], s[5 * 33]); o.w = pg8::cvt_pk_bf16(s[6 * 33], s[7 * 33]);
        *(GAS u32x4*)(WT + (size_t)n * ldt + 8 * c) = o; }
    LDS_WAIT(); asm volatile("" ::: "memory");
}
__device__ __forceinline__ void p0_transpose_item_fp8(const float* W, int ldw, unsigned char* WT, int ldt, LAS float* scr, int lane) {
    float tv[32];
    const float* wp_ = W + (size_t)(lane >> 5) * ldw + (lane & 31);
#pragma unroll
    for (int i = 0; i < 32; ++i) tv[i] = wp_[(size_t)(2 * i) * ldw];
#pragma unroll
    for (int i = 0; i < 32; ++i) scr[(2 * i + (lane >> 5)) * 33 + (lane & 31)] = tv[i];
    LDS_WAIT(); asm volatile("" ::: "memory");
    const int c = lane & 7;
#pragma unroll
    for (int j = 0; j < 4; ++j) { const int n = (lane >> 3) + 8 * j; const LAS float* s = scr + (8 * c) * 33 + n; const float k_ = pg8::FP8_SW;
        u32x2 o; o.x = pg8::pack4_fp8(s[0 * 33] * k_, s[1 * 33] * k_, s[2 * 33] * k_, s[3 * 33] * k_); o.y = pg8::pack4_fp8(s[4 * 33] * k_, s[5 * 33] * k_, s[6 * 33] * k_, s[7 * 33] * k_);
        *(GAS u32x2*)(WT + (size_t)n * ldt + 8 * c) = o; }
    LDS_WAIT(); asm volatile("" ::: "memory");
}
constexpr int J_WU = 32 * 16 * 32, J_WD = 32 * 16 * 16;
struct ConvItem { const float* src; int ldw; unsigned char* dst; };
__device__ __forceinline__ ConvItem conv_item(const Args& a, int r) {
    ConvItem it;
    if (r < J_WU) { const int e = r >> 9, kb = (r >> 5) & 15, nb = r & 31, n0 = 64 * nb;
        const int rowp = n0 < 1024 ? (n0 >> 7) * 256 + (n0 & 127) : ((n0 - 1024) >> 7) * 256 + 128 + ((n0 - 1024) & 127);
        it.src = a.in[10] + (size_t)e * DM * 2048 + (size_t)(64 * kb) * 2048 + n0; it.ldw = 2048; it.dst = a.ws + WS_WU + ((size_t)e * 2048 + rowp) * DM + 64 * kb; return it; }
    r -= J_WU;
    { const int e = r >> 8, kb = (r >> 4) & 15, nb = r & 15;
      it.src = a.in[12] + (size_t)e * DE * DM + (size_t)(64 * kb) * DM + 64 * nb; it.ldw = DM; it.dst = a.ws + WS_WD + ((size_t)e * DM + 64 * nb) * DE + 64 * kb; return it; }
}
__device__ __forceinline__ void conv_load(float (&tv)[64], const ConvItem& it, int lane) {
    const float* p_ = it.src + lane;
#pragma unroll
    for (int i = 0; i < 64; ++i) { tv[i] = *p_; p_ += it.ldw; asm volatile("" : "+v"(p_)); }
}
__device__ __forceinline__ void conv_finish(const float (&tv)[64], const ConvItem& it, int lane) {
    const float k_ = pg8::FP8_SW; unsigned char* d_ = it.dst + (size_t)lane * DM;
#pragma unroll
    for (int q = 0; q < 4; ++q) { u32x4 o;
        o.x = pg8::pack4_fp8(tv[16 * q + 0] * k_, tv[16 * q + 1] * k_, tv[16 * q + 2] * k_, tv[16 * q + 3] * k_); o.y = pg8::pack4_fp8(tv[16 * q + 4] * k_, tv[16 * q + 5] * k_, tv[16 * q + 6] * k_, tv[16 * q + 7] * k_);
        o.z = pg8::pack4_fp8(tv[16 * q + 8] * k_, tv[16 * q + 9] * k_, tv[16 * q + 10] * k_, tv[16 * q + 11] * k_); o.w = pg8::pack4_fp8(tv[16 * q + 12] * k_, tv[16 * q + 13] * k_, tv[16 * q + 14] * k_, tv[16 * q + 15] * k_);
        *(GAS u32x4*)(d_ + 16 * q) = o; }
}
constexpr int CONV_P2_CHUNKS = 1024, CONV_P4_PER_WAVE = 0, CONV_P0_PER_WAVE = 0;
static_assert(CONV_P2_CHUNKS * 24 + 2048 * CONV_P0_PER_WAVE == J_WU + J_WD, "conversion split");
__device__ __forceinline__ void conv_triple(const Args& a, int r0, int lane) {
    const ConvItem i0 = conv_item(a, r0), i1 = conv_item(a, r0 + 1), i2 = conv_item(a, r0 + 2);
    float ta[64], tb[64];
    conv_load(ta, i0, lane); conv_load(tb, i1, lane);
    conv_finish(ta, i0, lane);
    conv_load(ta, i2, lane);
    conv_finish(tb, i1, lane);
    conv_finish(ta, i2, lane);
}
__device__ __forceinline__ void conv_chunk(const Args& a, int cc, int lane, int wave) { conv_triple(a, cc * 24 + wave * 3, lane); }

constexpr int I_WIN = 16 * 64, I_WO = 8 * 32, I_WEFF = 4 * 16 * 16, I_WU = 32 * 16 * 64, I_WD = 32 * 16 * 32;
constexpr int P0_ITEMS = I_WIN + I_WO + I_WEFF;

__device__ __forceinline__ void phase0(const Args& a, LAS unsigned char* L, int vcu, int G, int tid, int lane, int wave) {
    const float* w_in = a.in[2]; const float* w_pool = a.in[4]; const float* pscale = a.in[5]; const float* w_out = a.in[6];
    bf16* Win_t = (bf16*)(a.ws + WS_WIN); bf16* Wo_t = (bf16*)(a.ws + WS_WO);
    LAS float* scr = (LAS float*)(L + wave * 8448);
    LAS float* wf = (LAS float*)(L + 69632);
    for (int i = tid; i < 1024 * 8; i += 512) { const int d = i >> 3, p_ = ((d & 255) >> 2) + 64 * (4 * (d >> 8) + (d & 3)); wf[p_ * 12 + (i & 7)] = w_in[(size_t)d * INW + 2048 + (i & 7)]; }
    __syncthreads();
    const int gw = vcu * NWAVES + wave, NGW = G * NWAVES;
    {
        const float* x = a.in[0]; const float* g_mix = a.in[1]; const float* b_forget = a.in[3];
        bf16* XN = (bf16*)(a.ws + WS_XN); float* LOGF = (float*)(a.ws + WS_LOGF);
        f32x4 g[4];
#pragma unroll
        for (int j = 0; j < 4; ++j) g[j] = *(const f32x4*)(g_mix + 4 * lane + 256 * j);
        f32x4 vn[2][4];
#pragma unroll
        for (int q = 0; q < 2; ++q)
#pragma unroll
            for (int j = 0; j < 4; ++j) vn[q][j] = *(const f32x4*)(x + (size_t)(gw + q * NGW) * DM + 4 * lane + 256 * j);
        int trip = 0;
        for (int m = gw; m < T; m += 2 * NGW, ++trip) {
            const bool cv_ = (NGW == 2048) && (trip < CONV_P0_PER_WAVE);
            ConvItem cit{}; float ct_[64];
            if (cv_) { cit = conv_item(a, CONV_P2_CHUNKS * 24 + gw * CONV_P0_PER_WAVE + trip); conv_load(ct_, cit, lane); }
            f32x4 v[2][4]; float ss[2] = {0.f, 0.f};
#pragma unroll
            for (int q = 0; q < 2; ++q)
#pragma unroll
                for (int j = 0; j < 4; ++j) { v[q][j] = vn[q][j]; ss[q] += v[q][j].x * v[q][j].x + v[q][j].y * v[q][j].y + v[q][j].z * v[q][j].z + v[q][j].w * v[q][j].w; }
            { const int mn = (m + 2 * NGW < T) ? m + 2 * NGW : m;
#pragma unroll
              for (int q = 0; q < 2; ++q)
#pragma unroll
                  for (int j = 0; j < 4; ++j) vn[q][j] = *(const f32x4*)(x + (size_t)(mn + q * NGW) * DM + 4 * lane + 256 * j); }
#pragma unroll
            for (int o = 1; o < 64; o <<= 1) { ss[0] += __shfl_xor(ss[0], o); ss[1] += __shfl_xor(ss[1], o); }
            float fl[2][8];
#pragma unroll
            for (int q = 0; q < 2; ++q) { const float rstd = rsqrtf(ss[q] * (1.f / DM) + RMS_EPS);
#pragma unroll
                for (int e = 0; e < 8; ++e) fl[q][e] = 0.f;
#pragma unroll
                for (int j = 0; j < 4; ++j) v[q][j] = v[q][j] * rstd * g[j]; }
#pragma unroll
            for (int j = 0; j < 4; ++j) {
#pragma unroll
                for (int i = 0; i < 4; ++i) {
                    const int prow = lane + 64 * (4 * j + i);
                    const f32x4 w0 = *(const LAS f32x4*)(wf + prow * 12), w1 = *(const LAS f32x4*)(wf + prow * 12 + 4);
#pragma unroll
                    for (int q = 0; q < 2; ++q) { const float hv = v[q][j][i];
                        fl[q][0] += hv * w0.x; fl[q][1] += hv * w0.y; fl[q][2] += hv * w0.z; fl[q][3] += hv * w0.w;
                        fl[q][4] += hv * w1.x; fl[q][5] += hv * w1.y; fl[q][6] += hv * w1.z; fl[q][7] += hv * w1.w; }
                }
#pragma unroll
                for (int q = 0; q < 2; ++q) { u32x2 o; o.x = pk2(v[q][j].x, v[q][j].y); o.y = pk2(v[q][j].z, v[q][j].w);
                    *(u32x2*)(XN + (size_t)(m + q * NGW) * DM + 4 * lane + 256 * j) = o; }
            }
            float z[2];
            { const bool u5 = lane >= 32, u4 = (lane & 16) != 0, u3 = (lane & 8) != 0; float a4[2][4], a2[2][2];
#pragma unroll
              for (int q = 0; q < 2; ++q)
#pragma unroll
                  for (int e = 0; e < 4; ++e) { const float keep = u5 ? fl[q][4 + e] : fl[q][e], give = u5 ? fl[q][e] : fl[q][4 + e]; a4[q][e] = keep + __shfl_xor(give, 32); }
#pragma unroll
              for (int q = 0; q < 2; ++q)
#pragma unroll
                  for (int e = 0; e < 2; ++e) { const float keep = u4 ? a4[q][2 + e] : a4[q][e], give = u4 ? a4[q][e] : a4[q][2 + e]; a2[q][e] = keep + __shfl_xor(give, 16); }
#pragma unroll
              for (int q = 0; q < 2; ++q) z[q] = (u3 ? a2[q][1] : a2[q][0]) + __shfl_xor(u3 ? a2[q][0] : a2[q][1], 8);
#pragma unroll
              for (int o = 4; o >= 1; o >>= 1) { z[0] += __shfl_xor(z[0], o); z[1] += __shfl_xor(z[1], o); } }
            if ((lane & 7) == 0) {
                const int hd = lane >> 3; const float bfv = b_forget[hd];
#pragma unroll
                for (int q = 0; q < 2; ++q) { const int mm = m + q * NGW; const float zz = z[q] + bfv; const float ls = fminf(zz, 0.f) - log1pf(expf(-fabsf(zz)));
                    LOGF[((size_t)(mm / SEQ) * NH + hd) * SEQ + (mm % SEQ)] = ls; }
            }
            if (cv_) conv_finish(ct_, cit, lane);
        }
    }
    for (int it = gw; it < P0_ITEMS; it += NGW) {
        int r = it;
        if (r < I_WIN) { const int kb = r >> 6, nb = r & 63; p0_transpose_item(w_in + (size_t)(64 * kb) * INW + 32 * nb, INW, Win_t + (size_t)(32 * nb) * DM + 64 * kb, DM, scr, lane); continue; } r -= I_WIN;
        if (r < I_WO) { const int kb = r >> 5, nb = r & 31; p0_transpose_item(w_out + (size_t)(512 + 64 * kb) * DM + 32 * nb, DM, Wo_t + (size_t)(32 * nb) * DM + 512 + 64 * kb, DM, scr, lane); continue; } r -= I_WO;
        if (r < I_WEFF) {
            const int g = r >> 8, nb = (r >> 4) & 15, kb = r & 15, n = nb * 64 + lane; float acc[8];
#pragma unroll
            for (int i = 0; i < 8; ++i) acc[i] = 0.f;
            const float* wp = w_pool + (size_t)g * 16384 + (size_t)(kb * 8) * 128;
#pragma unroll 2
            for (int d = 0; d < 128; d += 4) { f32x4 av;
#pragma unroll
                for (int q = 0; q < 4; ++q) av[q] = w_out[(size_t)(g * 128 + d + q) * DM + n];
                av = av * *(const f32x4*)(pscale + g * 128 + d);
#pragma unroll
                for (int i = 0; i < 8; ++i) { const f32x4 wv = *(const f32x4*)(wp + i * 128 + d); acc[i] += av.x * wv.x + av.y * wv.y + av.z * wv.z + av.w * wv.w; } }
            u32x4 o; o.x = pk2(acc[0], acc[1]); o.y = pk2(acc[2], acc[3]); o.z = pk2(acc[4], acc[5]); o.w = pk2(acc[6], acc[7]);
            *(GAS u32x4*)(Wo_t + (size_t)n * DM + g * 128 + kb * 8) = o; continue; } r -= I_WEFF;
        }
}

template <int W> __device__ __forceinline__ void pool_run(const bf16* U, bf16* CAT, int row0, int c0) {
    const int t0 = row0 % SEQ;
    u32x4 blk[8], tr[W - 1];
#pragma unroll
    for (int i = 0; i < 8; ++i) blk[i] = *(const u32x4*)(U + (size_t)(row0 + i) * PW + c0);
#pragma unroll
    for (int j = 1; j < W; ++j) { const u32x4 v_ = *(const u32x4*)(U + (size_t)(t0 - j >= 0 ? row0 - j : row0) * PW + c0); tr[j - 1] = (t0 - j >= 0) ? v_ : (u32x4){0u, 0u, 0u, 0u}; }
    float S[8];
#pragma unroll
    for (int k = 0; k < 8; ++k) S[k] = 0.f;
#pragma unroll
    for (int j = 0; j < W - 1; ++j) { const unsigned rr[4] = {tr[j].x, tr[j].y, tr[j].z, tr[j].w};
#pragma unroll
        for (int k = 0; k < 4; ++k) { S[2 * k] += __builtin_bit_cast(float, rr[k] << 16); S[2 * k + 1] += __builtin_bit_cast(float, rr[k] & 0xffff0000u); } }
#pragma unroll
    for (int i = 0; i < 8; ++i) { const int t = t0 + i; float cur[8];
        { const unsigned rr[4] = {blk[i].x, blk[i].y, blk[i].z, blk[i].w};
#pragma unroll
          for (int k = 0; k < 4; ++k) { cur[2 * k] = __builtin_bit_cast(float, rr[k] << 16); cur[2 * k + 1] = __builtin_bit_cast(float, rr[k] & 0xffff0000u); } }
        const float inv = 1.f / (float)(t + 1 < W ? t + 1 : W); float o[8];
#pragma unroll
        for (int k = 0; k < 8; ++k) { S[k] += cur[k]; o[k] = S[k] * inv - cur[k]; }
        u32x4 ov; ov.x = pk2(o[0], o[1]); ov.y = pk2(o[2], o[3]); ov.z = pk2(o[4], o[5]); ov.w = pk2(o[6], o[7]);
        *(u32x4*)(CAT + (size_t)(row0 + i) * DM + c0) = ov;
        const u32x4 sb = (i - (W - 1) >= 0) ? blk[(i - (W - 1) >= 0) ? i - (W - 1) : 0] : tr[(i - (W - 1) >= 0) ? 0 : (W - 1) - i - 1];
        { const unsigned rr[4] = {sb.x, sb.y, sb.z, sb.w};
#pragma unroll
          for (int k = 0; k < 4; ++k) { S[2 * k] -= __builtin_bit_cast(float, rr[k] << 16); S[2 * k + 1] -= __builtin_bit_cast(float, rr[k] & 0xffff0000u); } }
    }
}
__device__ __forceinline__ void pool_chunk(const Args& a, int c, int tid) {
    const bf16* U = (const bf16*)(a.ws + WS_U); bf16* CAT = (bf16*)(a.ws + WS_CAT);
    const int wv = tid >> 6, ln = tid & 63, g = wv & 3, ch = 16 * g + (ln & 15), c0 = ch * 8;
#pragma unroll 1
    for (int hf = 0; hf < 2; ++hf) { const int row0 = 128 * c + 8 * (hf * 8 + (wv >> 2) * 4 + (ln >> 4));
        if (g == 0) pool_run<2>(U, CAT, row0, c0); else if (g == 1) pool_run<4>(U, CAT, row0, c0); else if (g == 2) pool_run<8>(U, CAT, row0, c0); else pool_run<16>(U, CAT, row0, c0); }
}
__device__ __forceinline__ void c2_local_scan(const Args& a, LAS unsigned char* L, int bx, int tid, int lane, int wave) {
    if (bx >= 256) return;
    const int bh = bx >> 3, blk = bx & 7; const size_t off = (size_t)bh * SEQ + blk * 1024 + tid * 2;
    const float* src = (const float*)(a.ws + WS_LOGF) + off; float* dst = (float*)(a.ws + WS_CUM) + off;
    LAS double* wtot = (LAS double*)(L + 0);
    const float v0 = src[0], v1 = src[1]; const double s = (double)v0 + (double)v1; double inc = s;
#pragma unroll
    for (int o = 1; o < 64; o <<= 1) { const double t_ = __shfl_up(inc, o); if (lane >= o) inc += t_; }
    if (lane == 63) wtot[wave] = inc;
    __syncthreads();
    double base = inc - s;
    for (int w = 0; w < wave; ++w) base += wtot[w];
    dst[0] = (float)((base + (double)v0) * (double)LOG2E); dst[1] = (float)((base + s) * (double)LOG2E);
    if (tid == 511) ((float*)(a.ws + WS_TOT))[bh * 8 + blk] = (float)((base + s) * (double)LOG2E);
    __syncthreads();
}
__device__ __forceinline__ int c2_prepare(const Args& a, LAS unsigned char* L, int bh, int qb, float qkb2, int tid) {
    const float* cum = (const float*)(a.ws + WS_CUM) + (size_t)bh * SEQ; const float* tot = (const float*)(a.ws + WS_TOT) + bh * 8;
    LAS float* c2s = (LAS float*)(L + attn_body::LDS_C2);
    float pre[8]; { double b_ = 0.0;
#pragma unroll
        for (int w = 0; w < 8; ++w) { pre[w] = (float)b_; b_ += (double)tot[w]; } }
    const int q0 = qb * 256, NT = 4 * qb + 4, lane = tid & 63;
    float pq = 0.f;
#pragma unroll
    for (int w = 0; w < 8; ++w) if ((q0 >> 10) == w) pq = pre[w];
    const float cq = cum[q0] + pq + qkb2 + 40.0f;
    int j0;
    { const int m = lane; bool sk = false;
      if (m >= 1 && m <= ((NT - 4) >> 1)) { const int pos = 128 * m - 1; float pp = 0.f;
#pragma unroll
          for (int w = 0; w < 8; ++w) if ((pos >> 10) == w) pp = pre[w];
          sk = (cq - (cum[pos] + pp)) < 0.f; }
      const unsigned long long bal = __ballot(sk) >> 1;
      j0 = 2 * (int)__builtin_ctzll(~bal); }
    for (int idx = 64 * j0 + 4 * tid; idx < q0 + 256; idx += 4 * 512) { float pp = 0.f;
#pragma unroll
        for (int w = 0; w < 8; ++w) if ((idx >> 10) == w) pp = pre[w];
        f32x4 v = *(const f32x4*)(cum + idx); v = v + pp; *(LAS f32x4*)(c2s + idx) = v; }
    __syncthreads();
    return __builtin_amdgcn_readfirstlane(j0);
}

constexpr int RT_GWH = 0, RT_GWL = 65536, RT_GF = 131072, RT_CHE = 135168, RT_CHG = RT_CHE + 2048, RT_LCNT = RT_CHG + 2048, RT_LBASE = RT_LCNT + 128;
static_assert(RT_LBASE + 128 <= LDSCTL_OFF, "router LDS map");
__device__ __forceinline__ void router_phase(const Args& a, LAS unsigned char* L, int vcu, int G, int tid, int lane, int wave) {
    typedef short bf16x8_t __attribute__((ext_vector_type(8)));
    LAS unsigned short* gwh = (LAS unsigned short*)(L + RT_GWH); LAS unsigned short* gwl = (LAS unsigned short*)(L + RT_GWL); LAS float* gf = (LAS float*)(L + RT_GF);
    LAS int* ch_e = (LAS int*)(L + RT_CHE); LAS float* ch_g = (LAS float*)(L + RT_CHG); LAS int* lcnt = (LAS int*)(L + RT_LCNT); LAS int* lbase = (LAS int*)(L + RT_LBASE);
    const float* w_router = a.in[8]; const float* b_router = a.in[9]; const float* g_ffn = a.in[7];
    for (int idx = tid; idx < 1024 * 32; idx += 512) { const int k = idx >> 5, e = idx & 31; const float v = g_ffn[k] * w_router[idx];
        const unsigned hb = f2bf(v); const float hf = __builtin_bit_cast(float, hb << 16); const unsigned lb = f2bf(v - hf);
        const int pos = (((k >> 5) * 4 + ((k >> 3) & 3)) * 32 + e) * 8 + (k & 7); gwh[pos] = (unsigned short)hb; gwl[pos] = (unsigned short)lb; }
    for (int k = tid; k < 1024; k += 512) gf[k] = g_ffn[k];
    __syncthreads();
    const bf16* X1 = (const bf16*)(a.ws + WS_X1B); unsigned char* H2 = a.ws + WS_XN;
    int* cnt = (int*)(a.ws + WS_CTL) + CW_CNT; int* SEL = (int*)(a.ws + WS_SEL); int* LTK = (int*)(a.ws + WS_LTK); float* LGT = (float*)(a.ws + WS_LGT);
    const int j = lane & 15, q = lane >> 4;
    for (int grp = vcu; grp < T / 128; grp += G) {
        if (tid < 32) lcnt[tid] = 0;
        __syncthreads();
        {
            const int lt = wave * 16 + j, m = grp * 128 + lt;
            const bf16* xr = X1 + (size_t)m * DM + 8 * q;
            pg8::f32x4 acc0 = {0.f, 0.f, 0.f, 0.f}, acc1 = {0.f, 0.f, 0.f, 0.f}; float ss = 0.f;
#pragma unroll 8
            for (int s = 0; s < 32; ++s) {
                const u32x4 xb = *(const u32x4*)(xr + 32 * s);
                const LAS unsigned short* wp = gwh + ((s * 4 + q) * 32 + j) * 8; const LAS unsigned short* wl = gwl + ((s * 4 + q) * 32 + j) * 8;
                const bf16x8_t ah0 = *(const LAS bf16x8_t*)wp, ah1 = *(const LAS bf16x8_t*)(wp + 128), al0 = *(const LAS bf16x8_t*)wl, al1 = *(const LAS bf16x8_t*)(wl + 128);
                const bf16x8_t xf = __builtin_bit_cast(bf16x8_t, xb);
                acc0 = __builtin_amdgcn_mfma_f32_16x16x32_bf16(ah0, xf, acc0, 0, 0, 0); acc1 = __builtin_amdgcn_mfma_f32_16x16x32_bf16(ah1, xf, acc1, 0, 0, 0);
                acc0 = __builtin_amdgcn_mfma_f32_16x16x32_bf16(al0, xf, acc0, 0, 0, 0); acc1 = __builtin_amdgcn_mfma_f32_16x16x32_bf16(al1, xf, acc1, 0, 0, 0);
                const unsigned w_[4] = {xb.x, xb.y, xb.z, xb.w};
#pragma unroll
                for (int c = 0; c < 4; ++c) { const float lo = __builtin_bit_cast(float, w_[c] << 16), hi = __builtin_bit_cast(float, w_[c] & 0xffff0000u); ss += lo * lo + hi * hi; }
            }
            ss += __shfl_xor(ss, 16); ss += __shfl_xor(ss, 32);
            const float rstd = rsqrtf(ss * (1.f / DM) + RMS_EPS);
            float lv[8]; int li[8];
#pragma unroll
            for (int r = 0; r < 4; ++r) { li[r] = 4 * q + r; lv[r] = acc0[r] * rstd + b_router[li[r]]; li[4 + r] = 16 + 4 * q + r; lv[4 + r] = acc1[r] * rstd + b_router[li[4 + r]]; }
            float tv[4]; int ti[4];
#pragma unroll
            for (int k = 0; k < 4; ++k) { float bv = -INFINITY; int bi = 64;
#pragma unroll
                for (int r = 0; r < 8; ++r) if (lv[r] > bv) { bv = lv[r]; bi = li[r]; }
                tv[k] = bv; ti[k] = bi;
#pragma unroll
                for (int r = 0; r < 8; ++r) if (li[r] == bi) lv[r] = -INFINITY; }
#pragma unroll
            for (int st = 16; st <= 32; st <<= 1) {
                float cv[8]; int ci[8];
#pragma unroll
                for (int k = 0; k < 4; ++k) { cv[k] = tv[k]; ci[k] = ti[k]; cv[4 + k] = __shfl_xor(tv[k], st); ci[4 + k] = __shfl_xor(ti[k], st); }
#pragma unroll
                for (int k = 0; k < 4; ++k) { float bv = -INFINITY; int bi = 64;
#pragma unroll
                    for (int c = 0; c < 8; ++c) if (cv[c] > bv || (cv[c] == bv && ci[c] < bi)) { bv = cv[c]; bi = ci[c]; }
                    tv[k] = bv; ti[k] = bi;
#pragma unroll
                    for (int c = 0; c < 8; ++c) if (ci[c] == bi) cv[c] = -INFINITY; } }
            const float e1 = expf(tv[1] - tv[0]), e2 = expf(tv[2] - tv[0]), e3 = expf(tv[3] - tv[0]); const float inv = 1.f / (1.f + e1 + e2 + e3);
            if (q == 0) { ch_e[lt * 4 + 0] = ti[0]; ch_e[lt * 4 + 1] = ti[1]; ch_e[lt * 4 + 2] = ti[2]; ch_e[lt * 4 + 3] = ti[3];
                ch_g[lt * 4 + 0] = inv; ch_g[lt * 4 + 1] = e1 * inv; ch_g[lt * 4 + 2] = e2 * inv; ch_g[lt * 4 + 3] = e3 * inv;
#pragma unroll
                for (int k = 0; k < 4; ++k) __hip_atomic_fetch_add(&lcnt[ti[k]], 1, __ATOMIC_RELAXED, __HIP_MEMORY_SCOPE_WORKGROUP); }
            unsigned char* hr = H2 + (size_t)m * DM + 8 * q; const float sc = rstd * pg8::FP8_SA;
#pragma unroll 8
            for (int s = 0; s < 32; ++s) {
                const u32x4 xb = *(const u32x4*)(xr + 32 * s); const unsigned w_[4] = {xb.x, xb.y, xb.z, xb.w};
                const f32x4 g0 = *(const LAS f32x4*)(gf + 32 * s + 8 * q), g1 = *(const LAS f32x4*)(gf + 32 * s + 8 * q + 4);
                float x_[8];
#pragma unroll
                for (int c = 0; c < 4; ++c) { x_[2 * c] = __builtin_bit_cast(float, w_[c] << 16); x_[2 * c + 1] = __builtin_bit_cast(float, w_[c] & 0xffff0000u); }
                u32x2 o; o.x = pg8::pack4_fp8(x_[0] * g0.x * sc, x_[1] * g0.y * sc, x_[2] * g0.z * sc, x_[3] * g0.w * sc); o.y = pg8::pack4_fp8(x_[4] * g1.x * sc, x_[5] * g1.y * sc, x_[6] * g1.z * sc, x_[7] * g1.w * sc);
                *(u32x2*)(hr + 32 * s) = o;
            }
        }
        __syncthreads();
        if (tid < 32) { lbase[tid] = atomicAdd(&cnt[tid], lcnt[tid]); lcnt[tid] = 0; }
        __syncthreads();
        { const int e = ch_e[tid]; const int slot = lbase[e] + __hip_atomic_fetch_add(&lcnt[e], 1, __ATOMIC_RELAXED, __HIP_MEMORY_SCOPE_WORKGROUP); const int tk = (grp * 128 + (tid >> 2)) * 4 + (tid & 3);
          LTK[(size_t)e * T + slot] = tk; LGT[(size_t)e * T + slot] = ch_g[tid]; SEL[tk] = (slot << 5) | e; }
        __syncthreads();
    }
}

__device__ __forceinline__ void expert_map(const Args& a, volatile LAS unsigned* MISC, int tid) {
    if (tid == 0) { const int* cnt = (const int*)(a.ws + WS_CTL) + CW_CNT; int acc = 0;
        for (int e = 0; e < 32; ++e) { const int c = __hip_atomic_load((int*)cnt + e, RLX_AGENT); MISC[64 + e] = (unsigned)c; MISC[96 + e] = (unsigned)acc; acc += (c + RT - 1) / RT; } MISC[128] = (unsigned)acc; }
    __syncthreads();
}

__device__ __forceinline__ void final_phase(const Args& a, volatile LAS unsigned* MISC, int vcu, int G, int lane, int wave) {
    const int* SEL = (const int*)(a.ws + WS_SEL); const unsigned char* Y = a.ws + WS_Y; const bf16* X1 = (const bf16*)(a.ws + WS_X1B); const float* g_final = a.in[14];
    f32x4 g[4];
#pragma unroll
    for (int j = 0; j < 4; ++j) g[j] = *(const f32x4*)(g_final + 4 * lane + 256 * j);
    typedef float f32x2_t __attribute__((ext_vector_type(2)));
    const int m0 = vcu * 8 + wave, MS = G * 8;
    int svn[4]; u32x2 xbn[4];
#pragma unroll
    for (int k = 0; k < 4; ++k) svn[k] = SEL[m0 * 4 + k];
#pragma unroll
    for (int j = 0; j < 4; ++j) xbn[j] = *(const u32x2*)(X1 + (size_t)m0 * DM + 4 * lane + 256 * j);
    for (int m = m0; m < T; m += MS) {
        f32x4 v[4]; unsigned yv[4][4];
#pragma unroll
        for (int k = 0; k < 4; ++k) { const int e = svn[k] & 31, slot = svn[k] >> 5; const unsigned char* yr = Y + ((size_t)MISC[96 + e] * RT + slot) * DM;
#pragma unroll
            for (int j = 0; j < 4; ++j) yv[k][j] = *(const unsigned*)(yr + 4 * lane + 256 * j); }
#pragma unroll
        for (int j = 0; j < 4; ++j) { const u32x2 xb = xbn[j];
            v[j].x = __builtin_bit_cast(float, xb.x << 16); v[j].y = __builtin_bit_cast(float, xb.x & 0xffff0000u); v[j].z = __builtin_bit_cast(float, xb.y << 16); v[j].w = __builtin_bit_cast(float, xb.y & 0xffff0000u); }
        { const int mn = (m + MS < T) ? m + MS : m;
#pragma unroll
          for (int k = 0; k < 4; ++k) svn[k] = SEL[mn * 4 + k];
#pragma unroll
          for (int j = 0; j < 4; ++j) xbn[j] = *(const u32x2*)(X1 + (size_t)mn * DM + 4 * lane + 256 * j); }
        f32x4 ya[4];
#pragma unroll
        for (int j = 0; j < 4; ++j) ya[j] = (f32x4){0.f, 0.f, 0.f, 0.f};
#pragma unroll
        for (int k = 0; k < 4; ++k)
#pragma unroll
            for (int j = 0; j < 4; ++j) { const unsigned y = yv[k][j];
                const f32x2_t lo = __builtin_amdgcn_cvt_pk_f32_fp8((int)y, false), hi = __builtin_amdgcn_cvt_pk_f32_fp8((int)y, true);
                ya[j].x += lo.x; ya[j].y += lo.y; ya[j].z += hi.x; ya[j].w += hi.y; }
        float ss = 0.f;
#pragma unroll
        for (int j = 0; j < 4; ++j) { v[j] = v[j] + ya[j] * (1.0f / pg8::FP8_SY); ss += v[j].x * v[j].x + v[j].y * v[j].y + v[j].z * v[j].z + v[j].w * v[j].w; }
        const float rstd = rsqrtf(wave_sum(ss) * (1.f / DM) + RMS_EPS);
        float* orow = a.out + (size_t)m * DM;
#pragma unroll
        for (int j = 0; j < 4; ++j) *(f32x4*)(orow + 4 * lane + 256 * j) = v[j] * rstd * g[j];
    }
}

__global__ void __launch_bounds__(NWAVES * 64, 2) mk_fwd(Args args) {
    extern __shared__ __attribute__((aligned(16))) unsigned char lds[];
    LAS unsigned char* L = (LAS unsigned char*)lds;
    volatile LAS unsigned* MISC = (volatile LAS unsigned*)(L + LDSCTL_OFF);
    const int tid = threadIdx.x, lane = tid & 63, wave = __builtin_amdgcn_readfirstlane(tid >> 6);
    const int G = gridDim.x; const int bx = blockIdx.x; const int vcu = (G % 8 == 0) ? (bx % 8) * (G / 8) + bx / 8 : bx;
    unsigned char* ws = args.ws;
    for (int u = tid; u < (LDS_TOTAL - LDSCTL_OFF) / 4; u += NWAVES * 64) ((LAS unsigned*)(L + LDSCTL_OFF))[u] = 0u;
    __syncthreads();
    XcdBarrier bar; bar.bar = (unsigned*)(ws + WS_CTL) + CW_BAR; bar.x = 0; bar.st = nullptr;
    if (args.use_bar) bar = xcd_barrier_post((unsigned*)(ws + WS_CTL) + CW_BAR, MISC + 8);
    const int lo = args.ph_lo, hi = args.ph_hi;
#define IN(k) (lo <= (k) && (k) < hi)
#define SEAM(k) do { if (IN(k) && IN((k) + 1)) xcd_barrier(bar); } while (0)
#ifndef MK_DUP
#define MK_DUP -1
#endif
#ifndef MK_TPROBE
#define MK_TPROBE -1
#endif
#define CK0(k) do { if ((MK_TPROBE) == 100 + (k) && bx == 0 && tid == 0) { const unsigned long long c_ = __builtin_amdgcn_s_memtime(); const unsigned long long t_ = __builtin_amdgcn_s_memrealtime(); MISC[28] = (unsigned)c_; MISC[29] = (unsigned)(c_ >> 32); MISC[16] = (unsigned)t_; MISC[17] = (unsigned)(t_ >> 32); } } while (0)
#define CK1(k) do { if ((MK_TPROBE) == 100 + (k) && bx == 0 && tid == 0) { const unsigned long long c_ = __builtin_amdgcn_s_memtime(); const unsigned long long t_ = __builtin_amdgcn_s_memrealtime(); const unsigned long long c0_ = ((unsigned long long)MISC[29] << 32) | MISC[28], t0_ = ((unsigned long long)MISC[17] << 32) | MISC[16]; \
    const unsigned long long spin_ = (c_ - c0_) * 1000ull / (t_ - t0_); MISC[18] = (unsigned)(t0_ + spin_); MISC[19] = (unsigned)((t0_ + spin_) >> 32); } } while (0)
#define TP0(k) do { if ((MK_TPROBE) == (k) && bx == 0 && tid == 0) { const unsigned long long t_ = __builtin_amdgcn_s_memrealtime(); MISC[16] = (unsigned)t_; MISC[17] = (unsigned)(t_ >> 32); } } while (0)
#define TP1(k) do { if ((MK_TPROBE) == (k) && bx == 0 && tid == 0) { const unsigned long long t_ = __builtin_amdgcn_s_memrealtime(); MISC[18] = (unsigned)t_; MISC[19] = (unsigned)(t_ >> 32); } } while (0)
#define REPS(k) for (int rep_ = 0; rep_ < ((MK_DUP) == (k) ? 2 : 1); ++rep_, ((MK_DUP) == (k) && rep_ == 1 ? xcd_barrier(bar) : (void)0))

    TP0(0); CK0(0); TP0(200);
    if ((MK_TPROBE) == 300 || (MK_TPROBE) == 301) {
        if (bx == 0 && tid < 64) { typedef int v8i_ __attribute__((ext_vector_type(8))); typedef short s8_ __attribute__((ext_vector_type(8)));
            pg8::f32x4 c0 = {0, 0, 0, 0}, c1 = c0, c2 = c0, c3 = c0; v8i_ a8 = {tid, 1, 2, 3, 4, 5, 6, 7}, b8 = {7, 6, 5, 4, 3, 2, 1, tid}; s8_ a4 = {1, 2, 3, 4, 5, 6, 7, 8}, b4 = a4;
            const unsigned long long t0_ = __builtin_amdgcn_s_memtime();
            for (int it = 0; it < 1024; ++it) {
                if ((MK_TPROBE) == 300) { asm volatile("v_mfma_f32_16x16x128_f8f6f4 %0, %1, %2, %0" : "+v"(c0) : "v"(a8), "v"(b8)); asm volatile("v_mfma_f32_16x16x128_f8f6f4 %0, %1, %2, %0" : "+v"(c1) : "v"(a8), "v"(b8));
                    asm volatile("v_mfma_f32_16x16x128_f8f6f4 %0, %1, %2, %0" : "+v"(c2) : "v"(a8), "v"(b8)); asm volatile("v_mfma_f32_16x16x128_f8f6f4 %0, %1, %2, %0" : "+v"(c3) : "v"(a8), "v"(b8)); }
                else { c0 = __builtin_amdgcn_mfma_f32_16x16x32_bf16(a4, b4, c0, 0, 0, 0); c1 = __builtin_amdgcn_mfma_f32_16x16x32_bf16(a4, b4, c1, 0, 0, 0); c2 = __builtin_amdgcn_mfma_f32_16x16x32_bf16(a4, b4, c2, 0, 0, 0); c3 = __builtin_amdgcn_mfma_f32_16x16x32_bf16(a4, b4, c3, 0, 0, 0); } }
            asm volatile("s_nop 15\n\ts_nop 15" ::: "memory");
            const unsigned long long t1_ = __builtin_amdgcn_s_memtime();
            asm volatile("" :: "v"(c0), "v"(c1), "v"(c2), "v"(c3));
            if (tid == 0) MISC[21] = (unsigned)((t1_ - t0_) * 1000ull / 4096ull); } }
    if (IN(0)) REPS(0) { phase0(args, L, vcu, G, tid, lane, wave); }
    CK1(0); SEAM(0); TP1(0); TP0(1); CK0(1);
    if (IN(1)) REPS(1) {
        pg8::Gemm g{(const bf16*)(ws + WS_XN), (const bf16*)(ws + WS_WIN), DM}; pg8::StaticOrder S; S.init(T, 2048, G, bx);
        c2_local_scan(args, L, bx, tid, lane, wave);
        pg8::EpiInproj E{(bf16*)(ws + WS_U), (size_t)(WS_Q - WS_U) / 2, C2, (unsigned*)(ws + WS_CTL) + CW_NRM};
        pg8::gemm_phase<pg8::EpiInproj, pg8::StaticOrder, true, false>(L + RING_OFF, g, S, E, nullptr);
    }
    CK1(1); SEAM(1); TP1(1); TP0(2); CK0(2);
    if (IN(2)) {
        constexpr unsigned NQ_POOL = T / 128, NQA = NQ_POOL + 1024, NQC = CONV_P2_CHUNKS;
        unsigned* qhead = (unsigned*)(ws + WS_CTL) + CW_Q; const float* nrm = (const float*)(ws + WS_CTL) + CW_NRM;
        const attn_body::AttnTensors AT{(const attn_body::bf16*)(ws + WS_Q), (const attn_body::bf16*)(ws + WS_K), (const attn_body::bf16*)(ws + WS_V), (attn_body::bf16*)(ws + WS_CAT) + PW};
        #ifndef MK_CONV_MASK
#define MK_CONV_MASK 1
#endif
        const int pref = ((bx & (MK_CONV_MASK)) == 0) ? 1 : 0;
#define QT0() unsigned long long tq0_ = 0; if ((MK_TPROBE) >= 26 && (MK_TPROBE) <= 29 && threadIdx.x == 0) tq0_ = __builtin_amdgcn_s_memrealtime()
#define QT1(kind) do { if ((MK_TPROBE) == (kind) && threadIdx.x == 0) atomicAdd((unsigned*)(ws + WS_CTL) + 512, (unsigned)(__builtin_amdgcn_s_memrealtime() - tq0_)); } while (0)
#define CONV_LOOP() do { unsigned pend_ = 0; int sl_ = 0; if (threadIdx.x == 0) pend_ = atomicAdd(qhead + 64, 1u); \
        for (;;) { int tid_ = threadIdx.x; asm volatile("" : "+v"(tid_));   \
            if (tid_ == 0) MISC[24 + sl_] = pend_; __syncthreads(); const unsigned q = MISC[24 + sl_]; sl_ ^= 1; if (q >= NQC) break; \
            if (tid_ == 0) pend_ = atomicAdd(qhead + 64, 1u); \
            QT0(); conv_chunk(args, (int)q, tid_ & 63, tid_ >> 6); QT1(28); } } while (0)
        if (pref) { CONV_LOOP(); __syncthreads(); }
        { int sl_ = 0;
        for (;;) {
            int tid_ = threadIdx.x; asm volatile("" : "+v"(tid_));
            if (tid_ == 0) MISC[26 + sl_] = atomicAdd(qhead, 1u);
            __syncthreads();
            const unsigned q = MISC[26 + sl_]; sl_ ^= 1;
            if (q >= NQA) break;
            QT0();
            if (q < NQ_POOL) { pool_chunk(args, (int)q, tid_); }
            else { const int grp = (int)(q - NQ_POOL), qb = 31 - (grp >> 5), bh = grp & 31;
                const float qkb2 = 4.0f * sqrtf(nrm[bh] * nrm[32 + bh]) * 1.001f;
                attn_body::attn_unit<MK_THRL>(bh / NH, bh % NH, qb, AT.Q, AT.K, AT.V, AT.O, (char*)lds + RING_OFF, c2_prepare(args, L, bh, qb, qkb2, tid_), ((MK_TPROBE) == 400) ? (unsigned*)(ws + WS_CTL) + 513 : nullptr); }
            if (q < NQ_POOL) QT1(26); else QT1(27);
        } }
#ifndef MK_CONV_HELP
#define MK_CONV_HELP 1
#endif
        if (MK_CONV_HELP) { __syncthreads(); CONV_LOOP(); }
#undef CONV_LOOP
    }
    CK1(2); SEAM(2); TP1(2); TP0(3); CK0(3);
    if (IN(3)) REPS(3) {
        pg8::Gemm g{(const bf16*)(ws + WS_CAT), (const bf16*)(ws + WS_WO), DM}; pg8::StaticOrder S; S.init(T, DM, G, bx);
        pg8::EpiResBf16 E{args.in[0], (bf16*)(ws + WS_X1B)};
        pg8::gemm_phase<pg8::EpiResBf16, pg8::StaticOrder, true, false>(L + RING_OFF, g, S, E, nullptr);
    }
    CK1(3); SEAM(3); TP1(3); TP0(4); CK0(4);
    if (IN(4)) { router_phase(args, L, vcu, G, tid, lane, wave); }
    CK1(4); SEAM(4); TP1(4); TP0(5); CK0(5);
    if (IN(5)) REPS(5) {
        TP0(51); expert_map(args, MISC, tid);
        const LAS int* pt = (const LAS int*)(L + LDSCTL_OFF + 96 * 4); const LAS int* cn = (const LAS int*)(L + LDSCTL_OFF + 64 * 4);
        LAS unsigned* tab = (LAS unsigned*)(L + TAB_OFF);
        LAS int* ul = (LAS int*)(L + LDSCTL_OFF + 132 * 4);
        pg8::MoeOrder<8>::build(ul, pt, bx, tid);
        const pg8::MoeOrder<8> S{ul, (size_t)2048 * DM};
        { const int* LTK = (const int*)(ws + WS_LTK); const int nu = ul[0];
          for (int idx = tid; idx < nu * 256; idx += NWAVES * 64) { const int i = idx >> 8, r = idx & 255, e = ul[6 + 4 * i], slot = ul[7 + 4 * i] + r;
              const int tok = slot < cn[e] ? (LTK[(size_t)e * T + slot] >> 2) : 0; tab[idx] = (unsigned)tok * (unsigned)DM; } }
        __syncthreads(); TP1(51);
        pg8::Gemm g{(const bf16*)(ws + WS_XN), (const bf16*)(ws + WS_WU), DM / 2};
        pg8::EpiSwiglu8 E{ws + WS_ACT, args.in[11]};
        pg8::gemm_phase<pg8::EpiSwiglu8, pg8::MoeOrder<8>, true, true, true, 0, MK_SP2>(L + RING_OFF, g, S, E, tab, ((MK_TPROBE) == 52 && bx == 0) ? (volatile LAS unsigned*)(MISC + 20) : nullptr);
    }
#ifdef MK_ABL
    {
        xcd_barrier(bar);
        const pg8::MoeOrder<8> S2{(const LAS int*)(L + LDSCTL_OFF + 132 * 4), (size_t)2048 * DM};
        pg8::Gemm g2{(const bf16*)(ws + WS_XN), (const bf16*)(ws + WS_WU), DM / 2}; pg8::EpiSwiglu8 E2{ws + WS_Y, args.in[11]};
        pg8::gemm_phase<pg8::EpiSwiglu8, pg8::MoeOrder<8>, true, true, true, MK_ABL>(L + RING_OFF, g2, S2, E2, (const LAS unsigned*)(L + TAB_OFF));
    }
#endif
    CK1(5); SEAM(5); TP1(5); TP0(6); CK0(6);
    if (IN(6)) REPS(6) {
        expert_map(args, MISC, tid);
        const LAS int* pt = (const LAS int*)(L + LDSCTL_OFF + 96 * 4); const LAS int* cn = (const LAS int*)(L + LDSCTL_OFF + 64 * 4);
        LAS int* ul = (LAS int*)(L + LDSCTL_OFF + 132 * 4);
        pg8::MoeOrder<4>::build(ul, pt, bx, tid);
        const pg8::MoeOrder<4> S{ul, (size_t)DM * DE};
        pg8::Gemm g{(const bf16*)(ws + WS_ACT), (const bf16*)(ws + WS_WD), DE / 2};
        pg8::EpiDown E{ws + WS_Y, args.in[13], (const float*)(ws + WS_LGT), cn, T, pg8::FP8_INV};
        pg8::gemm_phase<pg8::EpiDown, pg8::MoeOrder<4>, true, false, true, 0, MK_SP2>(L + RING_OFF, g, S, E, nullptr);
    }
    CK1(6); SEAM(6); TP1(6); TP0(7); CK0(7); TP0(70);
    if (IN(7)) { expert_map(args, MISC, tid); final_phase(args, MISC, vcu, G, lane, wave); }
    if ((MK_TPROBE) == 70) { xcd_barrier(bar); }
    TP1(7); TP1(70); TP1(200);
    if ((MK_TPROBE) >= 0 && bx == 0) { __syncthreads(); const unsigned long long ta = ((unsigned long long)MISC[17] << 32) | MISC[16], tb = ((MK_TPROBE) == 400) ? ta + (__hip_atomic_load((unsigned*)(ws + WS_CTL) + 513, RLX_AGENT) * 1000u >> 10) : ((MK_TPROBE) == 300 || (MK_TPROBE) == 301) ? ta + MISC[21] : ((MK_TPROBE) >= 26 && (MK_TPROBE) <= 29) ? ta + (__hip_atomic_load((unsigned*)(ws + WS_CTL) + 512, RLX_AGENT) >> 8) : ((MK_TPROBE) == 52 || ((MK_TPROBE) >= 23 && (MK_TPROBE) <= 25)) ? ta + MISC[20] : (((unsigned long long)MISC[19] << 32) | MISC[18]);
        const unsigned long long tend = __builtin_amdgcn_s_memrealtime() + (tb - ta); while (__builtin_amdgcn_s_memrealtime() < tend) __builtin_amdgcn_s_sleep(10); }
#undef IN
#undef SEAM
}
extern "C" void kernel_launch(void* const* d_in, const int* in_sizes, int n_in, void* d_out, int out_size, void* d_ws, size_t ws_size, hipStream_t stream) {
    if (n_in != 15 || out_size != T * DM || ws_size < WS_END) { fprintf(stderr, "kernel_launch: unexpected shapes (n_in %d out %d ws %zu)\n", n_in, out_size, ws_size); return; }
    Args a{};
    for (int i = 0; i < 15; ++i) a.in[i] = (const float*)d_in[i];
    a.out = (float*)d_out; a.ws = (unsigned char*)d_ws;
    static bool attr_done = false;
    if (!attr_done) { if (hipFuncSetAttribute((const void*)mk_fwd, hipFuncAttributeMaxDynamicSharedMemorySize, LDS_TOTAL) != hipSuccess) fprintf(stderr, "kernel_launch: hipFuncSetAttribute failed\n"); attr_done = true; }
    (void)hipMemsetAsync((char*)d_ws + WS_CTL, 0, 64 * 1024, stream);
    a.ph_lo = 0; a.ph_hi = N_PHASES; a.use_bar = 1;
    hipLaunchKernelGGL(mk_fwd, dim3(256), dim3(NWAVES * 64), LDS_TOTAL, stream, a);
}
```
